# Optimizing an MI355X kernel written in HIP

```python
import jax, jax.numpy as jnp
from jax import lax
import numpy as np

D_MODEL = 1024
BATCH = 16
SEQ = 2048
DEPTH = 1
DEC_BATCH = 16
DEC_SEQ = 64
PAST_LEN = 4096

CHUNK = 64
HEAD_DIM = 64
SB_HEADS = 8
FOX_HEADS = 8
SB_WIDTH = SB_HEADS * HEAD_DIM
FOX_WIDTH = FOX_HEADS * HEAD_DIM
MIX_WIDTH = SB_WIDTH + FOX_WIDTH
IN_COLS = 3 * SB_WIDTH + 3 * FOX_WIDTH + FOX_HEADS
QBLOCK = 128
N_MEM = 256
MEM_HEADS = 4
MEM_HEAD_DIM = D_MODEL // MEM_HEADS
PEER_HEADS = 8
PEER_NKEYS = 128
PEER_EXPERTS = PEER_NKEYS * PEER_NKEYS
PEER_TOPK = 16
PEER_QDIM = 256
PEER_HALF = PEER_QDIM // 2
TOK_BLOCK = 128
DN_ALPHA = (2.0 * DEPTH) ** 0.25
DN_BETA = (8.0 * DEPTH) ** -0.25
LN_EPS = 1e-5
GN_EPS = 1e-6

kernel_name = 'stickbreak_fox_peer_stream_encoder_step'

F32 = jnp.float32


def _layer_norm(x, g, b):
    xf = x.astype(F32)
    mu = jnp.mean(xf, axis=-1, keepdims=True)
    var = jnp.mean(jnp.square(xf - mu), axis=-1, keepdims=True)
    return ((xf - mu) * lax.rsqrt(var + LN_EPS) * g.astype(F32) + b.astype(F32)).astype(x.dtype)


def _group_rms(o, g):
    return o * lax.rsqrt(jnp.mean(jnp.square(o), axis=-1, keepdims=True) + GN_EPS) * g.astype(F32)


def _query_blocks(q, q_pos):
    B, Tq, H, dh = q.shape
    qb = min(QBLOCK, Tq)
    nb = Tq // qb
    qs = q.astype(F32).reshape(B, nb, qb, H, dh).transpose(1, 0, 2, 3, 4)
    return qs, q_pos.reshape(nb, qb), nb, qb


def _stick_breaking_attn(q, k, v, q_pos, k_pos):
    B, Tq, H, dh = q.shape
    qs, ps, nb, qb = _query_blocks(q, q_pos)
    kf = k.astype(F32)
    vf = v.astype(F32)
    scale = HEAD_DIM ** -0.5

    def one(args):
        qblk, pblk = args
        z = jnp.einsum('bqhd,bkhd->bhqk', qblk, kf) * scale
        mask = (k_pos[None, :] < pblk[:, None])[None, None]
        log_keep = jnp.where(mask, -jax.nn.softplus(z), 0.0)
        later = lax.cumsum(log_keep, axis=3, reverse=True) - log_keep
        w = jnp.where(mask, jnp.exp(jax.nn.log_sigmoid(z) + later), 0.0)
        return jnp.einsum('bhqk,bkhd->bqhd', w, vf)

    o = lax.map(one, (qs, ps))
    return o.transpose(1, 0, 2, 3, 4).reshape(B, Tq, H * dh)


def _forgetting_attn(q, k, v, cq, ck, q_pos, k_pos):
    B, Tq, H, dh = q.shape
    qs, ps, nb, qb = _query_blocks(q, q_pos)
    cqs = cq.reshape(B, nb, qb, H).transpose(1, 0, 3, 2)
    ckT = ck.transpose(0, 2, 1)
    kf = k.astype(F32)
    vf = v.astype(F32)
    scale = HEAD_DIM ** -0.5

    def one(args):
        qblk, pblk, cblk = args
        s = jnp.einsum('bqhd,bkhd->bhqk', qblk, kf) * scale + cblk[..., None] - ckT[:, :, None, :]
        mask = (k_pos[None, :] <= pblk[:, None])[None, None]
        p = jax.nn.softmax(jnp.where(mask, s, -jnp.inf), axis=-1)
        return jnp.einsum('bhqk,bkhd->bqhd', p, vf)

    o = lax.map(one, (qs, ps, cqs))
    return o.transpose(1, 0, 2, 3, 4).reshape(B, Tq, H * dh)


def _mixer(x, sb_k_past, sb_v_past, fx_k_past, fx_v_past, fx_logf_past, w_in, b_f, w_gn, w_out):
    B, T, _ = x.shape
    P = sb_k_past.shape[1]
    proj = x @ w_in
    cuts = [SB_WIDTH, 2 * SB_WIDTH, 3 * SB_WIDTH, 3 * SB_WIDTH + FOX_WIDTH,
            3 * SB_WIDTH + 2 * FOX_WIDTH, 3 * SB_WIDTH + 3 * FOX_WIDTH]
    q_sb, k_sb, v_sb, q_fx, k_fx, v_fx, f_logit = jnp.split(proj, cuts, axis=-1)
    hs = lambda a, h: a.reshape(B, T, h, HEAD_DIM)
    q_sb, k_sb, v_sb = hs(q_sb, SB_HEADS), hs(k_sb, SB_HEADS), hs(v_sb, SB_HEADS)
    q_fx, k_fx, v_fx = hs(q_fx, FOX_HEADS), hs(k_fx, FOX_HEADS), hs(v_fx, FOX_HEADS)
    logf = jax.nn.log_sigmoid((f_logit + b_f).astype(F32))

    k_pos = jnp.arange(P + T, dtype=jnp.int32)
    q_pos = P + jnp.arange(T, dtype=jnp.int32)
    k_sb_all = jnp.concatenate([sb_k_past.astype(x.dtype), k_sb], axis=1)
    v_sb_all = jnp.concatenate([sb_v_past.astype(x.dtype), v_sb], axis=1)
    k_fx_all = jnp.concatenate([fx_k_past.astype(x.dtype), k_fx], axis=1)
    v_fx_all = jnp.concatenate([fx_v_past.astype(x.dtype), v_fx], axis=1)
    c_all = lax.cumsum(jnp.concatenate([fx_logf_past.astype(F32), logf], axis=1), axis=1)

    o_sb = _stick_breaking_attn(q_sb, k_sb_all, v_sb_all, q_pos, k_pos)
    o_fx = _forgetting_attn(q_fx, k_fx_all, v_fx_all, c_all[:, P:], c_all, q_pos, k_pos)
    o = jnp.concatenate([_group_rms(o_sb, w_gn[:SB_WIDTH]), _group_rms(o_fx, w_gn[SB_WIDTH:])], axis=-1)
    y = o.astype(x.dtype) @ w_out
    return y, (k_sb, v_sb, k_fx, v_fx, logf.astype(x.dtype))


def _mem_kv(mem, w_mk, w_mv):
    B, M, _ = mem.shape
    mk = (mem @ w_mk).reshape(B, M, MEM_HEADS, MEM_HEAD_DIM)
    mv = (mem @ w_mv).reshape(B, M, MEM_HEADS, MEM_HEAD_DIM)
    return mk, mv


def _mem_attn(x, mk, mv, w_mq, w_mo):
    B, T, _ = x.shape
    q = (x @ w_mq).reshape(B, T, MEM_HEADS, MEM_HEAD_DIM).astype(F32)
    s = jnp.einsum('bthd,bmhd->bhtm', q, mk.astype(F32)) * (MEM_HEAD_DIM ** -0.5)
    p = jax.nn.softmax(s, axis=-1)
    o = jnp.einsum('bhtm,bmhd->bthd', p, mv.astype(F32)).reshape(B, T, D_MODEL)
    return o.astype(x.dtype) @ w_mo


def _peer(x, w_pq, keys_a, keys_b, u, v):
    B, T, D = x.shape
    n = B * T
    xf = x.reshape(n, D)
    q = (xf @ w_pq).astype(F32).reshape(n, PEER_HEADS, 2, PEER_HALF)
    sa = jnp.einsum('nhd,hkd->nhk', q[:, :, 0], keys_a.astype(F32))
    sb = jnp.einsum('nhd,hkd->nhk', q[:, :, 1], keys_b.astype(F32))
    va, ia = lax.top_k(sa, PEER_TOPK)
    vb, ib = lax.top_k(sb, PEER_TOPK)
    cand = (va[..., :, None] + vb[..., None, :]).reshape(n, PEER_HEADS, PEER_TOPK * PEER_TOPK)
    cidx = (ia[..., :, None] * PEER_NKEYS + ib[..., None, :]).reshape(n, PEER_HEADS, PEER_TOPK * PEER_TOPK)
    top, pos = lax.top_k(cand, PEER_TOPK)
    idx = jnp.take_along_axis(cidx, pos, axis=-1)
    g = jax.nn.softmax(top, axis=-1)

    blk = min(TOK_BLOCK, n)
    pad = (-n) % blk
    nb = (n + pad) // blk
    xb = jnp.pad(xf, ((0, pad), (0, 0))).reshape(nb, blk, D)
    ibk = jnp.pad(idx, ((0, pad), (0, 0), (0, 0))).reshape(nb, blk, PEER_HEADS, PEER_TOPK)
    gbk = jnp.pad(g, ((0, pad), (0, 0), (0, 0))).reshape(nb, blk, PEER_HEADS, PEER_TOPK)

    def one(args):
        xx, ii, gg = args
        ue = jnp.take(u, ii, axis=0).astype(F32)
        h = jax.nn.gelu(jnp.einsum('nd,nhkd->nhk', xx.astype(F32), ue), approximate=False) * gg
        ve = jnp.take(v, ii, axis=0).astype(F32)
        return jnp.einsum('nhk,nhkd->nd', h, ve)

    out = lax.map(one, (xb, ibk, gbk)).reshape(nb * blk, D)[:n]
    return out.reshape(B, T, D).astype(x.dtype)


def _layer(x, sb_k_past, sb_v_past, fx_k_past, fx_v_past, fx_logf_past, mem_k, mem_v,
           w_in, b_f, w_gn, w_out, ln1_g, ln1_b, w_mq, w_mo, ln2_g, ln2_b,
           w_pq, keys_a, keys_b, u, v, ln3_g, ln3_b):
    mix, new_state = _mixer(x, sb_k_past, sb_v_past, fx_k_past, fx_v_past, fx_logf_past, w_in, b_f, w_gn, w_out)
    x = _layer_norm(DN_ALPHA * x + mix, ln1_g, ln1_b)
    x = _layer_norm(DN_ALPHA * x + _mem_attn(x, mem_k, mem_v, w_mq, w_mo), ln2_g, ln2_b)
    x = _layer_norm(DN_ALPHA * x + _peer(x, w_pq, keys_a, keys_b, u, v), ln3_g, ln3_b)
    return x, new_state


def setup_inputs(seed: int = 0) -> dict:
    key = jax.random.key(seed)
    ks = jax.random.split(key, 40)
    nrm = lambda k, shape, s: jax.random.normal(k, shape, F32) * s
    L = DEPTH
    kv_shape = (L, DEC_BATCH, PAST_LEN, SB_HEADS, HEAD_DIM)
    fx_shape = (L, DEC_BATCH, PAST_LEN, FOX_HEADS, HEAD_DIM)
    mem_shape = (L, DEC_BATCH, N_MEM, MEM_HEADS, MEM_HEAD_DIM)
    return {
        'x_prompt': nrm(ks[0], (BATCH, SEQ, D_MODEL), 1.0),
        'x_sample': nrm(ks[1], (DEC_BATCH, DEC_SEQ, D_MODEL), 1.0),
        'mem_prompt': nrm(ks[2], (BATCH, N_MEM, D_MODEL), 1.0),
        'cache_sb_k': nrm(ks[3], kv_shape, 1.0),
        'cache_sb_v': nrm(ks[4], kv_shape, 1.0),
        'cache_fox_k': nrm(ks[5], fx_shape, 1.0),
        'cache_fox_v': nrm(ks[6], fx_shape, 1.0),
        'cache_fox_logf': jax.nn.log_sigmoid(3.0 + nrm(ks[7], (L, DEC_BATCH, PAST_LEN, FOX_HEADS), 1.0)),
        'cache_mem_k': nrm(ks[8], mem_shape, 1.0),
        'cache_mem_v': nrm(ks[9], mem_shape, 1.0),
        'w_in': nrm(ks[10], (L, D_MODEL, IN_COLS), D_MODEL ** -0.5),
        'b_f': 3.0 + nrm(ks[11], (L, FOX_HEADS), 0.5),
        'w_gn': 1.0 + nrm(ks[12], (L, MIX_WIDTH), 0.02),
        'w_out': nrm(ks[13], (L, MIX_WIDTH, D_MODEL), DN_BETA * MIX_WIDTH ** -0.5),
        'ln1_g': 1.0 + nrm(ks[14], (L, D_MODEL), 0.02),
        'ln1_b': nrm(ks[15], (L, D_MODEL), 0.02),
        'w_mq': nrm(ks[16], (L, D_MODEL, D_MODEL), D_MODEL ** -0.5),
        'w_mk': nrm(ks[17], (L, D_MODEL, D_MODEL), D_MODEL ** -0.5),
        'w_mv': nrm(ks[18], (L, D_MODEL, D_MODEL), D_MODEL ** -0.5),
        'w_mo': nrm(ks[19], (L, D_MODEL, D_MODEL), DN_BETA * D_MODEL ** -0.5),
        'ln2_g': 1.0 + nrm(ks[20], (L, D_MODEL), 0.02),
        'ln2_b': nrm(ks[21], (L, D_MODEL), 0.02),
        'w_pq': nrm(ks[22], (L, D_MODEL, PEER_HEADS * PEER_QDIM), D_MODEL ** -0.5),
        'peer_keys_a': nrm(ks[23], (L, PEER_HEADS, PEER_NKEYS, PEER_HALF), PEER_HALF ** -0.5),
        'peer_keys_b': nrm(ks[24], (L, PEER_HEADS, PEER_NKEYS, PEER_HALF), PEER_HALF ** -0.5),
        'peer_u': nrm(ks[25], (L, PEER_EXPERTS, D_MODEL), D_MODEL ** -0.5),
        'peer_v': nrm(ks[26], (L, PEER_EXPERTS, D_MODEL), DN_BETA * PEER_HEADS ** -0.5),
        'ln3_g': 1.0 + nrm(ks[27], (L, D_MODEL), 0.02),
        'ln3_b': nrm(ks[28], (L, D_MODEL), 0.02),
    }


def reference(x_prompt, x_sample, mem_prompt, cache_sb_k, cache_sb_v, cache_fox_k, cache_fox_v,
              cache_fox_logf, cache_mem_k, cache_mem_v, w_in, b_f, w_gn, w_out, ln1_g, ln1_b,
              w_mq, w_mk, w_mv, w_mo, ln2_g, ln2_b, w_pq, peer_keys_a, peer_keys_b, peer_u, peer_v,
              ln3_g, ln3_b):
    hp = x_prompt
    hs = x_sample
    Bp = x_prompt.shape[0]
    p_sbk, p_sbv, p_fxk, p_fxv, p_lf, p_mk, p_mv = [], [], [], [], [], [], []
    s_sbk, s_sbv, s_fxk, s_fxv, s_lf = [], [], [], [], []
    for l in range(DEPTH):
        weights = (w_in[l], b_f[l], w_gn[l], w_out[l], ln1_g[l], ln1_b[l], w_mq[l], w_mo[l], ln2_g[l], ln2_b[l],
                   w_pq[l], peer_keys_a[l], peer_keys_b[l], peer_u[l], peer_v[l], ln3_g[l], ln3_b[l])
        mk_p, mv_p = _mem_kv(mem_prompt, w_mk[l], w_mv[l])
        e_sb = jnp.zeros((Bp, 0, SB_HEADS, HEAD_DIM), hp.dtype)
        e_fx = jnp.zeros((Bp, 0, FOX_HEADS, HEAD_DIM), hp.dtype)
        e_lf = jnp.zeros((Bp, 0, FOX_HEADS), F32)
        hp, st_p = _layer(hp, e_sb, e_sb, e_fx, e_fx, e_lf, mk_p, mv_p, *weights)
        hs, st_s = _layer(hs, cache_sb_k[l], cache_sb_v[l], cache_fox_k[l], cache_fox_v[l], cache_fox_logf[l],
                          cache_mem_k[l], cache_mem_v[l], *weights)
        p_sbk.append(st_p[0]); p_sbv.append(st_p[1]); p_fxk.append(st_p[2]); p_fxv.append(st_p[3]); p_lf.append(st_p[4])
        p_mk.append(mk_p); p_mv.append(mv_p)
        s_sbk.append(st_s[0]); s_sbv.append(st_s[1]); s_fxk.append(st_s[2]); s_fxv.append(st_s[3]); s_lf.append(st_s[4])
    y_prompt = hp
    y_sample = hs
    new_sb_k_p = jnp.stack(p_sbk)
    new_sb_v_p = jnp.stack(p_sbv)
    new_fox_k_p = jnp.stack(p_fxk)
    new_fox_v_p = jnp.stack(p_fxv)
    new_fox_logf_p = jnp.stack(p_lf)
    new_mem_k_p = jnp.stack(p_mk)
    new_mem_v_p = jnp.stack(p_mv)
    new_sb_k_s = jnp.stack(s_sbk)
    new_sb_v_s = jnp.stack(s_sbv)
    new_fox_k_s = jnp.stack(s_fxk)
    new_fox_v_s = jnp.stack(s_fxv)
    new_fox_logf_s = jnp.stack(s_lf)
    return (y_prompt, y_sample, new_sb_k_p, new_sb_v_p, new_fox_k_p, new_fox_v_p, new_fox_logf_p,
            new_mem_k_p, new_mem_v_p, new_sb_k_s, new_sb_v_s, new_fox_k_s, new_fox_v_s, new_fox_logf_s)
```

```cpp
#include <hip/hip_runtime.h>
#include <hip/hip_cooperative_groups.h>
#include <cstdio>
#include <cstdint>
namespace cg = cooperative_groups;

#ifndef ONE_LAUNCH
#define ONE_LAUNCH 0
#endif

#define DI __device__ __forceinline__
typedef unsigned short u16;
typedef short bf16x8 __attribute__((ext_vector_type(8)));
typedef short s16x4 __attribute__((ext_vector_type(4)));
typedef float f32x16 __attribute__((ext_vector_type(16)));
typedef __bf16 bf2_t __attribute__((ext_vector_type(2)));
typedef float f2_t __attribute__((ext_vector_type(2)));
#define MFMA(a, b, c) __builtin_amdgcn_mfma_f32_32x32x16_bf16((a), (b), (c), 0, 0, 0)

constexpr int DM = 1024;
constexpr int NTP = 32768;
constexpr int NTS = 1024;
constexpr int NT = NTP + NTS;
constexpr int SEQ = 2048, DSEQ = 64, PAST = 4096, NMEM = 256;
constexpr int INC = 3080, INCP = 3200;
constexpr float DN_ALPHA = 1.189207115002721f;
constexpr float LOG2E = 1.4426950408889634f;

constexpr size_t OUT_YP = 0;
constexpr size_t OUT_YS = OUT_YP + (size_t)NTP * DM;
constexpr size_t OUT_SBK_P = OUT_YS + (size_t)NTS * DM;
constexpr size_t OUT_SBV_P = OUT_SBK_P + (size_t)NTP * 512;
constexpr size_t OUT_FXK_P = OUT_SBV_P + (size_t)NTP * 512;
constexpr size_t OUT_FXV_P = OUT_FXK_P + (size_t)NTP * 512;
constexpr size_t OUT_LF_P = OUT_FXV_P + (size_t)NTP * 512;
constexpr size_t OUT_MK_P = OUT_LF_P + (size_t)NTP * 8;
constexpr size_t OUT_MV_P = OUT_MK_P + (size_t)4096 * DM;
constexpr size_t OUT_SBK_S = OUT_MV_P + (size_t)4096 * DM;
constexpr size_t OUT_SBV_S = OUT_SBK_S + (size_t)NTS * 512;
constexpr size_t OUT_FXK_S = OUT_SBV_S + (size_t)NTS * 512;
constexpr size_t OUT_FXV_S = OUT_FXK_S + (size_t)NTS * 512;
constexpr size_t OUT_LF_S = OUT_FXV_S + (size_t)NTS * 512;
constexpr size_t OUT_TOTAL = OUT_LF_S + (size_t)NTS * 8;

constexpr size_t WS_WIN = 0;
constexpr size_t WS_WOUT = WS_WIN + (size_t)INCP * DM * 2;
constexpr size_t WS_WMQ = WS_WOUT + (size_t)DM * DM * 2;
constexpr size_t WS_WMKV = WS_WMQ + (size_t)DM * DM * 2;
constexpr size_t WS_WMO = WS_WMKV + (size_t)2048 * DM * 2;
constexpr size_t WS_WPQ = WS_WMO + (size_t)DM * DM * 2;
constexpr size_t WS_KA = WS_WPQ + (size_t)2048 * DM * 2;
constexpr size_t WS_KB = WS_KA + (size_t)8 * 128 * 128 * 2;
constexpr size_t WS_U = WS_KB + (size_t)8 * 128 * 128 * 2;
constexpr size_t WS_V = WS_U + (size_t)16384 * DM * 2;
constexpr size_t WS_MEMK = WS_V + (size_t)16384 * DM * 2;
constexpr size_t WS_MEMVT = WS_MEMK + (size_t)32 * 256 * DM * 2;
constexpr size_t WS_A = WS_MEMVT + (size_t)32 * 256 * DM * 2;
constexpr size_t WS_B = WS_A + (size_t)NT * DM * 4;
constexpr size_t WS_C = WS_B + (size_t)NT * DM * 4;
constexpr size_t WS_D = WS_C + (size_t)NT * DM * 2;
constexpr size_t WS_E = WS_D + (size_t)NT * DM * 2;
constexpr size_t WS_F = WS_E + (size_t)NT * DM * 2;
constexpr size_t WS_TOTAL = WS_F + (size_t)NT * DM * 4;

struct Params {
  const float *x_prompt, *x_sample, *mem_prompt, *c_sb_k, *c_sb_v, *c_fx_k, *c_fx_v, *c_fx_logf, *c_mem_k, *c_mem_v;
  const float *w_in, *b_f, *w_gn, *w_out, *ln1_g, *ln1_b, *w_mq, *w_mk, *w_mv, *w_mo, *ln2_g, *ln2_b;
  const float *w_pq, *keys_a, *keys_b, *peer_u, *peer_v, *ln3_g, *ln3_b;
  float* out;
  char* ws;
};

constexpr int SMEM_BYTES = 73728 + 1024;

DI unsigned pk2(float a, float b) { f2_t v = {a, b}; bf2_t r = __builtin_convertvector(v, bf2_t); return __builtin_bit_cast(unsigned, r); }
DI u16 bf1(float a) { return (u16)(pk2(a, 0.f) & 0xffffu); }
DI float bflo(unsigned w) { return __uint_as_float(w << 16); }
DI float bfhi(unsigned w) { return __uint_as_float(w & 0xffff0000u); }
DI float wave_sum(float v) {
#pragma unroll
  for (int o = 32; o >= 1; o >>= 1) v += __shfl_xor(v, o);
  return v;
}
DI float wave_max(float v) {
#pragma unroll
  for (int o = 32; o >= 1; o >>= 1) v = fmaxf(v, __shfl_xor(v, o));
  return v;
}
DI int vblock() { int nb = gridDim.x, b = blockIdx.x; return ((nb & 7) == 0) ? (b & 7) * (nb >> 3) + (b >> 3) : b; }
DI const float* xrow(const Params& p, int g) { return g < NTP ? p.x_prompt + (size_t)g * DM : p.x_sample + (size_t)(g - NTP) * DM; }

DI void tconv_tile(const float* src, int ldsrc, int C, u16* dst, int lddst, const float* rowscale, int tr, int tc, float* tile) {
  const int tid = threadIdx.x;
  {
    const int r = tid >> 2, c0 = (tid & 3) * 16;
    const int gr = tr * 64 + r;
    const float sc = rowscale ? rowscale[gr] : 1.f;
#pragma unroll
    for (int j = 0; j < 4; ++j) {
      const int gc = tc * 64 + c0 + 4 * j;
      float4 v = make_float4(0.f, 0.f, 0.f, 0.f);
      if (gc < C) v = *(const float4*)(src + (size_t)gr * ldsrc + gc);
      float* t = tile + r * 65 + c0 + 4 * j;
      t[0] = v.x * sc; t[1] = v.y * sc; t[2] = v.z * sc; t[3] = v.w * sc;
    }
  }
  __syncthreads();
  {
    const int n = tid >> 2, k0 = (tid & 3) * 16;
    unsigned w[8];
#pragma unroll
    for (int e = 0; e < 8; ++e) w[e] = pk2(tile[(k0 + 2 * e) * 65 + n], tile[(k0 + 2 * e + 1) * 65 + n]);
    uint4* d = (uint4*)(dst + (size_t)(tc * 64 + n) * lddst + tr * 64 + k0);
    d[0] = make_uint4(w[0], w[1], w[2], w[3]);
    d[1] = make_uint4(w[4], w[5], w[6], w[7]);
  }
  __syncthreads();
}

DI void conv_range(const float* src, u16* dst, size_t n8, int bid, int nb) {
  for (size_t i = (size_t)bid * 256 + threadIdx.x; i < n8; i += (size_t)nb * 256) {
    const float4 a = ((const float4*)src)[2 * i], b = ((const float4*)src)[2 * i + 1];
    ((uint4*)dst)[i] = make_uint4(pk2(a.x, a.y), pk2(a.z, a.w), pk2(b.x, b.y), pk2(b.z, b.w));
  }
}

DI void phase_prep(const Params& p, char* smem) {
  float* tile = (float*)smem;
  const int bid = blockIdx.x, nb = gridDim.x;
  u16* ws16 = (u16*)p.ws;
  constexpr int T_WIN = 16 * 50, T_SQ = 256, T_PQ = 16 * 32, T_MV = 16 * 4 * 16;
  constexpr int T0 = T_WIN, T1 = T0 + T_SQ, T2 = T1 + T_SQ, T3 = T2 + T_SQ, T4 = T3 + T_SQ, T5 = T4 + T_SQ, T6 = T5 + T_PQ, T7 = T6 + T_MV;
  for (int t = bid; t < T7; t += nb) {
    if (t < T0) { tconv_tile(p.w_in, INC, INC, (u16*)(p.ws + WS_WIN), DM, nullptr, t / 50, t % 50, tile); }
    else if (t < T1) { int u = t - T0; tconv_tile(p.w_out, DM, DM, (u16*)(p.ws + WS_WOUT), DM, p.w_gn, u >> 4, u & 15, tile); }
    else if (t < T2) { int u = t - T1; tconv_tile(p.w_mq, DM, DM, (u16*)(p.ws + WS_WMQ), DM, nullptr, u >> 4, u & 15, tile); }
    else if (t < T3) { int u = t - T2; tconv_tile(p.w_mk, DM, DM, (u16*)(p.ws + WS_WMKV), DM, nullptr, u >> 4, u & 15, tile); }
    else if (t < T4) { int u = t - T3; tconv_tile(p.w_mv, DM, DM, (u16*)(p.ws + WS_WMKV) + (size_t)DM * DM, DM, nullptr, u >> 4, u & 15, tile); }
    else if (t < T5) { int u = t - T4; tconv_tile(p.w_mo, DM, DM, (u16*)(p.ws + WS_WMO), DM, nullptr, u >> 4, u & 15, tile); }
    else if (t < T6) { int u = t - T5; tconv_tile(p.w_pq, 2048, 2048, (u16*)(p.ws + WS_WPQ), DM, nullptr, u >> 5, u & 31, tile); }
    else { int u = t - T6; int b = u >> 6, r = u & 63;
      tconv_tile(p.c_mem_v + (size_t)b * 256 * DM, DM, DM, (u16*)(p.ws + WS_MEMVT) + (size_t)(16 + b) * DM * 256, 256, nullptr, r >> 4, r & 15, tile); }
  }
  (void)ws16;
  conv_range(p.c_mem_k, (u16*)(p.ws + WS_MEMK) + (size_t)16 * 256 * DM, (size_t)16 * 256 * DM / 8, bid, nb);
  conv_range(p.keys_a, (u16*)(p.ws + WS_KA), (size_t)8 * 128 * 128 / 8, bid, nb);
  conv_range(p.keys_b, (u16*)(p.ws + WS_KB), (size_t)8 * 128 * 128 / 8, bid, nb);
  conv_range(p.peer_u, (u16*)(p.ws + WS_U), (size_t)16384 * DM / 8, bid, nb);
  conv_range(p.peer_v, (u16*)(p.ws + WS_V), (size_t)16384 * DM / 8, bid, nb);
}

constexpr int LLD = 72;
struct SmemGemm { u16 a[2][128 * LLD]; u16 b[2][128 * LLD]; };

struct LdBf16 {
  const u16* base; int ld;
  uint4 r[4];
  DI void fetch(int kt, int tid) {
#pragma unroll
    for (int i = 0; i < 4; ++i) { const int c = tid + 256 * i; r[i] = *(const uint4*)(base + (size_t)(c >> 3) * ld + kt * 64 + (c & 7) * 8); }
  }
  DI void stash(u16* lds, int tid) {
#pragma unroll
    for (int i = 0; i < 4; ++i) { const int c = tid + 256 * i; *(uint4*)(lds + (c >> 3) * LLD + (c & 7) * 8) = r[i]; }
  }
};
struct LdF32 {
  const float* base; int ld;
  float4 r[8];
  DI void fetch(int kt, int tid) {
#pragma unroll
    for (int i = 0; i < 4; ++i) { const int c = tid + 256 * i; const float4* s = (const float4*)(base + (size_t)(c >> 3) * ld + kt * 64 + (c & 7) * 8); r[2 * i] = s[0]; r[2 * i + 1] = s[1]; }
  }
  DI void stash(u16* lds, int tid) {
#pragma unroll
    for (int i = 0; i < 4; ++i) { const int c = tid + 256 * i; const float4 a = r[2 * i], b = r[2 * i + 1];
      *(uint4*)(lds + (c >> 3) * LLD + (c & 7) * 8) = make_uint4(pk2(a.x, a.y), pk2(a.z, a.w), pk2(b.x, b.y), pk2(b.z, b.w)); }
  }
};
struct LdBf16Scaled {
  const u16* base; int ld; const float* sc;
  uint4 r[4];
  int ktc;
  DI void fetch(int kt, int tid) {
    ktc = kt;
#pragma unroll
    for (int i = 0; i < 4; ++i) { const int c = tid + 256 * i; r[i] = *(const uint4*)(base + (size_t)(c >> 3) * ld + kt * 64 + (c & 7) * 8); }
  }
  DI void stash(u16* lds, int tid) {
    const int half = (ktc >= 8) ? 1 : 0;
#pragma unroll
    for (int i = 0; i < 4; ++i) { const int c = tid + 256 * i; const float s = sc[(c >> 3) * 2 + half]; const uint4 v = r[i];
      *(uint4*)(lds + (c >> 3) * LLD + (c & 7) * 8) = make_uint4(pk2(bflo(v.x) * s, bfhi(v.x) * s), pk2(bflo(v.y) * s, bfhi(v.y) * s),
                                                               pk2(bflo(v.z) * s, bfhi(v.z) * s), pk2(bflo(v.w) * s, bfhi(v.w) * s)); }
  }
};

template <class AL, class EPI>
DI void gemm_tile(AL& al, const u16* Bt, int ldb, int K, int m0, int n0, EPI epi, char* smem) {
  SmemGemm& sm = *(SmemGemm*)smem;
  const int tid = threadIdx.x, lane = tid & 63, wid = tid >> 6, wr = wid >> 1, wc = wid & 1;
  LdBf16 bl; bl.base = Bt + (size_t)n0 * ldb; bl.ld = ldb;
  f32x16 acc[2][2];
#pragma unroll
  for (int i = 0; i < 2; ++i)
#pragma unroll
    for (int j = 0; j < 2; ++j)
#pragma unroll
      for (int e = 0; e < 16; ++e) acc[i][j][e] = 0.f;
  const int KT = K >> 6;
  al.fetch(0, tid); bl.fetch(0, tid);
  al.stash(sm.a[0], tid); bl.stash(sm.b[0], tid);
  __syncthreads();
  for (int kt = 0; kt < KT; ++kt) {
    const int cur = kt & 1;
    if (kt + 1 < KT) { al.fetch(kt + 1, tid); bl.fetch(kt + 1, tid); }
    const u16* pa = sm.a[cur] + (wr * 64 + (lane & 31)) * LLD + (lane >> 5) * 8;
    const u16* pb = sm.b[cur] + (wc * 64 + (lane & 31)) * LLD + (lane >> 5) * 8;
#pragma unroll
    for (int kk = 0; kk < 4; ++kk) {
      const bf16x8 a0 = *(const bf16x8*)(pa + kk * 16), a1 = *(const bf16x8*)(pa + 32 * LLD + kk * 16);
      const bf16x8 b0 = *(const bf16x8*)(pb + kk * 16), b1 = *(const bf16x8*)(pb + 32 * LLD + kk * 16);
      acc[0][0] = MFMA(a0, b0, acc[0][0]); acc[0][1] = MFMA(a0, b1, acc[0][1]);
      acc[1][0] = MFMA(a1, b0, acc[1][0]); acc[1][1] = MFMA(a1, b1, acc[1][1]);
    }
    if (kt + 1 < KT) { al.stash(sm.a[cur ^ 1], tid); bl.stash(sm.b[cur ^ 1], tid); }
    __syncthreads();
  }
#pragma unroll
  for (int i = 0; i < 2; ++i)
#pragma unroll
    for (int j = 0; j < 2; ++j) epi(m0 + wr * 64 + i * 32, n0 + wc * 64 + j * 32, acc[i][j]);
}
#define ACC_ROW(e, hh) (((e) & 3) + 8 * ((e) >> 2) + 4 * (hh))

DI void phase_proj(const Params& p, char* smem) {
  const int vb = vblock(), nb = gridDim.x;
  constexpr int T_G1 = 264 * 25, T_MKV = 32 * 16;
  float* out = p.out;
  for (int t = vb; t < T_G1 + T_MKV; t += nb) {
    if (t < T_G1) {
      const int mt = t / 25, nt = t % 25;
      const int m0 = mt * 128, n0 = nt * 128;
      LdF32 al; al.base = xrow(p, m0); al.ld = DM;
      const bool smp = m0 >= NTP;
      const float* b_f = p.b_f;
      u16* qsb = (u16*)(p.ws + WS_D);
      u16* qfx = qsb + (size_t)NT * 512;
      auto epi = [=](int r0, int c0, const f32x16& acc) {
        const int lane = threadIdx.x & 63, hh = lane >> 5, col = c0 + (lane & 31);
        const int seg = c0 >> 9, cc = col & 511;
        if (seg == 0 || seg == 3) {
          u16* q = (seg == 0) ? qsb : qfx;
#pragma unroll
          for (int e = 0; e < 16; ++e) q[(size_t)(r0 + ACC_ROW(e, hh)) * 512 + cc] = bf1(acc[e] * 0.125f);
        } else if (seg < 6) {
          size_t ob;
          if (!smp) ob = (seg == 1) ? OUT_SBK_P : (seg == 2) ? OUT_SBV_P : (seg == 4) ? OUT_FXK_P : OUT_FXV_P;
          else ob = (seg == 1) ? OUT_SBK_S : (seg == 2) ? OUT_SBV_S : (seg == 4) ? OUT_FXK_S : OUT_FXV_S;
          const int rb = smp ? r0 - NTP : r0;
#pragma unroll
          for (int e = 0; e < 16; ++e) out[ob + (size_t)(rb + ACC_ROW(e, hh)) * 512 + cc] = acc[e];
        } else {
          const int c = col - 3072;
          if (c < 8) {
            const float bf = b_f[c];
            const size_t ob = smp ? OUT_LF_S : OUT_LF_P;
            const int rb = smp ? r0 - NTP : r0;
#pragma unroll
            for (int e = 0; e < 16; ++e) {
              const float z = acc[e] + bf;
              const float ls = fminf(z, 0.f) - log1pf(__expf(-fabsf(z)));
              out[ob + (size_t)(rb + ACC_ROW(e, hh)) * 8 + c] = ls;
            }
          }
        }
      };
      gemm_tile(al, (const u16*)(p.ws + WS_WIN), DM, DM, m0, n0, epi, smem);
    } else {
      const int u = t - T_G1;
      const int mt = u >> 4, nt = u & 15;
      const int m0 = mt * 128, n0 = nt * 128;
      LdF32 al; al.base = p.mem_prompt + (size_t)m0 * DM; al.ld = DM;
      u16* kb = (u16*)(p.ws + WS_MEMK);
      u16* vt = (u16*)(p.ws + WS_MEMVT);
      auto epi = [=](int r0, int c0, const f32x16& acc) {
        const int lane = threadIdx.x & 63, hh = lane >> 5, col = c0 + (lane & 31);
        if (c0 < 1024) {
#pragma unroll
          for (int e = 0; e < 16; ++e) { const size_t idx = (size_t)(r0 + ACC_ROW(e, hh)) * DM + col; out[OUT_MK_P + idx] = acc[e]; kb[idx] = bf1(acc[e]); }
        } else {
          const int c = col - 1024;
#pragma unroll
          for (int e = 0; e < 16; ++e) out[OUT_MV_P + (size_t)(r0 + ACC_ROW(e, hh)) * DM + c] = acc[e];
          const int b = r0 >> 8;
#pragma unroll
          for (int g4 = 0; g4 < 4; ++g4) {
            const int m = (r0 & 255) + 8 * g4 + 4 * hh;
            *(uint2*)(vt + ((size_t)b * DM + c) * 256 + m) = make_uint2(pk2(acc[4 * g4], acc[4 * g4 + 1]), pk2(acc[4 * g4 + 2], acc[4 * g4 + 3]));
          }
        }
      };
      gemm_tile(al, (const u16*)(p.ws + WS_WMKV), DM, DM, m0, n0, epi, smem);
    }
  }
}

constexpr int KLD = 72, VLD = 68;
struct SmemAttn { u16 k[2][64 * KLD]; u16 vt[2][64 * VLD]; float cb[4160]; float part[256]; };
static_assert(sizeof(SmemAttn) <= SMEM_BYTES, "attn smem");

struct KVRegs { float4 k[4], v[4]; };
DI void kv_fetch(KVRegs& r, const float* kb, const float* vb, int tid) {
#pragma unroll
  for (int i = 0; i < 4; ++i) { const int c = tid + 256 * i; const size_t o = (size_t)(c >> 4) * 512 + (c & 15) * 4; r.k[i] = *(const float4*)(kb + o); r.v[i] = *(const float4*)(vb + o); }
}
DI void kv_stash(const KVRegs& r, u16* ks, u16* vts, int tid) {
#pragma unroll
  for (int i = 0; i < 4; ++i) {
    const int c = tid + 256 * i; const int row = c >> 4, c4 = (c & 15) * 4;
    *(uint2*)(ks + row * KLD + c4) = make_uint2(pk2(r.k[i].x, r.k[i].y), pk2(r.k[i].z, r.k[i].w));
    vts[(c4 + 0) * VLD + row] = bf1(r.v[i].x); vts[(c4 + 1) * VLD + row] = bf1(r.v[i].y);
    vts[(c4 + 2) * VLD + row] = bf1(r.v[i].z); vts[(c4 + 3) * VLD + row] = bf1(r.v[i].w);
  }
}
DI bf16x8 pack8(const f32x16& x, int s) {
  union { unsigned u[4]; bf16x8 v; } t;
  t.u[0] = pk2(x[8 * s + 0], x[8 * s + 1]); t.u[1] = pk2(x[8 * s + 2], x[8 * s + 3]);
  t.u[2] = pk2(x[8 * s + 4], x[8 * s + 5]); t.u[3] = pk2(x[8 * s + 6], x[8 * s + 7]);
  return t.v;
}

template <bool FOX>
DI void attn_item(const Params& p, int smp, int b, int h, int qb, char* smem) {
  SmemAttn& sm = *(SmemAttn*)smem;
  const int tid = threadIdx.x, lane = tid & 63, wid = tid >> 6, r31 = lane & 31, hh = lane >> 5;
  const int nkt = smp ? 65 : 2 * qb + 2;
  const int jdiag = smp ? 64 : 2 * qb;
  int qi = wid * 32 + r31; if (smp) qi &= 63;
  const int qpos = (smp ? PAST : qb * 128) + qi;
  const int g = smp ? NTP + b * DSEQ + qi : b * SEQ + qb * 128 + qi;
  const u16* Q = (const u16*)(p.ws + WS_D) + (FOX ? (size_t)NT * 512 : 0);
  bf16x8 qf[4];
#pragma unroll
  for (int kk = 0; kk < 4; ++kk) qf[kk] = *(const bf16x8*)(Q + (size_t)g * 512 + h * 64 + kk * 16 + hh * 8);

  const float* kcache = FOX ? p.c_fx_k : p.c_sb_k;
  const float* vcache = FOX ? p.c_fx_v : p.c_sb_v;
  const size_t okp = FOX ? OUT_FXK_P : OUT_SBK_P, ovp = FOX ? OUT_FXV_P : OUT_SBV_P;
  const size_t oks = FOX ? OUT_FXK_S : OUT_SBK_S, ovs = FOX ? OUT_FXV_S : OUT_SBV_S;
  auto kptr = [&](int j) -> const float* {
    if (!smp) return p.out + okp + ((size_t)(b * SEQ + 64 * j) * 512 + h * 64);
    if (j < 64) return kcache + ((size_t)(b * PAST + 64 * j) * 512 + h * 64);
    return p.out + oks + ((size_t)(b * DSEQ) * 512 + h * 64);
  };
  auto vptr = [&](int j) -> const float* {
    if (!smp) return p.out + ovp + ((size_t)(b * SEQ + 64 * j) * 512 + h * 64);
    if (j < 64) return vcache + ((size_t)(b * PAST + 64 * j) * 512 + h * 64);
    return p.out + ovs + ((size_t)(b * DSEQ) * 512 + h * 64);
  };

  if (FOX) {
    const int nkeys = nkt * 64;
    const int per = (nkeys + 255) >> 8;
    const int s0 = tid * per, s1 = min(s0 + per, nkeys);
    auto lf = [&](int s) -> float {
      if (!smp) return p.out[OUT_LF_P + (size_t)(b * SEQ + s) * 8 + h];
      if (s < PAST) return p.c_fx_logf[(size_t)(b * PAST + s) * 8 + h];
      return p.out[OUT_LF_S + (size_t)(b * DSEQ + s - PAST) * 8 + h];
    };
    float loc = 0.f;
    for (int s = s0; s < s1; ++s) loc += lf(s);
    sm.part[tid] = loc;
    __syncthreads();
    float run = 0.f;
    for (int i = 0; i < tid; ++i) run += sm.part[i];
    for (int s = s0; s < s1; ++s) { run += lf(s); sm.cb[s] = -run * LOG2E; }
    __syncthreads();
  }

  bf16x8 tri[2], ones;
  if (!FOX) {
#pragma unroll
    for (int s = 0; s < 2; ++s)
#pragma unroll
      for (int j = 0; j < 8; ++j) { const int kin = 16 * s + 8 * (j >> 2) + 4 * hh + (j & 3); tri[s][j] = (kin >= r31) ? (short)0x3F80 : (short)0; }
#pragma unroll
    for (int j = 0; j < 8; ++j) ones[j] = (short)0x3F80;
  }

  f32x16 o[2];
#pragma unroll
  for (int d = 0; d < 2; ++d)
#pragma unroll
    for (int e = 0; e < 16; ++e) o[d][e] = 0.f;
  float mrun = -1e30f, lrun = 0.f, R = 0.f;

  KVRegs kv;
  const int jfirst = FOX ? 0 : nkt - 1;
  kv_fetch(kv, kptr(jfirst), vptr(jfirst), tid);
  kv_stash(kv, sm.k[0], sm.vt[0], tid);
  __syncthreads();
  for (int it = 0; it < nkt; ++it) {
    const int j = FOX ? it : nkt - 1 - it;
    const int cur = it & 1;
    if (it + 1 < nkt) { const int jn = FOX ? j + 1 : j - 1; kv_fetch(kv, kptr(jn), vptr(jn), tid); }
    f32x16 s[2];
#pragma unroll
    for (int t2 = 0; t2 < 2; ++t2) {
#pragma unroll
      for (int e = 0; e < 16; ++e) s[t2][e] = 0.f;
      const u16* pk = sm.k[cur] + (t2 * 32 + r31) * KLD + hh * 8;
#pragma unroll
      for (int kk = 0; kk < 4; ++kk) { const bf16x8 a = *(const bf16x8*)(pk + kk * 16); s[t2] = MFMA(a, qf[kk], s[t2]); }
    }
    const bool diag = j >= jdiag;
    const int kbase = 64 * j + 4 * hh;
    if (FOX) {
      float mloc = -1e30f;
#pragma unroll
      for (int t2 = 0; t2 < 2; ++t2)
#pragma unroll
        for (int g4 = 0; g4 < 4; ++g4) {
          const float4 bb = *(const float4*)(sm.cb + 64 * j + 32 * t2 + 8 * g4 + 4 * hh);
          const float bv[4] = {bb.x, bb.y, bb.z, bb.w};
#pragma unroll
          for (int e = 0; e < 4; ++e) {
            float x = s[t2][4 * g4 + e] * LOG2E + bv[e];
            if (diag && (kbase + 32 * t2 + 8 * g4 + e > qpos)) x = -1e30f;
            s[t2][4 * g4 + e] = x;
            mloc = fmaxf(mloc, x);
          }
        }
      mloc = fmaxf(mloc, __shfl_xor(mloc, 32));
      const float mnew = fmaxf(mrun, mloc);
      const float alpha = exp2f(mrun - mnew);
      mrun = mnew;
      float ls = 0.f;
#pragma unroll
      for (int t2 = 0; t2 < 2; ++t2)
#pragma unroll
        for (int e = 0; e < 16; ++e) { const float pv = exp2f(s[t2][e] - mnew); s[t2][e] = pv; ls += pv; }
      lrun = lrun * alpha + ls;
#pragma unroll
      for (int d = 0; d < 2; ++d)
#pragma unroll
        for (int e = 0; e < 16; ++e) o[d][e] *= alpha;
    } else {
      f32x16 lk[2];
#pragma unroll
      for (int t2 = 0; t2 < 2; ++t2)
#pragma unroll
        for (int e = 0; e < 16; ++e) {
          const float z = s[t2][e];
          const float sp = fmaxf(z, 0.f) + __logf(1.f + __expf(-fabsf(z)));
          const bool vis = !diag || (kbase + 32 * t2 + ACC_ROW(e, 0) < qpos);
          lk[t2][e] = vis ? -sp : 0.f;
        }
      f32x16 inc[2];
#pragma unroll
      for (int e = 0; e < 16; ++e) { inc[0][e] = R; inc[1][e] = R; }
#pragma unroll
      for (int t2 = 0; t2 < 2; ++t2) {
        f32x16 lo;
        bf16x8 fh[2], fl[2];
#pragma unroll
        for (int sI = 0; sI < 2; ++sI) fh[sI] = pack8(lk[t2], sI);
#pragma unroll
        for (int e = 0; e < 16; ++e) {
          const unsigned w = ((unsigned)(u16)fh[e >> 3][e & 7]) << 16;
          lo[e] = lk[t2][e] - __uint_as_float(w);
        }
#pragma unroll
        for (int sI = 0; sI < 2; ++sI) fl[sI] = pack8(lo, sI);
#pragma unroll
        for (int sI = 0; sI < 2; ++sI) {
          inc[t2] = MFMA(tri[sI], fh[sI], inc[t2]);
          inc[t2] = MFMA(tri[sI], fl[sI], inc[t2]);
          if (t2 == 1) { inc[0] = MFMA(ones, fh[sI], inc[0]); inc[0] = MFMA(ones, fl[sI], inc[0]); }
        }
      }
#pragma unroll
      for (int t2 = 0; t2 < 2; ++t2)
#pragma unroll
        for (int e = 0; e < 16; ++e) {
          const bool vis = !diag || (kbase + 32 * t2 + ACC_ROW(e, 0) < qpos);
          const float w = exp2f((s[t2][e] + inc[t2][e]) * LOG2E);
          s[t2][e] = vis ? w : 0.f;
        }
      R = __shfl(inc[0][0], r31);
    }
#pragma unroll
    for (int t2 = 0; t2 < 2; ++t2)
#pragma unroll
      for (int sI = 0; sI < 2; ++sI) {
        const bf16x8 pf = pack8(s[t2], sI);
#pragma unroll
        for (int d = 0; d < 2; ++d) {
          const u16* pv = sm.vt[cur] + (d * 32 + r31) * VLD + 32 * t2 + 16 * sI + 4 * hh;
          union { s16x4 q[2]; bf16x8 v; } a;
          a.q[0] = *(const s16x4*)(pv); a.q[1] = *(const s16x4*)(pv + 8);
          o[d] = MFMA(a.v, pf, o[d]);
        }
      }
    if (it + 1 < nkt) kv_stash(kv, sm.k[cur ^ 1], sm.vt[cur ^ 1], tid);
    __syncthreads();
  }
  float inv = 1.f;
  if (FOX) { const float lt = lrun + __shfl_xor(lrun, 32); inv = 1.f / lt; }
  if (!smp || wid < 2) {
    u16* od = (u16*)(p.ws + WS_E) + (size_t)g * DM + (FOX ? 512 : 0) + h * 64;
#pragma unroll
    for (int d = 0; d < 2; ++d)
#pragma unroll
      for (int g4 = 0; g4 < 4; ++g4)
        *(uint2*)(od + d * 32 + 8 * g4 + 4 * hh) = make_uint2(pk2(o[d][4 * g4] * inv, o[d][4 * g4 + 1] * inv), pk2(o[d][4 * g4 + 2] * inv, o[d][4 * g4 + 3] * inv));
  }
}

DI void phase_attn(const Params& p, char* smem) {
  const int bid = blockIdx.x, nb = gridDim.x;
  constexpr int NI = 256 + 4096;
  for (int it = bid; it < NI; it += nb) {
    if (it < 128) { attn_item<true>(p, 1, it >> 3, it & 7, 0, smem); }
    else if (it < 256) { const int u = it - 128; attn_item<false>(p, 1, u >> 3, u & 7, 0, smem); }
    else {
      const int u = it - 256;
      const int qb = 15 - (u >> 8), w = u & 255;
      const int fox = w & 1, bh = w >> 1;
      if (fox) attn_item<true>(p, 0, bh >> 3, bh & 7, qb, smem); else attn_item<false>(p, 0, bh >> 3, bh & 7, qb, smem);
    }
  }
}

DI void phase_wout(const Params& p, char* smem) {
  const int vb = vblock(), nb = gridDim.x;
  float* pre = (float*)(p.ws + WS_A);
  const u16* o = (const u16*)(p.ws + WS_E);
  float* sc_s = (float*)(smem + 73728);
  for (int t = vb; t < 264 * 8; t += nb) {
    const int mt = t >> 3, nt = t & 7;
    const int m0 = mt * 128, n0 = nt * 128;
    {
      const int lane = threadIdx.x & 63, wid = threadIdx.x >> 6;
      for (int rr = 0; rr < 32; ++rr) {
        const int row = wid * 32 + rr;
#pragma unroll
        for (int gi = 0; gi < 2; ++gi) {
          const uint4 v = *(const uint4*)(o + (size_t)(m0 + row) * DM + gi * 512 + lane * 8);
          float ss = bflo(v.x) * bflo(v.x) + bfhi(v.x) * bfhi(v.x) + bflo(v.y) * bflo(v.y) + bfhi(v.y) * bfhi(v.y) +
                     bflo(v.z) * bflo(v.z) + bfhi(v.z) * bfhi(v.z) + bflo(v.w) * bflo(v.w) + bfhi(v.w) * bfhi(v.w);
          ss = wave_sum(ss);
          if (lane == 0) sc_s[row * 2 + gi] = rsqrtf(ss * (1.f / 512.f) + 1e-6f);
        }
      }
      __syncthreads();
    }
    LdBf16Scaled al; al.base = o + (size_t)m0 * DM; al.ld = DM; al.sc = sc_s; al.ktc = 0;
    const float* xr = xrow(p, m0);
    auto epi = [=](int r0, int c0, const f32x16& acc) {
      const int lane = threadIdx.x & 63, hh = lane >> 5, col = c0 + (lane & 31);
#pragma unroll
      for (int e = 0; e < 16; ++e) { const int r = r0 + ACC_ROW(e, hh); pre[(size_t)r * DM + col] = DN_ALPHA * xr[(size_t)(r - m0) * DM + col] + acc[e]; }
    };
    gemm_tile(al, (const u16*)(p.ws + WS_WOUT), DM, DM, m0, n0, epi, smem);
  }
}

DI void phase_ln(const Params& p, const float* gam, const float* bet) {
  const float* pre = (const float*)(p.ws + WS_A);
  float* xf = (float*)(p.ws + WS_B);
  u16* xb = (u16*)(p.ws + WS_C);
  const int lane = threadIdx.x & 63;
  const int wg = blockIdx.x * 4 + (threadIdx.x >> 6), nw = gridDim.x * 4;
  for (int row = wg; row < NT; row += nw) {
    float4 v[4];
    float s = 0.f;
#pragma unroll
    for (int j = 0; j < 4; ++j) { v[j] = ((const float4*)(pre + (size_t)row * DM))[lane + 64 * j]; s += v[j].x + v[j].y + v[j].z + v[j].w; }
    const float mu = wave_sum(s) * (1.f / 1024.f);
    float q = 0.f;
#pragma unroll
    for (int j = 0; j < 4; ++j) { const float a = v[j].x - mu, b2 = v[j].y - mu, c = v[j].z - mu, d = v[j].w - mu; q += a * a + b2 * b2 + c * c + d * d; }
    const float rs = rsqrtf(wave_sum(q) * (1.f / 1024.f) + 1e-5f);
#pragma unroll
    for (int j = 0; j < 4; ++j) {
      const float4 gg = ((const float4*)gam)[lane + 64 * j], bb = ((const float4*)bet)[lane + 64 * j];
      float4 y;
      y.x = (v[j].x - mu) * rs * gg.x + bb.x; y.y = (v[j].y - mu) * rs * gg.y + bb.y;
      y.z = (v[j].z - mu) * rs * gg.z + bb.z; y.w = (v[j].w - mu) * rs * gg.w + bb.w;
      ((float4*)(xf + (size_t)row * DM))[lane + 64 * j] = y;
      ((uint2*)(xb + (size_t)row * DM))[lane + 64 * j] = make_uint2(pk2(y.x, y.y), pk2(y.z, y.w));
    }
  }
}

DI void phase_gemm_bf16(const Params& p, const u16* A, const u16* Wt, int N, u16* O, float scale, char* smem) {
  const int vb = vblock(), nb = gridDim.x;
  const int ntn = N >> 7;
  for (int t = vb; t < 264 * ntn; t += nb) {
    const int mt = t / ntn, nt = t % ntn;
    const int m0 = mt * 128, n0 = nt * 128;
    LdBf16 al; al.base = A + (size_t)m0 * DM; al.ld = DM;
    auto epi = [=](int r0, int c0, const f32x16& acc) {
      const int lane = threadIdx.x & 63, hh = lane >> 5, col = c0 + (lane & 31);
#pragma unroll
      for (int e = 0; e < 16; ++e) O[(size_t)(r0 + ACC_ROW(e, hh)) * N + col] = bf1(acc[e] * scale);
    };
    gemm_tile(al, Wt, DM, DM, m0, n0, epi, smem);
  }
}

DI void memattn_decode(int t, int& mt, int& sb, int& hd, int& nt, int& batch) {
  if (t < 2048) { mt = t >> 3; hd = (t >> 1) & 3; nt = t & 1; sb = -1; batch = mt >> 4; }
  else { const int u = t - 2048; mt = 256 + (u >> 4); sb = (u >> 3) & 1; hd = (u >> 1) & 3; nt = u & 1; batch = 16 + (mt - 256) * 2 + sb; }
}
DI void phase_mem_s(const Params& p, char* smem) {
  const int vb = vblock(), nb = gridDim.x;
  const u16* qm = (const u16*)(p.ws + WS_D);
  float* S = (float*)(p.ws + WS_F);
  for (int t = vb; t < 2048 + 128; t += nb) {
    int mt, sb, hd, nt, batch; memattn_decode(t, mt, sb, hd, nt, batch);
    const int m0 = mt * 128;
    LdBf16 al; al.base = qm + (size_t)m0 * DM + hd * 256; al.ld = DM;
    const u16* Bt = (const u16*)(p.ws + WS_MEMK) + (size_t)batch * 256 * DM + hd * 256;
    auto epi = [=](int r0, int c0, const f32x16& acc) {
      const int lane = threadIdx.x & 63, hh = lane >> 5, col = c0 + (lane & 31);
#pragma unroll
      for (int e = 0; e < 16; ++e) { const int r = ACC_ROW(e, hh) + r0; if (sb < 0 || (((r - m0) >> 6) == sb)) S[(size_t)r * DM + hd * 256 + col] = acc[e]; }
    };
    gemm_tile(al, Bt, DM, 256, m0, nt * 128, epi, smem);
  }
}
DI void phase_mem_softmax(const Params& p) {
  const float* S = (const float*)(p.ws + WS_F);
  u16* P = (u16*)(p.ws + WS_D);
  const int lane = threadIdx.x & 63;
  const int wg = blockIdx.x * 4 + (threadIdx.x >> 6), nw = gridDim.x * 4;
  for (int row = wg; row < NT * 4; row += nw) {
    const float4 v = ((const float4*)(S + (size_t)row * 256))[lane];
    const float m = wave_max(fmaxf(fmaxf(v.x, v.y), fmaxf(v.z, v.w)));
    const float a = __expf(v.x - m), b = __expf(v.y - m), c = __expf(v.z - m), d = __expf(v.w - m);
    const float inv = 1.f / wave_sum(a + b + c + d);
    ((uint2*)(P + (size_t)row * 256))[lane] = make_uint2(pk2(a * inv, b * inv), pk2(c * inv, d * inv));
  }
}
DI void phase_mem_pv(const Params& p, char* smem) {
  const int vb = vblock(), nb = gridDim.x;
  const u16* P = (const u16*)(p.ws + WS_D);
  u16* om = (u16*)(p.ws + WS_E);
  for (int t = vb; t < 2048 + 128; t += nb) {
    int mt, sb, hd, nt, batch; memattn_decode(t, mt, sb, hd, nt, batch);
    const int m0 = mt * 128;
    LdBf16 al; al.base = P + (size_t)m0 * DM + hd * 256; al.ld = DM;
    const u16* Bt = (const u16*)(p.ws + WS_MEMVT) + ((size_t)batch * DM + hd * 256) * 256;
    auto epi = [=](int r0, int c0, const f32x16& acc) {
      const int lane = threadIdx.x & 63, hh = lane >> 5, col = c0 + (lane & 31);
#pragma unroll
      for (int e = 0; e < 16; ++e) { const int r = ACC_ROW(e, hh) + r0; if (sb < 0 || (((r - m0) >> 6) == sb)) om[(size_t)r * DM + hd * 256 + col] = bf1(acc[e]); }
    };
    gemm_tile(al, Bt, 256, 256, m0, nt * 128, epi, smem);
  }
}
DI void phase_wmo(const Params& p, char* smem) {
  const int vb = vblock(), nb = gridDim.x;
  float* pre = (float*)(p.ws + WS_A);
  const float* xf = (const float*)(p.ws + WS_B);
  const u16* om = (const u16*)(p.ws + WS_E);
  for (int t = vb; t < 264 * 8; t += nb) {
    const int mt = t >> 3, nt = t & 7;
    const int m0 = mt * 128, n0 = nt * 128;
    LdBf16 al; al.base = om + (size_t)m0 * DM; al.ld = DM;
    auto epi = [=](int r0, int c0, const f32x16& acc) {
      const int lane = threadIdx.x & 63, hh = lane >> 5, col = c0 + (lane & 31);
#pragma unroll
      for (int e = 0; e < 16; ++e) { const size_t i = (size_t)(r0 + ACC_ROW(e, hh)) * DM + col; pre[i] = DN_ALPHA * xf[i] + acc[e]; }
    };
    gemm_tile(al, (const u16*)(p.ws + WS_WMO), DM, DM, m0, n0, epi, smem);
  }
}

DI void insert16(float (&v)[16], float x) {
#pragma unroll
  for (int j = 15; j >= 1; --j) v[j] = __builtin_amdgcn_fmed3f(x, v[j - 1], v[j]);
  v[0] = fmaxf(v[0], x);
}
DI void phase_topk(const Params& p, char* smem) {
  const int vb = vblock(), nb = gridDim.x;
  const u16* qp = (const u16*)(p.ws + WS_F);
  int* idxo = (int*)(p.ws + WS_A);
  float* gato = (float*)(p.ws + WS_A + (size_t)NT * 128 * 4);
  float* sc = (float*)smem;
  const int tid = threadIdx.x;
  for (int t = vb; t < 264 * 8; t += nb) {
    const int mt = t >> 3, hd = t & 7;
    const int m0 = mt * 128;
    float va[16], vbv[16];
#pragma unroll
    for (int side = 0; side < 2; ++side) {
      LdBf16 al; al.base = qp + (size_t)m0 * 2048 + hd * 256 + side * 128; al.ld = 2048;
      const u16* Bt = (const u16*)(p.ws + (side ? WS_KB : WS_KA)) + (size_t)hd * 128 * 128;
      auto epi = [=](int r0, int c0, const f32x16& acc) {
        const int lane = threadIdx.x & 63, hh = lane >> 5, col = c0 + (lane & 31);
#pragma unroll
        for (int e = 0; e < 16; ++e) sc[(r0 - m0 + ACC_ROW(e, hh)) * 129 + col] = acc[e];
      };
      gemm_tile(al, Bt, 128, 128, m0, 0, epi, smem);
      __syncthreads();
      if (tid < 128) {
        float v[16];
#pragma unroll
        for (int j = 0; j < 16; ++j) v[j] = -INFINITY;
        for (int k = 0; k < 128; ++k) {
          const float x = __uint_as_float((__float_as_uint(sc[tid * 129 + k]) & ~0x7Fu) | (unsigned)k);
          insert16(v, x);
        }
#pragma unroll
        for (int j = 0; j < 16; ++j) { if (side == 0) va[j] = v[j]; else vbv[j] = v[j]; }
      }
      __syncthreads();
    }
    unsigned char* ids = (unsigned char*)smem;
    if (tid < 128) {
#pragma unroll
      for (int j = 0; j < 16; ++j) { ids[tid * 32 + j] = (unsigned char)(__float_as_uint(va[j]) & 0x7F); ids[tid * 32 + 16 + j] = (unsigned char)(__float_as_uint(vbv[j]) & 0x7F); }
      float top[16];
#pragma unroll
      for (int j = 0; j < 16; ++j) top[j] = -INFINITY;
#pragma unroll
      for (int i = 0; i < 16; ++i)
#pragma unroll
        for (int j = 0; j < 16; ++j)
          if ((i + 1) * (j + 1) <= 16) {
            const float a = __uint_as_float(__float_as_uint(va[i]) & ~0x7Fu), b = __uint_as_float(__float_as_uint(vbv[j]) & ~0x7Fu);
            const float c = __uint_as_float((__float_as_uint(a + b) & ~0xFFu) | (unsigned)(i * 16 + j));
            insert16(top, c);
          }
      const float m = __uint_as_float(__float_as_uint(top[0]) & ~0xFFu);
      float ex[16], ssum = 0.f;
      int eid[16];
#pragma unroll
      for (int j = 0; j < 16; ++j) {
        const unsigned bits = __float_as_uint(top[j]);
        const int code = bits & 0xFF;
        ex[j] = __expf(__uint_as_float(bits & ~0xFFu) - m); ssum += ex[j];
        eid[j] = (int)ids[tid * 32 + (code >> 4)] * 128 + (int)ids[tid * 32 + 16 + (code & 15)];
      }
      const float inv = 1.f / ssum;
      const size_t ob = (size_t)(m0 + tid) * 128 + hd * 16;
#pragma unroll
      for (int j4 = 0; j4 < 4; ++j4) {
        *(int4*)(idxo + ob + 4 * j4) = make_int4(eid[4 * j4], eid[4 * j4 + 1], eid[4 * j4 + 2], eid[4 * j4 + 3]);
        *(float4*)(gato + ob + 4 * j4) = make_float4(ex[4 * j4] * inv, ex[4 * j4 + 1] * inv, ex[4 * j4 + 2] * inv, ex[4 * j4 + 3] * inv);
      }
    }
    __syncthreads();
  }
}

DI void unpack8(const uint4& v, float (&f)[8]) {
  f[0] = bflo(v.x); f[1] = bfhi(v.x); f[2] = bflo(v.y); f[3] = bfhi(v.y); f[4] = bflo(v.z); f[5] = bfhi(v.z); f[6] = bflo(v.w); f[7] = bfhi(v.w);
}
DI void phase_peer(const Params& p) {
  const float* xf = (const float*)(p.ws + WS_B);
  const int* idxo = (const int*)(p.ws + WS_A);
  const float* gato = (const float*)(p.ws + WS_A + (size_t)NT * 128 * 4);
  const u16* U = (const u16*)(p.ws + WS_U);
  const u16* V = (const u16*)(p.ws + WS_V);
  const int lane = threadIdx.x & 63;
  const int wg = blockIdx.x * 4 + (threadIdx.x >> 6), nw = gridDim.x * 4;
  for (int row = wg; row < NT; row += nw) {
    float x[16];
    {
      const float4* xr = (const float4*)(xf + (size_t)row * DM);
      const float4 a = xr[2 * lane], b = xr[2 * lane + 1], c = xr[128 + 2 * lane], d = xr[128 + 2 * lane + 1];
      x[0] = a.x; x[1] = a.y; x[2] = a.z; x[3] = a.w; x[4] = b.x; x[5] = b.y; x[6] = b.z; x[7] = b.w;
      x[8] = c.x; x[9] = c.y; x[10] = c.z; x[11] = c.w; x[12] = d.x; x[13] = d.y; x[14] = d.z; x[15] = d.w;
    }
    const int id0 = idxo[(size_t)row * 128 + lane], id1 = idxo[(size_t)row * 128 + 64 + lane];
    const float g0 = gato[(size_t)row * 128 + lane], g1 = gato[(size_t)row * 128 + 64 + lane];
    float d0 = 0.f, d1 = 0.f;
#pragma unroll 8
    for (int e = 0; e < 64; ++e) {
      const int id = __builtin_amdgcn_readlane(id0, e);
      const uint4* ur = (const uint4*)(U + (size_t)id * DM);
      const uint4 ua = ur[lane], ub = ur[64 + lane];
      float f[8], s = 0.f;
      unpack8(ua, f);
#pragma unroll
      for (int k = 0; k < 8; ++k) s += f[k] * x[k];
      unpack8(ub, f);
#pragma unroll
      for (int k = 0; k < 8; ++k) s += f[k] * x[8 + k];
      s = wave_sum(s);
      if (lane == e) d0 = s;
    }
#pragma unroll 8
    for (int e = 0; e < 64; ++e) {
      const int id = __builtin_amdgcn_readlane(id1, e);
      const uint4* ur = (const uint4*)(U + (size_t)id * DM);
      const uint4 ua = ur[lane], ub = ur[64 + lane];
      float f[8], s = 0.f;
      unpack8(ua, f);
#pragma unroll
      for (int k = 0; k < 8; ++k) s += f[k] * x[k];
      unpack8(ub, f);
#pragma unroll
      for (int k = 0; k < 8; ++k) s += f[k] * x[8 + k];
      s = wave_sum(s);
      if (lane == e) d1 = s;
    }
    const float h0 = 0.5f * d0 * (1.f + erff(d0 * 0.7071067811865476f)) * g0;
    const float h1 = 0.5f * d1 * (1.f + erff(d1 * 0.7071067811865476f)) * g1;
    float acc[16];
#pragma unroll
    for (int k = 0; k < 16; ++k) acc[k] = 0.f;
#pragma unroll 8
    for (int e = 0; e < 64; ++e) {
      const int id = __builtin_amdgcn_readlane(id0, e);
      const float hs = __uint_as_float(__builtin_amdgcn_readlane(__float_as_uint(h0), e));
      const uint4* vr = (const uint4*)(V + (size_t)id * DM);
      const uint4 va = vr[lane], vb2 = vr[64 + lane];
      float f[8];
      unpack8(va, f);
#pragma unroll
      for (int k = 0; k < 8; ++k) acc[k] += hs * f[k];
      unpack8(vb2, f);
#pragma unroll
      for (int k = 0; k < 8; ++k) acc[8 + k] += hs * f[k];
    }
#pragma unroll 8
    for (int e = 0; e < 64; ++e) {
      const int id = __builtin_amdgcn_readlane(id1, e);
      const float hs = __uint_as_float(__builtin_amdgcn_readlane(__float_as_uint(h1), e));
      const uint4* vr = (const uint4*)(V + (size_t)id * DM);
      const uint4 va = vr[lane], vb2 = vr[64 + lane];
      float f[8];
      unpack8(va, f);
#pragma unroll
      for (int k = 0; k < 8; ++k) acc[k] += hs * f[k];
      unpack8(vb2, f);
#pragma unroll
      for (int k = 0; k < 8; ++k) acc[8 + k] += hs * f[k];
    }
    float s = 0.f;
#pragma unroll
    for (int k = 0; k < 16; ++k) { acc[k] = DN_ALPHA * x[k] + acc[k]; s += acc[k]; }
    const float mu = wave_sum(s) * (1.f / 1024.f);
    float q = 0.f;
#pragma unroll
    for (int k = 0; k < 16; ++k) { const float dd = acc[k] - mu; q += dd * dd; }
    const float rs = rsqrtf(wave_sum(q) * (1.f / 1024.f) + 1e-5f);
    float* y = (row < NTP) ? p.out + OUT_YP + (size_t)row * DM : p.out + OUT_YS + (size_t)(row - NTP) * DM;
#pragma unroll
    for (int c = 0; c < 2; ++c) {
      const int off = c * 512 + lane * 8;
      const float4 ga = *(const float4*)(p.ln3_g + off), gb = *(const float4*)(p.ln3_g + off + 4);
      const float4 ba = *(const float4*)(p.ln3_b + off), bb = *(const float4*)(p.ln3_b + off + 4);
      float4 ya, yb;
      ya.x = (acc[8 * c + 0] - mu) * rs * ga.x + ba.x; ya.y = (acc[8 * c + 1] - mu) * rs * ga.y + ba.y;
      ya.z = (acc[8 * c + 2] - mu) * rs * ga.z + ba.z; ya.w = (acc[8 * c + 3] - mu) * rs * ga.w + ba.w;
      yb.x = (acc[8 * c + 4] - mu) * rs * gb.x + bb.x; yb.y = (acc[8 * c + 5] - mu) * rs * gb.y + bb.y;
      yb.z = (acc[8 * c + 6] - mu) * rs * gb.z + bb.z; yb.w = (acc[8 * c + 7] - mu) * rs * gb.w + bb.w;
      *(float4*)(y + off) = ya; *(float4*)(y + off + 4) = yb;
    }
  }
}

constexpr int NPHASE = 14;
template <int PH>
DI void run_phase(const Params& p, char* smem) {
  if (PH == 0) phase_prep(p, smem);
  else if (PH == 1) phase_proj(p, smem);
  else if (PH == 2) phase_attn(p, smem);
  else if (PH == 3) phase_wout(p, smem);
  else if (PH == 4) phase_ln(p, p.ln1_g, p.ln1_b);
  else if (PH == 5) phase_gemm_bf16(p, (const u16*)(p.ws + WS_C), (const u16*)(p.ws + WS_WMQ), 1024, (u16*)(p.ws + WS_D), 0.0625f, smem);
  else if (PH == 6) phase_mem_s(p, smem);
  else if (PH == 7) phase_mem_softmax(p);
  else if (PH == 8) phase_mem_pv(p, smem);
  else if (PH == 9) phase_wmo(p, smem);
  else if (PH == 10) phase_ln(p, p.ln2_g, p.ln2_b);
  else if (PH == 11) phase_gemm_bf16(p, (const u16*)(p.ws + WS_C), (const u16*)(p.ws + WS_WPQ), 2048, (u16*)(p.ws + WS_F), 1.f, smem);
  else if (PH == 12) phase_topk(p, smem);
  else if (PH == 13) phase_peer(p);
}

template <int PH>
__global__ void __launch_bounds__(256, 2) k_phase(Params p) {
  __shared__ __attribute__((aligned(16))) char smem[SMEM_BYTES];
  run_phase<PH>(p, smem);
}

#if ONE_LAUNCH
__global__ void __launch_bounds__(256, 2) k_mega(Params p) {
  __shared__ __attribute__((aligned(16))) char smem[SMEM_BYTES];
  cg::grid_group grid = cg::this_grid();
  run_phase<0>(p, smem); grid.sync();
  run_phase<1>(p, smem); grid.sync();
  run_phase<2>(p, smem); grid.sync();
  run_phase<3>(p, smem); grid.sync();
  run_phase<4>(p, smem); grid.sync();
  run_phase<5>(p, smem); grid.sync();
  run_phase<6>(p, smem); grid.sync();
  run_phase<7>(p, smem); grid.sync();
  run_phase<8>(p, smem); grid.sync();
  run_phase<9>(p, smem); grid.sync();
  run_phase<10>(p, smem); grid.sync();
  run_phase<11>(p, smem); grid.sync();
  run_phase<12>(p, smem); grid.sync();
  run_phase<13>(p, smem);
}
#endif

extern "C" void kernel_launch(void* const* d_in, const int* in_sizes, int n_in, void* d_out, int out_size, void* d_ws, size_t ws_size,
                              hipStream_t stream) {
  (void)in_sizes; (void)n_in; (void)out_size;
  if (ws_size < WS_TOTAL) { fprintf(stderr, "workspace too small: %zu < %zu\n", ws_size, (size_t)WS_TOTAL); return; }
  Params p{};
  const float** pp = (const float**)&p;
  for (int i = 0; i < 29; ++i) pp[i] = (const float*)d_in[i];
  p.out = (float*)d_out;
  p.ws = (char*)d_ws;
#if ONE_LAUNCH
  static int grid_blocks = 0;
  if (!grid_blocks) {
    int dev = 0, cus = 0, per_cu = 0;
    hipGetDevice(&dev);
    hipDeviceGetAttribute(&cus, hipDeviceAttributeMultiprocessorCount, dev);
    hipOccupancyMaxActiveBlocksPerMultiprocessor(&per_cu, k_mega, 256, 0);
    if (per_cu > 2) per_cu = 2;
    grid_blocks = cus * per_cu;
  }
  void* args[] = {&p};
  hipError_t e = hipLaunchCooperativeKernel((void*)k_mega, dim3(grid_blocks), dim3(256), args, 0, stream);
  if (e != hipSuccess) fprintf(stderr, "cooperative launch failed: %s (grid %d)\n", hipGetErrorString(e), grid_blocks);
#else
  const int G = 512;
  k_phase<0><<<G, 256, 0, stream>>>(p);
  k_phase<1><<<G, 256, 0, stream>>>(p);
  k_phase<2><<<G, 256, 0, stream>>>(p);
  k_phase<3><<<G, 256, 0, stream>>>(p);
  k_phase<4><<<G, 256, 0, stream>>>(p);
  k_phase<5><<<G, 256, 0, stream>>>(p);
  k_phase<6><<<G, 256, 0, stream>>>(p);
  k_phase<7><<<G, 256, 0, stream>>>(p);
  k_phase<8><<<G, 256, 0, stream>>>(p);
  k_phase<9><<<G, 256, 0, stream>>>(p);
  k_phase<10><<<G, 256, 0, stream>>>(p);
  k_phase<11><<<G, 256, 0, stream>>>(p);
  k_phase<12><<<G, 256, 0, stream>>>(p);
  k_phase<13><<<G, 256, 0, stream>>>(p);
#endif
}
```

```cpp
#include <hip/hip_runtime.h>
#include <hip/hip_cooperative_groups.h>
#include <cstdio>
#include <cstdint>
namespace cg = cooperative_groups;

#ifndef ONE_LAUNCH
#define ONE_LAUNCH 1
#endif

#define DI __device__ __forceinline__
typedef unsigned short u16;
typedef short bf16x8 __attribute__((ext_vector_type(8)));
typedef short s16x4 __attribute__((ext_vector_type(4)));
typedef float f32x16 __attribute__((ext_vector_type(16)));
typedef __bf16 bf2_t __attribute__((ext_vector_type(2)));
typedef float f2_t __attribute__((ext_vector_type(2)));
#define MFMA(a, b, c) __builtin_amdgcn_mfma_f32_32x32x16_bf16((a), (b), (c), 0, 0, 0)

constexpr int DM = 1024;
constexpr int NTP = 32768;
constexpr int NTS = 1024;
constexpr int NT = NTP + NTS;
constexpr int SEQ = 2048, DSEQ = 64, PAST = 4096, NMEM = 256;
constexpr int INC = 3080, INCP = 3200;
constexpr float DN_ALPHA = 1.189207115002721f;
constexpr float LOG2E = 1.4426950408889634f;

constexpr size_t OUT_YP = 0;
constexpr size_t OUT_YS = OUT_YP + (size_t)NTP * DM;
constexpr size_t OUT_SBK_P = OUT_YS + (size_t)NTS * DM;
constexpr size_t OUT_SBV_P = OUT_SBK_P + (size_t)NTP * 512;
constexpr size_t OUT_FXK_P = OUT_SBV_P + (size_t)NTP * 512;
constexpr size_t OUT_FXV_P = OUT_FXK_P + (size_t)NTP * 512;
constexpr size_t OUT_LF_P = OUT_FXV_P + (size_t)NTP * 512;
constexpr size_t OUT_MK_P = OUT_LF_P + (size_t)NTP * 8;
constexpr size_t OUT_MV_P = OUT_MK_P + (size_t)4096 * DM;
constexpr size_t OUT_SBK_S = OUT_MV_P + (size_t)4096 * DM;
constexpr size_t OUT_SBV_S = OUT_SBK_S + (size_t)NTS * 512;
constexpr size_t OUT_FXK_S = OUT_SBV_S + (size_t)NTS * 512;
constexpr size_t OUT_FXV_S = OUT_FXK_S + (size_t)NTS * 512;
constexpr size_t OUT_LF_S = OUT_FXV_S + (size_t)NTS * 512;
constexpr size_t OUT_TOTAL = OUT_LF_S + (size_t)NTS * 8;

constexpr size_t WS_WIN = 0;
constexpr size_t WS_WOUT = WS_WIN + (size_t)INCP * DM * 2;
constexpr size_t WS_WMQ = WS_WOUT + (size_t)DM * DM * 2;
constexpr size_t WS_WMKV = WS_WMQ + (size_t)DM * DM * 2;
constexpr size_t WS_WMO = WS_WMKV + (size_t)2048 * DM * 2;
constexpr size_t WS_WPQ = WS_WMO + (size_t)DM * DM * 2;
constexpr size_t WS_KA = WS_WPQ + (size_t)2048 * DM * 2;
constexpr size_t WS_KB = WS_KA + (size_t)8 * 128 * 128 * 2;
constexpr size_t WS_U = WS_KB + (size_t)8 * 128 * 128 * 2;
constexpr size_t WS_V = WS_U + (size_t)16384 * DM * 2;
constexpr size_t WS_MEMK = WS_V + (size_t)16384 * DM * 2;
constexpr size_t WS_MEMVT = WS_MEMK + (size_t)32 * 256 * DM * 2;
constexpr size_t WS_A = WS_MEMVT + (size_t)32 * 256 * DM * 2;
constexpr size_t WS_B = WS_A + (size_t)NT * DM * 4;
constexpr size_t WS_C = WS_B + (size_t)NT * DM * 4;
constexpr size_t WS_D = WS_C + (size_t)NT * DM * 2;
constexpr size_t WS_E = WS_D + (size_t)NT * DM * 2;
constexpr size_t WS_F = WS_E + (size_t)NT * DM * 2;
constexpr size_t WS_TOTAL = WS_F + (size_t)NT * DM * 4;

struct Params {
  const float *x_prompt, *x_sample, *mem_prompt, *c_sb_k, *c_sb_v, *c_fx_k, *c_fx_v, *c_fx_logf, *c_mem_k, *c_mem_v;
  const float *w_in, *b_f, *w_gn, *w_out, *ln1_g, *ln1_b, *w_mq, *w_mk, *w_mv, *w_mo, *ln2_g, *ln2_b;
  const float *w_pq, *keys_a, *keys_b, *peer_u, *peer_v, *ln3_g, *ln3_b;
  float* out;
  char* ws;
};

constexpr int SMEM_BYTES = 73728 + 1024;

DI unsigned pk2(float a, float b) { f2_t v = {a, b}; bf2_t r = __builtin_convertvector(v, bf2_t); return __builtin_bit_cast(unsigned, r); }
DI u16 bf1(float a) { return (u16)(pk2(a, 0.f) & 0xffffu); }
DI float bflo(unsigned w) { return __uint_as_float(w << 16); }
DI float bfhi(unsigned w) { return __uint_as_float(w & 0xffff0000u); }
DI float wave_sum(float v) {
#pragma unroll
  for (int o = 32; o >= 1; o >>= 1) v += __shfl_xor(v, o);
  return v;
}
DI float wave_max(float v) {
#pragma unroll
  for (int o = 32; o >= 1; o >>= 1) v = fmaxf(v, __shfl_xor(v, o));
  return v;
}
DI int vblock() { int nb = gridDim.x, b = blockIdx.x; return ((nb & 7) == 0) ? (b & 7) * (nb >> 3) + (b >> 3) : b; }
DI const float* xrow(const Params& p, int g) { return g < NTP ? p.x_prompt + (size_t)g * DM : p.x_sample + (size_t)(g - NTP) * DM; }

DI void tconv_tile(const float* src, int ldsrc, int C, u16* dst, int lddst, const float* rowscale, int tr, int tc, float* tile) {
  const int tid = threadIdx.x;
  {
    const int r = tid >> 2, c0 = (tid & 3) * 16;
    const int gr = tr * 64 + r;
    const float sc = rowscale ? rowscale[gr] : 1.f;
#pragma unroll
    for (int j = 0; j < 4; ++j) {
      const int gc = tc * 64 + c0 + 4 * j;
      float4 v = make_float4(0.f, 0.f, 0.f, 0.f);
      if (gc < C) v = *(const float4*)(src + (size_t)gr * ldsrc + gc);
      float* t = tile + r * 65 + c0 + 4 * j;
      t[0] = v.x * sc; t[1] = v.y * sc; t[2] = v.z * sc; t[3] = v.w * sc;
    }
  }
  __syncthreads();
  {
    const int n = tid >> 2, k0 = (tid & 3) * 16;
    unsigned w[8];
#pragma unroll
    for (int e = 0; e < 8; ++e) w[e] = pk2(tile[(k0 + 2 * e) * 65 + n], tile[(k0 + 2 * e + 1) * 65 + n]);
    uint4* d = (uint4*)(dst + (size_t)(tc * 64 + n) * lddst + tr * 64 + k0);
    d[0] = make_uint4(w[0], w[1], w[2], w[3]);
    d[1] = make_uint4(w[4], w[5], w[6], w[7]);
  }
  __syncthreads();
}

DI void conv_range(const float* src, u16* dst, size_t n8, int bid, int nb) {
  for (size_t i = (size_t)bid * 256 + threadIdx.x; i < n8; i += (size_t)nb * 256) {
    const float4 a = ((const float4*)src)[2 * i], b = ((const float4*)src)[2 * i + 1];
    ((uint4*)dst)[i] = make_uint4(pk2(a.x, a.y), pk2(a.z, a.w), pk2(b.x, b.y), pk2(b.z, b.w));
  }
}

DI void phase_prep(const Params& p, char* smem) {
  float* tile = (float*)smem;
  const int bid = blockIdx.x, nb = gridDim.x;
  u16* ws16 = (u16*)p.ws;
  constexpr int T_WIN = 16 * 50, T_SQ = 256, T_PQ = 16 * 32, T_MV = 16 * 4 * 16;
  constexpr int T0 = T_WIN, T1 = T0 + T_SQ, T2 = T1 + T_SQ, T3 = T2 + T_SQ, T4 = T3 + T_SQ, T5 = T4 + T_SQ, T6 = T5 + T_PQ, T7 = T6 + T_MV;
  for (int t = bid; t < T7; t += nb) {
    if (t < T0) { tconv_tile(p.w_in, INC, INC, (u16*)(p.ws + WS_WIN), DM, nullptr, t / 50, t % 50, tile); }
    else if (t < T1) { int u = t - T0; tconv_tile(p.w_out, DM, DM, (u16*)(p.ws + WS_WOUT), DM, p.w_gn, u >> 4, u & 15, tile); }
    else if (t < T2) { int u = t - T1; tconv_tile(p.w_mq, DM, DM, (u16*)(p.ws + WS_WMQ), DM, nullptr, u >> 4, u & 15, tile); }
    else if (t < T3) { int u = t - T2; tconv_tile(p.w_mk, DM, DM, (u16*)(p.ws + WS_WMKV), DM, nullptr, u >> 4, u & 15, tile); }
    else if (t < T4) { int u = t - T3; tconv_tile(p.w_mv, DM, DM, (u16*)(p.ws + WS_WMKV) + (size_t)DM * DM, DM, nullptr, u >> 4, u & 15, tile); }
    else if (t < T5) { int u = t - T4; tconv_tile(p.w_mo, DM, DM, (u16*)(p.ws + WS_WMO), DM, nullptr, u >> 4, u & 15, tile); }
    else if (t < T6) { int u = t - T5; tconv_tile(p.w_pq, 2048, 2048, (u16*)(p.ws + WS_WPQ), DM, nullptr, u >> 5, u & 31, tile); }
    else { int u = t - T6; int b = u >> 6, r = u & 63;
      tconv_tile(p.c_mem_v + (size_t)b * 256 * DM, DM, DM, (u16*)(p.ws + WS_MEMVT) + (size_t)(16 + b) * DM * 256, 256, nullptr, r >> 4, r & 15, tile); }
  }
  (void)ws16;
  conv_range(p.c_mem_k, (u16*)(p.ws + WS_MEMK) + (size_t)16 * 256 * DM, (size_t)16 * 256 * DM / 8, bid, nb);
  conv_range(p.keys_a, (u16*)(p.ws + WS_KA), (size_t)8 * 128 * 128 / 8, bid, nb);
  conv_range(p.keys_b, (u16*)(p.ws + WS_KB), (size_t)8 * 128 * 128 / 8, bid, nb);
  conv_range(p.peer_u, (u16*)(p.ws + WS_U), (size_t)16384 * DM / 8, bid, nb);
  conv_range(p.peer_v, (u16*)(p.ws + WS_V), (size_t)16384 * DM / 8, bid, nb);
}

constexpr int LLD = 72;
struct SmemGemm { u16 a[2][128 * LLD]; u16 b[2][128 * LLD]; };

struct LdBf16 {
  const u16* base; int ld;
  uint4 r[4];
  DI void fetch(int kt, int tid) {
#pragma unroll
    for (int i = 0; i < 4; ++i) { const int c = tid + 256 * i; r[i] = *(const uint4*)(base + (size_t)(c >> 3) * ld + kt * 64 + (c & 7) * 8); }
  }
  DI void stash(u16* lds, int tid) {
#pragma unroll
    for (int i = 0; i < 4; ++i) { const int c = tid + 256 * i; *(uint4*)(lds + (c >> 3) * LLD + (c & 7) * 8) = r[i]; }
  }
};
struct LdF32 {
  const float* base; int ld;
  float4 r[8];
  DI void fetch(int kt, int tid) {
#pragma unroll
    for (int i = 0; i < 4; ++i) { const int c = tid + 256 * i; const float4* s = (const float4*)(base + (size_t)(c >> 3) * ld + kt * 64 + (c & 7) * 8); r[2 * i] = s[0]; r[2 * i + 1] = s[1]; }
  }
  DI void stash(u16* lds, int tid) {
#pragma unroll
    for (int i = 0; i < 4; ++i) { const int c = tid + 256 * i; const float4 a = r[2 * i], b = r[2 * i + 1];
      *(uint4*)(lds + (c >> 3) * LLD + (c & 7) * 8) = make_uint4(pk2(a.x, a.y), pk2(a.z, a.w), pk2(b.x, b.y), pk2(b.z, b.w)); }
  }
};
struct LdBf16Scaled {
  const u16* base; int ld; const float* sc;
  uint4 r[4];
  int ktc;
  DI void fetch(int kt, int tid) {
    ktc = kt;
#pragma unroll
    for (int i = 0; i < 4; ++i) { const int c = tid + 256 * i; r[i] = *(const uint4*)(base + (size_t)(c >> 3) * ld + kt * 64 + (c & 7) * 8); }
  }
  DI void stash(u16* lds, int tid) {
    const int half = (ktc >= 8) ? 1 : 0;
#pragma unroll
    for (int i = 0; i < 4; ++i) { const int c = tid + 256 * i; const float s = sc[(c >> 3) * 2 + half]; const uint4 v = r[i];
      *(uint4*)(lds + (c >> 3) * LLD + (c & 7) * 8) = make_uint4(pk2(bflo(v.x) * s, bfhi(v.x) * s), pk2(bflo(v.y) * s, bfhi(v.y) * s),
                                                               pk2(bflo(v.z) * s, bfhi(v.z) * s), pk2(bflo(v.w) * s, bfhi(v.w) * s)); }
  }
};

template <class AL, class EPI>
DI void gemm_tile(AL& al, const u16* Bt, int ldb, int K, int m0, int n0, EPI epi, char* smem) {
  SmemGemm& sm = *(SmemGemm*)smem;
  const int tid = threadIdx.x, lane = tid & 63, wid = tid >> 6, wr = wid >> 1, wc = wid & 1;
  LdBf16 bl; bl.base = Bt + (size_t)n0 * ldb; bl.ld = ldb;
  f32x16 acc[2][2];
#pragma unroll
  for (int i = 0; i < 2; ++i)
#pragma unroll
    for (int j = 0; j < 2; ++j)
#pragma unroll
      for (int e = 0; e < 16; ++e) acc[i][j][e] = 0.f;
  const int KT = K >> 6;
  al.fetch(0, tid); bl.fetch(0, tid);
  al.stash(sm.a[0], tid); bl.stash(sm.b[0], tid);
  __syncthreads();
  for (int kt = 0; kt < KT; ++kt) {
    const int cur = kt & 1;
    if (kt + 1 < KT) { al.fetch(kt + 1, tid); bl.fetch(kt + 1, tid); }
    const u16* pa = sm.a[cur] + (wr * 64 + (lane & 31)) * LLD + (lane >> 5) * 8;
    const u16* pb = sm.b[cur] + (wc * 64 + (lane & 31)) * LLD + (lane >> 5) * 8;
#pragma unroll
    for (int kk = 0; kk < 4; ++kk) {
      const bf16x8 a0 = *(const bf16x8*)(pa + kk * 16), a1 = *(const bf16x8*)(pa + 32 * LLD + kk * 16);
      const bf16x8 b0 = *(const bf16x8*)(pb + kk * 16), b1 = *(const bf16x8*)(pb + 32 * LLD + kk * 16);
      acc[0][0] = MFMA(a0, b0, acc[0][0]); acc[0][1] = MFMA(a0, b1, acc[0][1]);
      acc[1][0] = MFMA(a1, b0, acc[1][0]); acc[1][1] = MFMA(a1, b1, acc[1][1]);
    }
    if (kt + 1 < KT) { al.stash(sm.a[cur ^ 1], tid); bl.stash(sm.b[cur ^ 1], tid); }
    __syncthreads();
  }
#pragma unroll
  for (int i = 0; i < 2; ++i)
#pragma unroll
    for (int j = 0; j < 2; ++j) epi(m0 + wr * 64 + i * 32, n0 + wc * 64 + j * 32, acc[i][j]);
}
#define ACC_ROW(e, hh) (((e) & 3) + 8 * ((e) >> 2) + 4 * (hh))

DI void phase_proj(const Params& p, char* smem) {
  const int vb = vblock(), nb = gridDim.x;
  constexpr int T_G1 = 264 * 25, T_MKV = 32 * 16;
  float* out = p.out;
  for (int t = vb; t < T_G1 + T_MKV; t += nb) {
    if (t < T_G1) {
      const int mt = t / 25, nt = t % 25;
      const int m0 = mt * 128, n0 = nt * 128;
      LdF32 al; al.base = xrow(p, m0); al.ld = DM;
      const bool smp = m0 >= NTP;
      const float* b_f = p.b_f;
      u16* qsb = (u16*)(p.ws + WS_D);
      u16* qfx = qsb + (size_t)NT * 512;
      auto epi = [=](int r0, int c0, const f32x16& acc) {
        const int lane = threadIdx.x & 63, hh = lane >> 5, col = c0 + (lane & 31);
        const int seg = c0 >> 9, cc = col & 511;
        if (seg == 0 || seg == 3) {
          u16* q = (seg == 0) ? qsb : qfx;
#pragma unroll
          for (int e = 0; e < 16; ++e) q[(size_t)(r0 + ACC_ROW(e, hh)) * 512 + cc] = bf1(acc[e] * 0.125f);
        } else if (seg < 6) {
          size_t ob;
          if (!smp) ob = (seg == 1) ? OUT_SBK_P : (seg == 2) ? OUT_SBV_P : (seg == 4) ? OUT_FXK_P : OUT_FXV_P;
          else ob = (seg == 1) ? OUT_SBK_S : (seg == 2) ? OUT_SBV_S : (seg == 4) ? OUT_FXK_S : OUT_FXV_S;
          const int rb = smp ? r0 - NTP : r0;
#pragma unroll
          for (int e = 0; e < 16; ++e) out[ob + (size_t)(rb + ACC_ROW(e, hh)) * 512 + cc] = acc[e];
        } else {
          const int c = col - 3072;
          if (c < 8) {
            const float bf = b_f[c];
            const size_t ob = smp ? OUT_LF_S : OUT_LF_P;
            const int rb = smp ? r0 - NTP : r0;
#pragma unroll
            for (int e = 0; e < 16; ++e) {
              const float z = acc[e] + bf;
              const float ls = fminf(z, 0.f) - log1pf(__expf(-fabsf(z)));
              out[ob + (size_t)(rb + ACC_ROW(e, hh)) * 8 + c] = ls;
            }
          }
        }
      };
      gemm_tile(al, (const u16*)(p.ws + WS_WIN), DM, DM, m0, n0, epi, smem);
    } else {
      const int u = t - T_G1;
      const int mt = u >> 4, nt = u & 15;
      const int m0 = mt * 128, n0 = nt * 128;
      LdF32 al; al.base = p.mem_prompt + (size_t)m0 * DM; al.ld = DM;
      u16* kb = (u16*)(p.ws + WS_MEMK);
      u16* vt = (u16*)(p.ws + WS_MEMVT);
      auto epi = [=](int r0, int c0, const f32x16& acc) {
        const int lane = threadIdx.x & 63, hh = lane >> 5, col = c0 + (lane & 31);
        if (c0 < 1024) {
#pragma unroll
          for (int e = 0; e < 16; ++e) { const size_t idx = (size_t)(r0 + ACC_ROW(e, hh)) * DM + col; out[OUT_MK_P + idx] = acc[e]; kb[idx] = bf1(acc[e]); }
        } else {
          const int c = col - 1024;
#pragma unroll
          for (int e = 0; e < 16; ++e) out[OUT_MV_P + (size_t)(r0 + ACC_ROW(e, hh)) * DM + c] = acc[e];
          const int b = r0 >> 8;
#pragma unroll
          for (int g4 = 0; g4 < 4; ++g4) {
            const int m = (r0 & 255) + 8 * g4 + 4 * hh;
            *(uint2*)(vt + ((size_t)b * DM + c) * 256 + m) = make_uint2(pk2(acc[4 * g4], acc[4 * g4 + 1]), pk2(acc[4 * g4 + 2], acc[4 * g4 + 3]));
          }
        }
      };
      gemm_tile(al, (const u16*)(p.ws + WS_WMKV), DM, DM, m0, n0, epi, smem);
    }
  }
}

constexpr int KLD = 72, VLD = 68;
struct SmemAttn { u16 k[2][64 * KLD]; u16 vt[2][64 * VLD]; float cb[4160]; float part[256]; };
static_assert(sizeof(SmemAttn) <= SMEM_BYTES, "attn smem");

struct KVRegs { float4 k[4], v[4]; };
DI void kv_fetch(KVRegs& r, const float* kb, const float* vb, int tid) {
#pragma unroll
  for (int i = 0; i < 4; ++i) { const int c = tid + 256 * i; const size_t o = (size_t)(c >> 4) * 512 + (c & 15) * 4; r.k[i] = *(const float4*)(kb + o); r.v[i] = *(const float4*)(vb + o); }
}
DI void kv_stash(const KVRegs& r, u16* ks, u16* vts, int tid) {
#pragma unroll
  for (int i = 0; i < 4; ++i) {
    const int c = tid + 256 * i; const int row = c >> 4, c4 = (c & 15) * 4;
    *(uint2*)(ks + row * KLD + c4) = make_uint2(pk2(r.k[i].x, r.k[i].y), pk2(r.k[i].z, r.k[i].w));
    vts[(c4 + 0) * VLD + row] = bf1(r.v[i].x); vts[(c4 + 1) * VLD + row] = bf1(r.v[i].y);
    vts[(c4 + 2) * VLD + row] = bf1(r.v[i].z); vts[(c4 + 3) * VLD + row] = bf1(r.v[i].w);
  }
}
DI bf16x8 pack8(const f32x16& x, int s) {
  union { unsigned u[4]; bf16x8 v; } t;
  t.u[0] = pk2(x[8 * s + 0], x[8 * s + 1]); t.u[1] = pk2(x[8 * s + 2], x[8 * s + 3]);
  t.u[2] = pk2(x[8 * s + 4], x[8 * s + 5]); t.u[3] = pk2(x[8 * s + 6], x[8 * s + 7]);
  return t.v;
}

template <bool FOX>
DI void attn_item(const Params& p, int smp, int b, int h, int qb, char* smem) {
  SmemAttn& sm = *(SmemAttn*)smem;
  const int tid = threadIdx.x, lane = tid & 63, wid = tid >> 6, r31 = lane & 31, hh = lane >> 5;
  const int nkt = smp ? 65 : 2 * qb + 2;
  const int jdiag = smp ? 64 : 2 * qb;
  int qi = wid * 32 + r31; if (smp) qi &= 63;
  const int qpos = (smp ? PAST : qb * 128) + qi;
  const int g = smp ? NTP + b * DSEQ + qi : b * SEQ + qb * 128 + qi;
  const u16* Q = (const u16*)(p.ws + WS_D) + (FOX ? (size_t)NT * 512 : 0);
  bf16x8 qf[4];
#pragma unroll
  for (int kk = 0; kk < 4; ++kk) qf[kk] = *(const bf16x8*)(Q + (size_t)g * 512 + h * 64 + kk * 16 + hh * 8);

  const float* kcache = FOX ? p.c_fx_k : p.c_sb_k;
  const float* vcache = FOX ? p.c_fx_v : p.c_sb_v;
  const size_t okp = FOX ? OUT_FXK_P : OUT_SBK_P, ovp = FOX ? OUT_FXV_P : OUT_SBV_P;
  const size_t oks = FOX ? OUT_FXK_S : OUT_SBK_S, ovs = FOX ? OUT_FXV_S : OUT_SBV_S;
  auto kptr = [&](int j) -> const float* {
    if (!smp) return p.out + okp + ((size_t)(b * SEQ + 64 * j) * 512 + h * 64);
    if (j < 64) return kcache + ((size_t)(b * PAST + 64 * j) * 512 + h * 64);
    return p.out + oks + ((size_t)(b * DSEQ) * 512 + h * 64);
  };
  auto vptr = [&](int j) -> const float* {
    if (!smp) return p.out + ovp + ((size_t)(b * SEQ + 64 * j) * 512 + h * 64);
    if (j < 64) return vcache + ((size_t)(b * PAST + 64 * j) * 512 + h * 64);
    return p.out + ovs + ((size_t)(b * DSEQ) * 512 + h * 64);
  };

  if (FOX) {
    const int nkeys = nkt * 64;
    const int per = (nkeys + 255) >> 8;
    const int s0 = tid * per, s1 = min(s0 + per, nkeys);
    auto lf = [&](int s) -> float {
      if (!smp) return p.out[OUT_LF_P + (size_t)(b * SEQ + s) * 8 + h];
      if (s < PAST) return p.c_fx_logf[(size_t)(b * PAST + s) * 8 + h];
      return p.out[OUT_LF_S + (size_t)(b * DSEQ + s - PAST) * 8 + h];
    };
    float loc = 0.f;
    for (int s = s0; s < s1; ++s) loc += lf(s);
    sm.part[tid] = loc;
    __syncthreads();
    float run = 0.f;
    for (int i = 0; i < tid; ++i) run += sm.part[i];
    for (int s = s0; s < s1; ++s) { run += lf(s); sm.cb[s] = -run * LOG2E; }
    __syncthreads();
  }

  bf16x8 tri[2];
  if (!FOX) {
#pragma unroll
    for (int s = 0; s < 2; ++s)
#pragma unroll
      for (int j = 0; j < 8; ++j) { const int kin = 16 * s + 8 * (j >> 2) + 4 * hh + (j & 3); tri[s][j] = (kin >= r31) ? (short)0x3F80 : (short)0; }
  }

  f32x16 o[2];
#pragma unroll
  for (int d = 0; d < 2; ++d)
#pragma unroll
    for (int e = 0; e < 16; ++e) o[d][e] = 0.f;
  float mrun = -1e30f, lrun = 0.f, R = 0.f;

  KVRegs kv;
  const int jfirst = FOX ? 0 : nkt - 1;
  kv_fetch(kv, kptr(jfirst), vptr(jfirst), tid);
  kv_stash(kv, sm.k[0], sm.vt[0], tid);
  __syncthreads();
  for (int it = 0; it < nkt; ++it) {
    const int j = FOX ? it : nkt - 1 - it;
    const int cur = it & 1;
    if (it + 1 < nkt) { const int jn = FOX ? j + 1 : j - 1; kv_fetch(kv, kptr(jn), vptr(jn), tid); }
    f32x16 s[2];
#pragma unroll
    for (int t2 = 0; t2 < 2; ++t2) {
#pragma unroll
      for (int e = 0; e < 16; ++e) s[t2][e] = 0.f;
      const u16* pk = sm.k[cur] + (t2 * 32 + r31) * KLD + hh * 8;
#pragma unroll
      for (int kk = 0; kk < 4; ++kk) { const bf16x8 a = *(const bf16x8*)(pk + kk * 16); s[t2] = MFMA(a, qf[kk], s[t2]); }
    }
    const bool diag = j >= jdiag;
    const int kbase = 64 * j + 4 * hh;
    if (FOX) {
      float mloc = -1e30f;
#pragma unroll
      for (int t2 = 0; t2 < 2; ++t2)
#pragma unroll
        for (int g4 = 0; g4 < 4; ++g4) {
          const float4 bb = *(const float4*)(sm.cb + 64 * j + 32 * t2 + 8 * g4 + 4 * hh);
          const float bv[4] = {bb.x, bb.y, bb.z, bb.w};
#pragma unroll
          for (int e = 0; e < 4; ++e) {
            float x = s[t2][4 * g4 + e] * LOG2E + bv[e];
            if (diag && (kbase + 32 * t2 + 8 * g4 + e > qpos)) x = -1e30f;
            s[t2][4 * g4 + e] = x;
            mloc = fmaxf(mloc, x);
          }
        }
      mloc = fmaxf(mloc, __shfl_xor(mloc, 32));
      const float mnew = fmaxf(mrun, mloc);
      const float alpha = exp2f(mrun - mnew);
      mrun = mnew;
      float ls = 0.f;
#pragma unroll
      for (int t2 = 0; t2 < 2; ++t2)
#pragma unroll
        for (int e = 0; e < 16; ++e) { const float pv = exp2f(s[t2][e] - mnew); s[t2][e] = pv; ls += pv; }
      lrun = lrun * alpha + ls;
#pragma unroll
      for (int d = 0; d < 2; ++d)
#pragma unroll
        for (int e = 0; e < 16; ++e) o[d][e] *= alpha;
    } else {
#pragma unroll
      for (int t2 = 1; t2 >= 0; --t2) {
        f32x16 lk;
#pragma unroll
        for (int e = 0; e < 16; ++e) {
          const float z = s[t2][e];
          const float sp = fmaxf(z, 0.f) + __logf(1.f + __expf(-fabsf(z)));
          const bool vis = !diag || (kbase + 32 * t2 + ACC_ROW(e, 0) < qpos);
          lk[e] = vis ? -sp : 0.f;
        }
        bf16x8 fh[2], fl[2];
#pragma unroll
        for (int sI = 0; sI < 2; ++sI) fh[sI] = pack8(lk, sI);
#pragma unroll
        for (int e = 0; e < 16; ++e) lk[e] -= __uint_as_float(((unsigned)(u16)fh[e >> 3][e & 7]) << 16);
#pragma unroll
        for (int sI = 0; sI < 2; ++sI) fl[sI] = pack8(lk, sI);
        f32x16 inc;
#pragma unroll
        for (int e = 0; e < 16; ++e) inc[e] = R;
#pragma unroll
        for (int sI = 0; sI < 2; ++sI) { inc = MFMA(tri[sI], fh[sI], inc); inc = MFMA(tri[sI], fl[sI], inc); }
#pragma unroll
        for (int e = 0; e < 16; ++e) {
          const bool vis = !diag || (kbase + 32 * t2 + ACC_ROW(e, 0) < qpos);
          const float w = exp2f((s[t2][e] + inc[e]) * LOG2E);
          s[t2][e] = vis ? w : 0.f;
        }
        R = __shfl(inc[0], r31);
      }
    }
#pragma unroll
    for (int t2 = 0; t2 < 2; ++t2)
#pragma unroll
      for (int sI = 0; sI < 2; ++sI) {
        const bf16x8 pf = pack8(s[t2], sI);
#pragma unroll
        for (int d = 0; d < 2; ++d) {
          const u16* pv = sm.vt[cur] + (d * 32 + r31) * VLD + 32 * t2 + 16 * sI + 4 * hh;
          union { s16x4 q[2]; bf16x8 v; } a;
          a.q[0] = *(const s16x4*)(pv); a.q[1] = *(const s16x4*)(pv + 8);
          o[d] = MFMA(a.v, pf, o[d]);
        }
      }
    if (it + 1 < nkt) kv_stash(kv, sm.k[cur ^ 1], sm.vt[cur ^ 1], tid);
    __syncthreads();
  }
  float inv = 1.f;
  if (FOX) { const float lt = lrun + __shfl_xor(lrun, 32); inv = 1.f / lt; }
  if (!smp || wid < 2) {
    u16* od = (u16*)(p.ws + WS_E) + (size_t)g * DM + (FOX ? 512 : 0) + h * 64;
#pragma unroll
    for (int d = 0; d < 2; ++d)
#pragma unroll
      for (int g4 = 0; g4 < 4; ++g4)
        *(uint2*)(od + d * 32 + 8 * g4 + 4 * hh) = make_uint2(pk2(o[d][4 * g4] * inv, o[d][4 * g4 + 1] * inv), pk2(o[d][4 * g4 + 2] * inv, o[d][4 * g4 + 3] * inv));
  }
}

DI void phase_attn(const Params& p, char* smem) {
  const int bid = blockIdx.x, nb = gridDim.x;
  constexpr int NI = 256 + 4096;
  for (int it = bid; it < NI; it += nb) {
    if (it < 128) { attn_item<true>(p, 1, it >> 3, it & 7, 0, smem); }
    else if (it < 256) { const int u = it - 128; attn_item<false>(p, 1, u >> 3, u & 7, 0, smem); }
    else {
      const int u = it - 256;
      const int qb = 15 - (u >> 8), w = u & 255;
      const int fox = w & 1, bh = w >> 1;
      if (fox) attn_item<true>(p, 0, bh >> 3, bh & 7, qb, smem); else attn_item<false>(p, 0, bh >> 3, bh & 7, qb, smem);
    }
  }
}

DI void phase_wout(const Params& p, char* smem) {
  const int vb = vblock(), nb = gridDim.x;
  float* pre = (float*)(p.ws + WS_A);
  const u16* o = (const u16*)(p.ws + WS_E);
  float* sc_s = (float*)(smem + 73728);
  for (int t = vb; t < 264 * 8; t += nb) {
    const int mt = t >> 3, nt = t & 7;
    const int m0 = mt * 128, n0 = nt * 128;
    {
      const int lane = threadIdx.x & 63, wid = threadIdx.x >> 6;
      for (int rr = 0; rr < 32; ++rr) {
        const int row = wid * 32 + rr;
#pragma unroll
        for (int gi = 0; gi < 2; ++gi) {
          const uint4 v = *(const uint4*)(o + (size_t)(m0 + row) * DM + gi * 512 + lane * 8);
          float ss = bflo(v.x) * bflo(v.x) + bfhi(v.x) * bfhi(v.x) + bflo(v.y) * bflo(v.y) + bfhi(v.y) * bfhi(v.y) +
                     bflo(v.z) * bflo(v.z) + bfhi(v.z) * bfhi(v.z) + bflo(v.w) * bflo(v.w) + bfhi(v.w) * bfhi(v.w);
          ss = wave_sum(ss);
          if (lane == 0) sc_s[row * 2 + gi] = rsqrtf(ss * (1.f / 512.f) + 1e-6f);
        }
      }
      __syncthreads();
    }
    LdBf16Scaled al; al.base = o + (size_t)m0 * DM; al.ld = DM; al.sc = sc_s; al.ktc = 0;
    const float* xr = xrow(p, m0);
    auto epi = [=](int r0, int c0, const f32x16& acc) {
      const int lane = threadIdx.x & 63, hh = lane >> 5, col = c0 + (lane & 31);
#pragma unroll
      for (int e = 0; e < 16; ++e) { const int r = r0 + ACC_ROW(e, hh); pre[(size_t)r * DM + col] = DN_ALPHA * xr[(size_t)(r - m0) * DM + col] + acc[e]; }
    };
    gemm_tile(al, (const u16*)(p.ws + WS_WOUT), DM, DM, m0, n0, epi, smem);
  }
}

DI void phase_ln(const Params& p, const float* gam, const float* bet) {
  const float* pre = (const float*)(p.ws + WS_A);
  float* xf = (float*)(p.ws + WS_B);
  u16* xb = (u16*)(p.ws + WS_C);
  const int lane = threadIdx.x & 63;
  const int wg = blockIdx.x * 4 + (threadIdx.x >> 6), nw = gridDim.x * 4;
  for (int row = wg; row < NT; row += nw) {
    float4 v[4];
    float s = 0.f;
#pragma unroll
    for (int j = 0; j < 4; ++j) { v[j] = ((const float4*)(pre + (size_t)row * DM))[lane + 64 * j]; s += v[j].x + v[j].y + v[j].z + v[j].w; }
    const float mu = wave_sum(s) * (1.f / 1024.f);
    float q = 0.f;
#pragma unroll
    for (int j = 0; j < 4; ++j) { const float a = v[j].x - mu, b2 = v[j].y - mu, c = v[j].z - mu, d = v[j].w - mu; q += a * a + b2 * b2 + c * c + d * d; }
    const float rs = rsqrtf(wave_sum(q) * (1.f / 1024.f) + 1e-5f);
#pragma unroll
    for (int j = 0; j < 4; ++j) {
      const float4 gg = ((const float4*)gam)[lane + 64 * j], bb = ((const float4*)bet)[lane + 64 * j];
      float4 y;
      y.x = (v[j].x - mu) * rs * gg.x + bb.x; y.y = (v[j].y - mu) * rs * gg.y + bb.y;
      y.z = (v[j].z - mu) * rs * gg.z + bb.z; y.w = (v[j].w - mu) * rs * gg.w + bb.w;
      ((float4*)(xf + (size_t)row * DM))[lane + 64 * j] = y;
      ((uint2*)(xb + (size_t)row * DM))[lane + 64 * j] = make_uint2(pk2(y.x, y.y), pk2(y.z, y.w));
    }
  }
}

DI void phase_gemm_bf16(const Params& p, const u16* A, const u16* Wt, int N, u16* O, float scale, char* smem) {
  const int vb = vblock(), nb = gridDim.x;
  const int ntn = N >> 7;
  for (int t = vb; t < 264 * ntn; t += nb) {
    const int mt = t / ntn, nt = t % ntn;
    const int m0 = mt * 128, n0 = nt * 128;
    LdBf16 al; al.base = A + (size_t)m0 * DM; al.ld = DM;
    auto epi = [=](int r0, int c0, const f32x16& acc) {
      const int lane = threadIdx.x & 63, hh = lane >> 5, col = c0 + (lane & 31);
#pragma unroll
      for (int e = 0; e < 16; ++e) O[(size_t)(r0 + ACC_ROW(e, hh)) * N + col] = bf1(acc[e] * scale);
    };
    gemm_tile(al, Wt, DM, DM, m0, n0, epi, smem);
  }
}

DI void memattn_decode(int t, int& mt, int& sb, int& hd, int& nt, int& batch) {
  if (t < 2048) { mt = t >> 3; hd = (t >> 1) & 3; nt = t & 1; sb = -1; batch = mt >> 4; }
  else { const int u = t - 2048; mt = 256 + (u >> 4); sb = (u >> 3) & 1; hd = (u >> 1) & 3; nt = u & 1; batch = 16 + (mt - 256) * 2 + sb; }
}
DI void phase_mem_s(const Params& p, char* smem) {
  const int vb = vblock(), nb = gridDim.x;
  const u16* qm = (const u16*)(p.ws + WS_D);
  float* S = (float*)(p.ws + WS_F);
  for (int t = vb; t < 2048 + 128; t += nb) {
    int mt, sb, hd, nt, batch; memattn_decode(t, mt, sb, hd, nt, batch);
    const int m0 = mt * 128;
    LdBf16 al; al.base = qm + (size_t)m0 * DM + hd * 256; al.ld = DM;
    const u16* Bt = (const u16*)(p.ws + WS_MEMK) + (size_t)batch * 256 * DM + hd * 256;
    auto epi = [=](int r0, int c0, const f32x16& acc) {
      const int lane = threadIdx.x & 63, hh = lane >> 5, col = c0 + (lane & 31);
#pragma unroll
      for (int e = 0; e < 16; ++e) { const int r = ACC_ROW(e, hh) + r0; if (sb < 0 || (((r - m0) >> 6) == sb)) S[(size_t)r * DM + hd * 256 + col] = acc[e]; }
    };
    gemm_tile(al, Bt, DM, 256, m0, nt * 128, epi, smem);
  }
}
DI void phase_mem_softmax(const Params& p) {
  const float* S = (const float*)(p.ws + WS_F);
  u16* P = (u16*)(p.ws + WS_D);
  const int lane = threadIdx.x & 63;
  const int wg = blockIdx.x * 4 + (threadIdx.x >> 6), nw = gridDim.x * 4;
  for (int row = wg; row < NT * 4; row += nw) {
    const float4 v = ((const float4*)(S + (size_t)row * 256))[lane];
    const float m = wave_max(fmaxf(fmaxf(v.x, v.y), fmaxf(v.z, v.w)));
    const float a = __expf(v.x - m), b = __expf(v.y - m), c = __expf(v.z - m), d = __expf(v.w - m);
    const float inv = 1.f / wave_sum(a + b + c + d);
    ((uint2*)(P + (size_t)row * 256))[lane] = make_uint2(pk2(a * inv, b * inv), pk2(c * inv, d * inv));
  }
}
DI void phase_mem_pv(const Params& p, char* smem) {
  const int vb = vblock(), nb = gridDim.x;
  const u16* P = (const u16*)(p.ws + WS_D);
  u16* om = (u16*)(p.ws + WS_E);
  for (int t = vb; t < 2048 + 128; t += nb) {
    int mt, sb, hd, nt, batch; memattn_decode(t, mt, sb, hd, nt, batch);
    const int m0 = mt * 128;
    LdBf16 al; al.base = P + (size_t)m0 * DM + hd * 256; al.ld = DM;
    const u16* Bt = (const u16*)(p.ws + WS_MEMVT) + ((size_t)batch * DM + hd * 256) * 256;
    auto epi = [=](int r0, int c0, const f32x16& acc) {
      const int lane = threadIdx.x & 63, hh = lane >> 5, col = c0 + (lane & 31);
#pragma unroll
      for (int e = 0; e < 16; ++e) { const int r = ACC_ROW(e, hh) + r0; if (sb < 0 || (((r - m0) >> 6) == sb)) om[(size_t)r * DM + hd * 256 + col] = bf1(acc[e]); }
    };
    gemm_tile(al, Bt, 256, 256, m0, nt * 128, epi, smem);
  }
}
DI void phase_wmo(const Params& p, char* smem) {
  const int vb = vblock(), nb = gridDim.x;
  float* pre = (float*)(p.ws + WS_A);
  const float* xf = (const float*)(p.ws + WS_B);
  const u16* om = (const u16*)(p.ws + WS_E);
  for (int t = vb; t < 264 * 8; t += nb) {
    const int mt = t >> 3, nt = t & 7;
    const int m0 = mt * 128, n0 = nt * 128;
    LdBf16 al; al.base = om + (size_t)m0 * DM; al.ld = DM;
    auto epi = [=](int r0, int c0, const f32x16& acc) {
      const int lane = threadIdx.x & 63, hh = lane >> 5, col = c0 + (lane & 31);
#pragma unroll
      for (int e = 0; e < 16; ++e) { const size_t i = (size_t)(r0 + ACC_ROW(e, hh)) * DM + col; pre[i] = DN_ALPHA * xf[i] + acc[e]; }
    };
    gemm_tile(al, (const u16*)(p.ws + WS_WMO), DM, DM, m0, n0, epi, smem);
  }
}

DI void insert16(float (&v)[16], float x) {
#pragma unroll
  for (int j = 15; j >= 1; --j) v[j] = __builtin_amdgcn_fmed3f(x, v[j - 1], v[j]);
  v[0] = fmaxf(v[0], x);
}
DI void phase_topk(const Params& p, char* smem) {
  const int vb = vblock(), nb = gridDim.x;
  const u16* qp = (const u16*)(p.ws + WS_F);
  int* idxo = (int*)(p.ws + WS_A);
  float* gato = (float*)(p.ws + WS_A + (size_t)NT * 128 * 4);
  float* sc = (float*)smem;
  const int tid = threadIdx.x;
  for (int t = vb; t < 264 * 8; t += nb) {
    const int mt = t >> 3, hd = t & 7;
    const int m0 = mt * 128;
    float va[16], vbv[16];
#pragma unroll
    for (int side = 0; side < 2; ++side) {
      LdBf16 al; al.base = qp + (size_t)m0 * 2048 + hd * 256 + side * 128; al.ld = 2048;
      const u16* Bt = (const u16*)(p.ws + (side ? WS_KB : WS_KA)) + (size_t)hd * 128 * 128;
      auto epi = [=](int r0, int c0, const f32x16& acc) {
        const int lane = threadIdx.x & 63, hh = lane >> 5, col = c0 + (lane & 31);
#pragma unroll
        for (int e = 0; e < 16; ++e) sc[(r0 - m0 + ACC_ROW(e, hh)) * 129 + col] = acc[e];
      };
      gemm_tile(al, Bt, 128, 128, m0, 0, epi, smem);
      __syncthreads();
      if (tid < 128) {
        float v[16];
#pragma unroll
        for (int j = 0; j < 16; ++j) v[j] = -INFINITY;
        for (int k = 0; k < 128; ++k) {
          const float x = __uint_as_float((__float_as_uint(sc[tid * 129 + k]) & ~0x7Fu) | (unsigned)k);
          insert16(v, x);
        }
#pragma unroll
        for (int j = 0; j < 16; ++j) { if (side == 0) va[j] = v[j]; else vbv[j] = v[j]; }
      }
      __syncthreads();
    }
    unsigned char* ids = (unsigned char*)smem;
    if (tid < 128) {
#pragma unroll
      for (int j = 0; j < 16; ++j) { ids[tid * 32 + j] = (unsigned char)(__float_as_uint(va[j]) & 0x7F); ids[tid * 32 + 16 + j] = (unsigned char)(__float_as_uint(vbv[j]) & 0x7F); }
      float top[16];
#pragma unroll
      for (int j = 0; j < 16; ++j) top[j] = -INFINITY;
#pragma unroll
      for (int i = 0; i < 16; ++i)
#pragma unroll
        for (int j = 0; j < 16; ++j)
          if ((i + 1) * (j + 1) <= 16) {
            const float a = __uint_as_float(__float_as_uint(va[i]) & ~0x7Fu), b = __uint_as_float(__float_as_uint(vbv[j]) & ~0x7Fu);
            const float c = __uint_as_float((__float_as_uint(a + b) & ~0xFFu) | (unsigned)(i * 16 + j));
            insert16(top, c);
          }
      const float m = __uint_as_float(__float_as_uint(top[0]) & ~0xFFu);
      float ex[16], ssum = 0.f;
      int eid[16];
#pragma unroll
      for (int j = 0; j < 16; ++j) {
        const unsigned bits = __float_as_uint(top[j]);
        const int code = bits & 0xFF;
        ex[j] = __expf(__uint_as_float(bits & ~0xFFu) - m); ssum += ex[j];
        eid[j] = (int)ids[tid * 32 + (code >> 4)] * 128 + (int)ids[tid * 32 + 16 + (code & 15)];
      }
      const float inv = 1.f / ssum;
      const size_t ob = (size_t)(m0 + tid) * 128 + hd * 16;
#pragma unroll
      for (int j4 = 0; j4 < 4; ++j4) {
        *(int4*)(idxo + ob + 4 * j4) = make_int4(eid[4 * j4], eid[4 * j4 + 1], eid[4 * j4 + 2], eid[4 * j4 + 3]);
        *(float4*)(gato + ob + 4 * j4) = make_float4(ex[4 * j4] * inv, ex[4 * j4 + 1] * inv, ex[4 * j4 + 2] * inv, ex[4 * j4 + 3] * inv);
      }
    }
    __syncthreads();
  }
}

DI void unpack8(const uint4& v, float (&f)[8]) {
  f[0] = bflo(v.x); f[1] = bfhi(v.x); f[2] = bflo(v.y); f[3] = bfhi(v.y); f[4] = bflo(v.z); f[5] = bfhi(v.z); f[6] = bflo(v.w); f[7] = bfhi(v.w);
}
DI void phase_peer(const Params& p) {
  const float* xf = (const float*)(p.ws + WS_B);
  const int* idxo = (const int*)(p.ws + WS_A);
  const float* gato = (const float*)(p.ws + WS_A + (size_t)NT * 128 * 4);
  const u16* U = (const u16*)(p.ws + WS_U);
  const u16* V = (const u16*)(p.ws + WS_V);
  const int lane = threadIdx.x & 63;
  const int wg = blockIdx.x * 4 + (threadIdx.x >> 6), nw = gridDim.x * 4;
  for (int row = wg; row < NT; row += nw) {
    float x[16];
    {
      const float4* xr = (const float4*)(xf + (size_t)row * DM);
      const float4 a = xr[2 * lane], b = xr[2 * lane + 1], c = xr[128 + 2 * lane], d = xr[128 + 2 * lane + 1];
      x[0] = a.x; x[1] = a.y; x[2] = a.z; x[3] = a.w; x[4] = b.x; x[5] = b.y; x[6] = b.z; x[7] = b.w;
      x[8] = c.x; x[9] = c.y; x[10] = c.z; x[11] = c.w; x[12] = d.x; x[13] = d.y; x[14] = d.z; x[15] = d.w;
    }
    const int id0 = idxo[(size_t)row * 128 + lane], id1 = idxo[(size_t)row * 128 + 64 + lane];
    const float g0 = gato[(size_t)row * 128 + lane], g1 = gato[(size_t)row * 128 + 64 + lane];
    float d0 = 0.f, d1 = 0.f;
#pragma unroll 8
    for (int e = 0; e < 64; ++e) {
      const int id = __builtin_amdgcn_readlane(id0, e);
      const uint4* ur = (const uint4*)(U + (size_t)id * DM);
      const uint4 ua = ur[lane], ub = ur[64 + lane];
      float f[8], s = 0.f;
      unpack8(ua, f);
#pragma unroll
      for (int k = 0; k < 8; ++k) s += f[k] * x[k];
      unpack8(ub, f);
#pragma unroll
      for (int k = 0; k < 8; ++k) s += f[k] * x[8 + k];
      s = wave_sum(s);
      if (lane == e) d0 = s;
    }
#pragma unroll 8
    for (int e = 0; e < 64; ++e) {
      const int id = __builtin_amdgcn_readlane(id1, e);
      const uint4* ur = (const uint4*)(U + (size_t)id * DM);
      const uint4 ua = ur[lane], ub = ur[64 + lane];
      float f[8], s = 0.f;
      unpack8(ua, f);
#pragma unroll
      for (int k = 0; k < 8; ++k) s += f[k] * x[k];
      unpack8(ub, f);
#pragma unroll
      for (int k = 0; k < 8; ++k) s += f[k] * x[8 + k];
      s = wave_sum(s);
      if (lane == e) d1 = s;
    }
    const float h0 = 0.5f * d0 * (1.f + erff(d0 * 0.7071067811865476f)) * g0;
    const float h1 = 0.5f * d1 * (1.f + erff(d1 * 0.7071067811865476f)) * g1;
    float acc[16];
#pragma unroll
    for (int k = 0; k < 16; ++k) acc[k] = 0.f;
#pragma unroll 8
    for (int e = 0; e < 64; ++e) {
      const int id = __builtin_amdgcn_readlane(id0, e);
      const float hs = __uint_as_float(__builtin_amdgcn_readlane(__float_as_uint(h0), e));
      const uint4* vr = (const uint4*)(V + (size_t)id * DM);
      const uint4 va = vr[lane], vb2 = vr[64 + lane];
      float f[8];
      unpack8(va, f);
#pragma unroll
      for (int k = 0; k < 8; ++k) acc[k] += hs * f[k];
      unpack8(vb2, f);
#pragma unroll
      for (int k = 0; k < 8; ++k) acc[8 + k] += hs * f[k];
    }
#pragma unroll 8
    for (int e = 0; e < 64; ++e) {
      const int id = __builtin_amdgcn_readlane(id1, e);
      const float hs = __uint_as_float(__builtin_amdgcn_readlane(__float_as_uint(h1), e));
      const uint4* vr = (const uint4*)(V + (size_t)id * DM);
      const uint4 va = vr[lane], vb2 = vr[64 + lane];
      float f[8];
      unpack8(va, f);
#pragma unroll
      for (int k = 0; k < 8; ++k) acc[k] += hs * f[k];
      unpack8(vb2, f);
#pragma unroll
      for (int k = 0; k < 8; ++k) acc[8 + k] += hs * f[k];
    }
    float s = 0.f;
#pragma unroll
    for (int k = 0; k < 16; ++k) { acc[k] = DN_ALPHA * x[k] + acc[k]; s += acc[k]; }
    const float mu = wave_sum(s) * (1.f / 1024.f);
    float q = 0.f;
#pragma unroll
    for (int k = 0; k < 16; ++k) { const float dd = acc[k] - mu; q += dd * dd; }
    const float rs = rsqrtf(wave_sum(q) * (1.f / 1024.f) + 1e-5f);
    float* y = (row < NTP) ? p.out + OUT_YP + (size_t)row * DM : p.out + OUT_YS + (size_t)(row - NTP) * DM;
#pragma unroll
    for (int c = 0; c < 2; ++c) {
      const int off = c * 512 + lane * 8;
      const float4 ga = *(const float4*)(p.ln3_g + off), gb = *(const float4*)(p.ln3_g + off + 4);
      const float4 ba = *(const float4*)(p.ln3_b + off), bb = *(const float4*)(p.ln3_b + off + 4);
      float4 ya, yb;
      ya.x = (acc[8 * c + 0] - mu) * rs * ga.x + ba.x; ya.y = (acc[8 * c + 1] - mu) * rs * ga.y + ba.y;
      ya.z = (acc[8 * c + 2] - mu) * rs * ga.z + ba.z; ya.w = (acc[8 * c + 3] - mu) * rs * ga.w + ba.w;
      yb.x = (acc[8 * c + 4] - mu) * rs * gb.x + bb.x; yb.y = (acc[8 * c + 5] - mu) * rs * gb.y + bb.y;
      yb.z = (acc[8 * c + 6] - mu) * rs * gb.z + bb.z; yb.w = (acc[8 * c + 7] - mu) * rs * gb.w + bb.w;
      *(float4*)(y + off) = ya; *(float4*)(y + off + 4) = yb;
    }
  }
}

constexpr int NPHASE = 14;
template <int PH>
DI void run_phase(const Params& p, char* smem) {
  if (PH == 0) phase_prep(p, smem);
  else if (PH == 1) phase_proj(p, smem);
  else if (PH == 2) phase_attn(p, smem);
  else if (PH == 3) phase_wout(p, smem);
  else if (PH == 4) phase_ln(p, p.ln1_g, p.ln1_b);
  else if (PH == 5) phase_gemm_bf16(p, (const u16*)(p.ws + WS_C), (const u16*)(p.ws + WS_WMQ), 1024, (u16*)(p.ws + WS_D), 0.0625f, smem);
  else if (PH == 6) phase_mem_s(p, smem);
  else if (PH == 7) phase_mem_softmax(p);
  else if (PH == 8) phase_mem_pv(p, smem);
  else if (PH == 9) phase_wmo(p, smem);
  else if (PH == 10) phase_ln(p, p.ln2_g, p.ln2_b);
  else if (PH == 11) phase_gemm_bf16(p, (const u16*)(p.ws + WS_C), (const u16*)(p.ws + WS_WPQ), 2048, (u16*)(p.ws + WS_F), 1.f, smem);
  else if (PH == 12) phase_topk(p, smem);
  else if (PH == 13) phase_peer(p);
}

template <int PH>
__global__ void __launch_bounds__(256, 2) k_phase(Params p) {
  __shared__ __attribute__((aligned(16))) char smem[SMEM_BYTES];
  run_phase<PH>(p, smem);
}

#if ONE_LAUNCH
__global__ void __launch_bounds__(256, 2) k_mega(Params p) {
  __shared__ __attribute__((aligned(16))) char smem[SMEM_BYTES];
  cg::grid_group grid = cg::this_grid();
  run_phase<0>(p, smem); grid.sync();
  run_phase<1>(p, smem); grid.sync();
  run_phase<2>(p, smem); grid.sync();
  run_phase<3>(p, smem); grid.sync();
  run_phase<4>(p, smem); grid.sync();
  run_phase<5>(p, smem); grid.sync();
  run_phase<6>(p, smem); grid.sync();
  run_phase<7>(p, smem); grid.sync();
  run_phase<8>(p, smem); grid.sync();
  run_phase<9>(p, smem); grid.sync();
  run_phase<10>(p, smem); grid.sync();
  run_phase<11>(p, smem); grid.sync();
  run_phase<12>(p, smem); grid.sync();
  run_phase<13>(p, smem);
}
#endif

extern "C" void kernel_launch(void* const* d_in, const int* in_sizes, int n_in, void* d_out, int out_size, void* d_ws, size_t ws_size,
                              hipStream_t stream) {
  (void)in_sizes; (void)n_in; (void)out_size;
  if (ws_size < WS_TOTAL) { fprintf(stderr, "workspace too small: %zu < %zu\n", ws_size, (size_t)WS_TOTAL); return; }
  Params p{};
  const float** pp = (const float**)&p;
  for (int i = 0; i < 29; ++i) pp[i] = (const float*)d_in[i];
  p.out = (float*)d_out;
  p.ws = (char*)d_ws;
#if ONE_LAUNCH
  static int grid_blocks = 0;
  if (!grid_blocks) {
    int dev = 0, cus = 0, per_cu = 0;
    hipGetDevice(&dev);
    hipDeviceGetAttribute(&cus, hipDeviceAttributeMultiprocessorCount, dev);
    hipOccupancyMaxActiveBlocksPerMultiprocessor(&per_cu, k_mega, 256, 0);
    if (per_cu > 2) per_cu = 2;
    grid_blocks = cus * per_cu;
  }
  void* args[] = {&p};
  hipError_t e = hipLaunchCooperativeKernel((void*)k_mega, dim3(grid_blocks), dim3(256), args, 0, stream);
  if (e != hipSuccess) fprintf(stderr, "cooperative launch failed: %s (grid %d)\n", hipGetErrorString(e), grid_blocks);
#else
  const int G = 512;
  k_phase<0><<<G, 256, 0, stream>>>(p);
  k_phase<1><<<G, 256, 0, stream>>>(p);
  k_phase<2><<<G, 256, 0, stream>>>(p);
  k_phase<3><<<G, 256, 0, stream>>>(p);
  k_phase<4><<<G, 256, 0, stream>>>(p);
  k_phase<5><<<G, 256, 0, stream>>>(p);
  k_phase<6><<<G, 256, 0, stream>>>(p);
  k_phase<7><<<G, 256, 0, stream>>>(p);
  k_phase<8><<<G, 256, 0, stream>>>(p);
  k_phase<9><<<G, 256, 0, stream>>>(p);
  k_phase<10><<<G, 256, 0, stream>>>(p);
  k_phase<11><<<G, 256, 0, stream>>>(p);
  k_phase<12><<<G, 256, 0, stream>>>(p);
  k_phase<13><<<G, 256, 0, stream>>>(p);
#endif
}
```

```cpp
#include <hip/hip_runtime.h>
#include <hip/hip_cooperative_groups.h>
#include <cstdio>
#include <cstdint>
namespace cg = cooperative_groups;

#ifndef ONE_LAUNCH
#define ONE_LAUNCH 1
#endif

#ifndef USE_FP8
#define USE_FP8 1
#endif
#ifndef SB_EXIT
#define SB_EXIT 1
#endif
#ifndef CUSTOM_BAR
#define CUSTOM_BAR 1
#endif
#define DI __device__ __forceinline__
typedef unsigned short u16;
typedef short bf16x8 __attribute__((ext_vector_type(8)));
typedef short s16x4 __attribute__((ext_vector_type(4)));
typedef float f32x16 __attribute__((ext_vector_type(16)));
typedef __bf16 bf2_t __attribute__((ext_vector_type(2)));
typedef float f2_t __attribute__((ext_vector_type(2)));
#define MFMA(a, b, c) __builtin_amdgcn_mfma_f32_32x32x16_bf16((a), (b), (c), 0, 0, 0)

constexpr int DM = 1024;
constexpr int NTP = 32768;
constexpr int NTS = 1024;
constexpr int NT = NTP + NTS;
constexpr int SEQ = 2048, DSEQ = 64, PAST = 4096, NMEM = 256;
constexpr int INC = 3080, INCP = 3200;
constexpr float DN_ALPHA = 1.189207115002721f;
constexpr float LOG2E = 1.4426950408889634f;

constexpr size_t OUT_YP = 0;
constexpr size_t OUT_YS = OUT_YP + (size_t)NTP * DM;
constexpr size_t OUT_SBK_P = OUT_YS + (size_t)NTS * DM;
constexpr size_t OUT_SBV_P = OUT_SBK_P + (size_t)NTP * 512;
constexpr size_t OUT_FXK_P = OUT_SBV_P + (size_t)NTP * 512;
constexpr size_t OUT_FXV_P = OUT_FXK_P + (size_t)NTP * 512;
constexpr size_t OUT_LF_P = OUT_FXV_P + (size_t)NTP * 512;
constexpr size_t OUT_MK_P = OUT_LF_P + (size_t)NTP * 8;
constexpr size_t OUT_MV_P = OUT_MK_P + (size_t)4096 * DM;
constexpr size_t OUT_SBK_S = OUT_MV_P + (size_t)4096 * DM;
constexpr size_t OUT_SBV_S = OUT_SBK_S + (size_t)NTS * 512;
constexpr size_t OUT_FXK_S = OUT_SBV_S + (size_t)NTS * 512;
constexpr size_t OUT_FXV_S = OUT_FXK_S + (size_t)NTS * 512;
constexpr size_t OUT_LF_S = OUT_FXV_S + (size_t)NTS * 512;
constexpr size_t OUT_TOTAL = OUT_LF_S + (size_t)NTS * 8;

constexpr size_t WS_WIN = 0;
constexpr size_t WS_WOUT = WS_WIN + (size_t)INCP * DM * 2;
constexpr size_t WS_WMQ = WS_WOUT + (size_t)DM * DM * 2;
constexpr size_t WS_WMKV = WS_WMQ + (size_t)DM * DM * 2;
constexpr size_t WS_WMO = WS_WMKV + (size_t)2048 * DM * 2;
constexpr size_t WS_WPQ = WS_WMO + (size_t)DM * DM * 2;
constexpr size_t WS_KA = WS_WPQ + (size_t)2048 * DM * 2;
constexpr size_t WS_KB = WS_KA + (size_t)8 * 128 * 128 * 2;
constexpr size_t WS_U = WS_KB + (size_t)8 * 128 * 128 * 2;
constexpr size_t WS_V = WS_U + (size_t)16384 * DM * 2;
constexpr size_t WS_MEMK = WS_V + (size_t)16384 * DM * 2;
constexpr size_t WS_MEMVT = WS_MEMK + (size_t)32 * 256 * DM * 2;
constexpr size_t WS_A = WS_MEMVT + (size_t)32 * 256 * DM * 2;
constexpr size_t WS_B = WS_A + (size_t)NT * DM * 4;
constexpr size_t WS_C = WS_B + (size_t)NT * DM * 4;
constexpr size_t WS_D = WS_C + (size_t)NT * DM * 2;
constexpr size_t WS_E = WS_D + (size_t)NT * DM * 2;
constexpr size_t WS_F = WS_E + (size_t)NT * DM * 2;
constexpr size_t WS_BAR = WS_F + (size_t)NT * DM * 4;
constexpr size_t WS_USC = WS_BAR + 256;
constexpr size_t WS_VSC = WS_USC + (size_t)16384 * 4;
constexpr size_t WS_TOTAL = WS_VSC + (size_t)16384 * 4;

struct Params {
  const float *x_prompt, *x_sample, *mem_prompt, *c_sb_k, *c_sb_v, *c_fx_k, *c_fx_v, *c_fx_logf, *c_mem_k, *c_mem_v;
  const float *w_in, *b_f, *w_gn, *w_out, *ln1_g, *ln1_b, *w_mq, *w_mk, *w_mv, *w_mo, *ln2_g, *ln2_b;
  const float *w_pq, *keys_a, *keys_b, *peer_u, *peer_v, *ln3_g, *ln3_b;
  float* out;
  char* ws;
};

constexpr int SMEM_BYTES = 73728 + 1024;

DI unsigned pk2(float a, float b) { f2_t v = {a, b}; bf2_t r = __builtin_convertvector(v, bf2_t); return __builtin_bit_cast(unsigned, r); }
DI u16 bf1(float a) { return (u16)(pk2(a, 0.f) & 0xffffu); }
DI float bflo(unsigned w) { return __uint_as_float(w << 16); }
DI float bfhi(unsigned w) { return __uint_as_float(w & 0xffff0000u); }
DI float wave_sum(float v) {
#pragma unroll
  for (int o = 32; o >= 1; o >>= 1) v += __shfl_xor(v, o);
  return v;
}
DI float wave_max(float v) {
#pragma unroll
  for (int o = 32; o >= 1; o >>= 1) v = fmaxf(v, __shfl_xor(v, o));
  return v;
}
DI int vblock() { int nb = gridDim.x, b = blockIdx.x; return ((nb & 7) == 0) ? (b & 7) * (nb >> 3) + (b >> 3) : b; }
DI const float* xrow(const Params& p, int g) { return g < NTP ? p.x_prompt + (size_t)g * DM : p.x_sample + (size_t)(g - NTP) * DM; }

DI void tconv_tile(const float* src, int ldsrc, int C, u16* dst, int lddst, const float* rowscale, int tr, int tc, float* tile) {
  const int tid = threadIdx.x;
  {
    const int r = tid >> 2, c0 = (tid & 3) * 16;
    const int gr = tr * 64 + r;
    const float sc = rowscale ? rowscale[gr] : 1.f;
#pragma unroll
    for (int j = 0; j < 4; ++j) {
      const int gc = tc * 64 + c0 + 4 * j;
      float4 v = make_float4(0.f, 0.f, 0.f, 0.f);
      if (gc < C) v = *(const float4*)(src + (size_t)gr * ldsrc + gc);
      float* t = tile + r * 65 + c0 + 4 * j;
      t[0] = v.x * sc; t[1] = v.y * sc; t[2] = v.z * sc; t[3] = v.w * sc;
    }
  }
  __syncthreads();
  {
    const int n = tid >> 2, k0 = (tid & 3) * 16;
    unsigned w[8];
#pragma unroll
    for (int e = 0; e < 8; ++e) w[e] = pk2(tile[(k0 + 2 * e) * 65 + n], tile[(k0 + 2 * e + 1) * 65 + n]);
    uint4* d = (uint4*)(dst + (size_t)(tc * 64 + n) * lddst + tr * 64 + k0);
    d[0] = make_uint4(w[0], w[1], w[2], w[3]);
    d[1] = make_uint4(w[4], w[5], w[6], w[7]);
  }
  __syncthreads();
}

DI void conv_range(const float* src, u16* dst, size_t n8, int bid, int nb) {
  for (size_t i = (size_t)bid * 256 + threadIdx.x; i < n8; i += (size_t)nb * 256) {
    const float4 a = ((const float4*)src)[2 * i], b = ((const float4*)src)[2 * i + 1];
    ((uint4*)dst)[i] = make_uint4(pk2(a.x, a.y), pk2(a.z, a.w), pk2(b.x, b.y), pk2(b.z, b.w));
  }
}

DI void phase_prep(const Params& p, char* smem) {
  float* tile = (float*)smem;
  const int bid = blockIdx.x, nb = gridDim.x;
  u16* ws16 = (u16*)p.ws;
  constexpr int T_WIN = 16 * 50, T_SQ = 256, T_PQ = 16 * 32, T_MV = 16 * 4 * 16;
  constexpr int T0 = T_WIN, T1 = T0 + T_SQ, T2 = T1 + T_SQ, T3 = T2 + T_SQ, T4 = T3 + T_SQ, T5 = T4 + T_SQ, T6 = T5 + T_PQ, T7 = T6 + T_MV;
  for (int t = bid; t < T7; t += nb) {
    if (t < T0) { tconv_tile(p.w_in, INC, INC, (u16*)(p.ws + WS_WIN), DM, nullptr, t / 50, t % 50, tile); }
    else if (t < T1) { int u = t - T0; tconv_tile(p.w_out, DM, DM, (u16*)(p.ws + WS_WOUT), DM, p.w_gn, u >> 4, u & 15, tile); }
    else if (t < T2) { int u = t - T1; tconv_tile(p.w_mq, DM, DM, (u16*)(p.ws + WS_WMQ), DM, nullptr, u >> 4, u & 15, tile); }
    else if (t < T3) { int u = t - T2; tconv_tile(p.w_mk, DM, DM, (u16*)(p.ws + WS_WMKV), DM, nullptr, u >> 4, u & 15, tile); }
    else if (t < T4) { int u = t - T3; tconv_tile(p.w_mv, DM, DM, (u16*)(p.ws + WS_WMKV) + (size_t)DM * DM, DM, nullptr, u >> 4, u & 15, tile); }
    else if (t < T5) { int u = t - T4; tconv_tile(p.w_mo, DM, DM, (u16*)(p.ws + WS_WMO), DM, nullptr, u >> 4, u & 15, tile); }
    else if (t < T6) { int u = t - T5; tconv_tile(p.w_pq, 2048, 2048, (u16*)(p.ws + WS_WPQ), DM, nullptr, u >> 5, u & 31, tile); }
    else { int u = t - T6; int b = u >> 6, r = u & 63;
      tconv_tile(p.c_mem_v + (size_t)b * 256 * DM, DM, DM, (u16*)(p.ws + WS_MEMVT) + (size_t)(16 + b) * DM * 256, 256, nullptr, r >> 4, r & 15, tile); }
  }
  (void)ws16;
  conv_range(p.x_prompt, (u16*)(p.ws + WS_C), (size_t)NTP * DM / 8, bid, nb);
  conv_range(p.x_sample, (u16*)(p.ws + WS_C) + (size_t)NTP * DM, (size_t)NTS * DM / 8, bid, nb);
  conv_range(p.mem_prompt, (u16*)(p.ws + WS_E), (size_t)4096 * DM / 8, bid, nb);
  conv_range(p.c_mem_k, (u16*)(p.ws + WS_MEMK) + (size_t)16 * 256 * DM, (size_t)16 * 256 * DM / 8, bid, nb);
  conv_range(p.keys_a, (u16*)(p.ws + WS_KA), (size_t)8 * 128 * 128 / 8, bid, nb);
  conv_range(p.keys_b, (u16*)(p.ws + WS_KB), (size_t)8 * 128 * 128 / 8, bid, nb);
#if USE_FP8
  {
    const int lane = threadIdx.x & 63;
    const int wg = bid * 4 + (threadIdx.x >> 6), nw = nb * 4;
    for (int row = wg; row < 32768; row += nw) {
      const bool isv = row >= 16384;
      const int r = isv ? row - 16384 : row;
      const float4* src = (const float4*)((isv ? p.peer_v : p.peer_u) + (size_t)r * DM) + 4 * lane;
      float4 a[4];
      float am = 0.f;
#pragma unroll
      for (int j = 0; j < 4; ++j) { a[j] = src[j]; am = fmaxf(am, fmaxf(fmaxf(fabsf(a[j].x), fabsf(a[j].y)), fmaxf(fabsf(a[j].z), fabsf(a[j].w)))); }
      am = wave_max(am);
      int ex = 0;
      if (am > 0.f) (void)frexpf(am, &ex);
      const float sc = ldexpf(1.f, 8 - ex), isc = ldexpf(1.f, ex - 8);
      unsigned w[4];
#pragma unroll
      for (int j = 0; j < 4; ++j) {
        int t = __builtin_amdgcn_cvt_pk_fp8_f32(a[j].x * sc, a[j].y * sc, 0, false);
        t = __builtin_amdgcn_cvt_pk_fp8_f32(a[j].z * sc, a[j].w * sc, t, true);
        w[j] = (unsigned)t;
      }
      *(uint4*)(p.ws + (isv ? WS_V : WS_U) + (size_t)r * DM + 16 * lane) = make_uint4(w[0], w[1], w[2], w[3]);
      if (lane == 0) ((float*)(p.ws + (isv ? WS_VSC : WS_USC)))[r] = isc;
    }
  }
#else
  conv_range(p.peer_u, (u16*)(p.ws + WS_U), (size_t)16384 * DM / 8, bid, nb);
  conv_range(p.peer_v, (u16*)(p.ws + WS_V), (size_t)16384 * DM / 8, bid, nb);
#endif
}

constexpr int LLD = 72;
struct SmemGemm { u16 a[2][128 * LLD]; u16 b[2][128 * LLD]; };

struct LdBf16 {
  const u16* base; int ld;
  uint4 r[4];
  DI void fetch(int kt, int tid) {
#pragma unroll
    for (int i = 0; i < 4; ++i) { const int c = tid + 256 * i; r[i] = *(const uint4*)(base + (size_t)(c >> 3) * ld + kt * 64 + (c & 7) * 8); }
  }
  DI void stash(u16* lds, int tid) {
#pragma unroll
    for (int i = 0; i < 4; ++i) { const int c = tid + 256 * i; *(uint4*)(lds + (c >> 3) * LLD + (c & 7) * 8) = r[i]; }
  }
};
struct LdF32 {
  const float* base; int ld;
  float4 r[8];
  DI void fetch(int kt, int tid) {
#pragma unroll
    for (int i = 0; i < 4; ++i) { const int c = tid + 256 * i; const float4* s = (const float4*)(base + (size_t)(c >> 3) * ld + kt * 64 + (c & 7) * 8); r[2 * i] = s[0]; r[2 * i + 1] = s[1]; }
  }
  DI void stash(u16* lds, int tid) {
#pragma unroll
    for (int i = 0; i < 4; ++i) { const int c = tid + 256 * i; const float4 a = r[2 * i], b = r[2 * i + 1];
      *(uint4*)(lds + (c >> 3) * LLD + (c & 7) * 8) = make_uint4(pk2(a.x, a.y), pk2(a.z, a.w), pk2(b.x, b.y), pk2(b.z, b.w)); }
  }
};
struct LdBf16Scaled {
  const u16* base; int ld; const float* sc;
  uint4 r[4];
  int ktc;
  DI void fetch(int kt, int tid) {
    ktc = kt;
#pragma unroll
    for (int i = 0; i < 4; ++i) { const int c = tid + 256 * i; r[i] = *(const uint4*)(base + (size_t)(c >> 3) * ld + kt * 64 + (c & 7) * 8); }
  }
  DI void stash(u16* lds, int tid) {
    const int half = (ktc >= 8) ? 1 : 0;
#pragma unroll
    for (int i = 0; i < 4; ++i) { const int c = tid + 256 * i; const float s = sc[(c >> 3) * 2 + half]; const uint4 v = r[i];
      *(uint4*)(lds + (c >> 3) * LLD + (c & 7) * 8) = make_uint4(pk2(bflo(v.x) * s, bfhi(v.x) * s), pk2(bflo(v.y) * s, bfhi(v.y) * s),
                                                               pk2(bflo(v.z) * s, bfhi(v.z) * s), pk2(bflo(v.w) * s, bfhi(v.w) * s)); }
  }
};

template <class AL, class EPI>
DI void gemm_tile(AL& al, const u16* Bt, int ldb, int K, int m0, int n0, EPI epi, char* smem) {
  SmemGemm& sm = *(SmemGemm*)smem;
  const int tid = threadIdx.x, lane = tid & 63, wid = tid >> 6, wr = wid >> 1, wc = wid & 1;
  LdBf16 bl; bl.base = Bt + (size_t)n0 * ldb; bl.ld = ldb;
  f32x16 acc[2][2];
#pragma unroll
  for (int i = 0; i < 2; ++i)
#pragma unroll
    for (int j = 0; j < 2; ++j)
#pragma unroll
      for (int e = 0; e < 16; ++e) acc[i][j][e] = 0.f;
  const int KT = K >> 6;
  al.fetch(0, tid); bl.fetch(0, tid);
  al.stash(sm.a[0], tid); bl.stash(sm.b[0], tid);
  __syncthreads();
  for (int kt = 0; kt < KT; ++kt) {
    const int cur = kt & 1;
    if (kt + 1 < KT) { al.fetch(kt + 1, tid); bl.fetch(kt + 1, tid); }
    const u16* pa = sm.a[cur] + (wr * 64 + (lane & 31)) * LLD + (lane >> 5) * 8;
    const u16* pb = sm.b[cur] + (wc * 64 + (lane & 31)) * LLD + (lane >> 5) * 8;
#pragma unroll
    for (int kk = 0; kk < 4; ++kk) {
      const bf16x8 a0 = *(const bf16x8*)(pa + kk * 16), a1 = *(const bf16x8*)(pa + 32 * LLD + kk * 16);
      const bf16x8 b0 = *(const bf16x8*)(pb + kk * 16), b1 = *(const bf16x8*)(pb + 32 * LLD + kk * 16);
      acc[0][0] = MFMA(a0, b0, acc[0][0]); acc[0][1] = MFMA(a0, b1, acc[0][1]);
      acc[1][0] = MFMA(a1, b0, acc[1][0]); acc[1][1] = MFMA(a1, b1, acc[1][1]);
    }
    if (kt + 1 < KT) { al.stash(sm.a[cur ^ 1], tid); bl.stash(sm.b[cur ^ 1], tid); }
    __syncthreads();
  }
#pragma unroll
  for (int i = 0; i < 2; ++i)
#pragma unroll
    for (int j = 0; j < 2; ++j) epi(m0 + wr * 64 + i * 32, n0 + wc * 64 + j * 32, acc[i][j]);
}
#define ACC_ROW(e, hh) (((e) & 3) + 8 * ((e) >> 2) + 4 * (hh))

DI void phase_proj(const Params& p, char* smem) {
  const int vb = vblock(), nb = gridDim.x;
  constexpr int T_G1 = 264 * 25, T_MKV = 32 * 16;
  float* out = p.out;
  for (int t = vb; t < T_G1 + T_MKV; t += nb) {
    if (t < T_G1) {
      const int mt = t / 25, nt = t % 25;
      const int m0 = mt * 128, n0 = nt * 128;
      LdBf16 al; al.base = (const u16*)(p.ws + WS_C) + (size_t)m0 * DM; al.ld = DM;
      const bool smp = m0 >= NTP;
      const float* b_f = p.b_f;
      u16* qsb = (u16*)(p.ws + WS_D);
      u16* qfx = qsb + (size_t)NT * 512;
      auto epi = [=](int r0, int c0, const f32x16& acc) {
        const int lane = threadIdx.x & 63, hh = lane >> 5, col = c0 + (lane & 31);
        const int seg = c0 >> 9, cc = col & 511;
        if (seg == 0 || seg == 3) {
          u16* q = (seg == 0) ? qsb : qfx;
#pragma unroll
          for (int e = 0; e < 16; ++e) q[(size_t)(r0 + ACC_ROW(e, hh)) * 512 + cc] = bf1(acc[e] * 0.125f);
        } else if (seg < 6) {
          size_t ob;
          if (!smp) ob = (seg == 1) ? OUT_SBK_P : (seg == 2) ? OUT_SBV_P : (seg == 4) ? OUT_FXK_P : OUT_FXV_P;
          else ob = (seg == 1) ? OUT_SBK_S : (seg == 2) ? OUT_SBV_S : (seg == 4) ? OUT_FXK_S : OUT_FXV_S;
          const int rb = smp ? r0 - NTP : r0;
#pragma unroll
          for (int e = 0; e < 16; ++e) out[ob + (size_t)(rb + ACC_ROW(e, hh)) * 512 + cc] = acc[e];
        } else {
          const int c = col - 3072;
          if (c < 8) {
            const float bf = b_f[c];
            const size_t ob = smp ? OUT_LF_S : OUT_LF_P;
            const int rb = smp ? r0 - NTP : r0;
#pragma unroll
            for (int e = 0; e < 16; ++e) {
              const float z = acc[e] + bf;
              const float ls = fminf(z, 0.f) - log1pf(__expf(-fabsf(z)));
              out[ob + (size_t)(rb + ACC_ROW(e, hh)) * 8 + c] = ls;
            }
          }
        }
      };
      gemm_tile(al, (const u16*)(p.ws + WS_WIN), DM, DM, m0, n0, epi, smem);
    } else {
      const int u = t - T_G1;
      const int mt = u >> 4, nt = u & 15;
      const int m0 = mt * 128, n0 = nt * 128;
      LdBf16 al; al.base = (const u16*)(p.ws + WS_E) + (size_t)m0 * DM; al.ld = DM;
      u16* kb = (u16*)(p.ws + WS_MEMK);
      u16* vt = (u16*)(p.ws + WS_MEMVT);
      auto epi = [=](int r0, int c0, const f32x16& acc) {
        const int lane = threadIdx.x & 63, hh = lane >> 5, col = c0 + (lane & 31);
        if (c0 < 1024) {
#pragma unroll
          for (int e = 0; e < 16; ++e) { const size_t idx = (size_t)(r0 + ACC_ROW(e, hh)) * DM + col; out[OUT_MK_P + idx] = acc[e]; kb[idx] = bf1(acc[e]); }
        } else {
          const int c = col - 1024;
#pragma unroll
          for (int e = 0; e < 16; ++e) out[OUT_MV_P + (size_t)(r0 + ACC_ROW(e, hh)) * DM + c] = acc[e];
          const int b = r0 >> 8;
#pragma unroll
          for (int g4 = 0; g4 < 4; ++g4) {
            const int m = (r0 & 255) + 8 * g4 + 4 * hh;
            *(uint2*)(vt + ((size_t)b * DM + c) * 256 + m) = make_uint2(pk2(acc[4 * g4], acc[4 * g4 + 1]), pk2(acc[4 * g4 + 2], acc[4 * g4 + 3]));
          }
        }
      };
      gemm_tile(al, (const u16*)(p.ws + WS_WMKV), DM, DM, m0, n0, epi, smem);
    }
  }
}

constexpr int KLD = 72, VLD = 68;
struct SmemAttn { u16 k[2][64 * KLD]; u16 vt[2][64 * VLD]; float cb[4160]; float part[256]; };
static_assert(sizeof(SmemAttn) <= SMEM_BYTES, "attn smem");

struct KVRegs { float4 k[4], v[4]; };
DI void kv_fetch(KVRegs& r, const float* kb, const float* vb, int tid) {
#pragma unroll
  for (int i = 0; i < 4; ++i) { const int c = tid + 256 * i; const size_t o = (size_t)(c >> 4) * 512 + (c & 15) * 4; r.k[i] = *(const float4*)(kb + o); r.v[i] = *(const float4*)(vb + o); }
}
DI void kv_stash(const KVRegs& r, u16* ks, u16* vts, int tid) {
#pragma unroll
  for (int i = 0; i < 4; ++i) {
    const int c = tid + 256 * i; const int row = c >> 4, c4 = (c & 15) * 4;
    *(uint2*)(ks + row * KLD + c4) = make_uint2(pk2(r.k[i].x, r.k[i].y), pk2(r.k[i].z, r.k[i].w));
    vts[(c4 + 0) * VLD + row] = bf1(r.v[i].x); vts[(c4 + 1) * VLD + row] = bf1(r.v[i].y);
    vts[(c4 + 2) * VLD + row] = bf1(r.v[i].z); vts[(c4 + 3) * VLD + row] = bf1(r.v[i].w);
  }
}
DI bf16x8 pack8(const f32x16& x, int s) {
  union { unsigned u[4]; bf16x8 v; } t;
  t.u[0] = pk2(x[8 * s + 0], x[8 * s + 1]); t.u[1] = pk2(x[8 * s + 2], x[8 * s + 3]);
  t.u[2] = pk2(x[8 * s + 4], x[8 * s + 5]); t.u[3] = pk2(x[8 * s + 6], x[8 * s + 7]);
  return t.v;
}

template <bool FOX>
DI void attn_item(const Params& p, int smp, int b, int h, int qb, char* smem) {
  SmemAttn& sm = *(SmemAttn*)smem;
  const int tid = threadIdx.x, lane = tid & 63, wid = tid >> 6, r31 = lane & 31, hh = lane >> 5;
  const int nkt = smp ? 65 : 2 * qb + 2;
  const int jdiag = smp ? 64 : 2 * qb;
  int qi = wid * 32 + r31; if (smp) qi &= 63;
  const int qpos = (smp ? PAST : qb * 128) + qi;
  const int g = smp ? NTP + b * DSEQ + qi : b * SEQ + qb * 128 + qi;
  const u16* Q = (const u16*)(p.ws + WS_D) + (FOX ? (size_t)NT * 512 : 0);
  bf16x8 qf[4];
#pragma unroll
  for (int kk = 0; kk < 4; ++kk) qf[kk] = *(const bf16x8*)(Q + (size_t)g * 512 + h * 64 + kk * 16 + hh * 8);

  const float* kcache = FOX ? p.c_fx_k : p.c_sb_k;
  const float* vcache = FOX ? p.c_fx_v : p.c_sb_v;
  const size_t okp = FOX ? OUT_FXK_P : OUT_SBK_P, ovp = FOX ? OUT_FXV_P : OUT_SBV_P;
  const size_t oks = FOX ? OUT_FXK_S : OUT_SBK_S, ovs = FOX ? OUT_FXV_S : OUT_SBV_S;
  auto kptr = [&](int j) -> const float* {
    if (!smp) return p.out + okp + ((size_t)(b * SEQ + 64 * j) * 512 + h * 64);
    if (j < 64) return kcache + ((size_t)(b * PAST + 64 * j) * 512 + h * 64);
    return p.out + oks + ((size_t)(b * DSEQ) * 512 + h * 64);
  };
  auto vptr = [&](int j) -> const float* {
    if (!smp) return p.out + ovp + ((size_t)(b * SEQ + 64 * j) * 512 + h * 64);
    if (j < 64) return vcache + ((size_t)(b * PAST + 64 * j) * 512 + h * 64);
    return p.out + ovs + ((size_t)(b * DSEQ) * 512 + h * 64);
  };

  if (FOX) {
    const int nkeys = nkt * 64;
    const int per = (nkeys + 255) >> 8;
    const int s0 = tid * per, s1 = min(s0 + per, nkeys);
    auto lf = [&](int s) -> float {
      if (!smp) return p.out[OUT_LF_P + (size_t)(b * SEQ + s) * 8 + h];
      if (s < PAST) return p.c_fx_logf[(size_t)(b * PAST + s) * 8 + h];
      return p.out[OUT_LF_S + (size_t)(b * DSEQ + s - PAST) * 8 + h];
    };
    float loc = 0.f;
    for (int s = s0; s < s1; ++s) loc += lf(s);
    sm.part[tid] = loc;
    __syncthreads();
    float run = 0.f;
    for (int i = 0; i < tid; ++i) run += sm.part[i];
    for (int s = s0; s < s1; ++s) { run += lf(s); sm.cb[s] = -run * LOG2E; }
    __syncthreads();
  }

  bf16x8 tri[2];
  if (!FOX) {
#pragma unroll
    for (int s = 0; s < 2; ++s)
#pragma unroll
      for (int j = 0; j < 8; ++j) { const int kin = 16 * s + 8 * (j >> 2) + 4 * hh + (j & 3); tri[s][j] = (kin >= r31) ? (short)0x3F80 : (short)0; }
  }

  f32x16 o[2];
#pragma unroll
  for (int d = 0; d < 2; ++d)
#pragma unroll
    for (int e = 0; e < 16; ++e) o[d][e] = 0.f;
  float mrun = -1e30f, lrun = 0.f, R = 0.f;

  KVRegs kv;
  const int jfirst = FOX ? 0 : nkt - 1;
  kv_fetch(kv, kptr(jfirst), vptr(jfirst), tid);
  kv_stash(kv, sm.k[0], sm.vt[0], tid);
  __syncthreads();
  for (int it = 0; it < nkt; ++it) {
    const int j = FOX ? it : nkt - 1 - it;
    const int cur = it & 1;
    if (it + 1 < nkt) { const int jn = FOX ? j + 1 : j - 1; kv_fetch(kv, kptr(jn), vptr(jn), tid); }
    f32x16 s[2];
#pragma unroll
    for (int t2 = 0; t2 < 2; ++t2) {
#pragma unroll
      for (int e = 0; e < 16; ++e) s[t2][e] = 0.f;
      const u16* pk = sm.k[cur] + (t2 * 32 + r31) * KLD + hh * 8;
#pragma unroll
      for (int kk = 0; kk < 4; ++kk) { const bf16x8 a = *(const bf16x8*)(pk + kk * 16); s[t2] = MFMA(a, qf[kk], s[t2]); }
    }
    const bool diag = j >= jdiag;
    const int kbase = 64 * j + 4 * hh;
    if (FOX) {
      float mloc = -1e30f;
#pragma unroll
      for (int t2 = 0; t2 < 2; ++t2)
#pragma unroll
        for (int g4 = 0; g4 < 4; ++g4) {
          const float4 bb = *(const float4*)(sm.cb + 64 * j + 32 * t2 + 8 * g4 + 4 * hh);
          const float bv[4] = {bb.x, bb.y, bb.z, bb.w};
#pragma unroll
          for (int e = 0; e < 4; ++e) {
            float x = s[t2][4 * g4 + e] * LOG2E + bv[e];
            if (diag && (kbase + 32 * t2 + 8 * g4 + e > qpos)) x = -1e30f;
            s[t2][4 * g4 + e] = x;
            mloc = fmaxf(mloc, x);
          }
        }
      mloc = fmaxf(mloc, __shfl_xor(mloc, 32));
      const float mnew = fmaxf(mrun, mloc);
      const float alpha = exp2f(mrun - mnew);
      mrun = mnew;
      float ls = 0.f;
#pragma unroll
      for (int t2 = 0; t2 < 2; ++t2)
#pragma unroll
        for (int e = 0; e < 16; ++e) { const float pv = exp2f(s[t2][e] - mnew); s[t2][e] = pv; ls += pv; }
      lrun = lrun * alpha + ls;
#pragma unroll
      for (int d = 0; d < 2; ++d)
#pragma unroll
        for (int e = 0; e < 16; ++e) o[d][e] *= alpha;
    } else {
#pragma unroll
      for (int t2 = 1; t2 >= 0; --t2) {
        f32x16 lk;
#pragma unroll
        for (int e = 0; e < 16; ++e) {
          const float z = s[t2][e];
          const float sp = fmaxf(z, 0.f) + __logf(1.f + __expf(-fabsf(z)));
          const bool vis = !diag || (kbase + 32 * t2 + ACC_ROW(e, 0) < qpos);
          lk[e] = vis ? -sp : 0.f;
        }
        bf16x8 fh[2], fl[2];
#pragma unroll
        for (int sI = 0; sI < 2; ++sI) fh[sI] = pack8(lk, sI);
#pragma unroll
        for (int e = 0; e < 16; ++e) lk[e] -= __uint_as_float(((unsigned)(u16)fh[e >> 3][e & 7]) << 16);
#pragma unroll
        for (int sI = 0; sI < 2; ++sI) fl[sI] = pack8(lk, sI);
        f32x16 inc;
#pragma unroll
        for (int e = 0; e < 16; ++e) inc[e] = R;
#pragma unroll
        for (int sI = 0; sI < 2; ++sI) { inc = MFMA(tri[sI], fh[sI], inc); inc = MFMA(tri[sI], fl[sI], inc); }
#pragma unroll
        for (int e = 0; e < 16; ++e) {
          const bool vis = !diag || (kbase + 32 * t2 + ACC_ROW(e, 0) < qpos);
          const float w = exp2f((s[t2][e] + inc[e]) * LOG2E);
          s[t2][e] = vis ? w : 0.f;
        }
        R = __shfl(inc[0], r31);
      }
    }
#pragma unroll
    for (int t2 = 0; t2 < 2; ++t2)
#pragma unroll
      for (int sI = 0; sI < 2; ++sI) {
        const bf16x8 pf = pack8(s[t2], sI);
#pragma unroll
        for (int d = 0; d < 2; ++d) {
          const u16* pv = sm.vt[cur] + (d * 32 + r31) * VLD + 32 * t2 + 16 * sI + 4 * hh;
          union { s16x4 q[2]; bf16x8 v; } a;
          a.q[0] = *(const s16x4*)(pv); a.q[1] = *(const s16x4*)(pv + 8);
          o[d] = MFMA(a.v, pf, o[d]);
        }
      }
    if (it + 1 < nkt) kv_stash(kv, sm.k[cur ^ 1], sm.vt[cur ^ 1], tid);
#if SB_EXIT
    if (!FOX) { if (__syncthreads_and(R < -110.f)) break; } else __syncthreads();
#else
    __syncthreads();
#endif
  }
  float inv = 1.f;
  if (FOX) { const float lt = lrun + __shfl_xor(lrun, 32); inv = 1.f / lt; }
  if (!smp || wid < 2) {
    u16* od = (u16*)(p.ws + WS_E) + (size_t)g * DM + (FOX ? 512 : 0) + h * 64;
#pragma unroll
    for (int d = 0; d < 2; ++d)
#pragma unroll
      for (int g4 = 0; g4 < 4; ++g4)
        *(uint2*)(od + d * 32 + 8 * g4 + 4 * hh) = make_uint2(pk2(o[d][4 * g4] * inv, o[d][4 * g4 + 1] * inv), pk2(o[d][4 * g4 + 2] * inv, o[d][4 * g4 + 3] * inv));
  }
}

DI void phase_attn(const Params& p, char* smem) {
  const int bid = blockIdx.x, nb = gridDim.x;
  constexpr int NI = 256 + 4096;
  for (int it = bid; it < NI; it += nb) {
    if (it < 128) { attn_item<true>(p, 1, it >> 3, it & 7, 0, smem); }
    else if (it < 256) { const int u = it - 128; attn_item<false>(p, 1, u >> 3, u & 7, 0, smem); }
    else {
      const int u = it - 256;
      const int qb = 15 - (u >> 8), w = u & 255;
      const int fox = w & 1, bh = w >> 1;
      if (fox) attn_item<true>(p, 0, bh >> 3, bh & 7, qb, smem); else attn_item<false>(p, 0, bh >> 3, bh & 7, qb, smem);
    }
  }
}

DI void phase_wout(const Params& p, char* smem) {
  const int vb = vblock(), nb = gridDim.x;
  float* pre = (float*)(p.ws + WS_A);
  const u16* o = (const u16*)(p.ws + WS_E);
  float* sc_s = (float*)(smem + 73728);
  for (int t = vb; t < 264 * 8; t += nb) {
    const int mt = t >> 3, nt = t & 7;
    const int m0 = mt * 128, n0 = nt * 128;
    {
      const int lane = threadIdx.x & 63, wid = threadIdx.x >> 6;
      for (int rr = 0; rr < 32; ++rr) {
        const int row = wid * 32 + rr;
#pragma unroll
        for (int gi = 0; gi < 2; ++gi) {
          const uint4 v = *(const uint4*)(o + (size_t)(m0 + row) * DM + gi * 512 + lane * 8);
          float ss = bflo(v.x) * bflo(v.x) + bfhi(v.x) * bfhi(v.x) + bflo(v.y) * bflo(v.y) + bfhi(v.y) * bfhi(v.y) +
                     bflo(v.z) * bflo(v.z) + bfhi(v.z) * bfhi(v.z) + bflo(v.w) * bflo(v.w) + bfhi(v.w) * bfhi(v.w);
          ss = wave_sum(ss);
          if (lane == 0) sc_s[row * 2 + gi] = rsqrtf(ss * (1.f / 512.f) + 1e-6f);
        }
      }
      __syncthreads();
    }
    LdBf16Scaled al; al.base = o + (size_t)m0 * DM; al.ld = DM; al.sc = sc_s; al.ktc = 0;
    const float* xr = xrow(p, m0);
    auto epi = [=](int r0, int c0, const f32x16& acc) {
      const int lane = threadIdx.x & 63, hh = lane >> 5, col = c0 + (lane & 31);
#pragma unroll
      for (int e = 0; e < 16; ++e) { const int r = r0 + ACC_ROW(e, hh); pre[(size_t)r * DM + col] = DN_ALPHA * xr[(size_t)(r - m0) * DM + col] + acc[e]; }
    };
    gemm_tile(al, (const u16*)(p.ws + WS_WOUT), DM, DM, m0, n0, epi, smem);
  }
}

DI void phase_ln(const Params& p, const float* gam, const float* bet) {
  const float* pre = (const float*)(p.ws + WS_A);
  float* xf = (float*)(p.ws + WS_B);
  u16* xb = (u16*)(p.ws + WS_C);
  const int lane = threadIdx.x & 63;
  const int wg = blockIdx.x * 4 + (threadIdx.x >> 6), nw = gridDim.x * 4;
  for (int row = wg; row < NT; row += nw) {
    float4 v[4];
    float s = 0.f;
#pragma unroll
    for (int j = 0; j < 4; ++j) { v[j] = ((const float4*)(pre + (size_t)row * DM))[lane + 64 * j]; s += v[j].x + v[j].y + v[j].z + v[j].w; }
    const float mu = wave_sum(s) * (1.f / 1024.f);
    float q = 0.f;
#pragma unroll
    for (int j = 0; j < 4; ++j) { const float a = v[j].x - mu, b2 = v[j].y - mu, c = v[j].z - mu, d = v[j].w - mu; q += a * a + b2 * b2 + c * c + d * d; }
    const float rs = rsqrtf(wave_sum(q) * (1.f / 1024.f) + 1e-5f);
#pragma unroll
    for (int j = 0; j < 4; ++j) {
      const float4 gg = ((const float4*)gam)[lane + 64 * j], bb = ((const float4*)bet)[lane + 64 * j];
      float4 y;
      y.x = (v[j].x - mu) * rs * gg.x + bb.x; y.y = (v[j].y - mu) * rs * gg.y + bb.y;
      y.z = (v[j].z - mu) * rs * gg.z + bb.z; y.w = (v[j].w - mu) * rs * gg.w + bb.w;
      ((float4*)(xf + (size_t)row * DM))[lane + 64 * j] = y;
      ((uint2*)(xb + (size_t)row * DM))[lane + 64 * j] = make_uint2(pk2(y.x, y.y), pk2(y.z, y.w));
    }
  }
}

DI void phase_gemm_bf16(const Params& p, const u16* A, const u16* Wt, int N, u16* O, float scale, char* smem) {
  const int vb = vblock(), nb = gridDim.x;
  const int ntn = N >> 7;
  for (int t = vb; t < 264 * ntn; t += nb) {
    const int mt = t / ntn, nt = t % ntn;
    const int m0 = mt * 128, n0 = nt * 128;
    LdBf16 al; al.base = A + (size_t)m0 * DM; al.ld = DM;
    auto epi = [=](int r0, int c0, const f32x16& acc) {
      const int lane = threadIdx.x & 63, hh = lane >> 5, col = c0 + (lane & 31);
#pragma unroll
      for (int e = 0; e < 16; ++e) O[(size_t)(r0 + ACC_ROW(e, hh)) * N + col] = bf1(acc[e] * scale);
    };
    gemm_tile(al, Wt, DM, DM, m0, n0, epi, smem);
  }
}

DI void memattn_decode(int t, int& mt, int& sb, int& hd, int& nt, int& batch) {
  if (t < 2048) { mt = t >> 3; hd = (t >> 1) & 3; nt = t & 1; sb = -1; batch = mt >> 4; }
  else { const int u = t - 2048; mt = 256 + (u >> 4); sb = (u >> 3) & 1; hd = (u >> 1) & 3; nt = u & 1; batch = 16 + (mt - 256) * 2 + sb; }
}
DI void phase_mem_s(const Params& p, char* smem) {
  const int vb = vblock(), nb = gridDim.x;
  const u16* qm = (const u16*)(p.ws + WS_D);
  float* S = (float*)(p.ws + WS_F);
  for (int t = vb; t < 2048 + 128; t += nb) {
    int mt, sb, hd, nt, batch; memattn_decode(t, mt, sb, hd, nt, batch);
    const int m0 = mt * 128;
    LdBf16 al; al.base = qm + (size_t)m0 * DM + hd * 256; al.ld = DM;
    const u16* Bt = (const u16*)(p.ws + WS_MEMK) + (size_t)batch * 256 * DM + hd * 256;
    auto epi = [=](int r0, int c0, const f32x16& acc) {
      const int lane = threadIdx.x & 63, hh = lane >> 5, col = c0 + (lane & 31);
#pragma unroll
      for (int e = 0; e < 16; ++e) { const int r = ACC_ROW(e, hh) + r0; if (sb < 0 || (((r - m0) >> 6) == sb)) S[(size_t)r * DM + hd * 256 + col] = acc[e]; }
    };
    gemm_tile(al, Bt, DM, 256, m0, nt * 128, epi, smem);
  }
}
DI void phase_mem_softmax(const Params& p) {
  const float* S = (const float*)(p.ws + WS_F);
  u16* P = (u16*)(p.ws + WS_D);
  const int lane = threadIdx.x & 63;
  const int wg = blockIdx.x * 4 + (threadIdx.x >> 6), nw = gridDim.x * 4;
  for (int row = wg; row < NT * 4; row += nw) {
    const float4 v = ((const float4*)(S + (size_t)row * 256))[lane];
    const float m = wave_max(fmaxf(fmaxf(v.x, v.y), fmaxf(v.z, v.w)));
    const float a = __expf(v.x - m), b = __expf(v.y - m), c = __expf(v.z - m), d = __expf(v.w - m);
    const float inv = 1.f / wave_sum(a + b + c + d);
    ((uint2*)(P + (size_t)row * 256))[lane] = make_uint2(pk2(a * inv, b * inv), pk2(c * inv, d * inv));
  }
}
DI void phase_mem_pv(const Params& p, char* smem) {
  const int vb = vblock(), nb = gridDim.x;
  const u16* P = (const u16*)(p.ws + WS_D);
  u16* om = (u16*)(p.ws + WS_E);
  for (int t = vb; t < 2048 + 128; t += nb) {
    int mt, sb, hd, nt, batch; memattn_decode(t, mt, sb, hd, nt, batch);
    const int m0 = mt * 128;
    LdBf16 al; al.base = P + (size_t)m0 * DM + hd * 256; al.ld = DM;
    const u16* Bt = (const u16*)(p.ws + WS_MEMVT) + ((size_t)batch * DM + hd * 256) * 256;
    auto epi = [=](int r0, int c0, const f32x16& acc) {
      const int lane = threadIdx.x & 63, hh = lane >> 5, col = c0 + (lane & 31);
#pragma unroll
      for (int e = 0; e < 16; ++e) { const int r = ACC_ROW(e, hh) + r0; if (sb < 0 || (((r - m0) >> 6) == sb)) om[(size_t)r * DM + hd * 256 + col] = bf1(acc[e]); }
    };
    gemm_tile(al, Bt, 256, 256, m0, nt * 128, epi, smem);
  }
}
DI void phase_wmo(const Params& p, char* smem) {
  const int vb = vblock(), nb = gridDim.x;
  float* pre = (float*)(p.ws + WS_A);
  const float* xf = (const float*)(p.ws + WS_B);
  const u16* om = (const u16*)(p.ws + WS_E);
  for (int t = vb; t < 264 * 8; t += nb) {
    const int mt = t >> 3, nt = t & 7;
    const int m0 = mt * 128, n0 = nt * 128;
    LdBf16 al; al.base = om + (size_t)m0 * DM; al.ld = DM;
    auto epi = [=](int r0, int c0, const f32x16& acc) {
      const int lane = threadIdx.x & 63, hh = lane >> 5, col = c0 + (lane & 31);
#pragma unroll
      for (int e = 0; e < 16; ++e) { const size_t i = (size_t)(r0 + ACC_ROW(e, hh)) * DM + col; pre[i] = DN_ALPHA * xf[i] + acc[e]; }
    };
    gemm_tile(al, (const u16*)(p.ws + WS_WMO), DM, DM, m0, n0, epi, smem);
  }
}

DI void insert16(float (&v)[16], float x) {
#pragma unroll
  for (int j = 15; j >= 1; --j) v[j] = __builtin_amdgcn_fmed3f(x, v[j - 1], v[j]);
  v[0] = fmaxf(v[0], x);
}
DI void phase_topk(const Params& p, char* smem) {
  const int vb = vblock(), nb = gridDim.x;
  const u16* qp = (const u16*)(p.ws + WS_F);
  int* idxo = (int*)(p.ws + WS_A);
  float* gato = (float*)(p.ws + WS_A + (size_t)NT * 128 * 4);
  float* sc = (float*)smem;
  const int tid = threadIdx.x;
  for (int t = vb; t < 264 * 8; t += nb) {
    const int mt = t >> 3, hd = t & 7;
    const int m0 = mt * 128;
    float va[16], vbv[16];
#pragma unroll
    for (int side = 0; side < 2; ++side) {
      LdBf16 al; al.base = qp + (size_t)m0 * 2048 + hd * 256 + side * 128; al.ld = 2048;
      const u16* Bt = (const u16*)(p.ws + (side ? WS_KB : WS_KA)) + (size_t)hd * 128 * 128;
      auto epi = [=](int r0, int c0, const f32x16& acc) {
        const int lane = threadIdx.x & 63, hh = lane >> 5, col = c0 + (lane & 31);
#pragma unroll
        for (int e = 0; e < 16; ++e) sc[(r0 - m0 + ACC_ROW(e, hh)) * 129 + col] = acc[e];
      };
      gemm_tile(al, Bt, 128, 128, m0, 0, epi, smem);
      __syncthreads();
      if (tid < 128) {
        float v[16];
#pragma unroll
        for (int j = 0; j < 16; ++j) v[j] = -INFINITY;
        for (int k = 0; k < 128; ++k) {
          const float x = __uint_as_float((__float_as_uint(sc[tid * 129 + k]) & ~0x7Fu) | (unsigned)k);
          insert16(v, x);
        }
#pragma unroll
        for (int j = 0; j < 16; ++j) { if (side == 0) va[j] = v[j]; else vbv[j] = v[j]; }
      }
      __syncthreads();
    }
    unsigned char* ids = (unsigned char*)smem;
    if (tid < 128) {
#pragma unroll
      for (int j = 0; j < 16; ++j) { ids[tid * 32 + j] = (unsigned char)(__float_as_uint(va[j]) & 0x7F); ids[tid * 32 + 16 + j] = (unsigned char)(__float_as_uint(vbv[j]) & 0x7F); }
      float top[16];
#pragma unroll
      for (int j = 0; j < 16; ++j) top[j] = -INFINITY;
#pragma unroll
      for (int i = 0; i < 16; ++i)
#pragma unroll
        for (int j = 0; j < 16; ++j)
          if ((i + 1) * (j + 1) <= 16) {
            const float a = __uint_as_float(__float_as_uint(va[i]) & ~0x7Fu), b = __uint_as_float(__float_as_uint(vbv[j]) & ~0x7Fu);
            const float c = __uint_as_float((__float_as_uint(a + b) & ~0xFFu) | (unsigned)(i * 16 + j));
            insert16(top, c);
          }
      const float m = __uint_as_float(__float_as_uint(top[0]) & ~0xFFu);
      float ex[16], ssum = 0.f;
      int eid[16];
#pragma unroll
      for (int j = 0; j < 16; ++j) {
        const unsigned bits = __float_as_uint(top[j]);
        const int code = bits & 0xFF;
        ex[j] = __expf(__uint_as_float(bits & ~0xFFu) - m); ssum += ex[j];
        eid[j] = (int)ids[tid * 32 + (code >> 4)] * 128 + (int)ids[tid * 32 + 16 + (code & 15)];
      }
      const float inv = 1.f / ssum;
      const size_t ob = (size_t)(m0 + tid) * 128 + hd * 16;
#pragma unroll
      for (int j4 = 0; j4 < 4; ++j4) {
        *(int4*)(idxo + ob + 4 * j4) = make_int4(eid[4 * j4], eid[4 * j4 + 1], eid[4 * j4 + 2], eid[4 * j4 + 3]);
        *(float4*)(gato + ob + 4 * j4) = make_float4(ex[4 * j4] * inv, ex[4 * j4 + 1] * inv, ex[4 * j4 + 2] * inv, ex[4 * j4 + 3] * inv);
      }
    }
    __syncthreads();
  }
}

#if USE_FP8
typedef float f32x2v __attribute__((ext_vector_type(2)));
DI void unpack16(const uint4& v, float (&f)[16]) {
  const unsigned w[4] = {v.x, v.y, v.z, v.w};
#pragma unroll
  for (int j = 0; j < 4; ++j) {
    const f32x2v lo = __builtin_amdgcn_cvt_pk_f32_fp8((int)w[j], false), hi = __builtin_amdgcn_cvt_pk_f32_fp8((int)w[j], true);
    f[4 * j] = lo[0]; f[4 * j + 1] = lo[1]; f[4 * j + 2] = hi[0]; f[4 * j + 3] = hi[1];
  }
}
DI void phase_peer(const Params& p) {
  const float* xf = (const float*)(p.ws + WS_B);
  const int* idxo = (const int*)(p.ws + WS_A);
  const float* gato = (const float*)(p.ws + WS_A + (size_t)NT * 128 * 4);
  const char* U = p.ws + WS_U;
  const char* V = p.ws + WS_V;
  const float* usc = (const float*)(p.ws + WS_USC);
  const float* vsc = (const float*)(p.ws + WS_VSC);
  const int lane = threadIdx.x & 63;
  const int wg = blockIdx.x * 4 + (threadIdx.x >> 6), nw = gridDim.x * 4;
  for (int row = wg; row < NT; row += nw) {
    float x[16];
    {
      const float4* xr = (const float4*)(xf + (size_t)row * DM) + 4 * lane;
#pragma unroll
      for (int j = 0; j < 4; ++j) { const float4 a = xr[j]; x[4 * j] = a.x; x[4 * j + 1] = a.y; x[4 * j + 2] = a.z; x[4 * j + 3] = a.w; }
    }
    const int id0 = idxo[(size_t)row * 128 + lane], id1 = idxo[(size_t)row * 128 + 64 + lane];
    const float g0 = gato[(size_t)row * 128 + lane], g1 = gato[(size_t)row * 128 + 64 + lane];
    const float su0 = usc[id0], su1 = usc[id1], sv0 = vsc[id0], sv1 = vsc[id1];
    float d0 = 0.f, d1 = 0.f;
#pragma unroll 8
    for (int e = 0; e < 64; ++e) {
      const int id = __builtin_amdgcn_readlane(id0, e);
      const uint4 w = *(const uint4*)(U + (size_t)id * DM + 16 * lane);
      float f[16], s = 0.f;
      unpack16(w, f);
#pragma unroll
      for (int k = 0; k < 16; ++k) s += f[k] * x[k];
      s = wave_sum(s);
      if (lane == e) d0 = s;
    }
#pragma unroll 8
    for (int e = 0; e < 64; ++e) {
      const int id = __builtin_amdgcn_readlane(id1, e);
      const uint4 w = *(const uint4*)(U + (size_t)id * DM + 16 * lane);
      float f[16], s = 0.f;
      unpack16(w, f);
#pragma unroll
      for (int k = 0; k < 16; ++k) s += f[k] * x[k];
      s = wave_sum(s);
      if (lane == e) d1 = s;
    }
    d0 *= su0; d1 *= su1;
    const float h0 = 0.5f * d0 * (1.f + erff(d0 * 0.7071067811865476f)) * g0 * sv0;
    const float h1 = 0.5f * d1 * (1.f + erff(d1 * 0.7071067811865476f)) * g1 * sv1;
    float acc[16];
#pragma unroll
    for (int k = 0; k < 16; ++k) acc[k] = 0.f;
#pragma unroll 8
    for (int e = 0; e < 64; ++e) {
      const int id = __builtin_amdgcn_readlane(id0, e);
      const float hs = __uint_as_float(__builtin_amdgcn_readlane(__float_as_uint(h0), e));
      const uint4 w = *(const uint4*)(V + (size_t)id * DM + 16 * lane);
      float f[16];
      unpack16(w, f);
#pragma unroll
      for (int k = 0; k < 16; ++k) acc[k] += hs * f[k];
    }
#pragma unroll 8
    for (int e = 0; e < 64; ++e) {
      const int id = __builtin_amdgcn_readlane(id1, e);
      const float hs = __uint_as_float(__builtin_amdgcn_readlane(__float_as_uint(h1), e));
      const uint4 w = *(const uint4*)(V + (size_t)id * DM + 16 * lane);
      float f[16];
      unpack16(w, f);
#pragma unroll
      for (int k = 0; k < 16; ++k) acc[k] += hs * f[k];
    }
    float s = 0.f;
#pragma unroll
    for (int k = 0; k < 16; ++k) { acc[k] = DN_ALPHA * x[k] + acc[k]; s += acc[k]; }
    const float mu = wave_sum(s) * (1.f / 1024.f);
    float q = 0.f;
#pragma unroll
    for (int k = 0; k < 16; ++k) { const float dd = acc[k] - mu; q += dd * dd; }
    const float rs = rsqrtf(wave_sum(q) * (1.f / 1024.f) + 1e-5f);
    float* y = (row < NTP) ? p.out + OUT_YP + (size_t)row * DM : p.out + OUT_YS + (size_t)(row - NTP) * DM;
#pragma unroll
    for (int j = 0; j < 4; ++j) {
      const float4 ga = ((const float4*)p.ln3_g)[4 * lane + j], ba = ((const float4*)p.ln3_b)[4 * lane + j];
      float4 ya;
      ya.x = (acc[4 * j + 0] - mu) * rs * ga.x + ba.x; ya.y = (acc[4 * j + 1] - mu) * rs * ga.y + ba.y;
      ya.z = (acc[4 * j + 2] - mu) * rs * ga.z + ba.z; ya.w = (acc[4 * j + 3] - mu) * rs * ga.w + ba.w;
      ((float4*)y)[4 * lane + j] = ya;
    }
  }
}
#else
DI void unpack8(const uint4& v, float (&f)[8]) {
  f[0] = bflo(v.x); f[1] = bfhi(v.x); f[2] = bflo(v.y); f[3] = bfhi(v.y); f[4] = bflo(v.z); f[5] = bfhi(v.z); f[6] = bflo(v.w); f[7] = bfhi(v.w);
}
DI void phase_peer(const Params& p) {
  const float* xf = (const float*)(p.ws + WS_B);
  const int* idxo = (const int*)(p.ws + WS_A);
  const float* gato = (const float*)(p.ws + WS_A + (size_t)NT * 128 * 4);
  const u16* U = (const u16*)(p.ws + WS_U);
  const u16* V = (const u16*)(p.ws + WS_V);
  const int lane = threadIdx.x & 63;
  const int wg = blockIdx.x * 4 + (threadIdx.x >> 6), nw = gridDim.x * 4;
  for (int row = wg; row < NT; row += nw) {
    float x[16];
    {
      const float4* xr = (const float4*)(xf + (size_t)row * DM);
      const float4 a = xr[2 * lane], b = xr[2 * lane + 1], c = xr[128 + 2 * lane], d = xr[128 + 2 * lane + 1];
      x[0] = a.x; x[1] = a.y; x[2] = a.z; x[3] = a.w; x[4] = b.x; x[5] = b.y; x[6] = b.z; x[7] = b.w;
      x[8] = c.x; x[9] = c.y; x[10] = c.z; x[11] = c.w; x[12] = d.x; x[13] = d.y; x[14] = d.z; x[15] = d.w;
    }
    const int id0 = idxo[(size_t)row * 128 + lane], id1 = idxo[(size_t)row * 128 + 64 + lane];
    const float g0 = gato[(size_t)row * 128 + lane], g1 = gato[(size_t)row * 128 + 64 + lane];
    float d0 = 0.f, d1 = 0.f;
#pragma unroll 8
    for (int e = 0; e < 64; ++e) {
      const int id = __builtin_amdgcn_readlane(id0, e);
      const uint4* ur = (const uint4*)(U + (size_t)id * DM);
      const uint4 ua = ur[lane], ub = ur[64 + lane];
      float f[8], s = 0.f;
      unpack8(ua, f);
#pragma unroll
      for (int k = 0; k < 8; ++k) s += f[k] * x[k];
      unpack8(ub, f);
#pragma unroll
      for (int k = 0; k < 8; ++k) s += f[k] * x[8 + k];
      s = wave_sum(s);
      if (lane == e) d0 = s;
    }
#pragma unroll 8
    for (int e = 0; e < 64; ++e) {
      const int id = __builtin_amdgcn_readlane(id1, e);
      const uint4* ur = (const uint4*)(U + (size_t)id * DM);
      const uint4 ua = ur[lane], ub = ur[64 + lane];
      float f[8], s = 0.f;
      unpack8(ua, f);
#pragma unroll
      for (int k = 0; k < 8; ++k) s += f[k] * x[k];
      unpack8(ub, f);
#pragma unroll
      for (int k = 0; k < 8; ++k) s += f[k] * x[8 + k];
      s = wave_sum(s);
      if (lane == e) d1 = s;
    }
    const float h0 = 0.5f * d0 * (1.f + erff(d0 * 0.7071067811865476f)) * g0;
    const float h1 = 0.5f * d1 * (1.f + erff(d1 * 0.7071067811865476f)) * g1;
    float acc[16];
#pragma unroll
    for (int k = 0; k < 16; ++k) acc[k] = 0.f;
#pragma unroll 8
    for (int e = 0; e < 64; ++e) {
      const int id = __builtin_amdgcn_readlane(id0, e);
      const float hs = __uint_as_float(__builtin_amdgcn_readlane(__float_as_uint(h0), e));
      const uint4* vr = (const uint4*)(V + (size_t)id * DM);
      const uint4 va = vr[lane], vb2 = vr[64 + lane];
      float f[8];
      unpack8(va, f);
#pragma unroll
      for (int k = 0; k < 8; ++k) acc[k] += hs * f[k];
      unpack8(vb2, f);
#pragma unroll
      for (int k = 0; k < 8; ++k) acc[8 + k] += hs * f[k];
    }
#pragma unroll 8
    for (int e = 0; e < 64; ++e) {
      const int id = __builtin_amdgcn_readlane(id1, e);
      const float hs = __uint_as_float(__builtin_amdgcn_readlane(__float_as_uint(h1), e));
      const uint4* vr = (const uint4*)(V + (size_t)id * DM);
      const uint4 va = vr[lane], vb2 = vr[64 + lane];
      float f[8];
      unpack8(va, f);
#pragma unroll
      for (int k = 0; k < 8; ++k) acc[k] += hs * f[k];
      unpack8(vb2, f);
#pragma unroll
      for (int k = 0; k < 8; ++k) acc[8 + k] += hs * f[k];
    }
    float s = 0.f;
#pragma unroll
    for (int k = 0; k < 16; ++k) { acc[k] = DN_ALPHA * x[k] + acc[k]; s += acc[k]; }
    const float mu = wave_sum(s) * (1.f / 1024.f);
    float q = 0.f;
#pragma unroll
    for (int k = 0; k < 16; ++k) { const float dd = acc[k] - mu; q += dd * dd; }
    const float rs = rsqrtf(wave_sum(q) * (1.f / 1024.f) + 1e-5f);
    float* y = (row < NTP) ? p.out + OUT_YP + (size_t)row * DM : p.out + OUT_YS + (size_t)(row - NTP) * DM;
#pragma unroll
    for (int c = 0; c < 2; ++c) {
      const int off = c * 512 + lane * 8;
      const float4 ga = *(const float4*)(p.ln3_g + off), gb = *(const float4*)(p.ln3_g + off + 4);
      const float4 ba = *(const float4*)(p.ln3_b + off), bb = *(const float4*)(p.ln3_b + off + 4);
      float4 ya, yb;
      ya.x = (acc[8 * c + 0] - mu) * rs * ga.x + ba.x; ya.y = (acc[8 * c + 1] - mu) * rs * ga.y + ba.y;
      ya.z = (acc[8 * c + 2] - mu) * rs * ga.z + ba.z; ya.w = (acc[8 * c + 3] - mu) * rs * ga.w + ba.w;
      yb.x = (acc[8 * c + 4] - mu) * rs * gb.x + bb.x; yb.y = (acc[8 * c + 5] - mu) * rs * gb.y + bb.y;
      yb.z = (acc[8 * c + 6] - mu) * rs * gb.z + bb.z; yb.w = (acc[8 * c + 7] - mu) * rs * gb.w + bb.w;
      *(float4*)(y + off) = ya; *(float4*)(y + off + 4) = yb;
    }
  }
}

#endif

constexpr int NPHASE = 14;
template <int PH>
DI void run_phase(const Params& p, char* smem) {
  if (PH == 0) phase_prep(p, smem);
  else if (PH == 1) phase_proj(p, smem);
  else if (PH == 2) phase_attn(p, smem);
  else if (PH == 3) phase_wout(p, smem);
  else if (PH == 4) phase_ln(p, p.ln1_g, p.ln1_b);
  else if (PH == 5) phase_gemm_bf16(p, (const u16*)(p.ws + WS_C), (const u16*)(p.ws + WS_WMQ), 1024, (u16*)(p.ws + WS_D), 0.0625f, smem);
  else if (PH == 6) phase_mem_s(p, smem);
  else if (PH == 7) phase_mem_softmax(p);
  else if (PH == 8) phase_mem_pv(p, smem);
  else if (PH == 9) phase_wmo(p, smem);
  else if (PH == 10) phase_ln(p, p.ln2_g, p.ln2_b);
  else if (PH == 11) phase_gemm_bf16(p, (const u16*)(p.ws + WS_C), (const u16*)(p.ws + WS_WPQ), 2048, (u16*)(p.ws + WS_F), 1.f, smem);
  else if (PH == 12) phase_topk(p, smem);
  else if (PH == 13) phase_peer(p);
}

template <int PH>
__global__ void __launch_bounds__(256, 2) k_phase(Params p) {
  __shared__ __attribute__((aligned(16))) char smem[SMEM_BYTES];
  run_phase<PH>(p, smem);
}

#if ONE_LAUNCH
DI void grid_barrier(unsigned* bar, unsigned& target) {
  target += gridDim.x;
  asm volatile("s_waitcnt vmcnt(0)" ::: "memory");
  __syncthreads();
  if (threadIdx.x == 0) {
    __builtin_amdgcn_fence(__ATOMIC_RELEASE, "agent");
    asm volatile("s_waitcnt vmcnt(0)" ::: "memory");
    __hip_atomic_fetch_add(bar, 1u, __ATOMIC_RELAXED, __HIP_MEMORY_SCOPE_AGENT);
    while (__hip_atomic_load(bar, __ATOMIC_RELAXED, __HIP_MEMORY_SCOPE_AGENT) < target) __builtin_amdgcn_s_sleep(2);
    __builtin_amdgcn_fence(__ATOMIC_ACQUIRE, "agent");
    asm volatile("s_waitcnt vmcnt(0)" ::: "memory");
  }
  __syncthreads();
}
__global__ void __launch_bounds__(256, 2) k_mega(Params p) {
  __shared__ __attribute__((aligned(16))) char smem[SMEM_BYTES];
  cg::grid_group grid = cg::this_grid();
#if CUSTOM_BAR
  unsigned* bar = (unsigned*)(p.ws + WS_BAR);
  unsigned target = 0;
#define GSYNC() grid_barrier(bar, target)
#else
#define GSYNC() grid.sync()
#endif
  run_phase<0>(p, smem); grid.sync();
  run_phase<1>(p, smem); GSYNC();
  run_phase<2>(p, smem); GSYNC();
  run_phase<3>(p, smem); GSYNC();
  run_phase<4>(p, smem); GSYNC();
  run_phase<5>(p, smem); GSYNC();
  run_phase<6>(p, smem); GSYNC();
  run_phase<7>(p, smem); GSYNC();
  run_phase<8>(p, smem); GSYNC();
  run_phase<9>(p, smem); GSYNC();
  run_phase<10>(p, smem); GSYNC();
  run_phase<11>(p, smem); GSYNC();
  run_phase<12>(p, smem); GSYNC();
  run_phase<13>(p, smem);
}
#endif

extern "C" void kernel_launch(void* const* d_in, const int* in_sizes, int n_in, void* d_out, int out_size, void* d_ws, size_t ws_size,
                              hipStream_t stream) {
  (void)in_sizes; (void)n_in; (void)out_size;
  if (ws_size < WS_TOTAL) { fprintf(stderr, "workspace too small: %zu < %zu\n", ws_size, (size_t)WS_TOTAL); return; }
  Params p{};
  const float** pp = (const float**)&p;
  for (int i = 0; i < 29; ++i) pp[i] = (const float*)d_in[i];
  p.out = (float*)d_out;
  p.ws = (char*)d_ws;
#if ONE_LAUNCH
  static int grid_blocks = 0;
  if (!grid_blocks) {
    int dev = 0, cus = 0, per_cu = 0;
    hipGetDevice(&dev);
    hipDeviceGetAttribute(&cus, hipDeviceAttributeMultiprocessorCount, dev);
    hipOccupancyMaxActiveBlocksPerMultiprocessor(&per_cu, k_mega, 256, 0);
    if (per_cu > 2) per_cu = 2;
    grid_blocks = cus * per_cu;
  }
#if CUSTOM_BAR
  hipMemsetAsync((char*)d_ws + WS_BAR, 0, 256, stream);
#endif
  void* args[] = {&p};
  hipError_t e = hipLaunchCooperativeKernel((void*)k_mega, dim3(grid_blocks), dim3(256), args, 0, stream);
  if (e != hipSuccess) fprintf(stderr, "cooperative launch failed: %s (grid %d)\n", hipGetErrorString(e), grid_blocks);
#else
  const int G = 512;
  k_phase<0><<<G, 256, 0, stream>>>(p);
  k_phase<1><<<G, 256, 0, stream>>>(p);
  k_phase<2><<<G, 256, 0, stream>>>(p);
  k_phase<3><<<G, 256, 0, stream>>>(p);
  k_phase<4><<<G, 256, 0, stream>>>(p);
  k_phase<5><<<G, 256, 0, stream>>>(p);
  k_phase<6><<<G, 256, 0, stream>>>(p);
  k_phase<7><<<G, 256, 0, stream>>>(p);
  k_phase<8><<<G, 256, 0, stream>>>(p);
  k_phase<9><<<G, 256, 0, stream>>>(p);
  k_phase<10><<<G, 256, 0, stream>>>(p);
  k_phase<11><<<G, 256, 0, stream>>>(p);
  k_phase<12><<<G, 256, 0, stream>>>(p);
  k_phase<13><<<G, 256, 0, stream>>>(p);
#endif
}
```

```cpp
#include <hip/hip_runtime.h>
#include <hip/hip_cooperative_groups.h>
#include <cstdio>
#include <cstdint>
namespace cg = cooperative_groups;

#ifndef ONE_LAUNCH
#define ONE_LAUNCH 1
#endif

#ifndef USE_FP8
#define USE_FP8 1
#endif
#ifndef SB_EXIT
#define SB_EXIT 1
#endif
#ifndef REPEAT_PHASE
#define REPEAT_PHASE -1
#endif
#ifndef CUSTOM_BAR
#define CUSTOM_BAR 1
#endif
#define DI __device__ __forceinline__
typedef unsigned short u16;
typedef short bf16x8 __attribute__((ext_vector_type(8)));
typedef short s16x4 __attribute__((ext_vector_type(4)));
typedef float f32x16 __attribute__((ext_vector_type(16)));
typedef __bf16 bf2_t __attribute__((ext_vector_type(2)));
typedef float f2_t __attribute__((ext_vector_type(2)));
#define MFMA(a, b, c) __builtin_amdgcn_mfma_f32_32x32x16_bf16((a), (b), (c), 0, 0, 0)

constexpr int DM = 1024;
constexpr int NTP = 32768;
constexpr int NTS = 1024;
constexpr int NT = NTP + NTS;
constexpr int SEQ = 2048, DSEQ = 64, PAST = 4096, NMEM = 256;
constexpr int INC = 3080, INCP = 3200;
constexpr float DN_ALPHA = 1.189207115002721f;
constexpr float LOG2E = 1.4426950408889634f;

constexpr size_t OUT_YP = 0;
constexpr size_t OUT_YS = OUT_YP + (size_t)NTP * DM;
constexpr size_t OUT_SBK_P = OUT_YS + (size_t)NTS * DM;
constexpr size_t OUT_SBV_P = OUT_SBK_P + (size_t)NTP * 512;
constexpr size_t OUT_FXK_P = OUT_SBV_P + (size_t)NTP * 512;
constexpr size_t OUT_FXV_P = OUT_FXK_P + (size_t)NTP * 512;
constexpr size_t OUT_LF_P = OUT_FXV_P + (size_t)NTP * 512;
constexpr size_t OUT_MK_P = OUT_LF_P + (size_t)NTP * 8;
constexpr size_t OUT_MV_P = OUT_MK_P + (size_t)4096 * DM;
constexpr size_t OUT_SBK_S = OUT_MV_P + (size_t)4096 * DM;
constexpr size_t OUT_SBV_S = OUT_SBK_S + (size_t)NTS * 512;
constexpr size_t OUT_FXK_S = OUT_SBV_S + (size_t)NTS * 512;
constexpr size_t OUT_FXV_S = OUT_FXK_S + (size_t)NTS * 512;
constexpr size_t OUT_LF_S = OUT_FXV_S + (size_t)NTS * 512;
constexpr size_t OUT_TOTAL = OUT_LF_S + (size_t)NTS * 8;

constexpr size_t WS_WIN = 0;
constexpr size_t WS_WOUT = WS_WIN + (size_t)INCP * DM * 2;
constexpr size_t WS_WMQ = WS_WOUT + (size_t)DM * DM * 2;
constexpr size_t WS_WMKV = WS_WMQ + (size_t)DM * DM * 2;
constexpr size_t WS_WMO = WS_WMKV + (size_t)2048 * DM * 2;
constexpr size_t WS_WPQ = WS_WMO + (size_t)DM * DM * 2;
constexpr size_t WS_KA = WS_WPQ + (size_t)2048 * DM * 2;
constexpr size_t WS_KB = WS_KA + (size_t)8 * 128 * 128 * 2;
constexpr size_t WS_U = WS_KB + (size_t)8 * 128 * 128 * 2;
constexpr size_t WS_V = WS_U + (size_t)16384 * DM * 2;
constexpr size_t WS_MEMK = WS_V + (size_t)16384 * DM * 2;
constexpr size_t WS_MEMVT = WS_MEMK + (size_t)32 * 256 * DM * 2;
constexpr size_t WS_A = WS_MEMVT + (size_t)32 * 256 * DM * 2;
constexpr size_t WS_B = WS_A + (size_t)NT * DM * 4;
constexpr size_t WS_C = WS_B + (size_t)NT * DM * 4;
constexpr size_t WS_D = WS_C + (size_t)NT * DM * 2;
constexpr size_t WS_E = WS_D + (size_t)NT * DM * 2;
constexpr size_t WS_F = WS_E + (size_t)NT * DM * 2;
constexpr size_t WS_BAR = WS_F + (size_t)NT * DM * 4;
constexpr size_t WS_USC = WS_BAR + 256;
constexpr size_t WS_VSC = WS_USC + (size_t)16384 * 4;
constexpr size_t WS_CBP = WS_VSC + (size_t)16384 * 4;
constexpr size_t WS_CBS = WS_CBP + (size_t)128 * 2048 * 4;
constexpr size_t WS_SSQ = WS_CBS + (size_t)128 * 4160 * 4;
constexpr size_t WS_TOTAL = WS_SSQ + (size_t)NT * 2 * 4;

struct Params {
  const float *x_prompt, *x_sample, *mem_prompt, *c_sb_k, *c_sb_v, *c_fx_k, *c_fx_v, *c_fx_logf, *c_mem_k, *c_mem_v;
  const float *w_in, *b_f, *w_gn, *w_out, *ln1_g, *ln1_b, *w_mq, *w_mk, *w_mv, *w_mo, *ln2_g, *ln2_b;
  const float *w_pq, *keys_a, *keys_b, *peer_u, *peer_v, *ln3_g, *ln3_b;
  float* out;
  char* ws;
};

constexpr int SMEM_BYTES = 73728 + 1024;

DI unsigned pk2(float a, float b) { f2_t v = {a, b}; bf2_t r = __builtin_convertvector(v, bf2_t); return __builtin_bit_cast(unsigned, r); }
DI u16 bf1(float a) { return (u16)(pk2(a, 0.f) & 0xffffu); }
DI float bflo(unsigned w) { return __uint_as_float(w << 16); }
DI float bfhi(unsigned w) { return __uint_as_float(w & 0xffff0000u); }
DI float wave_sum(float v) {
#pragma unroll
  for (int o = 32; o >= 1; o >>= 1) v += __shfl_xor(v, o);
  return v;
}
DI float wave_max(float v) {
#pragma unroll
  for (int o = 32; o >= 1; o >>= 1) v = fmaxf(v, __shfl_xor(v, o));
  return v;
}
DI int vblock() { int nb = gridDim.x, b = blockIdx.x; return ((nb & 7) == 0) ? (b & 7) * (nb >> 3) + (b >> 3) : b; }
DI const float* xrow(const Params& p, int g) { return g < NTP ? p.x_prompt + (size_t)g * DM : p.x_sample + (size_t)(g - NTP) * DM; }

DI void tconv_tile(const float* src, int ldsrc, int C, u16* dst, int lddst, const float* rowscale, int tr, int tc, float* tile) {
  const int tid = threadIdx.x;
  {
    const int r = tid >> 2, c0 = (tid & 3) * 16;
    const int gr = tr * 64 + r;
    const float sc = rowscale ? rowscale[gr] : 1.f;
#pragma unroll
    for (int j = 0; j < 4; ++j) {
      const int gc = tc * 64 + c0 + 4 * j;
      float4 v = make_float4(0.f, 0.f, 0.f, 0.f);
      if (gc < C) v = *(const float4*)(src + (size_t)gr * ldsrc + gc);
      float* t = tile + r * 65 + c0 + 4 * j;
      t[0] = v.x * sc; t[1] = v.y * sc; t[2] = v.z * sc; t[3] = v.w * sc;
    }
  }
  __syncthreads();
  {
    const int n = tid >> 2, k0 = (tid & 3) * 16;
    unsigned w[8];
#pragma unroll
    for (int e = 0; e < 8; ++e) w[e] = pk2(tile[(k0 + 2 * e) * 65 + n], tile[(k0 + 2 * e + 1) * 65 + n]);
    uint4* d = (uint4*)(dst + (size_t)(tc * 64 + n) * lddst + tr * 64 + k0);
    d[0] = make_uint4(w[0], w[1], w[2], w[3]);
    d[1] = make_uint4(w[4], w[5], w[6], w[7]);
  }
  __syncthreads();
}

DI void conv_range(const float* src, u16* dst, size_t n8, int bid, int nb) {
  for (size_t i = (size_t)bid * 256 + threadIdx.x; i < n8; i += (size_t)nb * 256) {
    const float4 a = ((const float4*)src)[2 * i], b = ((const float4*)src)[2 * i + 1];
    ((uint4*)dst)[i] = make_uint4(pk2(a.x, a.y), pk2(a.z, a.w), pk2(b.x, b.y), pk2(b.z, b.w));
  }
}

DI void phase_prep(const Params& p, char* smem) {
  float* tile = (float*)smem;
  const int bid = blockIdx.x, nb = gridDim.x;
  u16* ws16 = (u16*)p.ws;
  constexpr int T_WIN = 16 * 50, T_SQ = 256, T_PQ = 16 * 32, T_MV = 16 * 4 * 16;
  constexpr int T0 = T_WIN, T1 = T0 + T_SQ, T2 = T1 + T_SQ, T3 = T2 + T_SQ, T4 = T3 + T_SQ, T5 = T4 + T_SQ, T6 = T5 + T_PQ, T7 = T6 + T_MV;
  for (int t = bid; t < T7; t += nb) {
    if (t < T0) { tconv_tile(p.w_in, INC, INC, (u16*)(p.ws + WS_WIN), DM, nullptr, t / 50, t % 50, tile); }
    else if (t < T1) { int u = t - T0; tconv_tile(p.w_out, DM, DM, (u16*)(p.ws + WS_WOUT), DM, p.w_gn, u >> 4, u & 15, tile); }
    else if (t < T2) { int u = t - T1; tconv_tile(p.w_mq, DM, DM, (u16*)(p.ws + WS_WMQ), DM, nullptr, u >> 4, u & 15, tile); }
    else if (t < T3) { int u = t - T2; tconv_tile(p.w_mk, DM, DM, (u16*)(p.ws + WS_WMKV), DM, nullptr, u >> 4, u & 15, tile); }
    else if (t < T4) { int u = t - T3; tconv_tile(p.w_mv, DM, DM, (u16*)(p.ws + WS_WMKV) + (size_t)DM * DM, DM, nullptr, u >> 4, u & 15, tile); }
    else if (t < T5) { int u = t - T4; tconv_tile(p.w_mo, DM, DM, (u16*)(p.ws + WS_WMO), DM, nullptr, u >> 4, u & 15, tile); }
    else if (t < T6) { int u = t - T5; tconv_tile(p.w_pq, 2048, 2048, (u16*)(p.ws + WS_WPQ), DM, nullptr, u >> 5, u & 31, tile); }
    else { int u = t - T6; int b = u >> 6, r = u & 63;
      tconv_tile(p.c_mem_v + (size_t)b * 256 * DM, DM, DM, (u16*)(p.ws + WS_MEMVT) + (size_t)(16 + b) * DM * 256, 256, nullptr, r >> 4, r & 15, tile); }
  }
  (void)ws16;
  for (int i = bid * 256 + threadIdx.x; i < NT * 2; i += nb * 256) ((float*)(p.ws + WS_SSQ))[i] = 0.f;
  conv_range(p.x_prompt, (u16*)(p.ws + WS_C), (size_t)NTP * DM / 8, bid, nb);
  conv_range(p.x_sample, (u16*)(p.ws + WS_C) + (size_t)NTP * DM, (size_t)NTS * DM / 8, bid, nb);
  conv_range(p.mem_prompt, (u16*)(p.ws + WS_E), (size_t)4096 * DM / 8, bid, nb);
  conv_range(p.c_mem_k, (u16*)(p.ws + WS_MEMK) + (size_t)16 * 256 * DM, (size_t)16 * 256 * DM / 8, bid, nb);
  conv_range(p.keys_a, (u16*)(p.ws + WS_KA), (size_t)8 * 128 * 128 / 8, bid, nb);
  conv_range(p.keys_b, (u16*)(p.ws + WS_KB), (size_t)8 * 128 * 128 / 8, bid, nb);
#if USE_FP8
  {
    const int lane = threadIdx.x & 63;
    const int wg = bid * 4 + (threadIdx.x >> 6), nw = nb * 4;
    for (int row = wg; row < 32768; row += nw) {
      const bool isv = row >= 16384;
      const int r = isv ? row - 16384 : row;
      const float4* src = (const float4*)((isv ? p.peer_v : p.peer_u) + (size_t)r * DM) + 4 * lane;
      float4 a[4];
      float am = 0.f;
#pragma unroll
      for (int j = 0; j < 4; ++j) { a[j] = src[j]; am = fmaxf(am, fmaxf(fmaxf(fabsf(a[j].x), fabsf(a[j].y)), fmaxf(fabsf(a[j].z), fabsf(a[j].w)))); }
      am = wave_max(am);
      int ex = 0;
      if (am > 0.f) (void)frexpf(am, &ex);
      const float sc = ldexpf(1.f, 8 - ex), isc = ldexpf(1.f, ex - 8);
      unsigned w[4];
#pragma unroll
      for (int j = 0; j < 4; ++j) {
        int t = __builtin_amdgcn_cvt_pk_fp8_f32(a[j].x * sc, a[j].y * sc, 0, false);
        t = __builtin_amdgcn_cvt_pk_fp8_f32(a[j].z * sc, a[j].w * sc, t, true);
        w[j] = (unsigned)t;
      }
      *(uint4*)(p.ws + (isv ? WS_V : WS_U) + (size_t)r * DM + 16 * lane) = make_uint4(w[0], w[1], w[2], w[3]);
      if (lane == 0) ((float*)(p.ws + (isv ? WS_VSC : WS_USC)))[r] = isc;
    }
  }
#else
  conv_range(p.peer_u, (u16*)(p.ws + WS_U), (size_t)16384 * DM / 8, bid, nb);
  conv_range(p.peer_v, (u16*)(p.ws + WS_V), (size_t)16384 * DM / 8, bid, nb);
#endif
}

#define ACC_ROW(e, hh) (((e) & 3) + 8 * ((e) >> 2) + 4 * (hh))
#define ACC_R0(e) (((e) & 3) + 8 * ((e) >> 2))
template <int V> struct IC { static constexpr int value = V; };
struct SmemGemm { u16 a[2][128 * 64]; u16 b[2][128 * 64]; };

template <int ROWS>
struct GldsBf16 {
  const u16* base; int ld;
  DI void issue(int kt, u16* lds, int tid) {
    const int wid = tid >> 6, lane = tid & 63;
    constexpr int NCH = ROWS / 32;
#pragma unroll
    for (int q = 0; q < NCH; ++q) {
      const int ch = wid * NCH + q;
      const int r = ch * 8 + (lane >> 3);
      const int c = (lane & 7) ^ ((r >> 1) & 7);
      __builtin_amdgcn_global_load_lds((const unsigned*)(base + (size_t)r * ld + kt * 64 + c * 8), (unsigned*)(lds + ch * 512), 16, 0, 0);
    }
  }
  DI void commit(u16*, int) {}
};
template <int MI, bool GRMS = false, class AL, class EPI>
DI void gemm_tile(AL& al, const u16* Bt, int ldb, int K, int m0, int n0, EPI epi, char* smem, const float* rsc = nullptr) {
  SmemGemm& sm = *(SmemGemm*)smem;
  const int tid = threadIdx.x, lane = tid & 63, wid = tid >> 6, wr = wid >> 1, wc = wid & 1, r31 = lane & 31, hh = lane >> 5;
  GldsBf16<MI * 64> bl; bl.base = Bt + (size_t)n0 * ldb; bl.ld = ldb;
  f32x16 acc[MI][MI];
#pragma unroll
  for (int i = 0; i < MI; ++i)
#pragma unroll
    for (int j = 0; j < MI; ++j)
#pragma unroll
      for (int e = 0; e < 16; ++e) acc[i][j][e] = 0.f;
  int off[4];
#pragma unroll
  for (int kk = 0; kk < 4; ++kk) off[kk] = r31 * 64 + (((kk * 2 + hh) ^ ((r31 >> 1) & 7)) * 8);
  const int KT = K >> 6;
  al.issue(0, sm.a[0], tid); bl.issue(0, sm.b[0], tid);
  al.commit(sm.a[0], tid);
  asm volatile("s_waitcnt vmcnt(0)" ::: "memory");
  __syncthreads();
  for (int kt = 0; kt < KT; ++kt) {
    const int cur = kt & 1;
    if (kt + 1 < KT) { al.issue(kt + 1, sm.a[cur ^ 1], tid); bl.issue(kt + 1, sm.b[cur ^ 1], tid); }
    const u16* pa = sm.a[cur] + (wr * MI * 32) * 64;
    const u16* pb = sm.b[cur] + (wc * MI * 32) * 64;
    if (GRMS && kt == (KT >> 1)) {
#pragma unroll
      for (int i = 0; i < MI; ++i)
#pragma unroll
        for (int e = 0; e < 16; ++e) {
          const float rt = rsc[((wr * MI + i) * 32 + ACC_ROW(e, hh)) * 2];
#pragma unroll
          for (int j = 0; j < MI; ++j) acc[i][j][e] *= rt;
        }
    }
#pragma unroll
    for (int kk = 0; kk < 4; ++kk) {
      bf16x8 af[MI], bfr[MI];
#pragma unroll
      for (int i = 0; i < MI; ++i) { af[i] = *(const bf16x8*)(pa + i * 32 * 64 + off[kk]); bfr[i] = *(const bf16x8*)(pb + i * 32 * 64 + off[kk]); }
#pragma unroll
      for (int i = 0; i < MI; ++i)
#pragma unroll
        for (int j = 0; j < MI; ++j) acc[i][j] = MFMA(af[i], bfr[j], acc[i][j]);
    }
    if (kt + 1 < KT) al.commit(sm.a[cur ^ 1], tid);
    asm volatile("s_waitcnt vmcnt(0)" ::: "memory");
    __syncthreads();
  }
  if (GRMS) {
#pragma unroll
    for (int i = 0; i < MI; ++i)
#pragma unroll
      for (int e = 0; e < 16; ++e) {
        const float s1 = rsc[((wr * MI + i) * 32 + ACC_ROW(e, hh)) * 2 + 1];
#pragma unroll
        for (int j = 0; j < MI; ++j) acc[i][j][e] *= s1;
      }
  }
#pragma unroll
  for (int i = 0; i < MI; ++i)
#pragma unroll
    for (int j = 0; j < MI; ++j) epi(m0 + (wr * MI + i) * 32, n0 + (wc * MI + j) * 32, acc[i][j]);
}
template <class F>
DI void for_tiles(int N, F body) {
  const int vb = vblock(), nb = gridDim.x;
  const int ntn = N >> 7, ntn2 = N >> 6;
  const int nbig = 256 * ntn, nsmall = 16 * ntn2;
  for (int t = vb; t < nbig + nsmall; t += nb) {
    if (t < nbig) { body((t / ntn) * 128, (t % ntn) * 128, IC<2>{}); }
    else { const int u = t - nbig; body(NTP + (u / ntn2) * 64, (u % ntn2) * 64, IC<1>{}); }
  }
}

DI void phase_proj(const Params& p, char* smem) {
  const int vb = vblock(), nb = gridDim.x;
  constexpr int T_G1 = 264 * 25, T_MKV = 32 * 16;
  float* out = p.out;
  for (int t = vb; t < T_G1 + T_MKV; t += nb) {
    if (t < T_G1) {
      const int mt = t / 25, nt = t % 25;
      const int m0 = mt * 128, n0 = nt * 128;
      GldsBf16<128> al; al.base = (const u16*)(p.ws + WS_C) + (size_t)m0 * DM; al.ld = DM;
      const bool smp = m0 >= NTP;
      const float* b_f = p.b_f;
      u16* qsb = (u16*)(p.ws + WS_D);
      u16* qfx = qsb + (size_t)NT * 512;
      auto epi = [=](int r0, int c0, const f32x16& acc) {
        const int lane = threadIdx.x & 63, hh = lane >> 5, col = c0 + (lane & 31);
        const int seg = c0 >> 9, cc = col & 511;
        if (seg == 0 || seg == 3) {
          u16* q = (seg == 0) ? qsb : qfx;
#pragma unroll
          for (int e = 0; e < 16; ++e) q[(unsigned)(r0 + 4 * hh) * 512u + cc + ACC_R0(e) * 512u] = bf1(acc[e] * 0.125f);
        } else if (seg < 6) {
          size_t ob;
          if (!smp) ob = (seg == 1) ? OUT_SBK_P : (seg == 2) ? OUT_SBV_P : (seg == 4) ? OUT_FXK_P : OUT_FXV_P;
          else ob = (seg == 1) ? OUT_SBK_S : (seg == 2) ? OUT_SBV_S : (seg == 4) ? OUT_FXK_S : OUT_FXV_S;
          const int rb = smp ? r0 - NTP : r0;
          float* ov = out + ob;
          const unsigned b0 = (unsigned)(rb + 4 * hh) * 512u + cc;
#pragma unroll
          for (int e = 0; e < 16; ++e) ov[b0 + ACC_R0(e) * 512u] = acc[e];
        } else {
          const int c = col - 3072;
          if (c < 8) {
            const float bf = b_f[c];
            const size_t ob = smp ? OUT_LF_S : OUT_LF_P;
            const int rb = smp ? r0 - NTP : r0;
#pragma unroll
            for (int e = 0; e < 16; ++e) {
              const float z = acc[e] + bf;
              const float ls = fminf(z, 0.f) - log1pf(__expf(-fabsf(z)));
              out[ob + (unsigned)(rb + ACC_ROW(e, hh)) * 8u + c] = ls;
            }
          }
        }
      };
      gemm_tile<2>(al, (const u16*)(p.ws + WS_WIN), DM, DM, m0, n0, epi, smem);
    } else {
      const int u = t - T_G1;
      const int mt = u >> 4, nt = u & 15;
      const int m0 = mt * 128, n0 = nt * 128;
      GldsBf16<128> al; al.base = (const u16*)(p.ws + WS_E) + (size_t)m0 * DM; al.ld = DM;
      u16* kb = (u16*)(p.ws + WS_MEMK);
      u16* vt = (u16*)(p.ws + WS_MEMVT);
      auto epi = [=](int r0, int c0, const f32x16& acc) {
        const int lane = threadIdx.x & 63, hh = lane >> 5, col = c0 + (lane & 31);
        if (c0 < 1024) {
          float* ov = out + OUT_MK_P;
          const unsigned b0 = (unsigned)(r0 + 4 * hh) * 1024u + col;
#pragma unroll
          for (int e = 0; e < 16; ++e) { const unsigned idx = b0 + ACC_R0(e) * 1024u; ov[idx] = acc[e]; kb[idx] = bf1(acc[e]); }
        } else {
          const int c = col - 1024;
          float* ov = out + OUT_MV_P;
          const unsigned b0 = (unsigned)(r0 + 4 * hh) * 1024u + c;
#pragma unroll
          for (int e = 0; e < 16; ++e) ov[b0 + ACC_R0(e) * 1024u] = acc[e];
          const int b = r0 >> 8;
#pragma unroll
          for (int g4 = 0; g4 < 4; ++g4) {
            const int m = (r0 & 255) + 8 * g4 + 4 * hh;
            *(uint2*)(vt + ((size_t)b * DM + c) * 256 + m) = make_uint2(pk2(acc[4 * g4], acc[4 * g4 + 1]), pk2(acc[4 * g4 + 2], acc[4 * g4 + 3]));
          }
        }
      };
      gemm_tile<2>(al, (const u16*)(p.ws + WS_WMKV), DM, DM, m0, n0, epi, smem);
    }
  }
}

template <int PER>
DI void scan_one(const float* src0, int n0, const float* src1, int n, float* dst, float* part) {
  const int tid = threadIdx.x;
  const int s0 = tid * PER;
  float v[PER];
#pragma unroll
  for (int i = 0; i < PER; ++i) { const int s = s0 + i; v[i] = (s < n) ? ((s < n0) ? src0[(size_t)s * 8] : src1[(size_t)(s - n0) * 8]) : 0.f; }
  float loc = 0.f;
#pragma unroll
  for (int i = 0; i < PER; ++i) loc += v[i];
  part[tid] = loc;
  __syncthreads();
  float run = 0.f;
  for (int i = 0; i < tid; ++i) run += part[i];
#pragma unroll
  for (int i = 0; i < PER; ++i) { run += v[i]; if (s0 + i < n) dst[s0 + i] = -run * LOG2E; }
  __syncthreads();
}
DI void phase_scan(const Params& p, char* smem) {
  float* part = (float*)smem;
  for (int it = blockIdx.x; it < 256; it += gridDim.x) {
    const int bh = it & 127, b = bh >> 3, h = bh & 7;
    if (it < 128) scan_one<17>(p.c_fx_logf + (size_t)b * PAST * 8 + h, PAST, p.out + OUT_LF_S + (size_t)b * DSEQ * 8 + h, PAST + DSEQ, (float*)(p.ws + WS_CBS) + (size_t)bh * 4160, part);
    else scan_one<8>(p.out + OUT_LF_P + (size_t)b * SEQ * 8 + h, SEQ, nullptr, SEQ, (float*)(p.ws + WS_CBP) + (size_t)bh * 2048, part);
  }
}

constexpr int KLD = 72, VLD = 68;
struct SmemAttn { u16 k[2][64 * KLD]; u16 vt[2][64 * VLD]; float cb[4160]; float part[256]; };
static_assert(sizeof(SmemAttn) <= SMEM_BYTES, "attn smem");

struct KVRegs { float4 k[4], v[4]; };
DI void kv_fetch(KVRegs& r, const float* kb, const float* vb, int tid) {
#pragma unroll
  for (int i = 0; i < 4; ++i) { const int c = tid + 256 * i; const size_t o = (size_t)(c >> 4) * 512 + (c & 15) * 4; r.k[i] = *(const float4*)(kb + o); r.v[i] = *(const float4*)(vb + o); }
}
DI void kv_stash(const KVRegs& r, u16* ks, u16* vts, int tid) {
#pragma unroll
  for (int i = 0; i < 4; ++i) {
    const int c = tid + 256 * i; const int row = c >> 4, c4 = (c & 15) * 4;
    *(uint2*)(ks + row * KLD + c4) = make_uint2(pk2(r.k[i].x, r.k[i].y), pk2(r.k[i].z, r.k[i].w));
    vts[(c4 + 0) * VLD + row] = bf1(r.v[i].x); vts[(c4 + 1) * VLD + row] = bf1(r.v[i].y);
    vts[(c4 + 2) * VLD + row] = bf1(r.v[i].z); vts[(c4 + 3) * VLD + row] = bf1(r.v[i].w);
  }
}
DI bf16x8 pack8(const f32x16& x, int s) {
  union { unsigned u[4]; bf16x8 v; } t;
  t.u[0] = pk2(x[8 * s + 0], x[8 * s + 1]); t.u[1] = pk2(x[8 * s + 2], x[8 * s + 3]);
  t.u[2] = pk2(x[8 * s + 4], x[8 * s + 5]); t.u[3] = pk2(x[8 * s + 6], x[8 * s + 7]);
  return t.v;
}

template <bool FOX>
DI void attn_item(const Params& p, int smp, int b, int h, int qb, char* smem) {
  SmemAttn& sm = *(SmemAttn*)smem;
  const int tid = threadIdx.x, lane = tid & 63, wid = tid >> 6, r31 = lane & 31, hh = lane >> 5;
  const int nkt = smp ? 65 : 2 * qb + 2;
  const int jdiag = smp ? 64 : 2 * qb;
  int qi = wid * 32 + r31; if (smp) qi &= 63;
  const int qpos = (smp ? PAST : qb * 128) + qi;
  const int g = smp ? NTP + b * DSEQ + qi : b * SEQ + qb * 128 + qi;
  const u16* Q = (const u16*)(p.ws + WS_D) + (FOX ? (size_t)NT * 512 : 0);
  bf16x8 qf[4];
#pragma unroll
  for (int kk = 0; kk < 4; ++kk) qf[kk] = *(const bf16x8*)(Q + (size_t)g * 512 + h * 64 + kk * 16 + hh * 8);

  const float* kcache = FOX ? p.c_fx_k : p.c_sb_k;
  const float* vcache = FOX ? p.c_fx_v : p.c_sb_v;
  const size_t okp = FOX ? OUT_FXK_P : OUT_SBK_P, ovp = FOX ? OUT_FXV_P : OUT_SBV_P;
  const size_t oks = FOX ? OUT_FXK_S : OUT_SBK_S, ovs = FOX ? OUT_FXV_S : OUT_SBV_S;
  auto kptr = [&](int j) -> const float* {
    if (!smp) return p.out + okp + ((size_t)(b * SEQ + 64 * j) * 512 + h * 64);
    if (j < 64) return kcache + ((size_t)(b * PAST + 64 * j) * 512 + h * 64);
    return p.out + oks + ((size_t)(b * DSEQ) * 512 + h * 64);
  };
  auto vptr = [&](int j) -> const float* {
    if (!smp) return p.out + ovp + ((size_t)(b * SEQ + 64 * j) * 512 + h * 64);
    if (j < 64) return vcache + ((size_t)(b * PAST + 64 * j) * 512 + h * 64);
    return p.out + ovs + ((size_t)(b * DSEQ) * 512 + h * 64);
  };

  if (FOX) {
    const float4* src = (const float4*)(smp ? (const float*)(p.ws + WS_CBS) + (size_t)(b * 8 + h) * 4160 : (const float*)(p.ws + WS_CBP) + (size_t)(b * 8 + h) * 2048);
    for (int i = tid; i < nkt * 16; i += 256) ((float4*)sm.cb)[i] = src[i];
    __syncthreads();
  }

  bf16x8 tri[2];
  if (!FOX) {
#pragma unroll
    for (int s = 0; s < 2; ++s)
#pragma unroll
      for (int j = 0; j < 8; ++j) { const int kin = 16 * s + 8 * (j >> 2) + 4 * hh + (j & 3); tri[s][j] = (kin >= r31) ? (short)0x3F80 : (short)0; }
  }

  f32x16 o[2];
#pragma unroll
  for (int d = 0; d < 2; ++d)
#pragma unroll
    for (int e = 0; e < 16; ++e) o[d][e] = 0.f;
  float mrun = -1e30f, lrun = 0.f, R = 0.f;

  KVRegs kv;
  const int jfirst = FOX ? 0 : nkt - 1;
  kv_fetch(kv, kptr(jfirst), vptr(jfirst), tid);
  kv_stash(kv, sm.k[0], sm.vt[0], tid);
  __syncthreads();
  for (int it = 0; it < nkt; ++it) {
    const int j = FOX ? it : nkt - 1 - it;
    const int cur = it & 1;
    if (it + 1 < nkt) { const int jn = FOX ? j + 1 : j - 1; kv_fetch(kv, kptr(jn), vptr(jn), tid); }
    f32x16 s[2];
#pragma unroll
    for (int t2 = 0; t2 < 2; ++t2) {
#pragma unroll
      for (int e = 0; e < 16; ++e) s[t2][e] = 0.f;
      const u16* pk = sm.k[cur] + (t2 * 32 + r31) * KLD + hh * 8;
#pragma unroll
      for (int kk = 0; kk < 4; ++kk) { const bf16x8 a = *(const bf16x8*)(pk + kk * 16); s[t2] = MFMA(a, qf[kk], s[t2]); }
    }
    const bool diag = j >= jdiag;
    const int kbase = 64 * j + 4 * hh;
    if (FOX) {
      float mloc = -1e30f;
#pragma unroll
      for (int t2 = 0; t2 < 2; ++t2)
#pragma unroll
        for (int g4 = 0; g4 < 4; ++g4) {
          const float4 bb = *(const float4*)(sm.cb + 64 * j + 32 * t2 + 8 * g4 + 4 * hh);
          const float bv[4] = {bb.x, bb.y, bb.z, bb.w};
#pragma unroll
          for (int e = 0; e < 4; ++e) {
            float x = s[t2][4 * g4 + e] * LOG2E + bv[e];
            if (diag && (kbase + 32 * t2 + 8 * g4 + e > qpos)) x = -1e30f;
            s[t2][4 * g4 + e] = x;
            mloc = fmaxf(mloc, x);
          }
        }
      mloc = fmaxf(mloc, __shfl_xor(mloc, 32));
      const float mnew = fmaxf(mrun, mloc);
      const float alpha = exp2f(mrun - mnew);
      mrun = mnew;
      float ls = 0.f;
#pragma unroll
      for (int t2 = 0; t2 < 2; ++t2)
#pragma unroll
        for (int e = 0; e < 16; ++e) { const float pv = exp2f(s[t2][e] - mnew); s[t2][e] = pv; ls += pv; }
      lrun = lrun * alpha + ls;
#pragma unroll
      for (int d = 0; d < 2; ++d)
#pragma unroll
        for (int e = 0; e < 16; ++e) o[d][e] *= alpha;
    } else {
#pragma unroll
      for (int t2 = 1; t2 >= 0; --t2) {
        f32x16 lk;
#pragma unroll
        for (int e = 0; e < 16; ++e) {
          const float z = s[t2][e];
          const float sp = fmaxf(z, 0.f) + __logf(1.f + __expf(-fabsf(z)));
          const bool vis = !diag || (kbase + 32 * t2 + ACC_ROW(e, 0) < qpos);
          lk[e] = vis ? -sp : 0.f;
        }
        bf16x8 fh[2], fl[2];
#pragma unroll
        for (int sI = 0; sI < 2; ++sI) fh[sI] = pack8(lk, sI);
#pragma unroll
        for (int e = 0; e < 16; ++e) lk[e] -= __uint_as_float(((unsigned)(u16)fh[e >> 3][e & 7]) << 16);
#pragma unroll
        for (int sI = 0; sI < 2; ++sI) fl[sI] = pack8(lk, sI);
        f32x16 inc;
#pragma unroll
        for (int e = 0; e < 16; ++e) inc[e] = R;
#pragma unroll
        for (int sI = 0; sI < 2; ++sI) { inc = MFMA(tri[sI], fh[sI], inc); inc = MFMA(tri[sI], fl[sI], inc); }
#pragma unroll
        for (int e = 0; e < 16; ++e) {
          const bool vis = !diag || (kbase + 32 * t2 + ACC_ROW(e, 0) < qpos);
          const float w = exp2f((s[t2][e] + inc[e]) * LOG2E);
          s[t2][e] = vis ? w : 0.f;
        }
        R = __shfl(inc[0], r31);
      }
    }
#pragma unroll
    for (int t2 = 0; t2 < 2; ++t2)
#pragma unroll
      for (int sI = 0; sI < 2; ++sI) {
        const bf16x8 pf = pack8(s[t2], sI);
#pragma unroll
        for (int d = 0; d < 2; ++d) {
          const u16* pv = sm.vt[cur] + (d * 32 + r31) * VLD + 32 * t2 + 16 * sI + 4 * hh;
          union { s16x4 q[2]; bf16x8 v; } a;
          a.q[0] = *(const s16x4*)(pv); a.q[1] = *(const s16x4*)(pv + 8);
          o[d] = MFMA(a.v, pf, o[d]);
        }
      }
    if (it + 1 < nkt) kv_stash(kv, sm.k[cur ^ 1], sm.vt[cur ^ 1], tid);
#if SB_EXIT
    if (!FOX) { if (__syncthreads_and(R < -110.f)) break; } else __syncthreads();
#else
    __syncthreads();
#endif
  }
  float inv = 1.f;
  if (FOX) { const float lt = lrun + __shfl_xor(lrun, 32); inv = 1.f / lt; }
  {
    float ssq = 0.f;
#pragma unroll
    for (int d = 0; d < 2; ++d)
#pragma unroll
      for (int e = 0; e < 16; ++e) { const float t = o[d][e] * inv; ssq += t * t; }
    ssq += __shfl_xor(ssq, 32);
    if (hh == 0 && (!smp || wid < 2)) atomicAdd((float*)(p.ws + WS_SSQ) + (size_t)g * 2 + (FOX ? 1 : 0), ssq);
  }
  if (!smp || wid < 2) {
    u16* od = (u16*)(p.ws + WS_E) + (size_t)g * DM + (FOX ? 512 : 0) + h * 64;
#pragma unroll
    for (int d = 0; d < 2; ++d)
#pragma unroll
      for (int g4 = 0; g4 < 4; ++g4)
        *(uint2*)(od + d * 32 + 8 * g4 + 4 * hh) = make_uint2(pk2(o[d][4 * g4] * inv, o[d][4 * g4 + 1] * inv), pk2(o[d][4 * g4 + 2] * inv, o[d][4 * g4 + 3] * inv));
  }
}

DI void phase_attn(const Params& p, char* smem) {
  constexpr int NI = 256 + 4096;
  unsigned* ctr = (unsigned*)(p.ws + WS_BAR + 128);
  int* slot = (int*)(smem + 73728 + 512);
  for (;;) {
    if (threadIdx.x == 0) *slot = (int)atomicAdd(ctr, 1u);
    __syncthreads();
    const int it = *slot;
    __syncthreads();
    if (it >= NI) break;
    if (it < 128) { attn_item<true>(p, 1, it >> 3, it & 7, 0, smem); }
    else if (it < 128 + 2048) { const int u = it - 128; const int qb = 15 - (u >> 7), bh = u & 127; attn_item<true>(p, 0, bh >> 3, bh & 7, qb, smem); }
    else if (it < 256 + 2048) { const int u = it - 128 - 2048; attn_item<false>(p, 1, u >> 3, u & 7, 0, smem); }
    else { const int u = it - 256 - 2048; const int qb = 15 - (u >> 7), bh = u & 127; attn_item<false>(p, 0, bh >> 3, bh & 7, qb, smem); }
  }
}

DI void phase_wout(const Params& p, char* smem) {
  float* pre = (float*)(p.ws + WS_A);
  const u16* o = (const u16*)(p.ws + WS_E);
  float* sc_s = (float*)(smem + 73728);
  for_tiles(DM, [&](int m0, int n0, auto tag) {
    constexpr int MI = decltype(tag)::value;
    {
      const int tid = threadIdx.x;
      if (tid < MI * 64) {
        const float2 q = ((const float2*)(p.ws + WS_SSQ))[m0 + tid];
        const float s0 = rsqrtf(q.x * (1.f / 512.f) + 1e-6f), s1 = rsqrtf(q.y * (1.f / 512.f) + 1e-6f);
        sc_s[tid * 2] = s0 / s1; sc_s[tid * 2 + 1] = s1;
      }
      __syncthreads();
    }
    GldsBf16<MI * 64> al; al.base = o + (size_t)m0 * DM; al.ld = DM;
    const float* xr = xrow(p, m0);
    auto epi = [=](int r0, int c0, const f32x16& acc) {
      const int lane = threadIdx.x & 63, hh = lane >> 5, col = c0 + (lane & 31);
      const unsigned b0 = (unsigned)(r0 + 4 * hh) * 1024u + col, b1 = (unsigned)(r0 - m0 + 4 * hh) * 1024u + col;
#pragma unroll
      for (int e = 0; e < 16; ++e) pre[b0 + ACC_R0(e) * 1024u] = DN_ALPHA * xr[b1 + ACC_R0(e) * 1024u] + acc[e];
    };
    gemm_tile<MI, true>(al, (const u16*)(p.ws + WS_WOUT), DM, DM, m0, n0, epi, smem, sc_s);
  });
}

DI void phase_ln(const Params& p, const float* gam, const float* bet) {
  const float* pre = (const float*)(p.ws + WS_A);
  float* xf = (float*)(p.ws + WS_B);
  u16* xb = (u16*)(p.ws + WS_C);
  const int lane = threadIdx.x & 63;
  const int wg = blockIdx.x * 4 + (threadIdx.x >> 6), nw = gridDim.x * 4;
  for (int row0 = wg * 2; row0 < NT; row0 += nw * 2) {
    float4 v[2][4];
    float s[2], q[2];
#pragma unroll
    for (int r = 0; r < 2; ++r) {
      s[r] = 0.f;
#pragma unroll
      for (int j = 0; j < 4; ++j) { v[r][j] = ((const float4*)(pre + (size_t)(row0 + r) * DM))[lane + 64 * j]; s[r] += v[r][j].x + v[r][j].y + v[r][j].z + v[r][j].w; }
    }
#pragma unroll
    for (int o = 32; o >= 1; o >>= 1)
#pragma unroll
      for (int r = 0; r < 2; ++r) s[r] += __shfl_xor(s[r], o);
#pragma unroll
    for (int r = 0; r < 2; ++r) {
      s[r] *= (1.f / 1024.f); q[r] = 0.f;
#pragma unroll
      for (int j = 0; j < 4; ++j) { const float a = v[r][j].x - s[r], b2 = v[r][j].y - s[r], c = v[r][j].z - s[r], d = v[r][j].w - s[r]; q[r] += a * a + b2 * b2 + c * c + d * d; }
    }
#pragma unroll
    for (int o = 32; o >= 1; o >>= 1)
#pragma unroll
      for (int r = 0; r < 2; ++r) q[r] += __shfl_xor(q[r], o);
#pragma unroll
    for (int r = 0; r < 2; ++r) {
      const float mu = s[r], rs = rsqrtf(q[r] * (1.f / 1024.f) + 1e-5f);
#pragma unroll
      for (int j = 0; j < 4; ++j) {
        const float4 gg = ((const float4*)gam)[lane + 64 * j], bb = ((const float4*)bet)[lane + 64 * j];
        float4 y;
        y.x = (v[r][j].x - mu) * rs * gg.x + bb.x; y.y = (v[r][j].y - mu) * rs * gg.y + bb.y;
        y.z = (v[r][j].z - mu) * rs * gg.z + bb.z; y.w = (v[r][j].w - mu) * rs * gg.w + bb.w;
        ((float4*)(xf + (size_t)(row0 + r) * DM))[lane + 64 * j] = y;
        ((uint2*)(xb + (size_t)(row0 + r) * DM))[lane + 64 * j] = make_uint2(pk2(y.x, y.y), pk2(y.z, y.w));
      }
    }
  }
}

DI void phase_gemm_bf16(const Params& p, const u16* A, const u16* Wt, int N, u16* O, float scale, char* smem) {
  for_tiles(N, [&](int m0, int n0, auto tag) {
    constexpr int MI = decltype(tag)::value;
    GldsBf16<MI * 64> al; al.base = A + (size_t)m0 * DM; al.ld = DM;
    auto epi = [=](int r0, int c0, const f32x16& acc) {
      const int lane = threadIdx.x & 63, hh = lane >> 5, col = c0 + (lane & 31);
      const unsigned b0 = (unsigned)(r0 + 4 * hh) * (unsigned)N + col;
#pragma unroll
      for (int e = 0; e < 16; ++e) O[b0 + ACC_R0(e) * (unsigned)N] = bf1(acc[e] * scale);
    };
    gemm_tile<MI>(al, Wt, DM, DM, m0, n0, epi, smem);
  });
}

template <class F>
DI void for_mem_tiles(F body) {
  const int vb = vblock(), nb = gridDim.x;
  for (int t = vb; t < 2048 + 256; t += nb) {
    if (t < 2048) { const int mt = t >> 3; body(mt * 128, (t >> 1) & 3, (t & 1) * 128, mt >> 4, IC<2>{}); }
    else { const int u = t - 2048; const int mt = u >> 4; body(NTP + mt * 64, (u >> 2) & 3, (u & 3) * 64, 16 + mt, IC<1>{}); }
  }
}
DI void phase_mem_s(const Params& p, char* smem) {
  const u16* qm = (const u16*)(p.ws + WS_D);
  float* S = (float*)(p.ws + WS_F);
  for_mem_tiles([&](int m0, int hd, int n0, int batch, auto tag) {
    constexpr int MI = decltype(tag)::value;
    GldsBf16<MI * 64> al; al.base = qm + (size_t)m0 * DM + hd * 256; al.ld = DM;
    const u16* Bt = (const u16*)(p.ws + WS_MEMK) + (size_t)batch * 256 * DM + hd * 256;
    auto epi = [=](int r0, int c0, const f32x16& acc) {
      const int lane = threadIdx.x & 63, hh = lane >> 5, col = c0 + (lane & 31);
      const unsigned b0 = (unsigned)(r0 + 4 * hh) * 1024u + hd * 256 + col;
#pragma unroll
      for (int e = 0; e < 16; ++e) S[b0 + ACC_R0(e) * 1024u] = acc[e];
    };
    gemm_tile<MI>(al, Bt, DM, 256, m0, n0, epi, smem);
  });
}
DI void phase_mem_softmax(const Params& p) {
  const float* S = (const float*)(p.ws + WS_F);
  u16* P = (u16*)(p.ws + WS_D);
  const int lane = threadIdx.x & 63;
  const int wg = blockIdx.x * 4 + (threadIdx.x >> 6), nw = gridDim.x * 4;
  for (int row0 = wg * 4; row0 < NT * 4; row0 += nw * 4) {
    float4 v[4]; float m[4], sm[4];
#pragma unroll
    for (int r = 0; r < 4; ++r) v[r] = ((const float4*)(S + (size_t)(row0 + r) * 256))[lane];
#pragma unroll
    for (int r = 0; r < 4; ++r) m[r] = fmaxf(fmaxf(v[r].x, v[r].y), fmaxf(v[r].z, v[r].w));
#pragma unroll
    for (int o = 32; o >= 1; o >>= 1)
#pragma unroll
      for (int r = 0; r < 4; ++r) m[r] = fmaxf(m[r], __shfl_xor(m[r], o));
#pragma unroll
    for (int r = 0; r < 4; ++r) { v[r].x = __expf(v[r].x - m[r]); v[r].y = __expf(v[r].y - m[r]); v[r].z = __expf(v[r].z - m[r]); v[r].w = __expf(v[r].w - m[r]); sm[r] = v[r].x + v[r].y + v[r].z + v[r].w; }
#pragma unroll
    for (int o = 32; o >= 1; o >>= 1)
#pragma unroll
      for (int r = 0; r < 4; ++r) sm[r] += __shfl_xor(sm[r], o);
#pragma unroll
    for (int r = 0; r < 4; ++r) { const float inv = 1.f / sm[r]; ((uint2*)(P + (size_t)(row0 + r) * 256))[lane] = make_uint2(pk2(v[r].x * inv, v[r].y * inv), pk2(v[r].z * inv, v[r].w * inv)); }
  }
}
DI void phase_mem_pv(const Params& p, char* smem) {
  const u16* P = (const u16*)(p.ws + WS_D);
  u16* om = (u16*)(p.ws + WS_E);
  for_mem_tiles([&](int m0, int hd, int n0, int batch, auto tag) {
    constexpr int MI = decltype(tag)::value;
    GldsBf16<MI * 64> al; al.base = P + (size_t)m0 * DM + hd * 256; al.ld = DM;
    const u16* Bt = (const u16*)(p.ws + WS_MEMVT) + ((size_t)batch * DM + hd * 256) * 256;
    auto epi = [=](int r0, int c0, const f32x16& acc) {
      const int lane = threadIdx.x & 63, hh = lane >> 5, col = c0 + (lane & 31);
      const unsigned b0 = (unsigned)(r0 + 4 * hh) * 1024u + hd * 256 + col;
#pragma unroll
      for (int e = 0; e < 16; ++e) om[b0 + ACC_R0(e) * 1024u] = bf1(acc[e]);
    };
    gemm_tile<MI>(al, Bt, 256, 256, m0, n0, epi, smem);
  });
}
DI void phase_wmo(const Params& p, char* smem) {
  float* pre = (float*)(p.ws + WS_A);
  const float* xf = (const float*)(p.ws + WS_B);
  const u16* om = (const u16*)(p.ws + WS_E);
  for_tiles(DM, [&](int m0, int n0, auto tag) {
    constexpr int MI = decltype(tag)::value;
    GldsBf16<MI * 64> al; al.base = om + (size_t)m0 * DM; al.ld = DM;
    auto epi = [=](int r0, int c0, const f32x16& acc) {
      const int lane = threadIdx.x & 63, hh = lane >> 5, col = c0 + (lane & 31);
      const unsigned b0 = (unsigned)(r0 + 4 * hh) * 1024u + col;
#pragma unroll
      for (int e = 0; e < 16; ++e) { const unsigned i = b0 + ACC_R0(e) * 1024u; pre[i] = DN_ALPHA * xf[i] + acc[e]; }
    };
    gemm_tile<MI>(al, (const u16*)(p.ws + WS_WMO), DM, DM, m0, n0, epi, smem);
  });
}

DI void insert16(float (&v)[16], float x) {
#pragma unroll
  for (int j = 15; j >= 1; --j) v[j] = __builtin_amdgcn_fmed3f(x, v[j - 1], v[j]);
  v[0] = fmaxf(v[0], x);
}
DI void phase_topk(const Params& p, char* smem) {
  const int vb = vblock(), nb = gridDim.x;
  const u16* qp = (const u16*)(p.ws + WS_F);
  int* idxo = (int*)(p.ws + WS_A);
  float* gato = (float*)(p.ws + WS_A + (size_t)NT * 128 * 4);
  float* sc = (float*)smem;
  const int tid = threadIdx.x;
  for (int t = vb; t < 264 * 8; t += nb) {
    const int mt = t >> 3, hd = t & 7;
    const int m0 = mt * 128;
    float va[16], vbv[16];
#pragma unroll
    for (int side = 0; side < 2; ++side) {
      GldsBf16<128> al; al.base = qp + (size_t)m0 * 2048 + hd * 256 + side * 128; al.ld = 2048;
      const u16* Bt = (const u16*)(p.ws + (side ? WS_KB : WS_KA)) + (size_t)hd * 128 * 128;
      auto epi = [=](int r0, int c0, const f32x16& acc) {
        const int lane = threadIdx.x & 63, hh = lane >> 5, col = c0 + (lane & 31);
#pragma unroll
        for (int e = 0; e < 16; ++e) sc[(r0 - m0 + ACC_ROW(e, hh)) * 129 + col] = acc[e];
      };
      gemm_tile<2>(al, Bt, 128, 128, m0, 0, epi, smem);
      __syncthreads();
      if (tid < 128) {
        float v[16];
#pragma unroll
        for (int j = 0; j < 16; ++j) v[j] = -INFINITY;
        for (int k = 0; k < 128; ++k) {
          const float x = __uint_as_float((__float_as_uint(sc[tid * 129 + k]) & ~0x7Fu) | (unsigned)k);
          insert16(v, x);
        }
#pragma unroll
        for (int j = 0; j < 16; ++j) { if (side == 0) va[j] = v[j]; else vbv[j] = v[j]; }
      }
      __syncthreads();
    }
    unsigned char* ids = (unsigned char*)smem;
    if (tid < 128) {
#pragma unroll
      for (int j = 0; j < 16; ++j) { ids[tid * 32 + j] = (unsigned char)(__float_as_uint(va[j]) & 0x7F); ids[tid * 32 + 16 + j] = (unsigned char)(__float_as_uint(vbv[j]) & 0x7F); }
      float top[16];
#pragma unroll
      for (int j = 0; j < 16; ++j) top[j] = -INFINITY;
#pragma unroll
      for (int i = 0; i < 16; ++i)
#pragma unroll
        for (int j = 0; j < 16; ++j)
          if ((i + 1) * (j + 1) <= 16) {
            const float a = __uint_as_float(__float_as_uint(va[i]) & ~0x7Fu), b = __uint_as_float(__float_as_uint(vbv[j]) & ~0x7Fu);
            const float c = __uint_as_float((__float_as_uint(a + b) & ~0xFFu) | (unsigned)(i * 16 + j));
            insert16(top, c);
          }
      const float m = __uint_as_float(__float_as_uint(top[0]) & ~0xFFu);
      float ex[16], ssum = 0.f;
      int eid[16];
#pragma unroll
      for (int j = 0; j < 16; ++j) {
        const unsigned bits = __float_as_uint(top[j]);
        const int code = bits & 0xFF;
        ex[j] = __expf(__uint_as_float(bits & ~0xFFu) - m); ssum += ex[j];
        eid[j] = (int)ids[tid * 32 + (code >> 4)] * 128 + (int)ids[tid * 32 + 16 + (code & 15)];
      }
      const float inv = 1.f / ssum;
      const size_t ob = (size_t)(m0 + tid) * 128 + hd * 16;
#pragma unroll
      for (int j4 = 0; j4 < 4; ++j4) {
        *(int4*)(idxo + ob + 4 * j4) = make_int4(eid[4 * j4], eid[4 * j4 + 1], eid[4 * j4 + 2], eid[4 * j4 + 3]);
        *(float4*)(gato + ob + 4 * j4) = make_float4(ex[4 * j4] * inv, ex[4 * j4 + 1] * inv, ex[4 * j4 + 2] * inv, ex[4 * j4 + 3] * inv);
      }
    }
    __syncthreads();
  }
}

#if USE_FP8
typedef float f32x2v __attribute__((ext_vector_type(2)));
DI void unpack16(const uint4& v, float (&f)[16]) {
  const unsigned w[4] = {v.x, v.y, v.z, v.w};
#pragma unroll
  for (int j = 0; j < 4; ++j) {
    const f32x2v lo = __builtin_amdgcn_cvt_pk_f32_fp8((int)w[j], false), hi = __builtin_amdgcn_cvt_pk_f32_fp8((int)w[j], true);
    f[4 * j] = lo[0]; f[4 * j + 1] = lo[1]; f[4 * j + 2] = hi[0]; f[4 * j + 3] = hi[1];
  }
}
DI void peer_dot8(const char* U, int idreg, int e0, int lane, const float (&x)[16], float& dacc) {
  uint4 w[8];
#pragma unroll
  for (int j = 0; j < 8; ++j) { const int id = __builtin_amdgcn_readlane(idreg, e0 + j); w[j] = *(const uint4*)(U + (size_t)id * DM + 16 * lane); }
  float s[8];
#pragma unroll
  for (int j = 0; j < 8; ++j) {
    float f[16]; unpack16(w[j], f);
    float a = 0.f;
#pragma unroll
    for (int k = 0; k < 16; ++k) a += f[k] * x[k];
    s[j] = a;
  }
  const bool b5 = lane & 32, b4 = lane & 16, b3 = lane & 8;
  float t4[4], t2[2], t1;
#pragma unroll
  for (int i = 0; i < 4; ++i) { const float snd = b5 ? s[i] : s[4 + i], kp = b5 ? s[4 + i] : s[i]; t4[i] = kp + __shfl_xor(snd, 32); }
#pragma unroll
  for (int i = 0; i < 2; ++i) { const float snd = b4 ? t4[i] : t4[2 + i], kp = b4 ? t4[2 + i] : t4[i]; t2[i] = kp + __shfl_xor(snd, 16); }
  { const float snd = b3 ? t2[0] : t2[1], kp = b3 ? t2[1] : t2[0]; t1 = kp + __shfl_xor(snd, 8); }
  t1 += __shfl_xor(t1, 4); t1 += __shfl_xor(t1, 2); t1 += __shfl_xor(t1, 1);
  const float g = __shfl(t1, (lane & 7) * 8);
  if ((lane >> 3) == (e0 >> 3)) dacc = g;
}
DI void peer_axpy8(const char* V, int idreg, float hreg, int e0, int lane, float (&acc)[16]) {
  uint4 w[8];
#pragma unroll
  for (int j = 0; j < 8; ++j) { const int id = __builtin_amdgcn_readlane(idreg, e0 + j); w[j] = *(const uint4*)(V + (size_t)id * DM + 16 * lane); }
#pragma unroll
  for (int j = 0; j < 8; ++j) {
    const float hs = __uint_as_float(__builtin_amdgcn_readlane(__float_as_uint(hreg), e0 + j));
    float f[16]; unpack16(w[j], f);
#pragma unroll
    for (int k = 0; k < 16; ++k) acc[k] += hs * f[k];
  }
}
DI void phase_peer(const Params& p) {
  const float* xf = (const float*)(p.ws + WS_B);
  const int* idxo = (const int*)(p.ws + WS_A);
  const float* gato = (const float*)(p.ws + WS_A + (size_t)NT * 128 * 4);
  const char* U = p.ws + WS_U;
  const char* V = p.ws + WS_V;
  const float* usc = (const float*)(p.ws + WS_USC);
  const float* vsc = (const float*)(p.ws + WS_VSC);
  const int lane = threadIdx.x & 63;
  const int wg = blockIdx.x * 4 + (threadIdx.x >> 6), nw = gridDim.x * 4;
  for (int row = wg; row < NT; row += nw) {
    float x[16];
    {
      const float4* xr = (const float4*)(xf + (size_t)row * DM) + 4 * lane;
#pragma unroll
      for (int j = 0; j < 4; ++j) { const float4 a = xr[j]; x[4 * j] = a.x; x[4 * j + 1] = a.y; x[4 * j + 2] = a.z; x[4 * j + 3] = a.w; }
    }
    const int id0 = idxo[(size_t)row * 128 + lane], id1 = idxo[(size_t)row * 128 + 64 + lane];
    const float g0 = gato[(size_t)row * 128 + lane], g1 = gato[(size_t)row * 128 + 64 + lane];
    const float su0 = usc[id0], su1 = usc[id1], sv0 = vsc[id0], sv1 = vsc[id1];
    float d0 = 0.f, d1 = 0.f;
#pragma unroll 1
    for (int e0 = 0; e0 < 64; e0 += 8) peer_dot8(U, id0, e0, lane, x, d0);
#pragma unroll 1
    for (int e0 = 0; e0 < 64; e0 += 8) peer_dot8(U, id1, e0, lane, x, d1);
    d0 *= su0; d1 *= su1;
    const float h0 = 0.5f * d0 * (1.f + erff(d0 * 0.7071067811865476f)) * g0 * sv0;
    const float h1 = 0.5f * d1 * (1.f + erff(d1 * 0.7071067811865476f)) * g1 * sv1;
    float acc[16];
#pragma unroll
    for (int k = 0; k < 16; ++k) acc[k] = 0.f;
#pragma unroll 1
    for (int e0 = 0; e0 < 64; e0 += 8) peer_axpy8(V, id0, h0, e0, lane, acc);
#pragma unroll 1
    for (int e0 = 0; e0 < 64; e0 += 8) peer_axpy8(V, id1, h1, e0, lane, acc);
    float s = 0.f;
#pragma unroll
    for (int k = 0; k < 16; ++k) { acc[k] = DN_ALPHA * x[k] + acc[k]; s += acc[k]; }
    const float mu = wave_sum(s) * (1.f / 1024.f);
    float q = 0.f;
#pragma unroll
    for (int k = 0; k < 16; ++k) { const float dd = acc[k] - mu; q += dd * dd; }
    const float rs = rsqrtf(wave_sum(q) * (1.f / 1024.f) + 1e-5f);
    float* y = (row < NTP) ? p.out + OUT_YP + (size_t)row * DM : p.out + OUT_YS + (size_t)(row - NTP) * DM;
#pragma unroll
    for (int j = 0; j < 4; ++j) {
      const float4 ga = ((const float4*)p.ln3_g)[4 * lane + j], ba = ((const float4*)p.ln3_b)[4 * lane + j];
      float4 ya;
      ya.x = (acc[4 * j + 0] - mu) * rs * ga.x + ba.x; ya.y = (acc[4 * j + 1] - mu) * rs * ga.y + ba.y;
      ya.z = (acc[4 * j + 2] - mu) * rs * ga.z + ba.z; ya.w = (acc[4 * j + 3] - mu) * rs * ga.w + ba.w;
      ((float4*)y)[4 * lane + j] = ya;
    }
  }
}
#else
DI void unpack8(const uint4& v, float (&f)[8]) {
  f[0] = bflo(v.x); f[1] = bfhi(v.x); f[2] = bflo(v.y); f[3] = bfhi(v.y); f[4] = bflo(v.z); f[5] = bfhi(v.z); f[6] = bflo(v.w); f[7] = bfhi(v.w);
}
DI void phase_peer(const Params& p) {
  const float* xf = (const float*)(p.ws + WS_B);
  const int* idxo = (const int*)(p.ws + WS_A);
  const float* gato = (const float*)(p.ws + WS_A + (size_t)NT * 128 * 4);
  const u16* U = (const u16*)(p.ws + WS_U);
  const u16* V = (const u16*)(p.ws + WS_V);
  const int lane = threadIdx.x & 63;
  const int wg = blockIdx.x * 4 + (threadIdx.x >> 6), nw = gridDim.x * 4;
  for (int row = wg; row < NT; row += nw) {
    float x[16];
    {
      const float4* xr = (const float4*)(xf + (size_t)row * DM);
      const float4 a = xr[2 * lane], b = xr[2 * lane + 1], c = xr[128 + 2 * lane], d = xr[128 + 2 * lane + 1];
      x[0] = a.x; x[1] = a.y; x[2] = a.z; x[3] = a.w; x[4] = b.x; x[5] = b.y; x[6] = b.z; x[7] = b.w;
      x[8] = c.x; x[9] = c.y; x[10] = c.z; x[11] = c.w; x[12] = d.x; x[13] = d.y; x[14] = d.z; x[15] = d.w;
    }
    const int id0 = idxo[(size_t)row * 128 + lane], id1 = idxo[(size_t)row * 128 + 64 + lane];
    const float g0 = gato[(size_t)row * 128 + lane], g1 = gato[(size_t)row * 128 + 64 + lane];
    float d0 = 0.f, d1 = 0.f;
#pragma unroll 8
    for (int e = 0; e < 64; ++e) {
      const int id = __builtin_amdgcn_readlane(id0, e);
      const uint4* ur = (const uint4*)(U + (size_t)id * DM);
      const uint4 ua = ur[lane], ub = ur[64 + lane];
      float f[8], s = 0.f;
      unpack8(ua, f);
#pragma unroll
      for (int k = 0; k < 8; ++k) s += f[k] * x[k];
      unpack8(ub, f);
#pragma unroll
      for (int k = 0; k < 8; ++k) s += f[k] * x[8 + k];
      s = wave_sum(s);
      if (lane == e) d0 = s;
    }
#pragma unroll 8
    for (int e = 0; e < 64; ++e) {
      const int id = __builtin_amdgcn_readlane(id1, e);
      const uint4* ur = (const uint4*)(U + (size_t)id * DM);
      const uint4 ua = ur[lane], ub = ur[64 + lane];
      float f[8], s = 0.f;
      unpack8(ua, f);
#pragma unroll
      for (int k = 0; k < 8; ++k) s += f[k] * x[k];
      unpack8(ub, f);
#pragma unroll
      for (int k = 0; k < 8; ++k) s += f[k] * x[8 + k];
      s = wave_sum(s);
      if (lane == e) d1 = s;
    }
    const float h0 = 0.5f * d0 * (1.f + erff(d0 * 0.7071067811865476f)) * g0;
    const float h1 = 0.5f * d1 * (1.f + erff(d1 * 0.7071067811865476f)) * g1;
    float acc[16];
#pragma unroll
    for (int k = 0; k < 16; ++k) acc[k] = 0.f;
#pragma unroll 8
    for (int e = 0; e < 64; ++e) {
      const int id = __builtin_amdgcn_readlane(id0, e);
      const float hs = __uint_as_float(__builtin_amdgcn_readlane(__float_as_uint(h0), e));
      const uint4* vr = (const uint4*)(V + (size_t)id * DM);
      const uint4 va = vr[lane], vb2 = vr[64 + lane];
      float f[8];
      unpack8(va, f);
#pragma unroll
      for (int k = 0; k < 8; ++k) acc[k] += hs * f[k];
      unpack8(vb2, f);
#pragma unroll
      for (int k = 0; k < 8; ++k) acc[8 + k] += hs * f[k];
    }
#pragma unroll 8
    for (int e = 0; e < 64; ++e) {
      const int id = __builtin_amdgcn_readlane(id1, e);
      const float hs = __uint_as_float(__builtin_amdgcn_readlane(__float_as_uint(h1), e));
      const uint4* vr = (const uint4*)(V + (size_t)id * DM);
      const uint4 va = vr[lane], vb2 = vr[64 + lane];
      float f[8];
      unpack8(va, f);
#pragma unroll
      for (int k = 0; k < 8; ++k) acc[k] += hs * f[k];
      unpack8(vb2, f);
#pragma unroll
      for (int k = 0; k < 8; ++k) acc[8 + k] += hs * f[k];
    }
    float s = 0.f;
#pragma unroll
    for (int k = 0; k < 16; ++k) { acc[k] = DN_ALPHA * x[k] + acc[k]; s += acc[k]; }
    const float mu = wave_sum(s) * (1.f / 1024.f);
    float q = 0.f;
#pragma unroll
    for (int k = 0; k < 16; ++k) { const float dd = acc[k] - mu; q += dd * dd; }
    const float rs = rsqrtf(wave_sum(q) * (1.f / 1024.f) + 1e-5f);
    float* y = (row < NTP) ? p.out + OUT_YP + (size_t)row * DM : p.out + OUT_YS + (size_t)(row - NTP) * DM;
#pragma unroll
    for (int c = 0; c < 2; ++c) {
      const int off = c * 512 + lane * 8;
      const float4 ga = *(const float4*)(p.ln3_g + off), gb = *(const float4*)(p.ln3_g + off + 4);
      const float4 ba = *(const float4*)(p.ln3_b + off), bb = *(const float4*)(p.ln3_b + off + 4);
      float4 ya, yb;
      ya.x = (acc[8 * c + 0] - mu) * rs * ga.x + ba.x; ya.y = (acc[8 * c + 1] - mu) * rs * ga.y + ba.y;
      ya.z = (acc[8 * c + 2] - mu) * rs * ga.z + ba.z; ya.w = (acc[8 * c + 3] - mu) * rs * ga.w + ba.w;
      yb.x = (acc[8 * c + 4] - mu) * rs * gb.x + bb.x; yb.y = (acc[8 * c + 5] - mu) * rs * gb.y + bb.y;
      yb.z = (acc[8 * c + 6] - mu) * rs * gb.z + bb.z; yb.w = (acc[8 * c + 7] - mu) * rs * gb.w + bb.w;
      *(float4*)(y + off) = ya; *(float4*)(y + off + 4) = yb;
    }
  }
}

#endif

constexpr int NPHASE = 15;
template <int PH>
DI void run_phase(const Params& p, char* smem) {
  if (PH == 0) phase_prep(p, smem);
  else if (PH == 1) phase_proj(p, smem);
  else if (PH == 2) phase_scan(p, smem);
  else if (PH == 3) phase_attn(p, smem);
  else if (PH == 4) phase_wout(p, smem);
  else if (PH == 5) phase_ln(p, p.ln1_g, p.ln1_b);
  else if (PH == 6) phase_gemm_bf16(p, (const u16*)(p.ws + WS_C), (const u16*)(p.ws + WS_WMQ), 1024, (u16*)(p.ws + WS_D), 0.0625f, smem);
  else if (PH == 7) phase_mem_s(p, smem);
  else if (PH == 8) phase_mem_softmax(p);
  else if (PH == 9) phase_mem_pv(p, smem);
  else if (PH == 10) phase_wmo(p, smem);
  else if (PH == 11) phase_ln(p, p.ln2_g, p.ln2_b);
  else if (PH == 12) phase_gemm_bf16(p, (const u16*)(p.ws + WS_C), (const u16*)(p.ws + WS_WPQ), 2048, (u16*)(p.ws + WS_F), 1.f, smem);
  else if (PH == 13) phase_topk(p, smem);
  else if (PH == 14) phase_peer(p);
}

template <int PH>
__global__ void __launch_bounds__(256, 2) k_phase(Params p) {
  __shared__ __attribute__((aligned(16))) char smem[SMEM_BYTES];
  run_phase<PH>(p, smem);
}

#if ONE_LAUNCH
DI void grid_barrier(unsigned* bar, unsigned& target) {
  target += gridDim.x;
  asm volatile("s_waitcnt vmcnt(0)" ::: "memory");
  __syncthreads();
  if (threadIdx.x == 0) {
    __builtin_amdgcn_fence(__ATOMIC_RELEASE, "agent");
    asm volatile("s_waitcnt vmcnt(0)" ::: "memory");
    __hip_atomic_fetch_add(bar, 1u, __ATOMIC_RELAXED, __HIP_MEMORY_SCOPE_AGENT);
    while (__hip_atomic_load(bar, __ATOMIC_RELAXED, __HIP_MEMORY_SCOPE_AGENT) < target) __builtin_amdgcn_s_sleep(2);
    __builtin_amdgcn_fence(__ATOMIC_ACQUIRE, "agent");
    asm volatile("s_waitcnt vmcnt(0)" ::: "memory");
  }
  __syncthreads();
}
__global__ void __launch_bounds__(256, 2) k_mega(Params p) {
  __shared__ __attribute__((aligned(16))) char smem[SMEM_BYTES];
  cg::grid_group grid = cg::this_grid();
#define RUN(n) do { run_phase<n>(p, smem); if (REPEAT_PHASE == n) { GSYNC(); run_phase<n>(p, smem); GSYNC(); run_phase<n>(p, smem); } } while (0)
#if CUSTOM_BAR
  unsigned* bar = (unsigned*)(p.ws + WS_BAR);
  unsigned target = 0;
#define GSYNC() grid_barrier(bar, target)
#else
#define GSYNC() grid.sync()
#endif
  RUN(0); grid.sync();
  RUN(1); GSYNC();
  RUN(2); GSYNC();
  RUN(3); GSYNC();
  RUN(4); GSYNC();
  RUN(5); GSYNC();
  RUN(6); GSYNC();
  RUN(7); GSYNC();
  RUN(8); GSYNC();
  RUN(9); GSYNC();
  RUN(10); GSYNC();
  RUN(11); GSYNC();
  RUN(12); GSYNC();
  RUN(13); GSYNC();
  RUN(14);
}
#endif

extern "C" void kernel_launch(void* const* d_in, const int* in_sizes, int n_in, void* d_out, int out_size, void* d_ws, size_t ws_size,
                              hipStream_t stream) {
  (void)in_sizes; (void)n_in; (void)out_size;
  if (ws_size < WS_TOTAL) { fprintf(stderr, "workspace too small: %zu < %zu\n", ws_size, (size_t)WS_TOTAL); return; }
  Params p{};
  const float** pp = (const float**)&p;
  for (int i = 0; i < 29; ++i) pp[i] = (const float*)d_in[i];
  p.out = (float*)d_out;
  p.ws = (char*)d_ws;
#if ONE_LAUNCH
  static int grid_blocks = 0;
  if (!grid_blocks) {
    int dev = 0, cus = 0, per_cu = 0;
    hipGetDevice(&dev);
    hipDeviceGetAttribute(&cus, hipDeviceAttributeMultiprocessorCount, dev);
    hipOccupancyMaxActiveBlocksPerMultiprocessor(&per_cu, k_mega, 256, 0);
    if (per_cu > 2) per_cu = 2;
    grid_blocks = cus * per_cu;
  }
#if CUSTOM_BAR
  hipMemsetAsync((char*)d_ws + WS_BAR, 0, 256, stream);
#endif
  void* args[] = {&p};
  hipError_t e = hipLaunchCooperativeKernel((void*)k_mega, dim3(grid_blocks), dim3(256), args, 0, stream);
  if (e != hipSuccess) fprintf(stderr, "cooperative launch failed: %s (grid %d)\n", hipGetErrorString(e), grid_blocks);
#else
  const int G = 512;
  hipMemsetAsync((char*)d_ws + WS_BAR, 0, 256, stream);
  k_phase<0><<<G, 256, 0, stream>>>(p);
  k_phase<1><<<G, 256, 0, stream>>>(p);
  k_phase<2><<<G, 256, 0, stream>>>(p);
  k_phase<3><<<G, 256, 0, stream>>>(p);
  k_phase<4><<<G, 256, 0, stream>>>(p);
  k_phase<5><<<G, 256, 0, stream>>>(p);
  k_phase<6><<<G, 256, 0, stream>>>(p);
  k_phase<7><<<G, 256, 0, stream>>>(p);
  k_phase<8><<<G, 256, 0, stream>>>(p);
  k_phase<9><<<G, 256, 0, stream>>>(p);
  k_phase<10><<<G, 256, 0, stream>>>(p);
  k_phase<11><<<G, 256, 0, stream>>>(p);
  k_phase<12><<<G, 256, 0, stream>>>(p);
  k_phase<13><<<G, 256, 0, stream>>>(p);
  k_phase<14><<<G, 256, 0, stream>>>(p);
#endif
}
```

```cpp
#include <hip/hip_runtime.h>
#include <hip/hip_cooperative_groups.h>
#include <cstdio>
#include <cstdint>
namespace cg = cooperative_groups;

#ifndef ONE_LAUNCH
#define ONE_LAUNCH 1
#endif

#ifndef USE_FP8
#define USE_FP8 1
#endif
#ifndef SB_EXIT
#define SB_EXIT 1
#endif
#ifndef REPEAT_PHASE
#define REPEAT_PHASE -1
#endif
#ifndef CUSTOM_BAR
#define CUSTOM_BAR 1
#endif
#define DI __device__ __forceinline__
typedef unsigned short u16;
typedef short bf16x8 __attribute__((ext_vector_type(8)));
typedef short s16x4 __attribute__((ext_vector_type(4)));
typedef float f32x16 __attribute__((ext_vector_type(16)));
typedef __bf16 bf2_t __attribute__((ext_vector_type(2)));
typedef float f2_t __attribute__((ext_vector_type(2)));
#define MFMA(a, b, c) __builtin_amdgcn_mfma_f32_32x32x16_bf16((a), (b), (c), 0, 0, 0)

constexpr int DM = 1024;
constexpr int NTP = 32768;
constexpr int NTS = 1024;
constexpr int NT = NTP + NTS;
constexpr int SEQ = 2048, DSEQ = 64, PAST = 4096, NMEM = 256;
constexpr int INC = 3080, INCP = 3200;
constexpr float DN_ALPHA = 1.189207115002721f;
constexpr float LOG2E = 1.4426950408889634f;

constexpr size_t OUT_YP = 0;
constexpr size_t OUT_YS = OUT_YP + (size_t)NTP * DM;
constexpr size_t OUT_SBK_P = OUT_YS + (size_t)NTS * DM;
constexpr size_t OUT_SBV_P = OUT_SBK_P + (size_t)NTP * 512;
constexpr size_t OUT_FXK_P = OUT_SBV_P + (size_t)NTP * 512;
constexpr size_t OUT_FXV_P = OUT_FXK_P + (size_t)NTP * 512;
constexpr size_t OUT_LF_P = OUT_FXV_P + (size_t)NTP * 512;
constexpr size_t OUT_MK_P = OUT_LF_P + (size_t)NTP * 8;
constexpr size_t OUT_MV_P = OUT_MK_P + (size_t)4096 * DM;
constexpr size_t OUT_SBK_S = OUT_MV_P + (size_t)4096 * DM;
constexpr size_t OUT_SBV_S = OUT_SBK_S + (size_t)NTS * 512;
constexpr size_t OUT_FXK_S = OUT_SBV_S + (size_t)NTS * 512;
constexpr size_t OUT_FXV_S = OUT_FXK_S + (size_t)NTS * 512;
constexpr size_t OUT_LF_S = OUT_FXV_S + (size_t)NTS * 512;
constexpr size_t OUT_TOTAL = OUT_LF_S + (size_t)NTS * 8;

constexpr size_t WS_WIN = 0;
constexpr size_t WS_WOUT = WS_WIN + (size_t)INCP * DM * 2;
constexpr size_t WS_WMQ = WS_WOUT + (size_t)DM * DM * 2;
constexpr size_t WS_WMKV = WS_WMQ + (size_t)DM * DM * 2;
constexpr size_t WS_WMO = WS_WMKV + (size_t)2048 * DM * 2;
constexpr size_t WS_WPQ = WS_WMO + (size_t)DM * DM * 2;
constexpr size_t WS_KA = WS_WPQ + (size_t)2048 * DM * 2;
constexpr size_t WS_KB = WS_KA + (size_t)8 * 128 * 128 * 2;
constexpr size_t WS_U = WS_KB + (size_t)8 * 128 * 128 * 2;
constexpr size_t WS_V = WS_U + (size_t)16384 * DM * 2;
constexpr size_t WS_MEMK = WS_V + (size_t)16384 * DM * 2;
constexpr size_t WS_MEMVT = WS_MEMK + (size_t)32 * 256 * DM * 2;
constexpr size_t WS_A = WS_MEMVT + (size_t)32 * 256 * DM * 2;
constexpr size_t WS_B = WS_A + (size_t)NT * DM * 4;
constexpr size_t WS_C = WS_B + (size_t)NT * DM * 4;
constexpr size_t WS_D = WS_C + (size_t)NT * DM * 2;
constexpr size_t WS_E = WS_D + (size_t)NT * DM * 2;
constexpr size_t WS_F = WS_E + (size_t)NT * DM * 2;
constexpr size_t WS_BAR = WS_F + (size_t)NT * DM * 4;
constexpr size_t WS_USC = WS_BAR + 2048;
constexpr size_t WS_VSC = WS_USC + (size_t)16384 * 4;
constexpr size_t WS_CBP = WS_VSC + (size_t)16384 * 4;
constexpr size_t WS_CBS = WS_CBP + (size_t)128 * 2048 * 4;
constexpr size_t WS_SSQ = WS_CBS + (size_t)128 * 4160 * 4;
constexpr size_t WS_XBAR = WS_SSQ + (size_t)NT * 2 * 4;
constexpr size_t WS_TOTAL = WS_XBAR + 16384;

struct Params {
  const float *x_prompt, *x_sample, *mem_prompt, *c_sb_k, *c_sb_v, *c_fx_k, *c_fx_v, *c_fx_logf, *c_mem_k, *c_mem_v;
  const float *w_in, *b_f, *w_gn, *w_out, *ln1_g, *ln1_b, *w_mq, *w_mk, *w_mv, *w_mo, *ln2_g, *ln2_b;
  const float *w_pq, *keys_a, *keys_b, *peer_u, *peer_v, *ln3_g, *ln3_b;
  float* out;
  char* ws;
};

constexpr int SMEM_BYTES = 73728 + 1024 + 64;

DI unsigned pk2(float a, float b) { f2_t v = {a, b}; bf2_t r = __builtin_convertvector(v, bf2_t); return __builtin_bit_cast(unsigned, r); }
DI u16 bf1(float a) { return (u16)(pk2(a, 0.f) & 0xffffu); }
DI float bflo(unsigned w) { return __uint_as_float(w << 16); }
DI float bfhi(unsigned w) { return __uint_as_float(w & 0xffff0000u); }
DI float wave_sum(float v) {
#pragma unroll
  for (int o = 32; o >= 1; o >>= 1) v += __shfl_xor(v, o);
  return v;
}
DI float wave_max(float v) {
#pragma unroll
  for (int o = 32; o >= 1; o >>= 1) v = fmaxf(v, __shfl_xor(v, o));
  return v;
}
DI int vblock() { int nb = gridDim.x, b = blockIdx.x; return ((nb & 7) == 0) ? (b & 7) * (nb >> 3) + (b >> 3) : b; }
DI const float* xrow(const Params& p, int g) { return g < NTP ? p.x_prompt + (size_t)g * DM : p.x_sample + (size_t)(g - NTP) * DM; }

DI void tconv_tile(const float* src, int ldsrc, int C, u16* dst, int lddst, const float* rowscale, int tr, int tc, float* tile) {
  const int tid = threadIdx.x;
  {
    const int r = tid >> 2, c0 = (tid & 3) * 16;
    const int gr = tr * 64 + r;
    const float sc = rowscale ? rowscale[gr] : 1.f;
#pragma unroll
    for (int j = 0; j < 4; ++j) {
      const int gc = tc * 64 + c0 + 4 * j;
      float4 v = make_float4(0.f, 0.f, 0.f, 0.f);
      if (gc < C) v = *(const float4*)(src + (size_t)gr * ldsrc + gc);
      float* t = tile + r * 65 + c0 + 4 * j;
      t[0] = v.x * sc; t[1] = v.y * sc; t[2] = v.z * sc; t[3] = v.w * sc;
    }
  }
  __syncthreads();
  {
    const int n = tid >> 2, k0 = (tid & 3) * 16;
    unsigned w[8];
#pragma unroll
    for (int e = 0; e < 8; ++e) w[e] = pk2(tile[(k0 + 2 * e) * 65 + n], tile[(k0 + 2 * e + 1) * 65 + n]);
    uint4* d = (uint4*)(dst + (size_t)(tc * 64 + n) * lddst + tr * 64 + k0);
    d[0] = make_uint4(w[0], w[1], w[2], w[3]);
    d[1] = make_uint4(w[4], w[5], w[6], w[7]);
  }
  __syncthreads();
}

DI void conv_range(const float* src, u16* dst, size_t n8, int bid, int nb) {
  for (size_t i = (size_t)bid * 256 + threadIdx.x; i < n8; i += (size_t)nb * 256) {
    const float4 a = ((const float4*)src)[2 * i], b = ((const float4*)src)[2 * i + 1];
    ((uint4*)dst)[i] = make_uint4(pk2(a.x, a.y), pk2(a.z, a.w), pk2(b.x, b.y), pk2(b.z, b.w));
  }
}

DI void phase_prep(const Params& p, char* smem) {
  float* tile = (float*)smem;
  const int bid = blockIdx.x, nb = gridDim.x;
  u16* ws16 = (u16*)p.ws;
  constexpr int T_WIN = 16 * 50, T_SQ = 256, T_PQ = 16 * 32, T_MV = 16 * 4 * 16;
  constexpr int T0 = T_WIN, T1 = T0 + T_SQ, T2 = T1 + T_SQ, T3 = T2 + T_SQ, T4 = T3 + T_SQ, T5 = T4 + T_SQ, T6 = T5 + T_PQ, T7 = T6 + T_MV;
  for (int t = bid; t < T7; t += nb) {
    if (t < T0) { tconv_tile(p.w_in, INC, INC, (u16*)(p.ws + WS_WIN), DM, nullptr, t / 50, t % 50, tile); }
    else if (t < T1) { int u = t - T0; tconv_tile(p.w_out, DM, DM, (u16*)(p.ws + WS_WOUT), DM, p.w_gn, u >> 4, u & 15, tile); }
    else if (t < T2) { int u = t - T1; tconv_tile(p.w_mq, DM, DM, (u16*)(p.ws + WS_WMQ), DM, nullptr, u >> 4, u & 15, tile); }
    else if (t < T3) { int u = t - T2; tconv_tile(p.w_mk, DM, DM, (u16*)(p.ws + WS_WMKV), DM, nullptr, u >> 4, u & 15, tile); }
    else if (t < T4) { int u = t - T3; tconv_tile(p.w_mv, DM, DM, (u16*)(p.ws + WS_WMKV) + (size_t)DM * DM, DM, nullptr, u >> 4, u & 15, tile); }
    else if (t < T5) { int u = t - T4; tconv_tile(p.w_mo, DM, DM, (u16*)(p.ws + WS_WMO), DM, nullptr, u >> 4, u & 15, tile); }
    else if (t < T6) { int u = t - T5; tconv_tile(p.w_pq, 2048, 2048, (u16*)(p.ws + WS_WPQ), DM, nullptr, u >> 5, u & 31, tile); }
    else { int u = t - T6; int b = u >> 6, r = u & 63;
      tconv_tile(p.c_mem_v + (size_t)b * 256 * DM, DM, DM, (u16*)(p.ws + WS_MEMVT) + (size_t)(16 + b) * DM * 256, 256, nullptr, r >> 4, r & 15, tile); }
  }
  (void)ws16;
  for (int i = bid * 256 + threadIdx.x; i < NT * 2; i += nb * 256) ((float*)(p.ws + WS_SSQ))[i] = 0.f;
  conv_range(p.x_prompt, (u16*)(p.ws + WS_C), (size_t)NTP * DM / 8, bid, nb);
  conv_range(p.x_sample, (u16*)(p.ws + WS_C) + (size_t)NTP * DM, (size_t)NTS * DM / 8, bid, nb);
  conv_range(p.mem_prompt, (u16*)(p.ws + WS_E), (size_t)4096 * DM / 8, bid, nb);
  conv_range(p.c_mem_k, (u16*)(p.ws + WS_MEMK) + (size_t)16 * 256 * DM, (size_t)16 * 256 * DM / 8, bid, nb);
  conv_range(p.keys_a, (u16*)(p.ws + WS_KA), (size_t)8 * 128 * 128 / 8, bid, nb);
  conv_range(p.keys_b, (u16*)(p.ws + WS_KB), (size_t)8 * 128 * 128 / 8, bid, nb);
#if USE_FP8
  {
    const int lane = threadIdx.x & 63;
    const int wg = bid * 4 + (threadIdx.x >> 6), nw = nb * 4;
    for (int row = wg; row < 32768; row += nw) {
      const bool isv = row >= 16384;
      const int r = isv ? row - 16384 : row;
      const float4* src = (const float4*)((isv ? p.peer_v : p.peer_u) + (size_t)r * DM) + 4 * lane;
      float4 a[4];
      float am = 0.f;
#pragma unroll
      for (int j = 0; j < 4; ++j) { a[j] = src[j]; am = fmaxf(am, fmaxf(fmaxf(fabsf(a[j].x), fabsf(a[j].y)), fmaxf(fabsf(a[j].z), fabsf(a[j].w)))); }
      am = wave_max(am);
      int ex = 0;
      if (am > 0.f) (void)frexpf(am, &ex);
      const float sc = ldexpf(1.f, 8 - ex), isc = ldexpf(1.f, ex - 8);
      unsigned w[4];
#pragma unroll
      for (int j = 0; j < 4; ++j) {
        int t = __builtin_amdgcn_cvt_pk_fp8_f32(a[j].x * sc, a[j].y * sc, 0, false);
        t = __builtin_amdgcn_cvt_pk_fp8_f32(a[j].z * sc, a[j].w * sc, t, true);
        w[j] = (unsigned)t;
      }
      *(uint4*)(p.ws + (isv ? WS_V : WS_U) + (size_t)r * DM + 16 * lane) = make_uint4(w[0], w[1], w[2], w[3]);
      if (lane == 0) ((float*)(p.ws + (isv ? WS_VSC : WS_USC)))[r] = isc;
    }
  }
#else
  conv_range(p.peer_u, (u16*)(p.ws + WS_U), (size_t)16384 * DM / 8, bid, nb);
  conv_range(p.peer_v, (u16*)(p.ws + WS_V), (size_t)16384 * DM / 8, bid, nb);
#endif
}

#define ACC_ROW(e, hh) (((e) & 3) + 8 * ((e) >> 2) + 4 * (hh))
#define ACC_R0(e) (((e) & 3) + 8 * ((e) >> 2))
template <int V> struct IC { static constexpr int value = V; };
struct SmemGemm { u16 a[2][128 * 64]; u16 b[2][128 * 64]; };

template <int ROWS>
struct GldsBf16 {
  const u16* base; int ld;
  DI void issue(int kt, u16* lds, int tid) {
    const int wid = tid >> 6, lane = tid & 63;
    constexpr int NCH = ROWS / 32;
#pragma unroll
    for (int q = 0; q < NCH; ++q) {
      const int ch = wid * NCH + q;
      const int r = ch * 8 + (lane >> 3);
      const int c = (lane & 7) ^ ((r >> 1) & 7);
      __builtin_amdgcn_global_load_lds((const unsigned*)(base + (size_t)r * ld + kt * 64 + c * 8), (unsigned*)(lds + ch * 512), 16, 0, 0);
    }
  }
  DI void commit(u16*, int) {}
};
#ifndef GEMM_REG2
#define GEMM_REG2 1
#endif
#if GEMM_REG2
typedef unsigned u32x4 __attribute__((ext_vector_type(4)));
template <int ROWS>
struct LdReg {
  static constexpr int N = ROWS / 32;
  const u16* base; int ld;
  u32x4 r0, r1, r2, r3;
  DI const u32x4* src(int kt, int tid, int i) const { const int c = tid + 256 * i; return (const u32x4*)(base + (size_t)(c >> 3) * ld + kt * 64 + (c & 7) * 8); }
  DI static u32x4* dst(u16* lds, int tid, int i) { const int c = tid + 256 * i; const int row = c >> 3; return (u32x4*)(lds + row * 64 + (((c & 7) ^ ((row >> 1) & 7)) * 8)); }
  DI void fetch(int kt, int tid) {
    r0 = *src(kt, tid, 0); r1 = *src(kt, tid, 1);
    if (N > 2) { r2 = *src(kt, tid, 2); r3 = *src(kt, tid, 3); }
  }
  DI void stash(u16* lds, int tid) const {
    *dst(lds, tid, 0) = r0; *dst(lds, tid, 1) = r1;
    if (N > 2) { *dst(lds, tid, 2) = r2; *dst(lds, tid, 3) = r3; }
  }
};
template <int MI, bool GRMS>
DI void gemm_compute(const u16* pa, const u16* pb, f32x16 (&acc)[MI][MI], int o0, int o1, int o2, int o3, int wr, int hh, bool scale_now, const float* rsc) {
  if (GRMS && scale_now) {
#pragma unroll
    for (int i = 0; i < MI; ++i)
#pragma unroll
      for (int e = 0; e < 16; ++e) {
        const float rt = rsc[((wr * MI + i) * 32 + ACC_ROW(e, hh)) * 2];
#pragma unroll
        for (int j = 0; j < MI; ++j) acc[i][j][e] *= rt;
      }
  }
  const int off[4] = {o0, o1, o2, o3};
  bf16x8 af[2][MI], bfr[2][MI];
#pragma unroll
  for (int i = 0; i < MI; ++i) { af[0][i] = *(const bf16x8*)(pa + i * 32 * 64 + off[0]); bfr[0][i] = *(const bf16x8*)(pb + i * 32 * 64 + off[0]); }
#pragma unroll
  for (int kk = 0; kk < 4; ++kk) {
    if (kk < 3) {
#pragma unroll
      for (int i = 0; i < MI; ++i) { af[(kk + 1) & 1][i] = *(const bf16x8*)(pa + i * 32 * 64 + off[kk + 1]); bfr[(kk + 1) & 1][i] = *(const bf16x8*)(pb + i * 32 * 64 + off[kk + 1]); }
    }
#pragma unroll
    for (int i = 0; i < MI; ++i)
#pragma unroll
      for (int j = 0; j < MI; ++j) acc[i][j] = MFMA(af[kk & 1][i], bfr[kk & 1][j], acc[i][j]);
  }
}
template <int MI, bool GRMS = false, class AL, class EPI>
DI void gemm_tile(AL& al, const u16* Bt, int ldb, int K, int m0, int n0, EPI epi, char* smem, const float* rsc = nullptr) {
  SmemGemm& sm = *(SmemGemm*)smem;
  const int tid = threadIdx.x, lane = tid & 63, wid = tid >> 6, wr = wid >> 1, wc = wid & 1, r31 = lane & 31, hh = lane >> 5;
  LdReg<MI * 64> a0, a1, b0, b1;
  a0.base = al.base; a0.ld = al.ld; a1.base = al.base; a1.ld = al.ld;
  b0.base = Bt + (size_t)n0 * ldb; b0.ld = ldb; b1.base = b0.base; b1.ld = ldb;
  f32x16 acc[MI][MI];
#pragma unroll
  for (int i = 0; i < MI; ++i)
#pragma unroll
    for (int j = 0; j < MI; ++j)
#pragma unroll
      for (int e = 0; e < 16; ++e) acc[i][j][e] = 0.f;
  int off[4];
#pragma unroll
  for (int kk = 0; kk < 4; ++kk) off[kk] = r31 * 64 + (((kk * 2 + hh) ^ ((r31 >> 1) & 7)) * 8);
  const int KT = K >> 6;
  a0.fetch(0, tid); b0.fetch(0, tid);
  a1.fetch(1, tid); b1.fetch(1, tid);
  a0.stash(sm.a[0], tid); b0.stash(sm.b[0], tid);
  __syncthreads();
  for (int kt = 0; kt < KT; kt += 2) {
    { const int kn = min(kt + 2, KT - 1); a0.fetch(kn, tid); b0.fetch(kn, tid); }
    gemm_compute<MI, GRMS>(sm.a[0] + (wr * MI * 32) * 64, sm.b[0] + (wc * MI * 32) * 64, acc, off[0], off[1], off[2], off[3], wr, hh, kt == (KT >> 1), rsc);
    a1.stash(sm.a[1], tid); b1.stash(sm.b[1], tid);
    __syncthreads();
    { const int kn = min(kt + 3, KT - 1); a1.fetch(kn, tid); b1.fetch(kn, tid); }
    gemm_compute<MI, GRMS>(sm.a[1] + (wr * MI * 32) * 64, sm.b[1] + (wc * MI * 32) * 64, acc, off[0], off[1], off[2], off[3], wr, hh, (kt + 1) == (KT >> 1), rsc);
    a0.stash(sm.a[0], tid); b0.stash(sm.b[0], tid);
    __syncthreads();
  }
  if (GRMS) {
#pragma unroll
    for (int i = 0; i < MI; ++i)
#pragma unroll
      for (int e = 0; e < 16; ++e) {
        const float s1 = rsc[((wr * MI + i) * 32 + ACC_ROW(e, hh)) * 2 + 1];
#pragma unroll
        for (int j = 0; j < MI; ++j) acc[i][j][e] *= s1;
      }
  }
#pragma unroll
  for (int i = 0; i < MI; ++i)
#pragma unroll
    for (int j = 0; j < MI; ++j) epi(m0 + (wr * MI + i) * 32, n0 + (wc * MI + j) * 32, acc[i][j]);
}
#else
template <int MI, bool GRMS = false, class AL, class EPI>
DI void gemm_tile(AL& al, const u16* Bt, int ldb, int K, int m0, int n0, EPI epi, char* smem, const float* rsc = nullptr) {
  SmemGemm& sm = *(SmemGemm*)smem;
  const int tid = threadIdx.x, lane = tid & 63, wid = tid >> 6, wr = wid >> 1, wc = wid & 1, r31 = lane & 31, hh = lane >> 5;
  GldsBf16<MI * 64> bl; bl.base = Bt + (size_t)n0 * ldb; bl.ld = ldb;
  f32x16 acc[MI][MI];
#pragma unroll
  for (int i = 0; i < MI; ++i)
#pragma unroll
    for (int j = 0; j < MI; ++j)
#pragma unroll
      for (int e = 0; e < 16; ++e) acc[i][j][e] = 0.f;
  int off[4];
#pragma unroll
  for (int kk = 0; kk < 4; ++kk) off[kk] = r31 * 64 + (((kk * 2 + hh) ^ ((r31 >> 1) & 7)) * 8);
  const int KT = K >> 6;
  al.issue(0, sm.a[0], tid); bl.issue(0, sm.b[0], tid);
  al.commit(sm.a[0], tid);
  asm volatile("s_waitcnt vmcnt(0)" ::: "memory");
  __syncthreads();
  for (int kt = 0; kt < KT; ++kt) {
    const int cur = kt & 1;
    if (kt + 1 < KT) { al.issue(kt + 1, sm.a[cur ^ 1], tid); bl.issue(kt + 1, sm.b[cur ^ 1], tid); }
    const u16* pa = sm.a[cur] + (wr * MI * 32) * 64;
    const u16* pb = sm.b[cur] + (wc * MI * 32) * 64;
    if (GRMS && kt == (KT >> 1)) {
#pragma unroll
      for (int i = 0; i < MI; ++i)
#pragma unroll
        for (int e = 0; e < 16; ++e) {
          const float rt = rsc[((wr * MI + i) * 32 + ACC_ROW(e, hh)) * 2];
#pragma unroll
          for (int j = 0; j < MI; ++j) acc[i][j][e] *= rt;
        }
    }
#pragma unroll
    for (int kk = 0; kk < 4; ++kk) {
      bf16x8 af[MI], bfr[MI];
#pragma unroll
      for (int i = 0; i < MI; ++i) { af[i] = *(const bf16x8*)(pa + i * 32 * 64 + off[kk]); bfr[i] = *(const bf16x8*)(pb + i * 32 * 64 + off[kk]); }
#pragma unroll
      for (int i = 0; i < MI; ++i)
#pragma unroll
        for (int j = 0; j < MI; ++j) acc[i][j] = MFMA(af[i], bfr[j], acc[i][j]);
    }
    if (kt + 1 < KT) al.commit(sm.a[cur ^ 1], tid);
    asm volatile("s_waitcnt vmcnt(0)" ::: "memory");
    __syncthreads();
  }
  if (GRMS) {
#pragma unroll
    for (int i = 0; i < MI; ++i)
#pragma unroll
      for (int e = 0; e < 16; ++e) {
        const float s1 = rsc[((wr * MI + i) * 32 + ACC_ROW(e, hh)) * 2 + 1];
#pragma unroll
        for (int j = 0; j < MI; ++j) acc[i][j][e] *= s1;
      }
  }
#pragma unroll
  for (int i = 0; i < MI; ++i)
#pragma unroll
    for (int j = 0; j < MI; ++j) epi(m0 + (wr * MI + i) * 32, n0 + (wc * MI + j) * 32, acc[i][j]);
}
#endif
template <class F>
DI void for_tiles(int N, F body) {
  const int vb = vblock(), nb = gridDim.x;
  const int ntn = N >> 7, ntn2 = N >> 6;
  const int nbig = 256 * ntn, nsmall = 16 * ntn2;
  for (int t = vb; t < nbig + nsmall; t += nb) {
    if (t < nbig) { body((t / ntn) * 128, (t % ntn) * 128, IC<2>{}); }
    else { const int u = t - nbig; body(NTP + (u / ntn2) * 64, (u % ntn2) * 64, IC<1>{}); }
  }
}

DI void phase_proj(const Params& p, char* smem) {
  const int vb = vblock(), nb = gridDim.x;
  constexpr int T_G1 = 264 * 25, T_MKV = 32 * 16;
  float* out = p.out;
  for (int t = vb; t < T_G1 + T_MKV; t += nb) {
    if (t < T_G1) {
      const int mt = t / 25, nt = t % 25;
      const int m0 = mt * 128, n0 = nt * 128;
      GldsBf16<128> al; al.base = (const u16*)(p.ws + WS_C) + (size_t)m0 * DM; al.ld = DM;
      const bool smp = m0 >= NTP;
      const float* b_f = p.b_f;
      u16* qsb = (u16*)(p.ws + WS_D);
      u16* qfx = qsb + (size_t)NT * 512;
      char* ws = p.ws;
      auto epi = [=](int r0, int c0, const f32x16& acc) {
        const int lane = threadIdx.x & 63, hh = lane >> 5, col = c0 + (lane & 31);
        const int seg = c0 >> 9, cc = col & 511;
        if (seg == 0 || seg == 3) {
          u16* q = (seg == 0) ? qsb : qfx;
#pragma unroll
          for (int e = 0; e < 16; ++e) q[(unsigned)(r0 + 4 * hh) * 512u + cc + ACC_R0(e) * 512u] = bf1(acc[e] * 0.125f);
        } else if (seg < 6) {
          size_t ob;
          if (!smp) ob = (seg == 1) ? OUT_SBK_P : (seg == 2) ? OUT_SBV_P : (seg == 4) ? OUT_FXK_P : OUT_FXV_P;
          else ob = (seg == 1) ? OUT_SBK_S : (seg == 2) ? OUT_SBV_S : (seg == 4) ? OUT_FXK_S : OUT_FXV_S;
          const int rb = smp ? r0 - NTP : r0;
          float* ov = out + ob;
          const unsigned b0 = (unsigned)(rb + 4 * hh) * 512u + cc;
#pragma unroll
          for (int e = 0; e < 16; ++e) ov[b0 + ACC_R0(e) * 512u] = acc[e];
          if (!smp) {
            if (seg == 1 || seg == 4) {
              u16* k16 = (u16*)(ws + WS_A) + (seg == 4 ? (size_t)NTP * 512 : 0);
#pragma unroll
              for (int e = 0; e < 16; ++e) k16[b0 + ACC_R0(e) * 512u] = bf1(acc[e]);
            } else {
              u16* vt16 = (u16*)(ws + WS_B) + (seg == 5 ? (size_t)NTP * 512 : 0);
              const unsigned vb0 = (unsigned)(((r0 >> 11) * 8 + (cc >> 6)) * 64 + (cc & 63)) * 2048u + (unsigned)(r0 & 2047) + 4 * hh;
#pragma unroll
              for (int g4 = 0; g4 < 4; ++g4) *(uint2*)(vt16 + vb0 + 8 * g4) = make_uint2(pk2(acc[4 * g4], acc[4 * g4 + 1]), pk2(acc[4 * g4 + 2], acc[4 * g4 + 3]));
            }
          }
        } else {
          const int c = col - 3072;
          if (c < 8) {
            const float bf = b_f[c];
            const size_t ob = smp ? OUT_LF_S : OUT_LF_P;
            const int rb = smp ? r0 - NTP : r0;
#pragma unroll
            for (int e = 0; e < 16; ++e) {
              const float z = acc[e] + bf;
              const float ls = fminf(z, 0.f) - log1pf(__expf(-fabsf(z)));
              out[ob + (unsigned)(rb + ACC_ROW(e, hh)) * 8u + c] = ls;
            }
          }
        }
      };
      gemm_tile<2>(al, (const u16*)(p.ws + WS_WIN), DM, DM, m0, n0, epi, smem);
    } else {
      const int u = t - T_G1;
      const int mt = u >> 4, nt = u & 15;
      const int m0 = mt * 128, n0 = nt * 128;
      GldsBf16<128> al; al.base = (const u16*)(p.ws + WS_E) + (size_t)m0 * DM; al.ld = DM;
      u16* kb = (u16*)(p.ws + WS_MEMK);
      u16* vt = (u16*)(p.ws + WS_MEMVT);
      auto epi = [=](int r0, int c0, const f32x16& acc) {
        const int lane = threadIdx.x & 63, hh = lane >> 5, col = c0 + (lane & 31);
        if (c0 < 1024) {
          float* ov = out + OUT_MK_P;
          const unsigned b0 = (unsigned)(r0 + 4 * hh) * 1024u + col;
#pragma unroll
          for (int e = 0; e < 16; ++e) { const unsigned idx = b0 + ACC_R0(e) * 1024u; ov[idx] = acc[e]; kb[idx] = bf1(acc[e]); }
        } else {
          const int c = col - 1024;
          float* ov = out + OUT_MV_P;
          const unsigned b0 = (unsigned)(r0 + 4 * hh) * 1024u + c;
#pragma unroll
          for (int e = 0; e < 16; ++e) ov[b0 + ACC_R0(e) * 1024u] = acc[e];
          const int b = r0 >> 8;
#pragma unroll
          for (int g4 = 0; g4 < 4; ++g4) {
            const int m = (r0 & 255) + 8 * g4 + 4 * hh;
            *(uint2*)(vt + ((size_t)b * DM + c) * 256 + m) = make_uint2(pk2(acc[4 * g4], acc[4 * g4 + 1]), pk2(acc[4 * g4 + 2], acc[4 * g4 + 3]));
          }
        }
      };
      gemm_tile<2>(al, (const u16*)(p.ws + WS_WMKV), DM, DM, m0, n0, epi, smem);
    }
  }
}

template <int PER>
DI void scan_one(const float* src0, int n0, const float* src1, int n, float* dst, float* part) {
  const int tid = threadIdx.x;
  const int s0 = tid * PER;
  float v[PER];
#pragma unroll
  for (int i = 0; i < PER; ++i) { const int s = s0 + i; v[i] = (s < n) ? ((s < n0) ? src0[(size_t)s * 8] : src1[(size_t)(s - n0) * 8]) : 0.f; }
  float loc = 0.f;
#pragma unroll
  for (int i = 0; i < PER; ++i) loc += v[i];
  part[tid] = loc;
  __syncthreads();
  float run = 0.f;
  for (int i = 0; i < tid; ++i) run += part[i];
#pragma unroll
  for (int i = 0; i < PER; ++i) { run += v[i]; if (s0 + i < n) dst[s0 + i] = -run * LOG2E; }
  __syncthreads();
}
DI void phase_scan(const Params& p, char* smem) {
  float* part = (float*)smem;
  for (int it = blockIdx.x; it < 256; it += gridDim.x) {
    const int bh = it & 127, b = bh >> 3, h = bh & 7;
    if (it < 128) scan_one<17>(p.c_fx_logf + (size_t)b * PAST * 8 + h, PAST, p.out + OUT_LF_S + (size_t)b * DSEQ * 8 + h, PAST + DSEQ, (float*)(p.ws + WS_CBS) + (size_t)bh * 4160, part);
    else scan_one<8>(p.out + OUT_LF_P + (size_t)b * SEQ * 8 + h, SEQ, nullptr, SEQ, (float*)(p.ws + WS_CBP) + (size_t)bh * 2048, part);
  }
}

constexpr int KLD = 72, VLD = 68;
struct SmemAttn { u16 k[2][64 * KLD]; u16 vt[2][64 * VLD]; float cb[4160]; float part[256]; u16 q[128 * KLD]; };
static_assert(sizeof(SmemAttn) <= SMEM_BYTES, "attn smem");

struct KVRegs { float4 k[4], v[4]; };
DI void kv_fetch(KVRegs& r, const float* kb, const float* vb, int tid) {
#pragma unroll
  for (int i = 0; i < 4; ++i) { const int c = tid + 256 * i; const size_t o = (size_t)(c >> 4) * 512 + (c & 15) * 4; r.k[i] = *(const float4*)(kb + o); r.v[i] = *(const float4*)(vb + o); }
}
DI void kv_stash(const KVRegs& r, u16* ks, u16* vts, int tid) {
#pragma unroll
  for (int i = 0; i < 4; ++i) {
    const int c = tid + 256 * i; const int row = c >> 4, c4 = (c & 15) * 4;
    *(uint2*)(ks + row * KLD + c4) = make_uint2(pk2(r.k[i].x, r.k[i].y), pk2(r.k[i].z, r.k[i].w));
    vts[(c4 + 0) * VLD + row] = bf1(r.v[i].x); vts[(c4 + 1) * VLD + row] = bf1(r.v[i].y);
    vts[(c4 + 2) * VLD + row] = bf1(r.v[i].z); vts[(c4 + 3) * VLD + row] = bf1(r.v[i].w);
  }
}
typedef unsigned kv_u32x4 __attribute__((ext_vector_type(4)));
typedef unsigned kv_u32x2 __attribute__((ext_vector_type(2)));
struct KV16 { kv_u32x4 k0, k1, v0, v1; };
DI void kv_fetch16(KV16& r, const u16* kb, const u16* vtb, int tid) {
  const int c0 = tid, c1 = tid + 256;
  r.k0 = *(const kv_u32x4*)(kb + (size_t)(c0 >> 3) * 512 + (c0 & 7) * 8); r.k1 = *(const kv_u32x4*)(kb + (size_t)(c1 >> 3) * 512 + (c1 & 7) * 8);
  r.v0 = *(const kv_u32x4*)(vtb + (size_t)(c0 >> 3) * SEQ + (c0 & 7) * 8); r.v1 = *(const kv_u32x4*)(vtb + (size_t)(c1 >> 3) * SEQ + (c1 & 7) * 8);
}
DI void kv_stash16(const KV16& r, u16* ks, u16* vts, int tid) {
  const int c0 = tid, c1 = tid + 256;
  *(kv_u32x4*)(ks + (c0 >> 3) * KLD + (c0 & 7) * 8) = r.k0;
  *(kv_u32x4*)(ks + (c1 >> 3) * KLD + (c1 & 7) * 8) = r.k1;
  kv_u32x2 a = {r.v0[0], r.v0[1]}, b2 = {r.v0[2], r.v0[3]}, c = {r.v1[0], r.v1[1]}, d = {r.v1[2], r.v1[3]};
  *(kv_u32x2*)(vts + (c0 >> 3) * VLD + (c0 & 7) * 8) = a; *(kv_u32x2*)(vts + (c0 >> 3) * VLD + (c0 & 7) * 8 + 4) = b2;
  *(kv_u32x2*)(vts + (c1 >> 3) * VLD + (c1 & 7) * 8) = c; *(kv_u32x2*)(vts + (c1 >> 3) * VLD + (c1 & 7) * 8 + 4) = d;
}
DI bf16x8 pack8(const f32x16& x, int s) {
  union { unsigned u[4]; bf16x8 v; } t;
  t.u[0] = pk2(x[8 * s + 0], x[8 * s + 1]); t.u[1] = pk2(x[8 * s + 2], x[8 * s + 3]);
  t.u[2] = pk2(x[8 * s + 4], x[8 * s + 5]); t.u[3] = pk2(x[8 * s + 6], x[8 * s + 7]);
  return t.v;
}

template <bool FOX, bool SMP>
DI void attn_item(const Params& p, int b, int h, int qb, char* smem, bool do_ssq = true, int split = 0) {
  constexpr int smp = SMP ? 1 : 0;
  constexpr bool SPLIT = FOX && SMP;
  SmemAttn& sm = *(SmemAttn*)smem;
  const int tid = threadIdx.x, lane = tid & 63, wid = tid >> 6, r31 = lane & 31, hh = lane >> 5;
  const int jt0 = SPLIT ? split * 8 : 0;
  const int nkt = SPLIT ? (split == 7 ? 9 : 8) : (smp ? 65 : 2 * qb + 2);
  const int jdiag = smp ? 64 : 2 * qb;
  int qi = wid * 32 + r31; if (smp) qi &= 63;
  const int qpos = (smp ? PAST : qb * 128) + qi;
  const int g = smp ? NTP + b * DSEQ + qi : b * SEQ + qb * 128 + qi;
  const u16* Q = (const u16*)(p.ws + WS_D) + (FOX ? (size_t)NT * 512 : 0);
  {
#pragma unroll
    for (int i = 0; i < 4; ++i) {
      const int c = tid + 256 * i; const int row = c >> 3, kc = (c & 7) * 8;
      const int qr = smp ? (row & 63) : row;
      const int gr = smp ? NTP + b * DSEQ + qr : b * SEQ + qb * 128 + qr;
      *(kv_u32x4*)(sm.q + row * KLD + kc) = *(const kv_u32x4*)(Q + (size_t)gr * 512 + h * 64 + kc);
    }
    __syncthreads();
  }

  const float* kcache = FOX ? p.c_fx_k : p.c_sb_k;
  const float* vcache = FOX ? p.c_fx_v : p.c_sb_v;
  const size_t okp = FOX ? OUT_FXK_P : OUT_SBK_P, ovp = FOX ? OUT_FXV_P : OUT_SBV_P;
  const size_t oks = FOX ? OUT_FXK_S : OUT_SBK_S, ovs = FOX ? OUT_FXV_S : OUT_SBV_S;
  auto kptr = [&](int j) -> const float* {
    if (!smp) return p.out + okp + ((size_t)(b * SEQ + 64 * j) * 512 + h * 64);
    if (j < 64) return kcache + ((size_t)(b * PAST + 64 * j) * 512 + h * 64);
    return p.out + oks + ((size_t)(b * DSEQ) * 512 + h * 64);
  };
  auto vptr = [&](int j) -> const float* {
    if (!smp) return p.out + ovp + ((size_t)(b * SEQ + 64 * j) * 512 + h * 64);
    if (j < 64) return vcache + ((size_t)(b * PAST + 64 * j) * 512 + h * 64);
    return p.out + ovs + ((size_t)(b * DSEQ) * 512 + h * 64);
  };

  if (FOX) {
    const float4* src = (const float4*)(smp ? (const float*)(p.ws + WS_CBS) + (size_t)(b * 8 + h) * 4160 : (const float*)(p.ws + WS_CBP) + (size_t)(b * 8 + h) * 2048);
    for (int i = jt0 * 16 + tid; i < (jt0 + nkt) * 16; i += 256) ((float4*)sm.cb)[i] = src[i];
    __syncthreads();
  }

  bf16x8 tri[2];
  if (!FOX) {
#pragma unroll
    for (int s = 0; s < 2; ++s)
#pragma unroll
      for (int j = 0; j < 8; ++j) { const int kin = 16 * s + 8 * (j >> 2) + 4 * hh + (j & 3); tri[s][j] = (kin >= r31) ? (short)0x3F80 : (short)0; }
  }

  f32x16 o[2];
#pragma unroll
  for (int d = 0; d < 2; ++d)
#pragma unroll
    for (int e = 0; e < 16; ++e) o[d][e] = 0.f;
  float mrun = -1e30f, lrun = 0.f, R = 0.f;

  KVRegs kv;
  KV16 kw;
  const int jfirst = FOX ? jt0 : nkt - 1;
  const u16* k16 = (const u16*)(p.ws + WS_A) + (FOX ? (size_t)NTP * 512 : 0) + (size_t)(b * SEQ) * 512 + h * 64;
  const u16* vt16 = (const u16*)(p.ws + WS_B) + (FOX ? (size_t)NTP * 512 : 0) + (size_t)((b * 8 + h) * 64) * SEQ;
  if (smp) { kv_fetch(kv, kptr(jfirst), vptr(jfirst), tid); kv_stash(kv, sm.k[0], sm.vt[0], tid); }
  else { kv_fetch16(kw, k16 + (size_t)(64 * jfirst) * 512, vt16 + 64 * jfirst, tid); kv_stash16(kw, sm.k[0], sm.vt[0], tid); }
  __syncthreads();
  for (int it = 0; it < nkt; ++it) {
    const int j = FOX ? jt0 + it : nkt - 1 - it;
    const int cur = it & 1;
    if (it + 1 < nkt) { const int jn = FOX ? j + 1 : j - 1; if (smp) kv_fetch(kv, kptr(jn), vptr(jn), tid); else kv_fetch16(kw, k16 + (size_t)(64 * jn) * 512, vt16 + 64 * jn, tid); }
    f32x16 s[2];
#pragma unroll
    for (int t2 = 0; t2 < 2; ++t2) {
#pragma unroll
      for (int e = 0; e < 16; ++e) s[t2][e] = 0.f;
      const u16* pk = sm.k[cur] + (t2 * 32 + r31) * KLD + hh * 8;
      const u16* pq = sm.q + (wid * 32 + r31) * KLD + hh * 8;
#pragma unroll
      for (int kk = 0; kk < 4; ++kk) { const bf16x8 a = *(const bf16x8*)(pk + kk * 16); const bf16x8 qv = *(const bf16x8*)(pq + kk * 16); s[t2] = MFMA(a, qv, s[t2]); }
    }
    const bool diag = j >= jdiag;
    const int kbase = 64 * j + 4 * hh;
    if (FOX) {
      float mloc = -1e30f;
#pragma unroll
      for (int t2 = 0; t2 < 2; ++t2)
#pragma unroll
        for (int g4 = 0; g4 < 4; ++g4) {
          const float4 bb = *(const float4*)(sm.cb + 64 * j + 32 * t2 + 8 * g4 + 4 * hh);
          const float bv[4] = {bb.x, bb.y, bb.z, bb.w};
#pragma unroll
          for (int e = 0; e < 4; ++e) {
            float x = s[t2][4 * g4 + e] * LOG2E + bv[e];
            if (diag && (kbase + 32 * t2 + 8 * g4 + e > qpos)) x = -1e30f;
            s[t2][4 * g4 + e] = x;
            mloc = fmaxf(mloc, x);
          }
        }
      mloc = fmaxf(mloc, __shfl_xor(mloc, 32));
      const float mnew = fmaxf(mrun, mloc);
      const float alpha = exp2f(mrun - mnew);
      mrun = mnew;
      float ls = 0.f;
#pragma unroll
      for (int t2 = 0; t2 < 2; ++t2)
#pragma unroll
        for (int e = 0; e < 16; ++e) { const float pv = exp2f(s[t2][e] - mnew); s[t2][e] = pv; ls += pv; }
      lrun = lrun * alpha + ls;
#pragma unroll
      for (int d = 0; d < 2; ++d)
#pragma unroll
        for (int e = 0; e < 16; ++e) o[d][e] *= alpha;
    } else {
#pragma unroll
      for (int t2 = 1; t2 >= 0; --t2) {
        f32x16 lk;
#pragma unroll
        for (int e = 0; e < 16; ++e) {
          const float z = s[t2][e];
          const float sp = fmaxf(z, 0.f) + __logf(1.f + __expf(-fabsf(z)));
          const bool vis = !diag || (kbase + 32 * t2 + ACC_ROW(e, 0) < qpos);
          lk[e] = vis ? -sp : 0.f;
        }
        bf16x8 fh[2], fl[2];
#pragma unroll
        for (int sI = 0; sI < 2; ++sI) fh[sI] = pack8(lk, sI);
#pragma unroll
        for (int e = 0; e < 16; ++e) lk[e] -= __uint_as_float(((unsigned)(u16)fh[e >> 3][e & 7]) << 16);
#pragma unroll
        for (int sI = 0; sI < 2; ++sI) fl[sI] = pack8(lk, sI);
        f32x16 inc;
#pragma unroll
        for (int e = 0; e < 16; ++e) inc[e] = R;
#pragma unroll
        for (int sI = 0; sI < 2; ++sI) { inc = MFMA(tri[sI], fh[sI], inc); inc = MFMA(tri[sI], fl[sI], inc); }
#pragma unroll
        for (int e = 0; e < 16; ++e) {
          const bool vis = !diag || (kbase + 32 * t2 + ACC_ROW(e, 0) < qpos);
          const float w = exp2f((s[t2][e] + inc[e]) * LOG2E);
          s[t2][e] = vis ? w : 0.f;
        }
        R = __shfl(inc[0], r31);
      }
    }
#pragma unroll
    for (int t2 = 0; t2 < 2; ++t2)
#pragma unroll
      for (int sI = 0; sI < 2; ++sI) {
        const bf16x8 pf = pack8(s[t2], sI);
#pragma unroll
        for (int d = 0; d < 2; ++d) {
          const u16* pv = sm.vt[cur] + (d * 32 + r31) * VLD + 32 * t2 + 16 * sI + 4 * hh;
          union { s16x4 q[2]; bf16x8 v; } a;
          a.q[0] = *(const s16x4*)(pv); a.q[1] = *(const s16x4*)(pv + 8);
          o[d] = MFMA(a.v, pf, o[d]);
        }
      }
    if (it + 1 < nkt) { if (smp) kv_stash(kv, sm.k[cur ^ 1], sm.vt[cur ^ 1], tid); else kv_stash16(kw, sm.k[cur ^ 1], sm.vt[cur ^ 1], tid); }
#if SB_EXIT
    if (!FOX) { if (__syncthreads_and(R < -110.f)) break; } else __syncthreads();
#else
    __syncthreads();
#endif
  }
  if (SPLIT) {
    constexpr int NS = 8;
    const int bh = b * 8 + h;
    float* po = (float*)(p.ws + WS_F) + (size_t)(bh * NS) * 4096;
    float* pml = (float*)(p.ws + WS_F) + (size_t)128 * NS * 4096 + (size_t)(bh * NS) * 128;
    const float lt = lrun + __shfl_xor(lrun, 32);
    if (wid < 2) {
      float* dst = po + (size_t)split * 4096 + qi * 64;
#pragma unroll
      for (int d = 0; d < 2; ++d)
#pragma unroll
        for (int g4 = 0; g4 < 4; ++g4) *(float4*)(dst + d * 32 + 8 * g4 + 4 * hh) = make_float4(o[d][4 * g4], o[d][4 * g4 + 1], o[d][4 * g4 + 2], o[d][4 * g4 + 3]);
      if (hh == 0) *(float2*)(pml + (size_t)split * 128 + qi * 2) = make_float2(mrun, lt);
    }
    int* slot2 = (int*)(smem + 73728 + 528);
    asm volatile("s_waitcnt vmcnt(0)" ::: "memory");
    __syncthreads();
    if (tid == 0) {
      __builtin_amdgcn_fence(__ATOMIC_RELEASE, "agent");
      asm volatile("s_waitcnt vmcnt(0)" ::: "memory");
      const unsigned old = __hip_atomic_fetch_add((unsigned*)(p.ws + WS_BAR + 256) + bh + (do_ssq ? 0 : 128), 1u, __ATOMIC_RELAXED, __HIP_MEMORY_SCOPE_AGENT);
      __builtin_amdgcn_fence(__ATOMIC_ACQUIRE, "agent");
      asm volatile("s_waitcnt vmcnt(0)" ::: "memory");
      *slot2 = (int)old;
    }
    __syncthreads();
    const bool last = (*slot2 == NS - 1);
    __syncthreads();
    if (last) {
      const int q = tid >> 2, d0 = (tid & 3) * 16;
      float ms[NS], ls[NS], M = -1e30f;
#pragma unroll
      for (int s2 = 0; s2 < NS; ++s2) { const float2 ml = *(const float2*)(pml + (size_t)s2 * 128 + q * 2); ms[s2] = ml.x; ls[s2] = ml.y; M = fmaxf(M, ml.x); }
      float L = 0.f, acc[16];
#pragma unroll
      for (int k = 0; k < 16; ++k) acc[k] = 0.f;
#pragma unroll
      for (int s2 = 0; s2 < NS; ++s2) {
        const float w = exp2f(ms[s2] - M);
        L += ls[s2] * w;
        const float4* src = (const float4*)(po + (size_t)s2 * 4096 + q * 64 + d0);
#pragma unroll
        for (int k4 = 0; k4 < 4; ++k4) { const float4 v = src[k4]; acc[4 * k4] += w * v.x; acc[4 * k4 + 1] += w * v.y; acc[4 * k4 + 2] += w * v.z; acc[4 * k4 + 3] += w * v.w; }
      }
      const float invL = 1.f / L;
      float ssq = 0.f;
#pragma unroll
      for (int k = 0; k < 16; ++k) { acc[k] *= invL; ssq += acc[k] * acc[k]; }
      ssq += __shfl_xor(ssq, 1); ssq += __shfl_xor(ssq, 2);
      const int gq = NTP + b * DSEQ + q;
      if (do_ssq && (tid & 3) == 0) atomicAdd((float*)(p.ws + WS_SSQ) + (size_t)gq * 2 + 1, ssq);
      u16* od = (u16*)(p.ws + WS_E) + (size_t)gq * DM + 512 + h * 64 + d0;
      *(uint4*)od = make_uint4(pk2(acc[0], acc[1]), pk2(acc[2], acc[3]), pk2(acc[4], acc[5]), pk2(acc[6], acc[7]));
      *(uint4*)(od + 8) = make_uint4(pk2(acc[8], acc[9]), pk2(acc[10], acc[11]), pk2(acc[12], acc[13]), pk2(acc[14], acc[15]));
    }
    return;
  }
  float inv = 1.f;
  if (FOX) { const float lt = lrun + __shfl_xor(lrun, 32); inv = 1.f / lt; }
  {
    float ssq = 0.f;
#pragma unroll
    for (int d = 0; d < 2; ++d)
#pragma unroll
      for (int e = 0; e < 16; ++e) { const float t = o[d][e] * inv; ssq += t * t; }
    ssq += __shfl_xor(ssq, 32);
    if (do_ssq && hh == 0 && (!smp || wid < 2)) atomicAdd((float*)(p.ws + WS_SSQ) + (size_t)g * 2 + (FOX ? 1 : 0), ssq);
  }
  if (!smp || wid < 2) {
    u16* od = (u16*)(p.ws + WS_E) + (size_t)g * DM + (FOX ? 512 : 0) + h * 64;
#pragma unroll
    for (int d = 0; d < 2; ++d)
#pragma unroll
      for (int g4 = 0; g4 < 4; ++g4)
        *(uint2*)(od + d * 32 + 8 * g4 + 4 * hh) = make_uint2(pk2(o[d][4 * g4] * inv, o[d][4 * g4 + 1] * inv), pk2(o[d][4 * g4 + 2] * inv, o[d][4 * g4 + 3] * inv));
  }
}

template <class F>
DI void attn_queue(unsigned* ctr, int n, int* slot, F body) {
  for (;;) {
    if (threadIdx.x == 0) *slot = (int)atomicAdd(ctr, 1u);
    __syncthreads();
    const int it = *slot;
    __syncthreads();
    if (it >= n) break;
    body(it);
  }
}
DI void phase_attn(const Params& p, char* smem, int rep = 0) {
  unsigned* ctr = (unsigned*)(p.ws + WS_BAR + 128) + rep * 4;
  int* slot = (int*)(smem + 73728 + 512);
  const bool dq = rep == 0;
  attn_queue(ctr + 0, 1024, slot, [&](int it) { const int bh = it >> 3; attn_item<true, true>(p, bh >> 3, bh & 7, 0, smem, dq, it & 7); });
  attn_queue(ctr + 1, 2048, slot, [&](int u) { const int w = u & 511; const int qb = 15 - (w >> 5), bh = (u >> 9) * 32 + (w & 31); attn_item<true, false>(p, bh >> 3, bh & 7, qb, smem, dq); });
  attn_queue(ctr + 2, 128, slot, [&](int u) { attn_item<false, true>(p, u >> 3, u & 7, 0, smem, dq); });
  attn_queue(ctr + 3, 2048, slot, [&](int u) { const int w = u & 511; const int qb = 15 - (w >> 5), bh = (u >> 9) * 32 + (w & 31); attn_item<false, false>(p, bh >> 3, bh & 7, qb, smem, dq); });
}

DI void phase_wout(const Params& p, char* smem) {
  float* pre = (float*)(p.ws + WS_A);
  const u16* o = (const u16*)(p.ws + WS_E);
  float* sc_s = (float*)(smem + 73728);
  for_tiles(DM, [&](int m0, int n0, auto tag) {
    constexpr int MI = decltype(tag)::value;
    {
      const int tid = threadIdx.x;
      if (tid < MI * 64) {
        const float2 q = ((const float2*)(p.ws + WS_SSQ))[m0 + tid];
        const float s0 = rsqrtf(q.x * (1.f / 512.f) + 1e-6f), s1 = rsqrtf(q.y * (1.f / 512.f) + 1e-6f);
        sc_s[tid * 2] = s0 / s1; sc_s[tid * 2 + 1] = s1;
      }
      __syncthreads();
    }
    GldsBf16<MI * 64> al; al.base = o + (size_t)m0 * DM; al.ld = DM;
    const float* xr = xrow(p, m0);
    auto epi = [=](int r0, int c0, const f32x16& acc) {
      const int lane = threadIdx.x & 63, hh = lane >> 5, col = c0 + (lane & 31);
      const unsigned b0 = (unsigned)(r0 + 4 * hh) * 1024u + col, b1 = (unsigned)(r0 - m0 + 4 * hh) * 1024u + col;
#pragma unroll
      for (int e = 0; e < 16; ++e) pre[b0 + ACC_R0(e) * 1024u] = DN_ALPHA * xr[b1 + ACC_R0(e) * 1024u] + acc[e];
    };
    gemm_tile<MI, true>(al, (const u16*)(p.ws + WS_WOUT), DM, DM, m0, n0, epi, smem, sc_s);
  });
}

DI void phase_ln(const Params& p, const float* gam, const float* bet) {
  const float* pre = (const float*)(p.ws + WS_A);
  float* xf = (float*)(p.ws + WS_B);
  u16* xb = (u16*)(p.ws + WS_C);
  const int lane = threadIdx.x & 63;
  const int wg = blockIdx.x * 4 + (threadIdx.x >> 6), nw = gridDim.x * 4;
  for (int row0 = wg * 2; row0 < NT; row0 += nw * 2) {
    float4 v[2][4];
    float s[2], q[2];
#pragma unroll
    for (int r = 0; r < 2; ++r) {
      s[r] = 0.f;
#pragma unroll
      for (int j = 0; j < 4; ++j) { v[r][j] = ((const float4*)(pre + (size_t)(row0 + r) * DM))[lane + 64 * j]; s[r] += v[r][j].x + v[r][j].y + v[r][j].z + v[r][j].w; }
    }
#pragma unroll
    for (int o = 32; o >= 1; o >>= 1)
#pragma unroll
      for (int r = 0; r < 2; ++r) s[r] += __shfl_xor(s[r], o);
#pragma unroll
    for (int r = 0; r < 2; ++r) {
      s[r] *= (1.f / 1024.f); q[r] = 0.f;
#pragma unroll
      for (int j = 0; j < 4; ++j) { const float a = v[r][j].x - s[r], b2 = v[r][j].y - s[r], c = v[r][j].z - s[r], d = v[r][j].w - s[r]; q[r] += a * a + b2 * b2 + c * c + d * d; }
    }
#pragma unroll
    for (int o = 32; o >= 1; o >>= 1)
#pragma unroll
      for (int r = 0; r < 2; ++r) q[r] += __shfl_xor(q[r], o);
#pragma unroll
    for (int r = 0; r < 2; ++r) {
      const float mu = s[r], rs = rsqrtf(q[r] * (1.f / 1024.f) + 1e-5f);
#pragma unroll
      for (int j = 0; j < 4; ++j) {
        const float4 gg = ((const float4*)gam)[lane + 64 * j], bb = ((const float4*)bet)[lane + 64 * j];
        float4 y;
        y.x = (v[r][j].x - mu) * rs * gg.x + bb.x; y.y = (v[r][j].y - mu) * rs * gg.y + bb.y;
        y.z = (v[r][j].z - mu) * rs * gg.z + bb.z; y.w = (v[r][j].w - mu) * rs * gg.w + bb.w;
        ((float4*)(xf + (size_t)(row0 + r) * DM))[lane + 64 * j] = y;
        ((uint2*)(xb + (size_t)(row0 + r) * DM))[lane + 64 * j] = make_uint2(pk2(y.x, y.y), pk2(y.z, y.w));
      }
    }
  }
}

template <bool NOEPI = false>
DI void phase_gemm_bf16(const Params& p, const u16* A, const u16* Wt, int N, u16* O, float scale, char* smem) {
  for_tiles(N, [&](int m0, int n0, auto tag) {
    constexpr int MI = decltype(tag)::value;
    GldsBf16<MI * 64> al; al.base = A + (size_t)m0 * DM; al.ld = DM;
    auto epi = [=](int r0, int c0, const f32x16& acc) {
      const int lane = threadIdx.x & 63, hh = lane >> 5, col = c0 + (lane & 31);
      const unsigned b0 = (unsigned)(r0 + 4 * hh) * (unsigned)N + col;
      if (NOEPI) { float t = 0.f;
#pragma unroll
        for (int e = 0; e < 16; ++e) t += acc[e];
        if (t == 12345.678f) O[b0] = bf1(t);
        return; }
#pragma unroll
      for (int e = 0; e < 16; ++e) O[b0 + ACC_R0(e) * (unsigned)N] = bf1(acc[e] * scale);
    };
    gemm_tile<MI>(al, Wt, DM, DM, m0, n0, epi, smem);
  });
}

template <class F>
DI void for_mem_tiles(F body) {
  const int vb = vblock(), nb = gridDim.x;
  for (int t = vb; t < 2048 + 256; t += nb) {
    if (t < 2048) { const int mt = t >> 3; body(mt * 128, (t >> 1) & 3, (t & 1) * 128, mt >> 4, IC<2>{}); }
    else { const int u = t - 2048; const int mt = u >> 4; body(NTP + mt * 64, (u >> 2) & 3, (u & 3) * 64, 16 + mt, IC<1>{}); }
  }
}
DI void phase_mem_s(const Params& p, char* smem) {
  const u16* qm = (const u16*)(p.ws + WS_D);
  float* S = (float*)(p.ws + WS_F);
  for_mem_tiles([&](int m0, int hd, int n0, int batch, auto tag) {
    constexpr int MI = decltype(tag)::value;
    GldsBf16<MI * 64> al; al.base = qm + (size_t)m0 * DM + hd * 256; al.ld = DM;
    const u16* Bt = (const u16*)(p.ws + WS_MEMK) + (size_t)batch * 256 * DM + hd * 256;
    auto epi = [=](int r0, int c0, const f32x16& acc) {
      const int lane = threadIdx.x & 63, hh = lane >> 5, col = c0 + (lane & 31);
      const unsigned b0 = (unsigned)(r0 + 4 * hh) * 1024u + hd * 256 + col;
#pragma unroll
      for (int e = 0; e < 16; ++e) S[b0 + ACC_R0(e) * 1024u] = acc[e];
    };
    gemm_tile<MI>(al, Bt, DM, 256, m0, n0, epi, smem);
  });
}
DI void phase_mem_softmax(const Params& p) {
  const float* S = (const float*)(p.ws + WS_F);
  u16* P = (u16*)(p.ws + WS_D);
  const int lane = threadIdx.x & 63;
  const int wg = blockIdx.x * 4 + (threadIdx.x >> 6), nw = gridDim.x * 4;
  for (int row0 = wg * 4; row0 < NT * 4; row0 += nw * 4) {
    float4 v[4]; float m[4], sm[4];
#pragma unroll
    for (int r = 0; r < 4; ++r) v[r] = ((const float4*)(S + (size_t)(row0 + r) * 256))[lane];
#pragma unroll
    for (int r = 0; r < 4; ++r) m[r] = fmaxf(fmaxf(v[r].x, v[r].y), fmaxf(v[r].z, v[r].w));
#pragma unroll
    for (int o = 32; o >= 1; o >>= 1)
#pragma unroll
      for (int r = 0; r < 4; ++r) m[r] = fmaxf(m[r], __shfl_xor(m[r], o));
#pragma unroll
    for (int r = 0; r < 4; ++r) { v[r].x = __expf(v[r].x - m[r]); v[r].y = __expf(v[r].y - m[r]); v[r].z = __expf(v[r].z - m[r]); v[r].w = __expf(v[r].w - m[r]); sm[r] = v[r].x + v[r].y + v[r].z + v[r].w; }
#pragma unroll
    for (int o = 32; o >= 1; o >>= 1)
#pragma unroll
      for (int r = 0; r < 4; ++r) sm[r] += __shfl_xor(sm[r], o);
#pragma unroll
    for (int r = 0; r < 4; ++r) { const float inv = 1.f / sm[r]; ((uint2*)(P + (size_t)(row0 + r) * 256))[lane] = make_uint2(pk2(v[r].x * inv, v[r].y * inv), pk2(v[r].z * inv, v[r].w * inv)); }
  }
}
DI void phase_mem_pv(const Params& p, char* smem) {
  const u16* P = (const u16*)(p.ws + WS_D);
  u16* om = (u16*)(p.ws + WS_E);
  for_mem_tiles([&](int m0, int hd, int n0, int batch, auto tag) {
    constexpr int MI = decltype(tag)::value;
    GldsBf16<MI * 64> al; al.base = P + (size_t)m0 * DM + hd * 256; al.ld = DM;
    const u16* Bt = (const u16*)(p.ws + WS_MEMVT) + ((size_t)batch * DM + hd * 256) * 256;
    auto epi = [=](int r0, int c0, const f32x16& acc) {
      const int lane = threadIdx.x & 63, hh = lane >> 5, col = c0 + (lane & 31);
      const unsigned b0 = (unsigned)(r0 + 4 * hh) * 1024u + hd * 256 + col;
#pragma unroll
      for (int e = 0; e < 16; ++e) om[b0 + ACC_R0(e) * 1024u] = bf1(acc[e]);
    };
    gemm_tile<MI>(al, Bt, 256, 256, m0, n0, epi, smem);
  });
}
DI void phase_wmo(const Params& p, char* smem) {
  float* pre = (float*)(p.ws + WS_A);
  const float* xf = (const float*)(p.ws + WS_B);
  const u16* om = (const u16*)(p.ws + WS_E);
  for_tiles(DM, [&](int m0, int n0, auto tag) {
    constexpr int MI = decltype(tag)::value;
    GldsBf16<MI * 64> al; al.base = om + (size_t)m0 * DM; al.ld = DM;
    auto epi = [=](int r0, int c0, const f32x16& acc) {
      const int lane = threadIdx.x & 63, hh = lane >> 5, col = c0 + (lane & 31);
      const unsigned b0 = (unsigned)(r0 + 4 * hh) * 1024u + col;
#pragma unroll
      for (int e = 0; e < 16; ++e) { const unsigned i = b0 + ACC_R0(e) * 1024u; pre[i] = DN_ALPHA * xf[i] + acc[e]; }
    };
    gemm_tile<MI>(al, (const u16*)(p.ws + WS_WMO), DM, DM, m0, n0, epi, smem);
  });
}

DI void insert16(float (&v)[16], float x) {
#pragma unroll
  for (int j = 15; j >= 1; --j) v[j] = __builtin_amdgcn_fmed3f(x, v[j - 1], v[j]);
  v[0] = fmaxf(v[0], x);
}
DI void phase_topk(const Params& p, char* smem) {
  const int vb = vblock(), nb = gridDim.x;
  const u16* qp = (const u16*)(p.ws + WS_F);
  int* idxo = (int*)(p.ws + WS_A);
  float* gato = (float*)(p.ws + WS_A + (size_t)NT * 128 * 4);
  float* sc = (float*)smem;
  const int tid = threadIdx.x;
  for (int t = vb; t < 264 * 8; t += nb) {
    const int mt = t >> 3, hd = t & 7;
    const int m0 = mt * 128;
    float va[16], vbv[16];
#pragma unroll
    for (int side = 0; side < 2; ++side) {
      GldsBf16<128> al; al.base = qp + (size_t)m0 * 2048 + hd * 256 + side * 128; al.ld = 2048;
      const u16* Bt = (const u16*)(p.ws + (side ? WS_KB : WS_KA)) + (size_t)hd * 128 * 128;
      auto epi = [=](int r0, int c0, const f32x16& acc) {
        const int lane = threadIdx.x & 63, hh = lane >> 5, col = c0 + (lane & 31);
#pragma unroll
        for (int e = 0; e < 16; ++e) sc[(r0 - m0 + ACC_ROW(e, hh)) * 129 + col] = acc[e];
      };
      gemm_tile<2>(al, Bt, 128, 128, m0, 0, epi, smem);
      __syncthreads();
      if (tid < 128) {
        float v[16];
#pragma unroll
        for (int j = 0; j < 16; ++j) v[j] = -INFINITY;
        for (int k = 0; k < 128; ++k) {
          const float x = __uint_as_float((__float_as_uint(sc[tid * 129 + k]) & ~0x7Fu) | (unsigned)k);
          insert16(v, x);
        }
#pragma unroll
        for (int j = 0; j < 16; ++j) { if (side == 0) va[j] = v[j]; else vbv[j] = v[j]; }
      }
      __syncthreads();
    }
    unsigned char* ids = (unsigned char*)smem;
    if (tid < 128) {
#pragma unroll
      for (int j = 0; j < 16; ++j) { ids[tid * 32 + j] = (unsigned char)(__float_as_uint(va[j]) & 0x7F); ids[tid * 32 + 16 + j] = (unsigned char)(__float_as_uint(vbv[j]) & 0x7F); }
      float top[16];
#pragma unroll
      for (int j = 0; j < 16; ++j) top[j] = -INFINITY;
#pragma unroll
      for (int i = 0; i < 16; ++i)
#pragma unroll
        for (int j = 0; j < 16; ++j)
          if ((i + 1) * (j + 1) <= 16) {
            const float a = __uint_as_float(__float_as_uint(va[i]) & ~0x7Fu), b = __uint_as_float(__float_as_uint(vbv[j]) & ~0x7Fu);
            const float c = __uint_as_float((__float_as_uint(a + b) & ~0xFFu) | (unsigned)(i * 16 + j));
            insert16(top, c);
          }
      const float m = __uint_as_float(__float_as_uint(top[0]) & ~0xFFu);
      float ex[16], ssum = 0.f;
      int eid[16];
#pragma unroll
      for (int j = 0; j < 16; ++j) {
        const unsigned bits = __float_as_uint(top[j]);
        const int code = bits & 0xFF;
        ex[j] = __expf(__uint_as_float(bits & ~0xFFu) - m); ssum += ex[j];
        eid[j] = (int)ids[tid * 32 + (code >> 4)] * 128 + (int)ids[tid * 32 + 16 + (code & 15)];
      }
      const float inv = 1.f / ssum;
      const size_t ob = (size_t)(m0 + tid) * 128 + hd * 16;
#pragma unroll
      for (int j4 = 0; j4 < 4; ++j4) {
        *(int4*)(idxo + ob + 4 * j4) = make_int4(eid[4 * j4], eid[4 * j4 + 1], eid[4 * j4 + 2], eid[4 * j4 + 3]);
        *(float4*)(gato + ob + 4 * j4) = make_float4(ex[4 * j4] * inv, ex[4 * j4 + 1] * inv, ex[4 * j4 + 2] * inv, ex[4 * j4 + 3] * inv);
      }
    }
    __syncthreads();
  }
}

#if USE_FP8
typedef float f32x2v __attribute__((ext_vector_type(2)));
DI void unpack16(const uint4& v, float (&f)[16]) {
  const unsigned w[4] = {v.x, v.y, v.z, v.w};
#pragma unroll
  for (int j = 0; j < 4; ++j) {
    const f32x2v lo = __builtin_amdgcn_cvt_pk_f32_fp8((int)w[j], false), hi = __builtin_amdgcn_cvt_pk_f32_fp8((int)w[j], true);
    f[4 * j] = lo[0]; f[4 * j + 1] = lo[1]; f[4 * j + 2] = hi[0]; f[4 * j + 3] = hi[1];
  }
}
DI void peer_dot8(const char* U, int idreg, int e0, int lane, const float (&x)[16], float& dacc) {
  uint4 w[8];
#pragma unroll
  for (int j = 0; j < 8; ++j) { const int id = __builtin_amdgcn_readlane(idreg, e0 + j); w[j] = *(const uint4*)(U + (size_t)id * DM + 16 * lane); }
  float s[8];
#pragma unroll
  for (int j = 0; j < 8; ++j) {
    float f[16]; unpack16(w[j], f);
    float a = 0.f;
#pragma unroll
    for (int k = 0; k < 16; ++k) a += f[k] * x[k];
    s[j] = a;
  }
  const bool b5 = lane & 32, b4 = lane & 16, b3 = lane & 8;
  float t4[4], t2[2], t1;
#pragma unroll
  for (int i = 0; i < 4; ++i) { const float snd = b5 ? s[i] : s[4 + i], kp = b5 ? s[4 + i] : s[i]; t4[i] = kp + __shfl_xor(snd, 32); }
#pragma unroll
  for (int i = 0; i < 2; ++i) { const float snd = b4 ? t4[i] : t4[2 + i], kp = b4 ? t4[2 + i] : t4[i]; t2[i] = kp + __shfl_xor(snd, 16); }
  { const float snd = b3 ? t2[0] : t2[1], kp = b3 ? t2[1] : t2[0]; t1 = kp + __shfl_xor(snd, 8); }
  t1 += __shfl_xor(t1, 4); t1 += __shfl_xor(t1, 2); t1 += __shfl_xor(t1, 1);
  const float g = __shfl(t1, (lane & 7) * 8);
  if ((lane >> 3) == (e0 >> 3)) dacc = g;
}
DI void peer_axpy8(const char* V, int idreg, float hreg, int e0, int lane, float (&acc)[16]) {
  uint4 w[8];
#pragma unroll
  for (int j = 0; j < 8; ++j) { const int id = __builtin_amdgcn_readlane(idreg, e0 + j); w[j] = *(const uint4*)(V + (size_t)id * DM + 16 * lane); }
#pragma unroll
  for (int j = 0; j < 8; ++j) {
    const float hs = __uint_as_float(__builtin_amdgcn_readlane(__float_as_uint(hreg), e0 + j));
    float f[16]; unpack16(w[j], f);
#pragma unroll
    for (int k = 0; k < 16; ++k) acc[k] += hs * f[k];
  }
}
DI void phase_peer(const Params& p) {
  const float* xf = (const float*)(p.ws + WS_B);
  const int* idxo = (const int*)(p.ws + WS_A);
  const float* gato = (const float*)(p.ws + WS_A + (size_t)NT * 128 * 4);
  const char* U = p.ws + WS_U;
  const char* V = p.ws + WS_V;
  const float* usc = (const float*)(p.ws + WS_USC);
  const float* vsc = (const float*)(p.ws + WS_VSC);
  const int lane = threadIdx.x & 63;
  const int wg = blockIdx.x * 4 + (threadIdx.x >> 6), nw = gridDim.x * 4;
  for (int row = wg; row < NT; row += nw) {
    float x[16];
    {
      const float4* xr = (const float4*)(xf + (size_t)row * DM) + 4 * lane;
#pragma unroll
      for (int j = 0; j < 4; ++j) { const float4 a = xr[j]; x[4 * j] = a.x; x[4 * j + 1] = a.y; x[4 * j + 2] = a.z; x[4 * j + 3] = a.w; }
    }
    const int id0 = idxo[(size_t)row * 128 + lane], id1 = idxo[(size_t)row * 128 + 64 + lane];
    const float g0 = gato[(size_t)row * 128 + lane], g1 = gato[(size_t)row * 128 + 64 + lane];
    const float su0 = usc[id0], su1 = usc[id1], sv0 = vsc[id0], sv1 = vsc[id1];
    float d0 = 0.f, d1 = 0.f;
#pragma unroll 1
    for (int e0 = 0; e0 < 64; e0 += 8) peer_dot8(U, id0, e0, lane, x, d0);
#pragma unroll 1
    for (int e0 = 0; e0 < 64; e0 += 8) peer_dot8(U, id1, e0, lane, x, d1);
    d0 *= su0; d1 *= su1;
    const float h0 = 0.5f * d0 * (1.f + erff(d0 * 0.7071067811865476f)) * g0 * sv0;
    const float h1 = 0.5f * d1 * (1.f + erff(d1 * 0.7071067811865476f)) * g1 * sv1;
    float acc[16];
#pragma unroll
    for (int k = 0; k < 16; ++k) acc[k] = 0.f;
#pragma unroll 1
    for (int e0 = 0; e0 < 64; e0 += 8) peer_axpy8(V, id0, h0, e0, lane, acc);
#pragma unroll 1
    for (int e0 = 0; e0 < 64; e0 += 8) peer_axpy8(V, id1, h1, e0, lane, acc);
    float s = 0.f;
#pragma unroll
    for (int k = 0; k < 16; ++k) { acc[k] = DN_ALPHA * x[k] + acc[k]; s += acc[k]; }
    const float mu = wave_sum(s) * (1.f / 1024.f);
    float q = 0.f;
#pragma unroll
    for (int k = 0; k < 16; ++k) { const float dd = acc[k] - mu; q += dd * dd; }
    const float rs = rsqrtf(wave_sum(q) * (1.f / 1024.f) + 1e-5f);
    float* y = (row < NTP) ? p.out + OUT_YP + (size_t)row * DM : p.out + OUT_YS + (size_t)(row - NTP) * DM;
#pragma unroll
    for (int j = 0; j < 4; ++j) {
      const float4 ga = ((const float4*)p.ln3_g)[4 * lane + j], ba = ((const float4*)p.ln3_b)[4 * lane + j];
      float4 ya;
      ya.x = (acc[4 * j + 0] - mu) * rs * ga.x + ba.x; ya.y = (acc[4 * j + 1] - mu) * rs * ga.y + ba.y;
      ya.z = (acc[4 * j + 2] - mu) * rs * ga.z + ba.z; ya.w = (acc[4 * j + 3] - mu) * rs * ga.w + ba.w;
      ((float4*)y)[4 * lane + j] = ya;
    }
  }
}
#else
DI void unpack8(const uint4& v, float (&f)[8]) {
  f[0] = bflo(v.x); f[1] = bfhi(v.x); f[2] = bflo(v.y); f[3] = bfhi(v.y); f[4] = bflo(v.z); f[5] = bfhi(v.z); f[6] = bflo(v.w); f[7] = bfhi(v.w);
}
DI void phase_peer(const Params& p) {
  const float* xf = (const float*)(p.ws + WS_B);
  const int* idxo = (const int*)(p.ws + WS_A);
  const float* gato = (const float*)(p.ws + WS_A + (size_t)NT * 128 * 4);
  const u16* U = (const u16*)(p.ws + WS_U);
  const u16* V = (const u16*)(p.ws + WS_V);
  const int lane = threadIdx.x & 63;
  const int wg = blockIdx.x * 4 + (threadIdx.x >> 6), nw = gridDim.x * 4;
  for (int row = wg; row < NT; row += nw) {
    float x[16];
    {
      const float4* xr = (const float4*)(xf + (size_t)row * DM);
      const float4 a = xr[2 * lane], b = xr[2 * lane + 1], c = xr[128 + 2 * lane], d = xr[128 + 2 * lane + 1];
      x[0] = a.x; x[1] = a.y; x[2] = a.z; x[3] = a.w; x[4] = b.x; x[5] = b.y; x[6] = b.z; x[7] = b.w;
      x[8] = c.x; x[9] = c.y; x[10] = c.z; x[11] = c.w; x[12] = d.x; x[13] = d.y; x[14] = d.z; x[15] = d.w;
    }
    const int id0 = idxo[(size_t)row * 128 + lane], id1 = idxo[(size_t)row * 128 + 64 + lane];
    const float g0 = gato[(size_t)row * 128 + lane], g1 = gato[(size_t)row * 128 + 64 + lane];
    float d0 = 0.f, d1 = 0.f;
#pragma unroll 8
    for (int e = 0; e < 64; ++e) {
      const int id = __builtin_amdgcn_readlane(id0, e);
      const uint4* ur = (const uint4*)(U + (size_t)id * DM);
      const uint4 ua = ur[lane], ub = ur[64 + lane];
      float f[8], s = 0.f;
      unpack8(ua, f);
#pragma unroll
      for (int k = 0; k < 8; ++k) s += f[k] * x[k];
      unpack8(ub, f);
#pragma unroll
      for (int k = 0; k < 8; ++k) s += f[k] * x[8 + k];
      s = wave_sum(s);
      if (lane == e) d0 = s;
    }
#pragma unroll 8
    for (int e = 0; e < 64; ++e) {
      const int id = __builtin_amdgcn_readlane(id1, e);
      const uint4* ur = (const uint4*)(U + (size_t)id * DM);
      const uint4 ua = ur[lane], ub = ur[64 + lane];
      float f[8], s = 0.f;
      unpack8(ua, f);
#pragma unroll
      for (int k = 0; k < 8; ++k) s += f[k] * x[k];
      unpack8(ub, f);
#pragma unroll
      for (int k = 0; k < 8; ++k) s += f[k] * x[8 + k];
      s = wave_sum(s);
      if (lane == e) d1 = s;
    }
    const float h0 = 0.5f * d0 * (1.f + erff(d0 * 0.7071067811865476f)) * g0;
    const float h1 = 0.5f * d1 * (1.f + erff(d1 * 0.7071067811865476f)) * g1;
    float acc[16];
#pragma unroll
    for (int k = 0; k < 16; ++k) acc[k] = 0.f;
#pragma unroll 8
    for (int e = 0; e < 64; ++e) {
      const int id = __builtin_amdgcn_readlane(id0, e);
      const float hs = __uint_as_float(__builtin_amdgcn_readlane(__float_as_uint(h0), e));
      const uint4* vr = (const uint4*)(V + (size_t)id * DM);
      const uint4 va = vr[lane], vb2 = vr[64 + lane];
      float f[8];
      unpack8(va, f);
#pragma unroll
      for (int k = 0; k < 8; ++k) acc[k] += hs * f[k];
      unpack8(vb2, f);
#pragma unroll
      for (int k = 0; k < 8; ++k) acc[8 + k] += hs * f[k];
    }
#pragma unroll 8
    for (int e = 0; e < 64; ++e) {
      const int id = __builtin_amdgcn_readlane(id1, e);
      const float hs = __uint_as_float(__builtin_amdgcn_readlane(__float_as_uint(h1), e));
      const uint4* vr = (const uint4*)(V + (size_t)id * DM);
      const uint4 va = vr[lane], vb2 = vr[64 + lane];
      float f[8];
      unpack8(va, f);
#pragma unroll
      for (int k = 0; k < 8; ++k) acc[k] += hs * f[k];
      unpack8(vb2, f);
#pragma unroll
      for (int k = 0; k < 8; ++k) acc[8 + k] += hs * f[k];
    }
    float s = 0.f;
#pragma unroll
    for (int k = 0; k < 16; ++k) { acc[k] = DN_ALPHA * x[k] + acc[k]; s += acc[k]; }
    const float mu = wave_sum(s) * (1.f / 1024.f);
    float q = 0.f;
#pragma unroll
    for (int k = 0; k < 16; ++k) { const float dd = acc[k] - mu; q += dd * dd; }
    const float rs = rsqrtf(wave_sum(q) * (1.f / 1024.f) + 1e-5f);
    float* y = (row < NTP) ? p.out + OUT_YP + (size_t)row * DM : p.out + OUT_YS + (size_t)(row - NTP) * DM;
#pragma unroll
    for (int c = 0; c < 2; ++c) {
      const int off = c * 512 + lane * 8;
      const float4 ga = *(const float4*)(p.ln3_g + off), gb = *(const float4*)(p.ln3_g + off + 4);
      const float4 ba = *(const float4*)(p.ln3_b + off), bb = *(const float4*)(p.ln3_b + off + 4);
      float4 ya, yb;
      ya.x = (acc[8 * c + 0] - mu) * rs * ga.x + ba.x; ya.y = (acc[8 * c + 1] - mu) * rs * ga.y + ba.y;
      ya.z = (acc[8 * c + 2] - mu) * rs * ga.z + ba.z; ya.w = (acc[8 * c + 3] - mu) * rs * ga.w + ba.w;
      yb.x = (acc[8 * c + 4] - mu) * rs * gb.x + bb.x; yb.y = (acc[8 * c + 5] - mu) * rs * gb.y + bb.y;
      yb.z = (acc[8 * c + 6] - mu) * rs * gb.z + bb.z; yb.w = (acc[8 * c + 7] - mu) * rs * gb.w + bb.w;
      *(float4*)(y + off) = ya; *(float4*)(y + off + 4) = yb;
    }
  }
}

#endif

constexpr int NPHASE = 15;
template <int PH>
DI void run_phase(const Params& p, char* smem) {
  if (PH == 0) phase_prep(p, smem);
  else if (PH == 1) phase_proj(p, smem);
  else if (PH == 2) phase_scan(p, smem);
  else if (PH == 3) phase_attn(p, smem);
  else if (PH == 4) phase_wout(p, smem);
  else if (PH == 5) phase_ln(p, p.ln1_g, p.ln1_b);
  else if (PH == 6) phase_gemm_bf16(p, (const u16*)(p.ws + WS_C), (const u16*)(p.ws + WS_WMQ), 1024, (u16*)(p.ws + WS_D), 0.0625f, smem);
  else if (PH == 7) phase_mem_s(p, smem);
  else if (PH == 8) phase_mem_softmax(p);
  else if (PH == 9) phase_mem_pv(p, smem);
  else if (PH == 10) phase_wmo(p, smem);
  else if (PH == 11) phase_ln(p, p.ln2_g, p.ln2_b);
  else if (PH == 12) phase_gemm_bf16(p, (const u16*)(p.ws + WS_C), (const u16*)(p.ws + WS_WPQ), 2048, (u16*)(p.ws + WS_F), 1.f, smem);
  else if (PH == 13) phase_topk(p, smem);
  else if (PH == 14) phase_peer(p);
}

template <int PH>
__global__ void __launch_bounds__(256, 2) k_phase(Params p) {
  __shared__ __attribute__((aligned(16))) char smem[SMEM_BYTES];
  run_phase<PH>(p, smem);
}

#define XB_TMO      128
#define XB_XCNT(j)  (256  + 64 * (j))
#define XB_XSUB(j)  (1280 + 64 * (j))
#define XB_XGEN(j)  (2304 + 64 * (j))
#define XB_TOP      3328
#define XB_TOPGEN   3392
#define XB_SPIN_CAP (1u << 20)
DI unsigned xb_ld(unsigned* p) { return __hip_atomic_load(p, __ATOMIC_RELAXED, __HIP_MEMORY_SCOPE_AGENT); }
DI unsigned xb_add(unsigned* p, unsigned v) { return __hip_atomic_fetch_add(p, v, __ATOMIC_RELAXED, __HIP_MEMORY_SCOPE_AGENT); }
DI unsigned xb_xcc_id() { return (unsigned)__builtin_amdgcn_s_getreg((3 << 11) | 20) & 0xFu; }
#define XB_SPIN(cond, bar) do { unsigned _sp = 0; while (cond) { __builtin_amdgcn_s_sleep(1); \
    if ((++_sp & 255u) == 0u) { if (xb_ld(&(bar)[XB_TMO])) break; if (_sp > XB_SPIN_CAP) { atomicAdd(&(bar)[XB_TMO], 1u); break; } } } } while (0)
struct XcdBarrier { unsigned* bar; unsigned x; volatile unsigned* st; };
DI XcdBarrier xcd_barrier_post(unsigned* bar, volatile unsigned* st) {
  XcdBarrier b; b.bar = bar; b.x = xb_xcc_id(); b.st = st;
  if (threadIdx.x == 0) (void)xb_add(&bar[XB_XCNT(b.x)], 1u);
  return b;
}
DI void xcd_barrier_complete(unsigned* bar, unsigned x, unsigned& nloc, unsigned& nx) {
  const unsigned G = gridDim.x;
  unsigned sum, cnt, mine, sp = 0u;
  for (;;) {
    sum = 0u; cnt = 0u; mine = 0u;
#pragma unroll
    for (unsigned j = 0; j < 16; ++j) { const unsigned c = xb_ld(&bar[XB_XCNT(j)]); sum += c; cnt += (c > 0u) ? 1u : 0u; mine = (j == x) ? c : mine; }
    if (sum == G) break;
    __builtin_amdgcn_s_sleep(1);
    if ((++sp & 255u) == 0u) { if (xb_ld(&bar[XB_TMO])) break; if (sp > XB_SPIN_CAP) { atomicAdd(&bar[XB_TMO], 1u); break; } }
  }
  nloc = mine > 0u ? mine : 1u; nx = cnt > 0u ? cnt : 1u;
}
DI void xcd_barrier(const XcdBarrier& b) {
  asm volatile("s_waitcnt vmcnt(0)" ::: "memory");
  __syncthreads();
  if (threadIdx.x == 0) {
    unsigned* bar = b.bar;
    __builtin_amdgcn_s_waitcnt(0);
    unsigned nloc = b.st[0], nx = b.st[1];
    if (nloc == 0u) { xcd_barrier_complete(bar, b.x, nloc, nx); b.st[0] = nloc; b.st[1] = nx; }
    const unsigned old = xb_add(&bar[XB_XSUB(b.x)], 1u);
    const unsigned gen = old / nloc;
    if (old + 1u == (gen + 1u) * nloc) {
      __builtin_amdgcn_fence(__ATOMIC_RELEASE, "agent");
      asm volatile("s_waitcnt vmcnt(0)" ::: "memory");
      const unsigned og = xb_add(&bar[XB_TOP], 1u);
      const unsigned tg = og / nx;
      if (og + 1u == (tg + 1u) * nx) xb_add(&bar[XB_TOPGEN], 1u);
      else XB_SPIN(xb_ld(&bar[XB_TOPGEN]) == tg, bar);
      __builtin_amdgcn_fence(__ATOMIC_ACQUIRE, "agent");
      xb_add(&bar[XB_XGEN(b.x)], 1u);
      asm volatile("s_waitcnt vmcnt(0)" ::: "memory");
    } else {
      XB_SPIN(xb_ld(&bar[XB_XGEN(b.x)]) == gen, bar);
      __builtin_amdgcn_fence(__ATOMIC_ACQUIRE, "agent");
      asm volatile("s_waitcnt vmcnt(0)" ::: "memory");
    }
  }
  __syncthreads();
}
#if ONE_LAUNCH
DI void grid_barrier(unsigned* bar, unsigned& target) {
  target += gridDim.x;
  asm volatile("s_waitcnt vmcnt(0)" ::: "memory");
  __syncthreads();
  if (threadIdx.x == 0) {
    __builtin_amdgcn_fence(__ATOMIC_RELEASE, "agent");
    asm volatile("s_waitcnt vmcnt(0)" ::: "memory");
    __hip_atomic_fetch_add(bar, 1u, __ATOMIC_RELAXED, __HIP_MEMORY_SCOPE_AGENT);
    while (__hip_atomic_load(bar, __ATOMIC_RELAXED, __HIP_MEMORY_SCOPE_AGENT) < target) __builtin_amdgcn_s_sleep(2);
    __builtin_amdgcn_fence(__ATOMIC_ACQUIRE, "agent");
    asm volatile("s_waitcnt vmcnt(0)" ::: "memory");
  }
  __syncthreads();
}
__global__ void __launch_bounds__(256, 2) k_mega(Params p) {
  __shared__ __attribute__((aligned(16))) char smem[SMEM_BYTES];
  cg::grid_group grid = cg::this_grid();
#define RUN(n) do { run_phase<n>(p, smem); if (REPEAT_PHASE == n) { GSYNC(); run_phase<n>(p, smem); GSYNC(); run_phase<n>(p, smem); } if (REPEAT_PHASE == 203 && n == 3) { GSYNC(); phase_attn(p, smem, 1); GSYNC(); phase_attn(p, smem, 2); } if (REPEAT_PHASE == 100 + n) { GSYNC(); phase_gemm_bf16<true>(p, (const u16*)(p.ws + WS_C), (const u16*)(p.ws + WS_WPQ), 2048, (u16*)(p.ws + WS_F), 1.f, smem); GSYNC(); phase_gemm_bf16<true>(p, (const u16*)(p.ws + WS_C), (const u16*)(p.ws + WS_WPQ), 2048, (u16*)(p.ws + WS_F), 1.f, smem); } } while (0)
#if CUSTOM_BAR
  volatile unsigned* xst = (volatile unsigned*)(smem + 73728 + 1024);
  if (threadIdx.x == 0) { xst[0] = 0u; xst[1] = 0u; }
  __syncthreads();
  const XcdBarrier xb = xcd_barrier_post((unsigned*)(p.ws + WS_XBAR), xst);
#define GSYNC() xcd_barrier(xb)
#else
#define GSYNC() grid.sync()
#endif
  RUN(0); grid.sync();
  RUN(1); GSYNC();
  RUN(2); GSYNC();
  RUN(3); GSYNC();
  RUN(4); GSYNC();
  RUN(5); GSYNC();
  if (REPEAT_PHASE == 300) { GSYNC(); GSYNC(); GSYNC(); GSYNC(); GSYNC(); GSYNC(); GSYNC(); GSYNC(); }
  RUN(6); GSYNC();
  RUN(7); GSYNC();
  RUN(8); GSYNC();
  RUN(9); GSYNC();
  RUN(10); GSYNC();
  RUN(11); GSYNC();
  RUN(12); GSYNC();
  RUN(13); GSYNC();
  RUN(14);
}
#endif

extern "C" void kernel_launch(void* const* d_in, const int* in_sizes, int n_in, void* d_out, int out_size, void* d_ws, size_t ws_size,
                              hipStream_t stream) {
  (void)in_sizes; (void)n_in; (void)out_size;
  if (ws_size < WS_TOTAL) { fprintf(stderr, "workspace too small: %zu < %zu\n", ws_size, (size_t)WS_TOTAL); return; }
  Params p{};
  const float** pp = (const float**)&p;
  for (int i = 0; i < 29; ++i) pp[i] = (const float*)d_in[i];
  p.out = (float*)d_out;
  p.ws = (char*)d_ws;
#if ONE_LAUNCH
  static int grid_blocks = 0;
  if (!grid_blocks) {
    int dev = 0, cus = 0, per_cu = 0;
    hipGetDevice(&dev);
    hipDeviceGetAttribute(&cus, hipDeviceAttributeMultiprocessorCount, dev);
    hipOccupancyMaxActiveBlocksPerMultiprocessor(&per_cu, k_mega, 256, 0);
    if (per_cu > 2) per_cu = 2;
    grid_blocks = cus * per_cu;
  }
  hipMemsetAsync((char*)d_ws + WS_BAR, 0, 2048, stream);
  hipMemsetAsync((char*)d_ws + WS_XBAR, 0, 16384, stream);
  void* args[] = {&p};
  hipError_t e = hipLaunchCooperativeKernel((void*)k_mega, dim3(grid_blocks), dim3(256), args, 0, stream);
  if (e != hipSuccess) fprintf(stderr, "cooperative launch failed: %s (grid %d)\n", hipGetErrorString(e), grid_blocks);
#else
  const int G = 512;
  hipMemsetAsync((char*)d_ws + WS_BAR, 0, 2048, stream);
  k_phase<0><<<G, 256, 0, stream>>>(p);
  k_phase<1><<<G, 256, 0, stream>>>(p);
  k_phase<2><<<G, 256, 0, stream>>>(p);
  k_phase<3><<<G, 256, 0, stream>>>(p);
  k_phase<4><<<G, 256, 0, stream>>>(p);
  k_phase<5><<<G, 256, 0, stream>>>(p);
  k_phase<6><<<G, 256, 0, stream>>>(p);
  k_phase<7><<<G, 256, 0, stream>>>(p);
  k_phase<8><<<G, 256, 0, stream>>>(p);
  k_phase<9><<<G, 256, 0, stream>>>(p);
  k_phase<10><<<G, 256, 0, stream>>>(p);
  k_phase<11><<<G, 256, 0, stream>>>(p);
  k_phase<12><<<G, 256, 0, stream>>>(p);
  k_phase<13><<<G, 256, 0, stream>>>(p);
  k_phase<14><<<G, 256, 0, stream>>>(p);
#endif
}
```

```cpp
#include <hip/hip_runtime.h>
#include <hip/hip_cooperative_groups.h>
#include <cstdio>
#include <cstdint>
namespace cg = cooperative_groups;

#ifndef ONE_LAUNCH
#define ONE_LAUNCH 1
#endif

#ifndef USE_FP8
#define USE_FP8 1
#endif
#ifndef SB_EXIT
#define SB_EXIT 1
#endif
#ifndef REPEAT_PHASE
#define REPEAT_PHASE -1
#endif
#ifndef CUSTOM_BAR
#define CUSTOM_BAR 1
#endif
#define DI __device__ __forceinline__
typedef unsigned short u16;
typedef short bf16x8 __attribute__((ext_vector_type(8)));
typedef short s16x4 __attribute__((ext_vector_type(4)));
typedef float f32x16 __attribute__((ext_vector_type(16)));
typedef __bf16 bf2_t __attribute__((ext_vector_type(2)));
typedef float f2_t __attribute__((ext_vector_type(2)));
#define MFMA(a, b, c) __builtin_amdgcn_mfma_f32_32x32x16_bf16((a), (b), (c), 0, 0, 0)

constexpr int DM = 1024;
constexpr int NTP = 32768;
constexpr int NTS = 1024;
constexpr int NT = NTP + NTS;
constexpr int SEQ = 2048, DSEQ = 64, PAST = 4096, NMEM = 256;
constexpr int INC = 3080, INCP = 3200;
constexpr float DN_ALPHA = 1.189207115002721f;
constexpr float LOG2E = 1.4426950408889634f;

constexpr size_t OUT_YP = 0;
constexpr size_t OUT_YS = OUT_YP + (size_t)NTP * DM;
constexpr size_t OUT_SBK_P = OUT_YS + (size_t)NTS * DM;
constexpr size_t OUT_SBV_P = OUT_SBK_P + (size_t)NTP * 512;
constexpr size_t OUT_FXK_P = OUT_SBV_P + (size_t)NTP * 512;
constexpr size_t OUT_FXV_P = OUT_FXK_P + (size_t)NTP * 512;
constexpr size_t OUT_LF_P = OUT_FXV_P + (size_t)NTP * 512;
constexpr size_t OUT_MK_P = OUT_LF_P + (size_t)NTP * 8;
constexpr size_t OUT_MV_P = OUT_MK_P + (size_t)4096 * DM;
constexpr size_t OUT_SBK_S = OUT_MV_P + (size_t)4096 * DM;
constexpr size_t OUT_SBV_S = OUT_SBK_S + (size_t)NTS * 512;
constexpr size_t OUT_FXK_S = OUT_SBV_S + (size_t)NTS * 512;
constexpr size_t OUT_FXV_S = OUT_FXK_S + (size_t)NTS * 512;
constexpr size_t OUT_LF_S = OUT_FXV_S + (size_t)NTS * 512;
constexpr size_t OUT_TOTAL = OUT_LF_S + (size_t)NTS * 8;

constexpr size_t WS_WIN = 0;
constexpr size_t WS_WOUT = WS_WIN + (size_t)INCP * DM * 2;
constexpr size_t WS_WMQ = WS_WOUT + (size_t)DM * DM * 2;
constexpr size_t WS_WMKV = WS_WMQ + (size_t)DM * DM * 2;
constexpr size_t WS_WMO = WS_WMKV + (size_t)2048 * DM * 2;
constexpr size_t WS_WPQ = WS_WMO + (size_t)DM * DM * 2;
constexpr size_t WS_KA = WS_WPQ + (size_t)2048 * DM * 2;
constexpr size_t WS_KB = WS_KA + (size_t)8 * 128 * 128 * 2;
constexpr size_t WS_U = WS_KB + (size_t)8 * 128 * 128 * 2;
constexpr size_t WS_V = WS_U + (size_t)16384 * DM * 2;
constexpr size_t WS_MEMK = WS_V + (size_t)16384 * DM * 2;
constexpr size_t WS_MEMVT = WS_MEMK + (size_t)32 * 256 * DM * 2;
constexpr size_t WS_A = WS_MEMVT + (size_t)32 * 256 * DM * 2;
constexpr size_t WS_B = WS_A + (size_t)NT * DM * 4;
constexpr size_t WS_C = WS_B + (size_t)NT * DM * 4;
constexpr size_t WS_D = WS_C + (size_t)NT * DM * 2;
constexpr size_t WS_E = WS_D + (size_t)NT * DM * 2;
constexpr size_t WS_F = WS_E + (size_t)NT * DM * 2;
constexpr size_t WS_BAR = WS_F + (size_t)NT * DM * 4;
constexpr size_t WS_USC = WS_BAR + 2048;
constexpr size_t WS_VSC = WS_USC + (size_t)16384 * 4;
constexpr size_t WS_CBP = WS_VSC + (size_t)16384 * 4;
constexpr size_t WS_CBS = WS_CBP + (size_t)128 * 2048 * 4;
constexpr size_t WS_SSQ = WS_CBS + (size_t)128 * 4160 * 4;
constexpr size_t WS_XBAR = WS_SSQ + (size_t)NT * 2 * 4;
constexpr size_t WS_TOTAL = WS_XBAR + 16384;

struct Params {
  const float *x_prompt, *x_sample, *mem_prompt, *c_sb_k, *c_sb_v, *c_fx_k, *c_fx_v, *c_fx_logf, *c_mem_k, *c_mem_v;
  const float *w_in, *b_f, *w_gn, *w_out, *ln1_g, *ln1_b, *w_mq, *w_mk, *w_mv, *w_mo, *ln2_g, *ln2_b;
  const float *w_pq, *keys_a, *keys_b, *peer_u, *peer_v, *ln3_g, *ln3_b;
  float* out;
  char* ws;
};

constexpr int SMEM_BYTES = 73728 + 1024 + 64;

DI unsigned pk2(float a, float b) { f2_t v = {a, b}; bf2_t r = __builtin_convertvector(v, bf2_t); return __builtin_bit_cast(unsigned, r); }
DI u16 bf1(float a) { return (u16)(pk2(a, 0.f) & 0xffffu); }
DI float bflo(unsigned w) { return __uint_as_float(w << 16); }
DI float bfhi(unsigned w) { return __uint_as_float(w & 0xffff0000u); }
DI float wave_sum(float v) {
#pragma unroll
  for (int o = 32; o >= 1; o >>= 1) v += __shfl_xor(v, o);
  return v;
}
DI float wave_max(float v) {
#pragma unroll
  for (int o = 32; o >= 1; o >>= 1) v = fmaxf(v, __shfl_xor(v, o));
  return v;
}
DI int vblock() { int nb = gridDim.x, b = blockIdx.x; return ((nb & 7) == 0) ? (b & 7) * (nb >> 3) + (b >> 3) : b; }
DI const float* xrow(const Params& p, int g) { return g < NTP ? p.x_prompt + (size_t)g * DM : p.x_sample + (size_t)(g - NTP) * DM; }

DI void tconv_tile(const float* src, int ldsrc, int C, u16* dst, int lddst, const float* rowscale, int tr, int tc, float* tile) {
  const int tid = threadIdx.x;
  {
    const int r = tid >> 2, c0 = (tid & 3) * 16;
    const int gr = tr * 64 + r;
    const float sc = rowscale ? rowscale[gr] : 1.f;
#pragma unroll
    for (int j = 0; j < 4; ++j) {
      const int gc = tc * 64 + c0 + 4 * j;
      float4 v = make_float4(0.f, 0.f, 0.f, 0.f);
      if (gc < C) v = *(const float4*)(src + (size_t)gr * ldsrc + gc);
      float* t = tile + r * 65 + c0 + 4 * j;
      t[0] = v.x * sc; t[1] = v.y * sc; t[2] = v.z * sc; t[3] = v.w * sc;
    }
  }
  __syncthreads();
  {
    const int n = tid >> 2, k0 = (tid & 3) * 16;
    unsigned w[8];
#pragma unroll
    for (int e = 0; e < 8; ++e) w[e] = pk2(tile[(k0 + 2 * e) * 65 + n], tile[(k0 + 2 * e + 1) * 65 + n]);
    uint4* d = (uint4*)(dst + (size_t)(tc * 64 + n) * lddst + tr * 64 + k0);
    d[0] = make_uint4(w[0], w[1], w[2], w[3]);
    d[1] = make_uint4(w[4], w[5], w[6], w[7]);
  }
  __syncthreads();
}

DI void conv_range(const float* src, u16* dst, size_t n8, int bid, int nb) {
  for (size_t i = (size_t)bid * 256 + threadIdx.x; i < n8; i += (size_t)nb * 256) {
    const float4 a = ((const float4*)src)[2 * i], b = ((const float4*)src)[2 * i + 1];
    ((uint4*)dst)[i] = make_uint4(pk2(a.x, a.y), pk2(a.z, a.w), pk2(b.x, b.y), pk2(b.z, b.w));
  }
}

DI void phase_prep(const Params& p, char* smem) {
  float* tile = (float*)smem;
  const int bid = blockIdx.x, nb = gridDim.x;
  u16* ws16 = (u16*)p.ws;
  constexpr int T_WIN = 16 * 50, T_SQ = 256, T_PQ = 16 * 32, T_MV = 16 * 4 * 16;
  constexpr int T0 = T_WIN, T1 = T0 + T_SQ, T2 = T1 + T_SQ, T3 = T2 + T_SQ, T4 = T3 + T_SQ, T5 = T4 + T_SQ, T6 = T5 + T_PQ, T7 = T6 + T_MV;
  for (int t = bid; t < T7; t += nb) {
    if (t < T0) { tconv_tile(p.w_in, INC, INC, (u16*)(p.ws + WS_WIN), DM, nullptr, t / 50, t % 50, tile); }
    else if (t < T1) { int u = t - T0; tconv_tile(p.w_out, DM, DM, (u16*)(p.ws + WS_WOUT), DM, p.w_gn, u >> 4, u & 15, tile); }
    else if (t < T2) { int u = t - T1; tconv_tile(p.w_mq, DM, DM, (u16*)(p.ws + WS_WMQ), DM, nullptr, u >> 4, u & 15, tile); }
    else if (t < T3) { int u = t - T2; tconv_tile(p.w_mk, DM, DM, (u16*)(p.ws + WS_WMKV), DM, nullptr, u >> 4, u & 15, tile); }
    else if (t < T4) { int u = t - T3; tconv_tile(p.w_mv, DM, DM, (u16*)(p.ws + WS_WMKV) + (size_t)DM * DM, DM, nullptr, u >> 4, u & 15, tile); }
    else if (t < T5) { int u = t - T4; tconv_tile(p.w_mo, DM, DM, (u16*)(p.ws + WS_WMO), DM, nullptr, u >> 4, u & 15, tile); }
    else if (t < T6) { int u = t - T5; tconv_tile(p.w_pq, 2048, 2048, (u16*)(p.ws + WS_WPQ), DM, nullptr, u >> 5, u & 31, tile); }
    else { int u = t - T6; int b = u >> 6, r = u & 63;
      tconv_tile(p.c_mem_v + (size_t)b * 256 * DM, DM, DM, (u16*)(p.ws + WS_MEMVT) + (size_t)(16 + b) * DM * 256, 256, nullptr, r >> 4, r & 15, tile); }
  }
  (void)ws16;
  for (int i = bid * 256 + threadIdx.x; i < NT * 2; i += nb * 256) ((float*)(p.ws + WS_SSQ))[i] = 0.f;
  conv_range(p.x_prompt, (u16*)(p.ws + WS_C), (size_t)NTP * DM / 8, bid, nb);
  conv_range(p.x_sample, (u16*)(p.ws + WS_C) + (size_t)NTP * DM, (size_t)NTS * DM / 8, bid, nb);
  conv_range(p.mem_prompt, (u16*)(p.ws + WS_E), (size_t)4096 * DM / 8, bid, nb);
  conv_range(p.c_mem_k, (u16*)(p.ws + WS_MEMK) + (size_t)16 * 256 * DM, (size_t)16 * 256 * DM / 8, bid, nb);
  conv_range(p.keys_a, (u16*)(p.ws + WS_KA), (size_t)8 * 128 * 128 / 8, bid, nb);
  conv_range(p.keys_b, (u16*)(p.ws + WS_KB), (size_t)8 * 128 * 128 / 8, bid, nb);
#if USE_FP8
  {
    const int lane = threadIdx.x & 63;
    const int wg = bid * 4 + (threadIdx.x >> 6), nw = nb * 4;
    for (int row = wg; row < 32768; row += nw) {
      const bool isv = row >= 16384;
      const int r = isv ? row - 16384 : row;
      const float4* src = (const float4*)((isv ? p.peer_v : p.peer_u) + (size_t)r * DM) + 4 * lane;
      float4 a[4];
      float am = 0.f;
#pragma unroll
      for (int j = 0; j < 4; ++j) { a[j] = src[j]; am = fmaxf(am, fmaxf(fmaxf(fabsf(a[j].x), fabsf(a[j].y)), fmaxf(fabsf(a[j].z), fabsf(a[j].w)))); }
      am = wave_max(am);
      int ex = 0;
      if (am > 0.f) (void)frexpf(am, &ex);
      const float sc = ldexpf(1.f, 8 - ex), isc = ldexpf(1.f, ex - 8);
      unsigned w[4];
#pragma unroll
      for (int j = 0; j < 4; ++j) {
        int t = __builtin_amdgcn_cvt_pk_fp8_f32(a[j].x * sc, a[j].y * sc, 0, false);
        t = __builtin_amdgcn_cvt_pk_fp8_f32(a[j].z * sc, a[j].w * sc, t, true);
        w[j] = (unsigned)t;
      }
      *(uint4*)(p.ws + (isv ? WS_V : WS_U) + (size_t)r * DM + 16 * lane) = make_uint4(w[0], w[1], w[2], w[3]);
      if (lane == 0) ((float*)(p.ws + (isv ? WS_VSC : WS_USC)))[r] = isc;
    }
  }
#else
  conv_range(p.peer_u, (u16*)(p.ws + WS_U), (size_t)16384 * DM / 8, bid, nb);
  conv_range(p.peer_v, (u16*)(p.ws + WS_V), (size_t)16384 * DM / 8, bid, nb);
#endif
}

#define ACC_ROW(e, hh) (((e) & 3) + 8 * ((e) >> 2) + 4 * (hh))
#define ACC_R0(e) (((e) & 3) + 8 * ((e) >> 2))
template <int V> struct IC { static constexpr int value = V; };
struct SmemGemm { u16 a[2][128 * 64]; u16 b[2][128 * 64]; };

template <int ROWS>
struct GldsBf16 {
  const u16* base; int ld;
  DI void issue(int kt, u16* lds, int tid) {
    const int wid = tid >> 6, lane = tid & 63;
    constexpr int NCH = ROWS / 32;
#pragma unroll
    for (int q = 0; q < NCH; ++q) {
      const int ch = wid * NCH + q;
      const int r = ch * 8 + (lane >> 3);
      const int c = (lane & 7) ^ ((r >> 1) & 7);
      __builtin_amdgcn_global_load_lds((const unsigned*)(base + (size_t)r * ld + kt * 64 + c * 8), (unsigned*)(lds + ch * 512), 16, 0, 0);
    }
  }
  DI void commit(u16*, int) {}
};
#ifndef GEMM_REG2
#define GEMM_REG2 1
#endif
#if GEMM_REG2
typedef unsigned u32x4 __attribute__((ext_vector_type(4)));
template <int ROWS>
struct LdReg {
  static constexpr int N = ROWS / 32;
  const u16* base; int ld;
  u32x4 r0, r1, r2, r3;
  DI const u32x4* src(int kt, int tid, int i) const { const int c = tid + 256 * i; return (const u32x4*)(base + (size_t)(c >> 3) * ld + kt * 64 + (c & 7) * 8); }
  DI static u32x4* dst(u16* lds, int tid, int i) { const int c = tid + 256 * i; const int row = c >> 3; return (u32x4*)(lds + row * 64 + (((c & 7) ^ ((row >> 1) & 7)) * 8)); }
  DI void fetch(int kt, int tid) {
    r0 = *src(kt, tid, 0); r1 = *src(kt, tid, 1);
    if (N > 2) { r2 = *src(kt, tid, 2); r3 = *src(kt, tid, 3); }
  }
  DI void stash(u16* lds, int tid) const {
    *dst(lds, tid, 0) = r0; *dst(lds, tid, 1) = r1;
    if (N > 2) { *dst(lds, tid, 2) = r2; *dst(lds, tid, 3) = r3; }
  }
};
template <int MI, bool GRMS>
DI void gemm_compute(const u16* pa, const u16* pb, f32x16 (&acc)[MI][MI], int o0, int o1, int o2, int o3, int wr, int hh, bool scale_now, const float* rsc) {
  if (GRMS && scale_now) {
#pragma unroll
    for (int i = 0; i < MI; ++i)
#pragma unroll
      for (int e = 0; e < 16; ++e) {
        const float rt = rsc[((wr * MI + i) * 32 + ACC_ROW(e, hh)) * 2];
#pragma unroll
        for (int j = 0; j < MI; ++j) acc[i][j][e] *= rt;
      }
  }
  const int off[4] = {o0, o1, o2, o3};
  bf16x8 af[2][MI], bfr[2][MI];
#pragma unroll
  for (int i = 0; i < MI; ++i) { af[0][i] = *(const bf16x8*)(pa + i * 32 * 64 + off[0]); bfr[0][i] = *(const bf16x8*)(pb + i * 32 * 64 + off[0]); }
#pragma unroll
  for (int kk = 0; kk < 4; ++kk) {
    if (kk < 3) {
#pragma unroll
      for (int i = 0; i < MI; ++i) { af[(kk + 1) & 1][i] = *(const bf16x8*)(pa + i * 32 * 64 + off[kk + 1]); bfr[(kk + 1) & 1][i] = *(const bf16x8*)(pb + i * 32 * 64 + off[kk + 1]); }
    }
#pragma unroll
    for (int i = 0; i < MI; ++i)
#pragma unroll
      for (int j = 0; j < MI; ++j) acc[i][j] = MFMA(af[kk & 1][i], bfr[kk & 1][j], acc[i][j]);
  }
}
template <int MI, bool GRMS = false, class AL, class EPI>
DI void gemm_tile(AL& al, const u16* Bt, int ldb, int K, int m0, int n0, EPI epi, char* smem, const float* rsc = nullptr) {
  SmemGemm& sm = *(SmemGemm*)smem;
  const int tid = threadIdx.x, lane = tid & 63, wid = tid >> 6, wr = wid >> 1, wc = wid & 1, r31 = lane & 31, hh = lane >> 5;
  LdReg<MI * 64> a0, a1, b0, b1;
  a0.base = al.base; a0.ld = al.ld; a1.base = al.base; a1.ld = al.ld;
  b0.base = Bt + (size_t)n0 * ldb; b0.ld = ldb; b1.base = b0.base; b1.ld = ldb;
  f32x16 acc[MI][MI];
#pragma unroll
  for (int i = 0; i < MI; ++i)
#pragma unroll
    for (int j = 0; j < MI; ++j)
#pragma unroll
      for (int e = 0; e < 16; ++e) acc[i][j][e] = 0.f;
  int off[4];
#pragma unroll
  for (int kk = 0; kk < 4; ++kk) off[kk] = r31 * 64 + (((kk * 2 + hh) ^ ((r31 >> 1) & 7)) * 8);
  const int KT = K >> 6;
  a0.fetch(0, tid); b0.fetch(0, tid);
  a1.fetch(1, tid); b1.fetch(1, tid);
  a0.stash(sm.a[0], tid); b0.stash(sm.b[0], tid);
  __syncthreads();
  for (int kt = 0; kt < KT; kt += 2) {
    { const int kn = min(kt + 2, KT - 1); a0.fetch(kn, tid); b0.fetch(kn, tid); }
    gemm_compute<MI, GRMS>(sm.a[0] + (wr * MI * 32) * 64, sm.b[0] + (wc * MI * 32) * 64, acc, off[0], off[1], off[2], off[3], wr, hh, kt == (KT >> 1), rsc);
    a1.stash(sm.a[1], tid); b1.stash(sm.b[1], tid);
    __syncthreads();
    { const int kn = min(kt + 3, KT - 1); a1.fetch(kn, tid); b1.fetch(kn, tid); }
    gemm_compute<MI, GRMS>(sm.a[1] + (wr * MI * 32) * 64, sm.b[1] + (wc * MI * 32) * 64, acc, off[0], off[1], off[2], off[3], wr, hh, (kt + 1) == (KT >> 1), rsc);
    a0.stash(sm.a[0], tid); b0.stash(sm.b[0], tid);
    __syncthreads();
  }
  if (GRMS) {
#pragma unroll
    for (int i = 0; i < MI; ++i)
#pragma unroll
      for (int e = 0; e < 16; ++e) {
        const float s1 = rsc[((wr * MI + i) * 32 + ACC_ROW(e, hh)) * 2 + 1];
#pragma unroll
        for (int j = 0; j < MI; ++j) acc[i][j][e] *= s1;
      }
  }
#pragma unroll
  for (int i = 0; i < MI; ++i)
#pragma unroll
    for (int j = 0; j < MI; ++j) epi(m0 + (wr * MI + i) * 32, n0 + (wc * MI + j) * 32, acc[i][j]);
}
#else
template <int MI, bool GRMS = false, class AL, class EPI>
DI void gemm_tile(AL& al, const u16* Bt, int ldb, int K, int m0, int n0, EPI epi, char* smem, const float* rsc = nullptr) {
  SmemGemm& sm = *(SmemGemm*)smem;
  const int tid = threadIdx.x, lane = tid & 63, wid = tid >> 6, wr = wid >> 1, wc = wid & 1, r31 = lane & 31, hh = lane >> 5;
  GldsBf16<MI * 64> bl; bl.base = Bt + (size_t)n0 * ldb; bl.ld = ldb;
  f32x16 acc[MI][MI];
#pragma unroll
  for (int i = 0; i < MI; ++i)
#pragma unroll
    for (int j = 0; j < MI; ++j)
#pragma unroll
      for (int e = 0; e < 16; ++e) acc[i][j][e] = 0.f;
  int off[4];
#pragma unroll
  for (int kk = 0; kk < 4; ++kk) off[kk] = r31 * 64 + (((kk * 2 + hh) ^ ((r31 >> 1) & 7)) * 8);
  const int KT = K >> 6;
  al.issue(0, sm.a[0], tid); bl.issue(0, sm.b[0], tid);
  al.commit(sm.a[0], tid);
  asm volatile("s_waitcnt vmcnt(0)" ::: "memory");
  __syncthreads();
  for (int kt = 0; kt < KT; ++kt) {
    const int cur = kt & 1;
    if (kt + 1 < KT) { al.issue(kt + 1, sm.a[cur ^ 1], tid); bl.issue(kt + 1, sm.b[cur ^ 1], tid); }
    const u16* pa = sm.a[cur] + (wr * MI * 32) * 64;
    const u16* pb = sm.b[cur] + (wc * MI * 32) * 64;
    if (GRMS && kt == (KT >> 1)) {
#pragma unroll
      for (int i = 0; i < MI; ++i)
#pragma unroll
        for (int e = 0; e < 16; ++e) {
          const float rt = rsc[((wr * MI + i) * 32 + ACC_ROW(e, hh)) * 2];
#pragma unroll
          for (int j = 0; j < MI; ++j) acc[i][j][e] *= rt;
        }
    }
#pragma unroll
    for (int kk = 0; kk < 4; ++kk) {
      bf16x8 af[MI], bfr[MI];
#pragma unroll
      for (int i = 0; i < MI; ++i) { af[i] = *(const bf16x8*)(pa + i * 32 * 64 + off[kk]); bfr[i] = *(const bf16x8*)(pb + i * 32 * 64 + off[kk]); }
#pragma unroll
      for (int i = 0; i < MI; ++i)
#pragma unroll
        for (int j = 0; j < MI; ++j) acc[i][j] = MFMA(af[i], bfr[j], acc[i][j]);
    }
    if (kt + 1 < KT) al.commit(sm.a[cur ^ 1], tid);
    asm volatile("s_waitcnt vmcnt(0)" ::: "memory");
    __syncthreads();
  }
  if (GRMS) {
#pragma unroll
    for (int i = 0; i < MI; ++i)
#pragma unroll
      for (int e = 0; e < 16; ++e) {
        const float s1 = rsc[((wr * MI + i) * 32 + ACC_ROW(e, hh)) * 2 + 1];
#pragma unroll
        for (int j = 0; j < MI; ++j) acc[i][j][e] *= s1;
      }
  }
#pragma unroll
  for (int i = 0; i < MI; ++i)
#pragma unroll
    for (int j = 0; j < MI; ++j) epi(m0 + (wr * MI + i) * 32, n0 + (wc * MI + j) * 32, acc[i][j]);
}
#endif
template <class F>
DI void for_tiles(int N, F body) {
  const int vb = vblock(), nb = gridDim.x;
  const int ntn = N >> 7, ntn2 = N >> 6;
  const int nbig = 256 * ntn, nsmall = 16 * ntn2;
  for (int t = vb; t < nbig + nsmall; t += nb) {
    if (t < nbig) { body((t / ntn) * 128, (t % ntn) * 128, IC<2>{}); }
    else { const int u = t - nbig; body(NTP + (u / ntn2) * 64, (u % ntn2) * 64, IC<1>{}); }
  }
}

DI void phase_proj(const Params& p, char* smem) {
  const int vb = vblock(), nb = gridDim.x;
  constexpr int T_G1 = 264 * 25, T_MKV = 32 * 16;
  float* out = p.out;
  for (int t = vb; t < T_G1 + T_MKV; t += nb) {
    if (t < T_G1) {
      const int mt = t / 25, nt = t % 25;
      const int m0 = mt * 128, n0 = nt * 128;
      GldsBf16<128> al; al.base = (const u16*)(p.ws + WS_C) + (size_t)m0 * DM; al.ld = DM;
      const bool smp = m0 >= NTP;
      const float* b_f = p.b_f;
      u16* qsb = (u16*)(p.ws + WS_D);
      u16* qfx = qsb + (size_t)NT * 512;
      char* ws = p.ws;
      auto epi = [=](int r0, int c0, const f32x16& acc) {
        const int lane = threadIdx.x & 63, hh = lane >> 5, col = c0 + (lane & 31);
        const int seg = c0 >> 9, cc = col & 511;
        if (seg == 0 || seg == 3) {
          u16* q = (seg == 0) ? qsb : qfx;
#pragma unroll
          for (int e = 0; e < 16; ++e) q[(unsigned)(r0 + 4 * hh) * 512u + cc + ACC_R0(e) * 512u] = bf1(acc[e] * 0.125f);
        } else if (seg < 6) {
          size_t ob;
          if (!smp) ob = (seg == 1) ? OUT_SBK_P : (seg == 2) ? OUT_SBV_P : (seg == 4) ? OUT_FXK_P : OUT_FXV_P;
          else ob = (seg == 1) ? OUT_SBK_S : (seg == 2) ? OUT_SBV_S : (seg == 4) ? OUT_FXK_S : OUT_FXV_S;
          const int rb = smp ? r0 - NTP : r0;
          float* ov = out + ob;
          const unsigned b0 = (unsigned)(rb + 4 * hh) * 512u + cc;
#pragma unroll
          for (int e = 0; e < 16; ++e) ov[b0 + ACC_R0(e) * 512u] = acc[e];
          if (!smp) {
            if (seg == 1 || seg == 4) {
              u16* k16 = (u16*)(ws + WS_A) + (seg == 4 ? (size_t)NTP * 512 : 0);
#pragma unroll
              for (int e = 0; e < 16; ++e) k16[b0 + ACC_R0(e) * 512u] = bf1(acc[e]);
            } else {
              u16* vt16 = (u16*)(ws + WS_B) + (seg == 5 ? (size_t)NTP * 512 : 0);
              const unsigned vb0 = (unsigned)(((r0 >> 11) * 8 + (cc >> 6)) * 64 + (cc & 63)) * 2048u + (unsigned)(r0 & 2047) + 4 * hh;
#pragma unroll
              for (int g4 = 0; g4 < 4; ++g4) *(uint2*)(vt16 + vb0 + 8 * g4) = make_uint2(pk2(acc[4 * g4], acc[4 * g4 + 1]), pk2(acc[4 * g4 + 2], acc[4 * g4 + 3]));
            }
          }
        } else {
          const int c = col - 3072;
          if (c < 8) {
            const float bf = b_f[c];
            const size_t ob = smp ? OUT_LF_S : OUT_LF_P;
            const int rb = smp ? r0 - NTP : r0;
#pragma unroll
            for (int e = 0; e < 16; ++e) {
              const float z = acc[e] + bf;
              const float ls = fminf(z, 0.f) - log1pf(__expf(-fabsf(z)));
              out[ob + (unsigned)(rb + ACC_ROW(e, hh)) * 8u + c] = ls;
            }
          }
        }
      };
      gemm_tile<2>(al, (const u16*)(p.ws + WS_WIN), DM, DM, m0, n0, epi, smem);
    } else {
      const int u = t - T_G1;
      const int mt = u >> 4, nt = u & 15;
      const int m0 = mt * 128, n0 = nt * 128;
      GldsBf16<128> al; al.base = (const u16*)(p.ws + WS_E) + (size_t)m0 * DM; al.ld = DM;
      u16* kb = (u16*)(p.ws + WS_MEMK);
      u16* vt = (u16*)(p.ws + WS_MEMVT);
      auto epi = [=](int r0, int c0, const f32x16& acc) {
        const int lane = threadIdx.x & 63, hh = lane >> 5, col = c0 + (lane & 31);
        if (c0 < 1024) {
          float* ov = out + OUT_MK_P;
          const unsigned b0 = (unsigned)(r0 + 4 * hh) * 1024u + col;
#pragma unroll
          for (int e = 0; e < 16; ++e) { const unsigned idx = b0 + ACC_R0(e) * 1024u; ov[idx] = acc[e]; kb[idx] = bf1(acc[e]); }
        } else {
          const int c = col - 1024;
          float* ov = out + OUT_MV_P;
          const unsigned b0 = (unsigned)(r0 + 4 * hh) * 1024u + c;
#pragma unroll
          for (int e = 0; e < 16; ++e) ov[b0 + ACC_R0(e) * 1024u] = acc[e];
          const int b = r0 >> 8;
#pragma unroll
          for (int g4 = 0; g4 < 4; ++g4) {
            const int m = (r0 & 255) + 8 * g4 + 4 * hh;
            *(uint2*)(vt + ((size_t)b * DM + c) * 256 + m) = make_uint2(pk2(acc[4 * g4], acc[4 * g4 + 1]), pk2(acc[4 * g4 + 2], acc[4 * g4 + 3]));
          }
        }
      };
      gemm_tile<2>(al, (const u16*)(p.ws + WS_WMKV), DM, DM, m0, n0, epi, smem);
    }
  }
}

template <int PER>
DI void scan_one(const float* src0, int n0, const float* src1, int n, float* dst, float* part) {
  const int tid = threadIdx.x;
  const int s0 = tid * PER;
  float v[PER];
#pragma unroll
  for (int i = 0; i < PER; ++i) { const int s = s0 + i; v[i] = (s < n) ? ((s < n0) ? src0[(size_t)s * 8] : src1[(size_t)(s - n0) * 8]) : 0.f; }
  float loc = 0.f;
#pragma unroll
  for (int i = 0; i < PER; ++i) loc += v[i];
  part[tid] = loc;
  __syncthreads();
  float run = 0.f;
  for (int i = 0; i < tid; ++i) run += part[i];
#pragma unroll
  for (int i = 0; i < PER; ++i) { run += v[i]; if (s0 + i < n) dst[s0 + i] = -run * LOG2E; }
  __syncthreads();
}
DI void phase_scan(const Params& p, char* smem) {
  float* part = (float*)smem;
  for (int it = blockIdx.x; it < 256; it += gridDim.x) {
    const int bh = it & 127, b = bh >> 3, h = bh & 7;
    if (it < 128) scan_one<17>(p.c_fx_logf + (size_t)b * PAST * 8 + h, PAST, p.out + OUT_LF_S + (size_t)b * DSEQ * 8 + h, PAST + DSEQ, (float*)(p.ws + WS_CBS) + (size_t)bh * 4160, part);
    else scan_one<8>(p.out + OUT_LF_P + (size_t)b * SEQ * 8 + h, SEQ, nullptr, SEQ, (float*)(p.ws + WS_CBP) + (size_t)bh * 2048, part);
  }
}

constexpr int KLD = 72, VLD = 68;
struct SmemAttn { u16 k[2][64 * KLD]; u16 vt[2][64 * VLD]; float cb[4160]; float part[256]; u16 q[128 * KLD]; };
static_assert(sizeof(SmemAttn) <= SMEM_BYTES, "attn smem");

struct KVRegs { float4 k[4], v[4]; };
DI void kv_fetch(KVRegs& r, const float* kb, const float* vb, int tid) {
#pragma unroll
  for (int i = 0; i < 4; ++i) { const int c = tid + 256 * i; const size_t o = (size_t)(c >> 4) * 512 + (c & 15) * 4; r.k[i] = *(const float4*)(kb + o); r.v[i] = *(const float4*)(vb + o); }
}
DI void kv_stash(const KVRegs& r, u16* ks, u16* vts, int tid) {
#pragma unroll
  for (int i = 0; i < 4; ++i) {
    const int c = tid + 256 * i; const int row = c >> 4, c4 = (c & 15) * 4;
    *(uint2*)(ks + row * KLD + c4) = make_uint2(pk2(r.k[i].x, r.k[i].y), pk2(r.k[i].z, r.k[i].w));
    vts[(c4 + 0) * VLD + row] = bf1(r.v[i].x); vts[(c4 + 1) * VLD + row] = bf1(r.v[i].y);
    vts[(c4 + 2) * VLD + row] = bf1(r.v[i].z); vts[(c4 + 3) * VLD + row] = bf1(r.v[i].w);
  }
}
typedef unsigned kv_u32x4 __attribute__((ext_vector_type(4)));
typedef unsigned kv_u32x2 __attribute__((ext_vector_type(2)));
struct KV16 { kv_u32x4 k0, k1, v0, v1; };
DI void kv_fetch16(KV16& r, const u16* kb, const u16* vtb, int tid) {
  const int c0 = tid, c1 = tid + 256;
  r.k0 = *(const kv_u32x4*)(kb + (size_t)(c0 >> 3) * 512 + (c0 & 7) * 8); r.k1 = *(const kv_u32x4*)(kb + (size_t)(c1 >> 3) * 512 + (c1 & 7) * 8);
  r.v0 = *(const kv_u32x4*)(vtb + (size_t)(c0 >> 3) * SEQ + (c0 & 7) * 8); r.v1 = *(const kv_u32x4*)(vtb + (size_t)(c1 >> 3) * SEQ + (c1 & 7) * 8);
}
DI void kv_stash16(const KV16& r, u16* ks, u16* vts, int tid) {
  const int c0 = tid, c1 = tid + 256;
  *(kv_u32x4*)(ks + (c0 >> 3) * KLD + (c0 & 7) * 8) = r.k0;
  *(kv_u32x4*)(ks + (c1 >> 3) * KLD + (c1 & 7) * 8) = r.k1;
  kv_u32x2 a = {r.v0[0], r.v0[1]}, b2 = {r.v0[2], r.v0[3]}, c = {r.v1[0], r.v1[1]}, d = {r.v1[2], r.v1[3]};
  *(kv_u32x2*)(vts + (c0 >> 3) * VLD + (c0 & 7) * 8) = a; *(kv_u32x2*)(vts + (c0 >> 3) * VLD + (c0 & 7) * 8 + 4) = b2;
  *(kv_u32x2*)(vts + (c1 >> 3) * VLD + (c1 & 7) * 8) = c; *(kv_u32x2*)(vts + (c1 >> 3) * VLD + (c1 & 7) * 8 + 4) = d;
}
DI bf16x8 pack8(const f32x16& x, int s) {
  union { unsigned u[4]; bf16x8 v; } t;
  t.u[0] = pk2(x[8 * s + 0], x[8 * s + 1]); t.u[1] = pk2(x[8 * s + 2], x[8 * s + 3]);
  t.u[2] = pk2(x[8 * s + 4], x[8 * s + 5]); t.u[3] = pk2(x[8 * s + 6], x[8 * s + 7]);
  return t.v;
}

template <bool FOX, bool SMP>
DI void attn_item(const Params& p, int b, int h, int qb, char* smem, bool do_ssq = true, int split = 0) {
  constexpr int smp = SMP ? 1 : 0;
  constexpr bool SPLIT = FOX && SMP;
  SmemAttn& sm = *(SmemAttn*)smem;
  const int tid = threadIdx.x, lane = tid & 63, wid = tid >> 6, r31 = lane & 31, hh = lane >> 5;
  const int jt0 = SPLIT ? split * 8 : 0;
  const int nkt = SPLIT ? (split == 7 ? 9 : 8) : (smp ? 65 : 2 * qb + 2);
  const int jdiag = smp ? 64 : 2 * qb;
  int qi = wid * 32 + r31; if (smp) qi &= 63;
  const int qpos = (smp ? PAST : qb * 128) + qi;
  const int g = smp ? NTP + b * DSEQ + qi : b * SEQ + qb * 128 + qi;
  const u16* Q = (const u16*)(p.ws + WS_D) + (FOX ? (size_t)NT * 512 : 0);
  {
#pragma unroll
    for (int i = 0; i < 4; ++i) {
      const int c = tid + 256 * i; const int row = c >> 3, kc = (c & 7) * 8;
      const int qr = smp ? (row & 63) : row;
      const int gr = smp ? NTP + b * DSEQ + qr : b * SEQ + qb * 128 + qr;
      *(kv_u32x4*)(sm.q + row * KLD + kc) = *(const kv_u32x4*)(Q + (size_t)gr * 512 + h * 64 + kc);
    }
    __syncthreads();
  }

  const float* kcache = FOX ? p.c_fx_k : p.c_sb_k;
  const float* vcache = FOX ? p.c_fx_v : p.c_sb_v;
  const size_t okp = FOX ? OUT_FXK_P : OUT_SBK_P, ovp = FOX ? OUT_FXV_P : OUT_SBV_P;
  const size_t oks = FOX ? OUT_FXK_S : OUT_SBK_S, ovs = FOX ? OUT_FXV_S : OUT_SBV_S;
  auto kptr = [&](int j) -> const float* {
    if (!smp) return p.out + okp + ((size_t)(b * SEQ + 64 * j) * 512 + h * 64);
    if (j < 64) return kcache + ((size_t)(b * PAST + 64 * j) * 512 + h * 64);
    return p.out + oks + ((size_t)(b * DSEQ) * 512 + h * 64);
  };
  auto vptr = [&](int j) -> const float* {
    if (!smp) return p.out + ovp + ((size_t)(b * SEQ + 64 * j) * 512 + h * 64);
    if (j < 64) return vcache + ((size_t)(b * PAST + 64 * j) * 512 + h * 64);
    return p.out + ovs + ((size_t)(b * DSEQ) * 512 + h * 64);
  };

  if (FOX) {
    const float4* src = (const float4*)(smp ? (const float*)(p.ws + WS_CBS) + (size_t)(b * 8 + h) * 4160 : (const float*)(p.ws + WS_CBP) + (size_t)(b * 8 + h) * 2048);
    for (int i = jt0 * 16 + tid; i < (jt0 + nkt) * 16; i += 256) ((float4*)sm.cb)[i] = src[i];
    __syncthreads();
  }

  bf16x8 tri[2];
  if (!FOX) {
#pragma unroll
    for (int s = 0; s < 2; ++s)
#pragma unroll
      for (int j = 0; j < 8; ++j) { const int kin = 16 * s + 8 * (j >> 2) + 4 * hh + (j & 3); tri[s][j] = (kin >= r31) ? (short)0x3F80 : (short)0; }
  }

  f32x16 o[2];
#pragma unroll
  for (int d = 0; d < 2; ++d)
#pragma unroll
    for (int e = 0; e < 16; ++e) o[d][e] = 0.f;
  float mrun = -1e30f, lrun = 0.f, R = 0.f;

  KVRegs kv;
  KV16 kw;
  const int jfirst = FOX ? jt0 : nkt - 1;
  const u16* k16 = (const u16*)(p.ws + WS_A) + (FOX ? (size_t)NTP * 512 : 0) + (size_t)(b * SEQ) * 512 + h * 64;
  const u16* vt16 = (const u16*)(p.ws + WS_B) + (FOX ? (size_t)NTP * 512 : 0) + (size_t)((b * 8 + h) * 64) * SEQ;
  if (smp) { kv_fetch(kv, kptr(jfirst), vptr(jfirst), tid); kv_stash(kv, sm.k[0], sm.vt[0], tid); }
  else { kv_fetch16(kw, k16 + (size_t)(64 * jfirst) * 512, vt16 + 64 * jfirst, tid); kv_stash16(kw, sm.k[0], sm.vt[0], tid); }
  __syncthreads();
  for (int it = 0; it < nkt; ++it) {
    const int j = FOX ? jt0 + it : nkt - 1 - it;
    const int cur = it & 1;
    if (it + 1 < nkt) { const int jn = FOX ? j + 1 : j - 1; if (smp) kv_fetch(kv, kptr(jn), vptr(jn), tid); else kv_fetch16(kw, k16 + (size_t)(64 * jn) * 512, vt16 + 64 * jn, tid); }
    f32x16 s[2];
#pragma unroll
    for (int t2 = 0; t2 < 2; ++t2) {
#pragma unroll
      for (int e = 0; e < 16; ++e) s[t2][e] = 0.f;
      const u16* pk = sm.k[cur] + (t2 * 32 + r31) * KLD + hh * 8;
      const u16* pq = sm.q + (wid * 32 + r31) * KLD + hh * 8;
#pragma unroll
      for (int kk = 0; kk < 4; ++kk) { const bf16x8 a = *(const bf16x8*)(pk + kk * 16); const bf16x8 qv = *(const bf16x8*)(pq + kk * 16); s[t2] = MFMA(a, qv, s[t2]); }
    }
    const bool diag = j >= jdiag;
    const int kbase = 64 * j + 4 * hh;
    if (FOX) {
      float mloc = -1e30f;
#pragma unroll
      for (int t2 = 0; t2 < 2; ++t2)
#pragma unroll
        for (int g4 = 0; g4 < 4; ++g4) {
          const float4 bb = *(const float4*)(sm.cb + 64 * j + 32 * t2 + 8 * g4 + 4 * hh);
          const float bv[4] = {bb.x, bb.y, bb.z, bb.w};
#pragma unroll
          for (int e = 0; e < 4; ++e) {
            float x = s[t2][4 * g4 + e] * LOG2E + bv[e];
            if (diag && (kbase + 32 * t2 + 8 * g4 + e > qpos)) x = -1e30f;
            s[t2][4 * g4 + e] = x;
            mloc = fmaxf(mloc, x);
          }
        }
      mloc = fmaxf(mloc, __shfl_xor(mloc, 32));
      const float mnew = fmaxf(mrun, mloc);
      const float alpha = exp2f(mrun - mnew);
      mrun = mnew;
      float ls = 0.f;
#pragma unroll
      for (int t2 = 0; t2 < 2; ++t2)
#pragma unroll
        for (int e = 0; e < 16; ++e) { const float pv = exp2f(s[t2][e] - mnew); s[t2][e] = pv; ls += pv; }
      lrun = lrun * alpha + ls;
#pragma unroll
      for (int d = 0; d < 2; ++d)
#pragma unroll
        for (int e = 0; e < 16; ++e) o[d][e] *= alpha;
    } else {
#pragma unroll
      for (int t2 = 1; t2 >= 0; --t2) {
        f32x16 lk;
#pragma unroll
        for (int e = 0; e < 16; ++e) {
          const float z = s[t2][e];
          const float sp = fmaxf(z, 0.f) + __logf(1.f + __expf(-fabsf(z)));
          const bool vis = !diag || (kbase + 32 * t2 + ACC_ROW(e, 0) < qpos);
          lk[e] = vis ? -sp : 0.f;
        }
        bf16x8 fh[2], fl[2];
#pragma unroll
        for (int sI = 0; sI < 2; ++sI) fh[sI] = pack8(lk, sI);
#pragma unroll
        for (int e = 0; e < 16; ++e) lk[e] -= __uint_as_float(((unsigned)(u16)fh[e >> 3][e & 7]) << 16);
#pragma unroll
        for (int sI = 0; sI < 2; ++sI) fl[sI] = pack8(lk, sI);
        f32x16 inc;
#pragma unroll
        for (int e = 0; e < 16; ++e) inc[e] = R;
#pragma unroll
        for (int sI = 0; sI < 2; ++sI) { inc = MFMA(tri[sI], fh[sI], inc); inc = MFMA(tri[sI], fl[sI], inc); }
#pragma unroll
        for (int e = 0; e < 16; ++e) {
          const bool vis = !diag || (kbase + 32 * t2 + ACC_ROW(e, 0) < qpos);
          const float w = exp2f((s[t2][e] + inc[e]) * LOG2E);
          s[t2][e] = vis ? w : 0.f;
        }
        R = __shfl(inc[0], r31);
      }
    }
#pragma unroll
    for (int t2 = 0; t2 < 2; ++t2)
#pragma unroll
      for (int sI = 0; sI < 2; ++sI) {
        const bf16x8 pf = pack8(s[t2], sI);
#pragma unroll
        for (int d = 0; d < 2; ++d) {
          const u16* pv = sm.vt[cur] + (d * 32 + r31) * VLD + 32 * t2 + 16 * sI + 4 * hh;
          union { s16x4 q[2]; bf16x8 v; } a;
          a.q[0] = *(const s16x4*)(pv); a.q[1] = *(const s16x4*)(pv + 8);
          o[d] = MFMA(a.v, pf, o[d]);
        }
      }
    if (it + 1 < nkt) { if (smp) kv_stash(kv, sm.k[cur ^ 1], sm.vt[cur ^ 1], tid); else kv_stash16(kw, sm.k[cur ^ 1], sm.vt[cur ^ 1], tid); }
#if SB_EXIT
    if (!FOX) { if (__syncthreads_and(R < -110.f)) break; } else __syncthreads();
#else
    __syncthreads();
#endif
  }
  if (SPLIT) {
    constexpr int NS = 8;
    const int bh = b * 8 + h;
    float* po = (float*)(p.ws + WS_F) + (size_t)(bh * NS) * 4096;
    float* pml = (float*)(p.ws + WS_F) + (size_t)128 * NS * 4096 + (size_t)(bh * NS) * 128;
    const float lt = lrun + __shfl_xor(lrun, 32);
    if (wid < 2) {
      float* dst = po + (size_t)split * 4096 + qi * 64;
#pragma unroll
      for (int d = 0; d < 2; ++d)
#pragma unroll
        for (int g4 = 0; g4 < 4; ++g4) *(float4*)(dst + d * 32 + 8 * g4 + 4 * hh) = make_float4(o[d][4 * g4], o[d][4 * g4 + 1], o[d][4 * g4 + 2], o[d][4 * g4 + 3]);
      if (hh == 0) *(float2*)(pml + (size_t)split * 128 + qi * 2) = make_float2(mrun, lt);
    }
    int* slot2 = (int*)(smem + 73728 + 528);
    asm volatile("s_waitcnt vmcnt(0)" ::: "memory");
    __syncthreads();
    if (tid == 0) {
      __builtin_amdgcn_fence(__ATOMIC_RELEASE, "agent");
      asm volatile("s_waitcnt vmcnt(0)" ::: "memory");
      const unsigned old = __hip_atomic_fetch_add((unsigned*)(p.ws + WS_BAR + 256) + bh + (do_ssq ? 0 : 128), 1u, __ATOMIC_RELAXED, __HIP_MEMORY_SCOPE_AGENT);
      __builtin_amdgcn_fence(__ATOMIC_ACQUIRE, "agent");
      asm volatile("s_waitcnt vmcnt(0)" ::: "memory");
      *slot2 = (int)old;
    }
    __syncthreads();
    const bool last = (*slot2 == NS - 1);
    __syncthreads();
    if (last) {
      const int q = tid >> 2, d0 = (tid & 3) * 16;
      float ms[NS], ls[NS], M = -1e30f;
#pragma unroll
      for (int s2 = 0; s2 < NS; ++s2) { const float2 ml = *(const float2*)(pml + (size_t)s2 * 128 + q * 2); ms[s2] = ml.x; ls[s2] = ml.y; M = fmaxf(M, ml.x); }
      float L = 0.f, acc[16];
#pragma unroll
      for (int k = 0; k < 16; ++k) acc[k] = 0.f;
#pragma unroll
      for (int s2 = 0; s2 < NS; ++s2) {
        const float w = exp2f(ms[s2] - M);
        L += ls[s2] * w;
        const float4* src = (const float4*)(po + (size_t)s2 * 4096 + q * 64 + d0);
#pragma unroll
        for (int k4 = 0; k4 < 4; ++k4) { const float4 v = src[k4]; acc[4 * k4] += w * v.x; acc[4 * k4 + 1] += w * v.y; acc[4 * k4 + 2] += w * v.z; acc[4 * k4 + 3] += w * v.w; }
      }
      const float invL = 1.f / L;
      float ssq = 0.f;
#pragma unroll
      for (int k = 0; k < 16; ++k) { acc[k] *= invL; ssq += acc[k] * acc[k]; }
      ssq += __shfl_xor(ssq, 1); ssq += __shfl_xor(ssq, 2);
      const int gq = NTP + b * DSEQ + q;
      if (do_ssq && (tid & 3) == 0) atomicAdd((float*)(p.ws + WS_SSQ) + (size_t)gq * 2 + 1, ssq);
      u16* od = (u16*)(p.ws + WS_E) + (size_t)gq * DM + 512 + h * 64 + d0;
      *(uint4*)od = make_uint4(pk2(acc[0], acc[1]), pk2(acc[2], acc[3]), pk2(acc[4], acc[5]), pk2(acc[6], acc[7]));
      *(uint4*)(od + 8) = make_uint4(pk2(acc[8], acc[9]), pk2(acc[10], acc[11]), pk2(acc[12], acc[13]), pk2(acc[14], acc[15]));
    }
    return;
  }
  float inv = 1.f;
  if (FOX) { const float lt = lrun + __shfl_xor(lrun, 32); inv = 1.f / lt; }
  {
    float ssq = 0.f;
#pragma unroll
    for (int d = 0; d < 2; ++d)
#pragma unroll
      for (int e = 0; e < 16; ++e) { const float t = o[d][e] * inv; ssq += t * t; }
    ssq += __shfl_xor(ssq, 32);
    if (do_ssq && hh == 0 && (!smp || wid < 2)) atomicAdd((float*)(p.ws + WS_SSQ) + (size_t)g * 2 + (FOX ? 1 : 0), ssq);
  }
  if (!smp || wid < 2) {
    u16* od = (u16*)(p.ws + WS_E) + (size_t)g * DM + (FOX ? 512 : 0) + h * 64;
#pragma unroll
    for (int d = 0; d < 2; ++d)
#pragma unroll
      for (int g4 = 0; g4 < 4; ++g4)
        *(uint2*)(od + d * 32 + 8 * g4 + 4 * hh) = make_uint2(pk2(o[d][4 * g4] * inv, o[d][4 * g4 + 1] * inv), pk2(o[d][4 * g4 + 2] * inv, o[d][4 * g4 + 3] * inv));
  }
}

template <class F>
DI void attn_queue(unsigned* ctr, int n, int* slot, F body) {
  for (;;) {
    if (threadIdx.x == 0) *slot = (int)atomicAdd(ctr, 1u);
    __syncthreads();
    const int it = *slot;
    __syncthreads();
    if (it >= n) break;
    body(it);
  }
}
DI void phase_attn(const Params& p, char* smem, int rep = 0) {
  unsigned* ctr = (unsigned*)(p.ws + WS_BAR + 128) + rep * 4;
  int* slot = (int*)(smem + 73728 + 512);
  const bool dq = rep == 0;
  attn_queue(ctr + 0, 1024, slot, [&](int it) { const int bh = it >> 3; attn_item<true, true>(p, bh >> 3, bh & 7, 0, smem, dq, it & 7); });
  attn_queue(ctr + 1, 2048, slot, [&](int u) { const int w = u & 511; const int qb = 15 - (w >> 5), bh = (u >> 9) * 32 + (w & 31); attn_item<true, false>(p, bh >> 3, bh & 7, qb, smem, dq); });
  attn_queue(ctr + 2, 128, slot, [&](int u) { attn_item<false, true>(p, u >> 3, u & 7, 0, smem, dq); });
  attn_queue(ctr + 3, 2048, slot, [&](int u) { const int w = u & 511; const int qb = 15 - (w >> 5), bh = (u >> 9) * 32 + (w & 31); attn_item<false, false>(p, bh >> 3, bh & 7, qb, smem, dq); });
}

DI void phase_wout(const Params& p, char* smem) {
  float* pre = (float*)(p.ws + WS_A);
  const u16* o = (const u16*)(p.ws + WS_E);
  float* sc_s = (float*)(smem + 73728);
  for_tiles(DM, [&](int m0, int n0, auto tag) {
    constexpr int MI = decltype(tag)::value;
    {
      const int tid = threadIdx.x;
      if (tid < MI * 64) {
        const float2 q = ((const float2*)(p.ws + WS_SSQ))[m0 + tid];
        const float s0 = rsqrtf(q.x * (1.f / 512.f) + 1e-6f), s1 = rsqrtf(q.y * (1.f / 512.f) + 1e-6f);
        sc_s[tid * 2] = s0 / s1; sc_s[tid * 2 + 1] = s1;
      }
      __syncthreads();
    }
    GldsBf16<MI * 64> al; al.base = o + (size_t)m0 * DM; al.ld = DM;
    const float* xr = xrow(p, m0);
    auto epi = [=](int r0, int c0, const f32x16& acc) {
      const int lane = threadIdx.x & 63, hh = lane >> 5, col = c0 + (lane & 31);
      const unsigned b0 = (unsigned)(r0 + 4 * hh) * 1024u + col, b1 = (unsigned)(r0 - m0 + 4 * hh) * 1024u + col;
#pragma unroll
      for (int e = 0; e < 16; ++e) pre[b0 + ACC_R0(e) * 1024u] = DN_ALPHA * xr[b1 + ACC_R0(e) * 1024u] + acc[e];
    };
    gemm_tile<MI, true>(al, (const u16*)(p.ws + WS_WOUT), DM, DM, m0, n0, epi, smem, sc_s);
  });
}

DI void phase_ln(const Params& p, const float* gam, const float* bet) {
  const float* pre = (const float*)(p.ws + WS_A);
  float* xf = (float*)(p.ws + WS_B);
  u16* xb = (u16*)(p.ws + WS_C);
  const int lane = threadIdx.x & 63;
  const int wg = blockIdx.x * 4 + (threadIdx.x >> 6), nw = gridDim.x * 4;
  for (int row0 = wg * 2; row0 < NT; row0 += nw * 2) {
    float4 v[2][4];
    float s[2], q[2];
#pragma unroll
    for (int r = 0; r < 2; ++r) {
      s[r] = 0.f;
#pragma unroll
      for (int j = 0; j < 4; ++j) { v[r][j] = ((const float4*)(pre + (size_t)(row0 + r) * DM))[lane + 64 * j]; s[r] += v[r][j].x + v[r][j].y + v[r][j].z + v[r][j].w; }
    }
#pragma unroll
    for (int o = 32; o >= 1; o >>= 1)
#pragma unroll
      for (int r = 0; r < 2; ++r) s[r] += __shfl_xor(s[r], o);
#pragma unroll
    for (int r = 0; r < 2; ++r) {
      s[r] *= (1.f / 1024.f); q[r] = 0.f;
#pragma unroll
      for (int j = 0; j < 4; ++j) { const float a = v[r][j].x - s[r], b2 = v[r][j].y - s[r], c = v[r][j].z - s[r], d = v[r][j].w - s[r]; q[r] += a * a + b2 * b2 + c * c + d * d; }
    }
#pragma unroll
    for (int o = 32; o >= 1; o >>= 1)
#pragma unroll
      for (int r = 0; r < 2; ++r) q[r] += __shfl_xor(q[r], o);
#pragma unroll
    for (int r = 0; r < 2; ++r) {
      const float mu = s[r], rs = rsqrtf(q[r] * (1.f / 1024.f) + 1e-5f);
#pragma unroll
      for (int j = 0; j < 4; ++j) {
        const float4 gg = ((const float4*)gam)[lane + 64 * j], bb = ((const float4*)bet)[lane + 64 * j];
        float4 y;
        y.x = (v[r][j].x - mu) * rs * gg.x + bb.x; y.y = (v[r][j].y - mu) * rs * gg.y + bb.y;
        y.z = (v[r][j].z - mu) * rs * gg.z + bb.z; y.w = (v[r][j].w - mu) * rs * gg.w + bb.w;
        ((float4*)(xf + (size_t)(row0 + r) * DM))[lane + 64 * j] = y;
        ((uint2*)(xb + (size_t)(row0 + r) * DM))[lane + 64 * j] = make_uint2(pk2(y.x, y.y), pk2(y.z, y.w));
      }
    }
  }
}

template <bool NOEPI = false>
DI void phase_gemm_bf16(const Params& p, const u16* A, const u16* Wt, int N, u16* O, float scale, char* smem) {
  for_tiles(N, [&](int m0, int n0, auto tag) {
    constexpr int MI = decltype(tag)::value;
    GldsBf16<MI * 64> al; al.base = A + (size_t)m0 * DM; al.ld = DM;
    auto epi = [=](int r0, int c0, const f32x16& acc) {
      const int lane = threadIdx.x & 63, hh = lane >> 5, col = c0 + (lane & 31);
      const unsigned b0 = (unsigned)(r0 + 4 * hh) * (unsigned)N + col;
      if (NOEPI) { float t = 0.f;
#pragma unroll
        for (int e = 0; e < 16; ++e) t += acc[e];
        if (t == 12345.678f) O[b0] = bf1(t);
        return; }
#pragma unroll
      for (int e = 0; e < 16; ++e) O[b0 + ACC_R0(e) * (unsigned)N] = bf1(acc[e] * scale);
    };
    gemm_tile<MI>(al, Wt, DM, DM, m0, n0, epi, smem);
  });
}

template <class F>
DI void for_mem_tiles(F body) {
  const int vb = vblock(), nb = gridDim.x;
  for (int t = vb; t < 2048 + 256; t += nb) {
    if (t < 2048) { const int mt = t >> 3; body(mt * 128, (t >> 1) & 3, (t & 1) * 128, mt >> 4, IC<2>{}); }
    else { const int u = t - 2048; const int mt = u >> 4; body(NTP + mt * 64, (u >> 2) & 3, (u & 3) * 64, 16 + mt, IC<1>{}); }
  }
}
DI void phase_mem_s(const Params& p, char* smem) {
  const u16* qm = (const u16*)(p.ws + WS_D);
  float* S = (float*)(p.ws + WS_F);
  for_mem_tiles([&](int m0, int hd, int n0, int batch, auto tag) {
    constexpr int MI = decltype(tag)::value;
    GldsBf16<MI * 64> al; al.base = qm + (size_t)m0 * DM + hd * 256; al.ld = DM;
    const u16* Bt = (const u16*)(p.ws + WS_MEMK) + (size_t)batch * 256 * DM + hd * 256;
    auto epi = [=](int r0, int c0, const f32x16& acc) {
      const int lane = threadIdx.x & 63, hh = lane >> 5, col = c0 + (lane & 31);
      const unsigned b0 = (unsigned)(r0 + 4 * hh) * 1024u + hd * 256 + col;
#pragma unroll
      for (int e = 0; e < 16; ++e) S[b0 + ACC_R0(e) * 1024u] = acc[e];
    };
    gemm_tile<MI>(al, Bt, DM, 256, m0, n0, epi, smem);
  });
}
DI void phase_mem_softmax(const Params& p) {
  const float* S = (const float*)(p.ws + WS_F);
  u16* P = (u16*)(p.ws + WS_D);
  const int lane = threadIdx.x & 63;
  const int wg = blockIdx.x * 4 + (threadIdx.x >> 6), nw = gridDim.x * 4;
  for (int row0 = wg * 4; row0 < NT * 4; row0 += nw * 4) {
    float4 v[4]; float m[4], sm[4];
#pragma unroll
    for (int r = 0; r < 4; ++r) v[r] = ((const float4*)(S + (size_t)(row0 + r) * 256))[lane];
#pragma unroll
    for (int r = 0; r < 4; ++r) m[r] = fmaxf(fmaxf(v[r].x, v[r].y), fmaxf(v[r].z, v[r].w));
#pragma unroll
    for (int o = 32; o >= 1; o >>= 1)
#pragma unroll
      for (int r = 0; r < 4; ++r) m[r] = fmaxf(m[r], __shfl_xor(m[r], o));
#pragma unroll
    for (int r = 0; r < 4; ++r) { v[r].x = __expf(v[r].x - m[r]); v[r].y = __expf(v[r].y - m[r]); v[r].z = __expf(v[r].z - m[r]); v[r].w = __expf(v[r].w - m[r]); sm[r] = v[r].x + v[r].y + v[r].z + v[r].w; }
#pragma unroll
    for (int o = 32; o >= 1; o >>= 1)
#pragma unroll
      for (int r = 0; r < 4; ++r) sm[r] += __shfl_xor(sm[r], o);
#pragma unroll
    for (int r = 0; r < 4; ++r) { const float inv = 1.f / sm[r]; ((uint2*)(P + (size_t)(row0 + r) * 256))[lane] = make_uint2(pk2(v[r].x * inv, v[r].y * inv), pk2(v[r].z * inv, v[r].w * inv)); }
  }
}
DI void phase_mem_pv(const Params& p, char* smem) {
  const u16* P = (const u16*)(p.ws + WS_D);
  u16* om = (u16*)(p.ws + WS_E);
  for_mem_tiles([&](int m0, int hd, int n0, int batch, auto tag) {
    constexpr int MI = decltype(tag)::value;
    GldsBf16<MI * 64> al; al.base = P + (size_t)m0 * DM + hd * 256; al.ld = DM;
    const u16* Bt = (const u16*)(p.ws + WS_MEMVT) + ((size_t)batch * DM + hd * 256) * 256;
    auto epi = [=](int r0, int c0, const f32x16& acc) {
      const int lane = threadIdx.x & 63, hh = lane >> 5, col = c0 + (lane & 31);
      const unsigned b0 = (unsigned)(r0 + 4 * hh) * 1024u + hd * 256 + col;
#pragma unroll
      for (int e = 0; e < 16; ++e) om[b0 + ACC_R0(e) * 1024u] = bf1(acc[e]);
    };
    gemm_tile<MI>(al, Bt, 256, 256, m0, n0, epi, smem);
  });
}
DI void phase_wmo(const Params& p, char* smem) {
  float* pre = (float*)(p.ws + WS_A);
  const float* xf = (const float*)(p.ws + WS_B);
  const u16* om = (const u16*)(p.ws + WS_E);
  for_tiles(DM, [&](int m0, int n0, auto tag) {
    constexpr int MI = decltype(tag)::value;
    GldsBf16<MI * 64> al; al.base = om + (size_t)m0 * DM; al.ld = DM;
    auto epi = [=](int r0, int c0, const f32x16& acc) {
      const int lane = threadIdx.x & 63, hh = lane >> 5, col = c0 + (lane & 31);
      const unsigned b0 = (unsigned)(r0 + 4 * hh) * 1024u + col;
#pragma unroll
      for (int e = 0; e < 16; ++e) { const unsigned i = b0 + ACC_R0(e) * 1024u; pre[i] = DN_ALPHA * xf[i] + acc[e]; }
    };
    gemm_tile<MI>(al, (const u16*)(p.ws + WS_WMO), DM, DM, m0, n0, epi, smem);
  });
}

DI void insert16(float (&v)[16], float x) {
#pragma unroll
  for (int j = 15; j >= 1; --j) v[j] = __builtin_amdgcn_fmed3f(x, v[j - 1], v[j]);
  v[0] = fmaxf(v[0], x);
}
DI void phase_topk(const Params& p, char* smem) {
  const int vb = vblock(), nb = gridDim.x;
  const u16* qp = (const u16*)(p.ws + WS_F);
  int* idxo = (int*)(p.ws + WS_A);
  float* gato = (float*)(p.ws + WS_A + (size_t)NT * 128 * 4);
  float* sc = (float*)smem;
  const int tid = threadIdx.x;
  for (int t = vb; t < 264 * 8; t += nb) {
    const int mt = t >> 3, hd = t & 7;
    const int m0 = mt * 128;
    float va[16], vbv[16];
#pragma unroll
    for (int side = 0; side < 2; ++side) {
      GldsBf16<128> al; al.base = qp + (size_t)m0 * 2048 + hd * 256 + side * 128; al.ld = 2048;
      const u16* Bt = (const u16*)(p.ws + (side ? WS_KB : WS_KA)) + (size_t)hd * 128 * 128;
      auto epi = [=](int r0, int c0, const f32x16& acc) {
        const int lane = threadIdx.x & 63, hh = lane >> 5, col = c0 + (lane & 31);
#pragma unroll
        for (int e = 0; e < 16; ++e) sc[(r0 - m0 + ACC_ROW(e, hh)) * 129 + col] = acc[e];
      };
      gemm_tile<2>(al, Bt, 128, 128, m0, 0, epi, smem);
      __syncthreads();
      {
        const int row = tid & 127, half = tid >> 7;
        float* mg = (float*)(smem + 66048);
        float v[16];
#pragma unroll
        for (int j = 0; j < 16; ++j) v[j] = -INFINITY;
        for (int k = 64 * half; k < 64 * half + 64; ++k) {
          const float x = __uint_as_float((__float_as_uint(sc[row * 129 + k]) & ~0x7Fu) | (unsigned)k);
          insert16(v, x);
        }
        if (half == 1) {
#pragma unroll
          for (int j = 0; j < 16; ++j) mg[row * 17 + j] = v[j];
        }
        __syncthreads();
        if (half == 0) {
#pragma unroll
          for (int j = 0; j < 16; ++j) insert16(v, mg[row * 17 + j]);
#pragma unroll
          for (int j = 0; j < 16; ++j) { if (side == 0) va[j] = v[j]; else vbv[j] = v[j]; }
        }
      }
      __syncthreads();
    }
    unsigned char* ids = (unsigned char*)smem;
    if (tid < 128) {
#pragma unroll
      for (int j = 0; j < 16; ++j) { ids[tid * 32 + j] = (unsigned char)(__float_as_uint(va[j]) & 0x7F); ids[tid * 32 + 16 + j] = (unsigned char)(__float_as_uint(vbv[j]) & 0x7F); }
      float top[16];
#pragma unroll
      for (int j = 0; j < 16; ++j) top[j] = -INFINITY;
#pragma unroll
      for (int i = 0; i < 16; ++i)
#pragma unroll
        for (int j = 0; j < 16; ++j)
          if ((i + 1) * (j + 1) <= 16) {
            const float a = __uint_as_float(__float_as_uint(va[i]) & ~0x7Fu), b = __uint_as_float(__float_as_uint(vbv[j]) & ~0x7Fu);
            const float c = __uint_as_float((__float_as_uint(a + b) & ~0xFFu) | (unsigned)(i * 16 + j));
            insert16(top, c);
          }
      const float m = __uint_as_float(__float_as_uint(top[0]) & ~0xFFu);
      float ex[16], ssum = 0.f;
      int eid[16];
#pragma unroll
      for (int j = 0; j < 16; ++j) {
        const unsigned bits = __float_as_uint(top[j]);
        const int code = bits & 0xFF;
        ex[j] = __expf(__uint_as_float(bits & ~0xFFu) - m); ssum += ex[j];
        eid[j] = (int)ids[tid * 32 + (code >> 4)] * 128 + (int)ids[tid * 32 + 16 + (code & 15)];
      }
      const float inv = 1.f / ssum;
      const size_t ob = (size_t)(m0 + tid) * 128 + hd * 16;
#pragma unroll
      for (int j4 = 0; j4 < 4; ++j4) {
        *(int4*)(idxo + ob + 4 * j4) = make_int4(eid[4 * j4], eid[4 * j4 + 1], eid[4 * j4 + 2], eid[4 * j4 + 3]);
        *(float4*)(gato + ob + 4 * j4) = make_float4(ex[4 * j4] * inv, ex[4 * j4 + 1] * inv, ex[4 * j4 + 2] * inv, ex[4 * j4 + 3] * inv);
      }
    }
    __syncthreads();
  }
}

#if USE_FP8
typedef float f32x2v __attribute__((ext_vector_type(2)));
DI void unpack16(const uint4& v, float (&f)[16]) {
  const unsigned w[4] = {v.x, v.y, v.z, v.w};
#pragma unroll
  for (int j = 0; j < 4; ++j) {
    const f32x2v lo = __builtin_amdgcn_cvt_pk_f32_fp8((int)w[j], false), hi = __builtin_amdgcn_cvt_pk_f32_fp8((int)w[j], true);
    f[4 * j] = lo[0]; f[4 * j + 1] = lo[1]; f[4 * j + 2] = hi[0]; f[4 * j + 3] = hi[1];
  }
}
DI void peer_dot8(const char* U, int idreg, int e0, int lane, const float (&x)[16], float& dacc) {
  uint4 w[8];
#pragma unroll
  for (int j = 0; j < 8; ++j) { const int id = __builtin_amdgcn_readlane(idreg, e0 + j); w[j] = *(const uint4*)(U + (size_t)id * DM + 16 * lane); }
  float s[8];
#pragma unroll
  for (int j = 0; j < 8; ++j) {
    float f[16]; unpack16(w[j], f);
    float a = 0.f;
#pragma unroll
    for (int k = 0; k < 16; ++k) a += f[k] * x[k];
    s[j] = a;
  }
  const bool b5 = lane & 32, b4 = lane & 16, b3 = lane & 8;
  float t4[4], t2[2], t1;
#pragma unroll
  for (int i = 0; i < 4; ++i) { const float snd = b5 ? s[i] : s[4 + i], kp = b5 ? s[4 + i] : s[i]; t4[i] = kp + __shfl_xor(snd, 32); }
#pragma unroll
  for (int i = 0; i < 2; ++i) { const float snd = b4 ? t4[i] : t4[2 + i], kp = b4 ? t4[2 + i] : t4[i]; t2[i] = kp + __shfl_xor(snd, 16); }
  { const float snd = b3 ? t2[0] : t2[1], kp = b3 ? t2[1] : t2[0]; t1 = kp + __shfl_xor(snd, 8); }
  t1 += __shfl_xor(t1, 4); t1 += __shfl_xor(t1, 2); t1 += __shfl_xor(t1, 1);
  const float g = __shfl(t1, (lane & 7) * 8);
  if ((lane >> 3) == (e0 >> 3)) dacc = g;
}
DI void peer_axpy8(const char* V, int idreg, float hreg, int e0, int lane, float (&acc)[16]) {
  uint4 w[8];
#pragma unroll
  for (int j = 0; j < 8; ++j) { const int id = __builtin_amdgcn_readlane(idreg, e0 + j); w[j] = *(const uint4*)(V + (size_t)id * DM + 16 * lane); }
#pragma unroll
  for (int j = 0; j < 8; ++j) {
    const float hs = __uint_as_float(__builtin_amdgcn_readlane(__float_as_uint(hreg), e0 + j));
    float f[16]; unpack16(w[j], f);
#pragma unroll
    for (int k = 0; k < 16; ++k) acc[k] += hs * f[k];
  }
}
DI void peer_sort(int& id0, int& id1, float& g0, float& g1, int lane) {
  unsigned k0 = ((unsigned)id0 << 7) | (unsigned)lane, k1 = ((unsigned)id1 << 7) | (unsigned)(lane + 64);
#pragma unroll
  for (int k = 2; k <= 128; k <<= 1) {
#pragma unroll
    for (int j = k >> 1; j >= 1; j >>= 1) {
      if (j == 64) {
        const unsigned lo = min(k0, k1), hi = max(k0, k1); k0 = lo; k1 = hi;
      } else {
        const unsigned p0 = (unsigned)__shfl_xor((int)k0, j), p1 = (unsigned)__shfl_xor((int)k1, j);
        const bool upper = (lane & j) != 0;
        const bool asc0 = ((lane & k) == 0), asc1 = (((lane + 64) & k) == 0);
        k0 = (upper == asc0) ? max(k0, p0) : min(k0, p0);
        k1 = (upper == asc1) ? max(k1, p1) : min(k1, p1);
      }
    }
  }
  const int s0 = k0 & 127, s1 = k1 & 127;
  const float a0 = __shfl(g0, s0 & 63), b0 = __shfl(g1, s0 & 63), a1 = __shfl(g0, s1 & 63), b1 = __shfl(g1, s1 & 63);
  g0 = (s0 < 64) ? a0 : b0; g1 = (s1 < 64) ? a1 : b1;
  id0 = (int)(k0 >> 7); id1 = (int)(k1 >> 7);
}
DI void peer_load(const Params& p, int row, int lane, float (&x)[16], int& id0, int& id1, float& g0, float& g1) {
  const float* xf = (const float*)(p.ws + WS_B);
  const int* idxo = (const int*)(p.ws + WS_A);
  const float* gato = (const float*)(p.ws + WS_A + (size_t)NT * 128 * 4);
  const float4* xr = (const float4*)(xf + (size_t)row * DM) + 4 * lane;
#pragma unroll
  for (int j = 0; j < 4; ++j) { const float4 a = xr[j]; x[4 * j] = a.x; x[4 * j + 1] = a.y; x[4 * j + 2] = a.z; x[4 * j + 3] = a.w; }
  id0 = idxo[(size_t)row * 128 + lane]; id1 = idxo[(size_t)row * 128 + 64 + lane];
  g0 = gato[(size_t)row * 128 + lane]; g1 = gato[(size_t)row * 128 + 64 + lane];
  peer_sort(id0, id1, g0, g1, lane);
}
DI void peer_finish(const Params& p, int row, int lane, const float (&x)[16], float (&acc)[16]) {
  float s = 0.f;
#pragma unroll
  for (int k = 0; k < 16; ++k) { acc[k] = DN_ALPHA * x[k] + acc[k]; s += acc[k]; }
  const float mu = wave_sum(s) * (1.f / 1024.f);
  float q = 0.f;
#pragma unroll
  for (int k = 0; k < 16; ++k) { const float dd = acc[k] - mu; q += dd * dd; }
  const float rs = rsqrtf(wave_sum(q) * (1.f / 1024.f) + 1e-5f);
  float* y = (row < NTP) ? p.out + OUT_YP + (size_t)row * DM : p.out + OUT_YS + (size_t)(row - NTP) * DM;
#pragma unroll
  for (int j = 0; j < 4; ++j) {
    const float4 ga = ((const float4*)p.ln3_g)[4 * lane + j], ba = ((const float4*)p.ln3_b)[4 * lane + j];
    float4 ya;
    ya.x = (acc[4 * j + 0] - mu) * rs * ga.x + ba.x; ya.y = (acc[4 * j + 1] - mu) * rs * ga.y + ba.y;
    ya.z = (acc[4 * j + 2] - mu) * rs * ga.z + ba.z; ya.w = (acc[4 * j + 3] - mu) * rs * ga.w + ba.w;
    ((float4*)y)[4 * lane + j] = ya;
  }
}
DI float peer_gelu_gate(float d, float g) { return 0.5f * d * (1.f + erff(d * 0.7071067811865476f)) * g; }
DI void phase_peer(const Params& p) {
  const char* U = p.ws + WS_U;
  const char* V = p.ws + WS_V;
  const float* usc = (const float*)(p.ws + WS_USC);
  const float* vsc = (const float*)(p.ws + WS_VSC);
  const int lane = threadIdx.x & 63;
  const int wg = blockIdx.x * 4 + (threadIdx.x >> 6), nw = gridDim.x * 4;
  for (int rowA = wg; rowA < NT; rowA += 2 * nw) {
    const bool hasB = rowA + nw < NT;
    const int rowB = hasB ? rowA + nw : rowA;
    float xA[16], xB[16];
    int a0, a1, b0, b1; float ga0, ga1, gb0, gb1;
    peer_load(p, rowA, lane, xA, a0, a1, ga0, ga1);
    peer_load(p, rowB, lane, xB, b0, b1, gb0, gb1);
    const float sua0 = usc[a0], sua1 = usc[a1], sva0 = vsc[a0], sva1 = vsc[a1];
    const float sub0 = usc[b0], sub1 = usc[b1], svb0 = vsc[b0], svb1 = vsc[b1];
    float da0 = 0.f, da1 = 0.f, db0 = 0.f, db1 = 0.f;
#pragma unroll 1
    for (int e0 = 0; e0 < 64; e0 += 8) { peer_dot8(U, a0, e0, lane, xA, da0); peer_dot8(U, b0, e0, lane, xB, db0); }
#pragma unroll 1
    for (int e0 = 0; e0 < 64; e0 += 8) { peer_dot8(U, a1, e0, lane, xA, da1); peer_dot8(U, b1, e0, lane, xB, db1); }
    const float ha0 = peer_gelu_gate(da0 * sua0, ga0) * sva0, ha1 = peer_gelu_gate(da1 * sua1, ga1) * sva1;
    const float hb0 = peer_gelu_gate(db0 * sub0, gb0) * svb0, hb1 = peer_gelu_gate(db1 * sub1, gb1) * svb1;
    float accA[16], accB[16];
#pragma unroll
    for (int k = 0; k < 16; ++k) { accA[k] = 0.f; accB[k] = 0.f; }
#pragma unroll 1
    for (int e0 = 0; e0 < 64; e0 += 8) { peer_axpy8(V, a0, ha0, e0, lane, accA); peer_axpy8(V, b0, hb0, e0, lane, accB); }
#pragma unroll 1
    for (int e0 = 0; e0 < 64; e0 += 8) { peer_axpy8(V, a1, ha1, e0, lane, accA); peer_axpy8(V, b1, hb1, e0, lane, accB); }
    peer_finish(p, rowA, lane, xA, accA);
    if (hasB) peer_finish(p, rowB, lane, xB, accB);
  }
}
#else
DI void unpack8(const uint4& v, float (&f)[8]) {
  f[0] = bflo(v.x); f[1] = bfhi(v.x); f[2] = bflo(v.y); f[3] = bfhi(v.y); f[4] = bflo(v.z); f[5] = bfhi(v.z); f[6] = bflo(v.w); f[7] = bfhi(v.w);
}
DI void phase_peer(const Params& p) {
  const float* xf = (const float*)(p.ws + WS_B);
  const int* idxo = (const int*)(p.ws + WS_A);
  const float* gato = (const float*)(p.ws + WS_A + (size_t)NT * 128 * 4);
  const u16* U = (const u16*)(p.ws + WS_U);
  const u16* V = (const u16*)(p.ws + WS_V);
  const int lane = threadIdx.x & 63;
  const int wg = blockIdx.x * 4 + (threadIdx.x >> 6), nw = gridDim.x * 4;
  for (int row = wg; row < NT; row += nw) {
    float x[16];
    {
      const float4* xr = (const float4*)(xf + (size_t)row * DM);
      const float4 a = xr[2 * lane], b = xr[2 * lane + 1], c = xr[128 + 2 * lane], d = xr[128 + 2 * lane + 1];
      x[0] = a.x; x[1] = a.y; x[2] = a.z; x[3] = a.w; x[4] = b.x; x[5] = b.y; x[6] = b.z; x[7] = b.w;
      x[8] = c.x; x[9] = c.y; x[10] = c.z; x[11] = c.w; x[12] = d.x; x[13] = d.y; x[14] = d.z; x[15] = d.w;
    }
    const int id0 = idxo[(size_t)row * 128 + lane], id1 = idxo[(size_t)row * 128 + 64 + lane];
    const float g0 = gato[(size_t)row * 128 + lane], g1 = gato[(size_t)row * 128 + 64 + lane];
    float d0 = 0.f, d1 = 0.f;
#pragma unroll 8
    for (int e = 0; e < 64; ++e) {
      const int id = __builtin_amdgcn_readlane(id0, e);
      const uint4* ur = (const uint4*)(U + (size_t)id * DM);
      const uint4 ua = ur[lane], ub = ur[64 + lane];
      float f[8], s = 0.f;
      unpack8(ua, f);
#pragma unroll
      for (int k = 0; k < 8; ++k) s += f[k] * x[k];
      unpack8(ub, f);
#pragma unroll
      for (int k = 0; k < 8; ++k) s += f[k] * x[8 + k];
      s = wave_sum(s);
      if (lane == e) d0 = s;
    }
#pragma unroll 8
    for (int e = 0; e < 64; ++e) {
      const int id = __builtin_amdgcn_readlane(id1, e);
      const uint4* ur = (const uint4*)(U + (size_t)id * DM);
      const uint4 ua = ur[lane], ub = ur[64 + lane];
      float f[8], s = 0.f;
      unpack8(ua, f);
#pragma unroll
      for (int k = 0; k < 8; ++k) s += f[k] * x[k];
      unpack8(ub, f);
#pragma unroll
      for (int k = 0; k < 8; ++k) s += f[k] * x[8 + k];
      s = wave_sum(s);
      if (lane == e) d1 = s;
    }
    const float h0 = 0.5f * d0 * (1.f + erff(d0 * 0.7071067811865476f)) * g0;
    const float h1 = 0.5f * d1 * (1.f + erff(d1 * 0.7071067811865476f)) * g1;
    float acc[16];
#pragma unroll
    for (int k = 0; k < 16; ++k) acc[k] = 0.f;
#pragma unroll 8
    for (int e = 0; e < 64; ++e) {
      const int id = __builtin_amdgcn_readlane(id0, e);
      const float hs = __uint_as_float(__builtin_amdgcn_readlane(__float_as_uint(h0), e));
      const uint4* vr = (const uint4*)(V + (size_t)id * DM);
      const uint4 va = vr[lane], vb2 = vr[64 + lane];
      float f[8];
      unpack8(va, f);
#pragma unroll
      for (int k = 0; k < 8; ++k) acc[k] += hs * f[k];
      unpack8(vb2, f);
#pragma unroll
      for (int k = 0; k < 8; ++k) acc[8 + k] += hs * f[k];
    }
#pragma unroll 8
    for (int e = 0; e < 64; ++e) {
      const int id = __builtin_amdgcn_readlane(id1, e);
      const float hs = __uint_as_float(__builtin_amdgcn_readlane(__float_as_uint(h1), e));
      const uint4* vr = (const uint4*)(V + (size_t)id * DM);
      const uint4 va = vr[lane], vb2 = vr[64 + lane];
      float f[8];
      unpack8(va, f);
#pragma unroll
      for (int k = 0; k < 8; ++k) acc[k] += hs * f[k];
      unpack8(vb2, f);
#pragma unroll
      for (int k = 0; k < 8; ++k) acc[8 + k] += hs * f[k];
    }
    float s = 0.f;
#pragma unroll
    for (int k = 0; k < 16; ++k) { acc[k] = DN_ALPHA * x[k] + acc[k]; s += acc[k]; }
    const float mu = wave_sum(s) * (1.f / 1024.f);
    float q = 0.f;
#pragma unroll
    for (int k = 0; k < 16; ++k) { const float dd = acc[k] - mu; q += dd * dd; }
    const float rs = rsqrtf(wave_sum(q) * (1.f / 1024.f) + 1e-5f);
    float* y = (row < NTP) ? p.out + OUT_YP + (size_t)row * DM : p.out + OUT_YS + (size_t)(row - NTP) * DM;
#pragma unroll
    for (int c = 0; c < 2; ++c) {
      const int off = c * 512 + lane * 8;
      const float4 ga = *(const float4*)(p.ln3_g + off), gb = *(const float4*)(p.ln3_g + off + 4);
      const float4 ba = *(const float4*)(p.ln3_b + off), bb = *(const float4*)(p.ln3_b + off + 4);
      float4 ya, yb;
      ya.x = (acc[8 * c + 0] - mu) * rs * ga.x + ba.x; ya.y = (acc[8 * c + 1] - mu) * rs * ga.y + ba.y;
      ya.z = (acc[8 * c + 2] - mu) * rs * ga.z + ba.z; ya.w = (acc[8 * c + 3] - mu) * rs * ga.w + ba.w;
      yb.x = (acc[8 * c + 4] - mu) * rs * gb.x + bb.x; yb.y = (acc[8 * c + 5] - mu) * rs * gb.y + bb.y;
      yb.z = (acc[8 * c + 6] - mu) * rs * gb.z + bb.z; yb.w = (acc[8 * c + 7] - mu) * rs * gb.w + bb.w;
      *(float4*)(y + off) = ya; *(float4*)(y + off + 4) = yb;
    }
  }
}

#endif

constexpr int NPHASE = 15;
template <int PH>
DI void run_phase(const Params& p, char* smem) {
  if (PH == 0) phase_prep(p, smem);
  else if (PH == 1) phase_proj(p, smem);
  else if (PH == 2) phase_scan(p, smem);
  else if (PH == 3) phase_attn(p, smem);
  else if (PH == 4) phase_wout(p, smem);
  else if (PH == 5) phase_ln(p, p.ln1_g, p.ln1_b);
  else if (PH == 6) phase_gemm_bf16(p, (const u16*)(p.ws + WS_C), (const u16*)(p.ws + WS_WMQ), 1024, (u16*)(p.ws + WS_D), 0.0625f, smem);
  else if (PH == 7) phase_mem_s(p, smem);
  else if (PH == 8) phase_mem_softmax(p);
  else if (PH == 9) phase_mem_pv(p, smem);
  else if (PH == 10) phase_wmo(p, smem);
  else if (PH == 11) phase_ln(p, p.ln2_g, p.ln2_b);
  else if (PH == 12) phase_gemm_bf16(p, (const u16*)(p.ws + WS_C), (const u16*)(p.ws + WS_WPQ), 2048, (u16*)(p.ws + WS_F), 1.f, smem);
  else if (PH == 13) phase_topk(p, smem);
  else if (PH == 14) phase_peer(p);
}

template <int PH>
__global__ void __launch_bounds__(256, 2) k_phase(Params p) {
  __shared__ __attribute__((aligned(16))) char smem[SMEM_BYTES];
  run_phase<PH>(p, smem);
}

#define XB_TMO      128
#define XB_XCNT(j)  (256  + 64 * (j))
#define XB_XSUB(j)  (1280 + 64 * (j))
#define XB_XGEN(j)  (2304 + 64 * (j))
#define XB_TOP      3328
#define XB_TOPGEN   3392
#define XB_SPIN_CAP (1u << 20)
DI unsigned xb_ld(unsigned* p) { return __hip_atomic_load(p, __ATOMIC_RELAXED, __HIP_MEMORY_SCOPE_AGENT); }
DI unsigned xb_add(unsigned* p, unsigned v) { return __hip_atomic_fetch_add(p, v, __ATOMIC_RELAXED, __HIP_MEMORY_SCOPE_AGENT); }
DI unsigned xb_xcc_id() { return (unsigned)__builtin_amdgcn_s_getreg((3 << 11) | 20) & 0xFu; }
#define XB_SPIN(cond, bar) do { unsigned _sp = 0; while (cond) { __builtin_amdgcn_s_sleep(1); \
    if ((++_sp & 255u) == 0u) { if (xb_ld(&(bar)[XB_TMO])) break; if (_sp > XB_SPIN_CAP) { atomicAdd(&(bar)[XB_TMO], 1u); break; } } } } while (0)
struct XcdBarrier { unsigned* bar; unsigned x; volatile unsigned* st; };
DI XcdBarrier xcd_barrier_post(unsigned* bar, volatile unsigned* st) {
  XcdBarrier b; b.bar = bar; b.x = xb_xcc_id(); b.st = st;
  if (threadIdx.x == 0) (void)xb_add(&bar[XB_XCNT(b.x)], 1u);
  return b;
}
DI void xcd_barrier_complete(unsigned* bar, unsigned x, unsigned& nloc, unsigned& nx) {
  const unsigned G = gridDim.x;
  unsigned sum, cnt, mine, sp = 0u;
  for (;;) {
    sum = 0u; cnt = 0u; mine = 0u;
#pragma unroll
    for (unsigned j = 0; j < 16; ++j) { const unsigned c = xb_ld(&bar[XB_XCNT(j)]); sum += c; cnt += (c > 0u) ? 1u : 0u; mine = (j == x) ? c : mine; }
    if (sum == G) break;
    __builtin_amdgcn_s_sleep(1);
    if ((++sp & 255u) == 0u) { if (xb_ld(&bar[XB_TMO])) break; if (sp > XB_SPIN_CAP) { atomicAdd(&bar[XB_TMO], 1u); break; } }
  }
  nloc = mine > 0u ? mine : 1u; nx = cnt > 0u ? cnt : 1u;
}
DI void xcd_barrier(const XcdBarrier& b) {
  asm volatile("s_waitcnt vmcnt(0)" ::: "memory");
  __syncthreads();
  if (threadIdx.x == 0) {
    unsigned* bar = b.bar;
    __builtin_amdgcn_s_waitcnt(0);
    unsigned nloc = b.st[0], nx = b.st[1];
    if (nloc == 0u) { xcd_barrier_complete(bar, b.x, nloc, nx); b.st[0] = nloc; b.st[1] = nx; }
    const unsigned old = xb_add(&bar[XB_XSUB(b.x)], 1u);
    const unsigned gen = old / nloc;
    if (old + 1u == (gen + 1u) * nloc) {
      __builtin_amdgcn_fence(__ATOMIC_RELEASE, "agent");
      asm volatile("s_waitcnt vmcnt(0)" ::: "memory");
      const unsigned og = xb_add(&bar[XB_TOP], 1u);
      const unsigned tg = og / nx;
      if (og + 1u == (tg + 1u) * nx) xb_add(&bar[XB_TOPGEN], 1u);
      else XB_SPIN(xb_ld(&bar[XB_TOPGEN]) == tg, bar);
      __builtin_amdgcn_fence(__ATOMIC_ACQUIRE, "agent");
      xb_add(&bar[XB_XGEN(b.x)], 1u);
      asm volatile("s_waitcnt vmcnt(0)" ::: "memory");
    } else {
      XB_SPIN(xb_ld(&bar[XB_XGEN(b.x)]) == gen, bar);
      __builtin_amdgcn_fence(__ATOMIC_ACQUIRE, "agent");
      asm volatile("s_waitcnt vmcnt(0)" ::: "memory");
    }
  }
  __syncthreads();
}
#if ONE_LAUNCH
DI void grid_barrier(unsigned* bar, unsigned& target) {
  target += gridDim.x;
  asm volatile("s_waitcnt vmcnt(0)" ::: "memory");
  __syncthreads();
  if (threadIdx.x == 0) {
    __builtin_amdgcn_fence(__ATOMIC_RELEASE, "agent");
    asm volatile("s_waitcnt vmcnt(0)" ::: "memory");
    __hip_atomic_fetch_add(bar, 1u, __ATOMIC_RELAXED, __HIP_MEMORY_SCOPE_AGENT);
    while (__hip_atomic_load(bar, __ATOMIC_RELAXED, __HIP_MEMORY_SCOPE_AGENT) < target) __builtin_amdgcn_s_sleep(2);
    __builtin_amdgcn_fence(__ATOMIC_ACQUIRE, "agent");
    asm volatile("s_waitcnt vmcnt(0)" ::: "memory");
  }
  __syncthreads();
}
__global__ void __launch_bounds__(256, 2) k_mega(Params p) {
  __shared__ __attribute__((aligned(16))) char smem[SMEM_BYTES];
  cg::grid_group grid = cg::this_grid();
#define RUN(n) do { run_phase<n>(p, smem); if (REPEAT_PHASE == n) { GSYNC(); run_phase<n>(p, smem); GSYNC(); run_phase<n>(p, smem); } if (REPEAT_PHASE == 203 && n == 3) { GSYNC(); phase_attn(p, smem, 1); GSYNC(); phase_attn(p, smem, 2); } if (REPEAT_PHASE == 100 + n) { GSYNC(); phase_gemm_bf16<true>(p, (const u16*)(p.ws + WS_C), (const u16*)(p.ws + WS_WPQ), 2048, (u16*)(p.ws + WS_F), 1.f, smem); GSYNC(); phase_gemm_bf16<true>(p, (const u16*)(p.ws + WS_C), (const u16*)(p.ws + WS_WPQ), 2048, (u16*)(p.ws + WS_F), 1.f, smem); } } while (0)
#if CUSTOM_BAR
  volatile unsigned* xst = (volatile unsigned*)(smem + 73728 + 1024);
  if (threadIdx.x == 0) { xst[0] = 0u; xst[1] = 0u; }
  __syncthreads();
  const XcdBarrier xb = xcd_barrier_post((unsigned*)(p.ws + WS_XBAR), xst);
#define GSYNC() xcd_barrier(xb)
#else
#define GSYNC() grid.sync()
#endif
  RUN(0); grid.sync();
  RUN(1); GSYNC();
  RUN(2); GSYNC();
  RUN(3); GSYNC();
  RUN(4); GSYNC();
  RUN(5); GSYNC();
  if (REPEAT_PHASE == 300) { GSYNC(); GSYNC(); GSYNC(); GSYNC(); GSYNC(); GSYNC(); GSYNC(); GSYNC(); }
  RUN(6); GSYNC();
  RUN(7); GSYNC();
  RUN(8); GSYNC();
  RUN(9); GSYNC();
  RUN(10); GSYNC();
  RUN(11); GSYNC();
  RUN(12); GSYNC();
  RUN(13); GSYNC();
  RUN(14);
}
#endif

extern "C" void kernel_launch(void* const* d_in, const int* in_sizes, int n_in, void* d_out, int out_size, void* d_ws, size_t ws_size,
                              hipStream_t stream) {
  (void)in_sizes; (void)n_in; (void)out_size;
  if (ws_size < WS_TOTAL) { fprintf(stderr, "workspace too small: %zu < %zu\n", ws_size, (size_t)WS_TOTAL); return; }
  Params p{};
  const float** pp = (const float**)&p;
  for (int i = 0; i < 29; ++i) pp[i] = (const float*)d_in[i];
  p.out = (float*)d_out;
  p.ws = (char*)d_ws;
#if ONE_LAUNCH
  static int grid_blocks = 0;
  if (!grid_blocks) {
    int dev = 0, cus = 0, per_cu = 0;
    hipGetDevice(&dev);
    hipDeviceGetAttribute(&cus, hipDeviceAttributeMultiprocessorCount, dev);
    hipOccupancyMaxActiveBlocksPerMultiprocessor(&per_cu, k_mega, 256, 0);
    if (per_cu > 2) per_cu = 2;
    grid_blocks = cus * per_cu;
  }
  hipMemsetAsync((char*)d_ws + WS_BAR, 0, 2048, stream);
  hipMemsetAsync((char*)d_ws + WS_XBAR, 0, 16384, stream);
  void* args[] = {&p};
  hipError_t e = hipLaunchCooperativeKernel((void*)k_mega, dim3(grid_blocks), dim3(256), args, 0, stream);
  if (e != hipSuccess) fprintf(stderr, "cooperative launch failed: %s (grid %d)\n", hipGetErrorString(e), grid_blocks);
#else
  const int G = 512;
  hipMemsetAsync((char*)d_ws + WS_BAR, 0, 2048, stream);
  k_phase<0><<<G, 256, 0, stream>>>(p);
  k_phase<1><<<G, 256, 0, stream>>>(p);
  k_phase<2><<<G, 256, 0, stream>>>(p);
  k_phase<3><<<G, 256, 0, stream>>>(p);
  k_phase<4><<<G, 256, 0, stream>>>(p);
  k_phase<5><<<G, 256, 0, stream>>>(p);
  k_phase<6><<<G, 256, 0, stream>>>(p);
  k_phase<7><<<G, 256, 0, stream>>>(p);
  k_phase<8><<<G, 256, 0, stream>>>(p);
  k_phase<9><<<G, 256, 0, stream>>>(p);
  k_phase<10><<<G, 256, 0, stream>>>(p);
  k_phase<11><<<G, 256, 0, stream>>>(p);
  k_phase<12><<<G, 256, 0, stream>>>(p);
  k_phase<13><<<G, 256, 0, stream>>>(p);
  k_phase<14><<<G, 256, 0, stream>>>(p);
#endif
}
```

```cpp
#include <hip/hip_runtime.h>
#include <hip/hip_cooperative_groups.h>
#include <cstdio>
#include <cstdint>
namespace cg = cooperative_groups;

#ifndef ONE_LAUNCH
#define ONE_LAUNCH 1
#endif

#ifndef USE_FP8
#define USE_FP8 1
#endif
#ifndef SB_EXIT
#define SB_EXIT 1
#endif
#ifndef REPEAT_PHASE
#define REPEAT_PHASE -1
#endif
#ifndef PEER_RESYNC
#define PEER_RESYNC 0
#endif
#ifndef CUSTOM_BAR
#define CUSTOM_BAR 1
#endif
#define DI __device__ __forceinline__
typedef unsigned short u16;
typedef short bf16x8 __attribute__((ext_vector_type(8)));
typedef short s16x4 __attribute__((ext_vector_type(4)));
typedef float f32x16 __attribute__((ext_vector_type(16)));
typedef __bf16 bf2_t __attribute__((ext_vector_type(2)));
typedef float f2_t __attribute__((ext_vector_type(2)));
#define MFMA(a, b, c) __builtin_amdgcn_mfma_f32_32x32x16_bf16((a), (b), (c), 0, 0, 0)

constexpr int DM = 1024;
constexpr int NTP = 32768;
constexpr int NTS = 1024;
constexpr int NT = NTP + NTS;
constexpr int SEQ = 2048, DSEQ = 64, PAST = 4096, NMEM = 256;
constexpr int INC = 3080, INCP = 3200;
constexpr float DN_ALPHA = 1.189207115002721f;
constexpr float LOG2E = 1.4426950408889634f;

constexpr size_t OUT_YP = 0;
constexpr size_t OUT_YS = OUT_YP + (size_t)NTP * DM;
constexpr size_t OUT_SBK_P = OUT_YS + (size_t)NTS * DM;
constexpr size_t OUT_SBV_P = OUT_SBK_P + (size_t)NTP * 512;
constexpr size_t OUT_FXK_P = OUT_SBV_P + (size_t)NTP * 512;
constexpr size_t OUT_FXV_P = OUT_FXK_P + (size_t)NTP * 512;
constexpr size_t OUT_LF_P = OUT_FXV_P + (size_t)NTP * 512;
constexpr size_t OUT_MK_P = OUT_LF_P + (size_t)NTP * 8;
constexpr size_t OUT_MV_P = OUT_MK_P + (size_t)4096 * DM;
constexpr size_t OUT_SBK_S = OUT_MV_P + (size_t)4096 * DM;
constexpr size_t OUT_SBV_S = OUT_SBK_S + (size_t)NTS * 512;
constexpr size_t OUT_FXK_S = OUT_SBV_S + (size_t)NTS * 512;
constexpr size_t OUT_FXV_S = OUT_FXK_S + (size_t)NTS * 512;
constexpr size_t OUT_LF_S = OUT_FXV_S + (size_t)NTS * 512;
constexpr size_t OUT_TOTAL = OUT_LF_S + (size_t)NTS * 8;

constexpr size_t WS_WIN = 0;
constexpr size_t WS_WOUT = WS_WIN + (size_t)INCP * DM * 2;
constexpr size_t WS_WMQ = WS_WOUT + (size_t)DM * DM * 2;
constexpr size_t WS_WMKV = WS_WMQ + (size_t)DM * DM * 2;
constexpr size_t WS_WMO = WS_WMKV + (size_t)2048 * DM * 2;
constexpr size_t WS_WPQ = WS_WMO + (size_t)DM * DM * 2;
constexpr size_t WS_KA = WS_WPQ + (size_t)2048 * DM * 2;
constexpr size_t WS_KB = WS_KA + (size_t)8 * 128 * 128 * 2;
constexpr size_t WS_U = WS_KB + (size_t)8 * 128 * 128 * 2;
constexpr size_t WS_V = WS_U + (size_t)16384 * DM * 2;
constexpr size_t WS_MEMK = WS_V + (size_t)16384 * DM * 2;
constexpr size_t WS_MEMVT = WS_MEMK + (size_t)32 * 256 * DM * 2;
constexpr size_t WS_A = WS_MEMVT + (size_t)32 * 256 * DM * 2;
constexpr size_t WS_B = WS_A + (size_t)NT * DM * 4;
constexpr size_t WS_C = WS_B + (size_t)NT * DM * 4;
constexpr size_t WS_D = WS_C + (size_t)NT * DM * 2;
constexpr size_t WS_E = WS_D + (size_t)NT * DM * 2;
constexpr size_t WS_F = WS_E + (size_t)NT * DM * 2;
constexpr size_t WS_BAR = WS_F + (size_t)NT * DM * 4;
constexpr size_t WS_USC = WS_BAR + 2048;
constexpr size_t WS_VSC = WS_USC + (size_t)16384 * 4;
constexpr size_t WS_CBP = WS_VSC + (size_t)16384 * 4;
constexpr size_t WS_CBS = WS_CBP + (size_t)128 * 2048 * 4;
constexpr size_t WS_SSQ = WS_CBS + (size_t)128 * 4160 * 4;
constexpr size_t WS_XBAR = WS_SSQ + (size_t)NT * 2 * 4;
constexpr size_t WS_TOTAL = WS_XBAR + 16384;

struct Params {
  const float *x_prompt, *x_sample, *mem_prompt, *c_sb_k, *c_sb_v, *c_fx_k, *c_fx_v, *c_fx_logf, *c_mem_k, *c_mem_v;
  const float *w_in, *b_f, *w_gn, *w_out, *ln1_g, *ln1_b, *w_mq, *w_mk, *w_mv, *w_mo, *ln2_g, *ln2_b;
  const float *w_pq, *keys_a, *keys_b, *peer_u, *peer_v, *ln3_g, *ln3_b;
  float* out;
  char* ws;
};

DI const Params* kparams() { auto ka = __builtin_amdgcn_kernarg_segment_ptr(); asm volatile("" : "+s"(ka)); return (const Params*)ka; }
constexpr int SMEM_BYTES = 73728 + 1024 + 64;

DI unsigned pk2(float a, float b) { f2_t v = {a, b}; bf2_t r = __builtin_convertvector(v, bf2_t); return __builtin_bit_cast(unsigned, r); }
DI u16 bf1(float a) { return (u16)(pk2(a, 0.f) & 0xffffu); }
DI float bflo(unsigned w) { return __uint_as_float(w << 16); }
DI float bfhi(unsigned w) { return __uint_as_float(w & 0xffff0000u); }
DI float wave_sum(float v) {
#pragma unroll
  for (int o = 32; o >= 1; o >>= 1) v += __shfl_xor(v, o);
  return v;
}
DI float wave_max(float v) {
#pragma unroll
  for (int o = 32; o >= 1; o >>= 1) v = fmaxf(v, __shfl_xor(v, o));
  return v;
}
DI int vblock() { int nb = gridDim.x, b = blockIdx.x; return ((nb & 7) == 0) ? (b & 7) * (nb >> 3) + (b >> 3) : b; }
DI const float* xrow(const Params& p, int g) { return g < NTP ? p.x_prompt + (size_t)g * DM : p.x_sample + (size_t)(g - NTP) * DM; }

DI void tconv_tile(const float* src, int ldsrc, int C, u16* dst, int lddst, const float* rowscale, int tr, int tc, float* tile) {
  const int tid = threadIdx.x;
  {
    const int r = tid >> 2, c0 = (tid & 3) * 16;
    const int gr = tr * 64 + r;
    const float sc = rowscale ? rowscale[gr] : 1.f;
#pragma unroll
    for (int j = 0; j < 4; ++j) {
      const int gc = tc * 64 + c0 + 4 * j;
      float4 v = make_float4(0.f, 0.f, 0.f, 0.f);
      if (gc < C) v = *(const float4*)(src + (size_t)gr * ldsrc + gc);
      float* t = tile + r * 65 + c0 + 4 * j;
      t[0] = v.x * sc; t[1] = v.y * sc; t[2] = v.z * sc; t[3] = v.w * sc;
    }
  }
  __syncthreads();
  {
    const int n = tid >> 2, k0 = (tid & 3) * 16;
    unsigned w[8];
#pragma unroll
    for (int e = 0; e < 8; ++e) w[e] = pk2(tile[(k0 + 2 * e) * 65 + n], tile[(k0 + 2 * e + 1) * 65 + n]);
    uint4* d = (uint4*)(dst + (size_t)(tc * 64 + n) * lddst + tr * 64 + k0);
    d[0] = make_uint4(w[0], w[1], w[2], w[3]);
    d[1] = make_uint4(w[4], w[5], w[6], w[7]);
  }
  __syncthreads();
}

DI void conv_range(const float* src, u16* dst, size_t n8, int bid, int nb) {
  for (size_t i = (size_t)bid * 256 + threadIdx.x; i < n8; i += (size_t)nb * 256) {
    const float4 a = ((const float4*)src)[2 * i], b = ((const float4*)src)[2 * i + 1];
    ((uint4*)dst)[i] = make_uint4(pk2(a.x, a.y), pk2(a.z, a.w), pk2(b.x, b.y), pk2(b.z, b.w));
  }
}

DI void phase_prep(const Params& p, char* smem) {
  float* tile = (float*)smem;
  const int bid = blockIdx.x, nb = gridDim.x;
  u16* ws16 = (u16*)p.ws;
  constexpr int T_WIN = 16 * 50, T_SQ = 256, T_PQ = 16 * 32, T_MV = 16 * 4 * 16;
  constexpr int T0 = T_WIN, T1 = T0 + T_SQ, T2 = T1 + T_SQ, T3 = T2 + T_SQ, T4 = T3 + T_SQ, T5 = T4 + T_SQ, T6 = T5 + T_PQ, T7 = T6 + T_MV;
  for (int t = bid; t < T7; t += nb) {
    if (t < T0) { tconv_tile(p.w_in, INC, INC, (u16*)(p.ws + WS_WIN), DM, nullptr, t / 50, t % 50, tile); }
    else if (t < T1) { int u = t - T0; tconv_tile(p.w_out, DM, DM, (u16*)(p.ws + WS_WOUT), DM, p.w_gn, u >> 4, u & 15, tile); }
    else if (t < T2) { int u = t - T1; tconv_tile(p.w_mq, DM, DM, (u16*)(p.ws + WS_WMQ), DM, nullptr, u >> 4, u & 15, tile); }
    else if (t < T3) { int u = t - T2; tconv_tile(p.w_mk, DM, DM, (u16*)(p.ws + WS_WMKV), DM, nullptr, u >> 4, u & 15, tile); }
    else if (t < T4) { int u = t - T3; tconv_tile(p.w_mv, DM, DM, (u16*)(p.ws + WS_WMKV) + (size_t)DM * DM, DM, nullptr, u >> 4, u & 15, tile); }
    else if (t < T5) { int u = t - T4; tconv_tile(p.w_mo, DM, DM, (u16*)(p.ws + WS_WMO), DM, nullptr, u >> 4, u & 15, tile); }
    else if (t < T6) { int u = t - T5; tconv_tile(p.w_pq, 2048, 2048, (u16*)(p.ws + WS_WPQ), DM, nullptr, u >> 5, u & 31, tile); }
    else { int u = t - T6; int b = u >> 6, r = u & 63;
      tconv_tile(p.c_mem_v + (size_t)b * 256 * DM, DM, DM, (u16*)(p.ws + WS_MEMVT) + (size_t)(16 + b) * DM * 256, 256, nullptr, r >> 4, r & 15, tile); }
  }
  (void)ws16;
  for (int i = bid * 256 + threadIdx.x; i < NT * 2; i += nb * 256) ((float*)(p.ws + WS_SSQ))[i] = 0.f;
  conv_range(p.x_prompt, (u16*)(p.ws + WS_C), (size_t)NTP * DM / 8, bid, nb);
  conv_range(p.x_sample, (u16*)(p.ws + WS_C) + (size_t)NTP * DM, (size_t)NTS * DM / 8, bid, nb);
  conv_range(p.mem_prompt, (u16*)(p.ws + WS_E), (size_t)4096 * DM / 8, bid, nb);
  conv_range(p.c_mem_k, (u16*)(p.ws + WS_MEMK) + (size_t)16 * 256 * DM, (size_t)16 * 256 * DM / 8, bid, nb);
  conv_range(p.keys_a, (u16*)(p.ws + WS_KA), (size_t)8 * 128 * 128 / 8, bid, nb);
  conv_range(p.keys_b, (u16*)(p.ws + WS_KB), (size_t)8 * 128 * 128 / 8, bid, nb);
#if USE_FP8
  {
    const int lane = threadIdx.x & 63;
    const int wg = bid * 4 + (threadIdx.x >> 6), nw = nb * 4;
    for (int row = wg; row < 32768; row += nw) {
      const bool isv = row >= 16384;
      const int r = isv ? row - 16384 : row;
      const float4* src = (const float4*)((isv ? p.peer_v : p.peer_u) + (size_t)r * DM) + 4 * lane;
      float4 a[4];
      float am = 0.f;
#pragma unroll
      for (int j = 0; j < 4; ++j) { a[j] = src[j]; am = fmaxf(am, fmaxf(fmaxf(fabsf(a[j].x), fabsf(a[j].y)), fmaxf(fabsf(a[j].z), fabsf(a[j].w)))); }
      am = wave_max(am);
      int ex = 0;
      if (am > 0.f) (void)frexpf(am, &ex);
      const float sc = ldexpf(1.f, 8 - ex), isc = ldexpf(1.f, ex - 8);
      unsigned w[4];
#pragma unroll
      for (int j = 0; j < 4; ++j) {
        int t = __builtin_amdgcn_cvt_pk_fp8_f32(a[j].x * sc, a[j].y * sc, 0, false);
        t = __builtin_amdgcn_cvt_pk_fp8_f32(a[j].z * sc, a[j].w * sc, t, true);
        w[j] = (unsigned)t;
      }
      *(uint4*)(p.ws + (isv ? WS_V : WS_U) + (size_t)r * DM + 16 * lane) = make_uint4(w[0], w[1], w[2], w[3]);
      if (lane == 0) ((float*)(p.ws + (isv ? WS_VSC : WS_USC)))[r] = isc;
    }
  }
#else
  conv_range(p.peer_u, (u16*)(p.ws + WS_U), (size_t)16384 * DM / 8, bid, nb);
  conv_range(p.peer_v, (u16*)(p.ws + WS_V), (size_t)16384 * DM / 8, bid, nb);
#endif
}

#define ACC_ROW(e, hh) (((e) & 3) + 8 * ((e) >> 2) + 4 * (hh))
#define ACC_R0(e) (((e) & 3) + 8 * ((e) >> 2))
DI void store_bf16_pairs(u16* O, unsigned b0, unsigned ld, const f32x16& acc, float scale) {
  const bool odd = (threadIdx.x & 1) != 0;
#pragma unroll
  for (int e = 0; e < 16; e += 2) {
    const float a = acc[e] * scale, b = acc[e + 1] * scale;
    const float snd = odd ? a : b;
    const float rcv = __int_as_float(__builtin_amdgcn_update_dpp(0, __float_as_int(snd), 0xB1, 0xF, 0xF, true));
    const unsigned w = odd ? pk2(rcv, b) : pk2(a, rcv);
    const unsigned idx = b0 + (ACC_R0(e) + (odd ? 1u : 0u)) * ld - (odd ? 1u : 0u);
    *(unsigned*)(O + idx) = w;
  }
}
template <int V> struct IC { static constexpr int value = V; };
struct SmemGemm { u16 a[2][128 * 64]; u16 b[2][128 * 64]; };

template <int ROWS>
struct GldsBf16 {
  const u16* base; int ld;
  DI void issue(int kt, u16* lds, int tid) {
    const int wid = tid >> 6, lane = tid & 63;
    constexpr int NCH = ROWS / 32;
#pragma unroll
    for (int q = 0; q < NCH; ++q) {
      const int ch = wid * NCH + q;
      const int r = ch * 8 + (lane >> 3);
      const int c = (lane & 7) ^ ((r >> 1) & 7);
      __builtin_amdgcn_global_load_lds((const unsigned*)(base + (size_t)r * ld + kt * 64 + c * 8), (unsigned*)(lds + ch * 512), 16, 0, 0);
    }
  }
  DI void commit(u16*, int) {}
};
#ifndef GEMM_REG2
#define GEMM_REG2 1
#endif
#if GEMM_REG2
typedef unsigned u32x4 __attribute__((ext_vector_type(4)));
template <int ROWS>
struct LdReg {
  static constexpr int N = ROWS / 32;
  const u16* base; int ld;
  u32x4 r0, r1, r2, r3;
  DI const u32x4* src(int kt, int tid, int i) const { const int c = tid + 256 * i; return (const u32x4*)(base + (size_t)(c >> 3) * ld + kt * 64 + (c & 7) * 8); }
  DI static u32x4* dst(u16* lds, int tid, int i) { const int c = tid + 256 * i; const int row = c >> 3; return (u32x4*)(lds + row * 64 + (((c & 7) ^ ((row >> 1) & 7)) * 8)); }
  DI void fetch(int kt, int tid) {
    r0 = *src(kt, tid, 0); r1 = *src(kt, tid, 1);
    if (N > 2) { r2 = *src(kt, tid, 2); r3 = *src(kt, tid, 3); }
  }
  DI void stash(u16* lds, int tid) const {
    *dst(lds, tid, 0) = r0; *dst(lds, tid, 1) = r1;
    if (N > 2) { *dst(lds, tid, 2) = r2; *dst(lds, tid, 3) = r3; }
  }
};
template <int MI, bool GRMS>
DI void gemm_compute(const u16* pa, const u16* pb, f32x16 (&acc)[MI][MI], int o0, int o1, int o2, int o3, int wr, int hh, bool scale_now, const float* rsc) {
  if (GRMS && scale_now) {
#pragma unroll
    for (int i = 0; i < MI; ++i)
#pragma unroll
      for (int e = 0; e < 16; ++e) {
        const float rt = rsc[((wr * MI + i) * 32 + ACC_ROW(e, hh)) * 2];
#pragma unroll
        for (int j = 0; j < MI; ++j) acc[i][j][e] *= rt;
      }
  }
  const int off[4] = {o0, o1, o2, o3};
  bf16x8 af[2][MI], bfr[2][MI];
#pragma unroll
  for (int i = 0; i < MI; ++i) { af[0][i] = *(const bf16x8*)(pa + i * 32 * 64 + off[0]); bfr[0][i] = *(const bf16x8*)(pb + i * 32 * 64 + off[0]); }
#pragma unroll
  for (int kk = 0; kk < 4; ++kk) {
    if (kk < 3) {
#pragma unroll
      for (int i = 0; i < MI; ++i) { af[(kk + 1) & 1][i] = *(const bf16x8*)(pa + i * 32 * 64 + off[kk + 1]); bfr[(kk + 1) & 1][i] = *(const bf16x8*)(pb + i * 32 * 64 + off[kk + 1]); }
    }
#pragma unroll
    for (int i = 0; i < MI; ++i)
#pragma unroll
      for (int j = 0; j < MI; ++j) acc[i][j] = MFMA(af[kk & 1][i], bfr[kk & 1][j], acc[i][j]);
  }
}
template <int MI, bool GRMS = false, class AL, class EPI>
DI void gemm_tile(AL& al, const u16* Bt, int ldb, int K, int m0, int n0, EPI epi, char* smem, const float* rsc = nullptr) {
  SmemGemm& sm = *(SmemGemm*)smem;
  const int tid = threadIdx.x, lane = tid & 63, wid = tid >> 6, wr = wid >> 1, wc = wid & 1, r31 = lane & 31, hh = lane >> 5;
  LdReg<MI * 64> a0, a1, b0, b1;
  a0.base = al.base; a0.ld = al.ld; a1.base = al.base; a1.ld = al.ld;
  b0.base = Bt + (size_t)n0 * ldb; b0.ld = ldb; b1.base = b0.base; b1.ld = ldb;
  f32x16 acc[MI][MI];
#pragma unroll
  for (int i = 0; i < MI; ++i)
#pragma unroll
    for (int j = 0; j < MI; ++j)
#pragma unroll
      for (int e = 0; e < 16; ++e) acc[i][j][e] = 0.f;
  int off[4];
#pragma unroll
  for (int kk = 0; kk < 4; ++kk) off[kk] = r31 * 64 + (((kk * 2 + hh) ^ ((r31 >> 1) & 7)) * 8);
  const int KT = K >> 6;
  a0.fetch(0, tid); b0.fetch(0, tid);
  a1.fetch(1, tid); b1.fetch(1, tid);
  a0.stash(sm.a[0], tid); b0.stash(sm.b[0], tid);
  __syncthreads();
  for (int kt = 0; kt < KT; kt += 2) {
    { const int kn = min(kt + 2, KT - 1); a0.fetch(kn, tid); b0.fetch(kn, tid); }
    gemm_compute<MI, GRMS>(sm.a[0] + (wr * MI * 32) * 64, sm.b[0] + (wc * MI * 32) * 64, acc, off[0], off[1], off[2], off[3], wr, hh, kt == (KT >> 1), rsc);
    a1.stash(sm.a[1], tid); b1.stash(sm.b[1], tid);
    __syncthreads();
    { const int kn = min(kt + 3, KT - 1); a1.fetch(kn, tid); b1.fetch(kn, tid); }
    gemm_compute<MI, GRMS>(sm.a[1] + (wr * MI * 32) * 64, sm.b[1] + (wc * MI * 32) * 64, acc, off[0], off[1], off[2], off[3], wr, hh, (kt + 1) == (KT >> 1), rsc);
    a0.stash(sm.a[0], tid); b0.stash(sm.b[0], tid);
    __syncthreads();
  }
  if (GRMS) {
#pragma unroll
    for (int i = 0; i < MI; ++i)
#pragma unroll
      for (int e = 0; e < 16; ++e) {
        const float s1 = rsc[((wr * MI + i) * 32 + ACC_ROW(e, hh)) * 2 + 1];
#pragma unroll
        for (int j = 0; j < MI; ++j) acc[i][j][e] *= s1;
      }
  }
#pragma unroll
  for (int i = 0; i < MI; ++i)
#pragma unroll
    for (int j = 0; j < MI; ++j) epi(m0 + (wr * MI + i) * 32, n0 + (wc * MI + j) * 32, acc[i][j]);
}
#else
template <int MI, bool GRMS = false, class AL, class EPI>
DI void gemm_tile(AL& al, const u16* Bt, int ldb, int K, int m0, int n0, EPI epi, char* smem, const float* rsc = nullptr) {
  SmemGemm& sm = *(SmemGemm*)smem;
  const int tid = threadIdx.x, lane = tid & 63, wid = tid >> 6, wr = wid >> 1, wc = wid & 1, r31 = lane & 31, hh = lane >> 5;
  GldsBf16<MI * 64> bl; bl.base = Bt + (size_t)n0 * ldb; bl.ld = ldb;
  f32x16 acc[MI][MI];
#pragma unroll
  for (int i = 0; i < MI; ++i)
#pragma unroll
    for (int j = 0; j < MI; ++j)
#pragma unroll
      for (int e = 0; e < 16; ++e) acc[i][j][e] = 0.f;
  int off[4];
#pragma unroll
  for (int kk = 0; kk < 4; ++kk) off[kk] = r31 * 64 + (((kk * 2 + hh) ^ ((r31 >> 1) & 7)) * 8);
  const int KT = K >> 6;
  al.issue(0, sm.a[0], tid); bl.issue(0, sm.b[0], tid);
  al.commit(sm.a[0], tid);
  asm volatile("s_waitcnt vmcnt(0)" ::: "memory");
  __syncthreads();
  for (int kt = 0; kt < KT; ++kt) {
    const int cur = kt & 1;
    if (kt + 1 < KT) { al.issue(kt + 1, sm.a[cur ^ 1], tid); bl.issue(kt + 1, sm.b[cur ^ 1], tid); }
    const u16* pa = sm.a[cur] + (wr * MI * 32) * 64;
    const u16* pb = sm.b[cur] + (wc * MI * 32) * 64;
    if (GRMS && kt == (KT >> 1)) {
#pragma unroll
      for (int i = 0; i < MI; ++i)
#pragma unroll
        for (int e = 0; e < 16; ++e) {
          const float rt = rsc[((wr * MI + i) * 32 + ACC_ROW(e, hh)) * 2];
#pragma unroll
          for (int j = 0; j < MI; ++j) acc[i][j][e] *= rt;
        }
    }
#pragma unroll
    for (int kk = 0; kk < 4; ++kk) {
      bf16x8 af[MI], bfr[MI];
#pragma unroll
      for (int i = 0; i < MI; ++i) { af[i] = *(const bf16x8*)(pa + i * 32 * 64 + off[kk]); bfr[i] = *(const bf16x8*)(pb + i * 32 * 64 + off[kk]); }
#pragma unroll
      for (int i = 0; i < MI; ++i)
#pragma unroll
        for (int j = 0; j < MI; ++j) acc[i][j] = MFMA(af[i], bfr[j], acc[i][j]);
    }
    if (kt + 1 < KT) al.commit(sm.a[cur ^ 1], tid);
    asm volatile("s_waitcnt vmcnt(0)" ::: "memory");
    __syncthreads();
  }
  if (GRMS) {
#pragma unroll
    for (int i = 0; i < MI; ++i)
#pragma unroll
      for (int e = 0; e < 16; ++e) {
        const float s1 = rsc[((wr * MI + i) * 32 + ACC_ROW(e, hh)) * 2 + 1];
#pragma unroll
        for (int j = 0; j < MI; ++j) acc[i][j][e] *= s1;
      }
  }
#pragma unroll
  for (int i = 0; i < MI; ++i)
#pragma unroll
    for (int j = 0; j < MI; ++j) epi(m0 + (wr * MI + i) * 32, n0 + (wc * MI + j) * 32, acc[i][j]);
}
#endif
template <class F>
DI void for_tiles(int N, F body) {
  const int vb = vblock(), nb = gridDim.x;
  const int ntn = N >> 7, ntn2 = N >> 6;
  const int nbig = 256 * ntn, nsmall = 16 * ntn2;
  for (int t = vb; t < nbig + nsmall; t += nb) {
    if (t < nbig) { body((t / ntn) * 128, (t % ntn) * 128, IC<2>{}); }
    else { const int u = t - nbig; body(NTP + (u / ntn2) * 64, (u % ntn2) * 64, IC<1>{}); }
  }
}

DI void phase_proj(const Params& p, char* smem) {
  const int vb = vblock(), nb = gridDim.x;
  constexpr int T_G1 = 264 * 25, T_MKV = 32 * 16;
  float* out = p.out;
  for (int t = vb; t < T_G1 + T_MKV; t += nb) {
    if (t < T_G1) {
      const int mt = t / 25, nt = t % 25;
      const int m0 = mt * 128, n0 = nt * 128;
      GldsBf16<128> al; al.base = (const u16*)(p.ws + WS_C) + (size_t)m0 * DM; al.ld = DM;
      const bool smp = m0 >= NTP;
      const float* b_f = p.b_f;
      u16* qsb = (u16*)(p.ws + WS_D);
      u16* qfx = qsb + (size_t)NT * 512;
      char* ws = p.ws;
      auto epi = [=](int r0, int c0, const f32x16& acc) {
        const int lane = threadIdx.x & 63, hh = lane >> 5, col = c0 + (lane & 31);
        const int seg = c0 >> 9, cc = col & 511;
        if (seg == 0 || seg == 3) {
          u16* q = (seg == 0) ? qsb : qfx;
#pragma unroll
          for (int e = 0; e < 16; ++e) q[(unsigned)(r0 + 4 * hh) * 512u + cc + ACC_R0(e) * 512u] = bf1(acc[e] * 0.125f);
        } else if (seg < 6) {
          size_t ob;
          if (!smp) ob = (seg == 1) ? OUT_SBK_P : (seg == 2) ? OUT_SBV_P : (seg == 4) ? OUT_FXK_P : OUT_FXV_P;
          else ob = (seg == 1) ? OUT_SBK_S : (seg == 2) ? OUT_SBV_S : (seg == 4) ? OUT_FXK_S : OUT_FXV_S;
          const int rb = smp ? r0 - NTP : r0;
          float* ov = out + ob;
          const unsigned b0 = (unsigned)(rb + 4 * hh) * 512u + cc;
#pragma unroll
          for (int e = 0; e < 16; ++e) ov[b0 + ACC_R0(e) * 512u] = acc[e];
          if (!smp) {
            if (seg == 1 || seg == 4) {
              u16* k16 = (u16*)(ws + WS_A) + (seg == 4 ? (size_t)NTP * 512 : 0);
#pragma unroll
              for (int e = 0; e < 16; ++e) k16[b0 + ACC_R0(e) * 512u] = bf1(acc[e]);
            } else {
              u16* vt16 = (u16*)(ws + WS_B) + (seg == 5 ? (size_t)NTP * 512 : 0);
              const unsigned vb0 = (unsigned)(((r0 >> 11) * 8 + (cc >> 6)) * 64 + (cc & 63)) * 2048u + (unsigned)(r0 & 2047) + 4 * hh;
#pragma unroll
              for (int g4 = 0; g4 < 4; ++g4) *(uint2*)(vt16 + vb0 + 8 * g4) = make_uint2(pk2(acc[4 * g4], acc[4 * g4 + 1]), pk2(acc[4 * g4 + 2], acc[4 * g4 + 3]));
            }
          }
        } else {
          const int c = col - 3072;
          if (c < 8) {
            const float bf = b_f[c];
            const size_t ob = smp ? OUT_LF_S : OUT_LF_P;
            const int rb = smp ? r0 - NTP : r0;
#pragma unroll
            for (int e = 0; e < 16; ++e) {
              const float z = acc[e] + bf;
              const float ls = fminf(z, 0.f) - log1pf(__expf(-fabsf(z)));
              out[ob + (unsigned)(rb + ACC_ROW(e, hh)) * 8u + c] = ls;
            }
          }
        }
      };
      gemm_tile<2>(al, (const u16*)(p.ws + WS_WIN), DM, DM, m0, n0, epi, smem);
    } else {
      const int u = t - T_G1;
      const int mt = u >> 4, nt = u & 15;
      const int m0 = mt * 128, n0 = nt * 128;
      GldsBf16<128> al; al.base = (const u16*)(p.ws + WS_E) + (size_t)m0 * DM; al.ld = DM;
      u16* kb = (u16*)(p.ws + WS_MEMK);
      u16* vt = (u16*)(p.ws + WS_MEMVT);
      auto epi = [=](int r0, int c0, const f32x16& acc) {
        const int lane = threadIdx.x & 63, hh = lane >> 5, col = c0 + (lane & 31);
        if (c0 < 1024) {
          float* ov = out + OUT_MK_P;
          const unsigned b0 = (unsigned)(r0 + 4 * hh) * 1024u + col;
#pragma unroll
          for (int e = 0; e < 16; ++e) { const unsigned idx = b0 + ACC_R0(e) * 1024u; ov[idx] = acc[e]; kb[idx] = bf1(acc[e]); }
        } else {
          const int c = col - 1024;
          float* ov = out + OUT_MV_P;
          const unsigned b0 = (unsigned)(r0 + 4 * hh) * 1024u + c;
#pragma unroll
          for (int e = 0; e < 16; ++e) ov[b0 + ACC_R0(e) * 1024u] = acc[e];
          const int b = r0 >> 8;
#pragma unroll
          for (int g4 = 0; g4 < 4; ++g4) {
            const int m = (r0 & 255) + 8 * g4 + 4 * hh;
            *(uint2*)(vt + ((size_t)b * DM + c) * 256 + m) = make_uint2(pk2(acc[4 * g4], acc[4 * g4 + 1]), pk2(acc[4 * g4 + 2], acc[4 * g4 + 3]));
          }
        }
      };
      gemm_tile<2>(al, (const u16*)(p.ws + WS_WMKV), DM, DM, m0, n0, epi, smem);
    }
  }
}

template <int PER>
DI void scan_one(const float* src0, int n0, const float* src1, int n, float* dst, float* part) {
  const int tid = threadIdx.x;
  const int s0 = tid * PER;
  float v[PER];
#pragma unroll
  for (int i = 0; i < PER; ++i) { const int s = s0 + i; v[i] = (s < n) ? ((s < n0) ? src0[(size_t)s * 8] : src1[(size_t)(s - n0) * 8]) : 0.f; }
  float loc = 0.f;
#pragma unroll
  for (int i = 0; i < PER; ++i) loc += v[i];
  part[tid] = loc;
  __syncthreads();
  float run = 0.f;
  for (int i = 0; i < tid; ++i) run += part[i];
#pragma unroll
  for (int i = 0; i < PER; ++i) { run += v[i]; if (s0 + i < n) dst[s0 + i] = -run * LOG2E; }
  __syncthreads();
}
DI void phase_scan(const Params& p, char* smem) {
  float* part = (float*)smem;
  for (int it = blockIdx.x; it < 256; it += gridDim.x) {
    const int bh = it & 127, b = bh >> 3, h = bh & 7;
    if (it < 128) scan_one<17>(p.c_fx_logf + (size_t)b * PAST * 8 + h, PAST, p.out + OUT_LF_S + (size_t)b * DSEQ * 8 + h, PAST + DSEQ, (float*)(p.ws + WS_CBS) + (size_t)bh * 4160, part);
    else scan_one<8>(p.out + OUT_LF_P + (size_t)b * SEQ * 8 + h, SEQ, nullptr, SEQ, (float*)(p.ws + WS_CBP) + (size_t)bh * 2048, part);
  }
}

constexpr int KLD = 72, VLD = 68;
struct SmemAttn { u16 k[2][64 * KLD]; u16 vt[2][64 * VLD]; float cb[4160]; float part[256]; u16 q[128 * KLD]; };
static_assert(sizeof(SmemAttn) <= SMEM_BYTES, "attn smem");

struct KVRegs { float4 k[4], v[4]; };
DI void kv_fetch(KVRegs& r, const float* kb, const float* vb, int tid) {
#pragma unroll
  for (int i = 0; i < 4; ++i) { const int c = tid + 256 * i; const size_t o = (size_t)(c >> 4) * 512 + (c & 15) * 4; r.k[i] = *(const float4*)(kb + o); r.v[i] = *(const float4*)(vb + o); }
}
DI void kv_stash(const KVRegs& r, u16* ks, u16* vts, int tid) {
#pragma unroll
  for (int i = 0; i < 4; ++i) {
    const int c = tid + 256 * i; const int row = c >> 4, c4 = (c & 15) * 4;
    *(uint2*)(ks + row * KLD + c4) = make_uint2(pk2(r.k[i].x, r.k[i].y), pk2(r.k[i].z, r.k[i].w));
    vts[(c4 + 0) * VLD + row] = bf1(r.v[i].x); vts[(c4 + 1) * VLD + row] = bf1(r.v[i].y);
    vts[(c4 + 2) * VLD + row] = bf1(r.v[i].z); vts[(c4 + 3) * VLD + row] = bf1(r.v[i].w);
  }
}
typedef unsigned kv_u32x4 __attribute__((ext_vector_type(4)));
typedef unsigned kv_u32x2 __attribute__((ext_vector_type(2)));
struct KV16 { kv_u32x4 k0, k1, v0, v1; };
DI void kv_fetch16(KV16& r, const u16* kb, const u16* vtb, int tid) {
  const int c0 = tid, c1 = tid + 256;
  r.k0 = *(const kv_u32x4*)(kb + (size_t)(c0 >> 3) * 512 + (c0 & 7) * 8); r.k1 = *(const kv_u32x4*)(kb + (size_t)(c1 >> 3) * 512 + (c1 & 7) * 8);
  r.v0 = *(const kv_u32x4*)(vtb + (size_t)(c0 >> 3) * SEQ + (c0 & 7) * 8); r.v1 = *(const kv_u32x4*)(vtb + (size_t)(c1 >> 3) * SEQ + (c1 & 7) * 8);
}
DI void kv_stash16(const KV16& r, u16* ks, u16* vts, int tid) {
  const int c0 = tid, c1 = tid + 256;
  *(kv_u32x4*)(ks + (c0 >> 3) * KLD + (c0 & 7) * 8) = r.k0;
  *(kv_u32x4*)(ks + (c1 >> 3) * KLD + (c1 & 7) * 8) = r.k1;
  kv_u32x2 a = {r.v0[0], r.v0[1]}, b2 = {r.v0[2], r.v0[3]}, c = {r.v1[0], r.v1[1]}, d = {r.v1[2], r.v1[3]};
  *(kv_u32x2*)(vts + (c0 >> 3) * VLD + (c0 & 7) * 8) = a; *(kv_u32x2*)(vts + (c0 >> 3) * VLD + (c0 & 7) * 8 + 4) = b2;
  *(kv_u32x2*)(vts + (c1 >> 3) * VLD + (c1 & 7) * 8) = c; *(kv_u32x2*)(vts + (c1 >> 3) * VLD + (c1 & 7) * 8 + 4) = d;
}
DI bf16x8 pack8(const f32x16& x, int s) {
  union { unsigned u[4]; bf16x8 v; } t;
  t.u[0] = pk2(x[8 * s + 0], x[8 * s + 1]); t.u[1] = pk2(x[8 * s + 2], x[8 * s + 3]);
  t.u[2] = pk2(x[8 * s + 4], x[8 * s + 5]); t.u[3] = pk2(x[8 * s + 6], x[8 * s + 7]);
  return t.v;
}

template <bool FOX, bool SMP>
DI void attn_item(const Params& p, int b, int h, int qb, char* smem, bool do_ssq = true, int split = 0) {
  constexpr int smp = SMP ? 1 : 0;
  constexpr bool SPLIT = FOX && SMP;
  SmemAttn& sm = *(SmemAttn*)smem;
  const int tid = threadIdx.x, lane = tid & 63, wid = tid >> 6, r31 = lane & 31, hh = lane >> 5;
  const int jt0 = SPLIT ? split * 8 : 0;
  const int nkt = SPLIT ? (split == 7 ? 9 : 8) : (smp ? 65 : 2 * qb + 2);
  const int jdiag = smp ? 64 : 2 * qb;
  int qi = wid * 32 + r31; if (smp) qi &= 63;
  const int qpos = (smp ? PAST : qb * 128) + qi;
  const int g = smp ? NTP + b * DSEQ + qi : b * SEQ + qb * 128 + qi;
  const u16* Q = (const u16*)(p.ws + WS_D) + (FOX ? (size_t)NT * 512 : 0);
  {
#pragma unroll
    for (int i = 0; i < 4; ++i) {
      const int c = tid + 256 * i; const int row = c >> 3, kc = (c & 7) * 8;
      const int qr = smp ? (row & 63) : row;
      const int gr = smp ? NTP + b * DSEQ + qr : b * SEQ + qb * 128 + qr;
      *(kv_u32x4*)(sm.q + row * KLD + kc) = *(const kv_u32x4*)(Q + (size_t)gr * 512 + h * 64 + kc);
    }
    __syncthreads();
  }

  const float* kcache = FOX ? p.c_fx_k : p.c_sb_k;
  const float* vcache = FOX ? p.c_fx_v : p.c_sb_v;
  const size_t okp = FOX ? OUT_FXK_P : OUT_SBK_P, ovp = FOX ? OUT_FXV_P : OUT_SBV_P;
  const size_t oks = FOX ? OUT_FXK_S : OUT_SBK_S, ovs = FOX ? OUT_FXV_S : OUT_SBV_S;
  auto kptr = [&](int j) -> const float* {
    if (!smp) return p.out + okp + ((size_t)(b * SEQ + 64 * j) * 512 + h * 64);
    if (j < 64) return kcache + ((size_t)(b * PAST + 64 * j) * 512 + h * 64);
    return p.out + oks + ((size_t)(b * DSEQ) * 512 + h * 64);
  };
  auto vptr = [&](int j) -> const float* {
    if (!smp) return p.out + ovp + ((size_t)(b * SEQ + 64 * j) * 512 + h * 64);
    if (j < 64) return vcache + ((size_t)(b * PAST + 64 * j) * 512 + h * 64);
    return p.out + ovs + ((size_t)(b * DSEQ) * 512 + h * 64);
  };

  if (FOX) {
    const float4* src = (const float4*)(smp ? (const float*)(p.ws + WS_CBS) + (size_t)(b * 8 + h) * 4160 : (const float*)(p.ws + WS_CBP) + (size_t)(b * 8 + h) * 2048);
    for (int i = jt0 * 16 + tid; i < (jt0 + nkt) * 16; i += 256) ((float4*)sm.cb)[i] = src[i];
    __syncthreads();
  }

  bf16x8 tri[2];
  if (!FOX) {
#pragma unroll
    for (int s = 0; s < 2; ++s)
#pragma unroll
      for (int j = 0; j < 8; ++j) { const int kin = 16 * s + 8 * (j >> 2) + 4 * hh + (j & 3); tri[s][j] = (kin >= r31) ? (short)0x3F80 : (short)0; }
  }

  f32x16 o[2];
#pragma unroll
  for (int d = 0; d < 2; ++d)
#pragma unroll
    for (int e = 0; e < 16; ++e) o[d][e] = 0.f;
  float mrun = -1e30f, lrun = 0.f, R = 0.f;

  KVRegs kv;
  KV16 kw;
  const int jfirst = FOX ? jt0 : nkt - 1;
  const u16* k16 = (const u16*)(p.ws + WS_A) + (FOX ? (size_t)NTP * 512 : 0) + (size_t)(b * SEQ) * 512 + h * 64;
  const u16* vt16 = (const u16*)(p.ws + WS_B) + (FOX ? (size_t)NTP * 512 : 0) + (size_t)((b * 8 + h) * 64) * SEQ;
  if (smp) { kv_fetch(kv, kptr(jfirst), vptr(jfirst), tid); kv_stash(kv, sm.k[0], sm.vt[0], tid); }
  else { kv_fetch16(kw, k16 + (size_t)(64 * jfirst) * 512, vt16 + 64 * jfirst, tid); kv_stash16(kw, sm.k[0], sm.vt[0], tid); }
  __syncthreads();
  for (int it = 0; it < nkt; ++it) {
    const int j = FOX ? jt0 + it : nkt - 1 - it;
    const int cur = it & 1;
    if (it + 1 < nkt) { const int jn = FOX ? j + 1 : j - 1; if (smp) kv_fetch(kv, kptr(jn), vptr(jn), tid); else kv_fetch16(kw, k16 + (size_t)(64 * jn) * 512, vt16 + 64 * jn, tid); }
    f32x16 s[2];
#pragma unroll
    for (int t2 = 0; t2 < 2; ++t2) {
#pragma unroll
      for (int e = 0; e < 16; ++e) s[t2][e] = 0.f;
      const u16* pk = sm.k[cur] + (t2 * 32 + r31) * KLD + hh * 8;
      const u16* pq = sm.q + (wid * 32 + r31) * KLD + hh * 8;
#pragma unroll
      for (int kk = 0; kk < 4; ++kk) { const bf16x8 a = *(const bf16x8*)(pk + kk * 16); const bf16x8 qv = *(const bf16x8*)(pq + kk * 16); s[t2] = MFMA(a, qv, s[t2]); }
    }
    const bool diag = j >= jdiag;
    const int kbase = 64 * j + 4 * hh;
    if (FOX) {
      float mloc = -1e30f;
#pragma unroll
      for (int t2 = 0; t2 < 2; ++t2)
#pragma unroll
        for (int g4 = 0; g4 < 4; ++g4) {
          const float4 bb = *(const float4*)(sm.cb + 64 * j + 32 * t2 + 8 * g4 + 4 * hh);
          const float bv[4] = {bb.x, bb.y, bb.z, bb.w};
#pragma unroll
          for (int e = 0; e < 4; ++e) {
            float x = s[t2][4 * g4 + e] * LOG2E + bv[e];
            if (diag && (kbase + 32 * t2 + 8 * g4 + e > qpos)) x = -1e30f;
            s[t2][4 * g4 + e] = x;
            mloc = fmaxf(mloc, x);
          }
        }
      mloc = fmaxf(mloc, __shfl_xor(mloc, 32));
      const float mnew = fmaxf(mrun, mloc);
      const float alpha = exp2f(mrun - mnew);
      mrun = mnew;
      float ls = 0.f;
#pragma unroll
      for (int t2 = 0; t2 < 2; ++t2)
#pragma unroll
        for (int e = 0; e < 16; ++e) { const float pv = exp2f(s[t2][e] - mnew); s[t2][e] = pv; ls += pv; }
      lrun = lrun * alpha + ls;
#pragma unroll
      for (int d = 0; d < 2; ++d)
#pragma unroll
        for (int e = 0; e < 16; ++e) o[d][e] *= alpha;
    } else {
#pragma unroll
      for (int t2 = 1; t2 >= 0; --t2) {
        f32x16 lk;
#pragma unroll
        for (int e = 0; e < 16; ++e) {
          const float z = s[t2][e];
          const float sp = fmaxf(z, 0.f) + __logf(1.f + __expf(-fabsf(z)));
          const bool vis = !diag || (kbase + 32 * t2 + ACC_ROW(e, 0) < qpos);
          lk[e] = vis ? -sp : 0.f;
        }
        bf16x8 fh[2], fl[2];
#pragma unroll
        for (int sI = 0; sI < 2; ++sI) fh[sI] = pack8(lk, sI);
#pragma unroll
        for (int e = 0; e < 16; ++e) lk[e] -= __uint_as_float(((unsigned)(u16)fh[e >> 3][e & 7]) << 16);
#pragma unroll
        for (int sI = 0; sI < 2; ++sI) fl[sI] = pack8(lk, sI);
        f32x16 inc;
#pragma unroll
        for (int e = 0; e < 16; ++e) inc[e] = R;
#pragma unroll
        for (int sI = 0; sI < 2; ++sI) { inc = MFMA(tri[sI], fh[sI], inc); inc = MFMA(tri[sI], fl[sI], inc); }
#pragma unroll
        for (int e = 0; e < 16; ++e) {
          const bool vis = !diag || (kbase + 32 * t2 + ACC_ROW(e, 0) < qpos);
          const float w = exp2f((s[t2][e] + inc[e]) * LOG2E);
          s[t2][e] = vis ? w : 0.f;
        }
        R = __shfl(inc[0], r31);
      }
    }
#pragma unroll
    for (int t2 = 0; t2 < 2; ++t2)
#pragma unroll
      for (int sI = 0; sI < 2; ++sI) {
        const bf16x8 pf = pack8(s[t2], sI);
#pragma unroll
        for (int d = 0; d < 2; ++d) {
          const u16* pv = sm.vt[cur] + (d * 32 + r31) * VLD + 32 * t2 + 16 * sI + 4 * hh;
          union { s16x4 q[2]; bf16x8 v; } a;
          a.q[0] = *(const s16x4*)(pv); a.q[1] = *(const s16x4*)(pv + 8);
          o[d] = MFMA(a.v, pf, o[d]);
        }
      }
    if (it + 1 < nkt) { if (smp) kv_stash(kv, sm.k[cur ^ 1], sm.vt[cur ^ 1], tid); else kv_stash16(kw, sm.k[cur ^ 1], sm.vt[cur ^ 1], tid); }
#if SB_EXIT
    if (!FOX) { if (__syncthreads_and(R < -110.f)) break; } else __syncthreads();
#else
    __syncthreads();
#endif
  }
  if (SPLIT) {
    constexpr int NS = 8;
    const int bh = b * 8 + h;
    float* po = (float*)(p.ws + WS_F) + (size_t)(bh * NS) * 4096;
    float* pml = (float*)(p.ws + WS_F) + (size_t)128 * NS * 4096 + (size_t)(bh * NS) * 128;
    const float lt = lrun + __shfl_xor(lrun, 32);
    if (wid < 2) {
      float* dst = po + (size_t)split * 4096 + qi * 64;
#pragma unroll
      for (int d = 0; d < 2; ++d)
#pragma unroll
        for (int g4 = 0; g4 < 4; ++g4) *(float4*)(dst + d * 32 + 8 * g4 + 4 * hh) = make_float4(o[d][4 * g4], o[d][4 * g4 + 1], o[d][4 * g4 + 2], o[d][4 * g4 + 3]);
      if (hh == 0) *(float2*)(pml + (size_t)split * 128 + qi * 2) = make_float2(mrun, lt);
    }
    int* slot2 = (int*)(smem + 73728 + 528);
    asm volatile("s_waitcnt vmcnt(0)" ::: "memory");
    __syncthreads();
    if (tid == 0) {
      __builtin_amdgcn_fence(__ATOMIC_RELEASE, "agent");
      asm volatile("s_waitcnt vmcnt(0)" ::: "memory");
      const unsigned old = __hip_atomic_fetch_add((unsigned*)(p.ws + WS_BAR + 256) + bh + (do_ssq ? 0 : 128), 1u, __ATOMIC_RELAXED, __HIP_MEMORY_SCOPE_AGENT);
      __builtin_amdgcn_fence(__ATOMIC_ACQUIRE, "agent");
      asm volatile("s_waitcnt vmcnt(0)" ::: "memory");
      *slot2 = (int)old;
    }
    __syncthreads();
    const bool last = (*slot2 == NS - 1);
    __syncthreads();
    if (last) {
      const int q = tid >> 2, d0 = (tid & 3) * 16;
      float ms[NS], ls[NS], M = -1e30f;
#pragma unroll
      for (int s2 = 0; s2 < NS; ++s2) { const float2 ml = *(const float2*)(pml + (size_t)s2 * 128 + q * 2); ms[s2] = ml.x; ls[s2] = ml.y; M = fmaxf(M, ml.x); }
      float L = 0.f, acc[16];
#pragma unroll
      for (int k = 0; k < 16; ++k) acc[k] = 0.f;
#pragma unroll
      for (int s2 = 0; s2 < NS; ++s2) {
        const float w = exp2f(ms[s2] - M);
        L += ls[s2] * w;
        const float4* src = (const float4*)(po + (size_t)s2 * 4096 + q * 64 + d0);
#pragma unroll
        for (int k4 = 0; k4 < 4; ++k4) { const float4 v = src[k4]; acc[4 * k4] += w * v.x; acc[4 * k4 + 1] += w * v.y; acc[4 * k4 + 2] += w * v.z; acc[4 * k4 + 3] += w * v.w; }
      }
      const float invL = 1.f / L;
      float ssq = 0.f;
#pragma unroll
      for (int k = 0; k < 16; ++k) { acc[k] *= invL; ssq += acc[k] * acc[k]; }
      ssq += __shfl_xor(ssq, 1); ssq += __shfl_xor(ssq, 2);
      const int gq = NTP + b * DSEQ + q;
      if (do_ssq && (tid & 3) == 0) atomicAdd((float*)(p.ws + WS_SSQ) + (size_t)gq * 2 + 1, ssq);
      u16* od = (u16*)(p.ws + WS_E) + (size_t)gq * DM + 512 + h * 64 + d0;
      *(uint4*)od = make_uint4(pk2(acc[0], acc[1]), pk2(acc[2], acc[3]), pk2(acc[4], acc[5]), pk2(acc[6], acc[7]));
      *(uint4*)(od + 8) = make_uint4(pk2(acc[8], acc[9]), pk2(acc[10], acc[11]), pk2(acc[12], acc[13]), pk2(acc[14], acc[15]));
    }
    return;
  }
  float inv = 1.f;
  if (FOX) { const float lt = lrun + __shfl_xor(lrun, 32); inv = 1.f / lt; }
  {
    float ssq = 0.f;
#pragma unroll
    for (int d = 0; d < 2; ++d)
#pragma unroll
      for (int e = 0; e < 16; ++e) { const float t = o[d][e] * inv; ssq += t * t; }
    ssq += __shfl_xor(ssq, 32);
    if (do_ssq && hh == 0 && (!smp || wid < 2)) atomicAdd((float*)(p.ws + WS_SSQ) + (size_t)g * 2 + (FOX ? 1 : 0), ssq);
  }
  if (!smp || wid < 2) {
    u16* od = (u16*)(p.ws + WS_E) + (size_t)g * DM + (FOX ? 512 : 0) + h * 64;
#pragma unroll
    for (int d = 0; d < 2; ++d)
#pragma unroll
      for (int g4 = 0; g4 < 4; ++g4)
        *(uint2*)(od + d * 32 + 8 * g4 + 4 * hh) = make_uint2(pk2(o[d][4 * g4] * inv, o[d][4 * g4 + 1] * inv), pk2(o[d][4 * g4 + 2] * inv, o[d][4 * g4 + 3] * inv));
  }
}

template <class F>
DI void attn_queue(unsigned* ctr, int n, int* slot, F body) {
  for (;;) {
    if (threadIdx.x == 0) *slot = (int)atomicAdd(ctr, 1u);
    __syncthreads();
    const int it = *slot;
    __syncthreads();
    if (it >= n) break;
    body(it);
  }
}
DI void phase_attn(const Params& p, char* smem, int rep = 0) {
  unsigned* ctr = (unsigned*)(p.ws + WS_BAR + 128) + rep * 4;
  int* slot = (int*)(smem + 73728 + 512);
  const bool dq = rep == 0;
  attn_queue(ctr + 0, 1024, slot, [&](int it) { const int bh = it >> 3; attn_item<true, true>(p, bh >> 3, bh & 7, 0, smem, dq, it & 7); });
  attn_queue(ctr + 1, 2048, slot, [&](int u) { const int w = u & 511; const int qb = 15 - (w >> 5), bh = (u >> 9) * 32 + (w & 31); attn_item<true, false>(p, bh >> 3, bh & 7, qb, smem, dq); });
  attn_queue(ctr + 2, 128, slot, [&](int u) { attn_item<false, true>(p, u >> 3, u & 7, 0, smem, dq); });
  attn_queue(ctr + 3, 2048, slot, [&](int u) { const int w = u & 511; const int qb = 15 - (w >> 5), bh = (u >> 9) * 32 + (w & 31); attn_item<false, false>(p, bh >> 3, bh & 7, qb, smem, dq); });
}

DI void phase_wout(const Params& p, char* smem) {
  float* pre = (float*)(p.ws + WS_A);
  const u16* o = (const u16*)(p.ws + WS_E);
  float* sc_s = (float*)(smem + 73728);
  for_tiles(DM, [&](int m0, int n0, auto tag) {
    constexpr int MI = decltype(tag)::value;
    {
      const int tid = threadIdx.x;
      if (tid < MI * 64) {
        const float2 q = ((const float2*)(p.ws + WS_SSQ))[m0 + tid];
        const float s0 = rsqrtf(q.x * (1.f / 512.f) + 1e-6f), s1 = rsqrtf(q.y * (1.f / 512.f) + 1e-6f);
        sc_s[tid * 2] = s0 / s1; sc_s[tid * 2 + 1] = s1;
      }
      __syncthreads();
    }
    GldsBf16<MI * 64> al; al.base = o + (size_t)m0 * DM; al.ld = DM;
    const float* xr = xrow(p, m0);
    auto epi = [=](int r0, int c0, const f32x16& acc) {
      const int lane = threadIdx.x & 63, hh = lane >> 5, col = c0 + (lane & 31);
      const unsigned b0 = (unsigned)(r0 + 4 * hh) * 1024u + col, b1 = (unsigned)(r0 - m0 + 4 * hh) * 1024u + col;
#pragma unroll
      for (int e = 0; e < 16; ++e) pre[b0 + ACC_R0(e) * 1024u] = DN_ALPHA * xr[b1 + ACC_R0(e) * 1024u] + acc[e];
    };
    gemm_tile<MI, true>(al, (const u16*)(p.ws + WS_WOUT), DM, DM, m0, n0, epi, smem, sc_s);
  });
}

DI void phase_ln(const Params& p, const float* gam, const float* bet) {
  const float* pre = (const float*)(p.ws + WS_A);
  float* xf = (float*)(p.ws + WS_B);
  u16* xb = (u16*)(p.ws + WS_C);
  const int lane = threadIdx.x & 63;
  const int wg = blockIdx.x * 4 + (threadIdx.x >> 6), nw = gridDim.x * 4;
  for (int row0 = wg * 2; row0 < NT; row0 += nw * 2) {
    float4 v[2][4];
    float s[2], q[2];
#pragma unroll
    for (int r = 0; r < 2; ++r) {
      s[r] = 0.f;
#pragma unroll
      for (int j = 0; j < 4; ++j) { v[r][j] = ((const float4*)(pre + (size_t)(row0 + r) * DM))[lane + 64 * j]; s[r] += v[r][j].x + v[r][j].y + v[r][j].z + v[r][j].w; }
    }
#pragma unroll
    for (int o = 32; o >= 1; o >>= 1)
#pragma unroll
      for (int r = 0; r < 2; ++r) s[r] += __shfl_xor(s[r], o);
#pragma unroll
    for (int r = 0; r < 2; ++r) {
      s[r] *= (1.f / 1024.f); q[r] = 0.f;
#pragma unroll
      for (int j = 0; j < 4; ++j) { const float a = v[r][j].x - s[r], b2 = v[r][j].y - s[r], c = v[r][j].z - s[r], d = v[r][j].w - s[r]; q[r] += a * a + b2 * b2 + c * c + d * d; }
    }
#pragma unroll
    for (int o = 32; o >= 1; o >>= 1)
#pragma unroll
      for (int r = 0; r < 2; ++r) q[r] += __shfl_xor(q[r], o);
#pragma unroll
    for (int r = 0; r < 2; ++r) {
      const float mu = s[r], rs = rsqrtf(q[r] * (1.f / 1024.f) + 1e-5f);
#pragma unroll
      for (int j = 0; j < 4; ++j) {
        const float4 gg = ((const float4*)gam)[lane + 64 * j], bb = ((const float4*)bet)[lane + 64 * j];
        float4 y;
        y.x = (v[r][j].x - mu) * rs * gg.x + bb.x; y.y = (v[r][j].y - mu) * rs * gg.y + bb.y;
        y.z = (v[r][j].z - mu) * rs * gg.z + bb.z; y.w = (v[r][j].w - mu) * rs * gg.w + bb.w;
        ((float4*)(xf + (size_t)(row0 + r) * DM))[lane + 64 * j] = y;
        ((uint2*)(xb + (size_t)(row0 + r) * DM))[lane + 64 * j] = make_uint2(pk2(y.x, y.y), pk2(y.z, y.w));
      }
    }
  }
}

template <bool NOEPI = false>
DI void phase_gemm_bf16(const Params& p, const u16* A, const u16* Wt, int N, u16* O, float scale, char* smem) {
  for_tiles(N, [&](int m0, int n0, auto tag) {
    constexpr int MI = decltype(tag)::value;
    GldsBf16<MI * 64> al; al.base = A + (size_t)m0 * DM; al.ld = DM;
    auto epi = [=](int r0, int c0, const f32x16& acc) {
      const int lane = threadIdx.x & 63, hh = lane >> 5, col = c0 + (lane & 31);
      const unsigned b0 = (unsigned)(r0 + 4 * hh) * (unsigned)N + col;
      if (NOEPI) { float t = 0.f;
#pragma unroll
        for (int e = 0; e < 16; ++e) t += acc[e];
        if (t == 12345.678f) O[b0] = bf1(t);
        return; }
#pragma unroll
      for (int e = 0; e < 16; ++e) O[b0 + ACC_R0(e) * (unsigned)N] = bf1(acc[e] * scale);
    };
    gemm_tile<MI>(al, Wt, DM, DM, m0, n0, epi, smem);
  });
}

template <class F>
DI void for_mem_tiles(F body) {
  const int vb = vblock(), nb = gridDim.x;
  for (int t = vb; t < 2048 + 256; t += nb) {
    if (t < 2048) { const int mt = t >> 3; body(mt * 128, (t >> 1) & 3, (t & 1) * 128, mt >> 4, IC<2>{}); }
    else { const int u = t - 2048; const int mt = u >> 4; body(NTP + mt * 64, (u >> 2) & 3, (u & 3) * 64, 16 + mt, IC<1>{}); }
  }
}
DI void phase_mem_s(const Params& p, char* smem) {
  const u16* qm = (const u16*)(p.ws + WS_D);
  float* S = (float*)(p.ws + WS_F);
  for_mem_tiles([&](int m0, int hd, int n0, int batch, auto tag) {
    constexpr int MI = decltype(tag)::value;
    GldsBf16<MI * 64> al; al.base = qm + (size_t)m0 * DM + hd * 256; al.ld = DM;
    const u16* Bt = (const u16*)(p.ws + WS_MEMK) + (size_t)batch * 256 * DM + hd * 256;
    auto epi = [=](int r0, int c0, const f32x16& acc) {
      const int lane = threadIdx.x & 63, hh = lane >> 5, col = c0 + (lane & 31);
      const unsigned b0 = (unsigned)(r0 + 4 * hh) * 1024u + hd * 256 + col;
#pragma unroll
      for (int e = 0; e < 16; ++e) S[b0 + ACC_R0(e) * 1024u] = acc[e];
    };
    gemm_tile<MI>(al, Bt, DM, 256, m0, n0, epi, smem);
  });
}
DI void phase_mem_softmax(const Params& p) {
  const float* S = (const float*)(p.ws + WS_F);
  u16* P = (u16*)(p.ws + WS_D);
  const int lane = threadIdx.x & 63;
  const int wg = blockIdx.x * 4 + (threadIdx.x >> 6), nw = gridDim.x * 4;
  for (int row0 = wg * 4; row0 < NT * 4; row0 += nw * 4) {
    float4 v[4]; float m[4], sm[4];
#pragma unroll
    for (int r = 0; r < 4; ++r) v[r] = ((const float4*)(S + (size_t)(row0 + r) * 256))[lane];
#pragma unroll
    for (int r = 0; r < 4; ++r) m[r] = fmaxf(fmaxf(v[r].x, v[r].y), fmaxf(v[r].z, v[r].w));
#pragma unroll
    for (int o = 32; o >= 1; o >>= 1)
#pragma unroll
      for (int r = 0; r < 4; ++r) m[r] = fmaxf(m[r], __shfl_xor(m[r], o));
#pragma unroll
    for (int r = 0; r < 4; ++r) { v[r].x = __expf(v[r].x - m[r]); v[r].y = __expf(v[r].y - m[r]); v[r].z = __expf(v[r].z - m[r]); v[r].w = __expf(v[r].w - m[r]); sm[r] = v[r].x + v[r].y + v[r].z + v[r].w; }
#pragma unroll
    for (int o = 32; o >= 1; o >>= 1)
#pragma unroll
      for (int r = 0; r < 4; ++r) sm[r] += __shfl_xor(sm[r], o);
#pragma unroll
    for (int r = 0; r < 4; ++r) { const float inv = 1.f / sm[r]; ((uint2*)(P + (size_t)(row0 + r) * 256))[lane] = make_uint2(pk2(v[r].x * inv, v[r].y * inv), pk2(v[r].z * inv, v[r].w * inv)); }
  }
}
DI void phase_mem_pv(const Params& p, char* smem) {
  const u16* P = (const u16*)(p.ws + WS_D);
  u16* om = (u16*)(p.ws + WS_E);
  for_mem_tiles([&](int m0, int hd, int n0, int batch, auto tag) {
    constexpr int MI = decltype(tag)::value;
    GldsBf16<MI * 64> al; al.base = P + (size_t)m0 * DM + hd * 256; al.ld = DM;
    const u16* Bt = (const u16*)(p.ws + WS_MEMVT) + ((size_t)batch * DM + hd * 256) * 256;
    auto epi = [=](int r0, int c0, const f32x16& acc) {
      const int lane = threadIdx.x & 63, hh = lane >> 5, col = c0 + (lane & 31);
      const unsigned b0 = (unsigned)(r0 + 4 * hh) * 1024u + hd * 256 + col;
#pragma unroll
      for (int e = 0; e < 16; ++e) om[b0 + ACC_R0(e) * 1024u] = bf1(acc[e]);
    };
    gemm_tile<MI>(al, Bt, 256, 256, m0, n0, epi, smem);
  });
}
DI void phase_wmo(const Params& p, char* smem) {
  float* pre = (float*)(p.ws + WS_A);
  const float* xf = (const float*)(p.ws + WS_B);
  const u16* om = (const u16*)(p.ws + WS_E);
  for_tiles(DM, [&](int m0, int n0, auto tag) {
    constexpr int MI = decltype(tag)::value;
    GldsBf16<MI * 64> al; al.base = om + (size_t)m0 * DM; al.ld = DM;
    auto epi = [=](int r0, int c0, const f32x16& acc) {
      const int lane = threadIdx.x & 63, hh = lane >> 5, col = c0 + (lane & 31);
      const unsigned b0 = (unsigned)(r0 + 4 * hh) * 1024u + col;
#pragma unroll
      for (int e = 0; e < 16; ++e) { const unsigned i = b0 + ACC_R0(e) * 1024u; pre[i] = DN_ALPHA * xf[i] + acc[e]; }
    };
    gemm_tile<MI>(al, (const u16*)(p.ws + WS_WMO), DM, DM, m0, n0, epi, smem);
  });
}

DI void insert16(float (&v)[16], float x) {
#pragma unroll
  for (int j = 15; j >= 1; --j) v[j] = __builtin_amdgcn_fmed3f(x, v[j - 1], v[j]);
  v[0] = fmaxf(v[0], x);
}
DI void phase_topk(const Params& p, char* smem) {
  const int vb = vblock(), nb = gridDim.x;
  const u16* qp = (const u16*)(p.ws + WS_F);
  int* idxo = (int*)(p.ws + WS_A);
  float* gato = (float*)(p.ws + WS_A + (size_t)NT * 128 * 4);
  float* sc = (float*)smem;
  const int tid = threadIdx.x;
  for (int t = vb; t < 264 * 8; t += nb) {
    const int mt = t >> 3, hd = t & 7;
    const int m0 = mt * 128;
    float va[16], vbv[16];
#pragma unroll
    for (int side = 0; side < 2; ++side) {
      GldsBf16<128> al; al.base = qp + (size_t)m0 * 2048 + hd * 256 + side * 128; al.ld = 2048;
      const u16* Bt = (const u16*)(p.ws + (side ? WS_KB : WS_KA)) + (size_t)hd * 128 * 128;
      auto epi = [=](int r0, int c0, const f32x16& acc) {
        const int lane = threadIdx.x & 63, hh = lane >> 5, col = c0 + (lane & 31);
#pragma unroll
        for (int e = 0; e < 16; ++e) sc[(r0 - m0 + ACC_ROW(e, hh)) * 129 + col] = acc[e];
      };
      gemm_tile<2>(al, Bt, 128, 128, m0, 0, epi, smem);
      __syncthreads();
      {
        const int row = tid & 127, half = tid >> 7;
        float* mg = (float*)(smem + 66048);
        float v[16];
#pragma unroll
        for (int j = 0; j < 16; ++j) v[j] = -INFINITY;
        for (int k = 64 * half; k < 64 * half + 64; ++k) {
          const float x = __uint_as_float((__float_as_uint(sc[row * 129 + k]) & ~0x7Fu) | (unsigned)k);
          insert16(v, x);
        }
        if (half == 1) {
#pragma unroll
          for (int j = 0; j < 16; ++j) mg[row * 17 + j] = v[j];
        }
        __syncthreads();
        if (half == 0) {
#pragma unroll
          for (int j = 0; j < 16; ++j) insert16(v, mg[row * 17 + j]);
#pragma unroll
          for (int j = 0; j < 16; ++j) { if (side == 0) va[j] = v[j]; else vbv[j] = v[j]; }
        }
      }
      __syncthreads();
    }
    unsigned char* ids = (unsigned char*)smem;
    if (tid < 128) {
#pragma unroll
      for (int j = 0; j < 16; ++j) { ids[tid * 32 + j] = (unsigned char)(__float_as_uint(va[j]) & 0x7F); ids[tid * 32 + 16 + j] = (unsigned char)(__float_as_uint(vbv[j]) & 0x7F); }
      float top[16];
#pragma unroll
      for (int j = 0; j < 16; ++j) top[j] = -INFINITY;
#pragma unroll
      for (int i = 0; i < 16; ++i)
#pragma unroll
        for (int j = 0; j < 16; ++j)
          if ((i + 1) * (j + 1) <= 16) {
            const float a = __uint_as_float(__float_as_uint(va[i]) & ~0x7Fu), b = __uint_as_float(__float_as_uint(vbv[j]) & ~0x7Fu);
            const float c = __uint_as_float((__float_as_uint(a + b) & ~0xFFu) | (unsigned)(i * 16 + j));
            insert16(top, c);
          }
      const float m = __uint_as_float(__float_as_uint(top[0]) & ~0xFFu);
      float ex[16], ssum = 0.f;
      int eid[16];
#pragma unroll
      for (int j = 0; j < 16; ++j) {
        const unsigned bits = __float_as_uint(top[j]);
        const int code = bits & 0xFF;
        ex[j] = __expf(__uint_as_float(bits & ~0xFFu) - m); ssum += ex[j];
        eid[j] = (int)ids[tid * 32 + (code >> 4)] * 128 + (int)ids[tid * 32 + 16 + (code & 15)];
      }
      const float inv = 1.f / ssum;
      const size_t ob = (size_t)(m0 + tid) * 128 + hd * 16;
#pragma unroll
      for (int j4 = 0; j4 < 4; ++j4) {
        *(int4*)(idxo + ob + 4 * j4) = make_int4(eid[4 * j4], eid[4 * j4 + 1], eid[4 * j4 + 2], eid[4 * j4 + 3]);
        *(float4*)(gato + ob + 4 * j4) = make_float4(ex[4 * j4] * inv, ex[4 * j4 + 1] * inv, ex[4 * j4 + 2] * inv, ex[4 * j4 + 3] * inv);
      }
    }
    __syncthreads();
  }
}

#if USE_FP8
typedef float f32x2v __attribute__((ext_vector_type(2)));
DI void unpack16(const uint4& v, float (&f)[16]) {
  const unsigned w[4] = {v.x, v.y, v.z, v.w};
#pragma unroll
  for (int j = 0; j < 4; ++j) {
    const f32x2v lo = __builtin_amdgcn_cvt_pk_f32_fp8((int)w[j], false), hi = __builtin_amdgcn_cvt_pk_f32_fp8((int)w[j], true);
    f[4 * j] = lo[0]; f[4 * j + 1] = lo[1]; f[4 * j + 2] = hi[0]; f[4 * j + 3] = hi[1];
  }
}
DI void peer_dot8(const char* U, int idreg, int e0, int lane, const float (&x)[16], float& dacc) {
  uint4 w[8];
#pragma unroll
  for (int j = 0; j < 8; ++j) { const int id = __builtin_amdgcn_readlane(idreg, e0 + j); w[j] = *(const uint4*)(U + (size_t)id * DM + 16 * lane); }
  float s[8];
#pragma unroll
  for (int j = 0; j < 8; ++j) {
    float f[16]; unpack16(w[j], f);
    float a = 0.f;
#pragma unroll
    for (int k = 0; k < 16; ++k) a += f[k] * x[k];
    s[j] = a;
  }
  const bool b5 = lane & 32, b4 = lane & 16, b3 = lane & 8;
  float t4[4], t2[2], t1;
#pragma unroll
  for (int i = 0; i < 4; ++i) { const float snd = b5 ? s[i] : s[4 + i], kp = b5 ? s[4 + i] : s[i]; t4[i] = kp + __shfl_xor(snd, 32); }
#pragma unroll
  for (int i = 0; i < 2; ++i) { const float snd = b4 ? t4[i] : t4[2 + i], kp = b4 ? t4[2 + i] : t4[i]; t2[i] = kp + __shfl_xor(snd, 16); }
  { const float snd = b3 ? t2[0] : t2[1], kp = b3 ? t2[1] : t2[0]; t1 = kp + __shfl_xor(snd, 8); }
  t1 += __shfl_xor(t1, 4); t1 += __shfl_xor(t1, 2); t1 += __shfl_xor(t1, 1);
  const float g = __shfl(t1, (lane & 7) * 8);
  if ((lane >> 3) == (e0 >> 3)) dacc = g;
}
DI void peer_axpy8(const char* V, int idreg, float hreg, int e0, int lane, float (&acc)[16]) {
  uint4 w[8];
#pragma unroll
  for (int j = 0; j < 8; ++j) { const int id = __builtin_amdgcn_readlane(idreg, e0 + j); w[j] = *(const uint4*)(V + (size_t)id * DM + 16 * lane); }
#pragma unroll
  for (int j = 0; j < 8; ++j) {
    const float hs = __uint_as_float(__builtin_amdgcn_readlane(__float_as_uint(hreg), e0 + j));
    float f[16]; unpack16(w[j], f);
#pragma unroll
    for (int k = 0; k < 16; ++k) acc[k] += hs * f[k];
  }
}
DI void peer_sort(int& id0, int& id1, float& g0, float& g1, int lane) {
  unsigned k0 = ((unsigned)id0 << 7) | (unsigned)lane, k1 = ((unsigned)id1 << 7) | (unsigned)(lane + 64);
#pragma unroll
  for (int k = 2; k <= 128; k <<= 1) {
#pragma unroll
    for (int j = k >> 1; j >= 1; j >>= 1) {
      if (j == 64) {
        const unsigned lo = min(k0, k1), hi = max(k0, k1); k0 = lo; k1 = hi;
      } else {
        const unsigned p0 = (unsigned)__shfl_xor((int)k0, j), p1 = (unsigned)__shfl_xor((int)k1, j);
        const bool upper = (lane & j) != 0;
        const bool asc0 = ((lane & k) == 0), asc1 = (((lane + 64) & k) == 0);
        k0 = (upper == asc0) ? max(k0, p0) : min(k0, p0);
        k1 = (upper == asc1) ? max(k1, p1) : min(k1, p1);
      }
    }
  }
  const int s0 = k0 & 127, s1 = k1 & 127;
  const float a0 = __shfl(g0, s0 & 63), b0 = __shfl(g1, s0 & 63), a1 = __shfl(g0, s1 & 63), b1 = __shfl(g1, s1 & 63);
  g0 = (s0 < 64) ? a0 : b0; g1 = (s1 < 64) ? a1 : b1;
  id0 = (int)(k0 >> 7); id1 = (int)(k1 >> 7);
}
DI void peer_load(const Params& p, int row, int lane, float (&x)[16], int& id0, int& id1, float& g0, float& g1) {
  const float* xf = (const float*)(p.ws + WS_B);
  const int* idxo = (const int*)(p.ws + WS_A);
  const float* gato = (const float*)(p.ws + WS_A + (size_t)NT * 128 * 4);
  const float4* xr = (const float4*)(xf + (size_t)row * DM) + 4 * lane;
#pragma unroll
  for (int j = 0; j < 4; ++j) { const float4 a = xr[j]; x[4 * j] = a.x; x[4 * j + 1] = a.y; x[4 * j + 2] = a.z; x[4 * j + 3] = a.w; }
  id0 = idxo[(size_t)row * 128 + lane]; id1 = idxo[(size_t)row * 128 + 64 + lane];
  g0 = gato[(size_t)row * 128 + lane]; g1 = gato[(size_t)row * 128 + 64 + lane];
  peer_sort(id0, id1, g0, g1, lane);
}
DI void peer_finish(const Params& p, int row, int lane, float (&acc)[16]) {
  float x[16];
  {
    const float4* xr = (const float4*)((const float*)(p.ws + WS_B) + (size_t)row * DM) + 4 * lane;
#pragma unroll
    for (int j = 0; j < 4; ++j) { const float4 a = xr[j]; x[4 * j] = a.x; x[4 * j + 1] = a.y; x[4 * j + 2] = a.z; x[4 * j + 3] = a.w; }
  }
  float s = 0.f;
#pragma unroll
  for (int k = 0; k < 16; ++k) { acc[k] = DN_ALPHA * x[k] + acc[k]; s += acc[k]; }
  const float mu = wave_sum(s) * (1.f / 1024.f);
  float q = 0.f;
#pragma unroll
  for (int k = 0; k < 16; ++k) { const float dd = acc[k] - mu; q += dd * dd; }
  const float rs = rsqrtf(wave_sum(q) * (1.f / 1024.f) + 1e-5f);
  float* y = (row < NTP) ? p.out + OUT_YP + (size_t)row * DM : p.out + OUT_YS + (size_t)(row - NTP) * DM;
#pragma unroll
  for (int j = 0; j < 4; ++j) {
    const float4 ga = ((const float4*)p.ln3_g)[4 * lane + j], ba = ((const float4*)p.ln3_b)[4 * lane + j];
    float4 ya;
    ya.x = (acc[4 * j + 0] - mu) * rs * ga.x + ba.x; ya.y = (acc[4 * j + 1] - mu) * rs * ga.y + ba.y;
    ya.z = (acc[4 * j + 2] - mu) * rs * ga.z + ba.z; ya.w = (acc[4 * j + 3] - mu) * rs * ga.w + ba.w;
    ((float4*)y)[4 * lane + j] = ya;
  }
}
DI float peer_gelu_gate(float d, float g) { return 0.5f * d * (1.f + erff(d * 0.7071067811865476f)) * g; }
DI void phase_peer(const Params& p, int rr0 = 0, int rr1 = 1 << 10) {
  const char* U = p.ws + WS_U;
  const char* V = p.ws + WS_V;
  const float* usc = (const float*)(p.ws + WS_USC);
  const float* vsc = (const float*)(p.ws + WS_VSC);
  const int lane = threadIdx.x & 63;
  const int wg = blockIdx.x * 4 + (threadIdx.x >> 6), nw = gridDim.x * 4;
  for (int rowA = wg + rr0 * 2 * nw; rowA < NT && rowA < wg + rr1 * 2 * nw; rowA += 2 * nw) {
    const bool hasB = rowA + nw < NT;
    const int rowB = hasB ? rowA + nw : rowA;
    asm volatile("" ::: "memory");
    float xA[16], xB[16];
    int a0, a1, b0, b1; float ga0, ga1, gb0, gb1;
    peer_load(p, rowA, lane, xA, a0, a1, ga0, ga1);
    peer_load(p, rowB, lane, xB, b0, b1, gb0, gb1);
    const float sua0 = usc[a0], sua1 = usc[a1], sva0 = vsc[a0], sva1 = vsc[a1];
    const float sub0 = usc[b0], sub1 = usc[b1], svb0 = vsc[b0], svb1 = vsc[b1];
    float da0 = 0.f, da1 = 0.f, db0 = 0.f, db1 = 0.f;
#pragma unroll 1
    for (int e0 = 0; e0 < 64; e0 += 8) { peer_dot8(U, a0, e0, lane, xA, da0); if (hasB) peer_dot8(U, b0, e0, lane, xB, db0); }
#pragma unroll 1
    for (int e0 = 0; e0 < 64; e0 += 8) { peer_dot8(U, a1, e0, lane, xA, da1); if (hasB) peer_dot8(U, b1, e0, lane, xB, db1); }
    const float ha0 = peer_gelu_gate(da0 * sua0, ga0) * sva0, ha1 = peer_gelu_gate(da1 * sua1, ga1) * sva1;
    const float hb0 = peer_gelu_gate(db0 * sub0, gb0) * svb0, hb1 = peer_gelu_gate(db1 * sub1, gb1) * svb1;
    float accA[16], accB[16];
#pragma unroll
    for (int k = 0; k < 16; ++k) { accA[k] = 0.f; accB[k] = 0.f; }
#pragma unroll 1
    for (int e0 = 0; e0 < 64; e0 += 8) { peer_axpy8(V, a0, ha0, e0, lane, accA); if (hasB) peer_axpy8(V, b0, hb0, e0, lane, accB); }
#pragma unroll 1
    for (int e0 = 0; e0 < 64; e0 += 8) { peer_axpy8(V, a1, ha1, e0, lane, accA); if (hasB) peer_axpy8(V, b1, hb1, e0, lane, accB); }
    peer_finish(p, rowA, lane, accA);
    if (hasB) peer_finish(p, rowB, lane, accB);
  }
}
#else
DI void unpack8(const uint4& v, float (&f)[8]) {
  f[0] = bflo(v.x); f[1] = bfhi(v.x); f[2] = bflo(v.y); f[3] = bfhi(v.y); f[4] = bflo(v.z); f[5] = bfhi(v.z); f[6] = bflo(v.w); f[7] = bfhi(v.w);
}
DI void phase_peer(const Params& p) {
  const float* xf = (const float*)(p.ws + WS_B);
  const int* idxo = (const int*)(p.ws + WS_A);
  const float* gato = (const float*)(p.ws + WS_A + (size_t)NT * 128 * 4);
  const u16* U = (const u16*)(p.ws + WS_U);
  const u16* V = (const u16*)(p.ws + WS_V);
  const int lane = threadIdx.x & 63;
  const int wg = blockIdx.x * 4 + (threadIdx.x >> 6), nw = gridDim.x * 4;
  for (int row = wg; row < NT; row += nw) {
    float x[16];
    {
      const float4* xr = (const float4*)(xf + (size_t)row * DM);
      const float4 a = xr[2 * lane], b = xr[2 * lane + 1], c = xr[128 + 2 * lane], d = xr[128 + 2 * lane + 1];
      x[0] = a.x; x[1] = a.y; x[2] = a.z; x[3] = a.w; x[4] = b.x; x[5] = b.y; x[6] = b.z; x[7] = b.w;
      x[8] = c.x; x[9] = c.y; x[10] = c.z; x[11] = c.w; x[12] = d.x; x[13] = d.y; x[14] = d.z; x[15] = d.w;
    }
    const int id0 = idxo[(size_t)row * 128 + lane], id1 = idxo[(size_t)row * 128 + 64 + lane];
    const float g0 = gato[(size_t)row * 128 + lane], g1 = gato[(size_t)row * 128 + 64 + lane];
    float d0 = 0.f, d1 = 0.f;
#pragma unroll 8
    for (int e = 0; e < 64; ++e) {
      const int id = __builtin_amdgcn_readlane(id0, e);
      const uint4* ur = (const uint4*)(U + (size_t)id * DM);
      const uint4 ua = ur[lane], ub = ur[64 + lane];
      float f[8], s = 0.f;
      unpack8(ua, f);
#pragma unroll
      for (int k = 0; k < 8; ++k) s += f[k] * x[k];
      unpack8(ub, f);
#pragma unroll
      for (int k = 0; k < 8; ++k) s += f[k] * x[8 + k];
      s = wave_sum(s);
      if (lane == e) d0 = s;
    }
#pragma unroll 8
    for (int e = 0; e < 64; ++e) {
      const int id = __builtin_amdgcn_readlane(id1, e);
      const uint4* ur = (const uint4*)(U + (size_t)id * DM);
      const uint4 ua = ur[lane], ub = ur[64 + lane];
      float f[8], s = 0.f;
      unpack8(ua, f);
#pragma unroll
      for (int k = 0; k < 8; ++k) s += f[k] * x[k];
      unpack8(ub, f);
#pragma unroll
      for (int k = 0; k < 8; ++k) s += f[k] * x[8 + k];
      s = wave_sum(s);
      if (lane == e) d1 = s;
    }
    const float h0 = 0.5f * d0 * (1.f + erff(d0 * 0.7071067811865476f)) * g0;
    const float h1 = 0.5f * d1 * (1.f + erff(d1 * 0.7071067811865476f)) * g1;
    float acc[16];
#pragma unroll
    for (int k = 0; k < 16; ++k) acc[k] = 0.f;
#pragma unroll 8
    for (int e = 0; e < 64; ++e) {
      const int id = __builtin_amdgcn_readlane(id0, e);
      const float hs = __uint_as_float(__builtin_amdgcn_readlane(__float_as_uint(h0), e));
      const uint4* vr = (const uint4*)(V + (size_t)id * DM);
      const uint4 va = vr[lane], vb2 = vr[64 + lane];
      float f[8];
      unpack8(va, f);
#pragma unroll
      for (int k = 0; k < 8; ++k) acc[k] += hs * f[k];
      unpack8(vb2, f);
#pragma unroll
      for (int k = 0; k < 8; ++k) acc[8 + k] += hs * f[k];
    }
#pragma unroll 8
    for (int e = 0; e < 64; ++e) {
      const int id = __builtin_amdgcn_readlane(id1, e);
      const float hs = __uint_as_float(__builtin_amdgcn_readlane(__float_as_uint(h1), e));
      const uint4* vr = (const uint4*)(V + (size_t)id * DM);
      const uint4 va = vr[lane], vb2 = vr[64 + lane];
      float f[8];
      unpack8(va, f);
#pragma unroll
      for (int k = 0; k < 8; ++k) acc[k] += hs * f[k];
      unpack8(vb2, f);
#pragma unroll
      for (int k = 0; k < 8; ++k) acc[8 + k] += hs * f[k];
    }
    float s = 0.f;
#pragma unroll
    for (int k = 0; k < 16; ++k) { acc[k] = DN_ALPHA * x[k] + acc[k]; s += acc[k]; }
    const float mu = wave_sum(s) * (1.f / 1024.f);
    float q = 0.f;
#pragma unroll
    for (int k = 0; k < 16; ++k) { const float dd = acc[k] - mu; q += dd * dd; }
    const float rs = rsqrtf(wave_sum(q) * (1.f / 1024.f) + 1e-5f);
    float* y = (row < NTP) ? p.out + OUT_YP + (size_t)row * DM : p.out + OUT_YS + (size_t)(row - NTP) * DM;
#pragma unroll
    for (int c = 0; c < 2; ++c) {
      const int off = c * 512 + lane * 8;
      const float4 ga = *(const float4*)(p.ln3_g + off), gb = *(const float4*)(p.ln3_g + off + 4);
      const float4 ba = *(const float4*)(p.ln3_b + off), bb = *(const float4*)(p.ln3_b + off + 4);
      float4 ya, yb;
      ya.x = (acc[8 * c + 0] - mu) * rs * ga.x + ba.x; ya.y = (acc[8 * c + 1] - mu) * rs * ga.y + ba.y;
      ya.z = (acc[8 * c + 2] - mu) * rs * ga.z + ba.z; ya.w = (acc[8 * c + 3] - mu) * rs * ga.w + ba.w;
      yb.x = (acc[8 * c + 4] - mu) * rs * gb.x + bb.x; yb.y = (acc[8 * c + 5] - mu) * rs * gb.y + bb.y;
      yb.z = (acc[8 * c + 6] - mu) * rs * gb.z + bb.z; yb.w = (acc[8 * c + 7] - mu) * rs * gb.w + bb.w;
      *(float4*)(y + off) = ya; *(float4*)(y + off + 4) = yb;
    }
  }
}

#endif

constexpr int NPHASE = 15;
template <int PH>
DI void run_phase(const Params& p, char* smem) {
  if (PH == 0) phase_prep(p, smem);
  else if (PH == 1) phase_proj(p, smem);
  else if (PH == 2) phase_scan(p, smem);
  else if (PH == 3) phase_attn(p, smem);
  else if (PH == 4) phase_wout(p, smem);
  else if (PH == 5) phase_ln(p, p.ln1_g, p.ln1_b);
  else if (PH == 6) phase_gemm_bf16(p, (const u16*)(p.ws + WS_C), (const u16*)(p.ws + WS_WMQ), 1024, (u16*)(p.ws + WS_D), 0.0625f, smem);
  else if (PH == 7) phase_mem_s(p, smem);
  else if (PH == 8) phase_mem_softmax(p);
  else if (PH == 9) phase_mem_pv(p, smem);
  else if (PH == 10) phase_wmo(p, smem);
  else if (PH == 11) phase_ln(p, p.ln2_g, p.ln2_b);
  else if (PH == 12) phase_gemm_bf16(p, (const u16*)(p.ws + WS_C), (const u16*)(p.ws + WS_WPQ), 2048, (u16*)(p.ws + WS_F), 1.f, smem);
  else if (PH == 13) phase_topk(p, smem);
  else if (PH == 14) phase_peer(p);
}

template <int PH>
__global__ void __launch_bounds__(256, 2) k_phase(Params p) {
  __shared__ __attribute__((aligned(16))) char smem[SMEM_BYTES];
  run_phase<PH>(p, smem);
}

#define XB_TMO      128
#define XB_XCNT(j)  (256  + 64 * (j))
#define XB_XSUB(j)  (1280 + 64 * (j))
#define XB_XGEN(j)  (2304 + 64 * (j))
#define XB_TOP      3328
#define XB_TOPGEN   3392
#define XB_SPIN_CAP (1u << 20)
DI unsigned xb_ld(unsigned* p) { return __hip_atomic_load(p, __ATOMIC_RELAXED, __HIP_MEMORY_SCOPE_AGENT); }
DI unsigned xb_add(unsigned* p, unsigned v) { return __hip_atomic_fetch_add(p, v, __ATOMIC_RELAXED, __HIP_MEMORY_SCOPE_AGENT); }
DI unsigned xb_xcc_id() { return (unsigned)__builtin_amdgcn_s_getreg((3 << 11) | 20) & 0xFu; }
#define XB_SPIN(cond, bar) do { unsigned _sp = 0; while (cond) { __builtin_amdgcn_s_sleep(1); \
    if ((++_sp & 255u) == 0u) { if (xb_ld(&(bar)[XB_TMO])) break; if (_sp > XB_SPIN_CAP) { atomicAdd(&(bar)[XB_TMO], 1u); break; } } } } while (0)
struct XcdBarrier { unsigned* bar; unsigned x; volatile unsigned* st; };
DI XcdBarrier xcd_barrier_post(unsigned* bar, volatile unsigned* st) {
  XcdBarrier b; b.bar = bar; b.x = xb_xcc_id(); b.st = st;
  if (threadIdx.x == 0) (void)xb_add(&bar[XB_XCNT(b.x)], 1u);
  return b;
}
DI void xcd_barrier_complete(unsigned* bar, unsigned x, unsigned& nloc, unsigned& nx) {
  const unsigned G = gridDim.x;
  unsigned sum, cnt, mine, sp = 0u;
  for (;;) {
    sum = 0u; cnt = 0u; mine = 0u;
#pragma unroll
    for (unsigned j = 0; j < 16; ++j) { const unsigned c = xb_ld(&bar[XB_XCNT(j)]); sum += c; cnt += (c > 0u) ? 1u : 0u; mine = (j == x) ? c : mine; }
    if (sum == G) break;
    __builtin_amdgcn_s_sleep(1);
    if ((++sp & 255u) == 0u) { if (xb_ld(&bar[XB_TMO])) break; if (sp > XB_SPIN_CAP) { atomicAdd(&bar[XB_TMO], 1u); break; } }
  }
  nloc = mine > 0u ? mine : 1u; nx = cnt > 0u ? cnt : 1u;
}
DI void xcd_barrier(const XcdBarrier& b) {
  asm volatile("s_waitcnt vmcnt(0)" ::: "memory");
  __syncthreads();
  if (threadIdx.x == 0) {
    unsigned* bar = b.bar;
    __builtin_amdgcn_s_waitcnt(0);
    unsigned nloc = b.st[0], nx = b.st[1];
    if (nloc == 0u) { xcd_barrier_complete(bar, b.x, nloc, nx); b.st[0] = nloc; b.st[1] = nx; }
    const unsigned old = xb_add(&bar[XB_XSUB(b.x)], 1u);
    const unsigned gen = old / nloc;
    if (old + 1u == (gen + 1u) * nloc) {
      __builtin_amdgcn_fence(__ATOMIC_RELEASE, "agent");
      asm volatile("s_waitcnt vmcnt(0)" ::: "memory");
      const unsigned og = xb_add(&bar[XB_TOP], 1u);
      const unsigned tg = og / nx;
      if (og + 1u == (tg + 1u) * nx) xb_add(&bar[XB_TOPGEN], 1u);
      else XB_SPIN(xb_ld(&bar[XB_TOPGEN]) == tg, bar);
      __builtin_amdgcn_fence(__ATOMIC_ACQUIRE, "agent");
      xb_add(&bar[XB_XGEN(b.x)], 1u);
      asm volatile("s_waitcnt vmcnt(0)" ::: "memory");
    } else {
      XB_SPIN(xb_ld(&bar[XB_XGEN(b.x)]) == gen, bar);
      __builtin_amdgcn_fence(__ATOMIC_ACQUIRE, "agent");
      asm volatile("s_waitcnt vmcnt(0)" ::: "memory");
    }
  }
  __syncthreads();
}
#if ONE_LAUNCH
DI void grid_barrier(unsigned* bar, unsigned& target) {
  target += gridDim.x;
  asm volatile("s_waitcnt vmcnt(0)" ::: "memory");
  __syncthreads();
  if (threadIdx.x == 0) {
    __builtin_amdgcn_fence(__ATOMIC_RELEASE, "agent");
    asm volatile("s_waitcnt vmcnt(0)" ::: "memory");
    __hip_atomic_fetch_add(bar, 1u, __ATOMIC_RELAXED, __HIP_MEMORY_SCOPE_AGENT);
    while (__hip_atomic_load(bar, __ATOMIC_RELAXED, __HIP_MEMORY_SCOPE_AGENT) < target) __builtin_amdgcn_s_sleep(2);
    __builtin_amdgcn_fence(__ATOMIC_ACQUIRE, "agent");
    asm volatile("s_waitcnt vmcnt(0)" ::: "memory");
  }
  __syncthreads();
}
__global__ void __launch_bounds__(256, 2) k_mega(Params p) {
  __shared__ __attribute__((aligned(16))) char smem[SMEM_BYTES];
  cg::grid_group grid = cg::this_grid();
#define RUN(n) do { run_phase<n>(p, smem); if (REPEAT_PHASE == n || (REPEAT_PHASE >= 1000 && (((REPEAT_PHASE - 1000) >> n) & 1))) { GSYNC(); run_phase<n>(p, smem); GSYNC(); run_phase<n>(p, smem); } if (REPEAT_PHASE == 203 && n == 3) { GSYNC(); phase_attn(p, smem, 1); GSYNC(); phase_attn(p, smem, 2); } if (REPEAT_PHASE == 100 + n) { GSYNC(); phase_gemm_bf16<true>(p, (const u16*)(p.ws + WS_C), (const u16*)(p.ws + WS_WPQ), 2048, (u16*)(p.ws + WS_F), 1.f, smem); GSYNC(); phase_gemm_bf16<true>(p, (const u16*)(p.ws + WS_C), (const u16*)(p.ws + WS_WPQ), 2048, (u16*)(p.ws + WS_F), 1.f, smem); } } while (0)
#if CUSTOM_BAR
  volatile unsigned* xst = (volatile unsigned*)(smem + 73728 + 1024);
  if (threadIdx.x == 0) { xst[0] = 0u; xst[1] = 0u; }
  __syncthreads();
  const XcdBarrier xb = xcd_barrier_post((unsigned*)(p.ws + WS_XBAR), xst);
#define GSYNC() xcd_barrier(xb)
#else
#define GSYNC() grid.sync()
#endif
  RUN(0); grid.sync();
  RUN(1); GSYNC();
  RUN(2); GSYNC();
  RUN(3); GSYNC();
  RUN(4); GSYNC();
  RUN(5); GSYNC();
  if (REPEAT_PHASE == 300) { GSYNC(); GSYNC(); GSYNC(); GSYNC(); GSYNC(); GSYNC(); GSYNC(); GSYNC(); }
  RUN(6); GSYNC();
  RUN(7); GSYNC();
  RUN(8); GSYNC();
  RUN(9); GSYNC();
  RUN(10); GSYNC();
  RUN(11); GSYNC();
  RUN(12); GSYNC();
  RUN(13); GSYNC();
#if PEER_RESYNC
  {
    const int nrounds = (NT + 8 * (int)gridDim.x - 1) / (8 * (int)gridDim.x);
    for (int rr = 0; rr < nrounds; rr += PEER_RESYNC) { if (rr) GSYNC(); phase_peer(p, rr, rr + PEER_RESYNC); }
  }
#else
  RUN(14);
#endif
}
#endif

extern "C" void kernel_launch(void* const* d_in, const int* in_sizes, int n_in, void* d_out, int out_size, void* d_ws, size_t ws_size,
                              hipStream_t stream) {
  (void)in_sizes; (void)n_in; (void)out_size;
  if (ws_size < WS_TOTAL) { fprintf(stderr, "workspace too small: %zu < %zu\n", ws_size, (size_t)WS_TOTAL); return; }
  Params p{};
  const float** pp = (const float**)&p;
  for (int i = 0; i < 29; ++i) pp[i] = (const float*)d_in[i];
  p.out = (float*)d_out;
  p.ws = (char*)d_ws;
#if ONE_LAUNCH
  static int grid_blocks = 0;
  if (!grid_blocks) {
    int dev = 0, cus = 0, per_cu = 0;
    hipGetDevice(&dev);
    hipDeviceGetAttribute(&cus, hipDeviceAttributeMultiprocessorCount, dev);
    hipOccupancyMaxActiveBlocksPerMultiprocessor(&per_cu, k_mega, 256, 0);
    if (per_cu > 2) per_cu = 2;
    grid_blocks = cus * per_cu;
  }
  hipMemsetAsync((char*)d_ws + WS_BAR, 0, 2048, stream);
  hipMemsetAsync((char*)d_ws + WS_XBAR, 0, 16384, stream);
  void* args[] = {&p};
  hipError_t e = hipLaunchCooperativeKernel((void*)k_mega, dim3(grid_blocks), dim3(256), args, 0, stream);
  if (e != hipSuccess) fprintf(stderr, "cooperative launch failed: %s (grid %d)\n", hipGetErrorString(e), grid_blocks);
#else
  const int G = 512;
  hipMemsetAsync((char*)d_ws + WS_BAR, 0, 2048, stream);
  k_phase<0><<<G, 256, 0, stream>>>(p);
  k_phase<1><<<G, 256, 0, stream>>>(p);
  k_phase<2><<<G, 256, 0, stream>>>(p);
  k_phase<3><<<G, 256, 0, stream>>>(p);
  k_phase<4><<<G, 256, 0, stream>>>(p);
  k_phase<5><<<G, 256, 0, stream>>>(p);
  k_phase<6><<<G, 256, 0, stream>>>(p);
  k_phase<7><<<G, 256, 0, stream>>>(p);
  k_phase<8><<<G, 256, 0, stream>>>(p);
  k_phase<9><<<G, 256, 0, stream>>>(p);
  k_phase<10><<<G, 256, 0, stream>>>(p);
  k_phase<11><<<G, 256, 0, stream>>>(p);
  k_phase<12><<<G, 256, 0, stream>>>(p);
  k_phase<13><<<G, 256, 0, stream>>>(p);
  k_phase<14><<<G, 256, 0, stream>>>(p);
#endif
}
```

```cpp
#include <hip/hip_runtime.h>
#include <hip/hip_cooperative_groups.h>
#include <cstdio>
#include <cstdint>
namespace cg = cooperative_groups;

#ifndef ONE_LAUNCH
#define ONE_LAUNCH 1
#endif

#ifndef USE_FP8
#define USE_FP8 1
#endif
#ifndef SB_EXIT
#define SB_EXIT 1
#endif
#ifndef REPEAT_PHASE
#define REPEAT_PHASE -1
#endif
#ifndef PEER_RESYNC
#define PEER_RESYNC 0
#endif
#ifndef CUSTOM_BAR
#define CUSTOM_BAR 1
#endif
#define DI __device__ __forceinline__
typedef unsigned short u16;
typedef short bf16x8 __attribute__((ext_vector_type(8)));
typedef short s16x4 __attribute__((ext_vector_type(4)));
typedef float f32x16 __attribute__((ext_vector_type(16)));
typedef __bf16 bf2_t __attribute__((ext_vector_type(2)));
typedef float f2_t __attribute__((ext_vector_type(2)));
#define MFMA(a, b, c) __builtin_amdgcn_mfma_f32_32x32x16_bf16((a), (b), (c), 0, 0, 0)

constexpr int DM = 1024;
constexpr int NTP = 32768;
constexpr int NTS = 1024;
constexpr int NT = NTP + NTS;
constexpr int SEQ = 2048, DSEQ = 64, PAST = 4096, NMEM = 256;
constexpr int INC = 3080, INCP = 3200;
constexpr float DN_ALPHA = 1.189207115002721f;
constexpr float LOG2E = 1.4426950408889634f;

constexpr size_t OUT_YP = 0;
constexpr size_t OUT_YS = OUT_YP + (size_t)NTP * DM;
constexpr size_t OUT_SBK_P = OUT_YS + (size_t)NTS * DM;
constexpr size_t OUT_SBV_P = OUT_SBK_P + (size_t)NTP * 512;
constexpr size_t OUT_FXK_P = OUT_SBV_P + (size_t)NTP * 512;
constexpr size_t OUT_FXV_P = OUT_FXK_P + (size_t)NTP * 512;
constexpr size_t OUT_LF_P = OUT_FXV_P + (size_t)NTP * 512;
constexpr size_t OUT_MK_P = OUT_LF_P + (size_t)NTP * 8;
constexpr size_t OUT_MV_P = OUT_MK_P + (size_t)4096 * DM;
constexpr size_t OUT_SBK_S = OUT_MV_P + (size_t)4096 * DM;
constexpr size_t OUT_SBV_S = OUT_SBK_S + (size_t)NTS * 512;
constexpr size_t OUT_FXK_S = OUT_SBV_S + (size_t)NTS * 512;
constexpr size_t OUT_FXV_S = OUT_FXK_S + (size_t)NTS * 512;
constexpr size_t OUT_LF_S = OUT_FXV_S + (size_t)NTS * 512;
constexpr size_t OUT_TOTAL = OUT_LF_S + (size_t)NTS * 8;

constexpr size_t WS_WIN = 0;
constexpr size_t WS_WOUT = WS_WIN + (size_t)INCP * DM * 2;
constexpr size_t WS_WMQ = WS_WOUT + (size_t)DM * DM * 2;
constexpr size_t WS_WMKV = WS_WMQ + (size_t)DM * DM * 2;
constexpr size_t WS_WMO = WS_WMKV + (size_t)2048 * DM * 2;
constexpr size_t WS_WPQ = WS_WMO + (size_t)DM * DM * 2;
constexpr size_t WS_KA = WS_WPQ + (size_t)2048 * DM * 2;
constexpr size_t WS_KB = WS_KA + (size_t)8 * 128 * 128 * 2;
constexpr size_t WS_U = WS_KB + (size_t)8 * 128 * 128 * 2;
constexpr size_t WS_V = WS_U + (size_t)16384 * DM * 2;
constexpr size_t WS_MEMK = WS_V + (size_t)16384 * DM * 2;
constexpr size_t WS_MEMVT = WS_MEMK + (size_t)32 * 256 * DM * 2;
constexpr size_t WS_A = WS_MEMVT + (size_t)32 * 256 * DM * 2;
constexpr size_t WS_B = WS_A + (size_t)NT * DM * 4;
constexpr size_t WS_C = WS_B + (size_t)NT * DM * 4;
constexpr size_t WS_D = WS_C + (size_t)NT * DM * 2;
constexpr size_t WS_E = WS_D + (size_t)NT * DM * 2;
constexpr size_t WS_F = WS_E + (size_t)NT * DM * 2;
constexpr size_t WS_BAR = WS_F + (size_t)NT * DM * 4;
constexpr size_t WS_USC = WS_BAR + 2048;
constexpr size_t WS_VSC = WS_USC + (size_t)16384 * 4;
constexpr size_t WS_CBP = WS_VSC + (size_t)16384 * 4;
constexpr size_t WS_CBS = WS_CBP + (size_t)128 * 2048 * 4;
constexpr size_t WS_SSQ = WS_CBS + (size_t)128 * 4160 * 4;
constexpr size_t WS_XBAR = WS_SSQ + (size_t)NT * 2 * 4;
constexpr size_t WS_TOTAL = WS_XBAR + 16384;

struct Params {
  const float *x_prompt, *x_sample, *mem_prompt, *c_sb_k, *c_sb_v, *c_fx_k, *c_fx_v, *c_fx_logf, *c_mem_k, *c_mem_v;
  const float *w_in, *b_f, *w_gn, *w_out, *ln1_g, *ln1_b, *w_mq, *w_mk, *w_mv, *w_mo, *ln2_g, *ln2_b;
  const float *w_pq, *keys_a, *keys_b, *peer_u, *peer_v, *ln3_g, *ln3_b;
  float* out;
  char* ws;
};

DI const Params* kparams() { auto ka = __builtin_amdgcn_kernarg_segment_ptr(); asm volatile("" : "+s"(ka)); return (const Params*)ka; }
constexpr int SMEM_BYTES = 73728 + 1024 + 64;

DI unsigned pk2(float a, float b) { f2_t v = {a, b}; bf2_t r = __builtin_convertvector(v, bf2_t); return __builtin_bit_cast(unsigned, r); }
DI u16 bf1(float a) { return (u16)(pk2(a, 0.f) & 0xffffu); }
DI float bflo(unsigned w) { return __uint_as_float(w << 16); }
DI float bfhi(unsigned w) { return __uint_as_float(w & 0xffff0000u); }
DI float wave_sum(float v) {
#pragma unroll
  for (int o = 32; o >= 1; o >>= 1) v += __shfl_xor(v, o);
  return v;
}
DI float wave_max(float v) {
#pragma unroll
  for (int o = 32; o >= 1; o >>= 1) v = fmaxf(v, __shfl_xor(v, o));
  return v;
}
DI int vblock() { int nb = gridDim.x, b = blockIdx.x; return ((nb & 7) == 0) ? (b & 7) * (nb >> 3) + (b >> 3) : b; }
DI const float* xrow(const Params& p, int g) { return g < NTP ? p.x_prompt + (size_t)g * DM : p.x_sample + (size_t)(g - NTP) * DM; }

DI void tconv_tile(const float* src, int ldsrc, int C, u16* dst, int lddst, const float* rowscale, int tr, int tc, float* tile) {
  const int tid = threadIdx.x;
  {
    const int r = tid >> 2, c0 = (tid & 3) * 16;
    const int gr = tr * 64 + r;
    const float sc = rowscale ? rowscale[gr] : 1.f;
#pragma unroll
    for (int j = 0; j < 4; ++j) {
      const int gc = tc * 64 + c0 + 4 * j;
      float4 v = make_float4(0.f, 0.f, 0.f, 0.f);
      if (gc < C) v = *(const float4*)(src + (size_t)gr * ldsrc + gc);
      float* t = tile + r * 65 + c0 + 4 * j;
      t[0] = v.x * sc; t[1] = v.y * sc; t[2] = v.z * sc; t[3] = v.w * sc;
    }
  }
  __syncthreads();
  {
    const int n = tid >> 2, k0 = (tid & 3) * 16;
    unsigned w[8];
#pragma unroll
    for (int e = 0; e < 8; ++e) w[e] = pk2(tile[(k0 + 2 * e) * 65 + n], tile[(k0 + 2 * e + 1) * 65 + n]);
    uint4* d = (uint4*)(dst + (size_t)(tc * 64 + n) * lddst + tr * 64 + k0);
    d[0] = make_uint4(w[0], w[1], w[2], w[3]);
    d[1] = make_uint4(w[4], w[5], w[6], w[7]);
  }
  __syncthreads();
}

DI void conv_range(const float* src, u16* dst, size_t n8, int bid, int nb) {
  const size_t step = (size_t)nb * 256;
  size_t i = (size_t)bid * 256 + threadIdx.x;
  for (; i + 3 * step < n8; i += 4 * step) {
    float4 a[4], b[4];
#pragma unroll
    for (int u = 0; u < 4; ++u) { a[u] = ((const float4*)src)[2 * (i + u * step)]; b[u] = ((const float4*)src)[2 * (i + u * step) + 1]; }
#pragma unroll
    for (int u = 0; u < 4; ++u) ((uint4*)dst)[i + u * step] = make_uint4(pk2(a[u].x, a[u].y), pk2(a[u].z, a[u].w), pk2(b[u].x, b[u].y), pk2(b[u].z, b[u].w));
  }
  for (; i < n8; i += step) {
    const float4 a = ((const float4*)src)[2 * i], b = ((const float4*)src)[2 * i + 1];
    ((uint4*)dst)[i] = make_uint4(pk2(a.x, a.y), pk2(a.z, a.w), pk2(b.x, b.y), pk2(b.z, b.w));
  }
}

DI void phase_prep(const Params& p, char* smem) {
  float* tile = (float*)smem;
  const int bid = blockIdx.x, nb = gridDim.x;
  u16* ws16 = (u16*)p.ws;
  constexpr int T_WIN = 16 * 50, T_SQ = 256, T_PQ = 16 * 32, T_MV = 16 * 4 * 16;
  constexpr int T0 = T_WIN, T1 = T0 + T_SQ, T2 = T1 + T_SQ, T3 = T2 + T_SQ, T4 = T3 + T_SQ, T5 = T4 + T_SQ, T6 = T5 + T_PQ, T7 = T6 + T_MV;
  for (int t = bid; t < T7; t += nb) {
    if (t < T0) { tconv_tile(p.w_in, INC, INC, (u16*)(p.ws + WS_WIN), DM, nullptr, t / 50, t % 50, tile); }
    else if (t < T1) { int u = t - T0; tconv_tile(p.w_out, DM, DM, (u16*)(p.ws + WS_WOUT), DM, p.w_gn, u >> 4, u & 15, tile); }
    else if (t < T2) { int u = t - T1; tconv_tile(p.w_mq, DM, DM, (u16*)(p.ws + WS_WMQ), DM, nullptr, u >> 4, u & 15, tile); }
    else if (t < T3) { int u = t - T2; tconv_tile(p.w_mk, DM, DM, (u16*)(p.ws + WS_WMKV), DM, nullptr, u >> 4, u & 15, tile); }
    else if (t < T4) { int u = t - T3; tconv_tile(p.w_mv, DM, DM, (u16*)(p.ws + WS_WMKV) + (size_t)DM * DM, DM, nullptr, u >> 4, u & 15, tile); }
    else if (t < T5) { int u = t - T4; tconv_tile(p.w_mo, DM, DM, (u16*)(p.ws + WS_WMO), DM, nullptr, u >> 4, u & 15, tile); }
    else if (t < T6) { int u = t - T5; tconv_tile(p.w_pq, 2048, 2048, (u16*)(p.ws + WS_WPQ), DM, nullptr, u >> 5, u & 31, tile); }
    else { int u = t - T6; int b = u >> 6, r = u & 63;
      tconv_tile(p.c_mem_v + (size_t)b * 256 * DM, DM, DM, (u16*)(p.ws + WS_MEMVT) + (size_t)(16 + b) * DM * 256, 256, nullptr, r >> 4, r & 15, tile); }
  }
  (void)ws16;
  for (int i = bid * 256 + threadIdx.x; i < NT * 2; i += nb * 256) ((float*)(p.ws + WS_SSQ))[i] = 0.f;
  conv_range(p.x_prompt, (u16*)(p.ws + WS_C), (size_t)NTP * DM / 8, bid, nb);
  conv_range(p.x_sample, (u16*)(p.ws + WS_C) + (size_t)NTP * DM, (size_t)NTS * DM / 8, bid, nb);
  conv_range(p.mem_prompt, (u16*)(p.ws + WS_E), (size_t)4096 * DM / 8, bid, nb);
  conv_range(p.c_mem_k, (u16*)(p.ws + WS_MEMK) + (size_t)16 * 256 * DM, (size_t)16 * 256 * DM / 8, bid, nb);
  conv_range(p.keys_a, (u16*)(p.ws + WS_KA), (size_t)8 * 128 * 128 / 8, bid, nb);
  conv_range(p.keys_b, (u16*)(p.ws + WS_KB), (size_t)8 * 128 * 128 / 8, bid, nb);
#if USE_FP8
  {
    const int lane = threadIdx.x & 63;
    const int wg = bid * 4 + (threadIdx.x >> 6), nw = nb * 4;
    for (int row0 = wg; row0 < 32768; row0 += 2 * nw) {
      float4 a[2][4];
      float am[2];
#pragma unroll
      for (int u = 0; u < 2; ++u) {
        const int row = row0 + u * nw;
        const bool isv = row >= 16384;
        const int r = isv ? row - 16384 : row;
        const float4* src = (const float4*)((isv ? p.peer_v : p.peer_u) + (size_t)r * DM) + 4 * lane;
        am[u] = 0.f;
#pragma unroll
        for (int j = 0; j < 4; ++j) { a[u][j] = src[j]; am[u] = fmaxf(am[u], fmaxf(fmaxf(fabsf(a[u][j].x), fabsf(a[u][j].y)), fmaxf(fabsf(a[u][j].z), fabsf(a[u][j].w)))); }
      }
#pragma unroll
      for (int o = 32; o >= 1; o >>= 1)
#pragma unroll
        for (int u = 0; u < 2; ++u) am[u] = fmaxf(am[u], __shfl_xor(am[u], o));
#pragma unroll
      for (int u = 0; u < 2; ++u) {
        const int row = row0 + u * nw;
        const bool isv = row >= 16384;
        const int r = isv ? row - 16384 : row;
        int ex = 0;
        if (am[u] > 0.f) (void)frexpf(am[u], &ex);
        const float sc = ldexpf(1.f, 8 - ex), isc = ldexpf(1.f, ex - 8);
        unsigned w[4];
#pragma unroll
        for (int j = 0; j < 4; ++j) {
          int t = __builtin_amdgcn_cvt_pk_fp8_f32(a[u][j].x * sc, a[u][j].y * sc, 0, false);
          t = __builtin_amdgcn_cvt_pk_fp8_f32(a[u][j].z * sc, a[u][j].w * sc, t, true);
          w[j] = (unsigned)t;
        }
        *(uint4*)(p.ws + (isv ? WS_V : WS_U) + (size_t)r * DM + 16 * lane) = make_uint4(w[0], w[1], w[2], w[3]);
        if (lane == 0) ((float*)(p.ws + (isv ? WS_VSC : WS_USC)))[r] = isc;
      }
    }
  }
#else
  conv_range(p.peer_u, (u16*)(p.ws + WS_U), (size_t)16384 * DM / 8, bid, nb);
  conv_range(p.peer_v, (u16*)(p.ws + WS_V), (size_t)16384 * DM / 8, bid, nb);
#endif
}

#define ACC_ROW(e, hh) (((e) & 3) + 8 * ((e) >> 2) + 4 * (hh))
#define ACC_R0(e) (((e) & 3) + 8 * ((e) >> 2))
DI void store_bf16_pairs(u16* O, unsigned b0, unsigned ld, const f32x16& acc, float scale) {
  const bool odd = (threadIdx.x & 1) != 0;
#pragma unroll
  for (int e = 0; e < 16; e += 2) {
    const float a = acc[e] * scale, b = acc[e + 1] * scale;
    const float snd = odd ? a : b;
    const float rcv = __int_as_float(__builtin_amdgcn_update_dpp(0, __float_as_int(snd), 0xB1, 0xF, 0xF, true));
    const unsigned w = odd ? pk2(rcv, b) : pk2(a, rcv);
    const unsigned idx = b0 + (ACC_R0(e) + (odd ? 1u : 0u)) * ld - (odd ? 1u : 0u);
    *(unsigned*)(O + idx) = w;
  }
}
template <int V> struct IC { static constexpr int value = V; };
struct SmemGemm { u16 a[2][128 * 64]; u16 b[2][128 * 64]; };

template <int ROWS>
struct GldsBf16 {
  const u16* base; int ld;
  DI void issue(int kt, u16* lds, int tid) {
    const int wid = tid >> 6, lane = tid & 63;
    constexpr int NCH = ROWS / 32;
#pragma unroll
    for (int q = 0; q < NCH; ++q) {
      const int ch = wid * NCH + q;
      const int r = ch * 8 + (lane >> 3);
      const int c = (lane & 7) ^ ((r >> 1) & 7);
      __builtin_amdgcn_global_load_lds((const unsigned*)(base + (size_t)r * ld + kt * 64 + c * 8), (unsigned*)(lds + ch * 512), 16, 0, 0);
    }
  }
  DI void commit(u16*, int) {}
};
#ifndef GEMM_REG2
#define GEMM_REG2 1
#endif
#if GEMM_REG2
typedef unsigned u32x4 __attribute__((ext_vector_type(4)));
template <int ROWS>
struct LdReg {
  static constexpr int N = ROWS / 32;
  const u16* base; int ld;
  u32x4 r0, r1, r2, r3;
  DI const u32x4* src(int kt, int tid, int i) const { const int c = tid + 256 * i; return (const u32x4*)(base + (size_t)(c >> 3) * ld + kt * 64 + (c & 7) * 8); }
  DI static u32x4* dst(u16* lds, int tid, int i) { const int c = tid + 256 * i; const int row = c >> 3; return (u32x4*)(lds + row * 64 + (((c & 7) ^ ((row >> 1) & 7)) * 8)); }
  DI void fetch(int kt, int tid) {
    r0 = *src(kt, tid, 0); r1 = *src(kt, tid, 1);
    if (N > 2) { r2 = *src(kt, tid, 2); r3 = *src(kt, tid, 3); }
  }
  DI void stash(u16* lds, int tid) const {
    *dst(lds, tid, 0) = r0; *dst(lds, tid, 1) = r1;
    if (N > 2) { *dst(lds, tid, 2) = r2; *dst(lds, tid, 3) = r3; }
  }
};
template <int MI, bool GRMS>
DI void gemm_compute(const u16* pa, const u16* pb, f32x16 (&acc)[MI][MI], int o0, int o1, int o2, int o3, int wr, int hh, bool scale_now, const float* rsc) {
  if (GRMS && scale_now) {
#pragma unroll
    for (int i = 0; i < MI; ++i)
#pragma unroll
      for (int e = 0; e < 16; ++e) {
        const float rt = rsc[((wr * MI + i) * 32 + ACC_ROW(e, hh)) * 2];
#pragma unroll
        for (int j = 0; j < MI; ++j) acc[i][j][e] *= rt;
      }
  }
  const int off[4] = {o0, o1, o2, o3};
  bf16x8 af[2][MI], bfr[2][MI];
#pragma unroll
  for (int i = 0; i < MI; ++i) { af[0][i] = *(const bf16x8*)(pa + i * 32 * 64 + off[0]); bfr[0][i] = *(const bf16x8*)(pb + i * 32 * 64 + off[0]); }
#pragma unroll
  for (int kk = 0; kk < 4; ++kk) {
    if (kk < 3) {
#pragma unroll
      for (int i = 0; i < MI; ++i) { af[(kk + 1) & 1][i] = *(const bf16x8*)(pa + i * 32 * 64 + off[kk + 1]); bfr[(kk + 1) & 1][i] = *(const bf16x8*)(pb + i * 32 * 64 + off[kk + 1]); }
    }
#pragma unroll
    for (int i = 0; i < MI; ++i)
#pragma unroll
      for (int j = 0; j < MI; ++j) acc[i][j] = MFMA(af[kk & 1][i], bfr[kk & 1][j], acc[i][j]);
  }
}
template <int MI, bool GRMS = false, class AL, class EPI>
DI void gemm_tile(AL& al, const u16* Bt, int ldb, int K, int m0, int n0, EPI epi, char* smem, const float* rsc = nullptr) {
  SmemGemm& sm = *(SmemGemm*)smem;
  const int tid = threadIdx.x, lane = tid & 63, wid = tid >> 6, wr = wid >> 1, wc = wid & 1, r31 = lane & 31, hh = lane >> 5;
  LdReg<MI * 64> a0, a1, b0, b1;
  a0.base = al.base; a0.ld = al.ld; a1.base = al.base; a1.ld = al.ld;
  b0.base = Bt + (size_t)n0 * ldb; b0.ld = ldb; b1.base = b0.base; b1.ld = ldb;
  f32x16 acc[MI][MI];
#pragma unroll
  for (int i = 0; i < MI; ++i)
#pragma unroll
    for (int j = 0; j < MI; ++j)
#pragma unroll
      for (int e = 0; e < 16; ++e) acc[i][j][e] = 0.f;
  int off[4];
#pragma unroll
  for (int kk = 0; kk < 4; ++kk) off[kk] = r31 * 64 + (((kk * 2 + hh) ^ ((r31 >> 1) & 7)) * 8);
  const int KT = K >> 6;
  a0.fetch(0, tid); b0.fetch(0, tid);
  a1.fetch(1, tid); b1.fetch(1, tid);
  a0.stash(sm.a[0], tid); b0.stash(sm.b[0], tid);
  __syncthreads();
  for (int kt = 0; kt < KT; kt += 2) {
    { const int kn = min(kt + 2, KT - 1); a0.fetch(kn, tid); b0.fetch(kn, tid); }
    gemm_compute<MI, GRMS>(sm.a[0] + (wr * MI * 32) * 64, sm.b[0] + (wc * MI * 32) * 64, acc, off[0], off[1], off[2], off[3], wr, hh, kt == (KT >> 1), rsc);
    a1.stash(sm.a[1], tid); b1.stash(sm.b[1], tid);
    __syncthreads();
    { const int kn = min(kt + 3, KT - 1); a1.fetch(kn, tid); b1.fetch(kn, tid); }
    gemm_compute<MI, GRMS>(sm.a[1] + (wr * MI * 32) * 64, sm.b[1] + (wc * MI * 32) * 64, acc, off[0], off[1], off[2], off[3], wr, hh, (kt + 1) == (KT >> 1), rsc);
    a0.stash(sm.a[0], tid); b0.stash(sm.b[0], tid);
    __syncthreads();
  }
  if (GRMS) {
#pragma unroll
    for (int i = 0; i < MI; ++i)
#pragma unroll
      for (int e = 0; e < 16; ++e) {
        const float s1 = rsc[((wr * MI + i) * 32 + ACC_ROW(e, hh)) * 2 + 1];
#pragma unroll
        for (int j = 0; j < MI; ++j) acc[i][j][e] *= s1;
      }
  }
#pragma unroll
  for (int i = 0; i < MI; ++i)
#pragma unroll
    for (int j = 0; j < MI; ++j) epi(m0 + (wr * MI + i) * 32, n0 + (wc * MI + j) * 32, acc[i][j]);
}
#else
template <int MI, bool GRMS = false, class AL, class EPI>
DI void gemm_tile(AL& al, const u16* Bt, int ldb, int K, int m0, int n0, EPI epi, char* smem, const float* rsc = nullptr) {
  SmemGemm& sm = *(SmemGemm*)smem;
  const int tid = threadIdx.x, lane = tid & 63, wid = tid >> 6, wr = wid >> 1, wc = wid & 1, r31 = lane & 31, hh = lane >> 5;
  GldsBf16<MI * 64> bl; bl.base = Bt + (size_t)n0 * ldb; bl.ld = ldb;
  f32x16 acc[MI][MI];
#pragma unroll
  for (int i = 0; i < MI; ++i)
#pragma unroll
    for (int j = 0; j < MI; ++j)
#pragma unroll
      for (int e = 0; e < 16; ++e) acc[i][j][e] = 0.f;
  int off[4];
#pragma unroll
  for (int kk = 0; kk < 4; ++kk) off[kk] = r31 * 64 + (((kk * 2 + hh) ^ ((r31 >> 1) & 7)) * 8);
  const int KT = K >> 6;
  al.issue(0, sm.a[0], tid); bl.issue(0, sm.b[0], tid);
  al.commit(sm.a[0], tid);
  asm volatile("s_waitcnt vmcnt(0)" ::: "memory");
  __syncthreads();
  for (int kt = 0; kt < KT; ++kt) {
    const int cur = kt & 1;
    if (kt + 1 < KT) { al.issue(kt + 1, sm.a[cur ^ 1], tid); bl.issue(kt + 1, sm.b[cur ^ 1], tid); }
    const u16* pa = sm.a[cur] + (wr * MI * 32) * 64;
    const u16* pb = sm.b[cur] + (wc * MI * 32) * 64;
    if (GRMS && kt == (KT >> 1)) {
#pragma unroll
      for (int i = 0; i < MI; ++i)
#pragma unroll
        for (int e = 0; e < 16; ++e) {
          const float rt = rsc[((wr * MI + i) * 32 + ACC_ROW(e, hh)) * 2];
#pragma unroll
          for (int j = 0; j < MI; ++j) acc[i][j][e] *= rt;
        }
    }
#pragma unroll
    for (int kk = 0; kk < 4; ++kk) {
      bf16x8 af[MI], bfr[MI];
#pragma unroll
      for (int i = 0; i < MI; ++i) { af[i] = *(const bf16x8*)(pa + i * 32 * 64 + off[kk]); bfr[i] = *(const bf16x8*)(pb + i * 32 * 64 + off[kk]); }
#pragma unroll
      for (int i = 0; i < MI; ++i)
#pragma unroll
        for (int j = 0; j < MI; ++j) acc[i][j] = MFMA(af[i], bfr[j], acc[i][j]);
    }
    if (kt + 1 < KT) al.commit(sm.a[cur ^ 1], tid);
    asm volatile("s_waitcnt vmcnt(0)" ::: "memory");
    __syncthreads();
  }
  if (GRMS) {
#pragma unroll
    for (int i = 0; i < MI; ++i)
#pragma unroll
      for (int e = 0; e < 16; ++e) {
        const float s1 = rsc[((wr * MI + i) * 32 + ACC_ROW(e, hh)) * 2 + 1];
#pragma unroll
        for (int j = 0; j < MI; ++j) acc[i][j][e] *= s1;
      }
  }
#pragma unroll
  for (int i = 0; i < MI; ++i)
#pragma unroll
    for (int j = 0; j < MI; ++j) epi(m0 + (wr * MI + i) * 32, n0 + (wc * MI + j) * 32, acc[i][j]);
}
#endif
template <class F>
DI void for_tiles(int N, F body) {
  const int vb = vblock(), nb = gridDim.x;
  const int ntn = N >> 7, ntn2 = N >> 6;
  const int nbig = 256 * ntn, nsmall = 16 * ntn2;
  for (int t = vb; t < nbig + nsmall; t += nb) {
    if (t < nbig) { body((t / ntn) * 128, (t % ntn) * 128, IC<2>{}); }
    else { const int u = t - nbig; body(NTP + (u / ntn2) * 64, (u % ntn2) * 64, IC<1>{}); }
  }
}

DI void phase_proj(const Params& p, char* smem) {
  const int vb = vblock(), nb = gridDim.x;
  constexpr int T_G1 = 264 * 25, T_MKV = 32 * 16;
  float* out = p.out;
  for (int t = vb; t < T_G1 + T_MKV; t += nb) {
    if (t < T_G1) {
      const int mt = t / 25, nt = t % 25;
      const int m0 = mt * 128, n0 = nt * 128;
      GldsBf16<128> al; al.base = (const u16*)(p.ws + WS_C) + (size_t)m0 * DM; al.ld = DM;
      const bool smp = m0 >= NTP;
      const float* b_f = p.b_f;
      u16* qsb = (u16*)(p.ws + WS_D);
      u16* qfx = qsb + (size_t)NT * 512;
      char* ws = p.ws;
      auto epi = [=](int r0, int c0, const f32x16& acc) {
        const int lane = threadIdx.x & 63, hh = lane >> 5, col = c0 + (lane & 31);
        const int seg = c0 >> 9, cc = col & 511;
        if (seg == 0 || seg == 3) {
          u16* q = (seg == 0) ? qsb : qfx;
#pragma unroll
          for (int e = 0; e < 16; ++e) q[(unsigned)(r0 + 4 * hh) * 512u + cc + ACC_R0(e) * 512u] = bf1(acc[e] * 0.125f);
        } else if (seg < 6) {
          size_t ob;
          if (!smp) ob = (seg == 1) ? OUT_SBK_P : (seg == 2) ? OUT_SBV_P : (seg == 4) ? OUT_FXK_P : OUT_FXV_P;
          else ob = (seg == 1) ? OUT_SBK_S : (seg == 2) ? OUT_SBV_S : (seg == 4) ? OUT_FXK_S : OUT_FXV_S;
          const int rb = smp ? r0 - NTP : r0;
          float* ov = out + ob;
          const unsigned b0 = (unsigned)(rb + 4 * hh) * 512u + cc;
#pragma unroll
          for (int e = 0; e < 16; ++e) ov[b0 + ACC_R0(e) * 512u] = acc[e];
          if (!smp) {
            if (seg == 1 || seg == 4) {
              u16* k16 = (u16*)(ws + WS_A) + (seg == 4 ? (size_t)NTP * 512 : 0);
#pragma unroll
              for (int e = 0; e < 16; ++e) k16[b0 + ACC_R0(e) * 512u] = bf1(acc[e]);
            } else {
              u16* vt16 = (u16*)(ws + WS_B) + (seg == 5 ? (size_t)NTP * 512 : 0);
              const unsigned vb0 = (unsigned)(((r0 >> 11) * 8 + (cc >> 6)) * 64 + (cc & 63)) * 2048u + (unsigned)(r0 & 2047) + 4 * hh;
#pragma unroll
              for (int g4 = 0; g4 < 4; ++g4) *(uint2*)(vt16 + vb0 + 8 * g4) = make_uint2(pk2(acc[4 * g4], acc[4 * g4 + 1]), pk2(acc[4 * g4 + 2], acc[4 * g4 + 3]));
            }
          }
        } else {
          const int c = col - 3072;
          if (c < 8) {
            const float bf = b_f[c];
            const size_t ob = smp ? OUT_LF_S : OUT_LF_P;
            const int rb = smp ? r0 - NTP : r0;
#pragma unroll
            for (int e = 0; e < 16; ++e) {
              const float z = acc[e] + bf;
              const float ls = fminf(z, 0.f) - log1pf(__expf(-fabsf(z)));
              out[ob + (unsigned)(rb + ACC_ROW(e, hh)) * 8u + c] = ls;
            }
          }
        }
      };
      gemm_tile<2>(al, (const u16*)(p.ws + WS_WIN), DM, DM, m0, n0, epi, smem);
    } else {
      const int u = t - T_G1;
      const int mt = u >> 4, nt = u & 15;
      const int m0 = mt * 128, n0 = nt * 128;
      GldsBf16<128> al; al.base = (const u16*)(p.ws + WS_E) + (size_t)m0 * DM; al.ld = DM;
      u16* kb = (u16*)(p.ws + WS_MEMK);
      u16* vt = (u16*)(p.ws + WS_MEMVT);
      auto epi = [=](int r0, int c0, const f32x16& acc) {
        const int lane = threadIdx.x & 63, hh = lane >> 5, col = c0 + (lane & 31);
        if (c0 < 1024) {
          float* ov = out + OUT_MK_P;
          const unsigned b0 = (unsigned)(r0 + 4 * hh) * 1024u + col;
#pragma unroll
          for (int e = 0; e < 16; ++e) { const unsigned idx = b0 + ACC_R0(e) * 1024u; ov[idx] = acc[e]; kb[idx] = bf1(acc[e]); }
        } else {
          const int c = col - 1024;
          float* ov = out + OUT_MV_P;
          const unsigned b0 = (unsigned)(r0 + 4 * hh) * 1024u + c;
#pragma unroll
          for (int e = 0; e < 16; ++e) ov[b0 + ACC_R0(e) * 1024u] = acc[e];
          const int b = r0 >> 8;
#pragma unroll
          for (int g4 = 0; g4 < 4; ++g4) {
            const int m = (r0 & 255) + 8 * g4 + 4 * hh;
            *(uint2*)(vt + ((size_t)b * DM + c) * 256 + m) = make_uint2(pk2(acc[4 * g4], acc[4 * g4 + 1]), pk2(acc[4 * g4 + 2], acc[4 * g4 + 3]));
          }
        }
      };
      gemm_tile<2>(al, (const u16*)(p.ws + WS_WMKV), DM, DM, m0, n0, epi, smem);
    }
  }
}

template <int PER>
DI void scan_one(const float* src0, int n0, const float* src1, int n, float* dst, float* part) {
  const int tid = threadIdx.x;
  const int s0 = tid * PER;
  float v[PER];
#pragma unroll
  for (int i = 0; i < PER; ++i) { const int s = s0 + i; v[i] = (s < n) ? ((s < n0) ? src0[(size_t)s * 8] : src1[(size_t)(s - n0) * 8]) : 0.f; }
  float loc = 0.f;
#pragma unroll
  for (int i = 0; i < PER; ++i) loc += v[i];
  part[tid] = loc;
  __syncthreads();
  float run = 0.f;
  for (int i = 0; i < tid; ++i) run += part[i];
#pragma unroll
  for (int i = 0; i < PER; ++i) { run += v[i]; if (s0 + i < n) dst[s0 + i] = -run * LOG2E; }
  __syncthreads();
}
DI void phase_scan(const Params& p, char* smem) {
  float* part = (float*)smem;
  for (int it = blockIdx.x; it < 256; it += gridDim.x) {
    const int bh = it & 127, b = bh >> 3, h = bh & 7;
    if (it < 128) scan_one<17>(p.c_fx_logf + (size_t)b * PAST * 8 + h, PAST, p.out + OUT_LF_S + (size_t)b * DSEQ * 8 + h, PAST + DSEQ, (float*)(p.ws + WS_CBS) + (size_t)bh * 4160, part);
    else scan_one<8>(p.out + OUT_LF_P + (size_t)b * SEQ * 8 + h, SEQ, nullptr, SEQ, (float*)(p.ws + WS_CBP) + (size_t)bh * 2048, part);
  }
}

constexpr int KLD = 72, VLD = 68;
struct SmemAttn { u16 k[2][64 * KLD]; u16 vt[2][64 * VLD]; float cb[4160]; float part[256]; u16 q[128 * KLD]; };
static_assert(sizeof(SmemAttn) <= SMEM_BYTES, "attn smem");

struct KVRegs { float4 k[4], v[4]; };
DI void kv_fetch(KVRegs& r, const float* kb, const float* vb, int tid) {
#pragma unroll
  for (int i = 0; i < 4; ++i) { const int c = tid + 256 * i; const size_t o = (size_t)(c >> 4) * 512 + (c & 15) * 4; r.k[i] = *(const float4*)(kb + o); r.v[i] = *(const float4*)(vb + o); }
}
DI void kv_stash(const KVRegs& r, u16* ks, u16* vts, int tid) {
#pragma unroll
  for (int i = 0; i < 4; ++i) {
    const int c = tid + 256 * i; const int row = c >> 4, c4 = (c & 15) * 4;
    *(uint2*)(ks + row * KLD + c4) = make_uint2(pk2(r.k[i].x, r.k[i].y), pk2(r.k[i].z, r.k[i].w));
    vts[(c4 + 0) * VLD + row] = bf1(r.v[i].x); vts[(c4 + 1) * VLD + row] = bf1(r.v[i].y);
    vts[(c4 + 2) * VLD + row] = bf1(r.v[i].z); vts[(c4 + 3) * VLD + row] = bf1(r.v[i].w);
  }
}
typedef unsigned kv_u32x4 __attribute__((ext_vector_type(4)));
typedef unsigned kv_u32x2 __attribute__((ext_vector_type(2)));
struct KV16 { kv_u32x4 k0, k1, v0, v1; };
DI void kv_fetch16(KV16& r, const u16* kb, const u16* vtb, int tid) {
  const int c0 = tid, c1 = tid + 256;
  r.k0 = *(const kv_u32x4*)(kb + (size_t)(c0 >> 3) * 512 + (c0 & 7) * 8); r.k1 = *(const kv_u32x4*)(kb + (size_t)(c1 >> 3) * 512 + (c1 & 7) * 8);
  r.v0 = *(const kv_u32x4*)(vtb + (size_t)(c0 >> 3) * SEQ + (c0 & 7) * 8); r.v1 = *(const kv_u32x4*)(vtb + (size_t)(c1 >> 3) * SEQ + (c1 & 7) * 8);
}
DI void kv_stash16(const KV16& r, u16* ks, u16* vts, int tid) {
  const int c0 = tid, c1 = tid + 256;
  *(kv_u32x4*)(ks + (c0 >> 3) * KLD + (c0 & 7) * 8) = r.k0;
  *(kv_u32x4*)(ks + (c1 >> 3) * KLD + (c1 & 7) * 8) = r.k1;
  kv_u32x2 a = {r.v0[0], r.v0[1]}, b2 = {r.v0[2], r.v0[3]}, c = {r.v1[0], r.v1[1]}, d = {r.v1[2], r.v1[3]};
  *(kv_u32x2*)(vts + (c0 >> 3) * VLD + (c0 & 7) * 8) = a; *(kv_u32x2*)(vts + (c0 >> 3) * VLD + (c0 & 7) * 8 + 4) = b2;
  *(kv_u32x2*)(vts + (c1 >> 3) * VLD + (c1 & 7) * 8) = c; *(kv_u32x2*)(vts + (c1 >> 3) * VLD + (c1 & 7) * 8 + 4) = d;
}
DI bf16x8 pack8(const f32x16& x, int s) {
  union { unsigned u[4]; bf16x8 v; } t;
  t.u[0] = pk2(x[8 * s + 0], x[8 * s + 1]); t.u[1] = pk2(x[8 * s + 2], x[8 * s + 3]);
  t.u[2] = pk2(x[8 * s + 4], x[8 * s + 5]); t.u[3] = pk2(x[8 * s + 6], x[8 * s + 7]);
  return t.v;
}

template <bool FOX, bool SMP>
DI void attn_item(const Params& p, int b, int h, int qb, char* smem, bool do_ssq = true, int split = 0) {
  constexpr int smp = SMP ? 1 : 0;
  constexpr bool SPLIT = FOX && SMP;
  SmemAttn& sm = *(SmemAttn*)smem;
  const int tid = threadIdx.x, lane = tid & 63, wid = tid >> 6, r31 = lane & 31, hh = lane >> 5;
  const int jt0 = SPLIT ? split * 8 : 0;
  const int nkt = SPLIT ? (split == 7 ? 9 : 8) : (smp ? 65 : 2 * qb + 2);
  const int jdiag = smp ? 64 : 2 * qb;
  int qi = wid * 32 + r31; if (smp) qi &= 63;
  const int qpos = (smp ? PAST : qb * 128) + qi;
  const int g = smp ? NTP + b * DSEQ + qi : b * SEQ + qb * 128 + qi;
  const u16* Q = (const u16*)(p.ws + WS_D) + (FOX ? (size_t)NT * 512 : 0);
  {
#pragma unroll
    for (int i = 0; i < 4; ++i) {
      const int c = tid + 256 * i; const int row = c >> 3, kc = (c & 7) * 8;
      const int qr = smp ? (row & 63) : row;
      const int gr = smp ? NTP + b * DSEQ + qr : b * SEQ + qb * 128 + qr;
      *(kv_u32x4*)(sm.q + row * KLD + kc) = *(const kv_u32x4*)(Q + (size_t)gr * 512 + h * 64 + kc);
    }
    __syncthreads();
  }

  const float* kcache = FOX ? p.c_fx_k : p.c_sb_k;
  const float* vcache = FOX ? p.c_fx_v : p.c_sb_v;
  const size_t okp = FOX ? OUT_FXK_P : OUT_SBK_P, ovp = FOX ? OUT_FXV_P : OUT_SBV_P;
  const size_t oks = FOX ? OUT_FXK_S : OUT_SBK_S, ovs = FOX ? OUT_FXV_S : OUT_SBV_S;
  auto kptr = [&](int j) -> const float* {
    if (!smp) return p.out + okp + ((size_t)(b * SEQ + 64 * j) * 512 + h * 64);
    if (j < 64) return kcache + ((size_t)(b * PAST + 64 * j) * 512 + h * 64);
    return p.out + oks + ((size_t)(b * DSEQ) * 512 + h * 64);
  };
  auto vptr = [&](int j) -> const float* {
    if (!smp) return p.out + ovp + ((size_t)(b * SEQ + 64 * j) * 512 + h * 64);
    if (j < 64) return vcache + ((size_t)(b * PAST + 64 * j) * 512 + h * 64);
    return p.out + ovs + ((size_t)(b * DSEQ) * 512 + h * 64);
  };

  if (FOX) {
    const float4* src = (const float4*)(smp ? (const float*)(p.ws + WS_CBS) + (size_t)(b * 8 + h) * 4160 : (const float*)(p.ws + WS_CBP) + (size_t)(b * 8 + h) * 2048);
    for (int i = jt0 * 16 + tid; i < (jt0 + nkt) * 16; i += 256) ((float4*)sm.cb)[i] = src[i];
    __syncthreads();
  }

  bf16x8 tri[2];
  if (!FOX) {
#pragma unroll
    for (int s = 0; s < 2; ++s)
#pragma unroll
      for (int j = 0; j < 8; ++j) { const int kin = 16 * s + 8 * (j >> 2) + 4 * hh + (j & 3); tri[s][j] = (kin >= r31) ? (short)0x3F80 : (short)0; }
  }

  f32x16 o[2];
#pragma unroll
  for (int d = 0; d < 2; ++d)
#pragma unroll
    for (int e = 0; e < 16; ++e) o[d][e] = 0.f;
  float mrun = -1e30f, lrun = 0.f, R = 0.f;

  KVRegs kv;
  KV16 kw;
  const int jfirst = FOX ? jt0 : nkt - 1;
  const u16* k16 = (const u16*)(p.ws + WS_A) + (FOX ? (size_t)NTP * 512 : 0) + (size_t)(b * SEQ) * 512 + h * 64;
  const u16* vt16 = (const u16*)(p.ws + WS_B) + (FOX ? (size_t)NTP * 512 : 0) + (size_t)((b * 8 + h) * 64) * SEQ;
  if (smp) { kv_fetch(kv, kptr(jfirst), vptr(jfirst), tid); kv_stash(kv, sm.k[0], sm.vt[0], tid); }
  else { kv_fetch16(kw, k16 + (size_t)(64 * jfirst) * 512, vt16 + 64 * jfirst, tid); kv_stash16(kw, sm.k[0], sm.vt[0], tid); }
  __syncthreads();
  for (int it = 0; it < nkt; ++it) {
    const int j = FOX ? jt0 + it : nkt - 1 - it;
    const int cur = it & 1;
    if (it + 1 < nkt) { const int jn = FOX ? j + 1 : j - 1; if (smp) kv_fetch(kv, kptr(jn), vptr(jn), tid); else kv_fetch16(kw, k16 + (size_t)(64 * jn) * 512, vt16 + 64 * jn, tid); }
    f32x16 s[2];
#pragma unroll
    for (int t2 = 0; t2 < 2; ++t2) {
#pragma unroll
      for (int e = 0; e < 16; ++e) s[t2][e] = 0.f;
      const u16* pk = sm.k[cur] + (t2 * 32 + r31) * KLD + hh * 8;
      const u16* pq = sm.q + (wid * 32 + r31) * KLD + hh * 8;
#pragma unroll
      for (int kk = 0; kk < 4; ++kk) { const bf16x8 a = *(const bf16x8*)(pk + kk * 16); const bf16x8 qv = *(const bf16x8*)(pq + kk * 16); s[t2] = MFMA(a, qv, s[t2]); }
    }
    const bool diag = j >= jdiag;
    const int kbase = 64 * j + 4 * hh;
    if (FOX) {
      float mloc = -1e30f;
#pragma unroll
      for (int t2 = 0; t2 < 2; ++t2) {
        f32x16 bvec;
#pragma unroll
        for (int g4 = 0; g4 < 4; ++g4) {
          const float4 bb = *(const float4*)(sm.cb + 64 * j + 32 * t2 + 8 * g4 + 4 * hh);
          bvec[4 * g4] = bb.x; bvec[4 * g4 + 1] = bb.y; bvec[4 * g4 + 2] = bb.z; bvec[4 * g4 + 3] = bb.w;
        }
        s[t2] = s[t2] * LOG2E + bvec;
      }
      if (diag) {
#pragma unroll
        for (int t2 = 0; t2 < 2; ++t2)
#pragma unroll
          for (int e = 0; e < 16; ++e) if (kbase + 32 * t2 + ACC_ROW(e, 0) > qpos) s[t2][e] = -1e30f;
      }
#pragma unroll
      for (int t2 = 0; t2 < 2; ++t2)
#pragma unroll
        for (int e = 0; e < 16; ++e) mloc = fmaxf(mloc, s[t2][e]);
      mloc = fmaxf(mloc, __shfl_xor(mloc, 32));
      const float mnew = fmaxf(mrun, mloc);
      const float alpha = __builtin_amdgcn_exp2f(mrun - mnew);
      mrun = mnew;
      float ls = 0.f;
#pragma unroll
      for (int t2 = 0; t2 < 2; ++t2) {
        s[t2] = s[t2] - mnew;
#pragma unroll
        for (int e = 0; e < 16; ++e) { const float pv = __builtin_amdgcn_exp2f(s[t2][e]); s[t2][e] = pv; ls += pv; }
      }
      lrun = lrun * alpha + ls;
#pragma unroll
      for (int d = 0; d < 2; ++d) o[d] = o[d] * alpha;
    } else {
#pragma unroll
      for (int t2 = 1; t2 >= 0; --t2) {
        f32x16 lk;
#pragma unroll
        for (int e = 0; e < 16; ++e) {
          const float z = s[t2][e];
          const float sp = fmaxf(z, 0.f) + __logf(1.f + __expf(-fabsf(z)));
          const bool vis = !diag || (kbase + 32 * t2 + ACC_ROW(e, 0) < qpos);
          lk[e] = vis ? -sp : 0.f;
        }
        bf16x8 fh[2], fl[2];
#pragma unroll
        for (int sI = 0; sI < 2; ++sI) fh[sI] = pack8(lk, sI);
#pragma unroll
        for (int e = 0; e < 16; ++e) lk[e] -= __uint_as_float(((unsigned)(u16)fh[e >> 3][e & 7]) << 16);
#pragma unroll
        for (int sI = 0; sI < 2; ++sI) fl[sI] = pack8(lk, sI);
        f32x16 inc;
#pragma unroll
        for (int e = 0; e < 16; ++e) inc[e] = R;
#pragma unroll
        for (int sI = 0; sI < 2; ++sI) { inc = MFMA(tri[sI], fh[sI], inc); inc = MFMA(tri[sI], fl[sI], inc); }
#pragma unroll
        for (int e = 0; e < 16; ++e) {
          const bool vis = !diag || (kbase + 32 * t2 + ACC_ROW(e, 0) < qpos);
          const float w = __builtin_amdgcn_exp2f((s[t2][e] + inc[e]) * LOG2E);
          s[t2][e] = vis ? w : 0.f;
        }
        R = __shfl(inc[0], r31);
      }
    }
#pragma unroll
    for (int t2 = 0; t2 < 2; ++t2)
#pragma unroll
      for (int sI = 0; sI < 2; ++sI) {
        const bf16x8 pf = pack8(s[t2], sI);
#pragma unroll
        for (int d = 0; d < 2; ++d) {
          const u16* pv = sm.vt[cur] + (d * 32 + r31) * VLD + 32 * t2 + 16 * sI + 4 * hh;
          union { s16x4 q[2]; bf16x8 v; } a;
          a.q[0] = *(const s16x4*)(pv); a.q[1] = *(const s16x4*)(pv + 8);
          o[d] = MFMA(a.v, pf, o[d]);
        }
      }
    if (it + 1 < nkt) { if (smp) kv_stash(kv, sm.k[cur ^ 1], sm.vt[cur ^ 1], tid); else kv_stash16(kw, sm.k[cur ^ 1], sm.vt[cur ^ 1], tid); }
#if SB_EXIT
    if (!FOX) { if (__syncthreads_and(R < -110.f)) break; } else __syncthreads();
#else
    __syncthreads();
#endif
  }
  if (SPLIT) {
    constexpr int NS = 8;
    const int bh = b * 8 + h;
    float* po = (float*)(p.ws + WS_F) + (size_t)(bh * NS) * 4096;
    float* pml = (float*)(p.ws + WS_F) + (size_t)128 * NS * 4096 + (size_t)(bh * NS) * 128;
    const float lt = lrun + __shfl_xor(lrun, 32);
    if (wid < 2) {
      float* dst = po + (size_t)split * 4096 + qi * 64;
#pragma unroll
      for (int d = 0; d < 2; ++d)
#pragma unroll
        for (int g4 = 0; g4 < 4; ++g4) *(float4*)(dst + d * 32 + 8 * g4 + 4 * hh) = make_float4(o[d][4 * g4], o[d][4 * g4 + 1], o[d][4 * g4 + 2], o[d][4 * g4 + 3]);
      if (hh == 0) *(float2*)(pml + (size_t)split * 128 + qi * 2) = make_float2(mrun, lt);
    }
    int* slot2 = (int*)(smem + 73728 + 528);
    asm volatile("s_waitcnt vmcnt(0)" ::: "memory");
    __syncthreads();
    if (tid == 0) {
      __builtin_amdgcn_fence(__ATOMIC_RELEASE, "agent");
      asm volatile("s_waitcnt vmcnt(0)" ::: "memory");
      const unsigned old = __hip_atomic_fetch_add((unsigned*)(p.ws + WS_BAR + 256) + bh + (do_ssq ? 0 : 128), 1u, __ATOMIC_RELAXED, __HIP_MEMORY_SCOPE_AGENT);
      __builtin_amdgcn_fence(__ATOMIC_ACQUIRE, "agent");
      asm volatile("s_waitcnt vmcnt(0)" ::: "memory");
      *slot2 = (int)old;
    }
    __syncthreads();
    const bool last = (*slot2 == NS - 1);
    __syncthreads();
    if (last) {
      const int q = tid >> 2, d0 = (tid & 3) * 16;
      float ms[NS], ls[NS], M = -1e30f;
#pragma unroll
      for (int s2 = 0; s2 < NS; ++s2) { const float2 ml = *(const float2*)(pml + (size_t)s2 * 128 + q * 2); ms[s2] = ml.x; ls[s2] = ml.y; M = fmaxf(M, ml.x); }
      float L = 0.f, acc[16];
#pragma unroll
      for (int k = 0; k < 16; ++k) acc[k] = 0.f;
#pragma unroll
      for (int s2 = 0; s2 < NS; ++s2) {
        const float w = exp2f(ms[s2] - M);
        L += ls[s2] * w;
        const float4* src = (const float4*)(po + (size_t)s2 * 4096 + q * 64 + d0);
#pragma unroll
        for (int k4 = 0; k4 < 4; ++k4) { const float4 v = src[k4]; acc[4 * k4] += w * v.x; acc[4 * k4 + 1] += w * v.y; acc[4 * k4 + 2] += w * v.z; acc[4 * k4 + 3] += w * v.w; }
      }
      const float invL = 1.f / L;
      float ssq = 0.f;
#pragma unroll
      for (int k = 0; k < 16; ++k) { acc[k] *= invL; ssq += acc[k] * acc[k]; }
      ssq += __shfl_xor(ssq, 1); ssq += __shfl_xor(ssq, 2);
      const int gq = NTP + b * DSEQ + q;
      if (do_ssq && (tid & 3) == 0) atomicAdd((float*)(p.ws + WS_SSQ) + (size_t)gq * 2 + 1, ssq);
      u16* od = (u16*)(p.ws + WS_E) + (size_t)gq * DM + 512 + h * 64 + d0;
      *(uint4*)od = make_uint4(pk2(acc[0], acc[1]), pk2(acc[2], acc[3]), pk2(acc[4], acc[5]), pk2(acc[6], acc[7]));
      *(uint4*)(od + 8) = make_uint4(pk2(acc[8], acc[9]), pk2(acc[10], acc[11]), pk2(acc[12], acc[13]), pk2(acc[14], acc[15]));
    }
    return;
  }
  float inv = 1.f;
  if (FOX) { const float lt = lrun + __shfl_xor(lrun, 32); inv = 1.f / lt; }
  {
    float ssq = 0.f;
#pragma unroll
    for (int d = 0; d < 2; ++d)
#pragma unroll
      for (int e = 0; e < 16; ++e) { const float t = o[d][e] * inv; ssq += t * t; }
    ssq += __shfl_xor(ssq, 32);
    if (do_ssq && hh == 0 && (!smp || wid < 2)) atomicAdd((float*)(p.ws + WS_SSQ) + (size_t)g * 2 + (FOX ? 1 : 0), ssq);
  }
  if (!smp || wid < 2) {
    u16* od = (u16*)(p.ws + WS_E) + (size_t)g * DM + (FOX ? 512 : 0) + h * 64;
#pragma unroll
    for (int d = 0; d < 2; ++d)
#pragma unroll
      for (int g4 = 0; g4 < 4; ++g4)
        *(uint2*)(od + d * 32 + 8 * g4 + 4 * hh) = make_uint2(pk2(o[d][4 * g4] * inv, o[d][4 * g4 + 1] * inv), pk2(o[d][4 * g4 + 2] * inv, o[d][4 * g4 + 3] * inv));
  }
}

template <class F>
DI void attn_queue(unsigned* ctr, int n, int* slot, F body) {
  for (;;) {
    if (threadIdx.x == 0) *slot = (int)atomicAdd(ctr, 1u);
    __syncthreads();
    const int it = *slot;
    __syncthreads();
    if (it >= n) break;
    body(it);
  }
}
DI void phase_attn(const Params& p, char* smem, int rep = 0) {
  unsigned* ctr = (unsigned*)(p.ws + WS_BAR + 128) + rep * 4;
  int* slot = (int*)(smem + 73728 + 512);
  const bool dq = rep == 0;
  attn_queue(ctr + 0, 1024, slot, [&](int it) { const int bh = it >> 3; attn_item<true, true>(p, bh >> 3, bh & 7, 0, smem, dq, it & 7); });
  attn_queue(ctr + 1, 2048, slot, [&](int u) { const int w = u & 511; const int qb = 15 - (w >> 5), bh = (u >> 9) * 32 + (w & 31); attn_item<true, false>(p, bh >> 3, bh & 7, qb, smem, dq); });
  attn_queue(ctr + 2, 128, slot, [&](int u) { attn_item<false, true>(p, u >> 3, u & 7, 0, smem, dq); });
  attn_queue(ctr + 3, 2048, slot, [&](int u) { const int w = u & 511; const int qb = 15 - (w >> 5), bh = (u >> 9) * 32 + (w & 31); attn_item<false, false>(p, bh >> 3, bh & 7, qb, smem, dq); });
}

DI void phase_wout(const Params& p, char* smem) {
  float* pre = (float*)(p.ws + WS_A);
  const u16* o = (const u16*)(p.ws + WS_E);
  float* sc_s = (float*)(smem + 73728);
  for_tiles(DM, [&](int m0, int n0, auto tag) {
    constexpr int MI = decltype(tag)::value;
    {
      const int tid = threadIdx.x;
      if (tid < MI * 64) {
        const float2 q = ((const float2*)(p.ws + WS_SSQ))[m0 + tid];
        const float s0 = rsqrtf(q.x * (1.f / 512.f) + 1e-6f), s1 = rsqrtf(q.y * (1.f / 512.f) + 1e-6f);
        sc_s[tid * 2] = s0 / s1; sc_s[tid * 2 + 1] = s1;
      }
      __syncthreads();
    }
    GldsBf16<MI * 64> al; al.base = o + (size_t)m0 * DM; al.ld = DM;
    const float* xr = xrow(p, m0);
    auto epi = [=](int r0, int c0, const f32x16& acc) {
      const int lane = threadIdx.x & 63, hh = lane >> 5, col = c0 + (lane & 31);
      const unsigned b0 = (unsigned)(r0 + 4 * hh) * 1024u + col, b1 = (unsigned)(r0 - m0 + 4 * hh) * 1024u + col;
#pragma unroll
      for (int e = 0; e < 16; ++e) pre[b0 + ACC_R0(e) * 1024u] = DN_ALPHA * xr[b1 + ACC_R0(e) * 1024u] + acc[e];
    };
    gemm_tile<MI, true>(al, (const u16*)(p.ws + WS_WOUT), DM, DM, m0, n0, epi, smem, sc_s);
  });
}

DI void phase_ln(const Params& p, const float* gam, const float* bet) {
  const float* pre = (const float*)(p.ws + WS_A);
  float* xf = (float*)(p.ws + WS_B);
  u16* xb = (u16*)(p.ws + WS_C);
  const int lane = threadIdx.x & 63;
  const int wg = blockIdx.x * 4 + (threadIdx.x >> 6), nw = gridDim.x * 4;
  for (int row0 = wg * 2; row0 < NT; row0 += nw * 2) {
    float4 v[2][4];
    float s[2], q[2];
#pragma unroll
    for (int r = 0; r < 2; ++r) {
      s[r] = 0.f;
#pragma unroll
      for (int j = 0; j < 4; ++j) { v[r][j] = ((const float4*)(pre + (size_t)(row0 + r) * DM))[lane + 64 * j]; s[r] += v[r][j].x + v[r][j].y + v[r][j].z + v[r][j].w; }
    }
#pragma unroll
    for (int o = 32; o >= 1; o >>= 1)
#pragma unroll
      for (int r = 0; r < 2; ++r) s[r] += __shfl_xor(s[r], o);
#pragma unroll
    for (int r = 0; r < 2; ++r) {
      s[r] *= (1.f / 1024.f); q[r] = 0.f;
#pragma unroll
      for (int j = 0; j < 4; ++j) { const float a = v[r][j].x - s[r], b2 = v[r][j].y - s[r], c = v[r][j].z - s[r], d = v[r][j].w - s[r]; q[r] += a * a + b2 * b2 + c * c + d * d; }
    }
#pragma unroll
    for (int o = 32; o >= 1; o >>= 1)
#pragma unroll
      for (int r = 0; r < 2; ++r) q[r] += __shfl_xor(q[r], o);
#pragma unroll
    for (int r = 0; r < 2; ++r) {
      const float mu = s[r], rs = rsqrtf(q[r] * (1.f / 1024.f) + 1e-5f);
#pragma unroll
      for (int j = 0; j < 4; ++j) {
        const float4 gg = ((const float4*)gam)[lane + 64 * j], bb = ((const float4*)bet)[lane + 64 * j];
        float4 y;
        y.x = (v[r][j].x - mu) * rs * gg.x + bb.x; y.y = (v[r][j].y - mu) * rs * gg.y + bb.y;
        y.z = (v[r][j].z - mu) * rs * gg.z + bb.z; y.w = (v[r][j].w - mu) * rs * gg.w + bb.w;
        ((float4*)(xf + (size_t)(row0 + r) * DM))[lane + 64 * j] = y;
        ((uint2*)(xb + (size_t)(row0 + r) * DM))[lane + 64 * j] = make_uint2(pk2(y.x, y.y), pk2(y.z, y.w));
      }
    }
  }
}

template <bool NOEPI = false>
DI void phase_gemm_bf16(const Params& p, const u16* A, const u16* Wt, int N, u16* O, float scale, char* smem) {
  for_tiles(N, [&](int m0, int n0, auto tag) {
    constexpr int MI = decltype(tag)::value;
    GldsBf16<MI * 64> al; al.base = A + (size_t)m0 * DM; al.ld = DM;
    auto epi = [=](int r0, int c0, const f32x16& acc) {
      const int lane = threadIdx.x & 63, hh = lane >> 5, col = c0 + (lane & 31);
      const unsigned b0 = (unsigned)(r0 + 4 * hh) * (unsigned)N + col;
      if (NOEPI) { float t = 0.f;
#pragma unroll
        for (int e = 0; e < 16; ++e) t += acc[e];
        if (t == 12345.678f) O[b0] = bf1(t);
        return; }
#pragma unroll
      for (int e = 0; e < 16; ++e) O[b0 + ACC_R0(e) * (unsigned)N] = bf1(acc[e] * scale);
    };
    gemm_tile<MI>(al, Wt, DM, DM, m0, n0, epi, smem);
  });
}

template <class F>
DI void for_mem_tiles(F body) {
  const int vb = vblock(), nb = gridDim.x;
  for (int t = vb; t < 2048 + 256; t += nb) {
    if (t < 2048) { const int mt = t >> 3; body(mt * 128, (t >> 1) & 3, (t & 1) * 128, mt >> 4, IC<2>{}); }
    else { const int u = t - 2048; const int mt = u >> 4; body(NTP + mt * 64, (u >> 2) & 3, (u & 3) * 64, 16 + mt, IC<1>{}); }
  }
}
DI void phase_mem_s(const Params& p, char* smem) {
  const u16* qm = (const u16*)(p.ws + WS_D);
  float* S = (float*)(p.ws + WS_F);
  for_mem_tiles([&](int m0, int hd, int n0, int batch, auto tag) {
    constexpr int MI = decltype(tag)::value;
    GldsBf16<MI * 64> al; al.base = qm + (size_t)m0 * DM + hd * 256; al.ld = DM;
    const u16* Bt = (const u16*)(p.ws + WS_MEMK) + (size_t)batch * 256 * DM + hd * 256;
    auto epi = [=](int r0, int c0, const f32x16& acc) {
      const int lane = threadIdx.x & 63, hh = lane >> 5, col = c0 + (lane & 31);
      const unsigned b0 = (unsigned)(r0 + 4 * hh) * 1024u + hd * 256 + col;
#pragma unroll
      for (int e = 0; e < 16; ++e) S[b0 + ACC_R0(e) * 1024u] = acc[e];
    };
    gemm_tile<MI>(al, Bt, DM, 256, m0, n0, epi, smem);
  });
}
DI void phase_mem_softmax(const Params& p) {
  const float* S = (const float*)(p.ws + WS_F);
  u16* P = (u16*)(p.ws + WS_D);
  const int lane = threadIdx.x & 63;
  const int wg = blockIdx.x * 4 + (threadIdx.x >> 6), nw = gridDim.x * 4;
  for (int row0 = wg * 8; row0 < NT * 4; row0 += nw * 8) {
    float4 v[8]; float m[8], sm[8];
#pragma unroll
    for (int r = 0; r < 8; ++r) v[r] = ((const float4*)(S + (size_t)(row0 + r) * 256))[lane];
#pragma unroll
    for (int r = 0; r < 8; ++r) m[r] = fmaxf(fmaxf(v[r].x, v[r].y), fmaxf(v[r].z, v[r].w));
#pragma unroll
    for (int o = 32; o >= 1; o >>= 1)
#pragma unroll
      for (int r = 0; r < 8; ++r) m[r] = fmaxf(m[r], __shfl_xor(m[r], o));
#pragma unroll
    for (int r = 0; r < 8; ++r) { v[r].x = __expf(v[r].x - m[r]); v[r].y = __expf(v[r].y - m[r]); v[r].z = __expf(v[r].z - m[r]); v[r].w = __expf(v[r].w - m[r]); sm[r] = v[r].x + v[r].y + v[r].z + v[r].w; }
#pragma unroll
    for (int o = 32; o >= 1; o >>= 1)
#pragma unroll
      for (int r = 0; r < 8; ++r) sm[r] += __shfl_xor(sm[r], o);
#pragma unroll
    for (int r = 0; r < 8; ++r) { const float inv = 1.f / sm[r]; ((uint2*)(P + (size_t)(row0 + r) * 256))[lane] = make_uint2(pk2(v[r].x * inv, v[r].y * inv), pk2(v[r].z * inv, v[r].w * inv)); }
  }
}
DI void phase_mem_pv(const Params& p, char* smem) {
  const u16* P = (const u16*)(p.ws + WS_D);
  u16* om = (u16*)(p.ws + WS_E);
  for_mem_tiles([&](int m0, int hd, int n0, int batch, auto tag) {
    constexpr int MI = decltype(tag)::value;
    GldsBf16<MI * 64> al; al.base = P + (size_t)m0 * DM + hd * 256; al.ld = DM;
    const u16* Bt = (const u16*)(p.ws + WS_MEMVT) + ((size_t)batch * DM + hd * 256) * 256;
    auto epi = [=](int r0, int c0, const f32x16& acc) {
      const int lane = threadIdx.x & 63, hh = lane >> 5, col = c0 + (lane & 31);
      const unsigned b0 = (unsigned)(r0 + 4 * hh) * 1024u + hd * 256 + col;
#pragma unroll
      for (int e = 0; e < 16; ++e) om[b0 + ACC_R0(e) * 1024u] = bf1(acc[e]);
    };
    gemm_tile<MI>(al, Bt, 256, 256, m0, n0, epi, smem);
  });
}
DI void phase_wmo(const Params& p, char* smem) {
  float* pre = (float*)(p.ws + WS_A);
  const float* xf = (const float*)(p.ws + WS_B);
  const u16* om = (const u16*)(p.ws + WS_E);
  for_tiles(DM, [&](int m0, int n0, auto tag) {
    constexpr int MI = decltype(tag)::value;
    GldsBf16<MI * 64> al; al.base = om + (size_t)m0 * DM; al.ld = DM;
    auto epi = [=](int r0, int c0, const f32x16& acc) {
      const int lane = threadIdx.x & 63, hh = lane >> 5, col = c0 + (lane & 31);
      const unsigned b0 = (unsigned)(r0 + 4 * hh) * 1024u + col;
#pragma unroll
      for (int e = 0; e < 16; ++e) { const unsigned i = b0 + ACC_R0(e) * 1024u; pre[i] = DN_ALPHA * xf[i] + acc[e]; }
    };
    gemm_tile<MI>(al, (const u16*)(p.ws + WS_WMO), DM, DM, m0, n0, epi, smem);
  });
}

DI void insert16(float (&v)[16], float x) {
#pragma unroll
  for (int j = 15; j >= 1; --j) v[j] = __builtin_amdgcn_fmed3f(x, v[j - 1], v[j]);
  v[0] = fmaxf(v[0], x);
}
DI void phase_topk(const Params& p, char* smem) {
  const int vb = vblock(), nb = gridDim.x;
  const u16* qp = (const u16*)(p.ws + WS_F);
  int* idxo = (int*)(p.ws + WS_A);
  float* gato = (float*)(p.ws + WS_A + (size_t)NT * 128 * 4);
  float* sc = (float*)smem;
  const int tid = threadIdx.x;
  for (int t = vb; t < 264 * 8; t += nb) {
    const int mt = t >> 3, hd = t & 7;
    const int m0 = mt * 128;
    float va[16], vbv[16];
#pragma unroll
    for (int side = 0; side < 2; ++side) {
      GldsBf16<128> al; al.base = qp + (size_t)m0 * 2048 + hd * 256 + side * 128; al.ld = 2048;
      const u16* Bt = (const u16*)(p.ws + (side ? WS_KB : WS_KA)) + (size_t)hd * 128 * 128;
      auto epi = [=](int r0, int c0, const f32x16& acc) {
        const int lane = threadIdx.x & 63, hh = lane >> 5, col = c0 + (lane & 31);
#pragma unroll
        for (int e = 0; e < 16; ++e) sc[(r0 - m0 + ACC_ROW(e, hh)) * 129 + col] = acc[e];
      };
      gemm_tile<2>(al, Bt, 128, 128, m0, 0, epi, smem);
      __syncthreads();
      {
        const int row = tid & 127, half = tid >> 7;
        float* mg = (float*)(smem + 66048);
        float v[16];
#pragma unroll
        for (int j = 0; j < 16; ++j) v[j] = -INFINITY;
        for (int k = 64 * half; k < 64 * half + 64; ++k) {
          const float x = __uint_as_float((__float_as_uint(sc[row * 129 + k]) & ~0x7Fu) | (unsigned)k);
          insert16(v, x);
        }
        if (half == 1) {
#pragma unroll
          for (int j = 0; j < 16; ++j) mg[row * 17 + j] = v[j];
        }
        __syncthreads();
        if (half == 0) {
#pragma unroll
          for (int j = 0; j < 16; ++j) insert16(v, mg[row * 17 + j]);
#pragma unroll
          for (int j = 0; j < 16; ++j) { if (side == 0) va[j] = v[j]; else vbv[j] = v[j]; }
        }
      }
      __syncthreads();
    }
    unsigned char* ids = (unsigned char*)smem;
    if (tid < 128) {
#pragma unroll
      for (int j = 0; j < 16; ++j) { ids[tid * 32 + j] = (unsigned char)(__float_as_uint(va[j]) & 0x7F); ids[tid * 32 + 16 + j] = (unsigned char)(__float_as_uint(vbv[j]) & 0x7F); }
      float top[16];
#pragma unroll
      for (int j = 0; j < 16; ++j) top[j] = -INFINITY;
#pragma unroll
      for (int i = 0; i < 16; ++i)
#pragma unroll
        for (int j = 0; j < 16; ++j)
          if ((i + 1) * (j + 1) <= 16) {
            const float a = __uint_as_float(__float_as_uint(va[i]) & ~0x7Fu), b = __uint_as_float(__float_as_uint(vbv[j]) & ~0x7Fu);
            const float c = __uint_as_float((__float_as_uint(a + b) & ~0xFFu) | (unsigned)(i * 16 + j));
            insert16(top, c);
          }
      const float m = __uint_as_float(__float_as_uint(top[0]) & ~0xFFu);
      float ex[16], ssum = 0.f;
      int eid[16];
#pragma unroll
      for (int j = 0; j < 16; ++j) {
        const unsigned bits = __float_as_uint(top[j]);
        const int code = bits & 0xFF;
        ex[j] = __expf(__uint_as_float(bits & ~0xFFu) - m); ssum += ex[j];
        eid[j] = (int)ids[tid * 32 + (code >> 4)] * 128 + (int)ids[tid * 32 + 16 + (code & 15)];
      }
      const float inv = 1.f / ssum;
      const size_t ob = (size_t)(m0 + tid) * 128 + hd * 16;
#pragma unroll
      for (int j4 = 0; j4 < 4; ++j4) {
        *(int4*)(idxo + ob + 4 * j4) = make_int4(eid[4 * j4], eid[4 * j4 + 1], eid[4 * j4 + 2], eid[4 * j4 + 3]);
        *(float4*)(gato + ob + 4 * j4) = make_float4(ex[4 * j4] * inv, ex[4 * j4 + 1] * inv, ex[4 * j4 + 2] * inv, ex[4 * j4 + 3] * inv);
      }
    }
    __syncthreads();
  }
}

#if USE_FP8
typedef float f32x2v __attribute__((ext_vector_type(2)));
DI void unpack16(const uint4& v, float (&f)[16]) {
  const unsigned w[4] = {v.x, v.y, v.z, v.w};
#pragma unroll
  for (int j = 0; j < 4; ++j) {
    const f32x2v lo = __builtin_amdgcn_cvt_pk_f32_fp8((int)w[j], false), hi = __builtin_amdgcn_cvt_pk_f32_fp8((int)w[j], true);
    f[4 * j] = lo[0]; f[4 * j + 1] = lo[1]; f[4 * j + 2] = hi[0]; f[4 * j + 3] = hi[1];
  }
}
DI void peer_dot8(const char* U, int idreg, int e0, int lane, const float (&x)[16], float& dacc) {
  uint4 w[8];
#pragma unroll
  for (int j = 0; j < 8; ++j) { const int id = __builtin_amdgcn_readlane(idreg, e0 + j); w[j] = *(const uint4*)(U + (size_t)id * DM + 16 * lane); }
  float s[8];
#pragma unroll
  for (int j = 0; j < 8; ++j) {
    float f[16]; unpack16(w[j], f);
    float a = 0.f;
#pragma unroll
    for (int k = 0; k < 16; ++k) a += f[k] * x[k];
    s[j] = a;
  }
  const bool b5 = lane & 32, b4 = lane & 16, b3 = lane & 8;
  float t4[4], t2[2], t1;
#pragma unroll
  for (int i = 0; i < 4; ++i) { const float snd = b5 ? s[i] : s[4 + i], kp = b5 ? s[4 + i] : s[i]; t4[i] = kp + __shfl_xor(snd, 32); }
#pragma unroll
  for (int i = 0; i < 2; ++i) { const float snd = b4 ? t4[i] : t4[2 + i], kp = b4 ? t4[2 + i] : t4[i]; t2[i] = kp + __shfl_xor(snd, 16); }
  { const float snd = b3 ? t2[0] : t2[1], kp = b3 ? t2[1] : t2[0]; t1 = kp + __shfl_xor(snd, 8); }
  t1 += __shfl_xor(t1, 4); t1 += __shfl_xor(t1, 2); t1 += __shfl_xor(t1, 1);
  const float g = __shfl(t1, (lane & 7) * 8);
  if ((lane >> 3) == (e0 >> 3)) dacc = g;
}
DI void peer_axpy8(const char* V, int idreg, float hreg, int e0, int lane, float (&acc)[16]) {
  uint4 w[8];
#pragma unroll
  for (int j = 0; j < 8; ++j) { const int id = __builtin_amdgcn_readlane(idreg, e0 + j); w[j] = *(const uint4*)(V + (size_t)id * DM + 16 * lane); }
#pragma unroll
  for (int j = 0; j < 8; ++j) {
    const float hs = __uint_as_float(__builtin_amdgcn_readlane(__float_as_uint(hreg), e0 + j));
    float f[16]; unpack16(w[j], f);
#pragma unroll
    for (int k = 0; k < 16; ++k) acc[k] += hs * f[k];
  }
}
DI void peer_sort(int& id0, int& id1, float& g0, float& g1, int lane) {
  unsigned k0 = ((unsigned)id0 << 7) | (unsigned)lane, k1 = ((unsigned)id1 << 7) | (unsigned)(lane + 64);
#pragma unroll
  for (int k = 2; k <= 128; k <<= 1) {
#pragma unroll
    for (int j = k >> 1; j >= 1; j >>= 1) {
      if (j == 64) {
        const unsigned lo = min(k0, k1), hi = max(k0, k1); k0 = lo; k1 = hi;
      } else {
        const unsigned p0 = (unsigned)__shfl_xor((int)k0, j), p1 = (unsigned)__shfl_xor((int)k1, j);
        const bool upper = (lane & j) != 0;
        const bool asc0 = ((lane & k) == 0), asc1 = (((lane + 64) & k) == 0);
        k0 = (upper == asc0) ? max(k0, p0) : min(k0, p0);
        k1 = (upper == asc1) ? max(k1, p1) : min(k1, p1);
      }
    }
  }
  const int s0 = k0 & 127, s1 = k1 & 127;
  const float a0 = __shfl(g0, s0 & 63), b0 = __shfl(g1, s0 & 63), a1 = __shfl(g0, s1 & 63), b1 = __shfl(g1, s1 & 63);
  g0 = (s0 < 64) ? a0 : b0; g1 = (s1 < 64) ? a1 : b1;
  id0 = (int)(k0 >> 7); id1 = (int)(k1 >> 7);
}
DI void peer_load(const Params& p, int row, int lane, float (&x)[16], int& id0, int& id1, float& g0, float& g1) {
  const float* xf = (const float*)(p.ws + WS_B);
  const int* idxo = (const int*)(p.ws + WS_A);
  const float* gato = (const float*)(p.ws + WS_A + (size_t)NT * 128 * 4);
  const float4* xr = (const float4*)(xf + (size_t)row * DM) + 4 * lane;
#pragma unroll
  for (int j = 0; j < 4; ++j) { const float4 a = xr[j]; x[4 * j] = a.x; x[4 * j + 1] = a.y; x[4 * j + 2] = a.z; x[4 * j + 3] = a.w; }
  id0 = idxo[(size_t)row * 128 + lane]; id1 = idxo[(size_t)row * 128 + 64 + lane];
  g0 = gato[(size_t)row * 128 + lane]; g1 = gato[(size_t)row * 128 + 64 + lane];
  peer_sort(id0, id1, g0, g1, lane);
}
DI void peer_finish(const Params& p, int row, int lane, float (&acc)[16]) {
  float x[16];
  {
    const float4* xr = (const float4*)((const float*)(p.ws + WS_B) + (size_t)row * DM) + 4 * lane;
#pragma unroll
    for (int j = 0; j < 4; ++j) { const float4 a = xr[j]; x[4 * j] = a.x; x[4 * j + 1] = a.y; x[4 * j + 2] = a.z; x[4 * j + 3] = a.w; }
  }
  float s = 0.f;
#pragma unroll
  for (int k = 0; k < 16; ++k) { acc[k] = DN_ALPHA * x[k] + acc[k]; s += acc[k]; }
  const float mu = wave_sum(s) * (1.f / 1024.f);
  float q = 0.f;
#pragma unroll
  for (int k = 0; k < 16; ++k) { const float dd = acc[k] - mu; q += dd * dd; }
  const float rs = rsqrtf(wave_sum(q) * (1.f / 1024.f) + 1e-5f);
  float* y = (row < NTP) ? p.out + OUT_YP + (size_t)row * DM : p.out + OUT_YS + (size_t)(row - NTP) * DM;
#pragma unroll
  for (int j = 0; j < 4; ++j) {
    const float4 ga = ((const float4*)p.ln3_g)[4 * lane + j], ba = ((const float4*)p.ln3_b)[4 * lane + j];
    float4 ya;
    ya.x = (acc[4 * j + 0] - mu) * rs * ga.x + ba.x; ya.y = (acc[4 * j + 1] - mu) * rs * ga.y + ba.y;
    ya.z = (acc[4 * j + 2] - mu) * rs * ga.z + ba.z; ya.w = (acc[4 * j + 3] - mu) * rs * ga.w + ba.w;
    ((float4*)y)[4 * lane + j] = ya;
  }
}
DI float peer_gelu_gate(float d, float g) { return 0.5f * d * (1.f + erff(d * 0.7071067811865476f)) * g; }
DI void phase_peer(const Params& p, int rr0 = 0, int rr1 = 1 << 10) {
  const char* U = p.ws + WS_U;
  const char* V = p.ws + WS_V;
  const float* usc = (const float*)(p.ws + WS_USC);
  const float* vsc = (const float*)(p.ws + WS_VSC);
  const int lane = threadIdx.x & 63;
  const int wg = blockIdx.x * 4 + (threadIdx.x >> 6), nw = gridDim.x * 4;
  for (int rowA = wg + rr0 * 2 * nw; rowA < NT && rowA < wg + rr1 * 2 * nw; rowA += 2 * nw) {
    const bool hasB = rowA + nw < NT;
    const int rowB = hasB ? rowA + nw : rowA;
    asm volatile("" ::: "memory");
    float xA[16], xB[16];
    int a0, a1, b0, b1; float ga0, ga1, gb0, gb1;
    peer_load(p, rowA, lane, xA, a0, a1, ga0, ga1);
    peer_load(p, rowB, lane, xB, b0, b1, gb0, gb1);
    const float sua0 = usc[a0], sua1 = usc[a1], sva0 = vsc[a0], sva1 = vsc[a1];
    const float sub0 = usc[b0], sub1 = usc[b1], svb0 = vsc[b0], svb1 = vsc[b1];
    float da0 = 0.f, da1 = 0.f, db0 = 0.f, db1 = 0.f;
#pragma unroll 1
    for (int e0 = 0; e0 < 64; e0 += 8) { peer_dot8(U, a0, e0, lane, xA, da0); if (hasB) peer_dot8(U, b0, e0, lane, xB, db0); }
#pragma unroll 1
    for (int e0 = 0; e0 < 64; e0 += 8) { peer_dot8(U, a1, e0, lane, xA, da1); if (hasB) peer_dot8(U, b1, e0, lane, xB, db1); }
    const float ha0 = peer_gelu_gate(da0 * sua0, ga0) * sva0, ha1 = peer_gelu_gate(da1 * sua1, ga1) * sva1;
    const float hb0 = peer_gelu_gate(db0 * sub0, gb0) * svb0, hb1 = peer_gelu_gate(db1 * sub1, gb1) * svb1;
    float accA[16], accB[16];
#pragma unroll
    for (int k = 0; k < 16; ++k) { accA[k] = 0.f; accB[k] = 0.f; }
#pragma unroll 1
    for (int e0 = 0; e0 < 64; e0 += 8) { peer_axpy8(V, a0, ha0, e0, lane, accA); if (hasB) peer_axpy8(V, b0, hb0, e0, lane, accB); }
#pragma unroll 1
    for (int e0 = 0; e0 < 64; e0 += 8) { peer_axpy8(V, a1, ha1, e0, lane, accA); if (hasB) peer_axpy8(V, b1, hb1, e0, lane, accB); }
    peer_finish(p, rowA, lane, accA);
    if (hasB) peer_finish(p, rowB, lane, accB);
  }
}
#else
DI void unpack8(const uint4& v, float (&f)[8]) {
  f[0] = bflo(v.x); f[1] = bfhi(v.x); f[2] = bflo(v.y); f[3] = bfhi(v.y); f[4] = bflo(v.z); f[5] = bfhi(v.z); f[6] = bflo(v.w); f[7] = bfhi(v.w);
}
DI void phase_peer(const Params& p) {
  const float* xf = (const float*)(p.ws + WS_B);
  const int* idxo = (const int*)(p.ws + WS_A);
  const float* gato = (const float*)(p.ws + WS_A + (size_t)NT * 128 * 4);
  const u16* U = (const u16*)(p.ws + WS_U);
  const u16* V = (const u16*)(p.ws + WS_V);
  const int lane = threadIdx.x & 63;
  const int wg = blockIdx.x * 4 + (threadIdx.x >> 6), nw = gridDim.x * 4;
  for (int row = wg; row < NT; row += nw) {
    float x[16];
    {
      const float4* xr = (const float4*)(xf + (size_t)row * DM);
      const float4 a = xr[2 * lane], b = xr[2 * lane + 1], c = xr[128 + 2 * lane], d = xr[128 + 2 * lane + 1];
      x[0] = a.x; x[1] = a.y; x[2] = a.z; x[3] = a.w; x[4] = b.x; x[5] = b.y; x[6] = b.z; x[7] = b.w;
      x[8] = c.x; x[9] = c.y; x[10] = c.z; x[11] = c.w; x[12] = d.x; x[13] = d.y; x[14] = d.z; x[15] = d.w;
    }
    const int id0 = idxo[(size_t)row * 128 + lane], id1 = idxo[(size_t)row * 128 + 64 + lane];
    const float g0 = gato[(size_t)row * 128 + lane], g1 = gato[(size_t)row * 128 + 64 + lane];
    float d0 = 0.f, d1 = 0.f;
#pragma unroll 8
    for (int e = 0; e < 64; ++e) {
      const int id = __builtin_amdgcn_readlane(id0, e);
      const uint4* ur = (const uint4*)(U + (size_t)id * DM);
      const uint4 ua = ur[lane], ub = ur[64 + lane];
      float f[8], s = 0.f;
      unpack8(ua, f);
#pragma unroll
      for (int k = 0; k < 8; ++k) s += f[k] * x[k];
      unpack8(ub, f);
#pragma unroll
      for (int k = 0; k < 8; ++k) s += f[k] * x[8 + k];
      s = wave_sum(s);
      if (lane == e) d0 = s;
    }
#pragma unroll 8
    for (int e = 0; e < 64; ++e) {
      const int id = __builtin_amdgcn_readlane(id1, e);
      const uint4* ur = (const uint4*)(U + (size_t)id * DM);
      const uint4 ua = ur[lane], ub = ur[64 + lane];
      float f[8], s = 0.f;
      unpack8(ua, f);
#pragma unroll
      for (int k = 0; k < 8; ++k) s += f[k] * x[k];
      unpack8(ub, f);
#pragma unroll
      for (int k = 0; k < 8; ++k) s += f[k] * x[8 + k];
      s = wave_sum(s);
      if (lane == e) d1 = s;
    }
    const float h0 = 0.5f * d0 * (1.f + erff(d0 * 0.7071067811865476f)) * g0;
    const float h1 = 0.5f * d1 * (1.f + erff(d1 * 0.7071067811865476f)) * g1;
    float acc[16];
#pragma unroll
    for (int k = 0; k < 16; ++k) acc[k] = 0.f;
#pragma unroll 8
    for (int e = 0; e < 64; ++e) {
      const int id = __builtin_amdgcn_readlane(id0, e);
      const float hs = __uint_as_float(__builtin_amdgcn_readlane(__float_as_uint(h0), e));
      const uint4* vr = (const uint4*)(V + (size_t)id * DM);
      const uint4 va = vr[lane], vb2 = vr[64 + lane];
      float f[8];
      unpack8(va, f);
#pragma unroll
      for (int k = 0; k < 8; ++k) acc[k] += hs * f[k];
      unpack8(vb2, f);
#pragma unroll
      for (int k = 0; k < 8; ++k) acc[8 + k] += hs * f[k];
    }
#pragma unroll 8
    for (int e = 0; e < 64; ++e) {
      const int id = __builtin_amdgcn_readlane(id1, e);
      const float hs = __uint_as_float(__builtin_amdgcn_readlane(__float_as_uint(h1), e));
      const uint4* vr = (const uint4*)(V + (size_t)id * DM);
      const uint4 va = vr[lane], vb2 = vr[64 + lane];
      float f[8];
      unpack8(va, f);
#pragma unroll
      for (int k = 0; k < 8; ++k) acc[k] += hs * f[k];
      unpack8(vb2, f);
#pragma unroll
      for (int k = 0; k < 8; ++k) acc[8 + k] += hs * f[k];
    }
    float s = 0.f;
#pragma unroll
    for (int k = 0; k < 16; ++k) { acc[k] = DN_ALPHA * x[k] + acc[k]; s += acc[k]; }
    const float mu = wave_sum(s) * (1.f / 1024.f);
    float q = 0.f;
#pragma unroll
    for (int k = 0; k < 16; ++k) { const float dd = acc[k] - mu; q += dd * dd; }
    const float rs = rsqrtf(wave_sum(q) * (1.f / 1024.f) + 1e-5f);
    float* y = (row < NTP) ? p.out + OUT_YP + (size_t)row * DM : p.out + OUT_YS + (size_t)(row - NTP) * DM;
#pragma unroll
    for (int c = 0; c < 2; ++c) {
      const int off = c * 512 + lane * 8;
      const float4 ga = *(const float4*)(p.ln3_g + off), gb = *(const float4*)(p.ln3_g + off + 4);
      const float4 ba = *(const float4*)(p.ln3_b + off), bb = *(const float4*)(p.ln3_b + off + 4);
      float4 ya, yb;
      ya.x = (acc[8 * c + 0] - mu) * rs * ga.x + ba.x; ya.y = (acc[8 * c + 1] - mu) * rs * ga.y + ba.y;
      ya.z = (acc[8 * c + 2] - mu) * rs * ga.z + ba.z; ya.w = (acc[8 * c + 3] - mu) * rs * ga.w + ba.w;
      yb.x = (acc[8 * c + 4] - mu) * rs * gb.x + bb.x; yb.y = (acc[8 * c + 5] - mu) * rs * gb.y + bb.y;
      yb.z = (acc[8 * c + 6] - mu) * rs * gb.z + bb.z; yb.w = (acc[8 * c + 7] - mu) * rs * gb.w + bb.w;
      *(float4*)(y + off) = ya; *(float4*)(y + off + 4) = yb;
    }
  }
}

#endif

constexpr int NPHASE = 15;
template <int PH>
DI void run_phase(const Params& p, char* smem) {
  if (PH == 0) phase_prep(p, smem);
  else if (PH == 1) phase_proj(p, smem);
  else if (PH == 2) phase_scan(p, smem);
  else if (PH == 3) phase_attn(p, smem);
  else if (PH == 4) phase_wout(p, smem);
  else if (PH == 5) phase_ln(p, p.ln1_g, p.ln1_b);
  else if (PH == 6) phase_gemm_bf16(p, (const u16*)(p.ws + WS_C), (const u16*)(p.ws + WS_WMQ), 1024, (u16*)(p.ws + WS_D), 0.0625f, smem);
  else if (PH == 7) phase_mem_s(p, smem);
  else if (PH == 8) phase_mem_softmax(p);
  else if (PH == 9) phase_mem_pv(p, smem);
  else if (PH == 10) phase_wmo(p, smem);
  else if (PH == 11) phase_ln(p, p.ln2_g, p.ln2_b);
  else if (PH == 12) phase_gemm_bf16(p, (const u16*)(p.ws + WS_C), (const u16*)(p.ws + WS_WPQ), 2048, (u16*)(p.ws + WS_F), 1.f, smem);
  else if (PH == 13) phase_topk(p, smem);
  else if (PH == 14) phase_peer(p);
}

template <int PH>
__global__ void __launch_bounds__(256, 2) k_phase(Params p) {
  __shared__ __attribute__((aligned(16))) char smem[SMEM_BYTES];
  run_phase<PH>(p, smem);
}

#define XB_TMO      128
#define XB_XCNT(j)  (256  + 64 * (j))
#define XB_XSUB(j)  (1280 + 64 * (j))
#define XB_XGEN(j)  (2304 + 64 * (j))
#define XB_TOP      3328
#define XB_TOPGEN   3392
#define XB_SPIN_CAP (1u << 20)
DI unsigned xb_ld(unsigned* p) { return __hip_atomic_load(p, __ATOMIC_RELAXED, __HIP_MEMORY_SCOPE_AGENT); }
DI unsigned xb_add(unsigned* p, unsigned v) { return __hip_atomic_fetch_add(p, v, __ATOMIC_RELAXED, __HIP_MEMORY_SCOPE_AGENT); }
DI unsigned xb_xcc_id() { return (unsigned)__builtin_amdgcn_s_getreg((3 << 11) | 20) & 0xFu; }
#define XB_SPIN(cond, bar) do { unsigned _sp = 0; while (cond) { __builtin_amdgcn_s_sleep(1); \
    if ((++_sp & 255u) == 0u) { if (xb_ld(&(bar)[XB_TMO])) break; if (_sp > XB_SPIN_CAP) { atomicAdd(&(bar)[XB_TMO], 1u); break; } } } } while (0)
struct XcdBarrier { unsigned* bar; unsigned x; volatile unsigned* st; };
DI XcdBarrier xcd_barrier_post(unsigned* bar, volatile unsigned* st) {
  XcdBarrier b; b.bar = bar; b.x = xb_xcc_id(); b.st = st;
  if (threadIdx.x == 0) (void)xb_add(&bar[XB_XCNT(b.x)], 1u);
  return b;
}
DI void xcd_barrier_complete(unsigned* bar, unsigned x, unsigned& nloc, unsigned& nx) {
  const unsigned G = gridDim.x;
  unsigned sum, cnt, mine, sp = 0u;
  for (;;) {
    sum = 0u; cnt = 0u; mine = 0u;
#pragma unroll
    for (unsigned j = 0; j < 16; ++j) { const unsigned c = xb_ld(&bar[XB_XCNT(j)]); sum += c; cnt += (c > 0u) ? 1u : 0u; mine = (j == x) ? c : mine; }
    if (sum == G) break;
    __builtin_amdgcn_s_sleep(1);
    if ((++sp & 255u) == 0u) { if (xb_ld(&bar[XB_TMO])) break; if (sp > XB_SPIN_CAP) { atomicAdd(&bar[XB_TMO], 1u); break; } }
  }
  nloc = mine > 0u ? mine : 1u; nx = cnt > 0u ? cnt : 1u;
}
DI void xcd_barrier(const XcdBarrier& b) {
  asm volatile("s_waitcnt vmcnt(0)" ::: "memory");
  __syncthreads();
  if (threadIdx.x == 0) {
    unsigned* bar = b.bar;
    __builtin_amdgcn_s_waitcnt(0);
    unsigned nloc = b.st[0], nx = b.st[1];
    if (nloc == 0u) { xcd_barrier_complete(bar, b.x, nloc, nx); b.st[0] = nloc; b.st[1] = nx; }
    const unsigned old = xb_add(&bar[XB_XSUB(b.x)], 1u);
    const unsigned gen = old / nloc;
    if (old + 1u == (gen + 1u) * nloc) {
      __builtin_amdgcn_fence(__ATOMIC_RELEASE, "agent");
      asm volatile("s_waitcnt vmcnt(0)" ::: "memory");
      const unsigned og = xb_add(&bar[XB_TOP], 1u);
      const unsigned tg = og / nx;
      if (og + 1u == (tg + 1u) * nx) xb_add(&bar[XB_TOPGEN], 1u);
      else XB_SPIN(xb_ld(&bar[XB_TOPGEN]) == tg, bar);
      __builtin_amdgcn_fence(__ATOMIC_ACQUIRE, "agent");
      xb_add(&bar[XB_XGEN(b.x)], 1u);
      asm volatile("s_waitcnt vmcnt(0)" ::: "memory");
    } else {
      XB_SPIN(xb_ld(&bar[XB_XGEN(b.x)]) == gen, bar);
      __builtin_amdgcn_fence(__ATOMIC_ACQUIRE, "agent");
      asm volatile("s_waitcnt vmcnt(0)" ::: "memory");
    }
  }
  __syncthreads();
}
#if ONE_LAUNCH
DI void grid_barrier(unsigned* bar, unsigned& target) {
  target += gridDim.x;
  asm volatile("s_waitcnt vmcnt(0)" ::: "memory");
  __syncthreads();
  if (threadIdx.x == 0) {
    __builtin_amdgcn_fence(__ATOMIC_RELEASE, "agent");
    asm volatile("s_waitcnt vmcnt(0)" ::: "memory");
    __hip_atomic_fetch_add(bar, 1u, __ATOMIC_RELAXED, __HIP_MEMORY_SCOPE_AGENT);
    while (__hip_atomic_load(bar, __ATOMIC_RELAXED, __HIP_MEMORY_SCOPE_AGENT) < target) __builtin_amdgcn_s_sleep(2);
    __builtin_amdgcn_fence(__ATOMIC_ACQUIRE, "agent");
    asm volatile("s_waitcnt vmcnt(0)" ::: "memory");
  }
  __syncthreads();
}
__global__ void __launch_bounds__(256, 2) k_mega(Params p) {
  __shared__ __attribute__((aligned(16))) char smem[SMEM_BYTES];
  cg::grid_group grid = cg::this_grid();
#define RUN(n) do { run_phase<n>(p, smem); if (REPEAT_PHASE == n || (REPEAT_PHASE >= 1000 && (((REPEAT_PHASE - 1000) >> n) & 1))) { GSYNC(); run_phase<n>(p, smem); GSYNC(); run_phase<n>(p, smem); } if (REPEAT_PHASE == 203 && n == 3) { GSYNC(); phase_attn(p, smem, 1); GSYNC(); phase_attn(p, smem, 2); } if (REPEAT_PHASE == 100 + n) { GSYNC(); phase_gemm_bf16<true>(p, (const u16*)(p.ws + WS_C), (const u16*)(p.ws + WS_WPQ), 2048, (u16*)(p.ws + WS_F), 1.f, smem); GSYNC(); phase_gemm_bf16<true>(p, (const u16*)(p.ws + WS_C), (const u16*)(p.ws + WS_WPQ), 2048, (u16*)(p.ws + WS_F), 1.f, smem); } } while (0)
#if CUSTOM_BAR
  volatile unsigned* xst = (volatile unsigned*)(smem + 73728 + 1024);
  if (threadIdx.x == 0) { xst[0] = 0u; xst[1] = 0u; }
  __syncthreads();
  const XcdBarrier xb = xcd_barrier_post((unsigned*)(p.ws + WS_XBAR), xst);
#define GSYNC() xcd_barrier(xb)
#else
#define GSYNC() grid.sync()
#endif
  RUN(0); grid.sync();
  RUN(1); GSYNC();
  RUN(2); GSYNC();
  RUN(3); GSYNC();
  RUN(4); GSYNC();
  RUN(5); GSYNC();
  if (REPEAT_PHASE == 300) { GSYNC(); GSYNC(); GSYNC(); GSYNC(); GSYNC(); GSYNC(); GSYNC(); GSYNC(); }
  RUN(6); GSYNC();
  RUN(7); GSYNC();
  RUN(8); GSYNC();
  RUN(9); GSYNC();
  RUN(10); GSYNC();
  RUN(11); GSYNC();
  RUN(12); GSYNC();
  RUN(13); GSYNC();
#if PEER_RESYNC
  {
    const int nrounds = (NT + 8 * (int)gridDim.x - 1) / (8 * (int)gridDim.x);
    for (int rr = 0; rr < nrounds; rr += PEER_RESYNC) { if (rr) GSYNC(); phase_peer(p, rr, rr + PEER_RESYNC); }
  }
#else
  RUN(14);
#endif
}
#endif

extern "C" void kernel_launch(void* const* d_in, const int* in_sizes, int n_in, void* d_out, int out_size, void* d_ws, size_t ws_size,
                              hipStream_t stream) {
  (void)in_sizes; (void)n_in; (void)out_size;
  if (ws_size < WS_TOTAL) { fprintf(stderr, "workspace too small: %zu < %zu\n", ws_size, (size_t)WS_TOTAL); return; }
  Params p{};
  const float** pp = (const float**)&p;
  for (int i = 0; i < 29; ++i) pp[i] = (const float*)d_in[i];
  p.out = (float*)d_out;
  p.ws = (char*)d_ws;
#if ONE_LAUNCH
  static int grid_blocks = 0;
  if (!grid_blocks) {
    int dev = 0, cus = 0, per_cu = 0;
    hipGetDevice(&dev);
    hipDeviceGetAttribute(&cus, hipDeviceAttributeMultiprocessorCount, dev);
    hipOccupancyMaxActiveBlocksPerMultiprocessor(&per_cu, k_mega, 256, 0);
    if (per_cu > 2) per_cu = 2;
    grid_blocks = cus * per_cu;
  }
  hipMemsetAsync((char*)d_ws + WS_BAR, 0, 2048, stream);
  hipMemsetAsync((char*)d_ws + WS_XBAR, 0, 16384, stream);
  void* args[] = {&p};
  hipError_t e = hipLaunchCooperativeKernel((void*)k_mega, dim3(grid_blocks), dim3(256), args, 0, stream);
  if (e != hipSuccess) fprintf(stderr, "cooperative launch failed: %s (grid %d)\n", hipGetErrorString(e), grid_blocks);
#else
  const int G = 512;
  hipMemsetAsync((char*)d_ws + WS_BAR, 0, 2048, stream);
  k_phase<0><<<G, 256, 0, stream>>>(p);
  k_phase<1><<<G, 256, 0, stream>>>(p);
  k_phase<2><<<G, 256, 0, stream>>>(p);
  k_phase<3><<<G, 256, 0, stream>>>(p);
  k_phase<4><<<G, 256, 0, stream>>>(p);
  k_phase<5><<<G, 256, 0, stream>>>(p);
  k_phase<6><<<G, 256, 0, stream>>>(p);
  k_phase<7><<<G, 256, 0, stream>>>(p);
  k_phase<8><<<G, 256, 0, stream>>>(p);
  k_phase<9><<<G, 256, 0, stream>>>(p);
  k_phase<10><<<G, 256, 0, stream>>>(p);
  k_phase<11><<<G, 256, 0, stream>>>(p);
  k_phase<12><<<G, 256, 0, stream>>>(p);
  k_phase<13><<<G, 256, 0, stream>>>(p);
  k_phase<14><<<G, 256, 0, stream>>>(p);
#endif
}
```

```cpp
#include <hip/hip_runtime.h>
#include <hip/hip_cooperative_groups.h>
#include <cstdio>
#include <cstdint>
namespace cg = cooperative_groups;

#ifndef ONE_LAUNCH
#define ONE_LAUNCH 1
#endif

#ifndef USE_FP8
#define USE_FP8 1
#endif
#ifndef SB_EXIT
#define SB_EXIT 1
#endif
#ifndef REPEAT_PHASE
#define REPEAT_PHASE -1
#endif
#ifndef PEER_RESYNC
#define PEER_RESYNC 0
#endif
#ifndef CUSTOM_BAR
#define CUSTOM_BAR 1
#endif
#define DI __device__ __forceinline__
typedef unsigned short u16;
typedef short bf16x8 __attribute__((ext_vector_type(8)));
typedef short s16x4 __attribute__((ext_vector_type(4)));
typedef float f32x16 __attribute__((ext_vector_type(16)));
typedef __bf16 bf2_t __attribute__((ext_vector_type(2)));
typedef float f2_t __attribute__((ext_vector_type(2)));
#define MFMA(a, b, c) __builtin_amdgcn_mfma_f32_32x32x16_bf16((a), (b), (c), 0, 0, 0)

constexpr int DM = 1024;
constexpr int NTP = 32768;
constexpr int NTS = 1024;
constexpr int NT = NTP + NTS;
constexpr int SEQ = 2048, DSEQ = 64, PAST = 4096, NMEM = 256;
constexpr int INC = 3080, INCP = 3200;
constexpr float DN_ALPHA = 1.189207115002721f;
constexpr float LOG2E = 1.4426950408889634f;

constexpr size_t OUT_YP = 0;
constexpr size_t OUT_YS = OUT_YP + (size_t)NTP * DM;
constexpr size_t OUT_SBK_P = OUT_YS + (size_t)NTS * DM;
constexpr size_t OUT_SBV_P = OUT_SBK_P + (size_t)NTP * 512;
constexpr size_t OUT_FXK_P = OUT_SBV_P + (size_t)NTP * 512;
constexpr size_t OUT_FXV_P = OUT_FXK_P + (size_t)NTP * 512;
constexpr size_t OUT_LF_P = OUT_FXV_P + (size_t)NTP * 512;
constexpr size_t OUT_MK_P = OUT_LF_P + (size_t)NTP * 8;
constexpr size_t OUT_MV_P = OUT_MK_P + (size_t)4096 * DM;
constexpr size_t OUT_SBK_S = OUT_MV_P + (size_t)4096 * DM;
constexpr size_t OUT_SBV_S = OUT_SBK_S + (size_t)NTS * 512;
constexpr size_t OUT_FXK_S = OUT_SBV_S + (size_t)NTS * 512;
constexpr size_t OUT_FXV_S = OUT_FXK_S + (size_t)NTS * 512;
constexpr size_t OUT_LF_S = OUT_FXV_S + (size_t)NTS * 512;
constexpr size_t OUT_TOTAL = OUT_LF_S + (size_t)NTS * 8;

constexpr size_t WS_WIN = 0;
constexpr size_t WS_WOUT = WS_WIN + (size_t)INCP * DM * 2;
constexpr size_t WS_WMQ = WS_WOUT + (size_t)DM * DM * 2;
constexpr size_t WS_WMKV = WS_WMQ + (size_t)DM * DM * 2;
constexpr size_t WS_WMO = WS_WMKV + (size_t)2048 * DM * 2;
constexpr size_t WS_WPQ = WS_WMO + (size_t)DM * DM * 2;
constexpr size_t WS_KA = WS_WPQ + (size_t)2048 * DM * 2;
constexpr size_t WS_KB = WS_KA + (size_t)8 * 128 * 128 * 2;
constexpr size_t WS_U = WS_KB + (size_t)8 * 128 * 128 * 2;
constexpr size_t WS_V = WS_U + (size_t)16384 * DM * 2;
constexpr size_t WS_MEMK = WS_V + (size_t)16384 * DM * 2;
constexpr size_t WS_MEMVT = WS_MEMK + (size_t)32 * 256 * DM * 2;
constexpr size_t WS_A = WS_MEMVT + (size_t)32 * 256 * DM * 2;
constexpr size_t WS_B = WS_A + (size_t)NT * DM * 4;
constexpr size_t WS_C = WS_B + (size_t)NT * DM * 4;
constexpr size_t WS_D = WS_C + (size_t)NT * DM * 2;
constexpr size_t WS_E = WS_D + (size_t)NT * DM * 2;
constexpr size_t WS_F = WS_E + (size_t)NT * DM * 2;
constexpr size_t WS_BAR = WS_F + (size_t)NT * DM * 4;
constexpr size_t WS_USC = WS_BAR + 2048;
constexpr size_t WS_VSC = WS_USC + (size_t)16384 * 4;
constexpr size_t WS_CBP = WS_VSC + (size_t)16384 * 4;
constexpr size_t WS_CBS = WS_CBP + (size_t)128 * 2048 * 4;
constexpr size_t WS_SSQ = WS_CBS + (size_t)128 * 4160 * 4;
constexpr size_t WS_XBAR = WS_SSQ + (size_t)NT * 2 * 4;
constexpr size_t WS_TOTAL = WS_XBAR + 16384;

struct Params {
  const float *x_prompt, *x_sample, *mem_prompt, *c_sb_k, *c_sb_v, *c_fx_k, *c_fx_v, *c_fx_logf, *c_mem_k, *c_mem_v;
  const float *w_in, *b_f, *w_gn, *w_out, *ln1_g, *ln1_b, *w_mq, *w_mk, *w_mv, *w_mo, *ln2_g, *ln2_b;
  const float *w_pq, *keys_a, *keys_b, *peer_u, *peer_v, *ln3_g, *ln3_b;
  float* out;
  char* ws;
};

DI const Params* kparams() { auto ka = __builtin_amdgcn_kernarg_segment_ptr(); asm volatile("" : "+s"(ka)); return (const Params*)ka; }
constexpr int SMEM_BYTES = 73728 + 1024 + 64;

DI unsigned pk2(float a, float b) { f2_t v = {a, b}; bf2_t r = __builtin_convertvector(v, bf2_t); return __builtin_bit_cast(unsigned, r); }
DI u16 bf1(float a) { return (u16)(pk2(a, 0.f) & 0xffffu); }
DI float bflo(unsigned w) { return __uint_as_float(w << 16); }
DI float bfhi(unsigned w) { return __uint_as_float(w & 0xffff0000u); }
DI float wave_sum(float v) {
#pragma unroll
  for (int o = 32; o >= 1; o >>= 1) v += __shfl_xor(v, o);
  return v;
}
DI float wave_max(float v) {
#pragma unroll
  for (int o = 32; o >= 1; o >>= 1) v = fmaxf(v, __shfl_xor(v, o));
  return v;
}
DI int vblock() { int nb = gridDim.x, b = blockIdx.x; return ((nb & 7) == 0) ? (b & 7) * (nb >> 3) + (b >> 3) : b; }
DI const float* xrow(const Params& p, int g) { return g < NTP ? p.x_prompt + (size_t)g * DM : p.x_sample + (size_t)(g - NTP) * DM; }

DI void tconv_tile(const float* src, int ldsrc, int C, u16* dst, int lddst, const float* rowscale, int tr, int tc, float* tile) {
  const int tid = threadIdx.x;
  {
    const int r = tid >> 2, c0 = (tid & 3) * 16;
    const int gr = tr * 64 + r;
    const float sc = rowscale ? rowscale[gr] : 1.f;
#pragma unroll
    for (int j = 0; j < 4; ++j) {
      const int gc = tc * 64 + c0 + 4 * j;
      float4 v = make_float4(0.f, 0.f, 0.f, 0.f);
      if (gc < C) v = *(const float4*)(src + (size_t)gr * ldsrc + gc);
      float* t = tile + r * 65 + c0 + 4 * j;
      t[0] = v.x * sc; t[1] = v.y * sc; t[2] = v.z * sc; t[3] = v.w * sc;
    }
  }
  __syncthreads();
  {
    const int n = tid >> 2, k0 = (tid & 3) * 16;
    unsigned w[8];
#pragma unroll
    for (int e = 0; e < 8; ++e) w[e] = pk2(tile[(k0 + 2 * e) * 65 + n], tile[(k0 + 2 * e + 1) * 65 + n]);
    uint4* d = (uint4*)(dst + (size_t)(tc * 64 + n) * lddst + tr * 64 + k0);
    d[0] = make_uint4(w[0], w[1], w[2], w[3]);
    d[1] = make_uint4(w[4], w[5], w[6], w[7]);
  }
  __syncthreads();
}

DI void conv_range(const float* src, u16* dst, size_t n8, int bid, int nb) {
  const size_t step = (size_t)nb * 256;
  size_t i = (size_t)bid * 256 + threadIdx.x;
  for (; i + 3 * step < n8; i += 4 * step) {
    float4 a[4], b[4];
#pragma unroll
    for (int u = 0; u < 4; ++u) { a[u] = ((const float4*)src)[2 * (i + u * step)]; b[u] = ((const float4*)src)[2 * (i + u * step) + 1]; }
#pragma unroll
    for (int u = 0; u < 4; ++u) ((uint4*)dst)[i + u * step] = make_uint4(pk2(a[u].x, a[u].y), pk2(a[u].z, a[u].w), pk2(b[u].x, b[u].y), pk2(b[u].z, b[u].w));
  }
  for (; i < n8; i += step) {
    const float4 a = ((const float4*)src)[2 * i], b = ((const float4*)src)[2 * i + 1];
    ((uint4*)dst)[i] = make_uint4(pk2(a.x, a.y), pk2(a.z, a.w), pk2(b.x, b.y), pk2(b.z, b.w));
  }
}

DI void phase_prep(const Params& p, char* smem) {
  float* tile = (float*)smem;
  const int bid = blockIdx.x, nb = gridDim.x;
  u16* ws16 = (u16*)p.ws;
  constexpr int T_WIN = 16 * 50, T_SQ = 256, T_PQ = 16 * 32, T_MV = 16 * 4 * 16;
  constexpr int T0 = T_WIN, T1 = T0 + T_SQ, T2 = T1 + T_SQ, T3 = T2 + T_SQ, T4 = T3 + T_SQ, T5 = T4 + T_SQ, T6 = T5 + T_PQ, T7 = T6 + T_MV;
  for (int t = bid; t < T7; t += nb) {
    if (t < T0) { tconv_tile(p.w_in, INC, INC, (u16*)(p.ws + WS_WIN), DM, nullptr, t / 50, t % 50, tile); }
    else if (t < T1) { int u = t - T0; tconv_tile(p.w_out, DM, DM, (u16*)(p.ws + WS_WOUT), DM, p.w_gn, u >> 4, u & 15, tile); }
    else if (t < T2) { int u = t - T1; tconv_tile(p.w_mq, DM, DM, (u16*)(p.ws + WS_WMQ), DM, nullptr, u >> 4, u & 15, tile); }
    else if (t < T3) { int u = t - T2; tconv_tile(p.w_mk, DM, DM, (u16*)(p.ws + WS_WMKV), DM, nullptr, u >> 4, u & 15, tile); }
    else if (t < T4) { int u = t - T3; tconv_tile(p.w_mv, DM, DM, (u16*)(p.ws + WS_WMKV) + (size_t)DM * DM, DM, nullptr, u >> 4, u & 15, tile); }
    else if (t < T5) { int u = t - T4; tconv_tile(p.w_mo, DM, DM, (u16*)(p.ws + WS_WMO), DM, nullptr, u >> 4, u & 15, tile); }
    else if (t < T6) { int u = t - T5; tconv_tile(p.w_pq, 2048, 2048, (u16*)(p.ws + WS_WPQ), DM, nullptr, u >> 5, u & 31, tile); }
    else { int u = t - T6; int b = u >> 6, r = u & 63;
      tconv_tile(p.c_mem_v + (size_t)b * 256 * DM, DM, DM, (u16*)(p.ws + WS_MEMVT) + (size_t)(16 + b) * DM * 256, 256, nullptr, r >> 4, r & 15, tile); }
  }
  (void)ws16;
  for (int i = bid * 256 + threadIdx.x; i < NT * 2; i += nb * 256) ((float*)(p.ws + WS_SSQ))[i] = 0.f;
  conv_range(p.x_prompt, (u16*)(p.ws + WS_C), (size_t)NTP * DM / 8, bid, nb);
  conv_range(p.x_sample, (u16*)(p.ws + WS_C) + (size_t)NTP * DM, (size_t)NTS * DM / 8, bid, nb);
  conv_range(p.mem_prompt, (u16*)(p.ws + WS_E), (size_t)4096 * DM / 8, bid, nb);
  conv_range(p.c_mem_k, (u16*)(p.ws + WS_MEMK) + (size_t)16 * 256 * DM, (size_t)16 * 256 * DM / 8, bid, nb);
  conv_range(p.keys_a, (u16*)(p.ws + WS_KA), (size_t)8 * 128 * 128 / 8, bid, nb);
  conv_range(p.keys_b, (u16*)(p.ws + WS_KB), (size_t)8 * 128 * 128 / 8, bid, nb);
#if USE_FP8
  {
    const int lane = threadIdx.x & 63;
    const int wg = bid * 4 + (threadIdx.x >> 6), nw = nb * 4;
    for (int row0 = wg; row0 < 32768; row0 += 2 * nw) {
      float4 a[2][4];
      float am[2];
#pragma unroll
      for (int u = 0; u < 2; ++u) {
        const int row = row0 + u * nw;
        const bool isv = row >= 16384;
        const int r = isv ? row - 16384 : row;
        const float4* src = (const float4*)((isv ? p.peer_v : p.peer_u) + (size_t)r * DM) + 4 * lane;
        am[u] = 0.f;
#pragma unroll
        for (int j = 0; j < 4; ++j) { a[u][j] = src[j]; am[u] = fmaxf(am[u], fmaxf(fmaxf(fabsf(a[u][j].x), fabsf(a[u][j].y)), fmaxf(fabsf(a[u][j].z), fabsf(a[u][j].w)))); }
      }
#pragma unroll
      for (int o = 32; o >= 1; o >>= 1)
#pragma unroll
        for (int u = 0; u < 2; ++u) am[u] = fmaxf(am[u], __shfl_xor(am[u], o));
#pragma unroll
      for (int u = 0; u < 2; ++u) {
        const int row = row0 + u * nw;
        const bool isv = row >= 16384;
        const int r = isv ? row - 16384 : row;
        int ex = 0;
        if (am[u] > 0.f) (void)frexpf(am[u], &ex);
        const float sc = ldexpf(1.f, 8 - ex), isc = ldexpf(1.f, ex - 8);
        unsigned w[4];
#pragma unroll
        for (int j = 0; j < 4; ++j) {
          int t = __builtin_amdgcn_cvt_pk_fp8_f32(a[u][j].x * sc, a[u][j].y * sc, 0, false);
          t = __builtin_amdgcn_cvt_pk_fp8_f32(a[u][j].z * sc, a[u][j].w * sc, t, true);
          w[j] = (unsigned)t;
        }
        *(uint4*)(p.ws + (isv ? WS_V : WS_U) + (size_t)r * DM + 16 * lane) = make_uint4(w[0], w[1], w[2], w[3]);
        if (lane == 0) ((float*)(p.ws + (isv ? WS_VSC : WS_USC)))[r] = isc;
      }
    }
  }
#else
  conv_range(p.peer_u, (u16*)(p.ws + WS_U), (size_t)16384 * DM / 8, bid, nb);
  conv_range(p.peer_v, (u16*)(p.ws + WS_V), (size_t)16384 * DM / 8, bid, nb);
#endif
}

#define ACC_ROW(e, hh) (((e) & 3) + 8 * ((e) >> 2) + 4 * (hh))
#define ACC_R0(e) (((e) & 3) + 8 * ((e) >> 2))
DI void store_bf16_pairs(u16* O, unsigned b0, unsigned ld, const f32x16& acc, float scale) {
  const bool odd = (threadIdx.x & 1) != 0;
#pragma unroll
  for (int e = 0; e < 16; e += 2) {
    const float a = acc[e] * scale, b = acc[e + 1] * scale;
    const float snd = odd ? a : b;
    const float rcv = __int_as_float(__builtin_amdgcn_update_dpp(0, __float_as_int(snd), 0xB1, 0xF, 0xF, true));
    const unsigned w = odd ? pk2(rcv, b) : pk2(a, rcv);
    const unsigned idx = b0 + (ACC_R0(e) + (odd ? 1u : 0u)) * ld - (odd ? 1u : 0u);
    *(unsigned*)(O + idx) = w;
  }
}
template <int V> struct IC { static constexpr int value = V; };
struct SmemGemm { u16 a[2][128 * 64]; u16 b[2][128 * 64]; };

template <int ROWS>
struct GldsBf16 {
  const u16* base; int ld;
  DI void issue(int kt, u16* lds, int tid) {
    const int wid = tid >> 6, lane = tid & 63;
    constexpr int NCH = ROWS / 32;
#pragma unroll
    for (int q = 0; q < NCH; ++q) {
      const int ch = wid * NCH + q;
      const int r = ch * 8 + (lane >> 3);
      const int c = (lane & 7) ^ ((r >> 1) & 7);
      __builtin_amdgcn_global_load_lds((const unsigned*)(base + (size_t)r * ld + kt * 64 + c * 8), (unsigned*)(lds + ch * 512), 16, 0, 0);
    }
  }
  DI void commit(u16*, int) {}
};
#ifndef GEMM_REG2
#define GEMM_REG2 1
#endif
#if GEMM_REG2
typedef unsigned u32x4 __attribute__((ext_vector_type(4)));
template <int ROWS>
struct LdReg {
  static constexpr int N = ROWS / 32;
  const u16* base; int ld;
  u32x4 r0, r1, r2, r3;
  DI const u32x4* src(int kt, int tid, int i) const { const int c = tid + 256 * i; return (const u32x4*)(base + (size_t)(c >> 3) * ld + kt * 64 + (c & 7) * 8); }
  DI static u32x4* dst(u16* lds, int tid, int i) { const int c = tid + 256 * i; const int row = c >> 3; return (u32x4*)(lds + row * 64 + (((c & 7) ^ ((row >> 1) & 7)) * 8)); }
  DI void fetch(int kt, int tid) {
    r0 = *src(kt, tid, 0); r1 = *src(kt, tid, 1);
    if (N > 2) { r2 = *src(kt, tid, 2); r3 = *src(kt, tid, 3); }
  }
  DI void stash(u16* lds, int tid) const {
    *dst(lds, tid, 0) = r0; *dst(lds, tid, 1) = r1;
    if (N > 2) { *dst(lds, tid, 2) = r2; *dst(lds, tid, 3) = r3; }
  }
};
template <int MI, bool GRMS>
DI void gemm_compute(const u16* pa, const u16* pb, f32x16 (&acc)[MI][MI], int o0, int o1, int o2, int o3, int wr, int hh, bool scale_now, const float* rsc) {
  if (GRMS && scale_now) {
#pragma unroll
    for (int i = 0; i < MI; ++i)
#pragma unroll
      for (int e = 0; e < 16; ++e) {
        const float rt = rsc[((wr * MI + i) * 32 + ACC_ROW(e, hh)) * 2];
#pragma unroll
        for (int j = 0; j < MI; ++j) acc[i][j][e] *= rt;
      }
  }
  const int off[4] = {o0, o1, o2, o3};
  bf16x8 af[2][MI], bfr[2][MI];
#pragma unroll
  for (int i = 0; i < MI; ++i) { af[0][i] = *(const bf16x8*)(pa + i * 32 * 64 + off[0]); bfr[0][i] = *(const bf16x8*)(pb + i * 32 * 64 + off[0]); }
#pragma unroll
  for (int kk = 0; kk < 4; ++kk) {
    if (kk < 3) {
#pragma unroll
      for (int i = 0; i < MI; ++i) { af[(kk + 1) & 1][i] = *(const bf16x8*)(pa + i * 32 * 64 + off[kk + 1]); bfr[(kk + 1) & 1][i] = *(const bf16x8*)(pb + i * 32 * 64 + off[kk + 1]); }
    }
#pragma unroll
    for (int i = 0; i < MI; ++i)
#pragma unroll
      for (int j = 0; j < MI; ++j) acc[i][j] = MFMA(af[kk & 1][i], bfr[kk & 1][j], acc[i][j]);
  }
}
template <int MI, bool GRMS = false, class AL, class EPI>
DI void gemm_tile(AL& al, const u16* Bt, int ldb, int K, int m0, int n0, EPI epi, char* smem, const float* rsc = nullptr) {
  SmemGemm& sm = *(SmemGemm*)smem;
  const int tid = threadIdx.x, lane = tid & 63, wid = tid >> 6, wr = wid >> 1, wc = wid & 1, r31 = lane & 31, hh = lane >> 5;
  LdReg<MI * 64> a0, a1, b0, b1;
  a0.base = al.base; a0.ld = al.ld; a1.base = al.base; a1.ld = al.ld;
  b0.base = Bt + (size_t)n0 * ldb; b0.ld = ldb; b1.base = b0.base; b1.ld = ldb;
  f32x16 acc[MI][MI];
#pragma unroll
  for (int i = 0; i < MI; ++i)
#pragma unroll
    for (int j = 0; j < MI; ++j)
#pragma unroll
      for (int e = 0; e < 16; ++e) acc[i][j][e] = 0.f;
  int off[4];
#pragma unroll
  for (int kk = 0; kk < 4; ++kk) off[kk] = r31 * 64 + (((kk * 2 + hh) ^ ((r31 >> 1) & 7)) * 8);
  const int KT = K >> 6;
  a0.fetch(0, tid); b0.fetch(0, tid);
  a1.fetch(1, tid); b1.fetch(1, tid);
  a0.stash(sm.a[0], tid); b0.stash(sm.b[0], tid);
  __syncthreads();
  for (int kt = 0; kt < KT; kt += 2) {
    { const int kn = min(kt + 2, KT - 1); a0.fetch(kn, tid); b0.fetch(kn, tid); }
    gemm_compute<MI, GRMS>(sm.a[0] + (wr * MI * 32) * 64, sm.b[0] + (wc * MI * 32) * 64, acc, off[0], off[1], off[2], off[3], wr, hh, kt == (KT >> 1), rsc);
    a1.stash(sm.a[1], tid); b1.stash(sm.b[1], tid);
    __syncthreads();
    { const int kn = min(kt + 3, KT - 1); a1.fetch(kn, tid); b1.fetch(kn, tid); }
    gemm_compute<MI, GRMS>(sm.a[1] + (wr * MI * 32) * 64, sm.b[1] + (wc * MI * 32) * 64, acc, off[0], off[1], off[2], off[3], wr, hh, (kt + 1) == (KT >> 1), rsc);
    a0.stash(sm.a[0], tid); b0.stash(sm.b[0], tid);
    __syncthreads();
  }
  if (GRMS) {
#pragma unroll
    for (int i = 0; i < MI; ++i)
#pragma unroll
      for (int e = 0; e < 16; ++e) {
        const float s1 = rsc[((wr * MI + i) * 32 + ACC_ROW(e, hh)) * 2 + 1];
#pragma unroll
        for (int j = 0; j < MI; ++j) acc[i][j][e] *= s1;
      }
  }
#pragma unroll
  for (int i = 0; i < MI; ++i)
#pragma unroll
    for (int j = 0; j < MI; ++j) epi(m0 + (wr * MI + i) * 32, n0 + (wc * MI + j) * 32, acc[i][j]);
}
#else
template <int MI, bool GRMS = false, class AL, class EPI>
DI void gemm_tile(AL& al, const u16* Bt, int ldb, int K, int m0, int n0, EPI epi, char* smem, const float* rsc = nullptr) {
  SmemGemm& sm = *(SmemGemm*)smem;
  const int tid = threadIdx.x, lane = tid & 63, wid = tid >> 6, wr = wid >> 1, wc = wid & 1, r31 = lane & 31, hh = lane >> 5;
  GldsBf16<MI * 64> bl; bl.base = Bt + (size_t)n0 * ldb; bl.ld = ldb;
  f32x16 acc[MI][MI];
#pragma unroll
  for (int i = 0; i < MI; ++i)
#pragma unroll
    for (int j = 0; j < MI; ++j)
#pragma unroll
      for (int e = 0; e < 16; ++e) acc[i][j][e] = 0.f;
  int off[4];
#pragma unroll
  for (int kk = 0; kk < 4; ++kk) off[kk] = r31 * 64 + (((kk * 2 + hh) ^ ((r31 >> 1) & 7)) * 8);
  const int KT = K >> 6;
  al.issue(0, sm.a[0], tid); bl.issue(0, sm.b[0], tid);
  al.commit(sm.a[0], tid);
  asm volatile("s_waitcnt vmcnt(0)" ::: "memory");
  __syncthreads();
  for (int kt = 0; kt < KT; ++kt) {
    const int cur = kt & 1;
    if (kt + 1 < KT) { al.issue(kt + 1, sm.a[cur ^ 1], tid); bl.issue(kt + 1, sm.b[cur ^ 1], tid); }
    const u16* pa = sm.a[cur] + (wr * MI * 32) * 64;
    const u16* pb = sm.b[cur] + (wc * MI * 32) * 64;
    if (GRMS && kt == (KT >> 1)) {
#pragma unroll
      for (int i = 0; i < MI; ++i)
#pragma unroll
        for (int e = 0; e < 16; ++e) {
          const float rt = rsc[((wr * MI + i) * 32 + ACC_ROW(e, hh)) * 2];
#pragma unroll
          for (int j = 0; j < MI; ++j) acc[i][j][e] *= rt;
        }
    }
#pragma unroll
    for (int kk = 0; kk < 4; ++kk) {
      bf16x8 af[MI], bfr[MI];
#pragma unroll
      for (int i = 0; i < MI; ++i) { af[i] = *(const bf16x8*)(pa + i * 32 * 64 + off[kk]); bfr[i] = *(const bf16x8*)(pb + i * 32 * 64 + off[kk]); }
#pragma unroll
      for (int i = 0; i < MI; ++i)
#pragma unroll
        for (int j = 0; j < MI; ++j) acc[i][j] = MFMA(af[i], bfr[j], acc[i][j]);
    }
    if (kt + 1 < KT) al.commit(sm.a[cur ^ 1], tid);
    asm volatile("s_waitcnt vmcnt(0)" ::: "memory");
    __syncthreads();
  }
  if (GRMS) {
#pragma unroll
    for (int i = 0; i < MI; ++i)
#pragma unroll
      for (int e = 0; e < 16; ++e) {
        const float s1 = rsc[((wr * MI + i) * 32 + ACC_ROW(e, hh)) * 2 + 1];
#pragma unroll
        for (int j = 0; j < MI; ++j) acc[i][j][e] *= s1;
      }
  }
#pragma unroll
  for (int i = 0; i < MI; ++i)
#pragma unroll
    for (int j = 0; j < MI; ++j) epi(m0 + (wr * MI + i) * 32, n0 + (wc * MI + j) * 32, acc[i][j]);
}
#endif
template <class F>
DI void for_tiles(int N, F body) {
  const int vb = vblock(), nb = gridDim.x;
  const int ntn = N >> 7, ntn2 = N >> 6;
  const int nbig = 256 * ntn, nsmall = 16 * ntn2;
  for (int t = vb; t < nbig + nsmall; t += nb) {
    if (t < nbig) { body((t / ntn) * 128, (t % ntn) * 128, IC<2>{}); }
    else { const int u = t - nbig; body(NTP + (u / ntn2) * 64, (u % ntn2) * 64, IC<1>{}); }
  }
}

DI void phase_proj(const Params& p, char* smem) {
  const int vb = vblock(), nb = gridDim.x;
  constexpr int T_G1 = 264 * 25, T_MKV = 32 * 16;
  float* out = p.out;
  for (int t = vb; t < T_G1 + T_MKV; t += nb) {
    if (t < T_G1) {
      const int mt = t / 25, nt = t % 25;
      const int m0 = mt * 128, n0 = nt * 128;
      GldsBf16<128> al; al.base = (const u16*)(p.ws + WS_C) + (size_t)m0 * DM; al.ld = DM;
      const bool smp = m0 >= NTP;
      const float* b_f = p.b_f;
      u16* qsb = (u16*)(p.ws + WS_D);
      u16* qfx = qsb + (size_t)NT * 512;
      char* ws = p.ws;
      auto epi = [=](int r0, int c0, const f32x16& acc) {
        const int lane = threadIdx.x & 63, hh = lane >> 5, col = c0 + (lane & 31);
        const int seg = c0 >> 9, cc = col & 511;
        if (seg == 0 || seg == 3) {
          u16* q = (seg == 0) ? qsb : qfx;
#pragma unroll
          for (int e = 0; e < 16; ++e) q[(unsigned)(r0 + 4 * hh) * 512u + cc + ACC_R0(e) * 512u] = bf1(acc[e] * 0.125f);
        } else if (seg < 6) {
          size_t ob;
          if (!smp) ob = (seg == 1) ? OUT_SBK_P : (seg == 2) ? OUT_SBV_P : (seg == 4) ? OUT_FXK_P : OUT_FXV_P;
          else ob = (seg == 1) ? OUT_SBK_S : (seg == 2) ? OUT_SBV_S : (seg == 4) ? OUT_FXK_S : OUT_FXV_S;
          const int rb = smp ? r0 - NTP : r0;
          float* ov = out + ob;
          const unsigned b0 = (unsigned)(rb + 4 * hh) * 512u + cc;
#pragma unroll
          for (int e = 0; e < 16; ++e) ov[b0 + ACC_R0(e) * 512u] = acc[e];
          if (!smp) {
            if (seg == 1 || seg == 4) {
              u16* k16 = (u16*)(ws + WS_A) + (seg == 4 ? (size_t)NTP * 512 : 0);
#pragma unroll
              for (int e = 0; e < 16; ++e) k16[b0 + ACC_R0(e) * 512u] = bf1(acc[e]);
            } else {
              u16* vt16 = (u16*)(ws + WS_B) + (seg == 5 ? (size_t)NTP * 512 : 0);
              const unsigned vb0 = (unsigned)(((r0 >> 11) * 8 + (cc >> 6)) * 64 + (cc & 63)) * 2048u + (unsigned)(r0 & 2047) + 4 * hh;
#pragma unroll
              for (int g4 = 0; g4 < 4; ++g4) *(uint2*)(vt16 + vb0 + 8 * g4) = make_uint2(pk2(acc[4 * g4], acc[4 * g4 + 1]), pk2(acc[4 * g4 + 2], acc[4 * g4 + 3]));
            }
          }
        } else {
          const int c = col - 3072;
          if (c < 8) {
            const float bf = b_f[c];
            const size_t ob = smp ? OUT_LF_S : OUT_LF_P;
            const int rb = smp ? r0 - NTP : r0;
#pragma unroll
            for (int e = 0; e < 16; ++e) {
              const float z = acc[e] + bf;
              const float ls = fminf(z, 0.f) - log1pf(__expf(-fabsf(z)));
              out[ob + (unsigned)(rb + ACC_ROW(e, hh)) * 8u + c] = ls;
            }
          }
        }
      };
      gemm_tile<2>(al, (const u16*)(p.ws + WS_WIN), DM, DM, m0, n0, epi, smem);
    } else {
      const int u = t - T_G1;
      const int mt = u >> 4, nt = u & 15;
      const int m0 = mt * 128, n0 = nt * 128;
      GldsBf16<128> al; al.base = (const u16*)(p.ws + WS_E) + (size_t)m0 * DM; al.ld = DM;
      u16* kb = (u16*)(p.ws + WS_MEMK);
      u16* vt = (u16*)(p.ws + WS_MEMVT);
      auto epi = [=](int r0, int c0, const f32x16& acc) {
        const int lane = threadIdx.x & 63, hh = lane >> 5, col = c0 + (lane & 31);
        if (c0 < 1024) {
          float* ov = out + OUT_MK_P;
          const unsigned b0 = (unsigned)(r0 + 4 * hh) * 1024u + col;
#pragma unroll
          for (int e = 0; e < 16; ++e) { const unsigned idx = b0 + ACC_R0(e) * 1024u; ov[idx] = acc[e]; kb[idx] = bf1(acc[e]); }
        } else {
          const int c = col - 1024;
          float* ov = out + OUT_MV_P;
          const unsigned b0 = (unsigned)(r0 + 4 * hh) * 1024u + c;
#pragma unroll
          for (int e = 0; e < 16; ++e) ov[b0 + ACC_R0(e) * 1024u] = acc[e];
          const int b = r0 >> 8;
#pragma unroll
          for (int g4 = 0; g4 < 4; ++g4) {
            const int m = (r0 & 255) + 8 * g4 + 4 * hh;
            *(uint2*)(vt + ((size_t)b * DM + c) * 256 + m) = make_uint2(pk2(acc[4 * g4], acc[4 * g4 + 1]), pk2(acc[4 * g4 + 2], acc[4 * g4 + 3]));
          }
        }
      };
      gemm_tile<2>(al, (const u16*)(p.ws + WS_WMKV), DM, DM, m0, n0, epi, smem);
    }
  }
}

template <int PER>
DI void scan_one(const float* src0, int n0, const float* src1, int n, float* dst, float* part) {
  const int tid = threadIdx.x;
  const int s0 = tid * PER;
  float v[PER];
#pragma unroll
  for (int i = 0; i < PER; ++i) { const int s = s0 + i; v[i] = (s < n) ? ((s < n0) ? src0[(size_t)s * 8] : src1[(size_t)(s - n0) * 8]) : 0.f; }
  float loc = 0.f;
#pragma unroll
  for (int i = 0; i < PER; ++i) loc += v[i];
  part[tid] = loc;
  __syncthreads();
  float run = 0.f;
  for (int i = 0; i < tid; ++i) run += part[i];
#pragma unroll
  for (int i = 0; i < PER; ++i) { run += v[i]; if (s0 + i < n) dst[s0 + i] = -run * LOG2E; }
  __syncthreads();
}
DI void phase_scan(const Params& p, char* smem) {
  float* part = (float*)smem;
  for (int it = blockIdx.x; it < 256; it += gridDim.x) {
    const int bh = it & 127, b = bh >> 3, h = bh & 7;
    if (it < 128) scan_one<17>(p.c_fx_logf + (size_t)b * PAST * 8 + h, PAST, p.out + OUT_LF_S + (size_t)b * DSEQ * 8 + h, PAST + DSEQ, (float*)(p.ws + WS_CBS) + (size_t)bh * 4160, part);
    else scan_one<8>(p.out + OUT_LF_P + (size_t)b * SEQ * 8 + h, SEQ, nullptr, SEQ, (float*)(p.ws + WS_CBP) + (size_t)bh * 2048, part);
  }
}

constexpr int KLD = 72, VLD = 68;
struct SmemAttn { u16 k[2][64 * KLD]; u16 vt[2][64 * VLD]; float cb[4160]; float part[256]; u16 q[128 * KLD]; };
static_assert(sizeof(SmemAttn) <= SMEM_BYTES, "attn smem");

struct KVRegs { float4 k[4], v[4]; };
DI void kv_fetch(KVRegs& r, const float* kb, const float* vb, int tid) {
#pragma unroll
  for (int i = 0; i < 4; ++i) { const int c = tid + 256 * i; const size_t o = (size_t)(c >> 4) * 512 + (c & 15) * 4; r.k[i] = *(const float4*)(kb + o); r.v[i] = *(const float4*)(vb + o); }
}
DI void kv_stash(const KVRegs& r, u16* ks, u16* vts, int tid) {
#pragma unroll
  for (int i = 0; i < 4; ++i) {
    const int c = tid + 256 * i; const int row = c >> 4, c4 = (c & 15) * 4;
    *(uint2*)(ks + row * KLD + c4) = make_uint2(pk2(r.k[i].x, r.k[i].y), pk2(r.k[i].z, r.k[i].w));
    vts[(c4 + 0) * VLD + row] = bf1(r.v[i].x); vts[(c4 + 1) * VLD + row] = bf1(r.v[i].y);
    vts[(c4 + 2) * VLD + row] = bf1(r.v[i].z); vts[(c4 + 3) * VLD + row] = bf1(r.v[i].w);
  }
}
typedef unsigned kv_u32x4 __attribute__((ext_vector_type(4)));
typedef unsigned kv_u32x2 __attribute__((ext_vector_type(2)));
struct KV16 { kv_u32x4 k0, k1, v0, v1; };
DI void kv_fetch16(KV16& r, const u16* kb, const u16* vtb, int tid) {
  const int c0 = tid, c1 = tid + 256;
  r.k0 = *(const kv_u32x4*)(kb + (size_t)(c0 >> 3) * 512 + (c0 & 7) * 8); r.k1 = *(const kv_u32x4*)(kb + (size_t)(c1 >> 3) * 512 + (c1 & 7) * 8);
  r.v0 = *(const kv_u32x4*)(vtb + (size_t)(c0 >> 3) * SEQ + (c0 & 7) * 8); r.v1 = *(const kv_u32x4*)(vtb + (size_t)(c1 >> 3) * SEQ + (c1 & 7) * 8);
}
DI void kv_stash16(const KV16& r, u16* ks, u16* vts, int tid) {
  const int c0 = tid, c1 = tid + 256;
  *(kv_u32x4*)(ks + (c0 >> 3) * KLD + (c0 & 7) * 8) = r.k0;
  *(kv_u32x4*)(ks + (c1 >> 3) * KLD + (c1 & 7) * 8) = r.k1;
  kv_u32x2 a = {r.v0[0], r.v0[1]}, b2 = {r.v0[2], r.v0[3]}, c = {r.v1[0], r.v1[1]}, d = {r.v1[2], r.v1[3]};
  *(kv_u32x2*)(vts + (c0 >> 3) * VLD + (c0 & 7) * 8) = a; *(kv_u32x2*)(vts + (c0 >> 3) * VLD + (c0 & 7) * 8 + 4) = b2;
  *(kv_u32x2*)(vts + (c1 >> 3) * VLD + (c1 & 7) * 8) = c; *(kv_u32x2*)(vts + (c1 >> 3) * VLD + (c1 & 7) * 8 + 4) = d;
}
DI bf16x8 pack8(const f32x16& x, int s) {
  union { unsigned u[4]; bf16x8 v; } t;
  t.u[0] = pk2(x[8 * s + 0], x[8 * s + 1]); t.u[1] = pk2(x[8 * s + 2], x[8 * s + 3]);
  t.u[2] = pk2(x[8 * s + 4], x[8 * s + 5]); t.u[3] = pk2(x[8 * s + 6], x[8 * s + 7]);
  return t.v;
}

template <bool FOX, bool SMP>
DI void attn_item(const Params& p, int b, int h, int qb, char* smem, bool do_ssq = true, int split = 0) {
  constexpr int smp = SMP ? 1 : 0;
  constexpr bool SPLIT = FOX && SMP;
  SmemAttn& sm = *(SmemAttn*)smem;
  const int tid = threadIdx.x, lane = tid & 63, wid = tid >> 6, r31 = lane & 31, hh = lane >> 5;
  const int jt0 = SPLIT ? split * 8 : 0;
  const int nkt = SPLIT ? (split == 7 ? 9 : 8) : (smp ? 65 : 2 * qb + 2);
  const int jdiag = smp ? 64 : 2 * qb;
  int qi = wid * 32 + r31; if (smp) qi &= 63;
  const int qpos = (smp ? PAST : qb * 128) + qi;
  const int g = smp ? NTP + b * DSEQ + qi : b * SEQ + qb * 128 + qi;
  const u16* Q = (const u16*)(p.ws + WS_D) + (FOX ? (size_t)NT * 512 : 0);
  {
#pragma unroll
    for (int i = 0; i < 4; ++i) {
      const int c = tid + 256 * i; const int row = c >> 3, kc = (c & 7) * 8;
      const int qr = smp ? (row & 63) : row;
      const int gr = smp ? NTP + b * DSEQ + qr : b * SEQ + qb * 128 + qr;
      *(kv_u32x4*)(sm.q + row * KLD + kc) = *(const kv_u32x4*)(Q + (size_t)gr * 512 + h * 64 + kc);
    }
    __syncthreads();
  }

  const float* kcache = FOX ? p.c_fx_k : p.c_sb_k;
  const float* vcache = FOX ? p.c_fx_v : p.c_sb_v;
  const size_t okp = FOX ? OUT_FXK_P : OUT_SBK_P, ovp = FOX ? OUT_FXV_P : OUT_SBV_P;
  const size_t oks = FOX ? OUT_FXK_S : OUT_SBK_S, ovs = FOX ? OUT_FXV_S : OUT_SBV_S;
  auto kptr = [&](int j) -> const float* {
    if (!smp) return p.out + okp + ((size_t)(b * SEQ + 64 * j) * 512 + h * 64);
    if (j < 64) return kcache + ((size_t)(b * PAST + 64 * j) * 512 + h * 64);
    return p.out + oks + ((size_t)(b * DSEQ) * 512 + h * 64);
  };
  auto vptr = [&](int j) -> const float* {
    if (!smp) return p.out + ovp + ((size_t)(b * SEQ + 64 * j) * 512 + h * 64);
    if (j < 64) return vcache + ((size_t)(b * PAST + 64 * j) * 512 + h * 64);
    return p.out + ovs + ((size_t)(b * DSEQ) * 512 + h * 64);
  };

  if (FOX) {
    const float4* src = (const float4*)(smp ? (const float*)(p.ws + WS_CBS) + (size_t)(b * 8 + h) * 4160 : (const float*)(p.ws + WS_CBP) + (size_t)(b * 8 + h) * 2048);
    for (int i = jt0 * 16 + tid; i < (jt0 + nkt) * 16; i += 256) ((float4*)sm.cb)[i] = src[i];
    __syncthreads();
  }

  bf16x8 tri[2];
  if (!FOX) {
#pragma unroll
    for (int s = 0; s < 2; ++s)
#pragma unroll
      for (int j = 0; j < 8; ++j) { const int kin = 16 * s + 8 * (j >> 2) + 4 * hh + (j & 3); tri[s][j] = (kin >= r31) ? (short)0x3F80 : (short)0; }
  }

  f32x16 o[2];
#pragma unroll
  for (int d = 0; d < 2; ++d)
#pragma unroll
    for (int e = 0; e < 16; ++e) o[d][e] = 0.f;
  float mrun = -1e30f, lrun = 0.f, R = 0.f;

  KVRegs kv;
  KV16 kw;
  const int jfirst = FOX ? jt0 : nkt - 1;
  const u16* k16 = (const u16*)(p.ws + WS_A) + (FOX ? (size_t)NTP * 512 : 0) + (size_t)(b * SEQ) * 512 + h * 64;
  const u16* vt16 = (const u16*)(p.ws + WS_B) + (FOX ? (size_t)NTP * 512 : 0) + (size_t)((b * 8 + h) * 64) * SEQ;
  if (smp) { kv_fetch(kv, kptr(jfirst), vptr(jfirst), tid); kv_stash(kv, sm.k[0], sm.vt[0], tid); }
  else { kv_fetch16(kw, k16 + (size_t)(64 * jfirst) * 512, vt16 + 64 * jfirst, tid); kv_stash16(kw, sm.k[0], sm.vt[0], tid); }
  __syncthreads();
  for (int it = 0; it < nkt; ++it) {
    const int j = FOX ? jt0 + it : nkt - 1 - it;
    const int cur = it & 1;
    if (it + 1 < nkt) { const int jn = FOX ? j + 1 : j - 1; if (smp) kv_fetch(kv, kptr(jn), vptr(jn), tid); else kv_fetch16(kw, k16 + (size_t)(64 * jn) * 512, vt16 + 64 * jn, tid); }
    f32x16 s[2];
#pragma unroll
    for (int t2 = 0; t2 < 2; ++t2) {
#pragma unroll
      for (int e = 0; e < 16; ++e) s[t2][e] = 0.f;
      const u16* pk = sm.k[cur] + (t2 * 32 + r31) * KLD + hh * 8;
      const u16* pq = sm.q + (wid * 32 + r31) * KLD + hh * 8;
#pragma unroll
      for (int kk = 0; kk < 4; ++kk) { const bf16x8 a = *(const bf16x8*)(pk + kk * 16); const bf16x8 qv = *(const bf16x8*)(pq + kk * 16); s[t2] = MFMA(a, qv, s[t2]); }
    }
    const bool diag = j >= jdiag;
    const int kbase = 64 * j + 4 * hh;
    if (FOX) {
      float mloc = -1e30f;
#pragma unroll
      for (int t2 = 0; t2 < 2; ++t2) {
        f32x16 bvec;
#pragma unroll
        for (int g4 = 0; g4 < 4; ++g4) {
          const float4 bb = *(const float4*)(sm.cb + 64 * j + 32 * t2 + 8 * g4 + 4 * hh);
          bvec[4 * g4] = bb.x; bvec[4 * g4 + 1] = bb.y; bvec[4 * g4 + 2] = bb.z; bvec[4 * g4 + 3] = bb.w;
        }
        s[t2] = s[t2] * LOG2E + bvec;
      }
      if (diag) {
#pragma unroll
        for (int t2 = 0; t2 < 2; ++t2)
#pragma unroll
          for (int e = 0; e < 16; ++e) if (kbase + 32 * t2 + ACC_ROW(e, 0) > qpos) s[t2][e] = -1e30f;
      }
#pragma unroll
      for (int t2 = 0; t2 < 2; ++t2)
#pragma unroll
        for (int e = 0; e < 16; ++e) mloc = fmaxf(mloc, s[t2][e]);
      mloc = fmaxf(mloc, __shfl_xor(mloc, 32));
      const float mnew = fmaxf(mrun, mloc);
      const float alpha = __builtin_amdgcn_exp2f(mrun - mnew);
      mrun = mnew;
      float ls = 0.f;
#pragma unroll
      for (int t2 = 0; t2 < 2; ++t2) {
        s[t2] = s[t2] - mnew;
#pragma unroll
        for (int e = 0; e < 16; ++e) { const float pv = __builtin_amdgcn_exp2f(s[t2][e]); s[t2][e] = pv; ls += pv; }
      }
      lrun = lrun * alpha + ls;
#pragma unroll
      for (int d = 0; d < 2; ++d) o[d] = o[d] * alpha;
    } else {
#pragma unroll
      for (int t2 = 1; t2 >= 0; --t2) {
        f32x16 lk;
#pragma unroll
        for (int e = 0; e < 16; ++e) {
          const float z = s[t2][e];
          const float sp = fmaxf(z, 0.f) + __logf(1.f + __expf(-fabsf(z)));
          const bool vis = !diag || (kbase + 32 * t2 + ACC_ROW(e, 0) < qpos);
          lk[e] = vis ? -sp : 0.f;
        }
        bf16x8 fh[2], fl[2];
#pragma unroll
        for (int sI = 0; sI < 2; ++sI) fh[sI] = pack8(lk, sI);
#pragma unroll
        for (int e = 0; e < 16; ++e) lk[e] -= __uint_as_float(((unsigned)(u16)fh[e >> 3][e & 7]) << 16);
#pragma unroll
        for (int sI = 0; sI < 2; ++sI) fl[sI] = pack8(lk, sI);
        f32x16 inc;
#pragma unroll
        for (int e = 0; e < 16; ++e) inc[e] = R;
#pragma unroll
        for (int sI = 0; sI < 2; ++sI) { inc = MFMA(tri[sI], fh[sI], inc); inc = MFMA(tri[sI], fl[sI], inc); }
#pragma unroll
        for (int e = 0; e < 16; ++e) {
          const bool vis = !diag || (kbase + 32 * t2 + ACC_ROW(e, 0) < qpos);
          const float w = __builtin_amdgcn_exp2f((s[t2][e] + inc[e]) * LOG2E);
          s[t2][e] = vis ? w : 0.f;
        }
        R = __shfl(inc[0], r31);
      }
    }
#pragma unroll
    for (int t2 = 0; t2 < 2; ++t2)
#pragma unroll
      for (int sI = 0; sI < 2; ++sI) {
        const bf16x8 pf = pack8(s[t2], sI);
#pragma unroll
        for (int d = 0; d < 2; ++d) {
          const u16* pv = sm.vt[cur] + (d * 32 + r31) * VLD + 32 * t2 + 16 * sI + 4 * hh;
          union { s16x4 q[2]; bf16x8 v; } a;
          a.q[0] = *(const s16x4*)(pv); a.q[1] = *(const s16x4*)(pv + 8);
          o[d] = MFMA(a.v, pf, o[d]);
        }
      }
    if (it + 1 < nkt) { if (smp) kv_stash(kv, sm.k[cur ^ 1], sm.vt[cur ^ 1], tid); else kv_stash16(kw, sm.k[cur ^ 1], sm.vt[cur ^ 1], tid); }
#if SB_EXIT
    if (!FOX) { if (__syncthreads_and(R < -110.f)) break; } else __syncthreads();
#else
    __syncthreads();
#endif
  }
  if (SPLIT) {
    constexpr int NS = 8;
    const int bh = b * 8 + h;
    float* po = (float*)(p.ws + WS_F) + (size_t)(bh * NS) * 4096;
    float* pml = (float*)(p.ws + WS_F) + (size_t)128 * NS * 4096 + (size_t)(bh * NS) * 128;
    const float lt = lrun + __shfl_xor(lrun, 32);
    if (wid < 2) {
      float* dst = po + (size_t)split * 4096 + qi * 64;
#pragma unroll
      for (int d = 0; d < 2; ++d)
#pragma unroll
        for (int g4 = 0; g4 < 4; ++g4) *(float4*)(dst + d * 32 + 8 * g4 + 4 * hh) = make_float4(o[d][4 * g4], o[d][4 * g4 + 1], o[d][4 * g4 + 2], o[d][4 * g4 + 3]);
      if (hh == 0) *(float2*)(pml + (size_t)split * 128 + qi * 2) = make_float2(mrun, lt);
    }
    int* slot2 = (int*)(smem + 73728 + 528);
    asm volatile("s_waitcnt vmcnt(0)" ::: "memory");
    __syncthreads();
    if (tid == 0) {
      __builtin_amdgcn_fence(__ATOMIC_RELEASE, "agent");
      asm volatile("s_waitcnt vmcnt(0)" ::: "memory");
      const unsigned old = __hip_atomic_fetch_add((unsigned*)(p.ws + WS_BAR + 256) + bh + (do_ssq ? 0 : 128), 1u, __ATOMIC_RELAXED, __HIP_MEMORY_SCOPE_AGENT);
      __builtin_amdgcn_fence(__ATOMIC_ACQUIRE, "agent");
      asm volatile("s_waitcnt vmcnt(0)" ::: "memory");
      *slot2 = (int)old;
    }
    __syncthreads();
    const bool last = (*slot2 == NS - 1);
    __syncthreads();
    if (last) {
      const int q = tid >> 2, d0 = (tid & 3) * 16;
      float ms[NS], ls[NS], M = -1e30f;
#pragma unroll
      for (int s2 = 0; s2 < NS; ++s2) { const float2 ml = *(const float2*)(pml + (size_t)s2 * 128 + q * 2); ms[s2] = ml.x; ls[s2] = ml.y; M = fmaxf(M, ml.x); }
      float L = 0.f, acc[16];
#pragma unroll
      for (int k = 0; k < 16; ++k) acc[k] = 0.f;
#pragma unroll
      for (int s2 = 0; s2 < NS; ++s2) {
        const float w = exp2f(ms[s2] - M);
        L += ls[s2] * w;
        const float4* src = (const float4*)(po + (size_t)s2 * 4096 + q * 64 + d0);
#pragma unroll
        for (int k4 = 0; k4 < 4; ++k4) { const float4 v = src[k4]; acc[4 * k4] += w * v.x; acc[4 * k4 + 1] += w * v.y; acc[4 * k4 + 2] += w * v.z; acc[4 * k4 + 3] += w * v.w; }
      }
      const float invL = 1.f / L;
      float ssq = 0.f;
#pragma unroll
      for (int k = 0; k < 16; ++k) { acc[k] *= invL; ssq += acc[k] * acc[k]; }
      ssq += __shfl_xor(ssq, 1); ssq += __shfl_xor(ssq, 2);
      const int gq = NTP + b * DSEQ + q;
      if (do_ssq && (tid & 3) == 0) atomicAdd((float*)(p.ws + WS_SSQ) + (size_t)gq * 2 + 1, ssq);
      u16* od = (u16*)(p.ws + WS_E) + (size_t)gq * DM + 512 + h * 64 + d0;
      *(uint4*)od = make_uint4(pk2(acc[0], acc[1]), pk2(acc[2], acc[3]), pk2(acc[4], acc[5]), pk2(acc[6], acc[7]));
      *(uint4*)(od + 8) = make_uint4(pk2(acc[8], acc[9]), pk2(acc[10], acc[11]), pk2(acc[12], acc[13]), pk2(acc[14], acc[15]));
    }
    return;
  }
  float inv = 1.f;
  if (FOX) { const float lt = lrun + __shfl_xor(lrun, 32); inv = 1.f / lt; }
  {
    float ssq = 0.f;
#pragma unroll
    for (int d = 0; d < 2; ++d)
#pragma unroll
      for (int e = 0; e < 16; ++e) { const float t = o[d][e] * inv; ssq += t * t; }
    ssq += __shfl_xor(ssq, 32);
    if (do_ssq && hh == 0 && (!smp || wid < 2)) atomicAdd((float*)(p.ws + WS_SSQ) + (size_t)g * 2 + (FOX ? 1 : 0), ssq);
  }
  if (!smp || wid < 2) {
    u16* od = (u16*)(p.ws + WS_E) + (size_t)g * DM + (FOX ? 512 : 0) + h * 64;
#pragma unroll
    for (int d = 0; d < 2; ++d)
#pragma unroll
      for (int g4 = 0; g4 < 4; ++g4)
        *(uint2*)(od + d * 32 + 8 * g4 + 4 * hh) = make_uint2(pk2(o[d][4 * g4] * inv, o[d][4 * g4 + 1] * inv), pk2(o[d][4 * g4 + 2] * inv, o[d][4 * g4 + 3] * inv));
  }
}

template <class F>
DI void attn_queue(unsigned* ctr, int n, int* slot, F body) {
  for (;;) {
    if (threadIdx.x == 0) *slot = (int)atomicAdd(ctr, 1u);
    __syncthreads();
    const int it = *slot;
    __syncthreads();
    if (it >= n) break;
    body(it);
  }
}
DI void phase_attn(const Params& p, char* smem, int rep = 0) {
  unsigned* ctr = (unsigned*)(p.ws + WS_BAR + 128) + rep * 4;
  int* slot = (int*)(smem + 73728 + 512);
  const bool dq = rep == 0;
  attn_queue(ctr + 0, 1024, slot, [&](int it) { const int bh = it >> 3; attn_item<true, true>(p, bh >> 3, bh & 7, 0, smem, dq, it & 7); });
  attn_queue(ctr + 1, 2048, slot, [&](int u) { const int w = u & 511; const int qb = 15 - (w >> 5), bh = (u >> 9) * 32 + (w & 31); attn_item<true, false>(p, bh >> 3, bh & 7, qb, smem, dq); });
  attn_queue(ctr + 2, 128, slot, [&](int u) { attn_item<false, true>(p, u >> 3, u & 7, 0, smem, dq); });
  attn_queue(ctr + 3, 2048, slot, [&](int u) { const int w = u & 511; const int qb = 15 - (w >> 5), bh = (u >> 9) * 32 + (w & 31); attn_item<false, false>(p, bh >> 3, bh & 7, qb, smem, dq); });
}

DI void phase_wout(const Params& p, char* smem) {
  float* pre = (float*)(p.ws + WS_A);
  const u16* o = (const u16*)(p.ws + WS_E);
  float* sc_s = (float*)(smem + 73728);
  for_tiles(DM, [&](int m0, int n0, auto tag) {
    constexpr int MI = decltype(tag)::value;
    {
      const int tid = threadIdx.x;
      if (tid < MI * 64) {
        const float2 q = ((const float2*)(p.ws + WS_SSQ))[m0 + tid];
        const float s0 = rsqrtf(q.x * (1.f / 512.f) + 1e-6f), s1 = rsqrtf(q.y * (1.f / 512.f) + 1e-6f);
        sc_s[tid * 2] = s0 / s1; sc_s[tid * 2 + 1] = s1;
      }
      __syncthreads();
    }
    GldsBf16<MI * 64> al; al.base = o + (size_t)m0 * DM; al.ld = DM;
    const float* xr = xrow(p, m0);
    auto epi = [=](int r0, int c0, const f32x16& acc) {
      const int lane = threadIdx.x & 63, hh = lane >> 5, col = c0 + (lane & 31);
      const unsigned b0 = (unsigned)(r0 + 4 * hh) * 1024u + col, b1 = (unsigned)(r0 - m0 + 4 * hh) * 1024u + col;
#pragma unroll
      for (int e = 0; e < 16; ++e) pre[b0 + ACC_R0(e) * 1024u] = DN_ALPHA * xr[b1 + ACC_R0(e) * 1024u] + acc[e];
    };
    gemm_tile<MI, true>(al, (const u16*)(p.ws + WS_WOUT), DM, DM, m0, n0, epi, smem, sc_s);
  });
}

DI void phase_ln(const Params& p, const float* gam, const float* bet) {
  const float* pre = (const float*)(p.ws + WS_A);
  u16* xb = (u16*)(p.ws + WS_C);
  const int lane = threadIdx.x & 63;
  const int wg = blockIdx.x * 4 + (threadIdx.x >> 6), nw = gridDim.x * 4;
  for (int row0 = wg * 2; row0 < NT; row0 += nw * 2) {
    float4 v[2][4];
    float s[2], q[2];
#pragma unroll
    for (int r = 0; r < 2; ++r) {
      s[r] = 0.f;
#pragma unroll
      for (int j = 0; j < 4; ++j) { v[r][j] = ((const float4*)(pre + (size_t)(row0 + r) * DM))[lane + 64 * j]; s[r] += v[r][j].x + v[r][j].y + v[r][j].z + v[r][j].w; }
    }
#pragma unroll
    for (int o = 32; o >= 1; o >>= 1)
#pragma unroll
      for (int r = 0; r < 2; ++r) s[r] += __shfl_xor(s[r], o);
#pragma unroll
    for (int r = 0; r < 2; ++r) {
      s[r] *= (1.f / 1024.f); q[r] = 0.f;
#pragma unroll
      for (int j = 0; j < 4; ++j) { const float a = v[r][j].x - s[r], b2 = v[r][j].y - s[r], c = v[r][j].z - s[r], d = v[r][j].w - s[r]; q[r] += a * a + b2 * b2 + c * c + d * d; }
    }
#pragma unroll
    for (int o = 32; o >= 1; o >>= 1)
#pragma unroll
      for (int r = 0; r < 2; ++r) q[r] += __shfl_xor(q[r], o);
#pragma unroll
    for (int r = 0; r < 2; ++r) {
      const float mu = s[r], rs = rsqrtf(q[r] * (1.f / 1024.f) + 1e-5f);
#pragma unroll
      for (int j = 0; j < 4; ++j) {
        const float4 gg = ((const float4*)gam)[lane + 64 * j], bb = ((const float4*)bet)[lane + 64 * j];
        float4 y;
        y.x = (v[r][j].x - mu) * rs * gg.x + bb.x; y.y = (v[r][j].y - mu) * rs * gg.y + bb.y;
        y.z = (v[r][j].z - mu) * rs * gg.z + bb.z; y.w = (v[r][j].w - mu) * rs * gg.w + bb.w;
        ((uint2*)(xb + (size_t)(row0 + r) * DM))[lane + 64 * j] = make_uint2(pk2(y.x, y.y), pk2(y.z, y.w));
      }
    }
  }
}

template <bool NOEPI = false>
DI void phase_gemm_bf16(const Params& p, const u16* A, const u16* Wt, int N, u16* O, float scale, char* smem) {
  for_tiles(N, [&](int m0, int n0, auto tag) {
    constexpr int MI = decltype(tag)::value;
    GldsBf16<MI * 64> al; al.base = A + (size_t)m0 * DM; al.ld = DM;
    auto epi = [=](int r0, int c0, const f32x16& acc) {
      const int lane = threadIdx.x & 63, hh = lane >> 5, col = c0 + (lane & 31);
      const unsigned b0 = (unsigned)(r0 + 4 * hh) * (unsigned)N + col;
      if (NOEPI) { float t = 0.f;
#pragma unroll
        for (int e = 0; e < 16; ++e) t += acc[e];
        if (t == 12345.678f) O[b0] = bf1(t);
        return; }
#pragma unroll
      for (int e = 0; e < 16; ++e) O[b0 + ACC_R0(e) * (unsigned)N] = bf1(acc[e] * scale);
    };
    gemm_tile<MI>(al, Wt, DM, DM, m0, n0, epi, smem);
  });
}

template <class F>
DI void for_mem_tiles(F body) {
  const int vb = vblock(), nb = gridDim.x;
  for (int t = vb; t < 2048 + 256; t += nb) {
    if (t < 2048) { const int mt = t >> 3; body(mt * 128, (t >> 1) & 3, (t & 1) * 128, mt >> 4, IC<2>{}); }
    else { const int u = t - 2048; const int mt = u >> 4; body(NTP + mt * 64, (u >> 2) & 3, (u & 3) * 64, 16 + mt, IC<1>{}); }
  }
}
DI void phase_mem_s(const Params& p, char* smem) {
  const u16* qm = (const u16*)(p.ws + WS_D);
  float* S = (float*)(p.ws + WS_F);
  for_mem_tiles([&](int m0, int hd, int n0, int batch, auto tag) {
    constexpr int MI = decltype(tag)::value;
    GldsBf16<MI * 64> al; al.base = qm + (size_t)m0 * DM + hd * 256; al.ld = DM;
    const u16* Bt = (const u16*)(p.ws + WS_MEMK) + (size_t)batch * 256 * DM + hd * 256;
    auto epi = [=](int r0, int c0, const f32x16& acc) {
      const int lane = threadIdx.x & 63, hh = lane >> 5, col = c0 + (lane & 31);
      const unsigned b0 = (unsigned)(r0 + 4 * hh) * 1024u + hd * 256 + col;
#pragma unroll
      for (int e = 0; e < 16; ++e) S[b0 + ACC_R0(e) * 1024u] = acc[e];
    };
    gemm_tile<MI>(al, Bt, DM, 256, m0, n0, epi, smem);
  });
}
DI void phase_mem_softmax(const Params& p) {
  const float* S = (const float*)(p.ws + WS_F);
  u16* P = (u16*)(p.ws + WS_D);
  const int lane = threadIdx.x & 63;
  const int wg = blockIdx.x * 4 + (threadIdx.x >> 6), nw = gridDim.x * 4;
  for (int row0 = wg * 8; row0 < NT * 4; row0 += nw * 8) {
    float4 v[8]; float m[8], sm[8];
#pragma unroll
    for (int r = 0; r < 8; ++r) v[r] = ((const float4*)(S + (size_t)(row0 + r) * 256))[lane];
#pragma unroll
    for (int r = 0; r < 8; ++r) m[r] = fmaxf(fmaxf(v[r].x, v[r].y), fmaxf(v[r].z, v[r].w));
#pragma unroll
    for (int o = 32; o >= 1; o >>= 1)
#pragma unroll
      for (int r = 0; r < 8; ++r) m[r] = fmaxf(m[r], __shfl_xor(m[r], o));
#pragma unroll
    for (int r = 0; r < 8; ++r) { v[r].x = __expf(v[r].x - m[r]); v[r].y = __expf(v[r].y - m[r]); v[r].z = __expf(v[r].z - m[r]); v[r].w = __expf(v[r].w - m[r]); sm[r] = v[r].x + v[r].y + v[r].z + v[r].w; }
#pragma unroll
    for (int o = 32; o >= 1; o >>= 1)
#pragma unroll
      for (int r = 0; r < 8; ++r) sm[r] += __shfl_xor(sm[r], o);
#pragma unroll
    for (int r = 0; r < 8; ++r) { const float inv = 1.f / sm[r]; ((uint2*)(P + (size_t)(row0 + r) * 256))[lane] = make_uint2(pk2(v[r].x * inv, v[r].y * inv), pk2(v[r].z * inv, v[r].w * inv)); }
  }
}
DI void phase_mem_pv(const Params& p, char* smem) {
  const u16* P = (const u16*)(p.ws + WS_D);
  u16* om = (u16*)(p.ws + WS_E);
  for_mem_tiles([&](int m0, int hd, int n0, int batch, auto tag) {
    constexpr int MI = decltype(tag)::value;
    GldsBf16<MI * 64> al; al.base = P + (size_t)m0 * DM + hd * 256; al.ld = DM;
    const u16* Bt = (const u16*)(p.ws + WS_MEMVT) + ((size_t)batch * DM + hd * 256) * 256;
    auto epi = [=](int r0, int c0, const f32x16& acc) {
      const int lane = threadIdx.x & 63, hh = lane >> 5, col = c0 + (lane & 31);
      const unsigned b0 = (unsigned)(r0 + 4 * hh) * 1024u + hd * 256 + col;
#pragma unroll
      for (int e = 0; e < 16; ++e) om[b0 + ACC_R0(e) * 1024u] = bf1(acc[e]);
    };
    gemm_tile<MI>(al, Bt, 256, 256, m0, n0, epi, smem);
  });
}
DI void phase_wmo(const Params& p, char* smem) {
  float* pre = (float*)(p.ws + WS_A);
  const u16* xbs = (const u16*)(p.ws + WS_C);
  const u16* om = (const u16*)(p.ws + WS_E);
  for_tiles(DM, [&](int m0, int n0, auto tag) {
    constexpr int MI = decltype(tag)::value;
    GldsBf16<MI * 64> al; al.base = om + (size_t)m0 * DM; al.ld = DM;
    auto epi = [=](int r0, int c0, const f32x16& acc) {
      const int lane = threadIdx.x & 63, hh = lane >> 5, col = c0 + (lane & 31);
      const unsigned b0 = (unsigned)(r0 + 4 * hh) * 1024u + col;
#pragma unroll
      for (int e = 0; e < 16; ++e) { const unsigned i = b0 + ACC_R0(e) * 1024u; pre[i] = DN_ALPHA * bflo((unsigned)xbs[i]) + acc[e]; }
    };
    gemm_tile<MI>(al, (const u16*)(p.ws + WS_WMO), DM, DM, m0, n0, epi, smem);
  });
}

DI void insert16(float (&v)[16], float x) {
#pragma unroll
  for (int j = 15; j >= 1; --j) v[j] = __builtin_amdgcn_fmed3f(x, v[j - 1], v[j]);
  v[0] = fmaxf(v[0], x);
}
DI void phase_topk(const Params& p, char* smem) {
  const int vb = vblock(), nb = gridDim.x;
  const u16* qp = (const u16*)(p.ws + WS_F);
  int* idxo = (int*)(p.ws + WS_A);
  float* gato = (float*)(p.ws + WS_A + (size_t)NT * 128 * 4);
  float* sc = (float*)smem;
  const int tid = threadIdx.x;
  for (int t = vb; t < 264 * 8; t += nb) {
    const int mt = t >> 3, hd = t & 7;
    const int m0 = mt * 128;
    float va[16], vbv[16];
#pragma unroll
    for (int side = 0; side < 2; ++side) {
      GldsBf16<128> al; al.base = qp + (size_t)m0 * 2048 + hd * 256 + side * 128; al.ld = 2048;
      const u16* Bt = (const u16*)(p.ws + (side ? WS_KB : WS_KA)) + (size_t)hd * 128 * 128;
      auto epi = [=](int r0, int c0, const f32x16& acc) {
        const int lane = threadIdx.x & 63, hh = lane >> 5, col = c0 + (lane & 31);
#pragma unroll
        for (int e = 0; e < 16; ++e) sc[(r0 - m0 + ACC_ROW(e, hh)) * 129 + col] = acc[e];
      };
      gemm_tile<2>(al, Bt, 128, 128, m0, 0, epi, smem);
      __syncthreads();
      {
        const int row = tid & 127, half = tid >> 7;
        float* mg = (float*)(smem + 66048);
        float v[16];
#pragma unroll
        for (int j = 0; j < 16; ++j) v[j] = -INFINITY;
        for (int k = 64 * half; k < 64 * half + 64; ++k) {
          const float x = __uint_as_float((__float_as_uint(sc[row * 129 + k]) & ~0x7Fu) | (unsigned)k);
          insert16(v, x);
        }
        if (half == 1) {
#pragma unroll
          for (int j = 0; j < 16; ++j) mg[row * 17 + j] = v[j];
        }
        __syncthreads();
        if (half == 0) {
#pragma unroll
          for (int j = 0; j < 16; ++j) insert16(v, mg[row * 17 + j]);
#pragma unroll
          for (int j = 0; j < 16; ++j) { if (side == 0) va[j] = v[j]; else vbv[j] = v[j]; }
        }
      }
      __syncthreads();
    }
    unsigned char* ids = (unsigned char*)smem;
    if (tid < 128) {
#pragma unroll
      for (int j = 0; j < 16; ++j) { ids[tid * 32 + j] = (unsigned char)(__float_as_uint(va[j]) & 0x7F); ids[tid * 32 + 16 + j] = (unsigned char)(__float_as_uint(vbv[j]) & 0x7F); }
      float top[16];
#pragma unroll
      for (int j = 0; j < 16; ++j) top[j] = -INFINITY;
#pragma unroll
      for (int i = 0; i < 16; ++i)
#pragma unroll
        for (int j = 0; j < 16; ++j)
          if ((i + 1) * (j + 1) <= 16) {
            const float a = __uint_as_float(__float_as_uint(va[i]) & ~0x7Fu), b = __uint_as_float(__float_as_uint(vbv[j]) & ~0x7Fu);
            const float c = __uint_as_float((__float_as_uint(a + b) & ~0xFFu) | (unsigned)(i * 16 + j));
            insert16(top, c);
          }
      const float m = __uint_as_float(__float_as_uint(top[0]) & ~0xFFu);
      float ex[16], ssum = 0.f;
      int eid[16];
#pragma unroll
      for (int j = 0; j < 16; ++j) {
        const unsigned bits = __float_as_uint(top[j]);
        const int code = bits & 0xFF;
        ex[j] = __expf(__uint_as_float(bits & ~0xFFu) - m); ssum += ex[j];
        eid[j] = (int)ids[tid * 32 + (code >> 4)] * 128 + (int)ids[tid * 32 + 16 + (code & 15)];
      }
      const float inv = 1.f / ssum;
      const size_t ob = (size_t)(m0 + tid) * 128 + hd * 16;
#pragma unroll
      for (int j4 = 0; j4 < 4; ++j4) {
        *(int4*)(idxo + ob + 4 * j4) = make_int4(eid[4 * j4], eid[4 * j4 + 1], eid[4 * j4 + 2], eid[4 * j4 + 3]);
        *(float4*)(gato + ob + 4 * j4) = make_float4(ex[4 * j4] * inv, ex[4 * j4 + 1] * inv, ex[4 * j4 + 2] * inv, ex[4 * j4 + 3] * inv);
      }
    }
    __syncthreads();
  }
}

#if USE_FP8
typedef float f32x2v __attribute__((ext_vector_type(2)));
DI void unpack16(const uint4& v, float (&f)[16]) {
  const unsigned w[4] = {v.x, v.y, v.z, v.w};
#pragma unroll
  for (int j = 0; j < 4; ++j) {
    const f32x2v lo = __builtin_amdgcn_cvt_pk_f32_fp8((int)w[j], false), hi = __builtin_amdgcn_cvt_pk_f32_fp8((int)w[j], true);
    f[4 * j] = lo[0]; f[4 * j + 1] = lo[1]; f[4 * j + 2] = hi[0]; f[4 * j + 3] = hi[1];
  }
}
DI void peer_dot8(const char* U, int idreg, int e0, int lane, const float (&x)[16], float& dacc) {
  uint4 w[8];
#pragma unroll
  for (int j = 0; j < 8; ++j) { const int id = __builtin_amdgcn_readlane(idreg, e0 + j); w[j] = *(const uint4*)(U + (size_t)id * DM + 16 * lane); }
  float s[8];
#pragma unroll
  for (int j = 0; j < 8; ++j) {
    float f[16]; unpack16(w[j], f);
    float a = 0.f;
#pragma unroll
    for (int k = 0; k < 16; ++k) a += f[k] * x[k];
    s[j] = a;
  }
  const bool b5 = lane & 32, b4 = lane & 16, b3 = lane & 8;
  float t4[4], t2[2], t1;
#pragma unroll
  for (int i = 0; i < 4; ++i) { const float snd = b5 ? s[i] : s[4 + i], kp = b5 ? s[4 + i] : s[i]; t4[i] = kp + __shfl_xor(snd, 32); }
#pragma unroll
  for (int i = 0; i < 2; ++i) { const float snd = b4 ? t4[i] : t4[2 + i], kp = b4 ? t4[2 + i] : t4[i]; t2[i] = kp + __shfl_xor(snd, 16); }
  { const float snd = b3 ? t2[0] : t2[1], kp = b3 ? t2[1] : t2[0]; t1 = kp + __shfl_xor(snd, 8); }
  t1 += __shfl_xor(t1, 4); t1 += __shfl_xor(t1, 2); t1 += __shfl_xor(t1, 1);
  const float g = __shfl(t1, (lane & 7) * 8);
  if ((lane >> 3) == (e0 >> 3)) dacc = g;
}
DI void peer_axpy8(const char* V, int idreg, float hreg, int e0, int lane, float (&acc)[16]) {
  uint4 w[8];
#pragma unroll
  for (int j = 0; j < 8; ++j) { const int id = __builtin_amdgcn_readlane(idreg, e0 + j); w[j] = *(const uint4*)(V + (size_t)id * DM + 16 * lane); }
#pragma unroll
  for (int j = 0; j < 8; ++j) {
    const float hs = __uint_as_float(__builtin_amdgcn_readlane(__float_as_uint(hreg), e0 + j));
    float f[16]; unpack16(w[j], f);
#pragma unroll
    for (int k = 0; k < 16; ++k) acc[k] += hs * f[k];
  }
}
DI void peer_sort(int& id0, int& id1, float& g0, float& g1, int lane) {
  unsigned k0 = ((unsigned)id0 << 7) | (unsigned)lane, k1 = ((unsigned)id1 << 7) | (unsigned)(lane + 64);
#pragma unroll
  for (int k = 2; k <= 128; k <<= 1) {
#pragma unroll
    for (int j = k >> 1; j >= 1; j >>= 1) {
      if (j == 64) {
        const unsigned lo = min(k0, k1), hi = max(k0, k1); k0 = lo; k1 = hi;
      } else {
        const unsigned p0 = (unsigned)__shfl_xor((int)k0, j), p1 = (unsigned)__shfl_xor((int)k1, j);
        const bool upper = (lane & j) != 0;
        const bool asc0 = ((lane & k) == 0), asc1 = (((lane + 64) & k) == 0);
        k0 = (upper == asc0) ? max(k0, p0) : min(k0, p0);
        k1 = (upper == asc1) ? max(k1, p1) : min(k1, p1);
      }
    }
  }
  const int s0 = k0 & 127, s1 = k1 & 127;
  const float a0 = __shfl(g0, s0 & 63), b0 = __shfl(g1, s0 & 63), a1 = __shfl(g0, s1 & 63), b1 = __shfl(g1, s1 & 63);
  g0 = (s0 < 64) ? a0 : b0; g1 = (s1 < 64) ? a1 : b1;
  id0 = (int)(k0 >> 7); id1 = (int)(k1 >> 7);
}
DI void peer_load(const Params& p, int row, int lane, float (&x)[16], int& id0, int& id1, float& g0, float& g1) {
  const int* idxo = (const int*)(p.ws + WS_A);
  const float* gato = (const float*)(p.ws + WS_A + (size_t)NT * 128 * 4);
  {
    const uint4* xr = (const uint4*)((const u16*)(p.ws + WS_C) + (size_t)row * DM) + 2 * lane;
    const uint4 a = xr[0], b = xr[1];
    x[0] = bflo(a.x); x[1] = bfhi(a.x); x[2] = bflo(a.y); x[3] = bfhi(a.y); x[4] = bflo(a.z); x[5] = bfhi(a.z); x[6] = bflo(a.w); x[7] = bfhi(a.w);
    x[8] = bflo(b.x); x[9] = bfhi(b.x); x[10] = bflo(b.y); x[11] = bfhi(b.y); x[12] = bflo(b.z); x[13] = bfhi(b.z); x[14] = bflo(b.w); x[15] = bfhi(b.w);
  }
  id0 = idxo[(size_t)row * 128 + lane]; id1 = idxo[(size_t)row * 128 + 64 + lane];
  g0 = gato[(size_t)row * 128 + lane]; g1 = gato[(size_t)row * 128 + 64 + lane];
  peer_sort(id0, id1, g0, g1, lane);
}
DI void peer_finish(const Params& p, int row, int lane, float (&acc)[16]) {
  float x[16];
  {
    const uint4* xr = (const uint4*)((const u16*)(p.ws + WS_C) + (size_t)row * DM) + 2 * lane;
    const uint4 a = xr[0], b = xr[1];
    x[0] = bflo(a.x); x[1] = bfhi(a.x); x[2] = bflo(a.y); x[3] = bfhi(a.y); x[4] = bflo(a.z); x[5] = bfhi(a.z); x[6] = bflo(a.w); x[7] = bfhi(a.w);
    x[8] = bflo(b.x); x[9] = bfhi(b.x); x[10] = bflo(b.y); x[11] = bfhi(b.y); x[12] = bflo(b.z); x[13] = bfhi(b.z); x[14] = bflo(b.w); x[15] = bfhi(b.w);
  }
  float s = 0.f;
#pragma unroll
  for (int k = 0; k < 16; ++k) { acc[k] = DN_ALPHA * x[k] + acc[k]; s += acc[k]; }
  const float mu = wave_sum(s) * (1.f / 1024.f);
  float q = 0.f;
#pragma unroll
  for (int k = 0; k < 16; ++k) { const float dd = acc[k] - mu; q += dd * dd; }
  const float rs = rsqrtf(wave_sum(q) * (1.f / 1024.f) + 1e-5f);
  float* y = (row < NTP) ? p.out + OUT_YP + (size_t)row * DM : p.out + OUT_YS + (size_t)(row - NTP) * DM;
#pragma unroll
  for (int j = 0; j < 4; ++j) {
    const float4 ga = ((const float4*)p.ln3_g)[4 * lane + j], ba = ((const float4*)p.ln3_b)[4 * lane + j];
    float4 ya;
    ya.x = (acc[4 * j + 0] - mu) * rs * ga.x + ba.x; ya.y = (acc[4 * j + 1] - mu) * rs * ga.y + ba.y;
    ya.z = (acc[4 * j + 2] - mu) * rs * ga.z + ba.z; ya.w = (acc[4 * j + 3] - mu) * rs * ga.w + ba.w;
    ((float4*)y)[4 * lane + j] = ya;
  }
}
DI float peer_gelu_gate(float d, float g) { return 0.5f * d * (1.f + erff(d * 0.7071067811865476f)) * g; }
DI void phase_peer(const Params& p, int rr0 = 0, int rr1 = 1 << 10) {
  const char* U = p.ws + WS_U;
  const char* V = p.ws + WS_V;
  const float* usc = (const float*)(p.ws + WS_USC);
  const float* vsc = (const float*)(p.ws + WS_VSC);
  const int lane = threadIdx.x & 63;
  const int wg = blockIdx.x * 4 + (threadIdx.x >> 6), nw = gridDim.x * 4;
  for (int rowA = wg + rr0 * 2 * nw; rowA < NT && rowA < wg + rr1 * 2 * nw; rowA += 2 * nw) {
    const bool hasB = rowA + nw < NT;
    const int rowB = hasB ? rowA + nw : rowA;
    asm volatile("" ::: "memory");
    float xA[16], xB[16];
    int a0, a1, b0, b1; float ga0, ga1, gb0, gb1;
    peer_load(p, rowA, lane, xA, a0, a1, ga0, ga1);
    peer_load(p, rowB, lane, xB, b0, b1, gb0, gb1);
    const float sua0 = usc[a0], sua1 = usc[a1], sva0 = vsc[a0], sva1 = vsc[a1];
    const float sub0 = usc[b0], sub1 = usc[b1], svb0 = vsc[b0], svb1 = vsc[b1];
    float da0 = 0.f, da1 = 0.f, db0 = 0.f, db1 = 0.f;
#pragma unroll 1
    for (int e0 = 0; e0 < 64; e0 += 8) { peer_dot8(U, a0, e0, lane, xA, da0); if (hasB) peer_dot8(U, b0, e0, lane, xB, db0); }
#pragma unroll 1
    for (int e0 = 0; e0 < 64; e0 += 8) { peer_dot8(U, a1, e0, lane, xA, da1); if (hasB) peer_dot8(U, b1, e0, lane, xB, db1); }
    const float ha0 = peer_gelu_gate(da0 * sua0, ga0) * sva0, ha1 = peer_gelu_gate(da1 * sua1, ga1) * sva1;
    const float hb0 = peer_gelu_gate(db0 * sub0, gb0) * svb0, hb1 = peer_gelu_gate(db1 * sub1, gb1) * svb1;
    float accA[16], accB[16];
#pragma unroll
    for (int k = 0; k < 16; ++k) { accA[k] = 0.f; accB[k] = 0.f; }
#pragma unroll 1
    for (int e0 = 0; e0 < 64; e0 += 8) { peer_axpy8(V, a0, ha0, e0, lane, accA); if (hasB) peer_axpy8(V, b0, hb0, e0, lane, accB); }
#pragma unroll 1
    for (int e0 = 0; e0 < 64; e0 += 8) { peer_axpy8(V, a1, ha1, e0, lane, accA); if (hasB) peer_axpy8(V, b1, hb1, e0, lane, accB); }
    peer_finish(p, rowA, lane, accA);
    if (hasB) peer_finish(p, rowB, lane, accB);
  }
}
#else
DI void unpack8(const uint4& v, float (&f)[8]) {
  f[0] = bflo(v.x); f[1] = bfhi(v.x); f[2] = bflo(v.y); f[3] = bfhi(v.y); f[4] = bflo(v.z); f[5] = bfhi(v.z); f[6] = bflo(v.w); f[7] = bfhi(v.w);
}
DI void phase_peer(const Params& p) {
  const float* xf = (const float*)(p.ws + WS_B);
  const int* idxo = (const int*)(p.ws + WS_A);
  const float* gato = (const float*)(p.ws + WS_A + (size_t)NT * 128 * 4);
  const u16* U = (const u16*)(p.ws + WS_U);
  const u16* V = (const u16*)(p.ws + WS_V);
  const int lane = threadIdx.x & 63;
  const int wg = blockIdx.x * 4 + (threadIdx.x >> 6), nw = gridDim.x * 4;
  for (int row = wg; row < NT; row += nw) {
    float x[16];
    {
      const float4* xr = (const float4*)(xf + (size_t)row * DM);
      const float4 a = xr[2 * lane], b = xr[2 * lane + 1], c = xr[128 + 2 * lane], d = xr[128 + 2 * lane + 1];
      x[0] = a.x; x[1] = a.y; x[2] = a.z; x[3] = a.w; x[4] = b.x; x[5] = b.y; x[6] = b.z; x[7] = b.w;
      x[8] = c.x; x[9] = c.y; x[10] = c.z; x[11] = c.w; x[12] = d.x; x[13] = d.y; x[14] = d.z; x[15] = d.w;
    }
    const int id0 = idxo[(size_t)row * 128 + lane], id1 = idxo[(size_t)row * 128 + 64 + lane];
    const float g0 = gato[(size_t)row * 128 + lane], g1 = gato[(size_t)row * 128 + 64 + lane];
    float d0 = 0.f, d1 = 0.f;
#pragma unroll 8
    for (int e = 0; e < 64; ++e) {
      const int id = __builtin_amdgcn_readlane(id0, e);
      const uint4* ur = (const uint4*)(U + (size_t)id * DM);
      const uint4 ua = ur[lane], ub = ur[64 + lane];
      float f[8], s = 0.f;
      unpack8(ua, f);
#pragma unroll
      for (int k = 0; k < 8; ++k) s += f[k] * x[k];
      unpack8(ub, f);
#pragma unroll
      for (int k = 0; k < 8; ++k) s += f[k] * x[8 + k];
      s = wave_sum(s);
      if (lane == e) d0 = s;
    }
#pragma unroll 8
    for (int e = 0; e < 64; ++e) {
      const int id = __builtin_amdgcn_readlane(id1, e);
      const uint4* ur = (const uint4*)(U + (size_t)id * DM);
      const uint4 ua = ur[lane], ub = ur[64 + lane];
      float f[8], s = 0.f;
      unpack8(ua, f);
#pragma unroll
      for (int k = 0; k < 8; ++k) s += f[k] * x[k];
      unpack8(ub, f);
#pragma unroll
      for (int k = 0; k < 8; ++k) s += f[k] * x[8 + k];
      s = wave_sum(s);
      if (lane == e) d1 = s;
    }
    const float h0 = 0.5f * d0 * (1.f + erff(d0 * 0.7071067811865476f)) * g0;
    const float h1 = 0.5f * d1 * (1.f + erff(d1 * 0.7071067811865476f)) * g1;
    float acc[16];
#pragma unroll
    for (int k = 0; k < 16; ++k) acc[k] = 0.f;
#pragma unroll 8
    for (int e = 0; e < 64; ++e) {
      const int id = __builtin_amdgcn_readlane(id0, e);
      const float hs = __uint_as_float(__builtin_amdgcn_readlane(__float_as_uint(h0), e));
      const uint4* vr = (const uint4*)(V + (size_t)id * DM);
      const uint4 va = vr[lane], vb2 = vr[64 + lane];
      float f[8];
      unpack8(va, f);
#pragma unroll
      for (int k = 0; k < 8; ++k) acc[k] += hs * f[k];
      unpack8(vb2, f);
#pragma unroll
      for (int k = 0; k < 8; ++k) acc[8 + k] += hs * f[k];
    }
#pragma unroll 8
    for (int e = 0; e < 64; ++e) {
      const int id = __builtin_amdgcn_readlane(id1, e);
      const float hs = __uint_as_float(__builtin_amdgcn_readlane(__float_as_uint(h1), e));
      const uint4* vr = (const uint4*)(V + (size_t)id * DM);
      const uint4 va = vr[lane], vb2 = vr[64 + lane];
      float f[8];
      unpack8(va, f);
#pragma unroll
      for (int k = 0; k < 8; ++k) acc[k] += hs * f[k];
      unpack8(vb2, f);
#pragma unroll
      for (int k = 0; k < 8; ++k) acc[8 + k] += hs * f[k];
    }
    float s = 0.f;
#pragma unroll
    for (int k = 0; k < 16; ++k) { acc[k] = DN_ALPHA * x[k] + acc[k]; s += acc[k]; }
    const float mu = wave_sum(s) * (1.f / 1024.f);
    float q = 0.f;
#pragma unroll
    for (int k = 0; k < 16; ++k) { const float dd = acc[k] - mu; q += dd * dd; }
    const float rs = rsqrtf(wave_sum(q) * (1.f / 1024.f) + 1e-5f);
    float* y = (row < NTP) ? p.out + OUT_YP + (size_t)row * DM : p.out + OUT_YS + (size_t)(row - NTP) * DM;
#pragma unroll
    for (int c = 0; c < 2; ++c) {
      const int off = c * 512 + lane * 8;
      const float4 ga = *(const float4*)(p.ln3_g + off), gb = *(const float4*)(p.ln3_g + off + 4);
      const float4 ba = *(const float4*)(p.ln3_b + off), bb = *(const float4*)(p.ln3_b + off + 4);
      float4 ya, yb;
      ya.x = (acc[8 * c + 0] - mu) * rs * ga.x + ba.x; ya.y = (acc[8 * c + 1] - mu) * rs * ga.y + ba.y;
      ya.z = (acc[8 * c + 2] - mu) * rs * ga.z + ba.z; ya.w = (acc[8 * c + 3] - mu) * rs * ga.w + ba.w;
      yb.x = (acc[8 * c + 4] - mu) * rs * gb.x + bb.x; yb.y = (acc[8 * c + 5] - mu) * rs * gb.y + bb.y;
      yb.z = (acc[8 * c + 6] - mu) * rs * gb.z + bb.z; yb.w = (acc[8 * c + 7] - mu) * rs * gb.w + bb.w;
      *(float4*)(y + off) = ya; *(float4*)(y + off + 4) = yb;
    }
  }
}

#endif

constexpr int NPHASE = 15;
template <int PH>
DI void run_phase(const Params& p, char* smem) {
  if (PH == 0) phase_prep(p, smem);
  else if (PH == 1) phase_proj(p, smem);
  else if (PH == 2) phase_scan(p, smem);
  else if (PH == 3) phase_attn(p, smem);
  else if (PH == 4) phase_wout(p, smem);
  else if (PH == 5) phase_ln(p, p.ln1_g, p.ln1_b);
  else if (PH == 6) phase_gemm_bf16(p, (const u16*)(p.ws + WS_C), (const u16*)(p.ws + WS_WMQ), 1024, (u16*)(p.ws + WS_D), 0.0625f, smem);
  else if (PH == 7) phase_mem_s(p, smem);
  else if (PH == 8) phase_mem_softmax(p);
  else if (PH == 9) phase_mem_pv(p, smem);
  else if (PH == 10) phase_wmo(p, smem);
  else if (PH == 11) phase_ln(p, p.ln2_g, p.ln2_b);
  else if (PH == 12) phase_gemm_bf16(p, (const u16*)(p.ws + WS_C), (const u16*)(p.ws + WS_WPQ), 2048, (u16*)(p.ws + WS_F), 1.f, smem);
  else if (PH == 13) phase_topk(p, smem);
  else if (PH == 14) phase_peer(p);
}

template <int PH>
__global__ void __launch_bounds__(256, 2) k_phase(Params p) {
  __shared__ __attribute__((aligned(16))) char smem[SMEM_BYTES];
  run_phase<PH>(p, smem);
}

#define XB_TMO      128
#define XB_XCNT(j)  (256  + 64 * (j))
#define XB_XSUB(j)  (1280 + 64 * (j))
#define XB_XGEN(j)  (2304 + 64 * (j))
#define XB_TOP      3328
#define XB_TOPGEN   3392
#define XB_SPIN_CAP (1u << 20)
DI unsigned xb_ld(unsigned* p) { return __hip_atomic_load(p, __ATOMIC_RELAXED, __HIP_MEMORY_SCOPE_AGENT); }
DI unsigned xb_add(unsigned* p, unsigned v) { return __hip_atomic_fetch_add(p, v, __ATOMIC_RELAXED, __HIP_MEMORY_SCOPE_AGENT); }
DI unsigned xb_xcc_id() { return (unsigned)__builtin_amdgcn_s_getreg((3 << 11) | 20) & 0xFu; }
#define XB_SPIN(cond, bar) do { unsigned _sp = 0; while (cond) { __builtin_amdgcn_s_sleep(1); \
    if ((++_sp & 255u) == 0u) { if (xb_ld(&(bar)[XB_TMO])) break; if (_sp > XB_SPIN_CAP) { atomicAdd(&(bar)[XB_TMO], 1u); break; } } } } while (0)
struct XcdBarrier { unsigned* bar; unsigned x; volatile unsigned* st; };
DI XcdBarrier xcd_barrier_post(unsigned* bar, volatile unsigned* st) {
  XcdBarrier b; b.bar = bar; b.x = xb_xcc_id(); b.st = st;
  if (threadIdx.x == 0) (void)xb_add(&bar[XB_XCNT(b.x)], 1u);
  return b;
}
DI void xcd_barrier_complete(unsigned* bar, unsigned x, unsigned& nloc, unsigned& nx) {
  const unsigned G = gridDim.x;
  unsigned sum, cnt, mine, sp = 0u;
  for (;;) {
    sum = 0u; cnt = 0u; mine = 0u;
#pragma unroll
    for (unsigned j = 0; j < 16; ++j) { const unsigned c = xb_ld(&bar[XB_XCNT(j)]); sum += c; cnt += (c > 0u) ? 1u : 0u; mine = (j == x) ? c : mine; }
    if (sum == G) break;
    __builtin_amdgcn_s_sleep(1);
    if ((++sp & 255u) == 0u) { if (xb_ld(&bar[XB_TMO])) break; if (sp > XB_SPIN_CAP) { atomicAdd(&bar[XB_TMO], 1u); break; } }
  }
  nloc = mine > 0u ? mine : 1u; nx = cnt > 0u ? cnt : 1u;
}
DI void xcd_barrier(const XcdBarrier& b) {
  asm volatile("s_waitcnt vmcnt(0)" ::: "memory");
  __syncthreads();
  if (threadIdx.x == 0) {
    unsigned* bar = b.bar;
    __builtin_amdgcn_s_waitcnt(0);
    unsigned nloc = b.st[0], nx = b.st[1];
    if (nloc == 0u) { xcd_barrier_complete(bar, b.x, nloc, nx); b.st[0] = nloc; b.st[1] = nx; }
    const unsigned old = xb_add(&bar[XB_XSUB(b.x)], 1u);
    const unsigned gen = old / nloc;
    if (old + 1u == (gen + 1u) * nloc) {
      __builtin_amdgcn_fence(__ATOMIC_RELEASE, "agent");
      asm volatile("s_waitcnt vmcnt(0)" ::: "memory");
      const unsigned og = xb_add(&bar[XB_TOP], 1u);
      const unsigned tg = og / nx;
      if (og + 1u == (tg + 1u) * nx) xb_add(&bar[XB_TOPGEN], 1u);
      else XB_SPIN(xb_ld(&bar[XB_TOPGEN]) == tg, bar);
      __builtin_amdgcn_fence(__ATOMIC_ACQUIRE, "agent");
      xb_add(&bar[XB_XGEN(b.x)], 1u);
      asm volatile("s_waitcnt vmcnt(0)" ::: "memory");
    } else {
      XB_SPIN(xb_ld(&bar[XB_XGEN(b.x)]) == gen, bar);
      __builtin_amdgcn_fence(__ATOMIC_ACQUIRE, "agent");
      asm volatile("s_waitcnt vmcnt(0)" ::: "memory");
    }
  }
  __syncthreads();
}
#if ONE_LAUNCH
DI void grid_barrier(unsigned* bar, unsigned& target) {
  target += gridDim.x;
  asm volatile("s_waitcnt vmcnt(0)" ::: "memory");
  __syncthreads();
  if (threadIdx.x == 0) {
    __builtin_amdgcn_fence(__ATOMIC_RELEASE, "agent");
    asm volatile("s_waitcnt vmcnt(0)" ::: "memory");
    __hip_atomic_fetch_add(bar, 1u, __ATOMIC_RELAXED, __HIP_MEMORY_SCOPE_AGENT);
    while (__hip_atomic_load(bar, __ATOMIC_RELAXED, __HIP_MEMORY_SCOPE_AGENT) < target) __builtin_amdgcn_s_sleep(2);
    __builtin_amdgcn_fence(__ATOMIC_ACQUIRE, "agent");
    asm volatile("s_waitcnt vmcnt(0)" ::: "memory");
  }
  __syncthreads();
}
__global__ void __launch_bounds__(256, 2) k_mega(Params p) {
  __shared__ __attribute__((aligned(16))) char smem[SMEM_BYTES];
  cg::grid_group grid = cg::this_grid();
#define RUN(n) do { run_phase<n>(p, smem); if (REPEAT_PHASE == n || (REPEAT_PHASE >= 1000 && (((REPEAT_PHASE - 1000) >> n) & 1))) { GSYNC(); run_phase<n>(p, smem); GSYNC(); run_phase<n>(p, smem); } if (REPEAT_PHASE == 203 && n == 3) { GSYNC(); phase_attn(p, smem, 1); GSYNC(); phase_attn(p, smem, 2); } if (REPEAT_PHASE == 100 + n) { GSYNC(); phase_gemm_bf16<true>(p, (const u16*)(p.ws + WS_C), (const u16*)(p.ws + WS_WPQ), 2048, (u16*)(p.ws + WS_F), 1.f, smem); GSYNC(); phase_gemm_bf16<true>(p, (const u16*)(p.ws + WS_C), (const u16*)(p.ws + WS_WPQ), 2048, (u16*)(p.ws + WS_F), 1.f, smem); } } while (0)
#if CUSTOM_BAR
  volatile unsigned* xst = (volatile unsigned*)(smem + 73728 + 1024);
  if (threadIdx.x == 0) { xst[0] = 0u; xst[1] = 0u; }
  __syncthreads();
  const XcdBarrier xb = xcd_barrier_post((unsigned*)(p.ws + WS_XBAR), xst);
#define GSYNC() xcd_barrier(xb)
#else
#define GSYNC() grid.sync()
#endif
  RUN(0); grid.sync();
  RUN(1); GSYNC();
  RUN(2); GSYNC();
  RUN(3); GSYNC();
  RUN(4); GSYNC();
  RUN(5); GSYNC();
  if (REPEAT_PHASE == 300) { GSYNC(); GSYNC(); GSYNC(); GSYNC(); GSYNC(); GSYNC(); GSYNC(); GSYNC(); }
  RUN(6); GSYNC();
  RUN(7); GSYNC();
  RUN(8); GSYNC();
  RUN(9); GSYNC();
  RUN(10); GSYNC();
  RUN(11); GSYNC();
  RUN(12); GSYNC();
  RUN(13); GSYNC();
#if PEER_RESYNC
  {
    const int nrounds = (NT + 8 * (int)gridDim.x - 1) / (8 * (int)gridDim.x);
    for (int rr = 0; rr < nrounds; rr += PEER_RESYNC) { if (rr) GSYNC(); phase_peer(p, rr, rr + PEER_RESYNC); }
  }
#else
  RUN(14);
#endif
}
#endif

extern "C" void kernel_launch(void* const* d_in, const int* in_sizes, int n_in, void* d_out, int out_size, void* d_ws, size_t ws_size,
                              hipStream_t stream) {
  (void)in_sizes; (void)n_in; (void)out_size;
  if (ws_size < WS_TOTAL) { fprintf(stderr, "workspace too small: %zu < %zu\n", ws_size, (size_t)WS_TOTAL); return; }
  Params p{};
  const float** pp = (const float**)&p;
  for (int i = 0; i < 29; ++i) pp[i] = (const float*)d_in[i];
  p.out = (float*)d_out;
  p.ws = (char*)d_ws;
#if ONE_LAUNCH
  static int grid_blocks = 0;
  if (!grid_blocks) {
    int dev = 0, cus = 0, per_cu = 0;
    hipGetDevice(&dev);
    hipDeviceGetAttribute(&cus, hipDeviceAttributeMultiprocessorCount, dev);
    hipOccupancyMaxActiveBlocksPerMultiprocessor(&per_cu, k_mega, 256, 0);
    if (per_cu > 2) per_cu = 2;
    grid_blocks = cus * per_cu;
  }
  hipMemsetAsync((char*)d_ws + WS_BAR, 0, 2048, stream);
  hipMemsetAsync((char*)d_ws + WS_XBAR, 0, 16384, stream);
  void* args[] = {&p};
  hipError_t e = hipLaunchCooperativeKernel((void*)k_mega, dim3(grid_blocks), dim3(256), args, 0, stream);
  if (e != hipSuccess) fprintf(stderr, "cooperative launch failed: %s (grid %d)\n", hipGetErrorString(e), grid_blocks);
#else
  const int G = 512;
  hipMemsetAsync((char*)d_ws + WS_BAR, 0, 2048, stream);
  k_phase<0><<<G, 256, 0, stream>>>(p);
  k_phase<1><<<G, 256, 0, stream>>>(p);
  k_phase<2><<<G, 256, 0, stream>>>(p);
  k_phase<3><<<G, 256, 0, stream>>>(p);
  k_phase<4><<<G, 256, 0, stream>>>(p);
  k_phase<5><<<G, 256, 0, stream>>>(p);
  k_phase<6><<<G, 256, 0, stream>>>(p);
  k_phase<7><<<G, 256, 0, stream>>>(p);
  k_phase<8><<<G, 256, 0, stream>>>(p);
  k_phase<9><<<G, 256, 0, stream>>>(p);
  k_phase<10><<<G, 256, 0, stream>>>(p);
  k_phase<11><<<G, 256, 0, stream>>>(p);
  k_phase<12><<<G, 256, 0, stream>>>(p);
  k_phase<13><<<G, 256, 0, stream>>>(p);
  k_phase<14><<<G, 256, 0, stream>>>(p);
#endif
}
```

```cpp
#include <hip/hip_runtime.h>
#include <hip/hip_cooperative_groups.h>
#include <cstdio>
#include <cstdint>
namespace cg = cooperative_groups;

#ifndef ONE_LAUNCH
#define ONE_LAUNCH 1
#endif

#ifndef USE_FP8
#define USE_FP8 1
#endif
#ifndef SB_EXIT
#define SB_EXIT 1
#endif
#ifndef REPEAT_PHASE
#define REPEAT_PHASE -1
#endif
#ifndef PEER_RESYNC
#define PEER_RESYNC 0
#endif
#ifndef CUSTOM_BAR
#define CUSTOM_BAR 1
#endif
#define DI __device__ __forceinline__
typedef unsigned short u16;
typedef short bf16x8 __attribute__((ext_vector_type(8)));
typedef short s16x4 __attribute__((ext_vector_type(4)));
typedef float f32x16 __attribute__((ext_vector_type(16)));
typedef __bf16 bf2_t __attribute__((ext_vector_type(2)));
typedef float f2_t __attribute__((ext_vector_type(2)));
#define MFMA(a, b, c) __builtin_amdgcn_mfma_f32_32x32x16_bf16((a), (b), (c), 0, 0, 0)

constexpr int DM = 1024;
constexpr int NTP = 32768;
constexpr int NTS = 1024;
constexpr int NT = NTP + NTS;
constexpr int SEQ = 2048, DSEQ = 64, PAST = 4096, NMEM = 256;
constexpr int INC = 3080, INCP = 3200;
constexpr float DN_ALPHA = 1.189207115002721f;
constexpr float LOG2E = 1.4426950408889634f;

constexpr size_t OUT_YP = 0;
constexpr size_t OUT_YS = OUT_YP + (size_t)NTP * DM;
constexpr size_t OUT_SBK_P = OUT_YS + (size_t)NTS * DM;
constexpr size_t OUT_SBV_P = OUT_SBK_P + (size_t)NTP * 512;
constexpr size_t OUT_FXK_P = OUT_SBV_P + (size_t)NTP * 512;
constexpr size_t OUT_FXV_P = OUT_FXK_P + (size_t)NTP * 512;
constexpr size_t OUT_LF_P = OUT_FXV_P + (size_t)NTP * 512;
constexpr size_t OUT_MK_P = OUT_LF_P + (size_t)NTP * 8;
constexpr size_t OUT_MV_P = OUT_MK_P + (size_t)4096 * DM;
constexpr size_t OUT_SBK_S = OUT_MV_P + (size_t)4096 * DM;
constexpr size_t OUT_SBV_S = OUT_SBK_S + (size_t)NTS * 512;
constexpr size_t OUT_FXK_S = OUT_SBV_S + (size_t)NTS * 512;
constexpr size_t OUT_FXV_S = OUT_FXK_S + (size_t)NTS * 512;
constexpr size_t OUT_LF_S = OUT_FXV_S + (size_t)NTS * 512;
constexpr size_t OUT_TOTAL = OUT_LF_S + (size_t)NTS * 8;

constexpr size_t WS_WIN = 0;
constexpr size_t WS_WOUT = WS_WIN + (size_t)INCP * DM * 2;
constexpr size_t WS_WMQ = WS_WOUT + (size_t)DM * DM * 2;
constexpr size_t WS_WMKV = WS_WMQ + (size_t)DM * DM * 2;
constexpr size_t WS_WMO = WS_WMKV + (size_t)2048 * DM * 2;
constexpr size_t WS_WPQ = WS_WMO + (size_t)DM * DM * 2;
constexpr size_t WS_KA = WS_WPQ + (size_t)2048 * DM * 2;
constexpr size_t WS_KB = WS_KA + (size_t)8 * 128 * 128 * 2;
constexpr size_t WS_U = WS_KB + (size_t)8 * 128 * 128 * 2;
constexpr size_t WS_V = WS_U + (size_t)16384 * DM * 2;
constexpr size_t WS_MEMK = WS_V + (size_t)16384 * DM * 2;
constexpr size_t WS_MEMVT = WS_MEMK + (size_t)32 * 256 * DM * 2;
constexpr size_t WS_A = WS_MEMVT + (size_t)32 * 256 * DM * 2;
constexpr size_t WS_B = WS_A + (size_t)NT * DM * 4;
constexpr size_t WS_C = WS_B + (size_t)NT * DM * 4;
constexpr size_t WS_D = WS_C + (size_t)NT * DM * 2;
constexpr size_t WS_E = WS_D + (size_t)NT * DM * 2;
constexpr size_t WS_F = WS_E + (size_t)NT * DM * 2;
constexpr size_t WS_BAR = WS_F + (size_t)NT * DM * 4;
constexpr size_t WS_USC = WS_BAR + 2048;
constexpr size_t WS_VSC = WS_USC + (size_t)16384 * 4;
constexpr size_t WS_CBP = WS_VSC + (size_t)16384 * 4;
constexpr size_t WS_CBS = WS_CBP + (size_t)128 * 2048 * 4;
constexpr size_t WS_SSQ = WS_CBS + (size_t)128 * 4160 * 4;
constexpr size_t WS_XBAR = WS_SSQ + (size_t)NT * 2 * 4;
constexpr size_t WS_TOTAL = WS_XBAR + 16384;

struct Params {
  const float *x_prompt, *x_sample, *mem_prompt, *c_sb_k, *c_sb_v, *c_fx_k, *c_fx_v, *c_fx_logf, *c_mem_k, *c_mem_v;
  const float *w_in, *b_f, *w_gn, *w_out, *ln1_g, *ln1_b, *w_mq, *w_mk, *w_mv, *w_mo, *ln2_g, *ln2_b;
  const float *w_pq, *keys_a, *keys_b, *peer_u, *peer_v, *ln3_g, *ln3_b;
  float* out;
  char* ws;
};

DI const Params* kparams() { auto ka = __builtin_amdgcn_kernarg_segment_ptr(); asm volatile("" : "+s"(ka)); return (const Params*)ka; }
constexpr int SMEM_BYTES = 73728 + 1024 + 64;

DI unsigned pk2(float a, float b) { f2_t v = {a, b}; bf2_t r = __builtin_convertvector(v, bf2_t); return __builtin_bit_cast(unsigned, r); }
DI u16 bf1(float a) { return (u16)(pk2(a, 0.f) & 0xffffu); }
DI float bflo(unsigned w) { return __uint_as_float(w << 16); }
DI float bfhi(unsigned w) { return __uint_as_float(w & 0xffff0000u); }
DI float wave_sum(float v) {
#pragma unroll
  for (int o = 32; o >= 1; o >>= 1) v += __shfl_xor(v, o);
  return v;
}
DI float wave_max(float v) {
#pragma unroll
  for (int o = 32; o >= 1; o >>= 1) v = fmaxf(v, __shfl_xor(v, o));
  return v;
}
DI int vblock() { int nb = gridDim.x, b = blockIdx.x; return ((nb & 7) == 0) ? (b & 7) * (nb >> 3) + (b >> 3) : b; }
DI const float* xrow(const Params& p, int g) { return g < NTP ? p.x_prompt + (size_t)g * DM : p.x_sample + (size_t)(g - NTP) * DM; }

DI void tconv_tile(const float* src, int ldsrc, int C, u16* dst, int lddst, const float* rowscale, int tr, int tc, float* tile) {
  const int tid = threadIdx.x;
  {
    const int r = tid >> 2, c0 = (tid & 3) * 16;
    const int gr = tr * 64 + r;
    const float sc = rowscale ? rowscale[gr] : 1.f;
#pragma unroll
    for (int j = 0; j < 4; ++j) {
      const int gc = tc * 64 + c0 + 4 * j;
      float4 v = make_float4(0.f, 0.f, 0.f, 0.f);
      if (gc < C) v = *(const float4*)(src + (size_t)gr * ldsrc + gc);
      float* t = tile + r * 65 + c0 + 4 * j;
      t[0] = v.x * sc; t[1] = v.y * sc; t[2] = v.z * sc; t[3] = v.w * sc;
    }
  }
  __syncthreads();
  {
    const int n = tid >> 2, k0 = (tid & 3) * 16;
    unsigned w[8];
#pragma unroll
    for (int e = 0; e < 8; ++e) w[e] = pk2(tile[(k0 + 2 * e) * 65 + n], tile[(k0 + 2 * e + 1) * 65 + n]);
    uint4* d = (uint4*)(dst + (size_t)(tc * 64 + n) * lddst + tr * 64 + k0);
    d[0] = make_uint4(w[0], w[1], w[2], w[3]);
    d[1] = make_uint4(w[4], w[5], w[6], w[7]);
  }
  __syncthreads();
}

DI void conv_range(const float* src, u16* dst, size_t n8, int bid, int nb) {
  const size_t step = (size_t)nb * 256;
  size_t i = (size_t)bid * 256 + threadIdx.x;
  for (; i + 3 * step < n8; i += 4 * step) {
    float4 a[4], b[4];
#pragma unroll
    for (int u = 0; u < 4; ++u) { a[u] = ((const float4*)src)[2 * (i + u * step)]; b[u] = ((const float4*)src)[2 * (i + u * step) + 1]; }
#pragma unroll
    for (int u = 0; u < 4; ++u) ((uint4*)dst)[i + u * step] = make_uint4(pk2(a[u].x, a[u].y), pk2(a[u].z, a[u].w), pk2(b[u].x, b[u].y), pk2(b[u].z, b[u].w));
  }
  for (; i < n8; i += step) {
    const float4 a = ((const float4*)src)[2 * i], b = ((const float4*)src)[2 * i + 1];
    ((uint4*)dst)[i] = make_uint4(pk2(a.x, a.y), pk2(a.z, a.w), pk2(b.x, b.y), pk2(b.z, b.w));
  }
}

DI void phase_prep(const Params& p, char* smem) {
  float* tile = (float*)smem;
  const int bid = blockIdx.x, nb = gridDim.x;
  u16* ws16 = (u16*)p.ws;
  constexpr int T_WIN = 16 * 50, T_SQ = 256, T_PQ = 16 * 32, T_MV = 16 * 4 * 16;
  constexpr int T0 = T_WIN, T1 = T0 + T_SQ, T2 = T1 + T_SQ, T3 = T2 + T_SQ, T4 = T3 + T_SQ, T5 = T4 + T_SQ, T6 = T5 + T_PQ, T7 = T6 + T_MV;
  for (int t = bid; t < T7; t += nb) {
    if (t < T0) { tconv_tile(p.w_in, INC, INC, (u16*)(p.ws + WS_WIN), DM, nullptr, t / 50, t % 50, tile); }
    else if (t < T1) { int u = t - T0; tconv_tile(p.w_out, DM, DM, (u16*)(p.ws + WS_WOUT), DM, p.w_gn, u >> 4, u & 15, tile); }
    else if (t < T2) { int u = t - T1; tconv_tile(p.w_mq, DM, DM, (u16*)(p.ws + WS_WMQ), DM, nullptr, u >> 4, u & 15, tile); }
    else if (t < T3) { int u = t - T2; tconv_tile(p.w_mk, DM, DM, (u16*)(p.ws + WS_WMKV), DM, nullptr, u >> 4, u & 15, tile); }
    else if (t < T4) { int u = t - T3; tconv_tile(p.w_mv, DM, DM, (u16*)(p.ws + WS_WMKV) + (size_t)DM * DM, DM, nullptr, u >> 4, u & 15, tile); }
    else if (t < T5) { int u = t - T4; tconv_tile(p.w_mo, DM, DM, (u16*)(p.ws + WS_WMO), DM, nullptr, u >> 4, u & 15, tile); }
    else if (t < T6) { int u = t - T5; tconv_tile(p.w_pq, 2048, 2048, (u16*)(p.ws + WS_WPQ), DM, nullptr, u >> 5, u & 31, tile); }
    else { int u = t - T6; int b = u >> 6, r = u & 63;
      tconv_tile(p.c_mem_v + (size_t)b * 256 * DM, DM, DM, (u16*)(p.ws + WS_MEMVT) + (size_t)(16 + b) * DM * 256, 256, nullptr, r >> 4, r & 15, tile); }
  }
  (void)ws16;
  for (int i = bid * 256 + threadIdx.x; i < NT * 2; i += nb * 256) ((float*)(p.ws + WS_SSQ))[i] = 0.f;
  conv_range(p.x_prompt, (u16*)(p.ws + WS_C), (size_t)NTP * DM / 8, bid, nb);
  conv_range(p.x_sample, (u16*)(p.ws + WS_C) + (size_t)NTP * DM, (size_t)NTS * DM / 8, bid, nb);
  conv_range(p.mem_prompt, (u16*)(p.ws + WS_E), (size_t)4096 * DM / 8, bid, nb);
  conv_range(p.c_mem_k, (u16*)(p.ws + WS_MEMK) + (size_t)16 * 256 * DM, (size_t)16 * 256 * DM / 8, bid, nb);
  conv_range(p.keys_a, (u16*)(p.ws + WS_KA), (size_t)8 * 128 * 128 / 8, bid, nb);
  conv_range(p.keys_b, (u16*)(p.ws + WS_KB), (size_t)8 * 128 * 128 / 8, bid, nb);
#if USE_FP8
  {
    const int lane = threadIdx.x & 63;
    const int wg = bid * 4 + (threadIdx.x >> 6), nw = nb * 4;
    for (int row0 = wg; row0 < 32768; row0 += 2 * nw) {
      float4 a[2][4];
      float am[2];
#pragma unroll
      for (int u = 0; u < 2; ++u) {
        const int row = row0 + u * nw;
        const bool isv = row >= 16384;
        const int r = isv ? row - 16384 : row;
        const float4* src = (const float4*)((isv ? p.peer_v : p.peer_u) + (size_t)r * DM) + 4 * lane;
        am[u] = 0.f;
#pragma unroll
        for (int j = 0; j < 4; ++j) { a[u][j] = src[j]; am[u] = fmaxf(am[u], fmaxf(fmaxf(fabsf(a[u][j].x), fabsf(a[u][j].y)), fmaxf(fabsf(a[u][j].z), fabsf(a[u][j].w)))); }
      }
#pragma unroll
      for (int o = 32; o >= 1; o >>= 1)
#pragma unroll
        for (int u = 0; u < 2; ++u) am[u] = fmaxf(am[u], __shfl_xor(am[u], o));
#pragma unroll
      for (int u = 0; u < 2; ++u) {
        const int row = row0 + u * nw;
        const bool isv = row >= 16384;
        const int r = isv ? row - 16384 : row;
        int ex = 0;
        if (am[u] > 0.f) (void)frexpf(am[u], &ex);
        const float sc = ldexpf(1.f, 8 - ex), isc = ldexpf(1.f, ex - 8);
        unsigned w[4];
#pragma unroll
        for (int j = 0; j < 4; ++j) {
          int t = __builtin_amdgcn_cvt_pk_fp8_f32(a[u][j].x * sc, a[u][j].y * sc, 0, false);
          t = __builtin_amdgcn_cvt_pk_fp8_f32(a[u][j].z * sc, a[u][j].w * sc, t, true);
          w[j] = (unsigned)t;
        }
        *(uint4*)(p.ws + (isv ? WS_V : WS_U) + (size_t)r * DM + 16 * lane) = make_uint4(w[0], w[1], w[2], w[3]);
        if (lane == 0) ((float*)(p.ws + (isv ? WS_VSC : WS_USC)))[r] = isc;
      }
    }
  }
#else
  conv_range(p.peer_u, (u16*)(p.ws + WS_U), (size_t)16384 * DM / 8, bid, nb);
  conv_range(p.peer_v, (u16*)(p.ws + WS_V), (size_t)16384 * DM / 8, bid, nb);
#endif
}

#define ACC_ROW(e, hh) (((e) & 3) + 8 * ((e) >> 2) + 4 * (hh))
#define ACC_R0(e) (((e) & 3) + 8 * ((e) >> 2))
DI void store_bf16_pairs(u16* O, unsigned b0, unsigned ld, const f32x16& acc, float scale) {
  const bool odd = (threadIdx.x & 1) != 0;
#pragma unroll
  for (int e = 0; e < 16; e += 2) {
    const float a = acc[e] * scale, b = acc[e + 1] * scale;
    const float snd = odd ? a : b;
    const float rcv = __int_as_float(__builtin_amdgcn_update_dpp(0, __float_as_int(snd), 0xB1, 0xF, 0xF, true));
    const unsigned w = odd ? pk2(rcv, b) : pk2(a, rcv);
    const unsigned idx = b0 + (ACC_R0(e) + (odd ? 1u : 0u)) * ld - (odd ? 1u : 0u);
    *(unsigned*)(O + idx) = w;
  }
}
template <int V> struct IC { static constexpr int value = V; };
struct SmemGemm { u16 a[2][128 * 64]; u16 b[2][128 * 64]; };

template <int ROWS>
struct GldsBf16 {
  const u16* base; int ld;
  DI void issue(int kt, u16* lds, int tid) {
    const int wid = tid >> 6, lane = tid & 63;
    constexpr int NCH = ROWS / 32;
#pragma unroll
    for (int q = 0; q < NCH; ++q) {
      const int ch = wid * NCH + q;
      const int r = ch * 8 + (lane >> 3);
      const int c = (lane & 7) ^ ((r >> 1) & 7);
      __builtin_amdgcn_global_load_lds((const unsigned*)(base + (size_t)r * ld + kt * 64 + c * 8), (unsigned*)(lds + ch * 512), 16, 0, 0);
    }
  }
  DI void commit(u16*, int) {}
};
#ifndef GEMM_REG2
#define GEMM_REG2 1
#endif
#if GEMM_REG2
typedef unsigned u32x4 __attribute__((ext_vector_type(4)));
template <int ROWS>
struct LdReg {
  static constexpr int N = ROWS / 32;
  const u16* base; int ld;
  u32x4 r0, r1, r2, r3;
  DI const u32x4* src(int kt, int tid, int i) const { const int c = tid + 256 * i; return (const u32x4*)(base + (size_t)(c >> 3) * ld + kt * 64 + (c & 7) * 8); }
  DI static u32x4* dst(u16* lds, int tid, int i) { const int c = tid + 256 * i; const int row = c >> 3; return (u32x4*)(lds + row * 64 + (((c & 7) ^ ((row >> 1) & 7)) * 8)); }
  DI void fetch(int kt, int tid) {
    r0 = *src(kt, tid, 0); r1 = *src(kt, tid, 1);
    if (N > 2) { r2 = *src(kt, tid, 2); r3 = *src(kt, tid, 3); }
  }
  DI void stash(u16* lds, int tid) const {
    *dst(lds, tid, 0) = r0; *dst(lds, tid, 1) = r1;
    if (N > 2) { *dst(lds, tid, 2) = r2; *dst(lds, tid, 3) = r3; }
  }
};
template <int MI, bool GRMS>
DI void gemm_compute(const u16* pa, const u16* pb, f32x16 (&acc)[MI][MI], int o0, int o1, int o2, int o3, int wr, int hh, bool scale_now, const float* rsc) {
  if (GRMS && scale_now) {
#pragma unroll
    for (int i = 0; i < MI; ++i)
#pragma unroll
      for (int e = 0; e < 16; ++e) {
        const float rt = rsc[((wr * MI + i) * 32 + ACC_ROW(e, hh)) * 2];
#pragma unroll
        for (int j = 0; j < MI; ++j) acc[i][j][e] *= rt;
      }
  }
  const int off[4] = {o0, o1, o2, o3};
  bf16x8 af[2][MI], bfr[2][MI];
#pragma unroll
  for (int i = 0; i < MI; ++i) { af[0][i] = *(const bf16x8*)(pa + i * 32 * 64 + off[0]); bfr[0][i] = *(const bf16x8*)(pb + i * 32 * 64 + off[0]); }
#pragma unroll
  for (int kk = 0; kk < 4; ++kk) {
    if (kk < 3) {
#pragma unroll
      for (int i = 0; i < MI; ++i) { af[(kk + 1) & 1][i] = *(const bf16x8*)(pa + i * 32 * 64 + off[kk + 1]); bfr[(kk + 1) & 1][i] = *(const bf16x8*)(pb + i * 32 * 64 + off[kk + 1]); }
    }
#pragma unroll
    for (int i = 0; i < MI; ++i)
#pragma unroll
      for (int j = 0; j < MI; ++j) acc[i][j] = MFMA(af[kk & 1][i], bfr[kk & 1][j], acc[i][j]);
  }
}
template <int MI, bool GRMS = false, class AL, class EPI>
DI void gemm_tile(AL& al, const u16* Bt, int ldb, int K, int m0, int n0, EPI epi, char* smem, const float* rsc = nullptr) {
  SmemGemm& sm = *(SmemGemm*)smem;
  const int tid = threadIdx.x, lane = tid & 63, wid = tid >> 6, wr = wid >> 1, wc = wid & 1, r31 = lane & 31, hh = lane >> 5;
  LdReg<MI * 64> a0, a1, b0, b1;
  a0.base = al.base; a0.ld = al.ld; a1.base = al.base; a1.ld = al.ld;
  b0.base = Bt + (size_t)n0 * ldb; b0.ld = ldb; b1.base = b0.base; b1.ld = ldb;
  f32x16 acc[MI][MI];
#pragma unroll
  for (int i = 0; i < MI; ++i)
#pragma unroll
    for (int j = 0; j < MI; ++j)
#pragma unroll
      for (int e = 0; e < 16; ++e) acc[i][j][e] = 0.f;
  int off[4];
#pragma unroll
  for (int kk = 0; kk < 4; ++kk) off[kk] = r31 * 64 + (((kk * 2 + hh) ^ ((r31 >> 1) & 7)) * 8);
  const int KT = K >> 6;
  a0.fetch(0, tid); b0.fetch(0, tid);
  a1.fetch(1, tid); b1.fetch(1, tid);
  a0.stash(sm.a[0], tid); b0.stash(sm.b[0], tid);
  __syncthreads();
  for (int kt = 0; kt < KT; kt += 2) {
    { const int kn = min(kt + 2, KT - 1); a0.fetch(kn, tid); b0.fetch(kn, tid); }
    gemm_compute<MI, GRMS>(sm.a[0] + (wr * MI * 32) * 64, sm.b[0] + (wc * MI * 32) * 64, acc, off[0], off[1], off[2], off[3], wr, hh, kt == (KT >> 1), rsc);
    a1.stash(sm.a[1], tid); b1.stash(sm.b[1], tid);
    __syncthreads();
    { const int kn = min(kt + 3, KT - 1); a1.fetch(kn, tid); b1.fetch(kn, tid); }
    gemm_compute<MI, GRMS>(sm.a[1] + (wr * MI * 32) * 64, sm.b[1] + (wc * MI * 32) * 64, acc, off[0], off[1], off[2], off[3], wr, hh, (kt + 1) == (KT >> 1), rsc);
    a0.stash(sm.a[0], tid); b0.stash(sm.b[0], tid);
    __syncthreads();
  }
  if (GRMS) {
#pragma unroll
    for (int i = 0; i < MI; ++i)
#pragma unroll
      for (int e = 0; e < 16; ++e) {
        const float s1 = rsc[((wr * MI + i) * 32 + ACC_ROW(e, hh)) * 2 + 1];
#pragma unroll
        for (int j = 0; j < MI; ++j) acc[i][j][e] *= s1;
      }
  }
#pragma unroll
  for (int i = 0; i < MI; ++i)
#pragma unroll
    for (int j = 0; j < MI; ++j) epi(m0 + (wr * MI + i) * 32, n0 + (wc * MI + j) * 32, acc[i][j]);
}
#else
template <int MI, bool GRMS = false, class AL, class EPI>
DI void gemm_tile(AL& al, const u16* Bt, int ldb, int K, int m0, int n0, EPI epi, char* smem, const float* rsc = nullptr) {
  SmemGemm& sm = *(SmemGemm*)smem;
  const int tid = threadIdx.x, lane = tid & 63, wid = tid >> 6, wr = wid >> 1, wc = wid & 1, r31 = lane & 31, hh = lane >> 5;
  GldsBf16<MI * 64> bl; bl.base = Bt + (size_t)n0 * ldb; bl.ld = ldb;
  f32x16 acc[MI][MI];
#pragma unroll
  for (int i = 0; i < MI; ++i)
#pragma unroll
    for (int j = 0; j < MI; ++j)
#pragma unroll
      for (int e = 0; e < 16; ++e) acc[i][j][e] = 0.f;
  int off[4];
#pragma unroll
  for (int kk = 0; kk < 4; ++kk) off[kk] = r31 * 64 + (((kk * 2 + hh) ^ ((r31 >> 1) & 7)) * 8);
  const int KT = K >> 6;
  al.issue(0, sm.a[0], tid); bl.issue(0, sm.b[0], tid);
  al.commit(sm.a[0], tid);
  asm volatile("s_waitcnt vmcnt(0)" ::: "memory");
  __syncthreads();
  for (int kt = 0; kt < KT; ++kt) {
    const int cur = kt & 1;
    if (kt + 1 < KT) { al.issue(kt + 1, sm.a[cur ^ 1], tid); bl.issue(kt + 1, sm.b[cur ^ 1], tid); }
    const u16* pa = sm.a[cur] + (wr * MI * 32) * 64;
    const u16* pb = sm.b[cur] + (wc * MI * 32) * 64;
    if (GRMS && kt == (KT >> 1)) {
#pragma unroll
      for (int i = 0; i < MI; ++i)
#pragma unroll
        for (int e = 0; e < 16; ++e) {
          const float rt = rsc[((wr * MI + i) * 32 + ACC_ROW(e, hh)) * 2];
#pragma unroll
          for (int j = 0; j < MI; ++j) acc[i][j][e] *= rt;
        }
    }
#pragma unroll
    for (int kk = 0; kk < 4; ++kk) {
      bf16x8 af[MI], bfr[MI];
#pragma unroll
      for (int i = 0; i < MI; ++i) { af[i] = *(const bf16x8*)(pa + i * 32 * 64 + off[kk]); bfr[i] = *(const bf16x8*)(pb + i * 32 * 64 + off[kk]); }
#pragma unroll
      for (int i = 0; i < MI; ++i)
#pragma unroll
        for (int j = 0; j < MI; ++j) acc[i][j] = MFMA(af[i], bfr[j], acc[i][j]);
    }
    if (kt + 1 < KT) al.commit(sm.a[cur ^ 1], tid);
    asm volatile("s_waitcnt vmcnt(0)" ::: "memory");
    __syncthreads();
  }
  if (GRMS) {
#pragma unroll
    for (int i = 0; i < MI; ++i)
#pragma unroll
      for (int e = 0; e < 16; ++e) {
        const float s1 = rsc[((wr * MI + i) * 32 + ACC_ROW(e, hh)) * 2 + 1];
#pragma unroll
        for (int j = 0; j < MI; ++j) acc[i][j][e] *= s1;
      }
  }
#pragma unroll
  for (int i = 0; i < MI; ++i)
#pragma unroll
    for (int j = 0; j < MI; ++j) epi(m0 + (wr * MI + i) * 32, n0 + (wc * MI + j) * 32, acc[i][j]);
}
#endif
template <class F>
DI void for_tiles(int N, F body) {
  const int vb = vblock(), nb = gridDim.x;
  const int ntn = N >> 7, ntn2 = N >> 6;
  const int nbig = 256 * ntn, nsmall = 16 * ntn2;
  for (int t = vb; t < nbig + nsmall; t += nb) {
    if (t < nbig) { body((t / ntn) * 128, (t % ntn) * 128, IC<2>{}); }
    else { const int u = t - nbig; body(NTP + (u / ntn2) * 64, (u % ntn2) * 64, IC<1>{}); }
  }
}

DI void phase_proj(const Params& p, char* smem) {
  const int vb = vblock(), nb = gridDim.x;
  constexpr int T_G1 = 264 * 25, T_MKV = 32 * 16;
  float* out = p.out;
  for (int t = vb; t < T_G1 + T_MKV; t += nb) {
    if (t < T_G1) {
      const int mt = t / 25, nt = t % 25;
      const int m0 = mt * 128, n0 = nt * 128;
      GldsBf16<128> al; al.base = (const u16*)(p.ws + WS_C) + (size_t)m0 * DM; al.ld = DM;
      const bool smp = m0 >= NTP;
      const float* b_f = p.b_f;
      u16* qsb = (u16*)(p.ws + WS_D);
      u16* qfx = qsb + (size_t)NT * 512;
      char* ws = p.ws;
      auto epi = [=](int r0, int c0, const f32x16& acc) {
        const int lane = threadIdx.x & 63, hh = lane >> 5, col = c0 + (lane & 31);
        const int seg = c0 >> 9, cc = col & 511;
        if (seg == 0 || seg == 3) {
          u16* q = (seg == 0) ? qsb : qfx;
#pragma unroll
          for (int e = 0; e < 16; ++e) q[(unsigned)(r0 + 4 * hh) * 512u + cc + ACC_R0(e) * 512u] = bf1(acc[e] * 0.125f);
        } else if (seg < 6) {
          size_t ob;
          if (!smp) ob = (seg == 1) ? OUT_SBK_P : (seg == 2) ? OUT_SBV_P : (seg == 4) ? OUT_FXK_P : OUT_FXV_P;
          else ob = (seg == 1) ? OUT_SBK_S : (seg == 2) ? OUT_SBV_S : (seg == 4) ? OUT_FXK_S : OUT_FXV_S;
          const int rb = smp ? r0 - NTP : r0;
          float* ov = out + ob;
          const unsigned b0 = (unsigned)(rb + 4 * hh) * 512u + cc;
#pragma unroll
          for (int e = 0; e < 16; ++e) ov[b0 + ACC_R0(e) * 512u] = acc[e];
          if (!smp) {
            if (seg == 1 || seg == 4) {
              u16* k16 = (u16*)(ws + WS_A) + (seg == 4 ? (size_t)NTP * 512 : 0);
#pragma unroll
              for (int e = 0; e < 16; ++e) k16[b0 + ACC_R0(e) * 512u] = bf1(acc[e]);
            } else {
              u16* vt16 = (u16*)(ws + WS_B) + (seg == 5 ? (size_t)NTP * 512 : 0);
              const unsigned vb0 = (unsigned)(((r0 >> 11) * 8 + (cc >> 6)) * 64 + (cc & 63)) * 2048u + (unsigned)(r0 & 2047) + 4 * hh;
#pragma unroll
              for (int g4 = 0; g4 < 4; ++g4) *(uint2*)(vt16 + vb0 + 8 * g4) = make_uint2(pk2(acc[4 * g4], acc[4 * g4 + 1]), pk2(acc[4 * g4 + 2], acc[4 * g4 + 3]));
            }
          }
        } else {
          const int c = col - 3072;
          if (c < 8) {
            const float bf = b_f[c];
            const size_t ob = smp ? OUT_LF_S : OUT_LF_P;
            const int rb = smp ? r0 - NTP : r0;
#pragma unroll
            for (int e = 0; e < 16; ++e) {
              const float z = acc[e] + bf;
              const float ls = fminf(z, 0.f) - log1pf(__expf(-fabsf(z)));
              out[ob + (unsigned)(rb + ACC_ROW(e, hh)) * 8u + c] = ls;
            }
          }
        }
      };
      gemm_tile<2>(al, (const u16*)(p.ws + WS_WIN), DM, DM, m0, n0, epi, smem);
    } else {
      const int u = t - T_G1;
      const int mt = u >> 4, nt = u & 15;
      const int m0 = mt * 128, n0 = nt * 128;
      GldsBf16<128> al; al.base = (const u16*)(p.ws + WS_E) + (size_t)m0 * DM; al.ld = DM;
      u16* kb = (u16*)(p.ws + WS_MEMK);
      u16* vt = (u16*)(p.ws + WS_MEMVT);
      auto epi = [=](int r0, int c0, const f32x16& acc) {
        const int lane = threadIdx.x & 63, hh = lane >> 5, col = c0 + (lane & 31);
        if (c0 < 1024) {
          float* ov = out + OUT_MK_P;
          const unsigned b0 = (unsigned)(r0 + 4 * hh) * 1024u + col;
#pragma unroll
          for (int e = 0; e < 16; ++e) { const unsigned idx = b0 + ACC_R0(e) * 1024u; ov[idx] = acc[e]; kb[idx] = bf1(acc[e]); }
        } else {
          const int c = col - 1024;
          float* ov = out + OUT_MV_P;
          const unsigned b0 = (unsigned)(r0 + 4 * hh) * 1024u + c;
#pragma unroll
          for (int e = 0; e < 16; ++e) ov[b0 + ACC_R0(e) * 1024u] = acc[e];
          const int b = r0 >> 8;
#pragma unroll
          for (int g4 = 0; g4 < 4; ++g4) {
            const int m = (r0 & 255) + 8 * g4 + 4 * hh;
            *(uint2*)(vt + ((size_t)b * DM + c) * 256 + m) = make_uint2(pk2(acc[4 * g4], acc[4 * g4 + 1]), pk2(acc[4 * g4 + 2], acc[4 * g4 + 3]));
          }
        }
      };
      gemm_tile<2>(al, (const u16*)(p.ws + WS_WMKV), DM, DM, m0, n0, epi, smem);
    }
  }
}

template <int PER>
DI void scan_one(const float* src0, int n0, const float* src1, int n, float* dst, float* part) {
  const int tid = threadIdx.x;
  const int s0 = tid * PER;
  float v[PER];
#pragma unroll
  for (int i = 0; i < PER; ++i) { const int s = s0 + i; v[i] = (s < n) ? ((s < n0) ? src0[(size_t)s * 8] : src1[(size_t)(s - n0) * 8]) : 0.f; }
  float loc = 0.f;
#pragma unroll
  for (int i = 0; i < PER; ++i) loc += v[i];
  part[tid] = loc;
  __syncthreads();
  float run = 0.f;
  for (int i = 0; i < tid; ++i) run += part[i];
#pragma unroll
  for (int i = 0; i < PER; ++i) { run += v[i]; if (s0 + i < n) dst[s0 + i] = -run * LOG2E; }
  __syncthreads();
}
DI void phase_scan(const Params& p, char* smem) {
  float* part = (float*)smem;
  for (int it = blockIdx.x; it < 256; it += gridDim.x) {
    const int bh = it & 127, b = bh >> 3, h = bh & 7;
    if (it < 128) scan_one<17>(p.c_fx_logf + (size_t)b * PAST * 8 + h, PAST, p.out + OUT_LF_S + (size_t)b * DSEQ * 8 + h, PAST + DSEQ, (float*)(p.ws + WS_CBS) + (size_t)bh * 4160, part);
    else scan_one<8>(p.out + OUT_LF_P + (size_t)b * SEQ * 8 + h, SEQ, nullptr, SEQ, (float*)(p.ws + WS_CBP) + (size_t)bh * 2048, part);
  }
}

constexpr int KLD = 72, VLD = 68;
struct SmemAttn { u16 k[2][64 * KLD]; u16 vt[2][64 * VLD]; float cb[4160]; float part[256]; u16 q[128 * KLD]; };
static_assert(sizeof(SmemAttn) <= SMEM_BYTES, "attn smem");

struct KVRegs { float4 k[4], v[4]; };
DI void kv_fetch(KVRegs& r, const float* kb, const float* vb, int tid) {
#pragma unroll
  for (int i = 0; i < 4; ++i) { const int c = tid + 256 * i; const size_t o = (size_t)(c >> 4) * 512 + (c & 15) * 4; r.k[i] = *(const float4*)(kb + o); r.v[i] = *(const float4*)(vb + o); }
}
DI void kv_stash(const KVRegs& r, u16* ks, u16* vts, int tid) {
#pragma unroll
  for (int i = 0; i < 4; ++i) {
    const int c = tid + 256 * i; const int row = c >> 4, c4 = (c & 15) * 4;
    *(uint2*)(ks + row * KLD + c4) = make_uint2(pk2(r.k[i].x, r.k[i].y), pk2(r.k[i].z, r.k[i].w));
    vts[(c4 + 0) * VLD + row] = bf1(r.v[i].x); vts[(c4 + 1) * VLD + row] = bf1(r.v[i].y);
    vts[(c4 + 2) * VLD + row] = bf1(r.v[i].z); vts[(c4 + 3) * VLD + row] = bf1(r.v[i].w);
  }
}
typedef unsigned kv_u32x4 __attribute__((ext_vector_type(4)));
typedef unsigned kv_u32x2 __attribute__((ext_vector_type(2)));
struct KV16 { kv_u32x4 k0, k1, v0, v1; };
DI void kv_fetch16(KV16& r, const u16* kb, const u16* vtb, int tid) {
  const int c0 = tid, c1 = tid + 256;
  r.k0 = *(const kv_u32x4*)(kb + (size_t)(c0 >> 3) * 512 + (c0 & 7) * 8); r.k1 = *(const kv_u32x4*)(kb + (size_t)(c1 >> 3) * 512 + (c1 & 7) * 8);
  r.v0 = *(const kv_u32x4*)(vtb + (size_t)(c0 >> 3) * SEQ + (c0 & 7) * 8); r.v1 = *(const kv_u32x4*)(vtb + (size_t)(c1 >> 3) * SEQ + (c1 & 7) * 8);
}
DI void kv_stash16(const KV16& r, u16* ks, u16* vts, int tid) {
  const int c0 = tid, c1 = tid + 256;
  *(kv_u32x4*)(ks + (c0 >> 3) * KLD + (c0 & 7) * 8) = r.k0;
  *(kv_u32x4*)(ks + (c1 >> 3) * KLD + (c1 & 7) * 8) = r.k1;
  kv_u32x2 a = {r.v0[0], r.v0[1]}, b2 = {r.v0[2], r.v0[3]}, c = {r.v1[0], r.v1[1]}, d = {r.v1[2], r.v1[3]};
  *(kv_u32x2*)(vts + (c0 >> 3) * VLD + (c0 & 7) * 8) = a; *(kv_u32x2*)(vts + (c0 >> 3) * VLD + (c0 & 7) * 8 + 4) = b2;
  *(kv_u32x2*)(vts + (c1 >> 3) * VLD + (c1 & 7) * 8) = c; *(kv_u32x2*)(vts + (c1 >> 3) * VLD + (c1 & 7) * 8 + 4) = d;
}
DI bf16x8 pack8(const f32x16& x, int s) {
  union { unsigned u[4]; bf16x8 v; } t;
  t.u[0] = pk2(x[8 * s + 0], x[8 * s + 1]); t.u[1] = pk2(x[8 * s + 2], x[8 * s + 3]);
  t.u[2] = pk2(x[8 * s + 4], x[8 * s + 5]); t.u[3] = pk2(x[8 * s + 6], x[8 * s + 7]);
  return t.v;
}

template <bool FOX, bool SMP>
DI void attn_item(const Params& p, int b, int h, int qb, char* smem, bool do_ssq = true, int split = 0) {
  constexpr int smp = SMP ? 1 : 0;
  constexpr bool SPLIT = FOX && SMP;
  SmemAttn& sm = *(SmemAttn*)smem;
  const int tid = threadIdx.x, lane = tid & 63, wid = tid >> 6, r31 = lane & 31, hh = lane >> 5;
  const int jt0 = SPLIT ? split * 8 : 0;
  const int nkt = SPLIT ? (split == 7 ? 9 : 8) : (smp ? 65 : 2 * qb + 2);
  const int jdiag = smp ? 64 : 2 * qb;
  int qi = wid * 32 + r31; if (smp) qi &= 63;
  const int qpos = (smp ? PAST : qb * 128) + qi;
  const int g = smp ? NTP + b * DSEQ + qi : b * SEQ + qb * 128 + qi;
  const u16* Q = (const u16*)(p.ws + WS_D) + (FOX ? (size_t)NT * 512 : 0);
  {
#pragma unroll
    for (int i = 0; i < 4; ++i) {
      const int c = tid + 256 * i; const int row = c >> 3, kc = (c & 7) * 8;
      const int qr = smp ? (row & 63) : row;
      const int gr = smp ? NTP + b * DSEQ + qr : b * SEQ + qb * 128 + qr;
      *(kv_u32x4*)(sm.q + row * KLD + kc) = *(const kv_u32x4*)(Q + (size_t)gr * 512 + h * 64 + kc);
    }
    __syncthreads();
  }

  const float* kcache = FOX ? p.c_fx_k : p.c_sb_k;
  const float* vcache = FOX ? p.c_fx_v : p.c_sb_v;
  const size_t okp = FOX ? OUT_FXK_P : OUT_SBK_P, ovp = FOX ? OUT_FXV_P : OUT_SBV_P;
  const size_t oks = FOX ? OUT_FXK_S : OUT_SBK_S, ovs = FOX ? OUT_FXV_S : OUT_SBV_S;
  auto kptr = [&](int j) -> const float* {
    if (!smp) return p.out + okp + ((size_t)(b * SEQ + 64 * j) * 512 + h * 64);
    if (j < 64) return kcache + ((size_t)(b * PAST + 64 * j) * 512 + h * 64);
    return p.out + oks + ((size_t)(b * DSEQ) * 512 + h * 64);
  };
  auto vptr = [&](int j) -> const float* {
    if (!smp) return p.out + ovp + ((size_t)(b * SEQ + 64 * j) * 512 + h * 64);
    if (j < 64) return vcache + ((size_t)(b * PAST + 64 * j) * 512 + h * 64);
    return p.out + ovs + ((size_t)(b * DSEQ) * 512 + h * 64);
  };

  if (FOX) {
    const float4* src = (const float4*)(smp ? (const float*)(p.ws + WS_CBS) + (size_t)(b * 8 + h) * 4160 : (const float*)(p.ws + WS_CBP) + (size_t)(b * 8 + h) * 2048);
    for (int i = jt0 * 16 + tid; i < (jt0 + nkt) * 16; i += 256) ((float4*)sm.cb)[i] = src[i];
    __syncthreads();
  }

  bf16x8 tri[2];
  if (!FOX) {
#pragma unroll
    for (int s = 0; s < 2; ++s)
#pragma unroll
      for (int j = 0; j < 8; ++j) { const int kin = 16 * s + 8 * (j >> 2) + 4 * hh + (j & 3); tri[s][j] = (kin >= r31) ? (short)0x3F80 : (short)0; }
  }

  f32x16 o[2];
#pragma unroll
  for (int d = 0; d < 2; ++d)
#pragma unroll
    for (int e = 0; e < 16; ++e) o[d][e] = 0.f;
  float mrun = -1e30f, lrun = 0.f, R = 0.f;

  KVRegs kv;
  KV16 kw;
  const int jfirst = FOX ? jt0 : nkt - 1;
  const u16* k16 = (const u16*)(p.ws + WS_A) + (FOX ? (size_t)NTP * 512 : 0) + (size_t)(b * SEQ) * 512 + h * 64;
  const u16* vt16 = (const u16*)(p.ws + WS_B) + (FOX ? (size_t)NTP * 512 : 0) + (size_t)((b * 8 + h) * 64) * SEQ;
  if (smp) { kv_fetch(kv, kptr(jfirst), vptr(jfirst), tid); kv_stash(kv, sm.k[0], sm.vt[0], tid); }
  else { kv_fetch16(kw, k16 + (size_t)(64 * jfirst) * 512, vt16 + 64 * jfirst, tid); kv_stash16(kw, sm.k[0], sm.vt[0], tid); }
  __syncthreads();
  for (int it = 0; it < nkt; ++it) {
    const int j = FOX ? jt0 + it : nkt - 1 - it;
    const int cur = it & 1;
    if (it + 1 < nkt) { const int jn = FOX ? j + 1 : j - 1; if (smp) kv_fetch(kv, kptr(jn), vptr(jn), tid); else kv_fetch16(kw, k16 + (size_t)(64 * jn) * 512, vt16 + 64 * jn, tid); }
    f32x16 s[2];
#pragma unroll
    for (int t2 = 0; t2 < 2; ++t2) {
#pragma unroll
      for (int e = 0; e < 16; ++e) s[t2][e] = 0.f;
      const u16* pk = sm.k[cur] + (t2 * 32 + r31) * KLD + hh * 8;
      const u16* pq = sm.q + (wid * 32 + r31) * KLD + hh * 8;
#pragma unroll
      for (int kk = 0; kk < 4; ++kk) { const bf16x8 a = *(const bf16x8*)(pk + kk * 16); const bf16x8 qv = *(const bf16x8*)(pq + kk * 16); s[t2] = MFMA(a, qv, s[t2]); }
    }
    const bool diag = j >= jdiag;
    const int kbase = 64 * j + 4 * hh;
    if (FOX) {
      float mloc = -1e30f;
#pragma unroll
      for (int t2 = 0; t2 < 2; ++t2) {
        f32x16 bvec;
#pragma unroll
        for (int g4 = 0; g4 < 4; ++g4) {
          const float4 bb = *(const float4*)(sm.cb + 64 * j + 32 * t2 + 8 * g4 + 4 * hh);
          bvec[4 * g4] = bb.x; bvec[4 * g4 + 1] = bb.y; bvec[4 * g4 + 2] = bb.z; bvec[4 * g4 + 3] = bb.w;
        }
        s[t2] = s[t2] * LOG2E + bvec;
      }
      if (diag) {
#pragma unroll
        for (int t2 = 0; t2 < 2; ++t2)
#pragma unroll
          for (int e = 0; e < 16; ++e) if (kbase + 32 * t2 + ACC_ROW(e, 0) > qpos) s[t2][e] = -1e30f;
      }
#pragma unroll
      for (int t2 = 0; t2 < 2; ++t2)
#pragma unroll
        for (int e = 0; e < 16; ++e) mloc = fmaxf(mloc, s[t2][e]);
      mloc = fmaxf(mloc, __shfl_xor(mloc, 32));
      const float mnew = fmaxf(mrun, mloc);
      const float alpha = __builtin_amdgcn_exp2f(mrun - mnew);
      mrun = mnew;
      float ls = 0.f;
#pragma unroll
      for (int t2 = 0; t2 < 2; ++t2) {
        s[t2] = s[t2] - mnew;
#pragma unroll
        for (int e = 0; e < 16; ++e) { const float pv = __builtin_amdgcn_exp2f(s[t2][e]); s[t2][e] = pv; ls += pv; }
      }
      lrun = lrun * alpha + ls;
#pragma unroll
      for (int d = 0; d < 2; ++d) o[d] = o[d] * alpha;
    } else {
#pragma unroll
      for (int t2 = 1; t2 >= 0; --t2) {
        f32x16 lk;
#pragma unroll
        for (int e = 0; e < 16; ++e) {
          const float z = s[t2][e];
          const float sp = fmaxf(z, 0.f) + __logf(1.f + __expf(-fabsf(z)));
          const bool vis = !diag || (kbase + 32 * t2 + ACC_ROW(e, 0) < qpos);
          lk[e] = vis ? -sp : 0.f;
        }
        bf16x8 fh[2], fl[2];
#pragma unroll
        for (int sI = 0; sI < 2; ++sI) fh[sI] = pack8(lk, sI);
#pragma unroll
        for (int e = 0; e < 16; ++e) lk[e] -= __uint_as_float(((unsigned)(u16)fh[e >> 3][e & 7]) << 16);
#pragma unroll
        for (int sI = 0; sI < 2; ++sI) fl[sI] = pack8(lk, sI);
        f32x16 inc;
#pragma unroll
        for (int e = 0; e < 16; ++e) inc[e] = R;
#pragma unroll
        for (int sI = 0; sI < 2; ++sI) { inc = MFMA(tri[sI], fh[sI], inc); inc = MFMA(tri[sI], fl[sI], inc); }
#pragma unroll
        for (int e = 0; e < 16; ++e) {
          const bool vis = !diag || (kbase + 32 * t2 + ACC_ROW(e, 0) < qpos);
          const float w = __builtin_amdgcn_exp2f((s[t2][e] + inc[e]) * LOG2E);
          s[t2][e] = vis ? w : 0.f;
        }
        R = __shfl(inc[0], r31);
      }
    }
#pragma unroll
    for (int t2 = 0; t2 < 2; ++t2)
#pragma unroll
      for (int sI = 0; sI < 2; ++sI) {
        const bf16x8 pf = pack8(s[t2], sI);
#pragma unroll
        for (int d = 0; d < 2; ++d) {
          const u16* pv = sm.vt[cur] + (d * 32 + r31) * VLD + 32 * t2 + 16 * sI + 4 * hh;
          union { s16x4 q[2]; bf16x8 v; } a;
          a.q[0] = *(const s16x4*)(pv); a.q[1] = *(const s16x4*)(pv + 8);
          o[d] = MFMA(a.v, pf, o[d]);
        }
      }
    if (it + 1 < nkt) { if (smp) kv_stash(kv, sm.k[cur ^ 1], sm.vt[cur ^ 1], tid); else kv_stash16(kw, sm.k[cur ^ 1], sm.vt[cur ^ 1], tid); }
#if SB_EXIT
    if (!FOX) { if (__syncthreads_and(R < -110.f)) break; } else __syncthreads();
#else
    __syncthreads();
#endif
  }
  if (SPLIT) {
    constexpr int NS = 8;
    const int bh = b * 8 + h;
    float* po = (float*)(p.ws + WS_F) + (size_t)(bh * NS) * 4096;
    float* pml = (float*)(p.ws + WS_F) + (size_t)128 * NS * 4096 + (size_t)(bh * NS) * 128;
    const float lt = lrun + __shfl_xor(lrun, 32);
    if (wid < 2) {
      float* dst = po + (size_t)split * 4096 + qi * 64;
#pragma unroll
      for (int d = 0; d < 2; ++d)
#pragma unroll
        for (int g4 = 0; g4 < 4; ++g4) *(float4*)(dst + d * 32 + 8 * g4 + 4 * hh) = make_float4(o[d][4 * g4], o[d][4 * g4 + 1], o[d][4 * g4 + 2], o[d][4 * g4 + 3]);
      if (hh == 0) *(float2*)(pml + (size_t)split * 128 + qi * 2) = make_float2(mrun, lt);
    }
    int* slot2 = (int*)(smem + 73728 + 528);
    asm volatile("s_waitcnt vmcnt(0)" ::: "memory");
    __syncthreads();
    if (tid == 0) {
      __builtin_amdgcn_fence(__ATOMIC_RELEASE, "agent");
      asm volatile("s_waitcnt vmcnt(0)" ::: "memory");
      const unsigned old = __hip_atomic_fetch_add((unsigned*)(p.ws + WS_BAR + 256) + bh + (do_ssq ? 0 : 128), 1u, __ATOMIC_RELAXED, __HIP_MEMORY_SCOPE_AGENT);
      __builtin_amdgcn_fence(__ATOMIC_ACQUIRE, "agent");
      asm volatile("s_waitcnt vmcnt(0)" ::: "memory");
      *slot2 = (int)old;
    }
    __syncthreads();
    const bool last = (*slot2 == NS - 1);
    __syncthreads();
    if (last) {
      const int q = tid >> 2, d0 = (tid & 3) * 16;
      float ms[NS], ls[NS], M = -1e30f;
#pragma unroll
      for (int s2 = 0; s2 < NS; ++s2) { const float2 ml = *(const float2*)(pml + (size_t)s2 * 128 + q * 2); ms[s2] = ml.x; ls[s2] = ml.y; M = fmaxf(M, ml.x); }
      float L = 0.f, acc[16];
#pragma unroll
      for (int k = 0; k < 16; ++k) acc[k] = 0.f;
#pragma unroll
      for (int s2 = 0; s2 < NS; ++s2) {
        const float w = exp2f(ms[s2] - M);
        L += ls[s2] * w;
        const float4* src = (const float4*)(po + (size_t)s2 * 4096 + q * 64 + d0);
#pragma unroll
        for (int k4 = 0; k4 < 4; ++k4) { const float4 v = src[k4]; acc[4 * k4] += w * v.x; acc[4 * k4 + 1] += w * v.y; acc[4 * k4 + 2] += w * v.z; acc[4 * k4 + 3] += w * v.w; }
      }
      const float invL = 1.f / L;
      float ssq = 0.f;
#pragma unroll
      for (int k = 0; k < 16; ++k) { acc[k] *= invL; ssq += acc[k] * acc[k]; }
      ssq += __shfl_xor(ssq, 1); ssq += __shfl_xor(ssq, 2);
      const int gq = NTP + b * DSEQ + q;
      if (do_ssq && (tid & 3) == 0) atomicAdd((float*)(p.ws + WS_SSQ) + (size_t)gq * 2 + 1, ssq);
      u16* od = (u16*)(p.ws + WS_E) + (size_t)gq * DM + 512 + h * 64 + d0;
      *(uint4*)od = make_uint4(pk2(acc[0], acc[1]), pk2(acc[2], acc[3]), pk2(acc[4], acc[5]), pk2(acc[6], acc[7]));
      *(uint4*)(od + 8) = make_uint4(pk2(acc[8], acc[9]), pk2(acc[10], acc[11]), pk2(acc[12], acc[13]), pk2(acc[14], acc[15]));
    }
    return;
  }
  float inv = 1.f;
  if (FOX) { const float lt = lrun + __shfl_xor(lrun, 32); inv = 1.f / lt; }
  {
    float ssq = 0.f;
#pragma unroll
    for (int d = 0; d < 2; ++d)
#pragma unroll
      for (int e = 0; e < 16; ++e) { const float t = o[d][e] * inv; ssq += t * t; }
    ssq += __shfl_xor(ssq, 32);
    if (do_ssq && hh == 0 && (!smp || wid < 2)) atomicAdd((float*)(p.ws + WS_SSQ) + (size_t)g * 2 + (FOX ? 1 : 0), ssq);
  }
  if (!smp || wid < 2) {
    u16* od = (u16*)(p.ws + WS_E) + (size_t)g * DM + (FOX ? 512 : 0) + h * 64;
#pragma unroll
    for (int d = 0; d < 2; ++d)
#pragma unroll
      for (int g4 = 0; g4 < 4; ++g4)
        *(uint2*)(od + d * 32 + 8 * g4 + 4 * hh) = make_uint2(pk2(o[d][4 * g4] * inv, o[d][4 * g4 + 1] * inv), pk2(o[d][4 * g4 + 2] * inv, o[d][4 * g4 + 3] * inv));
  }
}

template <class F>
DI void attn_queue(unsigned* ctr, int n, int* slot, F body) {
  for (;;) {
    if (threadIdx.x == 0) *slot = (int)atomicAdd(ctr, 1u);
    __syncthreads();
    const int it = *slot;
    __syncthreads();
    if (it >= n) break;
    body(it);
  }
}
DI void phase_attn(const Params& p, char* smem, int rep = 0) {
  unsigned* ctr = (unsigned*)(p.ws + WS_BAR + 128) + rep * 4;
  int* slot = (int*)(smem + 73728 + 512);
  const bool dq = rep == 0;
  attn_queue(ctr + 0, 1024, slot, [&](int it) { const int bh = it >> 3; attn_item<true, true>(p, bh >> 3, bh & 7, 0, smem, dq, it & 7); });
  attn_queue(ctr + 1, 2048, slot, [&](int u) { const int w = u & 511; const int qb = 15 - (w >> 5), bh = (u >> 9) * 32 + (w & 31); attn_item<true, false>(p, bh >> 3, bh & 7, qb, smem, dq); });
  attn_queue(ctr + 2, 128, slot, [&](int u) { attn_item<false, true>(p, u >> 3, u & 7, 0, smem, dq); });
  attn_queue(ctr + 3, 2048, slot, [&](int u) { const int w = u & 511; const int qb = 15 - (w >> 5), bh = (u >> 9) * 32 + (w & 31); attn_item<false, false>(p, bh >> 3, bh & 7, qb, smem, dq); });
}

DI void phase_wout(const Params& p, char* smem) {
  float* pre = (float*)(p.ws + WS_A);
  const u16* o = (const u16*)(p.ws + WS_E);
  float* sc_s = (float*)(smem + 73728);
  for_tiles(DM, [&](int m0, int n0, auto tag) {
    constexpr int MI = decltype(tag)::value;
    {
      const int tid = threadIdx.x;
      if (tid < MI * 64) {
        const float2 q = ((const float2*)(p.ws + WS_SSQ))[m0 + tid];
        const float s0 = rsqrtf(q.x * (1.f / 512.f) + 1e-6f), s1 = rsqrtf(q.y * (1.f / 512.f) + 1e-6f);
        sc_s[tid * 2] = s0 / s1; sc_s[tid * 2 + 1] = s1;
      }
      __syncthreads();
    }
    GldsBf16<MI * 64> al; al.base = o + (size_t)m0 * DM; al.ld = DM;
    const u16* xr = (const u16*)(p.ws + WS_C) + (size_t)m0 * DM;
    auto epi = [=](int r0, int c0, const f32x16& acc) {
      const int lane = threadIdx.x & 63, hh = lane >> 5, col = c0 + (lane & 31);
      const unsigned b0 = (unsigned)(r0 + 4 * hh) * 1024u + col, b1 = (unsigned)(r0 - m0 + 4 * hh) * 1024u + col;
#pragma unroll
      for (int e = 0; e < 16; ++e) pre[b0 + ACC_R0(e) * 1024u] = DN_ALPHA * bflo((unsigned)xr[b1 + ACC_R0(e) * 1024u]) + acc[e];
    };
    gemm_tile<MI, true>(al, (const u16*)(p.ws + WS_WOUT), DM, DM, m0, n0, epi, smem, sc_s);
  });
}

DI void phase_ln(const Params& p, const float* gam, const float* bet) {
  const float* pre = (const float*)(p.ws + WS_A);
  u16* xb = (u16*)(p.ws + WS_C);
  const int lane = threadIdx.x & 63;
  const int wg = blockIdx.x * 4 + (threadIdx.x >> 6), nw = gridDim.x * 4;
  for (int row0 = wg * 2; row0 < NT; row0 += nw * 2) {
    float4 v[2][4];
    float s[2], q[2];
#pragma unroll
    for (int r = 0; r < 2; ++r) {
      s[r] = 0.f;
#pragma unroll
      for (int j = 0; j < 4; ++j) { v[r][j] = ((const float4*)(pre + (size_t)(row0 + r) * DM))[lane + 64 * j]; s[r] += v[r][j].x + v[r][j].y + v[r][j].z + v[r][j].w; }
    }
#pragma unroll
    for (int o = 32; o >= 1; o >>= 1)
#pragma unroll
      for (int r = 0; r < 2; ++r) s[r] += __shfl_xor(s[r], o);
#pragma unroll
    for (int r = 0; r < 2; ++r) {
      s[r] *= (1.f / 1024.f); q[r] = 0.f;
#pragma unroll
      for (int j = 0; j < 4; ++j) { const float a = v[r][j].x - s[r], b2 = v[r][j].y - s[r], c = v[r][j].z - s[r], d = v[r][j].w - s[r]; q[r] += a * a + b2 * b2 + c * c + d * d; }
    }
#pragma unroll
    for (int o = 32; o >= 1; o >>= 1)
#pragma unroll
      for (int r = 0; r < 2; ++r) q[r] += __shfl_xor(q[r], o);
#pragma unroll
    for (int r = 0; r < 2; ++r) {
      const float mu = s[r], rs = rsqrtf(q[r] * (1.f / 1024.f) + 1e-5f);
#pragma unroll
      for (int j = 0; j < 4; ++j) {
        const float4 gg = ((const float4*)gam)[lane + 64 * j], bb = ((const float4*)bet)[lane + 64 * j];
        float4 y;
        y.x = (v[r][j].x - mu) * rs * gg.x + bb.x; y.y = (v[r][j].y - mu) * rs * gg.y + bb.y;
        y.z = (v[r][j].z - mu) * rs * gg.z + bb.z; y.w = (v[r][j].w - mu) * rs * gg.w + bb.w;
        ((uint2*)(xb + (size_t)(row0 + r) * DM))[lane + 64 * j] = make_uint2(pk2(y.x, y.y), pk2(y.z, y.w));
      }
    }
  }
}

template <bool NOEPI = false>
DI void phase_gemm_bf16(const Params& p, const u16* A, const u16* Wt, int N, u16* O, float scale, char* smem) {
  for_tiles(N, [&](int m0, int n0, auto tag) {
    constexpr int MI = decltype(tag)::value;
    GldsBf16<MI * 64> al; al.base = A + (size_t)m0 * DM; al.ld = DM;
    auto epi = [=](int r0, int c0, const f32x16& acc) {
      const int lane = threadIdx.x & 63, hh = lane >> 5, col = c0 + (lane & 31);
      const unsigned b0 = (unsigned)(r0 + 4 * hh) * (unsigned)N + col;
      if (NOEPI) { float t = 0.f;
#pragma unroll
        for (int e = 0; e < 16; ++e) t += acc[e];
        if (t == 12345.678f) O[b0] = bf1(t);
        return; }
#pragma unroll
      for (int e = 0; e < 16; ++e) O[b0 + ACC_R0(e) * (unsigned)N] = bf1(acc[e] * scale);
    };
    gemm_tile<MI>(al, Wt, DM, DM, m0, n0, epi, smem);
  });
}

template <class F>
DI void for_mem_tiles(F body) {
  const int vb = vblock(), nb = gridDim.x;
  for (int t = vb; t < 2048 + 256; t += nb) {
    if (t < 2048) { const int mt = t >> 3; body(mt * 128, (t >> 1) & 3, (t & 1) * 128, mt >> 4, IC<2>{}); }
    else { const int u = t - 2048; const int mt = u >> 4; body(NTP + mt * 64, (u >> 2) & 3, (u & 3) * 64, 16 + mt, IC<1>{}); }
  }
}
DI void phase_mem_s(const Params& p, char* smem) {
  const u16* qm = (const u16*)(p.ws + WS_D);
  float* S = (float*)(p.ws + WS_F);
  for_mem_tiles([&](int m0, int hd, int n0, int batch, auto tag) {
    constexpr int MI = decltype(tag)::value;
    GldsBf16<MI * 64> al; al.base = qm + (size_t)m0 * DM + hd * 256; al.ld = DM;
    const u16* Bt = (const u16*)(p.ws + WS_MEMK) + (size_t)batch * 256 * DM + hd * 256;
    auto epi = [=](int r0, int c0, const f32x16& acc) {
      const int lane = threadIdx.x & 63, hh = lane >> 5, col = c0 + (lane & 31);
      const unsigned b0 = (unsigned)(r0 + 4 * hh) * 1024u + hd * 256 + col;
#pragma unroll
      for (int e = 0; e < 16; ++e) S[b0 + ACC_R0(e) * 1024u] = acc[e];
    };
    gemm_tile<MI>(al, Bt, DM, 256, m0, n0, epi, smem);
  });
}
DI void phase_mem_softmax(const Params& p) {
  const float* S = (const float*)(p.ws + WS_F);
  u16* P = (u16*)(p.ws + WS_D);
  const int lane = threadIdx.x & 63;
  const int wg = blockIdx.x * 4 + (threadIdx.x >> 6), nw = gridDim.x * 4;
  for (int row0 = wg * 8; row0 < NT * 4; row0 += nw * 8) {
    float4 v[8]; float m[8], sm[8];
#pragma unroll
    for (int r = 0; r < 8; ++r) v[r] = ((const float4*)(S + (size_t)(row0 + r) * 256))[lane];
#pragma unroll
    for (int r = 0; r < 8; ++r) m[r] = fmaxf(fmaxf(v[r].x, v[r].y), fmaxf(v[r].z, v[r].w));
#pragma unroll
    for (int o = 32; o >= 1; o >>= 1)
#pragma unroll
      for (int r = 0; r < 8; ++r) m[r] = fmaxf(m[r], __shfl_xor(m[r], o));
#pragma unroll
    for (int r = 0; r < 8; ++r) { v[r].x = __expf(v[r].x - m[r]); v[r].y = __expf(v[r].y - m[r]); v[r].z = __expf(v[r].z - m[r]); v[r].w = __expf(v[r].w - m[r]); sm[r] = v[r].x + v[r].y + v[r].z + v[r].w; }
#pragma unroll
    for (int o = 32; o >= 1; o >>= 1)
#pragma unroll
      for (int r = 0; r < 8; ++r) sm[r] += __shfl_xor(sm[r], o);
#pragma unroll
    for (int r = 0; r < 8; ++r) { const float inv = 1.f / sm[r]; ((uint2*)(P + (size_t)(row0 + r) * 256))[lane] = make_uint2(pk2(v[r].x * inv, v[r].y * inv), pk2(v[r].z * inv, v[r].w * inv)); }
  }
}
DI void phase_mem_pv(const Params& p, char* smem) {
  const u16* P = (const u16*)(p.ws + WS_D);
  u16* om = (u16*)(p.ws + WS_E);
  for_mem_tiles([&](int m0, int hd, int n0, int batch, auto tag) {
    constexpr int MI = decltype(tag)::value;
    GldsBf16<MI * 64> al; al.base = P + (size_t)m0 * DM + hd * 256; al.ld = DM;
    const u16* Bt = (const u16*)(p.ws + WS_MEMVT) + ((size_t)batch * DM + hd * 256) * 256;
    auto epi = [=](int r0, int c0, const f32x16& acc) {
      const int lane = threadIdx.x & 63, hh = lane >> 5, col = c0 + (lane & 31);
      const unsigned b0 = (unsigned)(r0 + 4 * hh) * 1024u + hd * 256 + col;
#pragma unroll
      for (int e = 0; e < 16; ++e) om[b0 + ACC_R0(e) * 1024u] = bf1(acc[e]);
    };
    gemm_tile<MI>(al, Bt, 256, 256, m0, n0, epi, smem);
  });
}
DI void phase_wmo(const Params& p, char* smem) {
  float* pre = (float*)(p.ws + WS_A);
  const u16* xbs = (const u16*)(p.ws + WS_C);
  const u16* om = (const u16*)(p.ws + WS_E);
  for_tiles(DM, [&](int m0, int n0, auto tag) {
    constexpr int MI = decltype(tag)::value;
    GldsBf16<MI * 64> al; al.base = om + (size_t)m0 * DM; al.ld = DM;
    auto epi = [=](int r0, int c0, const f32x16& acc) {
      const int lane = threadIdx.x & 63, hh = lane >> 5, col = c0 + (lane & 31);
      const unsigned b0 = (unsigned)(r0 + 4 * hh) * 1024u + col;
#pragma unroll
      for (int e = 0; e < 16; ++e) { const unsigned i = b0 + ACC_R0(e) * 1024u; pre[i] = DN_ALPHA * bflo((unsigned)xbs[i]) + acc[e]; }
    };
    gemm_tile<MI>(al, (const u16*)(p.ws + WS_WMO), DM, DM, m0, n0, epi, smem);
  });
}

DI void insert16(float (&v)[16], float x) {
#pragma unroll
  for (int j = 15; j >= 1; --j) v[j] = __builtin_amdgcn_fmed3f(x, v[j - 1], v[j]);
  v[0] = fmaxf(v[0], x);
}
DI void phase_topk(const Params& p, char* smem) {
  const int vb = vblock(), nb = gridDim.x;
  const u16* qp = (const u16*)(p.ws + WS_F);
  int* idxo = (int*)(p.ws + WS_A);
  float* gato = (float*)(p.ws + WS_A + (size_t)NT * 128 * 4);
  float* sc = (float*)smem;
  const int tid = threadIdx.x;
  for (int t = vb; t < 264 * 8; t += nb) {
    const int mt = t >> 3, hd = t & 7;
    const int m0 = mt * 128;
    float va[16], vbv[16];
#pragma unroll
    for (int side = 0; side < 2; ++side) {
      GldsBf16<128> al; al.base = qp + (size_t)m0 * 2048 + hd * 256 + side * 128; al.ld = 2048;
      const u16* Bt = (const u16*)(p.ws + (side ? WS_KB : WS_KA)) + (size_t)hd * 128 * 128;
      auto epi = [=](int r0, int c0, const f32x16& acc) {
        const int lane = threadIdx.x & 63, hh = lane >> 5, col = c0 + (lane & 31);
#pragma unroll
        for (int e = 0; e < 16; ++e) sc[(r0 - m0 + ACC_ROW(e, hh)) * 129 + col] = acc[e];
      };
      gemm_tile<2>(al, Bt, 128, 128, m0, 0, epi, smem);
      __syncthreads();
      {
        const int row = tid & 127, half = tid >> 7;
        float* mg = (float*)(smem + 66048);
        float v[16];
#pragma unroll
        for (int j = 0; j < 16; ++j) v[j] = -INFINITY;
        for (int k = 64 * half; k < 64 * half + 64; ++k) {
          const float x = __uint_as_float((__float_as_uint(sc[row * 129 + k]) & ~0x7Fu) | (unsigned)k);
          insert16(v, x);
        }
        if (half == 1) {
#pragma unroll
          for (int j = 0; j < 16; ++j) mg[row * 17 + j] = v[j];
        }
        __syncthreads();
        if (half == 0) {
#pragma unroll
          for (int j = 0; j < 16; ++j) insert16(v, mg[row * 17 + j]);
#pragma unroll
          for (int j = 0; j < 16; ++j) { if (side == 0) va[j] = v[j]; else vbv[j] = v[j]; }
        }
      }
      __syncthreads();
    }
    unsigned char* ids = (unsigned char*)smem;
    if (tid < 128) {
#pragma unroll
      for (int j = 0; j < 16; ++j) { ids[tid * 32 + j] = (unsigned char)(__float_as_uint(va[j]) & 0x7F); ids[tid * 32 + 16 + j] = (unsigned char)(__float_as_uint(vbv[j]) & 0x7F); }
      float top[16];
#pragma unroll
      for (int j = 0; j < 16; ++j) top[j] = -INFINITY;
#pragma unroll
      for (int i = 0; i < 16; ++i)
#pragma unroll
        for (int j = 0; j < 16; ++j)
          if ((i + 1) * (j + 1) <= 16) {
            const float a = __uint_as_float(__float_as_uint(va[i]) & ~0x7Fu), b = __uint_as_float(__float_as_uint(vbv[j]) & ~0x7Fu);
            const float c = __uint_as_float((__float_as_uint(a + b) & ~0xFFu) | (unsigned)(i * 16 + j));
            insert16(top, c);
          }
      const float m = __uint_as_float(__float_as_uint(top[0]) & ~0xFFu);
      float ex[16], ssum = 0.f;
      int eid[16];
#pragma unroll
      for (int j = 0; j < 16; ++j) {
        const unsigned bits = __float_as_uint(top[j]);
        const int code = bits & 0xFF;
        ex[j] = __expf(__uint_as_float(bits & ~0xFFu) - m); ssum += ex[j];
        eid[j] = (int)ids[tid * 32 + (code >> 4)] * 128 + (int)ids[tid * 32 + 16 + (code & 15)];
      }
      const float inv = 1.f / ssum;
      const size_t ob = (size_t)(m0 + tid) * 128 + hd * 16;
#pragma unroll
      for (int j4 = 0; j4 < 4; ++j4) {
        *(int4*)(idxo + ob + 4 * j4) = make_int4(eid[4 * j4], eid[4 * j4 + 1], eid[4 * j4 + 2], eid[4 * j4 + 3]);
        *(float4*)(gato + ob + 4 * j4) = make_float4(ex[4 * j4] * inv, ex[4 * j4 + 1] * inv, ex[4 * j4 + 2] * inv, ex[4 * j4 + 3] * inv);
      }
    }
    __syncthreads();
  }
}

#if USE_FP8
typedef float f32x2v __attribute__((ext_vector_type(2)));
DI void unpack16(const uint4& v, float (&f)[16]) {
  const unsigned w[4] = {v.x, v.y, v.z, v.w};
#pragma unroll
  for (int j = 0; j < 4; ++j) {
    const f32x2v lo = __builtin_amdgcn_cvt_pk_f32_fp8((int)w[j], false), hi = __builtin_amdgcn_cvt_pk_f32_fp8((int)w[j], true);
    f[4 * j] = lo[0]; f[4 * j + 1] = lo[1]; f[4 * j + 2] = hi[0]; f[4 * j + 3] = hi[1];
  }
}
DI void peer_dot8(const char* U, int idreg, int e0, int lane, const float (&x)[16], float& dacc) {
  uint4 w[8];
#pragma unroll
  for (int j = 0; j < 8; ++j) { const int id = __builtin_amdgcn_readlane(idreg, e0 + j); w[j] = *(const uint4*)(U + (size_t)id * DM + 16 * lane); }
  float s[8];
#pragma unroll
  for (int j = 0; j < 8; ++j) {
    float f[16]; unpack16(w[j], f);
    float a = 0.f;
#pragma unroll
    for (int k = 0; k < 16; ++k) a += f[k] * x[k];
    s[j] = a;
  }
  const bool b5 = lane & 32, b4 = lane & 16, b3 = lane & 8;
  float t4[4], t2[2], t1;
#pragma unroll
  for (int i = 0; i < 4; ++i) { const float snd = b5 ? s[i] : s[4 + i], kp = b5 ? s[4 + i] : s[i]; t4[i] = kp + __shfl_xor(snd, 32); }
#pragma unroll
  for (int i = 0; i < 2; ++i) { const float snd = b4 ? t4[i] : t4[2 + i], kp = b4 ? t4[2 + i] : t4[i]; t2[i] = kp + __shfl_xor(snd, 16); }
  { const float snd = b3 ? t2[0] : t2[1], kp = b3 ? t2[1] : t2[0]; t1 = kp + __shfl_xor(snd, 8); }
  t1 += __shfl_xor(t1, 4); t1 += __shfl_xor(t1, 2); t1 += __shfl_xor(t1, 1);
  const float g = __shfl(t1, (lane & 7) * 8);
  if ((lane >> 3) == (e0 >> 3)) dacc = g;
}
DI void peer_axpy8(const char* V, int idreg, float hreg, int e0, int lane, float (&acc)[16]) {
  uint4 w[8];
#pragma unroll
  for (int j = 0; j < 8; ++j) { const int id = __builtin_amdgcn_readlane(idreg, e0 + j); w[j] = *(const uint4*)(V + (size_t)id * DM + 16 * lane); }
#pragma unroll
  for (int j = 0; j < 8; ++j) {
    const float hs = __uint_as_float(__builtin_amdgcn_readlane(__float_as_uint(hreg), e0 + j));
    float f[16]; unpack16(w[j], f);
#pragma unroll
    for (int k = 0; k < 16; ++k) acc[k] += hs * f[k];
  }
}
DI void peer_sort(int& id0, int& id1, float& g0, float& g1, int lane) {
  unsigned k0 = ((unsigned)id0 << 7) | (unsigned)lane, k1 = ((unsigned)id1 << 7) | (unsigned)(lane + 64);
#pragma unroll
  for (int k = 2; k <= 128; k <<= 1) {
#pragma unroll
    for (int j = k >> 1; j >= 1; j >>= 1) {
      if (j == 64) {
        const unsigned lo = min(k0, k1), hi = max(k0, k1); k0 = lo; k1 = hi;
      } else {
        const unsigned p0 = (unsigned)__shfl_xor((int)k0, j), p1 = (unsigned)__shfl_xor((int)k1, j);
        const bool upper = (lane & j) != 0;
        const bool asc0 = ((lane & k) == 0), asc1 = (((lane + 64) & k) == 0);
        k0 = (upper == asc0) ? max(k0, p0) : min(k0, p0);
        k1 = (upper == asc1) ? max(k1, p1) : min(k1, p1);
      }
    }
  }
  const int s0 = k0 & 127, s1 = k1 & 127;
  const float a0 = __shfl(g0, s0 & 63), b0 = __shfl(g1, s0 & 63), a1 = __shfl(g0, s1 & 63), b1 = __shfl(g1, s1 & 63);
  g0 = (s0 < 64) ? a0 : b0; g1 = (s1 < 64) ? a1 : b1;
  id0 = (int)(k0 >> 7); id1 = (int)(k1 >> 7);
}
DI void peer_load(const Params& p, int row, int lane, float (&x)[16], int& id0, int& id1, float& g0, float& g1) {
  const int* idxo = (const int*)(p.ws + WS_A);
  const float* gato = (const float*)(p.ws + WS_A + (size_t)NT * 128 * 4);
  {
    const uint4* xr = (const uint4*)((const u16*)(p.ws + WS_C) + (size_t)row * DM) + 2 * lane;
    const uint4 a = xr[0], b = xr[1];
    x[0] = bflo(a.x); x[1] = bfhi(a.x); x[2] = bflo(a.y); x[3] = bfhi(a.y); x[4] = bflo(a.z); x[5] = bfhi(a.z); x[6] = bflo(a.w); x[7] = bfhi(a.w);
    x[8] = bflo(b.x); x[9] = bfhi(b.x); x[10] = bflo(b.y); x[11] = bfhi(b.y); x[12] = bflo(b.z); x[13] = bfhi(b.z); x[14] = bflo(b.w); x[15] = bfhi(b.w);
  }
  id0 = idxo[(size_t)row * 128 + lane]; id1 = idxo[(size_t)row * 128 + 64 + lane];
  g0 = gato[(size_t)row * 128 + lane]; g1 = gato[(size_t)row * 128 + 64 + lane];
  peer_sort(id0, id1, g0, g1, lane);
}
DI void peer_finish(const Params& p, int row, int lane, float (&acc)[16]) {
  float x[16];
  {
    const uint4* xr = (const uint4*)((const u16*)(p.ws + WS_C) + (size_t)row * DM) + 2 * lane;
    const uint4 a = xr[0], b = xr[1];
    x[0] = bflo(a.x); x[1] = bfhi(a.x); x[2] = bflo(a.y); x[3] = bfhi(a.y); x[4] = bflo(a.z); x[5] = bfhi(a.z); x[6] = bflo(a.w); x[7] = bfhi(a.w);
    x[8] = bflo(b.x); x[9] = bfhi(b.x); x[10] = bflo(b.y); x[11] = bfhi(b.y); x[12] = bflo(b.z); x[13] = bfhi(b.z); x[14] = bflo(b.w); x[15] = bfhi(b.w);
  }
  float s = 0.f;
#pragma unroll
  for (int k = 0; k < 16; ++k) { acc[k] = DN_ALPHA * x[k] + acc[k]; s += acc[k]; }
  const float mu = wave_sum(s) * (1.f / 1024.f);
  float q = 0.f;
#pragma unroll
  for (int k = 0; k < 16; ++k) { const float dd = acc[k] - mu; q += dd * dd; }
  const float rs = rsqrtf(wave_sum(q) * (1.f / 1024.f) + 1e-5f);
  float* y = (row < NTP) ? p.out + OUT_YP + (size_t)row * DM : p.out + OUT_YS + (size_t)(row - NTP) * DM;
#pragma unroll
  for (int j = 0; j < 4; ++j) {
    const float4 ga = ((const float4*)p.ln3_g)[4 * lane + j], ba = ((const float4*)p.ln3_b)[4 * lane + j];
    float4 ya;
    ya.x = (acc[4 * j + 0] - mu) * rs * ga.x + ba.x; ya.y = (acc[4 * j + 1] - mu) * rs * ga.y + ba.y;
    ya.z = (acc[4 * j + 2] - mu) * rs * ga.z + ba.z; ya.w = (acc[4 * j + 3] - mu) * rs * ga.w + ba.w;
    ((float4*)y)[4 * lane + j] = ya;
  }
}
DI float peer_gelu_gate(float d, float g) { return 0.5f * d * (1.f + erff(d * 0.7071067811865476f)) * g; }
DI void phase_peer(const Params& p, int rr0 = 0, int rr1 = 1 << 10) {
  const char* U = p.ws + WS_U;
  const char* V = p.ws + WS_V;
  const float* usc = (const float*)(p.ws + WS_USC);
  const float* vsc = (const float*)(p.ws + WS_VSC);
  const int lane = threadIdx.x & 63;
  const int wg = blockIdx.x * 4 + (threadIdx.x >> 6), nw = gridDim.x * 4;
  for (int rowA = wg + rr0 * 2 * nw; rowA < NT && rowA < wg + rr1 * 2 * nw; rowA += 2 * nw) {
    const bool hasB = rowA + nw < NT;
    const int rowB = hasB ? rowA + nw : rowA;
    asm volatile("" ::: "memory");
    float xA[16], xB[16];
    int a0, a1, b0, b1; float ga0, ga1, gb0, gb1;
    peer_load(p, rowA, lane, xA, a0, a1, ga0, ga1);
    peer_load(p, rowB, lane, xB, b0, b1, gb0, gb1);
    const float sua0 = usc[a0], sua1 = usc[a1], sva0 = vsc[a0], sva1 = vsc[a1];
    const float sub0 = usc[b0], sub1 = usc[b1], svb0 = vsc[b0], svb1 = vsc[b1];
    float da0 = 0.f, da1 = 0.f, db0 = 0.f, db1 = 0.f;
#pragma unroll 1
    for (int e0 = 0; e0 < 64; e0 += 8) { peer_dot8(U, a0, e0, lane, xA, da0); if (hasB) peer_dot8(U, b0, e0, lane, xB, db0); }
#pragma unroll 1
    for (int e0 = 0; e0 < 64; e0 += 8) { peer_dot8(U, a1, e0, lane, xA, da1); if (hasB) peer_dot8(U, b1, e0, lane, xB, db1); }
    const float ha0 = peer_gelu_gate(da0 * sua0, ga0) * sva0, ha1 = peer_gelu_gate(da1 * sua1, ga1) * sva1;
    const float hb0 = peer_gelu_gate(db0 * sub0, gb0) * svb0, hb1 = peer_gelu_gate(db1 * sub1, gb1) * svb1;
    float accA[16], accB[16];
#pragma unroll
    for (int k = 0; k < 16; ++k) { accA[k] = 0.f; accB[k] = 0.f; }
#pragma unroll 1
    for (int e0 = 0; e0 < 64; e0 += 8) { peer_axpy8(V, a0, ha0, e0, lane, accA); if (hasB) peer_axpy8(V, b0, hb0, e0, lane, accB); }
#pragma unroll 1
    for (int e0 = 0; e0 < 64; e0 += 8) { peer_axpy8(V, a1, ha1, e0, lane, accA); if (hasB) peer_axpy8(V, b1, hb1, e0, lane, accB); }
    peer_finish(p, rowA, lane, accA);
    if (hasB) peer_finish(p, rowB, lane, accB);
  }
}
#else
DI void unpack8(const uint4& v, float (&f)[8]) {
  f[0] = bflo(v.x); f[1] = bfhi(v.x); f[2] = bflo(v.y); f[3] = bfhi(v.y); f[4] = bflo(v.z); f[5] = bfhi(v.z); f[6] = bflo(v.w); f[7] = bfhi(v.w);
}
DI void phase_peer(const Params& p) {
  const float* xf = (const float*)(p.ws + WS_B);
  const int* idxo = (const int*)(p.ws + WS_A);
  const float* gato = (const float*)(p.ws + WS_A + (size_t)NT * 128 * 4);
  const u16* U = (const u16*)(p.ws + WS_U);
  const u16* V = (const u16*)(p.ws + WS_V);
  const int lane = threadIdx.x & 63;
  const int wg = blockIdx.x * 4 + (threadIdx.x >> 6), nw = gridDim.x * 4;
  for (int row = wg; row < NT; row += nw) {
    float x[16];
    {
      const float4* xr = (const float4*)(xf + (size_t)row * DM);
      const float4 a = xr[2 * lane], b = xr[2 * lane + 1], c = xr[128 + 2 * lane], d = xr[128 + 2 * lane + 1];
      x[0] = a.x; x[1] = a.y; x[2] = a.z; x[3] = a.w; x[4] = b.x; x[5] = b.y; x[6] = b.z; x[7] = b.w;
      x[8] = c.x; x[9] = c.y; x[10] = c.z; x[11] = c.w; x[12] = d.x; x[13] = d.y; x[14] = d.z; x[15] = d.w;
    }
    const int id0 = idxo[(size_t)row * 128 + lane], id1 = idxo[(size_t)row * 128 + 64 + lane];
    const float g0 = gato[(size_t)row * 128 + lane], g1 = gato[(size_t)row * 128 + 64 + lane];
    float d0 = 0.f, d1 = 0.f;
#pragma unroll 8
    for (int e = 0; e < 64; ++e) {
      const int id = __builtin_amdgcn_readlane(id0, e);
      const uint4* ur = (const uint4*)(U + (size_t)id * DM);
      const uint4 ua = ur[lane], ub = ur[64 + lane];
      float f[8], s = 0.f;
      unpack8(ua, f);
#pragma unroll
      for (int k = 0; k < 8; ++k) s += f[k] * x[k];
      unpack8(ub, f);
#pragma unroll
      for (int k = 0; k < 8; ++k) s += f[k] * x[8 + k];
      s = wave_sum(s);
      if (lane == e) d0 = s;
    }
#pragma unroll 8
    for (int e = 0; e < 64; ++e) {
      const int id = __builtin_amdgcn_readlane(id1, e);
      const uint4* ur = (const uint4*)(U + (size_t)id * DM);
      const uint4 ua = ur[lane], ub = ur[64 + lane];
      float f[8], s = 0.f;
      unpack8(ua, f);
#pragma unroll
      for (int k = 0; k < 8; ++k) s += f[k] * x[k];
      unpack8(ub, f);
#pragma unroll
      for (int k = 0; k < 8; ++k) s += f[k] * x[8 + k];
      s = wave_sum(s);
      if (lane == e) d1 = s;
    }
    const float h0 = 0.5f * d0 * (1.f + erff(d0 * 0.7071067811865476f)) * g0;
    const float h1 = 0.5f * d1 * (1.f + erff(d1 * 0.7071067811865476f)) * g1;
    float acc[16];
#pragma unroll
    for (int k = 0; k < 16; ++k) acc[k] = 0.f;
#pragma unroll 8
    for (int e = 0; e < 64; ++e) {
      const int id = __builtin_amdgcn_readlane(id0, e);
      const float hs = __uint_as_float(__builtin_amdgcn_readlane(__float_as_uint(h0), e));
      const uint4* vr = (const uint4*)(V + (size_t)id * DM);
      const uint4 va = vr[lane], vb2 = vr[64 + lane];
      float f[8];
      unpack8(va, f);
#pragma unroll
      for (int k = 0; k < 8; ++k) acc[k] += hs * f[k];
      unpack8(vb2, f);
#pragma unroll
      for (int k = 0; k < 8; ++k) acc[8 + k] += hs * f[k];
    }
#pragma unroll 8
    for (int e = 0; e < 64; ++e) {
      const int id = __builtin_amdgcn_readlane(id1, e);
      const float hs = __uint_as_float(__builtin_amdgcn_readlane(__float_as_uint(h1), e));
      const uint4* vr = (const uint4*)(V + (size_t)id * DM);
      const uint4 va = vr[lane], vb2 = vr[64 + lane];
      float f[8];
      unpack8(va, f);
#pragma unroll
      for (int k = 0; k < 8; ++k) acc[k] += hs * f[k];
      unpack8(vb2, f);
#pragma unroll
      for (int k = 0; k < 8; ++k) acc[8 + k] += hs * f[k];
    }
    float s = 0.f;
#pragma unroll
    for (int k = 0; k < 16; ++k) { acc[k] = DN_ALPHA * x[k] + acc[k]; s += acc[k]; }
    const float mu = wave_sum(s) * (1.f / 1024.f);
    float q = 0.f;
#pragma unroll
    for (int k = 0; k < 16; ++k) { const float dd = acc[k] - mu; q += dd * dd; }
    const float rs = rsqrtf(wave_sum(q) * (1.f / 1024.f) + 1e-5f);
    float* y = (row < NTP) ? p.out + OUT_YP + (size_t)row * DM : p.out + OUT_YS + (size_t)(row - NTP) * DM;
#pragma unroll
    for (int c = 0; c < 2; ++c) {
      const int off = c * 512 + lane * 8;
      const float4 ga = *(const float4*)(p.ln3_g + off), gb = *(const float4*)(p.ln3_g + off + 4);
      const float4 ba = *(const float4*)(p.ln3_b + off), bb = *(const float4*)(p.ln3_b + off + 4);
      float4 ya, yb;
      ya.x = (acc[8 * c + 0] - mu) * rs * ga.x + ba.x; ya.y = (acc[8 * c + 1] - mu) * rs * ga.y + ba.y;
      ya.z = (acc[8 * c + 2] - mu) * rs * ga.z + ba.z; ya.w = (acc[8 * c + 3] - mu) * rs * ga.w + ba.w;
      yb.x = (acc[8 * c + 4] - mu) * rs * gb.x + bb.x; yb.y = (acc[8 * c + 5] - mu) * rs * gb.y + bb.y;
      yb.z = (acc[8 * c + 6] - mu) * rs * gb.z + bb.z; yb.w = (acc[8 * c + 7] - mu) * rs * gb.w + bb.w;
      *(float4*)(y + off) = ya; *(float4*)(y + off + 4) = yb;
    }
  }
}

#endif

constexpr int NPHASE = 15;
template <int PH>
DI void run_phase(const Params& p, char* smem) {
  if (PH == 0) phase_prep(p, smem);
  else if (PH == 1) phase_proj(p, smem);
  else if (PH == 2) phase_scan(p, smem);
  else if (PH == 3) phase_attn(p, smem);
  else if (PH == 4) phase_wout(p, smem);
  else if (PH == 5) phase_ln(p, p.ln1_g, p.ln1_b);
  else if (PH == 6) phase_gemm_bf16(p, (const u16*)(p.ws + WS_C), (const u16*)(p.ws + WS_WMQ), 1024, (u16*)(p.ws + WS_D), 0.0625f, smem);
  else if (PH == 7) phase_mem_s(p, smem);
  else if (PH == 8) phase_mem_softmax(p);
  else if (PH == 9) phase_mem_pv(p, smem);
  else if (PH == 10) phase_wmo(p, smem);
  else if (PH == 11) phase_ln(p, p.ln2_g, p.ln2_b);
  else if (PH == 12) phase_gemm_bf16(p, (const u16*)(p.ws + WS_C), (const u16*)(p.ws + WS_WPQ), 2048, (u16*)(p.ws + WS_F), 1.f, smem);
  else if (PH == 13) phase_topk(p, smem);
  else if (PH == 14) phase_peer(p);
}

template <int PH>
__global__ void __launch_bounds__(256, 2) k_phase(Params p) {
  __shared__ __attribute__((aligned(16))) char smem[SMEM_BYTES];
  run_phase<PH>(p, smem);
}

#define XB_TMO      128
#define XB_XCNT(j)  (256  + 64 * (j))
#define XB_XSUB(j)  (1280 + 64 * (j))
#define XB_XGEN(j)  (2304 + 64 * (j))
#define XB_TOP      3328
#define XB_TOPGEN   3392
#define XB_SPIN_CAP (1u << 20)
DI unsigned xb_ld(unsigned* p) { return __hip_atomic_load(p, __ATOMIC_RELAXED, __HIP_MEMORY_SCOPE_AGENT); }
DI unsigned xb_add(unsigned* p, unsigned v) { return __hip_atomic_fetch_add(p, v, __ATOMIC_RELAXED, __HIP_MEMORY_SCOPE_AGENT); }
DI unsigned xb_xcc_id() { return (unsigned)__builtin_amdgcn_s_getreg((3 << 11) | 20) & 0xFu; }
#define XB_SPIN(cond, bar) do { unsigned _sp = 0; while (cond) { __builtin_amdgcn_s_sleep(1); \
    if ((++_sp & 255u) == 0u) { if (xb_ld(&(bar)[XB_TMO])) break; if (_sp > XB_SPIN_CAP) { atomicAdd(&(bar)[XB_TMO], 1u); break; } } } } while (0)
struct XcdBarrier { unsigned* bar; unsigned x; volatile unsigned* st; };
DI XcdBarrier xcd_barrier_post(unsigned* bar, volatile unsigned* st) {
  XcdBarrier b; b.bar = bar; b.x = xb_xcc_id(); b.st = st;
  if (threadIdx.x == 0) (void)xb_add(&bar[XB_XCNT(b.x)], 1u);
  return b;
}
DI void xcd_barrier_complete(unsigned* bar, unsigned x, unsigned& nloc, unsigned& nx) {
  const unsigned G = gridDim.x;
  unsigned sum, cnt, mine, sp = 0u;
  for (;;) {
    sum = 0u; cnt = 0u; mine = 0u;
#pragma unroll
    for (unsigned j = 0; j < 16; ++j) { const unsigned c = xb_ld(&bar[XB_XCNT(j)]); sum += c; cnt += (c > 0u) ? 1u : 0u; mine = (j == x) ? c : mine; }
    if (sum == G) break;
    __builtin_amdgcn_s_sleep(1);
    if ((++sp & 255u) == 0u) { if (xb_ld(&bar[XB_TMO])) break; if (sp > XB_SPIN_CAP) { atomicAdd(&bar[XB_TMO], 1u); break; } }
  }
  nloc = mine > 0u ? mine : 1u; nx = cnt > 0u ? cnt : 1u;
}
DI void xcd_barrier(const XcdBarrier& b) {
  asm volatile("s_waitcnt vmcnt(0)" ::: "memory");
  __syncthreads();
  if (threadIdx.x == 0) {
    unsigned* bar = b.bar;
    __builtin_amdgcn_s_waitcnt(0);
    unsigned nloc = b.st[0], nx = b.st[1];
    if (nloc == 0u) { xcd_barrier_complete(bar, b.x, nloc, nx); b.st[0] = nloc; b.st[1] = nx; }
    const unsigned old = xb_add(&bar[XB_XSUB(b.x)], 1u);
    const unsigned gen = old / nloc;
    if (old + 1u == (gen + 1u) * nloc) {
      __builtin_amdgcn_fence(__ATOMIC_RELEASE, "agent");
      asm volatile("s_waitcnt vmcnt(0)" ::: "memory");
      const unsigned og = xb_add(&bar[XB_TOP], 1u);
      const unsigned tg = og / nx;
      if (og + 1u == (tg + 1u) * nx) xb_add(&bar[XB_TOPGEN], 1u);
      else XB_SPIN(xb_ld(&bar[XB_TOPGEN]) == tg, bar);
      __builtin_amdgcn_fence(__ATOMIC_ACQUIRE, "agent");
      xb_add(&bar[XB_XGEN(b.x)], 1u);
      asm volatile("s_waitcnt vmcnt(0)" ::: "memory");
    } else {
      XB_SPIN(xb_ld(&bar[XB_XGEN(b.x)]) == gen, bar);
      __builtin_amdgcn_fence(__ATOMIC_ACQUIRE, "agent");
      asm volatile("s_waitcnt vmcnt(0)" ::: "memory");
    }
  }
  __syncthreads();
}
#if ONE_LAUNCH
DI void grid_barrier(unsigned* bar, unsigned& target) {
  target += gridDim.x;
  asm volatile("s_waitcnt vmcnt(0)" ::: "memory");
  __syncthreads();
  if (threadIdx.x == 0) {
    __builtin_amdgcn_fence(__ATOMIC_RELEASE, "agent");
    asm volatile("s_waitcnt vmcnt(0)" ::: "memory");
    __hip_atomic_fetch_add(bar, 1u, __ATOMIC_RELAXED, __HIP_MEMORY_SCOPE_AGENT);
    while (__hip_atomic_load(bar, __ATOMIC_RELAXED, __HIP_MEMORY_SCOPE_AGENT) < target) __builtin_amdgcn_s_sleep(2);
    __builtin_amdgcn_fence(__ATOMIC_ACQUIRE, "agent");
    asm volatile("s_waitcnt vmcnt(0)" ::: "memory");
  }
  __syncthreads();
}
__global__ void __launch_bounds__(256, 2) k_mega(Params p) {
  __shared__ __attribute__((aligned(16))) char smem[SMEM_BYTES];
  cg::grid_group grid = cg::this_grid();
#define RUN(n) do { run_phase<n>(p, smem); if (REPEAT_PHASE == n || (REPEAT_PHASE >= 1000 && (((REPEAT_PHASE - 1000) >> n) & 1))) { GSYNC(); run_phase<n>(p, smem); GSYNC(); run_phase<n>(p, smem); } if (REPEAT_PHASE == 203 && n == 3) { GSYNC(); phase_attn(p, smem, 1); GSYNC(); phase_attn(p, smem, 2); } if (REPEAT_PHASE == 100 + n) { GSYNC(); phase_gemm_bf16<true>(p, (const u16*)(p.ws + WS_C), (const u16*)(p.ws + WS_WPQ), 2048, (u16*)(p.ws + WS_F), 1.f, smem); GSYNC(); phase_gemm_bf16<true>(p, (const u16*)(p.ws + WS_C), (const u16*)(p.ws + WS_WPQ), 2048, (u16*)(p.ws + WS_F), 1.f, smem); } } while (0)
#if CUSTOM_BAR
  volatile unsigned* xst = (volatile unsigned*)(smem + 73728 + 1024);
  if (threadIdx.x == 0) { xst[0] = 0u; xst[1] = 0u; }
  __syncthreads();
  const XcdBarrier xb = xcd_barrier_post((unsigned*)(p.ws + WS_XBAR), xst);
#define GSYNC() xcd_barrier(xb)
#else
#define GSYNC() grid.sync()
#endif
  RUN(0); grid.sync();
  RUN(1); GSYNC();
  RUN(2); GSYNC();
  RUN(3); GSYNC();
  RUN(4); GSYNC();
  RUN(5); GSYNC();
  if (REPEAT_PHASE == 300) { GSYNC(); GSYNC(); GSYNC(); GSYNC(); GSYNC(); GSYNC(); GSYNC(); GSYNC(); }
  RUN(6); GSYNC();
  RUN(7); GSYNC();
  RUN(8); GSYNC();
  RUN(9); GSYNC();
  RUN(10); GSYNC();
  RUN(11); GSYNC();
  RUN(12); GSYNC();
  RUN(13); GSYNC();
#if PEER_RESYNC
  {
    const int nrounds = (NT + 8 * (int)gridDim.x - 1) / (8 * (int)gridDim.x);
    for (int rr = 0; rr < nrounds; rr += PEER_RESYNC) { if (rr) GSYNC(); phase_peer(p, rr, rr + PEER_RESYNC); }
  }
#else
  RUN(14);
#endif
}
#endif

extern "C" void kernel_launch(void* const* d_in, const int* in_sizes, int n_in, void* d_out, int out_size, void* d_ws, size_t ws_size,
                              hipStream_t stream) {
  (void)in_sizes; (void)n_in; (void)out_size;
  if (ws_size < WS_TOTAL) { fprintf(stderr, "workspace too small: %zu < %zu\n", ws_size, (size_t)WS_TOTAL); return; }
  Params p{};
  const float** pp = (const float**)&p;
  for (int i = 0; i < 29; ++i) pp[i] = (const float*)d_in[i];
  p.out = (float*)d_out;
  p.ws = (char*)d_ws;
#if ONE_LAUNCH
  static int grid_blocks = 0;
  if (!grid_blocks) {
    int dev = 0, cus = 0, per_cu = 0;
    hipGetDevice(&dev);
    hipDeviceGetAttribute(&cus, hipDeviceAttributeMultiprocessorCount, dev);
    hipOccupancyMaxActiveBlocksPerMultiprocessor(&per_cu, k_mega, 256, 0);
    if (per_cu > 2) per_cu = 2;
    grid_blocks = cus * per_cu;
  }
  hipMemsetAsync((char*)d_ws + WS_BAR, 0, 2048, stream);
  hipMemsetAsync((char*)d_ws + WS_XBAR, 0, 16384, stream);
  void* args[] = {&p};
  hipError_t e = hipLaunchCooperativeKernel((void*)k_mega, dim3(grid_blocks), dim3(256), args, 0, stream);
  if (e != hipSuccess) fprintf(stderr, "cooperative launch failed: %s (grid %d)\n", hipGetErrorString(e), grid_blocks);
#else
  const int G = 512;
  hipMemsetAsync((char*)d_ws + WS_BAR, 0, 2048, stream);
  k_phase<0><<<G, 256, 0, stream>>>(p);
  k_phase<1><<<G, 256, 0, stream>>>(p);
  k_phase<2><<<G, 256, 0, stream>>>(p);
  k_phase<3><<<G, 256, 0, stream>>>(p);
  k_phase<4><<<G, 256, 0, stream>>>(p);
  k_phase<5><<<G, 256, 0, stream>>>(p);
  k_phase<6><<<G, 256, 0, stream>>>(p);
  k_phase<7><<<G, 256, 0, stream>>>(p);
  k_phase<8><<<G, 256, 0, stream>>>(p);
  k_phase<9><<<G, 256, 0, stream>>>(p);
  k_phase<10><<<G, 256, 0, stream>>>(p);
  k_phase<11><<<G, 256, 0, stream>>>(p);
  k_phase<12><<<G, 256, 0, stream>>>(p);
  k_phase<13><<<G, 256, 0, stream>>>(p);
  k_phase<14><<<G, 256, 0, stream>>>(p);
#endif
}
```

```cpp
#include <hip/hip_runtime.h>
#include <hip/hip_cooperative_groups.h>
#include <cstdio>
#include <cstdint>
namespace cg = cooperative_groups;

#ifndef ONE_LAUNCH
#define ONE_LAUNCH 1
#endif

#ifndef USE_FP8
#define USE_FP8 1
#endif
#ifndef SB_EXIT
#define SB_EXIT 1
#endif
#ifndef REPEAT_PHASE
#define REPEAT_PHASE -1
#endif
#ifndef PEER_RESYNC
#define PEER_RESYNC 0
#endif
#ifndef CUSTOM_BAR
#define CUSTOM_BAR 1
#endif
#define DI __device__ __forceinline__
typedef unsigned short u16;
typedef short bf16x8 __attribute__((ext_vector_type(8)));
typedef short s16x4 __attribute__((ext_vector_type(4)));
typedef float f32x16 __attribute__((ext_vector_type(16)));
typedef __bf16 bf2_t __attribute__((ext_vector_type(2)));
typedef float f2_t __attribute__((ext_vector_type(2)));
#define MFMA(a, b, c) __builtin_amdgcn_mfma_f32_32x32x16_bf16((a), (b), (c), 0, 0, 0)

constexpr int DM = 1024;
constexpr int NTP = 32768;
constexpr int NTS = 1024;
constexpr int NT = NTP + NTS;
constexpr int SEQ = 2048, DSEQ = 64, PAST = 4096, NMEM = 256;
constexpr int INC = 3080, INCP = 3200;
constexpr float DN_ALPHA = 1.189207115002721f;
constexpr float LOG2E = 1.4426950408889634f;

constexpr size_t OUT_YP = 0;
constexpr size_t OUT_YS = OUT_YP + (size_t)NTP * DM;
constexpr size_t OUT_SBK_P = OUT_YS + (size_t)NTS * DM;
constexpr size_t OUT_SBV_P = OUT_SBK_P + (size_t)NTP * 512;
constexpr size_t OUT_FXK_P = OUT_SBV_P + (size_t)NTP * 512;
constexpr size_t OUT_FXV_P = OUT_FXK_P + (size_t)NTP * 512;
constexpr size_t OUT_LF_P = OUT_FXV_P + (size_t)NTP * 512;
constexpr size_t OUT_MK_P = OUT_LF_P + (size_t)NTP * 8;
constexpr size_t OUT_MV_P = OUT_MK_P + (size_t)4096 * DM;
constexpr size_t OUT_SBK_S = OUT_MV_P + (size_t)4096 * DM;
constexpr size_t OUT_SBV_S = OUT_SBK_S + (size_t)NTS * 512;
constexpr size_t OUT_FXK_S = OUT_SBV_S + (size_t)NTS * 512;
constexpr size_t OUT_FXV_S = OUT_FXK_S + (size_t)NTS * 512;
constexpr size_t OUT_LF_S = OUT_FXV_S + (size_t)NTS * 512;
constexpr size_t OUT_TOTAL = OUT_LF_S + (size_t)NTS * 8;

constexpr size_t WS_WIN = 0;
constexpr size_t WS_WOUT = WS_WIN + (size_t)INCP * DM * 2;
constexpr size_t WS_WMQ = WS_WOUT + (size_t)DM * DM * 2;
constexpr size_t WS_WMKV = WS_WMQ + (size_t)DM * DM * 2;
constexpr size_t WS_WMO = WS_WMKV + (size_t)2048 * DM * 2;
constexpr size_t WS_WPQ = WS_WMO + (size_t)DM * DM * 2;
constexpr size_t WS_KA = WS_WPQ + (size_t)2048 * DM * 2;
constexpr size_t WS_KB = WS_KA + (size_t)8 * 128 * 128 * 2;
constexpr size_t WS_U = WS_KB + (size_t)8 * 128 * 128 * 2;
constexpr size_t WS_V = WS_U + (size_t)16384 * DM * 2;
constexpr size_t WS_MEMK = WS_V + (size_t)16384 * DM * 2;
constexpr size_t WS_MEMVT = WS_MEMK + (size_t)32 * 256 * DM * 2;
constexpr size_t WS_A = WS_MEMVT + (size_t)32 * 256 * DM * 2;
constexpr size_t WS_B = WS_A + (size_t)NT * DM * 4;
constexpr size_t WS_C = WS_B + (size_t)NT * DM * 4;
constexpr size_t WS_D = WS_C + (size_t)NT * DM * 2;
constexpr size_t WS_E = WS_D + (size_t)NT * DM * 2;
constexpr size_t WS_F = WS_E + (size_t)NT * DM * 2;
constexpr size_t WS_BAR = WS_F + (size_t)NT * DM * 4;
constexpr size_t WS_USC = WS_BAR + 2048;
constexpr size_t WS_VSC = WS_USC + (size_t)16384 * 4;
constexpr size_t WS_CBP = WS_VSC + (size_t)16384 * 4;
constexpr size_t WS_CBS = WS_CBP + (size_t)128 * 2048 * 4;
constexpr size_t WS_SSQ = WS_CBS + (size_t)128 * 4160 * 4;
constexpr size_t WS_XBAR = WS_SSQ + (size_t)NT * 2 * 4;
constexpr size_t WS_TOTAL = WS_XBAR + 16384;

struct Params {
  const float *x_prompt, *x_sample, *mem_prompt, *c_sb_k, *c_sb_v, *c_fx_k, *c_fx_v, *c_fx_logf, *c_mem_k, *c_mem_v;
  const float *w_in, *b_f, *w_gn, *w_out, *ln1_g, *ln1_b, *w_mq, *w_mk, *w_mv, *w_mo, *ln2_g, *ln2_b;
  const float *w_pq, *keys_a, *keys_b, *peer_u, *peer_v, *ln3_g, *ln3_b;
  float* out;
  char* ws;
};

DI const Params* kparams() { auto ka = __builtin_amdgcn_kernarg_segment_ptr(); asm volatile("" : "+s"(ka)); return (const Params*)ka; }
constexpr int SMEM_BYTES = 73728 + 1024 + 64;

DI unsigned pk2(float a, float b) { f2_t v = {a, b}; bf2_t r = __builtin_convertvector(v, bf2_t); return __builtin_bit_cast(unsigned, r); }
DI u16 bf1(float a) { return (u16)(pk2(a, 0.f) & 0xffffu); }
DI float bflo(unsigned w) { return __uint_as_float(w << 16); }
DI float bfhi(unsigned w) { return __uint_as_float(w & 0xffff0000u); }
DI float wave_sum(float v) {
#pragma unroll
  for (int o = 32; o >= 1; o >>= 1) v += __shfl_xor(v, o);
  return v;
}
DI float wave_max(float v) {
#pragma unroll
  for (int o = 32; o >= 1; o >>= 1) v = fmaxf(v, __shfl_xor(v, o));
  return v;
}
DI int vblock() { int nb = gridDim.x, b = blockIdx.x; return ((nb & 7) == 0) ? (b & 7) * (nb >> 3) + (b >> 3) : b; }
DI const float* xrow(const Params& p, int g) { return g < NTP ? p.x_prompt + (size_t)g * DM : p.x_sample + (size_t)(g - NTP) * DM; }

DI void tconv_tile(const float* src, int ldsrc, int C, u16* dst, int lddst, const float* rowscale, int tr, int tc, float* tile) {
  const int tid = threadIdx.x;
  {
    const int r = tid >> 2, c0 = (tid & 3) * 16;
    const int gr = tr * 64 + r;
    const float sc = rowscale ? rowscale[gr] : 1.f;
#pragma unroll
    for (int j = 0; j < 4; ++j) {
      const int gc = tc * 64 + c0 + 4 * j;
      float4 v = make_float4(0.f, 0.f, 0.f, 0.f);
      if (gc < C) v = *(const float4*)(src + (size_t)gr * ldsrc + gc);
      float* t = tile + r * 65 + c0 + 4 * j;
      t[0] = v.x * sc; t[1] = v.y * sc; t[2] = v.z * sc; t[3] = v.w * sc;
    }
  }
  __syncthreads();
  {
    const int n = tid >> 2, k0 = (tid & 3) * 16;
    unsigned w[8];
#pragma unroll
    for (int e = 0; e < 8; ++e) w[e] = pk2(tile[(k0 + 2 * e) * 65 + n], tile[(k0 + 2 * e + 1) * 65 + n]);
    uint4* d = (uint4*)(dst + (size_t)(tc * 64 + n) * lddst + tr * 64 + k0);
    d[0] = make_uint4(w[0], w[1], w[2], w[3]);
    d[1] = make_uint4(w[4], w[5], w[6], w[7]);
  }
  __syncthreads();
}

DI void conv_range(const float* src, u16* dst, size_t n8, int bid, int nb) {
  const size_t step = (size_t)nb * 256;
  size_t i = (size_t)bid * 256 + threadIdx.x;
  for (; i + 3 * step < n8; i += 4 * step) {
    float4 a[4], b[4];
#pragma unroll
    for (int u = 0; u < 4; ++u) { a[u] = ((const float4*)src)[2 * (i + u * step)]; b[u] = ((const float4*)src)[2 * (i + u * step) + 1]; }
#pragma unroll
    for (int u = 0; u < 4; ++u) ((uint4*)dst)[i + u * step] = make_uint4(pk2(a[u].x, a[u].y), pk2(a[u].z, a[u].w), pk2(b[u].x, b[u].y), pk2(b[u].z, b[u].w));
  }
  for (; i < n8; i += step) {
    const float4 a = ((const float4*)src)[2 * i], b = ((const float4*)src)[2 * i + 1];
    ((uint4*)dst)[i] = make_uint4(pk2(a.x, a.y), pk2(a.z, a.w), pk2(b.x, b.y), pk2(b.z, b.w));
  }
}

DI void phase_prep(const Params& p, char* smem) {
  float* tile = (float*)smem;
  const int bid = blockIdx.x, nb = gridDim.x;
  u16* ws16 = (u16*)p.ws;
  constexpr int T_WIN = 16 * 50, T_SQ = 256, T_PQ = 16 * 32, T_MV = 16 * 4 * 16;
  constexpr int T0 = T_WIN, T1 = T0 + T_SQ, T2 = T1 + T_SQ, T3 = T2 + T_SQ, T4 = T3 + T_SQ, T5 = T4 + T_SQ, T6 = T5 + T_PQ, T7 = T6 + T_MV;
  for (int t = bid; t < T7; t += nb) {
    if (t < T0) { tconv_tile(p.w_in, INC, INC, (u16*)(p.ws + WS_WIN), DM, nullptr, t / 50, t % 50, tile); }
    else if (t < T1) { int u = t - T0; tconv_tile(p.w_out, DM, DM, (u16*)(p.ws + WS_WOUT), DM, p.w_gn, u >> 4, u & 15, tile); }
    else if (t < T2) { int u = t - T1; tconv_tile(p.w_mq, DM, DM, (u16*)(p.ws + WS_WMQ), DM, nullptr, u >> 4, u & 15, tile); }
    else if (t < T3) { int u = t - T2; tconv_tile(p.w_mk, DM, DM, (u16*)(p.ws + WS_WMKV), DM, nullptr, u >> 4, u & 15, tile); }
    else if (t < T4) { int u = t - T3; tconv_tile(p.w_mv, DM, DM, (u16*)(p.ws + WS_WMKV) + (size_t)DM * DM, DM, nullptr, u >> 4, u & 15, tile); }
    else if (t < T5) { int u = t - T4; tconv_tile(p.w_mo, DM, DM, (u16*)(p.ws + WS_WMO), DM, nullptr, u >> 4, u & 15, tile); }
    else if (t < T6) { int u = t - T5; tconv_tile(p.w_pq, 2048, 2048, (u16*)(p.ws + WS_WPQ), DM, nullptr, u >> 5, u & 31, tile); }
    else { int u = t - T6; int b = u >> 6, r = u & 63;
      tconv_tile(p.c_mem_v + (size_t)b * 256 * DM, DM, DM, (u16*)(p.ws + WS_MEMVT) + (size_t)(16 + b) * DM * 256, 256, nullptr, r >> 4, r & 15, tile); }
  }
  (void)ws16;
  for (int i = bid * 256 + threadIdx.x; i < NT * 2; i += nb * 256) ((float*)(p.ws + WS_SSQ))[i] = 0.f;
  conv_range(p.x_prompt, (u16*)(p.ws + WS_C), (size_t)NTP * DM / 8, bid, nb);
  conv_range(p.x_sample, (u16*)(p.ws + WS_C) + (size_t)NTP * DM, (size_t)NTS * DM / 8, bid, nb);
  conv_range(p.mem_prompt, (u16*)(p.ws + WS_E), (size_t)4096 * DM / 8, bid, nb);
  conv_range(p.c_mem_k, (u16*)(p.ws + WS_MEMK) + (size_t)16 * 256 * DM, (size_t)16 * 256 * DM / 8, bid, nb);
  conv_range(p.keys_a, (u16*)(p.ws + WS_KA), (size_t)8 * 128 * 128 / 8, bid, nb);
  conv_range(p.keys_b, (u16*)(p.ws + WS_KB), (size_t)8 * 128 * 128 / 8, bid, nb);
#if USE_FP8
  {
    const int lane = threadIdx.x & 63;
    const int wg = bid * 4 + (threadIdx.x >> 6), nw = nb * 4;
    for (int row0 = wg; row0 < 32768; row0 += 2 * nw) {
      float4 a[2][4];
      float am[2];
#pragma unroll
      for (int u = 0; u < 2; ++u) {
        const int row = row0 + u * nw;
        const bool isv = row >= 16384;
        const int r = isv ? row - 16384 : row;
        const float4* src = (const float4*)((isv ? p.peer_v : p.peer_u) + (size_t)r * DM) + 4 * lane;
        am[u] = 0.f;
#pragma unroll
        for (int j = 0; j < 4; ++j) { a[u][j] = src[j]; am[u] = fmaxf(am[u], fmaxf(fmaxf(fabsf(a[u][j].x), fabsf(a[u][j].y)), fmaxf(fabsf(a[u][j].z), fabsf(a[u][j].w)))); }
      }
#pragma unroll
      for (int o = 32; o >= 1; o >>= 1)
#pragma unroll
        for (int u = 0; u < 2; ++u) am[u] = fmaxf(am[u], __shfl_xor(am[u], o));
#pragma unroll
      for (int u = 0; u < 2; ++u) {
        const int row = row0 + u * nw;
        const bool isv = row >= 16384;
        const int r = isv ? row - 16384 : row;
        int ex = 0;
        if (am[u] > 0.f) (void)frexpf(am[u], &ex);
        const float sc = ldexpf(1.f, 8 - ex), isc = ldexpf(1.f, ex - 8);
        unsigned w[4];
#pragma unroll
        for (int j = 0; j < 4; ++j) {
          int t = __builtin_amdgcn_cvt_pk_fp8_f32(a[u][j].x * sc, a[u][j].y * sc, 0, false);
          t = __builtin_amdgcn_cvt_pk_fp8_f32(a[u][j].z * sc, a[u][j].w * sc, t, true);
          w[j] = (unsigned)t;
        }
        *(uint4*)(p.ws + (isv ? WS_V : WS_U) + (size_t)r * DM + 16 * lane) = make_uint4(w[0], w[1], w[2], w[3]);
        if (lane == 0) ((float*)(p.ws + (isv ? WS_VSC : WS_USC)))[r] = isc;
      }
    }
  }
#else
  conv_range(p.peer_u, (u16*)(p.ws + WS_U), (size_t)16384 * DM / 8, bid, nb);
  conv_range(p.peer_v, (u16*)(p.ws + WS_V), (size_t)16384 * DM / 8, bid, nb);
#endif
}

#define ACC_ROW(e, hh) (((e) & 3) + 8 * ((e) >> 2) + 4 * (hh))
#define ACC_R0(e) (((e) & 3) + 8 * ((e) >> 2))
DI void store_bf16_pairs(u16* O, unsigned b0, unsigned ld, const f32x16& acc, float scale) {
  const bool odd = (threadIdx.x & 1) != 0;
#pragma unroll
  for (int e = 0; e < 16; e += 2) {
    const float a = acc[e] * scale, b = acc[e + 1] * scale;
    const float snd = odd ? a : b;
    const float rcv = __int_as_float(__builtin_amdgcn_update_dpp(0, __float_as_int(snd), 0xB1, 0xF, 0xF, true));
    const unsigned w = odd ? pk2(rcv, b) : pk2(a, rcv);
    const unsigned idx = b0 + (ACC_R0(e) + (odd ? 1u : 0u)) * ld - (odd ? 1u : 0u);
    *(unsigned*)(O + idx) = w;
  }
}
DI void store_bf16_pairs_res(u16* O, unsigned b0, const f32x16& acc, const u16* res, unsigned r0) {
  const bool odd = (threadIdx.x & 1) != 0;
#pragma unroll
  for (int e = 0; e < 16; e += 2) {
    const float a = DN_ALPHA * bflo((unsigned)res[r0 + ACC_R0(e) * 1024u]) + acc[e];
    const float b = DN_ALPHA * bflo((unsigned)res[r0 + ACC_R0(e + 1) * 1024u]) + acc[e + 1];
    const float snd = odd ? a : b;
    const float rcv = __int_as_float(__builtin_amdgcn_update_dpp(0, __float_as_int(snd), 0xB1, 0xF, 0xF, true));
    const unsigned w = odd ? pk2(rcv, b) : pk2(a, rcv);
    const unsigned idx = b0 + (ACC_R0(e) + (odd ? 1u : 0u)) * 1024u - (odd ? 1u : 0u);
    *(unsigned*)(O + idx) = w;
  }
}
template <int V> struct IC { static constexpr int value = V; };
struct SmemGemm { u16 a[2][128 * 64]; u16 b[2][128 * 64]; };

template <int ROWS>
struct GldsBf16 {
  const u16* base; int ld;
  DI void issue(int kt, u16* lds, int tid) {
    const int wid = tid >> 6, lane = tid & 63;
    constexpr int NCH = ROWS / 32;
#pragma unroll
    for (int q = 0; q < NCH; ++q) {
      const int ch = wid * NCH + q;
      const int r = ch * 8 + (lane >> 3);
      const int c = (lane & 7) ^ ((r >> 1) & 7);
      __builtin_amdgcn_global_load_lds((const unsigned*)(base + (size_t)r * ld + kt * 64 + c * 8), (unsigned*)(lds + ch * 512), 16, 0, 0);
    }
  }
  DI void commit(u16*, int) {}
};
#ifndef GEMM_REG2
#define GEMM_REG2 1
#endif
#if GEMM_REG2
typedef unsigned u32x4 __attribute__((ext_vector_type(4)));
template <int ROWS>
struct LdReg {
  static constexpr int N = ROWS / 32;
  const u16* base; int ld;
  u32x4 r0, r1, r2, r3;
  DI const u32x4* src(int kt, int tid, int i) const { const int c = tid + 256 * i; return (const u32x4*)(base + (size_t)(c >> 3) * ld + kt * 64 + (c & 7) * 8); }
  DI static u32x4* dst(u16* lds, int tid, int i) { const int c = tid + 256 * i; const int row = c >> 3; return (u32x4*)(lds + row * 64 + (((c & 7) ^ ((row >> 1) & 7)) * 8)); }
  DI void fetch(int kt, int tid) {
    r0 = *src(kt, tid, 0); r1 = *src(kt, tid, 1);
    if (N > 2) { r2 = *src(kt, tid, 2); r3 = *src(kt, tid, 3); }
  }
  DI void stash(u16* lds, int tid) const {
    *dst(lds, tid, 0) = r0; *dst(lds, tid, 1) = r1;
    if (N > 2) { *dst(lds, tid, 2) = r2; *dst(lds, tid, 3) = r3; }
  }
};
template <int MI, bool GRMS>
DI void gemm_compute(const u16* pa, const u16* pb, f32x16 (&acc)[MI][MI], int o0, int o1, int o2, int o3, int wr, int hh, bool scale_now, const float* rsc) {
  if (GRMS && scale_now) {
#pragma unroll
    for (int i = 0; i < MI; ++i)
#pragma unroll
      for (int e = 0; e < 16; ++e) {
        const float rt = rsc[((wr * MI + i) * 32 + ACC_ROW(e, hh)) * 2];
#pragma unroll
        for (int j = 0; j < MI; ++j) acc[i][j][e] *= rt;
      }
  }
  const int off[4] = {o0, o1, o2, o3};
  bf16x8 af[2][MI], bfr[2][MI];
#pragma unroll
  for (int i = 0; i < MI; ++i) { af[0][i] = *(const bf16x8*)(pa + i * 32 * 64 + off[0]); bfr[0][i] = *(const bf16x8*)(pb + i * 32 * 64 + off[0]); }
#pragma unroll
  for (int kk = 0; kk < 4; ++kk) {
    if (kk < 3) {
#pragma unroll
      for (int i = 0; i < MI; ++i) { af[(kk + 1) & 1][i] = *(const bf16x8*)(pa + i * 32 * 64 + off[kk + 1]); bfr[(kk + 1) & 1][i] = *(const bf16x8*)(pb + i * 32 * 64 + off[kk + 1]); }
    }
#pragma unroll
    for (int i = 0; i < MI; ++i)
#pragma unroll
      for (int j = 0; j < MI; ++j) acc[i][j] = MFMA(af[kk & 1][i], bfr[kk & 1][j], acc[i][j]);
  }
}
template <int MI, bool GRMS = false, class AL, class EPI>
DI void gemm_tile(AL& al, const u16* Bt, int ldb, int K, int m0, int n0, EPI epi, char* smem, const float* rsc = nullptr) {
  SmemGemm& sm = *(SmemGemm*)smem;
  const int tid = threadIdx.x, lane = tid & 63, wid = tid >> 6, wr = wid >> 1, wc = wid & 1, r31 = lane & 31, hh = lane >> 5;
  LdReg<MI * 64> a0, a1, b0, b1;
  a0.base = al.base; a0.ld = al.ld; a1.base = al.base; a1.ld = al.ld;
  b0.base = Bt + (size_t)n0 * ldb; b0.ld = ldb; b1.base = b0.base; b1.ld = ldb;
  f32x16 acc[MI][MI];
#pragma unroll
  for (int i = 0; i < MI; ++i)
#pragma unroll
    for (int j = 0; j < MI; ++j)
#pragma unroll
      for (int e = 0; e < 16; ++e) acc[i][j][e] = 0.f;
  int off[4];
#pragma unroll
  for (int kk = 0; kk < 4; ++kk) off[kk] = r31 * 64 + (((kk * 2 + hh) ^ ((r31 >> 1) & 7)) * 8);
  const int KT = K >> 6;
  a0.fetch(0, tid); b0.fetch(0, tid);
  a1.fetch(1, tid); b1.fetch(1, tid);
  a0.stash(sm.a[0], tid); b0.stash(sm.b[0], tid);
  __syncthreads();
  for (int kt = 0; kt < KT; kt += 2) {
    { const int kn = min(kt + 2, KT - 1); a0.fetch(kn, tid); b0.fetch(kn, tid); }
    gemm_compute<MI, GRMS>(sm.a[0] + (wr * MI * 32) * 64, sm.b[0] + (wc * MI * 32) * 64, acc, off[0], off[1], off[2], off[3], wr, hh, kt == (KT >> 1), rsc);
    a1.stash(sm.a[1], tid); b1.stash(sm.b[1], tid);
    __syncthreads();
    { const int kn = min(kt + 3, KT - 1); a1.fetch(kn, tid); b1.fetch(kn, tid); }
    gemm_compute<MI, GRMS>(sm.a[1] + (wr * MI * 32) * 64, sm.b[1] + (wc * MI * 32) * 64, acc, off[0], off[1], off[2], off[3], wr, hh, (kt + 1) == (KT >> 1), rsc);
    a0.stash(sm.a[0], tid); b0.stash(sm.b[0], tid);
    __syncthreads();
  }
  if (GRMS) {
#pragma unroll
    for (int i = 0; i < MI; ++i)
#pragma unroll
      for (int e = 0; e < 16; ++e) {
        const float s1 = rsc[((wr * MI + i) * 32 + ACC_ROW(e, hh)) * 2 + 1];
#pragma unroll
        for (int j = 0; j < MI; ++j) acc[i][j][e] *= s1;
      }
  }
#pragma unroll
  for (int i = 0; i < MI; ++i)
#pragma unroll
    for (int j = 0; j < MI; ++j) epi(m0 + (wr * MI + i) * 32, n0 + (wc * MI + j) * 32, acc[i][j]);
}
#else
template <int MI, bool GRMS = false, class AL, class EPI>
DI void gemm_tile(AL& al, const u16* Bt, int ldb, int K, int m0, int n0, EPI epi, char* smem, const float* rsc = nullptr) {
  SmemGemm& sm = *(SmemGemm*)smem;
  const int tid = threadIdx.x, lane = tid & 63, wid = tid >> 6, wr = wid >> 1, wc = wid & 1, r31 = lane & 31, hh = lane >> 5;
  GldsBf16<MI * 64> bl; bl.base = Bt + (size_t)n0 * ldb; bl.ld = ldb;
  f32x16 acc[MI][MI];
#pragma unroll
  for (int i = 0; i < MI; ++i)
#pragma unroll
    for (int j = 0; j < MI; ++j)
#pragma unroll
      for (int e = 0; e < 16; ++e) acc[i][j][e] = 0.f;
  int off[4];
#pragma unroll
  for (int kk = 0; kk < 4; ++kk) off[kk] = r31 * 64 + (((kk * 2 + hh) ^ ((r31 >> 1) & 7)) * 8);
  const int KT = K >> 6;
  al.issue(0, sm.a[0], tid); bl.issue(0, sm.b[0], tid);
  al.commit(sm.a[0], tid);
  asm volatile("s_waitcnt vmcnt(0)" ::: "memory");
  __syncthreads();
  for (int kt = 0; kt < KT; ++kt) {
    const int cur = kt & 1;
    if (kt + 1 < KT) { al.issue(kt + 1, sm.a[cur ^ 1], tid); bl.issue(kt + 1, sm.b[cur ^ 1], tid); }
    const u16* pa = sm.a[cur] + (wr * MI * 32) * 64;
    const u16* pb = sm.b[cur] + (wc * MI * 32) * 64;
    if (GRMS && kt == (KT >> 1)) {
#pragma unroll
      for (int i = 0; i < MI; ++i)
#pragma unroll
        for (int e = 0; e < 16; ++e) {
          const float rt = rsc[((wr * MI + i) * 32 + ACC_ROW(e, hh)) * 2];
#pragma unroll
          for (int j = 0; j < MI; ++j) acc[i][j][e] *= rt;
        }
    }
#pragma unroll
    for (int kk = 0; kk < 4; ++kk) {
      bf16x8 af[MI], bfr[MI];
#pragma unroll
      for (int i = 0; i < MI; ++i) { af[i] = *(const bf16x8*)(pa + i * 32 * 64 + off[kk]); bfr[i] = *(const bf16x8*)(pb + i * 32 * 64 + off[kk]); }
#pragma unroll
      for (int i = 0; i < MI; ++i)
#pragma unroll
        for (int j = 0; j < MI; ++j) acc[i][j] = MFMA(af[i], bfr[j], acc[i][j]);
    }
    if (kt + 1 < KT) al.commit(sm.a[cur ^ 1], tid);
    asm volatile("s_waitcnt vmcnt(0)" ::: "memory");
    __syncthreads();
  }
  if (GRMS) {
#pragma unroll
    for (int i = 0; i < MI; ++i)
#pragma unroll
      for (int e = 0; e < 16; ++e) {
        const float s1 = rsc[((wr * MI + i) * 32 + ACC_ROW(e, hh)) * 2 + 1];
#pragma unroll
        for (int j = 0; j < MI; ++j) acc[i][j][e] *= s1;
      }
  }
#pragma unroll
  for (int i = 0; i < MI; ++i)
#pragma unroll
    for (int j = 0; j < MI; ++j) epi(m0 + (wr * MI + i) * 32, n0 + (wc * MI + j) * 32, acc[i][j]);
}
#endif
template <class F>
DI void for_tiles(int N, F body) {
  const int vb = vblock(), nb = gridDim.x;
  const int ntn = N >> 7, ntn2 = N >> 6;
  const int nbig = 256 * ntn, nsmall = 16 * ntn2;
  for (int t = vb; t < nbig + nsmall; t += nb) {
    if (t < nbig) { body((t / ntn) * 128, (t % ntn) * 128, IC<2>{}); }
    else { const int u = t - nbig; body(NTP + (u / ntn2) * 64, (u % ntn2) * 64, IC<1>{}); }
  }
}

DI void phase_proj(const Params& p, char* smem) {
  const int vb = vblock(), nb = gridDim.x;
  constexpr int T_G1 = 264 * 25, T_MKV = 32 * 16;
  float* out = p.out;
  for (int t = vb; t < T_G1 + T_MKV; t += nb) {
    if (t < T_G1) {
      const int mt = t / 25, nt = t % 25;
      const int m0 = mt * 128, n0 = nt * 128;
      GldsBf16<128> al; al.base = (const u16*)(p.ws + WS_C) + (size_t)m0 * DM; al.ld = DM;
      const bool smp = m0 >= NTP;
      const float* b_f = p.b_f;
      u16* qsb = (u16*)(p.ws + WS_D);
      u16* qfx = qsb + (size_t)NT * 512;
      char* ws = p.ws;
      auto epi = [=](int r0, int c0, const f32x16& acc) {
        const int lane = threadIdx.x & 63, hh = lane >> 5, col = c0 + (lane & 31);
        const int seg = c0 >> 9, cc = col & 511;
        if (seg == 0 || seg == 3) {
          u16* q = (seg == 0) ? qsb : qfx;
#pragma unroll
          for (int e = 0; e < 16; ++e) q[(unsigned)(r0 + 4 * hh) * 512u + cc + ACC_R0(e) * 512u] = bf1(acc[e] * 0.125f);
        } else if (seg < 6) {
          size_t ob;
          if (!smp) ob = (seg == 1) ? OUT_SBK_P : (seg == 2) ? OUT_SBV_P : (seg == 4) ? OUT_FXK_P : OUT_FXV_P;
          else ob = (seg == 1) ? OUT_SBK_S : (seg == 2) ? OUT_SBV_S : (seg == 4) ? OUT_FXK_S : OUT_FXV_S;
          const int rb = smp ? r0 - NTP : r0;
          float* ov = out + ob;
          const unsigned b0 = (unsigned)(rb + 4 * hh) * 512u + cc;
#pragma unroll
          for (int e = 0; e < 16; ++e) ov[b0 + ACC_R0(e) * 512u] = acc[e];
          if (!smp) {
            if (seg == 1 || seg == 4) {
              u16* k16 = (u16*)(ws + WS_A) + (seg == 4 ? (size_t)NTP * 512 : 0);
#pragma unroll
              for (int e = 0; e < 16; ++e) k16[b0 + ACC_R0(e) * 512u] = bf1(acc[e]);
            } else {
              u16* vt16 = (u16*)(ws + WS_B) + (seg == 5 ? (size_t)NTP * 512 : 0);
              const unsigned vb0 = (unsigned)(((r0 >> 11) * 8 + (cc >> 6)) * 64 + (cc & 63)) * 2048u + (unsigned)(r0 & 2047) + 4 * hh;
#pragma unroll
              for (int g4 = 0; g4 < 4; ++g4) *(uint2*)(vt16 + vb0 + 8 * g4) = make_uint2(pk2(acc[4 * g4], acc[4 * g4 + 1]), pk2(acc[4 * g4 + 2], acc[4 * g4 + 3]));
            }
          }
        } else {
          const int c = col - 3072;
          if (c < 8) {
            const float bf = b_f[c];
            const size_t ob = smp ? OUT_LF_S : OUT_LF_P;
            const int rb = smp ? r0 - NTP : r0;
#pragma unroll
            for (int e = 0; e < 16; ++e) {
              const float z = acc[e] + bf;
              const float ls = fminf(z, 0.f) - log1pf(__expf(-fabsf(z)));
              out[ob + (unsigned)(rb + ACC_ROW(e, hh)) * 8u + c] = ls;
            }
          }
        }
      };
      gemm_tile<2>(al, (const u16*)(p.ws + WS_WIN), DM, DM, m0, n0, epi, smem);
    } else {
      const int u = t - T_G1;
      const int mt = u >> 4, nt = u & 15;
      const int m0 = mt * 128, n0 = nt * 128;
      GldsBf16<128> al; al.base = (const u16*)(p.ws + WS_E) + (size_t)m0 * DM; al.ld = DM;
      u16* kb = (u16*)(p.ws + WS_MEMK);
      u16* vt = (u16*)(p.ws + WS_MEMVT);
      auto epi = [=](int r0, int c0, const f32x16& acc) {
        const int lane = threadIdx.x & 63, hh = lane >> 5, col = c0 + (lane & 31);
        if (c0 < 1024) {
          float* ov = out + OUT_MK_P;
          const unsigned b0 = (unsigned)(r0 + 4 * hh) * 1024u + col;
#pragma unroll
          for (int e = 0; e < 16; ++e) { const unsigned idx = b0 + ACC_R0(e) * 1024u; ov[idx] = acc[e]; kb[idx] = bf1(acc[e]); }
        } else {
          const int c = col - 1024;
          float* ov = out + OUT_MV_P;
          const unsigned b0 = (unsigned)(r0 + 4 * hh) * 1024u + c;
#pragma unroll
          for (int e = 0; e < 16; ++e) ov[b0 + ACC_R0(e) * 1024u] = acc[e];
          const int b = r0 >> 8;
#pragma unroll
          for (int g4 = 0; g4 < 4; ++g4) {
            const int m = (r0 & 255) + 8 * g4 + 4 * hh;
            *(uint2*)(vt + ((size_t)b * DM + c) * 256 + m) = make_uint2(pk2(acc[4 * g4], acc[4 * g4 + 1]), pk2(acc[4 * g4 + 2], acc[4 * g4 + 3]));
          }
        }
      };
      gemm_tile<2>(al, (const u16*)(p.ws + WS_WMKV), DM, DM, m0, n0, epi, smem);
    }
  }
}

template <int PER>
DI void scan_one(const float* src0, int n0, const float* src1, int n, float* dst, float* part) {
  const int tid = threadIdx.x;
  const int s0 = tid * PER;
  float v[PER];
#pragma unroll
  for (int i = 0; i < PER; ++i) { const int s = s0 + i; v[i] = (s < n) ? ((s < n0) ? src0[(size_t)s * 8] : src1[(size_t)(s - n0) * 8]) : 0.f; }
  float loc = 0.f;
#pragma unroll
  for (int i = 0; i < PER; ++i) loc += v[i];
  part[tid] = loc;
  __syncthreads();
  float run = 0.f;
  for (int i = 0; i < tid; ++i) run += part[i];
#pragma unroll
  for (int i = 0; i < PER; ++i) { run += v[i]; if (s0 + i < n) dst[s0 + i] = -run * LOG2E; }
  __syncthreads();
}
DI void phase_scan(const Params& p, char* smem) {
  float* part = (float*)smem;
  for (int it = blockIdx.x; it < 256; it += gridDim.x) {
    const int bh = it & 127, b = bh >> 3, h = bh & 7;
    if (it < 128) scan_one<17>(p.c_fx_logf + (size_t)b * PAST * 8 + h, PAST, p.out + OUT_LF_S + (size_t)b * DSEQ * 8 + h, PAST + DSEQ, (float*)(p.ws + WS_CBS) + (size_t)bh * 4160, part);
    else scan_one<8>(p.out + OUT_LF_P + (size_t)b * SEQ * 8 + h, SEQ, nullptr, SEQ, (float*)(p.ws + WS_CBP) + (size_t)bh * 2048, part);
  }
}

constexpr int KLD = 72, VLD = 68;
struct SmemAttn { u16 k[2][64 * KLD]; u16 vt[2][64 * VLD]; float cb[4160]; float part[256]; u16 q[128 * KLD]; };
static_assert(sizeof(SmemAttn) <= SMEM_BYTES, "attn smem");

struct KVRegs { float4 k[4], v[4]; };
DI void kv_fetch(KVRegs& r, const float* kb, const float* vb, int tid) {
#pragma unroll
  for (int i = 0; i < 4; ++i) { const int c = tid + 256 * i; const size_t o = (size_t)(c >> 4) * 512 + (c & 15) * 4; r.k[i] = *(const float4*)(kb + o); r.v[i] = *(const float4*)(vb + o); }
}
DI void kv_stash(const KVRegs& r, u16* ks, u16* vts, int tid) {
#pragma unroll
  for (int i = 0; i < 4; ++i) {
    const int c = tid + 256 * i; const int row = c >> 4, c4 = (c & 15) * 4;
    *(uint2*)(ks + row * KLD + c4) = make_uint2(pk2(r.k[i].x, r.k[i].y), pk2(r.k[i].z, r.k[i].w));
    vts[(c4 + 0) * VLD + row] = bf1(r.v[i].x); vts[(c4 + 1) * VLD + row] = bf1(r.v[i].y);
    vts[(c4 + 2) * VLD + row] = bf1(r.v[i].z); vts[(c4 + 3) * VLD + row] = bf1(r.v[i].w);
  }
}
typedef unsigned kv_u32x4 __attribute__((ext_vector_type(4)));
typedef unsigned kv_u32x2 __attribute__((ext_vector_type(2)));
struct KV16 { kv_u32x4 k0, k1, v0, v1; };
DI void kv_fetch16(KV16& r, const u16* kb, const u16* vtb, int tid) {
  const int c0 = tid, c1 = tid + 256;
  r.k0 = *(const kv_u32x4*)(kb + (size_t)(c0 >> 3) * 512 + (c0 & 7) * 8); r.k1 = *(const kv_u32x4*)(kb + (size_t)(c1 >> 3) * 512 + (c1 & 7) * 8);
  r.v0 = *(const kv_u32x4*)(vtb + (size_t)(c0 >> 3) * SEQ + (c0 & 7) * 8); r.v1 = *(const kv_u32x4*)(vtb + (size_t)(c1 >> 3) * SEQ + (c1 & 7) * 8);
}
DI void kv_stash16(const KV16& r, u16* ks, u16* vts, int tid) {
  const int c0 = tid, c1 = tid + 256;
  *(kv_u32x4*)(ks + (c0 >> 3) * KLD + (c0 & 7) * 8) = r.k0;
  *(kv_u32x4*)(ks + (c1 >> 3) * KLD + (c1 & 7) * 8) = r.k1;
  kv_u32x2 a = {r.v0[0], r.v0[1]}, b2 = {r.v0[2], r.v0[3]}, c = {r.v1[0], r.v1[1]}, d = {r.v1[2], r.v1[3]};
  *(kv_u32x2*)(vts + (c0 >> 3) * VLD + (c0 & 7) * 8) = a; *(kv_u32x2*)(vts + (c0 >> 3) * VLD + (c0 & 7) * 8 + 4) = b2;
  *(kv_u32x2*)(vts + (c1 >> 3) * VLD + (c1 & 7) * 8) = c; *(kv_u32x2*)(vts + (c1 >> 3) * VLD + (c1 & 7) * 8 + 4) = d;
}
DI bf16x8 pack8(const f32x16& x, int s) {
  union { unsigned u[4]; bf16x8 v; } t;
  t.u[0] = pk2(x[8 * s + 0], x[8 * s + 1]); t.u[1] = pk2(x[8 * s + 2], x[8 * s + 3]);
  t.u[2] = pk2(x[8 * s + 4], x[8 * s + 5]); t.u[3] = pk2(x[8 * s + 6], x[8 * s + 7]);
  return t.v;
}

template <bool FOX, bool SMP>
DI void attn_item(const Params& p, int b, int h, int qb, char* smem, bool do_ssq = true, int split = 0) {
  constexpr int smp = SMP ? 1 : 0;
  constexpr bool SPLIT = FOX && SMP;
  SmemAttn& sm = *(SmemAttn*)smem;
  const int tid = threadIdx.x, lane = tid & 63, wid = tid >> 6, r31 = lane & 31, hh = lane >> 5;
  const int jt0 = SPLIT ? split * 8 : 0;
  const int nkt = SPLIT ? (split == 7 ? 9 : 8) : (smp ? 65 : 2 * qb + 2);
  const int jdiag = smp ? 64 : 2 * qb;
  int qi = wid * 32 + r31; if (smp) qi &= 63;
  const int qpos = (smp ? PAST : qb * 128) + qi;
  const int g = smp ? NTP + b * DSEQ + qi : b * SEQ + qb * 128 + qi;
  const u16* Q = (const u16*)(p.ws + WS_D) + (FOX ? (size_t)NT * 512 : 0);
  {
#pragma unroll
    for (int i = 0; i < 4; ++i) {
      const int c = tid + 256 * i; const int row = c >> 3, kc = (c & 7) * 8;
      const int qr = smp ? (row & 63) : row;
      const int gr = smp ? NTP + b * DSEQ + qr : b * SEQ + qb * 128 + qr;
      *(kv_u32x4*)(sm.q + row * KLD + kc) = *(const kv_u32x4*)(Q + (size_t)gr * 512 + h * 64 + kc);
    }
    __syncthreads();
  }

  const float* kcache = FOX ? p.c_fx_k : p.c_sb_k;
  const float* vcache = FOX ? p.c_fx_v : p.c_sb_v;
  const size_t okp = FOX ? OUT_FXK_P : OUT_SBK_P, ovp = FOX ? OUT_FXV_P : OUT_SBV_P;
  const size_t oks = FOX ? OUT_FXK_S : OUT_SBK_S, ovs = FOX ? OUT_FXV_S : OUT_SBV_S;
  auto kptr = [&](int j) -> const float* {
    if (!smp) return p.out + okp + ((size_t)(b * SEQ + 64 * j) * 512 + h * 64);
    if (j < 64) return kcache + ((size_t)(b * PAST + 64 * j) * 512 + h * 64);
    return p.out + oks + ((size_t)(b * DSEQ) * 512 + h * 64);
  };
  auto vptr = [&](int j) -> const float* {
    if (!smp) return p.out + ovp + ((size_t)(b * SEQ + 64 * j) * 512 + h * 64);
    if (j < 64) return vcache + ((size_t)(b * PAST + 64 * j) * 512 + h * 64);
    return p.out + ovs + ((size_t)(b * DSEQ) * 512 + h * 64);
  };

  if (FOX) {
    const float4* src = (const float4*)(smp ? (const float*)(p.ws + WS_CBS) + (size_t)(b * 8 + h) * 4160 : (const float*)(p.ws + WS_CBP) + (size_t)(b * 8 + h) * 2048);
    for (int i = jt0 * 16 + tid; i < (jt0 + nkt) * 16; i += 256) ((float4*)sm.cb)[i] = src[i];
    __syncthreads();
  }

  bf16x8 tri[2];
  if (!FOX) {
#pragma unroll
    for (int s = 0; s < 2; ++s)
#pragma unroll
      for (int j = 0; j < 8; ++j) { const int kin = 16 * s + 8 * (j >> 2) + 4 * hh + (j & 3); tri[s][j] = (kin >= r31) ? (short)0x3F80 : (short)0; }
  }

  f32x16 o[2];
#pragma unroll
  for (int d = 0; d < 2; ++d)
#pragma unroll
    for (int e = 0; e < 16; ++e) o[d][e] = 0.f;
  float mrun = -1e30f, lrun = 0.f, R = 0.f;

  KVRegs kv;
  KV16 kw;
  const int jfirst = FOX ? jt0 : nkt - 1;
  const u16* k16 = (const u16*)(p.ws + WS_A) + (FOX ? (size_t)NTP * 512 : 0) + (size_t)(b * SEQ) * 512 + h * 64;
  const u16* vt16 = (const u16*)(p.ws + WS_B) + (FOX ? (size_t)NTP * 512 : 0) + (size_t)((b * 8 + h) * 64) * SEQ;
  if (smp) { kv_fetch(kv, kptr(jfirst), vptr(jfirst), tid); kv_stash(kv, sm.k[0], sm.vt[0], tid); }
  else { kv_fetch16(kw, k16 + (size_t)(64 * jfirst) * 512, vt16 + 64 * jfirst, tid); kv_stash16(kw, sm.k[0], sm.vt[0], tid); }
  __syncthreads();
  for (int it = 0; it < nkt; ++it) {
    const int j = FOX ? jt0 + it : nkt - 1 - it;
    const int cur = it & 1;
    if (it + 1 < nkt) { const int jn = FOX ? j + 1 : j - 1; if (smp) kv_fetch(kv, kptr(jn), vptr(jn), tid); else kv_fetch16(kw, k16 + (size_t)(64 * jn) * 512, vt16 + 64 * jn, tid); }
    f32x16 s[2];
#pragma unroll
    for (int t2 = 0; t2 < 2; ++t2) {
#pragma unroll
      for (int e = 0; e < 16; ++e) s[t2][e] = 0.f;
      const u16* pk = sm.k[cur] + (t2 * 32 + r31) * KLD + hh * 8;
      const u16* pq = sm.q + (wid * 32 + r31) * KLD + hh * 8;
#pragma unroll
      for (int kk = 0; kk < 4; ++kk) { const bf16x8 a = *(const bf16x8*)(pk + kk * 16); const bf16x8 qv = *(const bf16x8*)(pq + kk * 16); s[t2] = MFMA(a, qv, s[t2]); }
    }
    const bool diag = j >= jdiag;
    const int kbase = 64 * j + 4 * hh;
    if (FOX) {
      float mloc = -1e30f;
#pragma unroll
      for (int t2 = 0; t2 < 2; ++t2) {
        f32x16 bvec;
#pragma unroll
        for (int g4 = 0; g4 < 4; ++g4) {
          const float4 bb = *(const float4*)(sm.cb + 64 * j + 32 * t2 + 8 * g4 + 4 * hh);
          bvec[4 * g4] = bb.x; bvec[4 * g4 + 1] = bb.y; bvec[4 * g4 + 2] = bb.z; bvec[4 * g4 + 3] = bb.w;
        }
        s[t2] = s[t2] * LOG2E + bvec;
      }
      if (diag) {
#pragma unroll
        for (int t2 = 0; t2 < 2; ++t2)
#pragma unroll
          for (int e = 0; e < 16; ++e) if (kbase + 32 * t2 + ACC_ROW(e, 0) > qpos) s[t2][e] = -1e30f;
      }
#pragma unroll
      for (int t2 = 0; t2 < 2; ++t2)
#pragma unroll
        for (int e = 0; e < 16; ++e) mloc = fmaxf(mloc, s[t2][e]);
      mloc = fmaxf(mloc, __shfl_xor(mloc, 32));
      const float mnew = fmaxf(mrun, mloc);
      const float alpha = __builtin_amdgcn_exp2f(mrun - mnew);
      mrun = mnew;
      float ls = 0.f;
#pragma unroll
      for (int t2 = 0; t2 < 2; ++t2) {
        s[t2] = s[t2] - mnew;
#pragma unroll
        for (int e = 0; e < 16; ++e) { const float pv = __builtin_amdgcn_exp2f(s[t2][e]); s[t2][e] = pv; ls += pv; }
      }
      lrun = lrun * alpha + ls;
#pragma unroll
      for (int d = 0; d < 2; ++d) o[d] = o[d] * alpha;
    } else {
#pragma unroll
      for (int t2 = 1; t2 >= 0; --t2) {
        f32x16 lk;
#pragma unroll
        for (int e = 0; e < 16; ++e) {
          const float z = s[t2][e];
          const float sp = fmaxf(z, 0.f) + __logf(1.f + __expf(-fabsf(z)));
          const bool vis = !diag || (kbase + 32 * t2 + ACC_ROW(e, 0) < qpos);
          lk[e] = vis ? -sp : 0.f;
        }
        bf16x8 fh[2], fl[2];
#pragma unroll
        for (int sI = 0; sI < 2; ++sI) fh[sI] = pack8(lk, sI);
#pragma unroll
        for (int e = 0; e < 16; ++e) lk[e] -= __uint_as_float(((unsigned)(u16)fh[e >> 3][e & 7]) << 16);
#pragma unroll
        for (int sI = 0; sI < 2; ++sI) fl[sI] = pack8(lk, sI);
        f32x16 inc;
#pragma unroll
        for (int e = 0; e < 16; ++e) inc[e] = R;
#pragma unroll
        for (int sI = 0; sI < 2; ++sI) { inc = MFMA(tri[sI], fh[sI], inc); inc = MFMA(tri[sI], fl[sI], inc); }
#pragma unroll
        for (int e = 0; e < 16; ++e) {
          const bool vis = !diag || (kbase + 32 * t2 + ACC_ROW(e, 0) < qpos);
          const float w = __builtin_amdgcn_exp2f((s[t2][e] + inc[e]) * LOG2E);
          s[t2][e] = vis ? w : 0.f;
        }
        R = __shfl(inc[0], r31);
      }
    }
#pragma unroll
    for (int t2 = 0; t2 < 2; ++t2)
#pragma unroll
      for (int sI = 0; sI < 2; ++sI) {
        const bf16x8 pf = pack8(s[t2], sI);
#pragma unroll
        for (int d = 0; d < 2; ++d) {
          const u16* pv = sm.vt[cur] + (d * 32 + r31) * VLD + 32 * t2 + 16 * sI + 4 * hh;
          union { s16x4 q[2]; bf16x8 v; } a;
          a.q[0] = *(const s16x4*)(pv); a.q[1] = *(const s16x4*)(pv + 8);
          o[d] = MFMA(a.v, pf, o[d]);
        }
      }
    if (it + 1 < nkt) { if (smp) kv_stash(kv, sm.k[cur ^ 1], sm.vt[cur ^ 1], tid); else kv_stash16(kw, sm.k[cur ^ 1], sm.vt[cur ^ 1], tid); }
#if SB_EXIT
    if (!FOX) { if (__syncthreads_and(R < -110.f)) break; } else __syncthreads();
#else
    __syncthreads();
#endif
  }
  if (SPLIT) {
    constexpr int NS = 8;
    const int bh = b * 8 + h;
    float* po = (float*)(p.ws + WS_F) + (size_t)(bh * NS) * 4096;
    float* pml = (float*)(p.ws + WS_F) + (size_t)128 * NS * 4096 + (size_t)(bh * NS) * 128;
    const float lt = lrun + __shfl_xor(lrun, 32);
    if (wid < 2) {
      float* dst = po + (size_t)split * 4096 + qi * 64;
#pragma unroll
      for (int d = 0; d < 2; ++d)
#pragma unroll
        for (int g4 = 0; g4 < 4; ++g4) *(float4*)(dst + d * 32 + 8 * g4 + 4 * hh) = make_float4(o[d][4 * g4], o[d][4 * g4 + 1], o[d][4 * g4 + 2], o[d][4 * g4 + 3]);
      if (hh == 0) *(float2*)(pml + (size_t)split * 128 + qi * 2) = make_float2(mrun, lt);
    }
    int* slot2 = (int*)(smem + 73728 + 528);
    asm volatile("s_waitcnt vmcnt(0)" ::: "memory");
    __syncthreads();
    if (tid == 0) {
      __builtin_amdgcn_fence(__ATOMIC_RELEASE, "agent");
      asm volatile("s_waitcnt vmcnt(0)" ::: "memory");
      const unsigned old = __hip_atomic_fetch_add((unsigned*)(p.ws + WS_BAR + 256) + bh + (do_ssq ? 0 : 128), 1u, __ATOMIC_RELAXED, __HIP_MEMORY_SCOPE_AGENT);
      __builtin_amdgcn_fence(__ATOMIC_ACQUIRE, "agent");
      asm volatile("s_waitcnt vmcnt(0)" ::: "memory");
      *slot2 = (int)old;
    }
    __syncthreads();
    const bool last = (*slot2 == NS - 1);
    __syncthreads();
    if (last) {
      const int q = tid >> 2, d0 = (tid & 3) * 16;
      float ms[NS], ls[NS], M = -1e30f;
#pragma unroll
      for (int s2 = 0; s2 < NS; ++s2) { const float2 ml = *(const float2*)(pml + (size_t)s2 * 128 + q * 2); ms[s2] = ml.x; ls[s2] = ml.y; M = fmaxf(M, ml.x); }
      float L = 0.f, acc[16];
#pragma unroll
      for (int k = 0; k < 16; ++k) acc[k] = 0.f;
#pragma unroll
      for (int s2 = 0; s2 < NS; ++s2) {
        const float w = exp2f(ms[s2] - M);
        L += ls[s2] * w;
        const float4* src = (const float4*)(po + (size_t)s2 * 4096 + q * 64 + d0);
#pragma unroll
        for (int k4 = 0; k4 < 4; ++k4) { const float4 v = src[k4]; acc[4 * k4] += w * v.x; acc[4 * k4 + 1] += w * v.y; acc[4 * k4 + 2] += w * v.z; acc[4 * k4 + 3] += w * v.w; }
      }
      const float invL = 1.f / L;
      float ssq = 0.f;
#pragma unroll
      for (int k = 0; k < 16; ++k) { acc[k] *= invL; ssq += acc[k] * acc[k]; }
      ssq += __shfl_xor(ssq, 1); ssq += __shfl_xor(ssq, 2);
      const int gq = NTP + b * DSEQ + q;
      if (do_ssq && (tid & 3) == 0) atomicAdd((float*)(p.ws + WS_SSQ) + (size_t)gq * 2 + 1, ssq);
      u16* od = (u16*)(p.ws + WS_E) + (size_t)gq * DM + 512 + h * 64 + d0;
      *(uint4*)od = make_uint4(pk2(acc[0], acc[1]), pk2(acc[2], acc[3]), pk2(acc[4], acc[5]), pk2(acc[6], acc[7]));
      *(uint4*)(od + 8) = make_uint4(pk2(acc[8], acc[9]), pk2(acc[10], acc[11]), pk2(acc[12], acc[13]), pk2(acc[14], acc[15]));
    }
    return;
  }
  float inv = 1.f;
  if (FOX) { const float lt = lrun + __shfl_xor(lrun, 32); inv = 1.f / lt; }
  {
    float ssq = 0.f;
#pragma unroll
    for (int d = 0; d < 2; ++d)
#pragma unroll
      for (int e = 0; e < 16; ++e) { const float t = o[d][e] * inv; ssq += t * t; }
    ssq += __shfl_xor(ssq, 32);
    if (do_ssq && hh == 0 && (!smp || wid < 2)) atomicAdd((float*)(p.ws + WS_SSQ) + (size_t)g * 2 + (FOX ? 1 : 0), ssq);
  }
  if (!smp || wid < 2) {
    u16* od = (u16*)(p.ws + WS_E) + (size_t)g * DM + (FOX ? 512 : 0) + h * 64;
#pragma unroll
    for (int d = 0; d < 2; ++d)
#pragma unroll
      for (int g4 = 0; g4 < 4; ++g4)
        *(uint2*)(od + d * 32 + 8 * g4 + 4 * hh) = make_uint2(pk2(o[d][4 * g4] * inv, o[d][4 * g4 + 1] * inv), pk2(o[d][4 * g4 + 2] * inv, o[d][4 * g4 + 3] * inv));
  }
}

template <class F>
DI void attn_queue(unsigned* ctr, int n, int* slot, F body) {
  for (;;) {
    if (threadIdx.x == 0) *slot = (int)atomicAdd(ctr, 1u);
    __syncthreads();
    const int it = *slot;
    __syncthreads();
    if (it >= n) break;
    body(it);
  }
}
DI void phase_attn(const Params& p, char* smem, int rep = 0) {
  unsigned* ctr = (unsigned*)(p.ws + WS_BAR + 128) + rep * 4;
  int* slot = (int*)(smem + 73728 + 512);
  const bool dq = rep == 0;
  attn_queue(ctr + 0, 1024, slot, [&](int it) { const int bh = it >> 3; attn_item<true, true>(p, bh >> 3, bh & 7, 0, smem, dq, it & 7); });
  attn_queue(ctr + 1, 2048, slot, [&](int u) { const int w = u & 511; const int qb = 15 - (w >> 5), bh = (u >> 9) * 32 + (w & 31); attn_item<true, false>(p, bh >> 3, bh & 7, qb, smem, dq); });
  attn_queue(ctr + 2, 128, slot, [&](int u) { attn_item<false, true>(p, u >> 3, u & 7, 0, smem, dq); });
  attn_queue(ctr + 3, 2048, slot, [&](int u) { const int w = u & 511; const int qb = 15 - (w >> 5), bh = (u >> 9) * 32 + (w & 31); attn_item<false, false>(p, bh >> 3, bh & 7, qb, smem, dq); });
}

DI void phase_wout(const Params& p, char* smem) {
  u16* pre = (u16*)(p.ws + WS_A);
  const u16* o = (const u16*)(p.ws + WS_E);
  float* sc_s = (float*)(smem + 73728);
  for_tiles(DM, [&](int m0, int n0, auto tag) {
    constexpr int MI = decltype(tag)::value;
    {
      const int tid = threadIdx.x;
      if (tid < MI * 64) {
        const float2 q = ((const float2*)(p.ws + WS_SSQ))[m0 + tid];
        const float s0 = rsqrtf(q.x * (1.f / 512.f) + 1e-6f), s1 = rsqrtf(q.y * (1.f / 512.f) + 1e-6f);
        sc_s[tid * 2] = s0 / s1; sc_s[tid * 2 + 1] = s1;
      }
      __syncthreads();
    }
    GldsBf16<MI * 64> al; al.base = o + (size_t)m0 * DM; al.ld = DM;
    const u16* xr = (const u16*)(p.ws + WS_C) + (size_t)m0 * DM;
    auto epi = [=](int r0, int c0, const f32x16& acc) {
      const int lane = threadIdx.x & 63, hh = lane >> 5, col = c0 + (lane & 31);
      const unsigned b0 = (unsigned)(r0 + 4 * hh) * 1024u + col, b1 = (unsigned)(r0 - m0 + 4 * hh) * 1024u + col;
      store_bf16_pairs_res(pre, b0, acc, xr, b1);
    };
    gemm_tile<MI, true>(al, (const u16*)(p.ws + WS_WOUT), DM, DM, m0, n0, epi, smem, sc_s);
  });
}

DI void phase_ln(const Params& p, const float* gam, const float* bet) {
  const u16* pre = (const u16*)(p.ws + WS_A);
  u16* xb = (u16*)(p.ws + WS_C);
  const int lane = threadIdx.x & 63;
  const int wg = blockIdx.x * 4 + (threadIdx.x >> 6), nw = gridDim.x * 4;
  for (int row0 = wg * 2; row0 < NT; row0 += nw * 2) {
    float4 v[2][4];
    float s[2], q[2];
#pragma unroll
    for (int r = 0; r < 2; ++r) {
      s[r] = 0.f;
#pragma unroll
      for (int j = 0; j < 4; ++j) { const uint2 w = ((const uint2*)(pre + (size_t)(row0 + r) * DM))[lane + 64 * j]; v[r][j] = make_float4(bflo(w.x), bfhi(w.x), bflo(w.y), bfhi(w.y)); s[r] += v[r][j].x + v[r][j].y + v[r][j].z + v[r][j].w; }
    }
#pragma unroll
    for (int o = 32; o >= 1; o >>= 1)
#pragma unroll
      for (int r = 0; r < 2; ++r) s[r] += __shfl_xor(s[r], o);
#pragma unroll
    for (int r = 0; r < 2; ++r) {
      s[r] *= (1.f / 1024.f); q[r] = 0.f;
#pragma unroll
      for (int j = 0; j < 4; ++j) { const float a = v[r][j].x - s[r], b2 = v[r][j].y - s[r], c = v[r][j].z - s[r], d = v[r][j].w - s[r]; q[r] += a * a + b2 * b2 + c * c + d * d; }
    }
#pragma unroll
    for (int o = 32; o >= 1; o >>= 1)
#pragma unroll
      for (int r = 0; r < 2; ++r) q[r] += __shfl_xor(q[r], o);
#pragma unroll
    for (int r = 0; r < 2; ++r) {
      const float mu = s[r], rs = rsqrtf(q[r] * (1.f / 1024.f) + 1e-5f);
#pragma unroll
      for (int j = 0; j < 4; ++j) {
        const float4 gg = ((const float4*)gam)[lane + 64 * j], bb = ((const float4*)bet)[lane + 64 * j];
        float4 y;
        y.x = (v[r][j].x - mu) * rs * gg.x + bb.x; y.y = (v[r][j].y - mu) * rs * gg.y + bb.y;
        y.z = (v[r][j].z - mu) * rs * gg.z + bb.z; y.w = (v[r][j].w - mu) * rs * gg.w + bb.w;
        ((uint2*)(xb + (size_t)(row0 + r) * DM))[lane + 64 * j] = make_uint2(pk2(y.x, y.y), pk2(y.z, y.w));
      }
    }
  }
}

template <bool NOEPI = false>
DI void phase_gemm_bf16(const Params& p, const u16* A, const u16* Wt, int N, u16* O, float scale, char* smem) {
  for_tiles(N, [&](int m0, int n0, auto tag) {
    constexpr int MI = decltype(tag)::value;
    GldsBf16<MI * 64> al; al.base = A + (size_t)m0 * DM; al.ld = DM;
    auto epi = [=](int r0, int c0, const f32x16& acc) {
      const int lane = threadIdx.x & 63, hh = lane >> 5, col = c0 + (lane & 31);
      const unsigned b0 = (unsigned)(r0 + 4 * hh) * (unsigned)N + col;
      if (NOEPI) { float t = 0.f;
#pragma unroll
        for (int e = 0; e < 16; ++e) t += acc[e];
        if (t == 12345.678f) O[b0] = bf1(t);
        return; }
#pragma unroll
      for (int e = 0; e < 16; ++e) O[b0 + ACC_R0(e) * (unsigned)N] = bf1(acc[e] * scale);
    };
    gemm_tile<MI>(al, Wt, DM, DM, m0, n0, epi, smem);
  });
}

template <class F>
DI void for_mem_tiles(F body) {
  const int vb = vblock(), nb = gridDim.x;
  for (int t = vb; t < 2048 + 256; t += nb) {
    if (t < 2048) { const int mt = t >> 3; body(mt * 128, (t >> 1) & 3, (t & 1) * 128, mt >> 4, IC<2>{}); }
    else { const int u = t - 2048; const int mt = u >> 4; body(NTP + mt * 64, (u >> 2) & 3, (u & 3) * 64, 16 + mt, IC<1>{}); }
  }
}
DI void phase_mem_s(const Params& p, char* smem) {
  const u16* qm = (const u16*)(p.ws + WS_D);
  u16* S = (u16*)(p.ws + WS_F);
  for_mem_tiles([&](int m0, int hd, int n0, int batch, auto tag) {
    constexpr int MI = decltype(tag)::value;
    GldsBf16<MI * 64> al; al.base = qm + (size_t)m0 * DM + hd * 256; al.ld = DM;
    const u16* Bt = (const u16*)(p.ws + WS_MEMK) + (size_t)batch * 256 * DM + hd * 256;
    auto epi = [=](int r0, int c0, const f32x16& acc) {
      const int lane = threadIdx.x & 63, hh = lane >> 5, col = c0 + (lane & 31);
      const unsigned b0 = (unsigned)(r0 + 4 * hh) * 1024u + hd * 256 + col;
      store_bf16_pairs(S, b0, 1024u, acc, 1.f);
    };
    gemm_tile<MI>(al, Bt, DM, 256, m0, n0, epi, smem);
  });
}
DI void phase_mem_softmax(const Params& p) {
  const u16* S = (const u16*)(p.ws + WS_F);
  u16* P = (u16*)(p.ws + WS_D);
  const int lane = threadIdx.x & 63;
  const int wg = blockIdx.x * 4 + (threadIdx.x >> 6), nw = gridDim.x * 4;
  for (int row0 = wg * 8; row0 < NT * 4; row0 += nw * 8) {
    float4 v[8]; float m[8], sm[8];
#pragma unroll
    for (int r = 0; r < 8; ++r) { const uint2 w = ((const uint2*)(S + (size_t)(row0 + r) * 256))[lane]; v[r] = make_float4(bflo(w.x), bfhi(w.x), bflo(w.y), bfhi(w.y)); }
#pragma unroll
    for (int r = 0; r < 8; ++r) m[r] = fmaxf(fmaxf(v[r].x, v[r].y), fmaxf(v[r].z, v[r].w));
#pragma unroll
    for (int o = 32; o >= 1; o >>= 1)
#pragma unroll
      for (int r = 0; r < 8; ++r) m[r] = fmaxf(m[r], __shfl_xor(m[r], o));
#pragma unroll
    for (int r = 0; r < 8; ++r) { v[r].x = __expf(v[r].x - m[r]); v[r].y = __expf(v[r].y - m[r]); v[r].z = __expf(v[r].z - m[r]); v[r].w = __expf(v[r].w - m[r]); sm[r] = v[r].x + v[r].y + v[r].z + v[r].w; }
#pragma unroll
    for (int o = 32; o >= 1; o >>= 1)
#pragma unroll
      for (int r = 0; r < 8; ++r) sm[r] += __shfl_xor(sm[r], o);
#pragma unroll
    for (int r = 0; r < 8; ++r) { const float inv = 1.f / sm[r]; ((uint2*)(P + (size_t)(row0 + r) * 256))[lane] = make_uint2(pk2(v[r].x * inv, v[r].y * inv), pk2(v[r].z * inv, v[r].w * inv)); }
  }
}
DI void phase_mem_pv(const Params& p, char* smem) {
  const u16* P = (const u16*)(p.ws + WS_D);
  u16* om = (u16*)(p.ws + WS_E);
  for_mem_tiles([&](int m0, int hd, int n0, int batch, auto tag) {
    constexpr int MI = decltype(tag)::value;
    GldsBf16<MI * 64> al; al.base = P + (size_t)m0 * DM + hd * 256; al.ld = DM;
    const u16* Bt = (const u16*)(p.ws + WS_MEMVT) + ((size_t)batch * DM + hd * 256) * 256;
    auto epi = [=](int r0, int c0, const f32x16& acc) {
      const int lane = threadIdx.x & 63, hh = lane >> 5, col = c0 + (lane & 31);
      const unsigned b0 = (unsigned)(r0 + 4 * hh) * 1024u + hd * 256 + col;
#pragma unroll
      for (int e = 0; e < 16; ++e) om[b0 + ACC_R0(e) * 1024u] = bf1(acc[e]);
    };
    gemm_tile<MI>(al, Bt, 256, 256, m0, n0, epi, smem);
  });
}
DI void phase_wmo(const Params& p, char* smem) {
  u16* pre = (u16*)(p.ws + WS_A);
  const u16* xbs = (const u16*)(p.ws + WS_C);
  const u16* om = (const u16*)(p.ws + WS_E);
  for_tiles(DM, [&](int m0, int n0, auto tag) {
    constexpr int MI = decltype(tag)::value;
    GldsBf16<MI * 64> al; al.base = om + (size_t)m0 * DM; al.ld = DM;
    auto epi = [=](int r0, int c0, const f32x16& acc) {
      const int lane = threadIdx.x & 63, hh = lane >> 5, col = c0 + (lane & 31);
      const unsigned b0 = (unsigned)(r0 + 4 * hh) * 1024u + col;
      store_bf16_pairs_res(pre, b0, acc, xbs, b0);
    };
    gemm_tile<MI>(al, (const u16*)(p.ws + WS_WMO), DM, DM, m0, n0, epi, smem);
  });
}

DI void insert16(float (&v)[16], float x) {
#pragma unroll
  for (int j = 15; j >= 1; --j) v[j] = __builtin_amdgcn_fmed3f(x, v[j - 1], v[j]);
  v[0] = fmaxf(v[0], x);
}
DI void phase_topk(const Params& p, char* smem) {
  const int vb = vblock(), nb = gridDim.x;
  const u16* qp = (const u16*)(p.ws + WS_F);
  int* idxo = (int*)(p.ws + WS_A);
  float* gato = (float*)(p.ws + WS_A + (size_t)NT * 128 * 4);
  float* sc = (float*)smem;
  const int tid = threadIdx.x;
  for (int t = vb; t < 264 * 8; t += nb) {
    const int mt = t >> 3, hd = t & 7;
    const int m0 = mt * 128;
    float va[16], vbv[16];
#pragma unroll
    for (int side = 0; side < 2; ++side) {
      GldsBf16<128> al; al.base = qp + (size_t)m0 * 2048 + hd * 256 + side * 128; al.ld = 2048;
      const u16* Bt = (const u16*)(p.ws + (side ? WS_KB : WS_KA)) + (size_t)hd * 128 * 128;
      auto epi = [=](int r0, int c0, const f32x16& acc) {
        const int lane = threadIdx.x & 63, hh = lane >> 5, col = c0 + (lane & 31);
#pragma unroll
        for (int e = 0; e < 16; ++e) sc[(r0 - m0 + ACC_ROW(e, hh)) * 129 + col] = acc[e];
      };
      gemm_tile<2>(al, Bt, 128, 128, m0, 0, epi, smem);
      __syncthreads();
      {
        const int row = tid & 127, half = tid >> 7;
        float* mg = (float*)(smem + 66048);
        float v[16];
#pragma unroll
        for (int j = 0; j < 16; ++j) v[j] = -INFINITY;
        for (int k = 64 * half; k < 64 * half + 64; ++k) {
          const float x = __uint_as_float((__float_as_uint(sc[row * 129 + k]) & ~0x7Fu) | (unsigned)k);
          insert16(v, x);
        }
        if (half == 1) {
#pragma unroll
          for (int j = 0; j < 16; ++j) mg[row * 17 + j] = v[j];
        }
        __syncthreads();
        if (half == 0) {
#pragma unroll
          for (int j = 0; j < 16; ++j) insert16(v, mg[row * 17 + j]);
#pragma unroll
          for (int j = 0; j < 16; ++j) { if (side == 0) va[j] = v[j]; else vbv[j] = v[j]; }
        }
      }
      __syncthreads();
    }
    unsigned char* ids = (unsigned char*)smem;
    if (tid < 128) {
#pragma unroll
      for (int j = 0; j < 16; ++j) { ids[tid * 32 + j] = (unsigned char)(__float_as_uint(va[j]) & 0x7F); ids[tid * 32 + 16 + j] = (unsigned char)(__float_as_uint(vbv[j]) & 0x7F); }
      float top[16];
#pragma unroll
      for (int j = 0; j < 16; ++j) top[j] = -INFINITY;
#pragma unroll
      for (int i = 0; i < 16; ++i)
#pragma unroll
        for (int j = 0; j < 16; ++j)
          if ((i + 1) * (j + 1) <= 16) {
            const float a = __uint_as_float(__float_as_uint(va[i]) & ~0x7Fu), b = __uint_as_float(__float_as_uint(vbv[j]) & ~0x7Fu);
            const float c = __uint_as_float((__float_as_uint(a + b) & ~0xFFu) | (unsigned)(i * 16 + j));
            insert16(top, c);
          }
      const float m = __uint_as_float(__float_as_uint(top[0]) & ~0xFFu);
      float ex[16], ssum = 0.f;
      int eid[16];
#pragma unroll
      for (int j = 0; j < 16; ++j) {
        const unsigned bits = __float_as_uint(top[j]);
        const int code = bits & 0xFF;
        ex[j] = __expf(__uint_as_float(bits & ~0xFFu) - m); ssum += ex[j];
        eid[j] = (int)ids[tid * 32 + (code >> 4)] * 128 + (int)ids[tid * 32 + 16 + (code & 15)];
      }
      const float inv = 1.f / ssum;
      const size_t ob = (size_t)(m0 + tid) * 128 + hd * 16;
#pragma unroll
      for (int j4 = 0; j4 < 4; ++j4) {
        *(int4*)(idxo + ob + 4 * j4) = make_int4(eid[4 * j4], eid[4 * j4 + 1], eid[4 * j4 + 2], eid[4 * j4 + 3]);
        *(float4*)(gato + ob + 4 * j4) = make_float4(ex[4 * j4] * inv, ex[4 * j4 + 1] * inv, ex[4 * j4 + 2] * inv, ex[4 * j4 + 3] * inv);
      }
    }
    __syncthreads();
  }
}

#if USE_FP8
typedef float f32x2v __attribute__((ext_vector_type(2)));
DI void unpack16(const uint4& v, float (&f)[16]) {
  const unsigned w[4] = {v.x, v.y, v.z, v.w};
#pragma unroll
  for (int j = 0; j < 4; ++j) {
    const f32x2v lo = __builtin_amdgcn_cvt_pk_f32_fp8((int)w[j], false), hi = __builtin_amdgcn_cvt_pk_f32_fp8((int)w[j], true);
    f[4 * j] = lo[0]; f[4 * j + 1] = lo[1]; f[4 * j + 2] = hi[0]; f[4 * j + 3] = hi[1];
  }
}
DI void peer_dot8(const char* U, int idreg, int e0, int lane, const float (&x)[16], float& dacc) {
  uint4 w[8];
#pragma unroll
  for (int j = 0; j < 8; ++j) { const int id = __builtin_amdgcn_readlane(idreg, e0 + j); w[j] = *(const uint4*)(U + (size_t)id * DM + 16 * lane); }
  float s[8];
#pragma unroll
  for (int j = 0; j < 8; ++j) {
    float f[16]; unpack16(w[j], f);
    float a = 0.f;
#pragma unroll
    for (int k = 0; k < 16; ++k) a += f[k] * x[k];
    s[j] = a;
  }
  const bool b5 = lane & 32, b4 = lane & 16, b3 = lane & 8;
  float t4[4], t2[2], t1;
#pragma unroll
  for (int i = 0; i < 4; ++i) { const float snd = b5 ? s[i] : s[4 + i], kp = b5 ? s[4 + i] : s[i]; t4[i] = kp + __shfl_xor(snd, 32); }
#pragma unroll
  for (int i = 0; i < 2; ++i) { const float snd = b4 ? t4[i] : t4[2 + i], kp = b4 ? t4[2 + i] : t4[i]; t2[i] = kp + __shfl_xor(snd, 16); }
  { const float snd = b3 ? t2[0] : t2[1], kp = b3 ? t2[1] : t2[0]; t1 = kp + __shfl_xor(snd, 8); }
  t1 += __shfl_xor(t1, 4); t1 += __shfl_xor(t1, 2); t1 += __shfl_xor(t1, 1);
  const float g = __shfl(t1, (lane & 7) * 8);
  if ((lane >> 3) == (e0 >> 3)) dacc = g;
}
DI void peer_axpy8(const char* V, int idreg, float hreg, int e0, int lane, float (&acc)[16]) {
  uint4 w[8];
#pragma unroll
  for (int j = 0; j < 8; ++j) { const int id = __builtin_amdgcn_readlane(idreg, e0 + j); w[j] = *(const uint4*)(V + (size_t)id * DM + 16 * lane); }
#pragma unroll
  for (int j = 0; j < 8; ++j) {
    const float hs = __uint_as_float(__builtin_amdgcn_readlane(__float_as_uint(hreg), e0 + j));
    float f[16]; unpack16(w[j], f);
#pragma unroll
    for (int k = 0; k < 16; ++k) acc[k] += hs * f[k];
  }
}
DI void peer_sort(int& id0, int& id1, float& g0, float& g1, int lane) {
  unsigned k0 = ((unsigned)id0 << 7) | (unsigned)lane, k1 = ((unsigned)id1 << 7) | (unsigned)(lane + 64);
#pragma unroll
  for (int k = 2; k <= 128; k <<= 1) {
#pragma unroll
    for (int j = k >> 1; j >= 1; j >>= 1) {
      if (j == 64) {
        const unsigned lo = min(k0, k1), hi = max(k0, k1); k0 = lo; k1 = hi;
      } else {
        const unsigned p0 = (unsigned)__shfl_xor((int)k0, j), p1 = (unsigned)__shfl_xor((int)k1, j);
        const bool upper = (lane & j) != 0;
        const bool asc0 = ((lane & k) == 0), asc1 = (((lane + 64) & k) == 0);
        k0 = (upper == asc0) ? max(k0, p0) : min(k0, p0);
        k1 = (upper == asc1) ? max(k1, p1) : min(k1, p1);
      }
    }
  }
  const int s0 = k0 & 127, s1 = k1 & 127;
  const float a0 = __shfl(g0, s0 & 63), b0 = __shfl(g1, s0 & 63), a1 = __shfl(g0, s1 & 63), b1 = __shfl(g1, s1 & 63);
  g0 = (s0 < 64) ? a0 : b0; g1 = (s1 < 64) ? a1 : b1;
  id0 = (int)(k0 >> 7); id1 = (int)(k1 >> 7);
}
DI void peer_load(const Params& p, int row, int lane, float (&x)[16], int& id0, int& id1, float& g0, float& g1) {
  const int* idxo = (const int*)(p.ws + WS_A);
  const float* gato = (const float*)(p.ws + WS_A + (size_t)NT * 128 * 4);
  {
    const uint4* xr = (const uint4*)((const u16*)(p.ws + WS_C) + (size_t)row * DM) + 2 * lane;
    const uint4 a = xr[0], b = xr[1];
    x[0] = bflo(a.x); x[1] = bfhi(a.x); x[2] = bflo(a.y); x[3] = bfhi(a.y); x[4] = bflo(a.z); x[5] = bfhi(a.z); x[6] = bflo(a.w); x[7] = bfhi(a.w);
    x[8] = bflo(b.x); x[9] = bfhi(b.x); x[10] = bflo(b.y); x[11] = bfhi(b.y); x[12] = bflo(b.z); x[13] = bfhi(b.z); x[14] = bflo(b.w); x[15] = bfhi(b.w);
  }
  id0 = idxo[(size_t)row * 128 + lane]; id1 = idxo[(size_t)row * 128 + 64 + lane];
  g0 = gato[(size_t)row * 128 + lane]; g1 = gato[(size_t)row * 128 + 64 + lane];
  peer_sort(id0, id1, g0, g1, lane);
}
DI void peer_finish(const Params& p, int row, int lane, float (&acc)[16]) {
  float x[16];
  {
    const uint4* xr = (const uint4*)((const u16*)(p.ws + WS_C) + (size_t)row * DM) + 2 * lane;
    const uint4 a = xr[0], b = xr[1];
    x[0] = bflo(a.x); x[1] = bfhi(a.x); x[2] = bflo(a.y); x[3] = bfhi(a.y); x[4] = bflo(a.z); x[5] = bfhi(a.z); x[6] = bflo(a.w); x[7] = bfhi(a.w);
    x[8] = bflo(b.x); x[9] = bfhi(b.x); x[10] = bflo(b.y); x[11] = bfhi(b.y); x[12] = bflo(b.z); x[13] = bfhi(b.z); x[14] = bflo(b.w); x[15] = bfhi(b.w);
  }
  float s = 0.f;
#pragma unroll
  for (int k = 0; k < 16; ++k) { acc[k] = DN_ALPHA * x[k] + acc[k]; s += acc[k]; }
  const float mu = wave_sum(s) * (1.f / 1024.f);
  float q = 0.f;
#pragma unroll
  for (int k = 0; k < 16; ++k) { const float dd = acc[k] - mu; q += dd * dd; }
  const float rs = rsqrtf(wave_sum(q) * (1.f / 1024.f) + 1e-5f);
  float* y = (row < NTP) ? p.out + OUT_YP + (size_t)row * DM : p.out + OUT_YS + (size_t)(row - NTP) * DM;
#pragma unroll
  for (int j = 0; j < 4; ++j) {
    const float4 ga = ((const float4*)p.ln3_g)[4 * lane + j], ba = ((const float4*)p.ln3_b)[4 * lane + j];
    float4 ya;
    ya.x = (acc[4 * j + 0] - mu) * rs * ga.x + ba.x; ya.y = (acc[4 * j + 1] - mu) * rs * ga.y + ba.y;
    ya.z = (acc[4 * j + 2] - mu) * rs * ga.z + ba.z; ya.w = (acc[4 * j + 3] - mu) * rs * ga.w + ba.w;
    ((float4*)y)[4 * lane + j] = ya;
  }
}
DI float peer_gelu_gate(float d, float g) { return 0.5f * d * (1.f + erff(d * 0.7071067811865476f)) * g; }
DI void phase_peer(const Params& p, int rr0 = 0, int rr1 = 1 << 10) {
  const char* U = p.ws + WS_U;
  const char* V = p.ws + WS_V;
  const float* usc = (const float*)(p.ws + WS_USC);
  const float* vsc = (const float*)(p.ws + WS_VSC);
  const int lane = threadIdx.x & 63;
  const int wg = blockIdx.x * 4 + (threadIdx.x >> 6), nw = gridDim.x * 4;
  for (int rowA = wg + rr0 * 2 * nw; rowA < NT && rowA < wg + rr1 * 2 * nw; rowA += 2 * nw) {
    const bool hasB = rowA + nw < NT;
    const int rowB = hasB ? rowA + nw : rowA;
    asm volatile("" ::: "memory");
    float xA[16], xB[16];
    int a0, a1, b0, b1; float ga0, ga1, gb0, gb1;
    peer_load(p, rowA, lane, xA, a0, a1, ga0, ga1);
    peer_load(p, rowB, lane, xB, b0, b1, gb0, gb1);
    const float sua0 = usc[a0], sua1 = usc[a1], sva0 = vsc[a0], sva1 = vsc[a1];
    const float sub0 = usc[b0], sub1 = usc[b1], svb0 = vsc[b0], svb1 = vsc[b1];
    float da0 = 0.f, da1 = 0.f, db0 = 0.f, db1 = 0.f;
#pragma unroll 1
    for (int e0 = 0; e0 < 64; e0 += 8) { peer_dot8(U, a0, e0, lane, xA, da0); if (hasB) peer_dot8(U, b0, e0, lane, xB, db0); }
#pragma unroll 1
    for (int e0 = 0; e0 < 64; e0 += 8) { peer_dot8(U, a1, e0, lane, xA, da1); if (hasB) peer_dot8(U, b1, e0, lane, xB, db1); }
    const float ha0 = peer_gelu_gate(da0 * sua0, ga0) * sva0, ha1 = peer_gelu_gate(da1 * sua1, ga1) * sva1;
    const float hb0 = peer_gelu_gate(db0 * sub0, gb0) * svb0, hb1 = peer_gelu_gate(db1 * sub1, gb1) * svb1;
    float accA[16], accB[16];
#pragma unroll
    for (int k = 0; k < 16; ++k) { accA[k] = 0.f; accB[k] = 0.f; }
#pragma unroll 1
    for (int e0 = 0; e0 < 64; e0 += 8) { peer_axpy8(V, a0, ha0, e0, lane, accA); if (hasB) peer_axpy8(V, b0, hb0, e0, lane, accB); }
#pragma unroll 1
    for (int e0 = 0; e0 < 64; e0 += 8) { peer_axpy8(V, a1, ha1, e0, lane, accA); if (hasB) peer_axpy8(V, b1, hb1, e0, lane, accB); }
    peer_finish(p, rowA, lane, accA);
    if (hasB) peer_finish(p, rowB, lane, accB);
  }
}
#else
DI void unpack8(const uint4& v, float (&f)[8]) {
  f[0] = bflo(v.x); f[1] = bfhi(v.x); f[2] = bflo(v.y); f[3] = bfhi(v.y); f[4] = bflo(v.z); f[5] = bfhi(v.z); f[6] = bflo(v.w); f[7] = bfhi(v.w);
}
DI void phase_peer(const Params& p) {
  const float* xf = (const float*)(p.ws + WS_B);
  const int* idxo = (const int*)(p.ws + WS_A);
  const float* gato = (const float*)(p.ws + WS_A + (size_t)NT * 128 * 4);
  const u16* U = (const u16*)(p.ws + WS_U);
  const u16* V = (const u16*)(p.ws + WS_V);
  const int lane = threadIdx.x & 63;
  const int wg = blockIdx.x * 4 + (threadIdx.x >> 6), nw = gridDim.x * 4;
  for (int row = wg; row < NT; row += nw) {
    float x[16];
    {
      const float4* xr = (const float4*)(xf + (size_t)row * DM);
      const float4 a = xr[2 * lane], b = xr[2 * lane + 1], c = xr[128 + 2 * lane], d = xr[128 + 2 * lane + 1];
      x[0] = a.x; x[1] = a.y; x[2] = a.z; x[3] = a.w; x[4] = b.x; x[5] = b.y; x[6] = b.z; x[7] = b.w;
      x[8] = c.x; x[9] = c.y; x[10] = c.z; x[11] = c.w; x[12] = d.x; x[13] = d.y; x[14] = d.z; x[15] = d.w;
    }
    const int id0 = idxo[(size_t)row * 128 + lane], id1 = idxo[(size_t)row * 128 + 64 + lane];
    const float g0 = gato[(size_t)row * 128 + lane], g1 = gato[(size_t)row * 128 + 64 + lane];
    float d0 = 0.f, d1 = 0.f;
#pragma unroll 8
    for (int e = 0; e < 64; ++e) {
      const int id = __builtin_amdgcn_readlane(id0, e);
      const uint4* ur = (const uint4*)(U + (size_t)id * DM);
      const uint4 ua = ur[lane], ub = ur[64 + lane];
      float f[8], s = 0.f;
      unpack8(ua, f);
#pragma unroll
      for (int k = 0; k < 8; ++k) s += f[k] * x[k];
      unpack8(ub, f);
#pragma unroll
      for (int k = 0; k < 8; ++k) s += f[k] * x[8 + k];
      s = wave_sum(s);
      if (lane == e) d0 = s;
    }
#pragma unroll 8
    for (int e = 0; e < 64; ++e) {
      const int id = __builtin_amdgcn_readlane(id1, e);
      const uint4* ur = (const uint4*)(U + (size_t)id * DM);
      const uint4 ua = ur[lane], ub = ur[64 + lane];
      float f[8], s = 0.f;
      unpack8(ua, f);
#pragma unroll
      for (int k = 0; k < 8; ++k) s += f[k] * x[k];
      unpack8(ub, f);
#pragma unroll
      for (int k = 0; k < 8; ++k) s += f[k] * x[8 + k];
      s = wave_sum(s);
      if (lane == e) d1 = s;
    }
    const float h0 = 0.5f * d0 * (1.f + erff(d0 * 0.7071067811865476f)) * g0;
    const float h1 = 0.5f * d1 * (1.f + erff(d1 * 0.7071067811865476f)) * g1;
    float acc[16];
#pragma unroll
    for (int k = 0; k < 16; ++k) acc[k] = 0.f;
#pragma unroll 8
    for (int e = 0; e < 64; ++e) {
      const int id = __builtin_amdgcn_readlane(id0, e);
      const float hs = __uint_as_float(__builtin_amdgcn_readlane(__float_as_uint(h0), e));
      const uint4* vr = (const uint4*)(V + (size_t)id * DM);
      const uint4 va = vr[lane], vb2 = vr[64 + lane];
      float f[8];
      unpack8(va, f);
#pragma unroll
      for (int k = 0; k < 8; ++k) acc[k] += hs * f[k];
      unpack8(vb2, f);
#pragma unroll
      for (int k = 0; k < 8; ++k) acc[8 + k] += hs * f[k];
    }
#pragma unroll 8
    for (int e = 0; e < 64; ++e) {
      const int id = __builtin_amdgcn_readlane(id1, e);
      const float hs = __uint_as_float(__builtin_amdgcn_readlane(__float_as_uint(h1), e));
      const uint4* vr = (const uint4*)(V + (size_t)id * DM);
      const uint4 va = vr[lane], vb2 = vr[64 + lane];
      float f[8];
      unpack8(va, f);
#pragma unroll
      for (int k = 0; k < 8; ++k) acc[k] += hs * f[k];
      unpack8(vb2, f);
#pragma unroll
      for (int k = 0; k < 8; ++k) acc[8 + k] += hs * f[k];
    }
    float s = 0.f;
#pragma unroll
    for (int k = 0; k < 16; ++k) { acc[k] = DN_ALPHA * x[k] + acc[k]; s += acc[k]; }
    const float mu = wave_sum(s) * (1.f / 1024.f);
    float q = 0.f;
#pragma unroll
    for (int k = 0; k < 16; ++k) { const float dd = acc[k] - mu; q += dd * dd; }
    const float rs = rsqrtf(wave_sum(q) * (1.f / 1024.f) + 1e-5f);
    float* y = (row < NTP) ? p.out + OUT_YP + (size_t)row * DM : p.out + OUT_YS + (size_t)(row - NTP) * DM;
#pragma unroll
    for (int c = 0; c < 2; ++c) {
      const int off = c * 512 + lane * 8;
      const float4 ga = *(const float4*)(p.ln3_g + off), gb = *(const float4*)(p.ln3_g + off + 4);
      const float4 ba = *(const float4*)(p.ln3_b + off), bb = *(const float4*)(p.ln3_b + off + 4);
      float4 ya, yb;
      ya.x = (acc[8 * c + 0] - mu) * rs * ga.x + ba.x; ya.y = (acc[8 * c + 1] - mu) * rs * ga.y + ba.y;
      ya.z = (acc[8 * c + 2] - mu) * rs * ga.z + ba.z; ya.w = (acc[8 * c + 3] - mu) * rs * ga.w + ba.w;
      yb.x = (acc[8 * c + 4] - mu) * rs * gb.x + bb.x; yb.y = (acc[8 * c + 5] - mu) * rs * gb.y + bb.y;
      yb.z = (acc[8 * c + 6] - mu) * rs * gb.z + bb.z; yb.w = (acc[8 * c + 7] - mu) * rs * gb.w + bb.w;
      *(float4*)(y + off) = ya; *(float4*)(y + off + 4) = yb;
    }
  }
}

#endif

constexpr int NPHASE = 15;
template <int PH>
DI void run_phase(const Params& p, char* smem) {
  if (PH == 0) phase_prep(p, smem);
  else if (PH == 1) phase_proj(p, smem);
  else if (PH == 2) phase_scan(p, smem);
  else if (PH == 3) phase_attn(p, smem);
  else if (PH == 4) phase_wout(p, smem);
  else if (PH == 5) phase_ln(p, p.ln1_g, p.ln1_b);
  else if (PH == 6) phase_gemm_bf16(p, (const u16*)(p.ws + WS_C), (const u16*)(p.ws + WS_WMQ), 1024, (u16*)(p.ws + WS_D), 0.0625f, smem);
  else if (PH == 7) phase_mem_s(p, smem);
  else if (PH == 8) phase_mem_softmax(p);
  else if (PH == 9) phase_mem_pv(p, smem);
  else if (PH == 10) phase_wmo(p, smem);
  else if (PH == 11) phase_ln(p, p.ln2_g, p.ln2_b);
  else if (PH == 12) phase_gemm_bf16(p, (const u16*)(p.ws + WS_C), (const u16*)(p.ws + WS_WPQ), 2048, (u16*)(p.ws + WS_F), 1.f, smem);
  else if (PH == 13) phase_topk(p, smem);
  else if (PH == 14) phase_peer(p);
}

template <int PH>
__global__ void __launch_bounds__(256, 2) k_phase(Params p) {
  __shared__ __attribute__((aligned(16))) char smem[SMEM_BYTES];
  run_phase<PH>(p, smem);
}

#define XB_TMO      128
#define XB_XCNT(j)  (256  + 64 * (j))
#define XB_XSUB(j)  (1280 + 64 * (j))
#define XB_XGEN(j)  (2304 + 64 * (j))
#define XB_TOP      3328
#define XB_TOPGEN   3392
#define XB_SPIN_CAP (1u << 20)
DI unsigned xb_ld(unsigned* p) { return __hip_atomic_load(p, __ATOMIC_RELAXED, __HIP_MEMORY_SCOPE_AGENT); }
DI unsigned xb_add(unsigned* p, unsigned v) { return __hip_atomic_fetch_add(p, v, __ATOMIC_RELAXED, __HIP_MEMORY_SCOPE_AGENT); }
DI unsigned xb_xcc_id() { return (unsigned)__builtin_amdgcn_s_getreg((3 << 11) | 20) & 0xFu; }
#define XB_SPIN(cond, bar) do { unsigned _sp = 0; while (cond) { __builtin_amdgcn_s_sleep(1); \
    if ((++_sp & 255u) == 0u) { if (xb_ld(&(bar)[XB_TMO])) break; if (_sp > XB_SPIN_CAP) { atomicAdd(&(bar)[XB_TMO], 1u); break; } } } } while (0)
struct XcdBarrier { unsigned* bar; unsigned x; volatile unsigned* st; };
DI XcdBarrier xcd_barrier_post(unsigned* bar, volatile unsigned* st) {
  XcdBarrier b; b.bar = bar; b.x = xb_xcc_id(); b.st = st;
  if (threadIdx.x == 0) (void)xb_add(&bar[XB_XCNT(b.x)], 1u);
  return b;
}
DI void xcd_barrier_complete(unsigned* bar, unsigned x, unsigned& nloc, unsigned& nx) {
  const unsigned G = gridDim.x;
  unsigned sum, cnt, mine, sp = 0u;
  for (;;) {
    sum = 0u; cnt = 0u; mine = 0u;
#pragma unroll
    for (unsigned j = 0; j < 16; ++j) { const unsigned c = xb_ld(&bar[XB_XCNT(j)]); sum += c; cnt += (c > 0u) ? 1u : 0u; mine = (j == x) ? c : mine; }
    if (sum == G) break;
    __builtin_amdgcn_s_sleep(1);
    if ((++sp & 255u) == 0u) { if (xb_ld(&bar[XB_TMO])) break; if (sp > XB_SPIN_CAP) { atomicAdd(&bar[XB_TMO], 1u); break; } }
  }
  nloc = mine > 0u ? mine : 1u; nx = cnt > 0u ? cnt : 1u;
}
DI void xcd_barrier(const XcdBarrier& b) {
  asm volatile("s_waitcnt vmcnt(0)" ::: "memory");
  __syncthreads();
  if (threadIdx.x == 0) {
    unsigned* bar = b.bar;
    __builtin_amdgcn_s_waitcnt(0);
    unsigned nloc = b.st[0], nx = b.st[1];
    if (nloc == 0u) { xcd_barrier_complete(bar, b.x, nloc, nx); b.st[0] = nloc; b.st[1] = nx; }
    const unsigned old = xb_add(&bar[XB_XSUB(b.x)], 1u);
    const unsigned gen = old / nloc;
    if (old + 1u == (gen + 1u) * nloc) {
      __builtin_amdgcn_fence(__ATOMIC_RELEASE, "agent");
      asm volatile("s_waitcnt vmcnt(0)" ::: "memory");
      const unsigned og = xb_add(&bar[XB_TOP], 1u);
      const unsigned tg = og / nx;
      if (og + 1u == (tg + 1u) * nx) xb_add(&bar[XB_TOPGEN], 1u);
      else XB_SPIN(xb_ld(&bar[XB_TOPGEN]) == tg, bar);
      __builtin_amdgcn_fence(__ATOMIC_ACQUIRE, "agent");
      xb_add(&bar[XB_XGEN(b.x)], 1u);
      asm volatile("s_waitcnt vmcnt(0)" ::: "memory");
    } else {
      XB_SPIN(xb_ld(&bar[XB_XGEN(b.x)]) == gen, bar);
      __builtin_amdgcn_fence(__ATOMIC_ACQUIRE, "agent");
      asm volatile("s_waitcnt vmcnt(0)" ::: "memory");
    }
  }
  __syncthreads();
}
#if ONE_LAUNCH
DI void grid_barrier(unsigned* bar, unsigned& target) {
  target += gridDim.x;
  asm volatile("s_waitcnt vmcnt(0)" ::: "memory");
  __syncthreads();
  if (threadIdx.x == 0) {
    __builtin_amdgcn_fence(__ATOMIC_RELEASE, "agent");
    asm volatile("s_waitcnt vmcnt(0)" ::: "memory");
    __hip_atomic_fetch_add(bar, 1u, __ATOMIC_RELAXED, __HIP_MEMORY_SCOPE_AGENT);
    while (__hip_atomic_load(bar, __ATOMIC_RELAXED, __HIP_MEMORY_SCOPE_AGENT) < target) __builtin_amdgcn_s_sleep(2);
    __builtin_amdgcn_fence(__ATOMIC_ACQUIRE, "agent");
    asm volatile("s_waitcnt vmcnt(0)" ::: "memory");
  }
  __syncthreads();
}
__global__ void __launch_bounds__(256, 2) k_mega(Params p) {
  __shared__ __attribute__((aligned(16))) char smem[SMEM_BYTES];
  cg::grid_group grid = cg::this_grid();
#define RUN(n) do { run_phase<n>(p, smem); if (REPEAT_PHASE == n || (REPEAT_PHASE >= 1000 && (((REPEAT_PHASE - 1000) >> n) & 1))) { GSYNC(); run_phase<n>(p, smem); GSYNC(); run_phase<n>(p, smem); } if (REPEAT_PHASE == 203 && n == 3) { GSYNC(); phase_attn(p, smem, 1); GSYNC(); phase_attn(p, smem, 2); } if (REPEAT_PHASE == 100 + n) { GSYNC(); phase_gemm_bf16<true>(p, (const u16*)(p.ws + WS_C), (const u16*)(p.ws + WS_WPQ), 2048, (u16*)(p.ws + WS_F), 1.f, smem); GSYNC(); phase_gemm_bf16<true>(p, (const u16*)(p.ws + WS_C), (const u16*)(p.ws + WS_WPQ), 2048, (u16*)(p.ws + WS_F), 1.f, smem); } } while (0)
#if CUSTOM_BAR
  volatile unsigned* xst = (volatile unsigned*)(smem + 73728 + 1024);
  if (threadIdx.x == 0) { xst[0] = 0u; xst[1] = 0u; }
  __syncthreads();
  const XcdBarrier xb = xcd_barrier_post((unsigned*)(p.ws + WS_XBAR), xst);
#define GSYNC() xcd_barrier(xb)
#else
#define GSYNC() grid.sync()
#endif
  RUN(0); grid.sync();
  RUN(1); GSYNC();
  RUN(2); GSYNC();
  RUN(3); GSYNC();
  RUN(4); GSYNC();
  RUN(5); GSYNC();
  if (REPEAT_PHASE == 300) { GSYNC(); GSYNC(); GSYNC(); GSYNC(); GSYNC(); GSYNC(); GSYNC(); GSYNC(); }
  RUN(6); GSYNC();
  RUN(7); GSYNC();
  RUN(8); GSYNC();
  RUN(9); GSYNC();
  RUN(10); GSYNC();
  RUN(11); GSYNC();
  RUN(12); GSYNC();
  RUN(13); GSYNC();
#if PEER_RESYNC
  {
    const int nrounds = (NT + 8 * (int)gridDim.x - 1) / (8 * (int)gridDim.x);
    for (int rr = 0; rr < nrounds; rr += PEER_RESYNC) { if (rr) GSYNC(); phase_peer(p, rr, rr + PEER_RESYNC); }
  }
#else
  RUN(14);
#endif
}
#endif

extern "C" void kernel_launch(void* const* d_in, const int* in_sizes, int n_in, void* d_out, int out_size, void* d_ws, size_t ws_size,
                              hipStream_t stream) {
  (void)in_sizes; (void)n_in; (void)out_size;
  if (ws_size < WS_TOTAL) { fprintf(stderr, "workspace too small: %zu < %zu\n", ws_size, (size_t)WS_TOTAL); return; }
  Params p{};
  const float** pp = (const float**)&p;
  for (int i = 0; i < 29; ++i) pp[i] = (const float*)d_in[i];
  p.out = (float*)d_out;
  p.ws = (char*)d_ws;
#if ONE_LAUNCH
  static int grid_blocks = 0;
  if (!grid_blocks) {
    int dev = 0, cus = 0, per_cu = 0;
    hipGetDevice(&dev);
    hipDeviceGetAttribute(&cus, hipDeviceAttributeMultiprocessorCount, dev);
    hipOccupancyMaxActiveBlocksPerMultiprocessor(&per_cu, k_mega, 256, 0);
    if (per_cu > 2) per_cu = 2;
    grid_blocks = cus * per_cu;
  }
  hipMemsetAsync((char*)d_ws + WS_BAR, 0, 2048, stream);
  hipMemsetAsync((char*)d_ws + WS_XBAR, 0, 16384, stream);
  void* args[] = {&p};
  hipError_t e = hipLaunchCooperativeKernel((void*)k_mega, dim3(grid_blocks), dim3(256), args, 0, stream);
  if (e != hipSuccess) fprintf(stderr, "cooperative launch failed: %s (grid %d)\n", hipGetErrorString(e), grid_blocks);
#else
  const int G = 512;
  hipMemsetAsync((char*)d_ws + WS_BAR, 0, 2048, stream);
  k_phase<0><<<G, 256, 0, stream>>>(p);
  k_phase<1><<<G, 256, 0, stream>>>(p);
  k_phase<2><<<G, 256, 0, stream>>>(p);
  k_phase<3><<<G, 256, 0, stream>>>(p);
  k_phase<4><<<G, 256, 0, stream>>>(p);
  k_phase<5><<<G, 256, 0, stream>>>(p);
  k_phase<6><<<G, 256, 0, stream>>>(p);
  k_phase<7><<<G, 256, 0, stream>>>(p);
  k_phase<8><<<G, 256, 0, stream>>>(p);
  k_phase<9><<<G, 256, 0, stream>>>(p);
  k_phase<10><<<G, 256, 0, stream>>>(p);
  k_phase<11><<<G, 256, 0, stream>>>(p);
  k_phase<12><<<G, 256, 0, stream>>>(p);
  k_phase<13><<<G, 256, 0, stream>>>(p);
  k_phase<14><<<G, 256, 0, stream>>>(p);
#endif
}
```

```cpp
#include <hip/hip_runtime.h>
#include <hip/hip_cooperative_groups.h>
#include <cstdio>
#include <cstdint>
namespace cg = cooperative_groups;

#ifndef ONE_LAUNCH
#define ONE_LAUNCH 1
#endif

#ifndef USE_FP8
#define USE_FP8 1
#endif
#ifndef SB_EXIT
#define SB_EXIT 1
#endif
#ifndef REPEAT_PHASE
#define REPEAT_PHASE -1
#endif
#ifndef PEER_RESYNC
#define PEER_RESYNC 0
#endif
#ifndef CUSTOM_BAR
#define CUSTOM_BAR 1
#endif
#define DI __device__ __forceinline__
typedef unsigned short u16;
typedef short bf16x8 __attribute__((ext_vector_type(8)));
typedef short s16x4 __attribute__((ext_vector_type(4)));
typedef float f32x16 __attribute__((ext_vector_type(16)));
typedef __bf16 bf2_t __attribute__((ext_vector_type(2)));
typedef float f2_t __attribute__((ext_vector_type(2)));
#define MFMA(a, b, c) __builtin_amdgcn_mfma_f32_32x32x16_bf16((a), (b), (c), 0, 0, 0)

constexpr int DM = 1024;
constexpr int NTP = 32768;
constexpr int NTS = 1024;
constexpr int NT = NTP + NTS;
constexpr int SEQ = 2048, DSEQ = 64, PAST = 4096, NMEM = 256;
constexpr int INC = 3080, INCP = 3200;
constexpr float DN_ALPHA = 1.189207115002721f;
constexpr float LOG2E = 1.4426950408889634f;

constexpr size_t OUT_YP = 0;
constexpr size_t OUT_YS = OUT_YP + (size_t)NTP * DM;
constexpr size_t OUT_SBK_P = OUT_YS + (size_t)NTS * DM;
constexpr size_t OUT_SBV_P = OUT_SBK_P + (size_t)NTP * 512;
constexpr size_t OUT_FXK_P = OUT_SBV_P + (size_t)NTP * 512;
constexpr size_t OUT_FXV_P = OUT_FXK_P + (size_t)NTP * 512;
constexpr size_t OUT_LF_P = OUT_FXV_P + (size_t)NTP * 512;
constexpr size_t OUT_MK_P = OUT_LF_P + (size_t)NTP * 8;
constexpr size_t OUT_MV_P = OUT_MK_P + (size_t)4096 * DM;
constexpr size_t OUT_SBK_S = OUT_MV_P + (size_t)4096 * DM;
constexpr size_t OUT_SBV_S = OUT_SBK_S + (size_t)NTS * 512;
constexpr size_t OUT_FXK_S = OUT_SBV_S + (size_t)NTS * 512;
constexpr size_t OUT_FXV_S = OUT_FXK_S + (size_t)NTS * 512;
constexpr size_t OUT_LF_S = OUT_FXV_S + (size_t)NTS * 512;
constexpr size_t OUT_TOTAL = OUT_LF_S + (size_t)NTS * 8;

constexpr size_t WS_WIN = 0;
constexpr size_t WS_WOUT = WS_WIN + (size_t)INCP * DM * 2;
constexpr size_t WS_WMQ = WS_WOUT + (size_t)DM * DM * 2;
constexpr size_t WS_WMKV = WS_WMQ + (size_t)DM * DM * 2;
constexpr size_t WS_WMO = WS_WMKV + (size_t)2048 * DM * 2;
constexpr size_t WS_WPQ = WS_WMO + (size_t)DM * DM * 2;
constexpr size_t WS_KA = WS_WPQ + (size_t)2048 * DM * 2;
constexpr size_t WS_KB = WS_KA + (size_t)8 * 128 * 128 * 2;
constexpr size_t WS_U = WS_KB + (size_t)8 * 128 * 128 * 2;
constexpr size_t WS_V = WS_U + (size_t)16384 * DM * 2;
constexpr size_t WS_MEMK = WS_V + (size_t)16384 * DM * 2;
constexpr size_t WS_MEMVT = WS_MEMK + (size_t)32 * 256 * DM * 2;
constexpr size_t WS_A = WS_MEMVT + (size_t)32 * 256 * DM * 2;
constexpr size_t WS_B = WS_A + (size_t)NT * DM * 4;
constexpr size_t WS_C = WS_B + (size_t)NT * DM * 4;
constexpr size_t WS_D = WS_C + (size_t)NT * DM * 2;
constexpr size_t WS_E = WS_D + (size_t)NT * DM * 2;
constexpr size_t WS_F = WS_E + (size_t)NT * DM * 2;
constexpr size_t WS_BAR = WS_F + (size_t)NT * DM * 4;
constexpr size_t WS_USC = WS_BAR + 2048;
constexpr size_t WS_VSC = WS_USC + (size_t)16384 * 4;
constexpr size_t WS_CBP = WS_VSC + (size_t)16384 * 4;
constexpr size_t WS_CBS = WS_CBP + (size_t)128 * 2048 * 4;
constexpr size_t WS_SSQ = WS_CBS + (size_t)128 * 4160 * 4;
constexpr size_t WS_XBAR = WS_SSQ + (size_t)NT * 2 * 4;
constexpr size_t WS_TOTAL = WS_XBAR + 16384;

struct Params {
  const float *x_prompt, *x_sample, *mem_prompt, *c_sb_k, *c_sb_v, *c_fx_k, *c_fx_v, *c_fx_logf, *c_mem_k, *c_mem_v;
  const float *w_in, *b_f, *w_gn, *w_out, *ln1_g, *ln1_b, *w_mq, *w_mk, *w_mv, *w_mo, *ln2_g, *ln2_b;
  const float *w_pq, *keys_a, *keys_b, *peer_u, *peer_v, *ln3_g, *ln3_b;
  float* out;
  char* ws;
};

DI const Params* kparams() { auto ka = __builtin_amdgcn_kernarg_segment_ptr(); asm volatile("" : "+s"(ka)); return (const Params*)ka; }
constexpr int SMEM_BYTES = 73728 + 1024 + 64;

typedef float nf4 __attribute__((ext_vector_type(4)));
DI nf4 ld_nt(const float* p) { return __builtin_nontemporal_load((const nf4*)p); }
DI unsigned pk2(float a, float b) { f2_t v = {a, b}; bf2_t r = __builtin_convertvector(v, bf2_t); return __builtin_bit_cast(unsigned, r); }
DI u16 bf1(float a) { return (u16)(pk2(a, 0.f) & 0xffffu); }
DI float bflo(unsigned w) { return __uint_as_float(w << 16); }
DI float bfhi(unsigned w) { return __uint_as_float(w & 0xffff0000u); }
DI float wave_sum(float v) {
#pragma unroll
  for (int o = 32; o >= 1; o >>= 1) v += __shfl_xor(v, o);
  return v;
}
DI float wave_max(float v) {
#pragma unroll
  for (int o = 32; o >= 1; o >>= 1) v = fmaxf(v, __shfl_xor(v, o));
  return v;
}
DI int vblock() { int nb = gridDim.x, b = blockIdx.x; return ((nb & 7) == 0) ? (b & 7) * (nb >> 3) + (b >> 3) : b; }
DI const float* xrow(const Params& p, int g) { return g < NTP ? p.x_prompt + (size_t)g * DM : p.x_sample + (size_t)(g - NTP) * DM; }

DI void tconv_tile(const float* src, int ldsrc, int C, u16* dst, int lddst, const float* rowscale, int tr, int tc, float* tile) {
  const int tid = threadIdx.x;
  {
    const int r = tid >> 2, c0 = (tid & 3) * 16;
    const int gr = tr * 64 + r;
    const float sc = rowscale ? rowscale[gr] : 1.f;
#pragma unroll
    for (int j = 0; j < 4; ++j) {
      const int gc = tc * 64 + c0 + 4 * j;
      float4 v = make_float4(0.f, 0.f, 0.f, 0.f);
      if (gc < C) v = *(const float4*)(src + (size_t)gr * ldsrc + gc);
      float* t = tile + r * 65 + c0 + 4 * j;
      t[0] = v.x * sc; t[1] = v.y * sc; t[2] = v.z * sc; t[3] = v.w * sc;
    }
  }
  __syncthreads();
  {
    const int n = tid >> 2, k0 = (tid & 3) * 16;
    unsigned w[8];
#pragma unroll
    for (int e = 0; e < 8; ++e) w[e] = pk2(tile[(k0 + 2 * e) * 65 + n], tile[(k0 + 2 * e + 1) * 65 + n]);
    uint4* d = (uint4*)(dst + (size_t)(tc * 64 + n) * lddst + tr * 64 + k0);
    d[0] = make_uint4(w[0], w[1], w[2], w[3]);
    d[1] = make_uint4(w[4], w[5], w[6], w[7]);
  }
  __syncthreads();
}

DI void conv_range(const float* src, u16* dst, size_t n8, int bid, int nb) {
  const size_t step = (size_t)nb * 256;
  size_t i = (size_t)bid * 256 + threadIdx.x;
  for (; i + 3 * step < n8; i += 4 * step) {
    float4 a[4], b[4];
#pragma unroll
    for (int u = 0; u < 4; ++u) { a[u] = ((const float4*)src)[2 * (i + u * step)]; b[u] = ((const float4*)src)[2 * (i + u * step) + 1]; }
#pragma unroll
    for (int u = 0; u < 4; ++u) ((uint4*)dst)[i + u * step] = make_uint4(pk2(a[u].x, a[u].y), pk2(a[u].z, a[u].w), pk2(b[u].x, b[u].y), pk2(b[u].z, b[u].w));
  }
  for (; i < n8; i += step) {
    const float4 a = ((const float4*)src)[2 * i], b = ((const float4*)src)[2 * i + 1];
    ((uint4*)dst)[i] = make_uint4(pk2(a.x, a.y), pk2(a.z, a.w), pk2(b.x, b.y), pk2(b.z, b.w));
  }
}

DI void phase_prep(const Params& p, char* smem) {
  float* tile = (float*)smem;
  const int bid = blockIdx.x, nb = gridDim.x;
  u16* ws16 = (u16*)p.ws;
  constexpr int T_WIN = 16 * 50, T_SQ = 256, T_PQ = 16 * 32, T_MV = 16 * 4 * 16;
  constexpr int T0 = T_WIN, T1 = T0 + T_SQ, T2 = T1 + T_SQ, T3 = T2 + T_SQ, T4 = T3 + T_SQ, T5 = T4 + T_SQ, T6 = T5 + T_PQ, T7 = T6 + T_MV;
  for (int t = bid; t < T7; t += nb) {
    if (t < T0) { tconv_tile(p.w_in, INC, INC, (u16*)(p.ws + WS_WIN), DM, nullptr, t / 50, t % 50, tile); }
    else if (t < T1) { int u = t - T0; tconv_tile(p.w_out, DM, DM, (u16*)(p.ws + WS_WOUT), DM, p.w_gn, u >> 4, u & 15, tile); }
    else if (t < T2) { int u = t - T1; tconv_tile(p.w_mq, DM, DM, (u16*)(p.ws + WS_WMQ), DM, nullptr, u >> 4, u & 15, tile); }
    else if (t < T3) { int u = t - T2; tconv_tile(p.w_mk, DM, DM, (u16*)(p.ws + WS_WMKV), DM, nullptr, u >> 4, u & 15, tile); }
    else if (t < T4) { int u = t - T3; tconv_tile(p.w_mv, DM, DM, (u16*)(p.ws + WS_WMKV) + (size_t)DM * DM, DM, nullptr, u >> 4, u & 15, tile); }
    else if (t < T5) { int u = t - T4; tconv_tile(p.w_mo, DM, DM, (u16*)(p.ws + WS_WMO), DM, nullptr, u >> 4, u & 15, tile); }
    else if (t < T6) { int u = t - T5; tconv_tile(p.w_pq, 2048, 2048, (u16*)(p.ws + WS_WPQ), DM, nullptr, u >> 5, u & 31, tile); }
    else { int u = t - T6; int b = u >> 6, r = u & 63;
      tconv_tile(p.c_mem_v + (size_t)b * 256 * DM, DM, DM, (u16*)(p.ws + WS_MEMVT) + (size_t)(16 + b) * DM * 256, 256, nullptr, r >> 4, r & 15, tile); }
  }
  (void)ws16;
  for (int i = bid * 256 + threadIdx.x; i < NT * 2; i += nb * 256) ((float*)(p.ws + WS_SSQ))[i] = 0.f;
  conv_range(p.x_prompt, (u16*)(p.ws + WS_C), (size_t)NTP * DM / 8, bid, nb);
  conv_range(p.x_sample, (u16*)(p.ws + WS_C) + (size_t)NTP * DM, (size_t)NTS * DM / 8, bid, nb);
  conv_range(p.mem_prompt, (u16*)(p.ws + WS_E), (size_t)4096 * DM / 8, bid, nb);
  conv_range(p.c_mem_k, (u16*)(p.ws + WS_MEMK) + (size_t)16 * 256 * DM, (size_t)16 * 256 * DM / 8, bid, nb);
  conv_range(p.keys_a, (u16*)(p.ws + WS_KA), (size_t)8 * 128 * 128 / 8, bid, nb);
  conv_range(p.keys_b, (u16*)(p.ws + WS_KB), (size_t)8 * 128 * 128 / 8, bid, nb);
#if USE_FP8
  {
    const int lane = threadIdx.x & 63;
    const int wg = bid * 4 + (threadIdx.x >> 6), nw = nb * 4;
    for (int row0 = wg; row0 < 32768; row0 += 2 * nw) {
      float4 a[2][4];
      float am[2];
#pragma unroll
      for (int u = 0; u < 2; ++u) {
        const int row = row0 + u * nw;
        const bool isv = row >= 16384;
        const int r = isv ? row - 16384 : row;
        const float4* src = (const float4*)((isv ? p.peer_v : p.peer_u) + (size_t)r * DM) + 4 * lane;
        am[u] = 0.f;
#pragma unroll
        for (int j = 0; j < 4; ++j) { a[u][j] = src[j]; am[u] = fmaxf(am[u], fmaxf(fmaxf(fabsf(a[u][j].x), fabsf(a[u][j].y)), fmaxf(fabsf(a[u][j].z), fabsf(a[u][j].w)))); }
      }
#pragma unroll
      for (int o = 32; o >= 1; o >>= 1)
#pragma unroll
        for (int u = 0; u < 2; ++u) am[u] = fmaxf(am[u], __shfl_xor(am[u], o));
#pragma unroll
      for (int u = 0; u < 2; ++u) {
        const int row = row0 + u * nw;
        const bool isv = row >= 16384;
        const int r = isv ? row - 16384 : row;
        int ex = 0;
        if (am[u] > 0.f) (void)frexpf(am[u], &ex);
        const float sc = ldexpf(1.f, 8 - ex), isc = ldexpf(1.f, ex - 8);
        unsigned w[4];
#pragma unroll
        for (int j = 0; j < 4; ++j) {
          int t = __builtin_amdgcn_cvt_pk_fp8_f32(a[u][j].x * sc, a[u][j].y * sc, 0, false);
          t = __builtin_amdgcn_cvt_pk_fp8_f32(a[u][j].z * sc, a[u][j].w * sc, t, true);
          w[j] = (unsigned)t;
        }
        *(uint4*)(p.ws + (isv ? WS_V : WS_U) + (size_t)r * DM + 16 * lane) = make_uint4(w[0], w[1], w[2], w[3]);
        if (lane == 0) ((float*)(p.ws + (isv ? WS_VSC : WS_USC)))[r] = isc;
      }
    }
  }
#else
  conv_range(p.peer_u, (u16*)(p.ws + WS_U), (size_t)16384 * DM / 8, bid, nb);
  conv_range(p.peer_v, (u16*)(p.ws + WS_V), (size_t)16384 * DM / 8, bid, nb);
#endif
}

#define ACC_ROW(e, hh) (((e) & 3) + 8 * ((e) >> 2) + 4 * (hh))
#define ACC_R0(e) (((e) & 3) + 8 * ((e) >> 2))
DI void store_bf16_pairs(u16* O, unsigned b0, unsigned ld, const f32x16& acc, float scale) {
  const bool odd = (threadIdx.x & 1) != 0;
#pragma unroll
  for (int e = 0; e < 16; e += 2) {
    const float a = acc[e] * scale, b = acc[e + 1] * scale;
    const float snd = odd ? a : b;
    const float rcv = __int_as_float(__builtin_amdgcn_update_dpp(0, __float_as_int(snd), 0xB1, 0xF, 0xF, true));
    const unsigned w = odd ? pk2(rcv, b) : pk2(a, rcv);
    const unsigned idx = b0 + (ACC_R0(e) + (odd ? 1u : 0u)) * ld - (odd ? 1u : 0u);
    *(unsigned*)(O + idx) = w;
  }
}
DI void store_bf16_pairs_res(u16* O, unsigned b0, const f32x16& acc, const u16* res, unsigned r0) {
  const bool odd = (threadIdx.x & 1) != 0;
#pragma unroll
  for (int e = 0; e < 16; e += 2) {
    const float a = DN_ALPHA * bflo((unsigned)res[r0 + ACC_R0(e) * 1024u]) + acc[e];
    const float b = DN_ALPHA * bflo((unsigned)res[r0 + ACC_R0(e + 1) * 1024u]) + acc[e + 1];
    const float snd = odd ? a : b;
    const float rcv = __int_as_float(__builtin_amdgcn_update_dpp(0, __float_as_int(snd), 0xB1, 0xF, 0xF, true));
    const unsigned w = odd ? pk2(rcv, b) : pk2(a, rcv);
    const unsigned idx = b0 + (ACC_R0(e) + (odd ? 1u : 0u)) * 1024u - (odd ? 1u : 0u);
    *(unsigned*)(O + idx) = w;
  }
}
template <int V> struct IC { static constexpr int value = V; };
struct SmemGemm { u16 a[2][128 * 64]; u16 b[2][128 * 64]; };

template <int ROWS>
struct GldsBf16 {
  const u16* base; int ld;
  DI void issue(int kt, u16* lds, int tid) {
    const int wid = tid >> 6, lane = tid & 63;
    constexpr int NCH = ROWS / 32;
#pragma unroll
    for (int q = 0; q < NCH; ++q) {
      const int ch = wid * NCH + q;
      const int r = ch * 8 + (lane >> 3);
      const int c = (lane & 7) ^ ((r >> 1) & 7);
      __builtin_amdgcn_global_load_lds((const unsigned*)(base + (size_t)r * ld + kt * 64 + c * 8), (unsigned*)(lds + ch * 512), 16, 0, 0);
    }
  }
  DI void commit(u16*, int) {}
};
#ifndef GEMM_REG2
#define GEMM_REG2 1
#endif
#if GEMM_REG2
typedef unsigned u32x4 __attribute__((ext_vector_type(4)));
template <int ROWS>
struct LdReg {
  static constexpr int N = ROWS / 32;
  const u16* base; int ld;
  u32x4 r0, r1, r2, r3;
  DI const u32x4* src(int kt, int tid, int i) const { const int c = tid + 256 * i; return (const u32x4*)(base + (size_t)(c >> 3) * ld + kt * 64 + (c & 7) * 8); }
  DI static u32x4* dst(u16* lds, int tid, int i) { const int c = tid + 256 * i; const int row = c >> 3; return (u32x4*)(lds + row * 64 + (((c & 7) ^ ((row >> 1) & 7)) * 8)); }
  DI void fetch(int kt, int tid) {
    r0 = *src(kt, tid, 0); r1 = *src(kt, tid, 1);
    if (N > 2) { r2 = *src(kt, tid, 2); r3 = *src(kt, tid, 3); }
  }
  DI void stash(u16* lds, int tid) const {
    *dst(lds, tid, 0) = r0; *dst(lds, tid, 1) = r1;
    if (N > 2) { *dst(lds, tid, 2) = r2; *dst(lds, tid, 3) = r3; }
  }
};
template <int MI, bool GRMS>
DI void gemm_compute(const u16* pa, const u16* pb, f32x16 (&acc)[MI][MI], int o0, int o1, int o2, int o3, int wr, int hh, bool scale_now, const float* rsc) {
  if (GRMS && scale_now) {
#pragma unroll
    for (int i = 0; i < MI; ++i)
#pragma unroll
      for (int e = 0; e < 16; ++e) {
        const float rt = rsc[((wr * MI + i) * 32 + ACC_ROW(e, hh)) * 2];
#pragma unroll
        for (int j = 0; j < MI; ++j) acc[i][j][e] *= rt;
      }
  }
  const int off[4] = {o0, o1, o2, o3};
  bf16x8 af[2][MI], bfr[2][MI];
#pragma unroll
  for (int i = 0; i < MI; ++i) { af[0][i] = *(const bf16x8*)(pa + i * 32 * 64 + off[0]); bfr[0][i] = *(const bf16x8*)(pb + i * 32 * 64 + off[0]); }
#pragma unroll
  for (int kk = 0; kk < 4; ++kk) {
    if (kk < 3) {
#pragma unroll
      for (int i = 0; i < MI; ++i) { af[(kk + 1) & 1][i] = *(const bf16x8*)(pa + i * 32 * 64 + off[kk + 1]); bfr[(kk + 1) & 1][i] = *(const bf16x8*)(pb + i * 32 * 64 + off[kk + 1]); }
    }
#pragma unroll
    for (int i = 0; i < MI; ++i)
#pragma unroll
      for (int j = 0; j < MI; ++j) acc[i][j] = MFMA(af[kk & 1][i], bfr[kk & 1][j], acc[i][j]);
  }
}
template <int MI, bool GRMS = false, class AL, class EPI>
DI void gemm_tile(AL& al, const u16* Bt, int ldb, int K, int m0, int n0, EPI epi, char* smem, const float* rsc = nullptr) {
  SmemGemm& sm = *(SmemGemm*)smem;
  const int tid = threadIdx.x, lane = tid & 63, wid = tid >> 6, wr = wid >> 1, wc = wid & 1, r31 = lane & 31, hh = lane >> 5;
  LdReg<MI * 64> a0, a1, b0, b1;
  a0.base = al.base; a0.ld = al.ld; a1.base = al.base; a1.ld = al.ld;
  b0.base = Bt + (size_t)n0 * ldb; b0.ld = ldb; b1.base = b0.base; b1.ld = ldb;
  f32x16 acc[MI][MI];
#pragma unroll
  for (int i = 0; i < MI; ++i)
#pragma unroll
    for (int j = 0; j < MI; ++j)
#pragma unroll
      for (int e = 0; e < 16; ++e) acc[i][j][e] = 0.f;
  int off[4];
#pragma unroll
  for (int kk = 0; kk < 4; ++kk) off[kk] = r31 * 64 + (((kk * 2 + hh) ^ ((r31 >> 1) & 7)) * 8);
  const int KT = K >> 6;
  a0.fetch(0, tid); b0.fetch(0, tid);
  a1.fetch(1, tid); b1.fetch(1, tid);
  a0.stash(sm.a[0], tid); b0.stash(sm.b[0], tid);
  __syncthreads();
  for (int kt = 0; kt < KT; kt += 2) {
    { const int kn = min(kt + 2, KT - 1); a0.fetch(kn, tid); b0.fetch(kn, tid); }
    gemm_compute<MI, GRMS>(sm.a[0] + (wr * MI * 32) * 64, sm.b[0] + (wc * MI * 32) * 64, acc, off[0], off[1], off[2], off[3], wr, hh, kt == (KT >> 1), rsc);
    a1.stash(sm.a[1], tid); b1.stash(sm.b[1], tid);
    __syncthreads();
    { const int kn = min(kt + 3, KT - 1); a1.fetch(kn, tid); b1.fetch(kn, tid); }
    gemm_compute<MI, GRMS>(sm.a[1] + (wr * MI * 32) * 64, sm.b[1] + (wc * MI * 32) * 64, acc, off[0], off[1], off[2], off[3], wr, hh, (kt + 1) == (KT >> 1), rsc);
    a0.stash(sm.a[0], tid); b0.stash(sm.b[0], tid);
    __syncthreads();
  }
  if (GRMS) {
#pragma unroll
    for (int i = 0; i < MI; ++i)
#pragma unroll
      for (int e = 0; e < 16; ++e) {
        const float s1 = rsc[((wr * MI + i) * 32 + ACC_ROW(e, hh)) * 2 + 1];
#pragma unroll
        for (int j = 0; j < MI; ++j) acc[i][j][e] *= s1;
      }
  }
#pragma unroll
  for (int i = 0; i < MI; ++i)
#pragma unroll
    for (int j = 0; j < MI; ++j) epi(m0 + (wr * MI + i) * 32, n0 + (wc * MI + j) * 32, acc[i][j]);
}
#else
template <int MI, bool GRMS = false, class AL, class EPI>
DI void gemm_tile(AL& al, const u16* Bt, int ldb, int K, int m0, int n0, EPI epi, char* smem, const float* rsc = nullptr) {
  SmemGemm& sm = *(SmemGemm*)smem;
  const int tid = threadIdx.x, lane = tid & 63, wid = tid >> 6, wr = wid >> 1, wc = wid & 1, r31 = lane & 31, hh = lane >> 5;
  GldsBf16<MI * 64> bl; bl.base = Bt + (size_t)n0 * ldb; bl.ld = ldb;
  f32x16 acc[MI][MI];
#pragma unroll
  for (int i = 0; i < MI; ++i)
#pragma unroll
    for (int j = 0; j < MI; ++j)
#pragma unroll
      for (int e = 0; e < 16; ++e) acc[i][j][e] = 0.f;
  int off[4];
#pragma unroll
  for (int kk = 0; kk < 4; ++kk) off[kk] = r31 * 64 + (((kk * 2 + hh) ^ ((r31 >> 1) & 7)) * 8);
  const int KT = K >> 6;
  al.issue(0, sm.a[0], tid); bl.issue(0, sm.b[0], tid);
  al.commit(sm.a[0], tid);
  asm volatile("s_waitcnt vmcnt(0)" ::: "memory");
  __syncthreads();
  for (int kt = 0; kt < KT; ++kt) {
    const int cur = kt & 1;
    if (kt + 1 < KT) { al.issue(kt + 1, sm.a[cur ^ 1], tid); bl.issue(kt + 1, sm.b[cur ^ 1], tid); }
    const u16* pa = sm.a[cur] + (wr * MI * 32) * 64;
    const u16* pb = sm.b[cur] + (wc * MI * 32) * 64;
    if (GRMS && kt == (KT >> 1)) {
#pragma unroll
      for (int i = 0; i < MI; ++i)
#pragma unroll
        for (int e = 0; e < 16; ++e) {
          const float rt = rsc[((wr * MI + i) * 32 + ACC_ROW(e, hh)) * 2];
#pragma unroll
          for (int j = 0; j < MI; ++j) acc[i][j][e] *= rt;
        }
    }
#pragma unroll
    for (int kk = 0; kk < 4; ++kk) {
      bf16x8 af[MI], bfr[MI];
#pragma unroll
      for (int i = 0; i < MI; ++i) { af[i] = *(const bf16x8*)(pa + i * 32 * 64 + off[kk]); bfr[i] = *(const bf16x8*)(pb + i * 32 * 64 + off[kk]); }
#pragma unroll
      for (int i = 0; i < MI; ++i)
#pragma unroll
        for (int j = 0; j < MI; ++j) acc[i][j] = MFMA(af[i], bfr[j], acc[i][j]);
    }
    if (kt + 1 < KT) al.commit(sm.a[cur ^ 1], tid);
    asm volatile("s_waitcnt vmcnt(0)" ::: "memory");
    __syncthreads();
  }
  if (GRMS) {
#pragma unroll
    for (int i = 0; i < MI; ++i)
#pragma unroll
      for (int e = 0; e < 16; ++e) {
        const float s1 = rsc[((wr * MI + i) * 32 + ACC_ROW(e, hh)) * 2 + 1];
#pragma unroll
        for (int j = 0; j < MI; ++j) acc[i][j][e] *= s1;
      }
  }
#pragma unroll
  for (int i = 0; i < MI; ++i)
#pragma unroll
    for (int j = 0; j < MI; ++j) epi(m0 + (wr * MI + i) * 32, n0 + (wc * MI + j) * 32, acc[i][j]);
}
#endif
template <class F>
DI void for_tiles(int N, F body) {
  const int vb = vblock(), nb = gridDim.x;
  const int ntn = N >> 7, ntn2 = N >> 6;
  const int nbig = 256 * ntn, nsmall = 16 * ntn2;
  for (int t = vb; t < nbig + nsmall; t += nb) {
    if (t < nbig) { body((t / ntn) * 128, (t % ntn) * 128, IC<2>{}); }
    else { const int u = t - nbig; body(NTP + (u / ntn2) * 64, (u % ntn2) * 64, IC<1>{}); }
  }
}

DI void phase_proj(const Params& p, char* smem) {
  const int vb = vblock(), nb = gridDim.x;
  constexpr int T_G1 = 264 * 25, T_MKV = 32 * 16;
  float* out = p.out;
  for (int t = vb; t < T_G1 + T_MKV; t += nb) {
    if (t < T_G1) {
      const int mt = t / 25, nt = t % 25;
      const int m0 = mt * 128, n0 = nt * 128;
      GldsBf16<128> al; al.base = (const u16*)(p.ws + WS_C) + (size_t)m0 * DM; al.ld = DM;
      const bool smp = m0 >= NTP;
      const float* b_f = p.b_f;
      u16* qsb = (u16*)(p.ws + WS_D);
      u16* qfx = qsb + (size_t)NT * 512;
      char* ws = p.ws;
      auto epi = [=](int r0, int c0, const f32x16& acc) {
        const int lane = threadIdx.x & 63, hh = lane >> 5, col = c0 + (lane & 31);
        const int seg = c0 >> 9, cc = col & 511;
        if (seg == 0 || seg == 3) {
          u16* q = (seg == 0) ? qsb : qfx;
#pragma unroll
          for (int e = 0; e < 16; ++e) q[(unsigned)(r0 + 4 * hh) * 512u + cc + ACC_R0(e) * 512u] = bf1(acc[e] * 0.125f);
        } else if (seg < 6) {
          size_t ob;
          if (!smp) ob = (seg == 1) ? OUT_SBK_P : (seg == 2) ? OUT_SBV_P : (seg == 4) ? OUT_FXK_P : OUT_FXV_P;
          else ob = (seg == 1) ? OUT_SBK_S : (seg == 2) ? OUT_SBV_S : (seg == 4) ? OUT_FXK_S : OUT_FXV_S;
          const int rb = smp ? r0 - NTP : r0;
          float* ov = out + ob;
          const unsigned b0 = (unsigned)(rb + 4 * hh) * 512u + cc;
#pragma unroll
          for (int e = 0; e < 16; ++e) ov[b0 + ACC_R0(e) * 512u] = acc[e];
          if (!smp) {
            if (seg == 1 || seg == 4) {
              u16* k16 = (u16*)(ws + WS_A) + (seg == 4 ? (size_t)NTP * 512 : 0);
#pragma unroll
              for (int e = 0; e < 16; ++e) k16[b0 + ACC_R0(e) * 512u] = bf1(acc[e]);
            } else {
              u16* vt16 = (u16*)(ws + WS_B) + (seg == 5 ? (size_t)NTP * 512 : 0);
              const unsigned vb0 = (unsigned)(((r0 >> 11) * 8 + (cc >> 6)) * 64 + (cc & 63)) * 2048u + (unsigned)(r0 & 2047) + 4 * hh;
#pragma unroll
              for (int g4 = 0; g4 < 4; ++g4) *(uint2*)(vt16 + vb0 + 8 * g4) = make_uint2(pk2(acc[4 * g4], acc[4 * g4 + 1]), pk2(acc[4 * g4 + 2], acc[4 * g4 + 3]));
            }
          }
        } else {
          const int c = col - 3072;
          if (c < 8) {
            const float bf = b_f[c];
            const size_t ob = smp ? OUT_LF_S : OUT_LF_P;
            const int rb = smp ? r0 - NTP : r0;
#pragma unroll
            for (int e = 0; e < 16; ++e) {
              const float z = acc[e] + bf;
              const float ls = fminf(z, 0.f) - log1pf(__expf(-fabsf(z)));
              out[ob + (unsigned)(rb + ACC_ROW(e, hh)) * 8u + c] = ls;
            }
          }
        }
      };
      gemm_tile<2>(al, (const u16*)(p.ws + WS_WIN), DM, DM, m0, n0, epi, smem);
    } else {
      const int u = t - T_G1;
      const int mt = u >> 4, nt = u & 15;
      const int m0 = mt * 128, n0 = nt * 128;
      GldsBf16<128> al; al.base = (const u16*)(p.ws + WS_E) + (size_t)m0 * DM; al.ld = DM;
      u16* kb = (u16*)(p.ws + WS_MEMK);
      u16* vt = (u16*)(p.ws + WS_MEMVT);
      auto epi = [=](int r0, int c0, const f32x16& acc) {
        const int lane = threadIdx.x & 63, hh = lane >> 5, col = c0 + (lane & 31);
        if (c0 < 1024) {
          float* ov = out + OUT_MK_P;
          const unsigned b0 = (unsigned)(r0 + 4 * hh) * 1024u + col;
#pragma unroll
          for (int e = 0; e < 16; ++e) { const unsigned idx = b0 + ACC_R0(e) * 1024u; ov[idx] = acc[e]; kb[idx] = bf1(acc[e]); }
        } else {
          const int c = col - 1024;
          float* ov = out + OUT_MV_P;
          const unsigned b0 = (unsigned)(r0 + 4 * hh) * 1024u + c;
#pragma unroll
          for (int e = 0; e < 16; ++e) ov[b0 + ACC_R0(e) * 1024u] = acc[e];
          const int b = r0 >> 8;
#pragma unroll
          for (int g4 = 0; g4 < 4; ++g4) {
            const int m = (r0 & 255) + 8 * g4 + 4 * hh;
            *(uint2*)(vt + ((size_t)b * DM + c) * 256 + m) = make_uint2(pk2(acc[4 * g4], acc[4 * g4 + 1]), pk2(acc[4 * g4 + 2], acc[4 * g4 + 3]));
          }
        }
      };
      gemm_tile<2>(al, (const u16*)(p.ws + WS_WMKV), DM, DM, m0, n0, epi, smem);
    }
  }
}

template <int PER>
DI void scan_one(const float* src0, int n0, const float* src1, int n, float* dst, float* part) {
  const int tid = threadIdx.x;
  const int s0 = tid * PER;
  float v[PER];
#pragma unroll
  for (int i = 0; i < PER; ++i) { const int s = s0 + i; v[i] = (s < n) ? ((s < n0) ? src0[(size_t)s * 8] : src1[(size_t)(s - n0) * 8]) : 0.f; }
  float loc = 0.f;
#pragma unroll
  for (int i = 0; i < PER; ++i) loc += v[i];
  part[tid] = loc;
  __syncthreads();
  float run = 0.f;
  for (int i = 0; i < tid; ++i) run += part[i];
#pragma unroll
  for (int i = 0; i < PER; ++i) { run += v[i]; if (s0 + i < n) dst[s0 + i] = -run * LOG2E; }
  __syncthreads();
}
DI void phase_scan(const Params& p, char* smem) {
  float* part = (float*)smem;
  for (int it = blockIdx.x; it < 256; it += gridDim.x) {
    const int bh = it & 127, b = bh >> 3, h = bh & 7;
    if (it < 128) scan_one<17>(p.c_fx_logf + (size_t)b * PAST * 8 + h, PAST, p.out + OUT_LF_S + (size_t)b * DSEQ * 8 + h, PAST + DSEQ, (float*)(p.ws + WS_CBS) + (size_t)bh * 4160, part);
    else scan_one<8>(p.out + OUT_LF_P + (size_t)b * SEQ * 8 + h, SEQ, nullptr, SEQ, (float*)(p.ws + WS_CBP) + (size_t)bh * 2048, part);
  }
}

constexpr int KLD = 72, VLD = 68;
struct SmemAttn { u16 k[2][64 * KLD]; u16 vt[2][64 * VLD]; float cb[4160]; float part[256]; u16 q[128 * KLD]; };
static_assert(sizeof(SmemAttn) <= SMEM_BYTES, "attn smem");

struct KVRegs { float4 k[4], v[4]; };
DI void kv_fetch(KVRegs& r, const float* kb, const float* vb, int tid) {
#pragma unroll
  for (int i = 0; i < 4; ++i) { const int c = tid + 256 * i; const size_t o = (size_t)(c >> 4) * 512 + (c & 15) * 4; const nf4 tk = ld_nt(kb + o), tv = ld_nt(vb + o); r.k[i] = make_float4(tk[0], tk[1], tk[2], tk[3]); r.v[i] = make_float4(tv[0], tv[1], tv[2], tv[3]); }
}
DI void kv_stash(const KVRegs& r, u16* ks, u16* vts, int tid) {
#pragma unroll
  for (int i = 0; i < 4; ++i) {
    const int c = tid + 256 * i; const int row = c >> 4, c4 = (c & 15) * 4;
    *(uint2*)(ks + row * KLD + c4) = make_uint2(pk2(r.k[i].x, r.k[i].y), pk2(r.k[i].z, r.k[i].w));
    vts[(c4 + 0) * VLD + row] = bf1(r.v[i].x); vts[(c4 + 1) * VLD + row] = bf1(r.v[i].y);
    vts[(c4 + 2) * VLD + row] = bf1(r.v[i].z); vts[(c4 + 3) * VLD + row] = bf1(r.v[i].w);
  }
}
typedef unsigned kv_u32x4 __attribute__((ext_vector_type(4)));
typedef unsigned kv_u32x2 __attribute__((ext_vector_type(2)));
struct KV16 { kv_u32x4 k0, k1, v0, v1; };
DI void kv_fetch16(KV16& r, const u16* kb, const u16* vtb, int tid) {
  const int c0 = tid, c1 = tid + 256;
  r.k0 = *(const kv_u32x4*)(kb + (size_t)(c0 >> 3) * 512 + (c0 & 7) * 8); r.k1 = *(const kv_u32x4*)(kb + (size_t)(c1 >> 3) * 512 + (c1 & 7) * 8);
  r.v0 = *(const kv_u32x4*)(vtb + (size_t)(c0 >> 3) * SEQ + (c0 & 7) * 8); r.v1 = *(const kv_u32x4*)(vtb + (size_t)(c1 >> 3) * SEQ + (c1 & 7) * 8);
}
DI void kv_stash16(const KV16& r, u16* ks, u16* vts, int tid) {
  const int c0 = tid, c1 = tid + 256;
  *(kv_u32x4*)(ks + (c0 >> 3) * KLD + (c0 & 7) * 8) = r.k0;
  *(kv_u32x4*)(ks + (c1 >> 3) * KLD + (c1 & 7) * 8) = r.k1;
  kv_u32x2 a = {r.v0[0], r.v0[1]}, b2 = {r.v0[2], r.v0[3]}, c = {r.v1[0], r.v1[1]}, d = {r.v1[2], r.v1[3]};
  *(kv_u32x2*)(vts + (c0 >> 3) * VLD + (c0 & 7) * 8) = a; *(kv_u32x2*)(vts + (c0 >> 3) * VLD + (c0 & 7) * 8 + 4) = b2;
  *(kv_u32x2*)(vts + (c1 >> 3) * VLD + (c1 & 7) * 8) = c; *(kv_u32x2*)(vts + (c1 >> 3) * VLD + (c1 & 7) * 8 + 4) = d;
}
DI bf16x8 pack8(const f32x16& x, int s) {
  union { unsigned u[4]; bf16x8 v; } t;
  t.u[0] = pk2(x[8 * s + 0], x[8 * s + 1]); t.u[1] = pk2(x[8 * s + 2], x[8 * s + 3]);
  t.u[2] = pk2(x[8 * s + 4], x[8 * s + 5]); t.u[3] = pk2(x[8 * s + 6], x[8 * s + 7]);
  return t.v;
}

template <bool FOX, bool SMP>
DI void attn_item(const Params& p, int b, int h, int qb, char* smem, bool do_ssq = true, int split = 0) {
  constexpr int smp = SMP ? 1 : 0;
  constexpr bool SPLIT = FOX && SMP;
  SmemAttn& sm = *(SmemAttn*)smem;
  const int tid = threadIdx.x, lane = tid & 63, wid = tid >> 6, r31 = lane & 31, hh = lane >> 5;
  const int jt0 = SPLIT ? split * 8 : 0;
  const int nkt = SPLIT ? (split == 7 ? 9 : 8) : (smp ? 65 : 2 * qb + 2);
  const int jdiag = smp ? 64 : 2 * qb;
  int qi = wid * 32 + r31; if (smp) qi &= 63;
  const int qpos = (smp ? PAST : qb * 128) + qi;
  const int g = smp ? NTP + b * DSEQ + qi : b * SEQ + qb * 128 + qi;
  const u16* Q = (const u16*)(p.ws + WS_D) + (FOX ? (size_t)NT * 512 : 0);
  {
#pragma unroll
    for (int i = 0; i < 4; ++i) {
      const int c = tid + 256 * i; const int row = c >> 3, kc = (c & 7) * 8;
      const int qr = smp ? (row & 63) : row;
      const int gr = smp ? NTP + b * DSEQ + qr : b * SEQ + qb * 128 + qr;
      *(kv_u32x4*)(sm.q + row * KLD + kc) = *(const kv_u32x4*)(Q + (size_t)gr * 512 + h * 64 + kc);
    }
    __syncthreads();
  }

  const float* kcache = FOX ? p.c_fx_k : p.c_sb_k;
  const float* vcache = FOX ? p.c_fx_v : p.c_sb_v;
  const size_t okp = FOX ? OUT_FXK_P : OUT_SBK_P, ovp = FOX ? OUT_FXV_P : OUT_SBV_P;
  const size_t oks = FOX ? OUT_FXK_S : OUT_SBK_S, ovs = FOX ? OUT_FXV_S : OUT_SBV_S;
  auto kptr = [&](int j) -> const float* {
    if (!smp) return p.out + okp + ((size_t)(b * SEQ + 64 * j) * 512 + h * 64);
    if (j < 64) return kcache + ((size_t)(b * PAST + 64 * j) * 512 + h * 64);
    return p.out + oks + ((size_t)(b * DSEQ) * 512 + h * 64);
  };
  auto vptr = [&](int j) -> const float* {
    if (!smp) return p.out + ovp + ((size_t)(b * SEQ + 64 * j) * 512 + h * 64);
    if (j < 64) return vcache + ((size_t)(b * PAST + 64 * j) * 512 + h * 64);
    return p.out + ovs + ((size_t)(b * DSEQ) * 512 + h * 64);
  };

  if (FOX) {
    const float4* src = (const float4*)(smp ? (const float*)(p.ws + WS_CBS) + (size_t)(b * 8 + h) * 4160 : (const float*)(p.ws + WS_CBP) + (size_t)(b * 8 + h) * 2048);
    for (int i = jt0 * 16 + tid; i < (jt0 + nkt) * 16; i += 256) ((float4*)sm.cb)[i] = src[i];
    __syncthreads();
  }

  bf16x8 tri[2];
  if (!FOX) {
#pragma unroll
    for (int s = 0; s < 2; ++s)
#pragma unroll
      for (int j = 0; j < 8; ++j) { const int kin = 16 * s + 8 * (j >> 2) + 4 * hh + (j & 3); tri[s][j] = (kin >= r31) ? (short)0x3F80 : (short)0; }
  }

  f32x16 o[2];
#pragma unroll
  for (int d = 0; d < 2; ++d)
#pragma unroll
    for (int e = 0; e < 16; ++e) o[d][e] = 0.f;
  float mrun = -1e30f, lrun = 0.f, R = 0.f;

  KVRegs kv;
  KV16 kw;
  const int jfirst = FOX ? jt0 : nkt - 1;
  const u16* k16 = (const u16*)(p.ws + WS_A) + (FOX ? (size_t)NTP * 512 : 0) + (size_t)(b * SEQ) * 512 + h * 64;
  const u16* vt16 = (const u16*)(p.ws + WS_B) + (FOX ? (size_t)NTP * 512 : 0) + (size_t)((b * 8 + h) * 64) * SEQ;
  if (smp) { kv_fetch(kv, kptr(jfirst), vptr(jfirst), tid); kv_stash(kv, sm.k[0], sm.vt[0], tid); }
  else { kv_fetch16(kw, k16 + (size_t)(64 * jfirst) * 512, vt16 + 64 * jfirst, tid); kv_stash16(kw, sm.k[0], sm.vt[0], tid); }
  __syncthreads();
  for (int it = 0; it < nkt; ++it) {
    const int j = FOX ? jt0 + it : nkt - 1 - it;
    const int cur = it & 1;
    if (it + 1 < nkt) { const int jn = FOX ? j + 1 : j - 1; if (smp) kv_fetch(kv, kptr(jn), vptr(jn), tid); else kv_fetch16(kw, k16 + (size_t)(64 * jn) * 512, vt16 + 64 * jn, tid); }
    f32x16 s[2];
#pragma unroll
    for (int t2 = 0; t2 < 2; ++t2) {
#pragma unroll
      for (int e = 0; e < 16; ++e) s[t2][e] = 0.f;
      const u16* pk = sm.k[cur] + (t2 * 32 + r31) * KLD + hh * 8;
      const u16* pq = sm.q + (wid * 32 + r31) * KLD + hh * 8;
#pragma unroll
      for (int kk = 0; kk < 4; ++kk) { const bf16x8 a = *(const bf16x8*)(pk + kk * 16); const bf16x8 qv = *(const bf16x8*)(pq + kk * 16); s[t2] = MFMA(a, qv, s[t2]); }
    }
    const bool diag = j >= jdiag;
    const int kbase = 64 * j + 4 * hh;
    if (FOX) {
      float mloc = -1e30f;
#pragma unroll
      for (int t2 = 0; t2 < 2; ++t2) {
        f32x16 bvec;
#pragma unroll
        for (int g4 = 0; g4 < 4; ++g4) {
          const float4 bb = *(const float4*)(sm.cb + 64 * j + 32 * t2 + 8 * g4 + 4 * hh);
          bvec[4 * g4] = bb.x; bvec[4 * g4 + 1] = bb.y; bvec[4 * g4 + 2] = bb.z; bvec[4 * g4 + 3] = bb.w;
        }
        s[t2] = s[t2] * LOG2E + bvec;
      }
      if (diag) {
#pragma unroll
        for (int t2 = 0; t2 < 2; ++t2)
#pragma unroll
          for (int e = 0; e < 16; ++e) if (kbase + 32 * t2 + ACC_ROW(e, 0) > qpos) s[t2][e] = -1e30f;
      }
#pragma unroll
      for (int t2 = 0; t2 < 2; ++t2)
#pragma unroll
        for (int e = 0; e < 16; ++e) mloc = fmaxf(mloc, s[t2][e]);
      mloc = fmaxf(mloc, __shfl_xor(mloc, 32));
      const float mnew = fmaxf(mrun, mloc);
      const float alpha = __builtin_amdgcn_exp2f(mrun - mnew);
      mrun = mnew;
      float ls = 0.f;
#pragma unroll
      for (int t2 = 0; t2 < 2; ++t2) {
        s[t2] = s[t2] - mnew;
#pragma unroll
        for (int e = 0; e < 16; ++e) { const float pv = __builtin_amdgcn_exp2f(s[t2][e]); s[t2][e] = pv; ls += pv; }
      }
      lrun = lrun * alpha + ls;
#pragma unroll
      for (int d = 0; d < 2; ++d) o[d] = o[d] * alpha;
    } else {
#pragma unroll
      for (int t2 = 1; t2 >= 0; --t2) {
        f32x16 lk;
#pragma unroll
        for (int e = 0; e < 16; ++e) {
          const float z = s[t2][e];
          const float sp = fmaxf(z, 0.f) + __logf(1.f + __expf(-fabsf(z)));
          const bool vis = !diag || (kbase + 32 * t2 + ACC_ROW(e, 0) < qpos);
          lk[e] = vis ? -sp : 0.f;
        }
        bf16x8 fh[2], fl[2];
#pragma unroll
        for (int sI = 0; sI < 2; ++sI) fh[sI] = pack8(lk, sI);
#pragma unroll
        for (int e = 0; e < 16; ++e) lk[e] -= __uint_as_float(((unsigned)(u16)fh[e >> 3][e & 7]) << 16);
#pragma unroll
        for (int sI = 0; sI < 2; ++sI) fl[sI] = pack8(lk, sI);
        f32x16 inc;
#pragma unroll
        for (int e = 0; e < 16; ++e) inc[e] = R;
#pragma unroll
        for (int sI = 0; sI < 2; ++sI) { inc = MFMA(tri[sI], fh[sI], inc); inc = MFMA(tri[sI], fl[sI], inc); }
#pragma unroll
        for (int e = 0; e < 16; ++e) {
          const bool vis = !diag || (kbase + 32 * t2 + ACC_ROW(e, 0) < qpos);
          const float w = __builtin_amdgcn_exp2f((s[t2][e] + inc[e]) * LOG2E);
          s[t2][e] = vis ? w : 0.f;
        }
        R = __shfl(inc[0], r31);
      }
    }
#pragma unroll
    for (int t2 = 0; t2 < 2; ++t2)
#pragma unroll
      for (int sI = 0; sI < 2; ++sI) {
        const bf16x8 pf = pack8(s[t2], sI);
#pragma unroll
        for (int d = 0; d < 2; ++d) {
          const u16* pv = sm.vt[cur] + (d * 32 + r31) * VLD + 32 * t2 + 16 * sI + 4 * hh;
          union { s16x4 q[2]; bf16x8 v; } a;
          a.q[0] = *(const s16x4*)(pv); a.q[1] = *(const s16x4*)(pv + 8);
          o[d] = MFMA(a.v, pf, o[d]);
        }
      }
    if (it + 1 < nkt) { if (smp) kv_stash(kv, sm.k[cur ^ 1], sm.vt[cur ^ 1], tid); else kv_stash16(kw, sm.k[cur ^ 1], sm.vt[cur ^ 1], tid); }
#if SB_EXIT
    if (!FOX) { if (__syncthreads_and(R < -110.f)) break; } else __syncthreads();
#else
    __syncthreads();
#endif
  }
  if (SPLIT) {
    constexpr int NS = 8;
    const int bh = b * 8 + h;
    float* po = (float*)(p.ws + WS_F) + (size_t)(bh * NS) * 4096;
    float* pml = (float*)(p.ws + WS_F) + (size_t)128 * NS * 4096 + (size_t)(bh * NS) * 128;
    const float lt = lrun + __shfl_xor(lrun, 32);
    if (wid < 2) {
      float* dst = po + (size_t)split * 4096 + qi * 64;
#pragma unroll
      for (int d = 0; d < 2; ++d)
#pragma unroll
        for (int g4 = 0; g4 < 4; ++g4) *(float4*)(dst + d * 32 + 8 * g4 + 4 * hh) = make_float4(o[d][4 * g4], o[d][4 * g4 + 1], o[d][4 * g4 + 2], o[d][4 * g4 + 3]);
      if (hh == 0) *(float2*)(pml + (size_t)split * 128 + qi * 2) = make_float2(mrun, lt);
    }
    int* slot2 = (int*)(smem + 73728 + 528);
    asm volatile("s_waitcnt vmcnt(0)" ::: "memory");
    __syncthreads();
    if (tid == 0) {
      __builtin_amdgcn_fence(__ATOMIC_RELEASE, "agent");
      asm volatile("s_waitcnt vmcnt(0)" ::: "memory");
      const unsigned old = __hip_atomic_fetch_add((unsigned*)(p.ws + WS_BAR + 256) + bh + (do_ssq ? 0 : 128), 1u, __ATOMIC_RELAXED, __HIP_MEMORY_SCOPE_AGENT);
      __builtin_amdgcn_fence(__ATOMIC_ACQUIRE, "agent");
      asm volatile("s_waitcnt vmcnt(0)" ::: "memory");
      *slot2 = (int)old;
    }
    __syncthreads();
    const bool last = (*slot2 == NS - 1);
    __syncthreads();
    if (last) {
      const int q = tid >> 2, d0 = (tid & 3) * 16;
      float ms[NS], ls[NS], M = -1e30f;
#pragma unroll
      for (int s2 = 0; s2 < NS; ++s2) { const float2 ml = *(const float2*)(pml + (size_t)s2 * 128 + q * 2); ms[s2] = ml.x; ls[s2] = ml.y; M = fmaxf(M, ml.x); }
      float L = 0.f, acc[16];
#pragma unroll
      for (int k = 0; k < 16; ++k) acc[k] = 0.f;
#pragma unroll
      for (int s2 = 0; s2 < NS; ++s2) {
        const float w = exp2f(ms[s2] - M);
        L += ls[s2] * w;
        const float4* src = (const float4*)(po + (size_t)s2 * 4096 + q * 64 + d0);
#pragma unroll
        for (int k4 = 0; k4 < 4; ++k4) { const float4 v = src[k4]; acc[4 * k4] += w * v.x; acc[4 * k4 + 1] += w * v.y; acc[4 * k4 + 2] += w * v.z; acc[4 * k4 + 3] += w * v.w; }
      }
      const float invL = 1.f / L;
      float ssq = 0.f;
#pragma unroll
      for (int k = 0; k < 16; ++k) { acc[k] *= invL; ssq += acc[k] * acc[k]; }
      ssq += __shfl_xor(ssq, 1); ssq += __shfl_xor(ssq, 2);
      const int gq = NTP + b * DSEQ + q;
      if (do_ssq && (tid & 3) == 0) atomicAdd((float*)(p.ws + WS_SSQ) + (size_t)gq * 2 + 1, ssq);
      u16* od = (u16*)(p.ws + WS_E) + (size_t)gq * DM + 512 + h * 64 + d0;
      *(uint4*)od = make_uint4(pk2(acc[0], acc[1]), pk2(acc[2], acc[3]), pk2(acc[4], acc[5]), pk2(acc[6], acc[7]));
      *(uint4*)(od + 8) = make_uint4(pk2(acc[8], acc[9]), pk2(acc[10], acc[11]), pk2(acc[12], acc[13]), pk2(acc[14], acc[15]));
    }
    return;
  }
  float inv = 1.f;
  if (FOX) { const float lt = lrun + __shfl_xor(lrun, 32); inv = 1.f / lt; }
  {
    float ssq = 0.f;
#pragma unroll
    for (int d = 0; d < 2; ++d)
#pragma unroll
      for (int e = 0; e < 16; ++e) { const float t = o[d][e] * inv; ssq += t * t; }
    ssq += __shfl_xor(ssq, 32);
    if (do_ssq && hh == 0 && (!smp || wid < 2)) atomicAdd((float*)(p.ws + WS_SSQ) + (size_t)g * 2 + (FOX ? 1 : 0), ssq);
  }
  if (!smp || wid < 2) {
    u16* od = (u16*)(p.ws + WS_E) + (size_t)g * DM + (FOX ? 512 : 0) + h * 64;
#pragma unroll
    for (int d = 0; d < 2; ++d)
#pragma unroll
      for (int g4 = 0; g4 < 4; ++g4)
        *(uint2*)(od + d * 32 + 8 * g4 + 4 * hh) = make_uint2(pk2(o[d][4 * g4] * inv, o[d][4 * g4 + 1] * inv), pk2(o[d][4 * g4 + 2] * inv, o[d][4 * g4 + 3] * inv));
  }
}

template <class F>
DI void attn_queue(unsigned* ctr, int n, int* slot, F body) {
  for (;;) {
    if (threadIdx.x == 0) *slot = (int)atomicAdd(ctr, 1u);
    __syncthreads();
    const int it = *slot;
    __syncthreads();
    if (it >= n) break;
    body(it);
  }
}
DI void phase_attn(const Params& p, char* smem, int rep = 0) {
  unsigned* ctr = (unsigned*)(p.ws + WS_BAR + 128) + rep * 4;
  int* slot = (int*)(smem + 73728 + 512);
  const bool dq = rep == 0;
  attn_queue(ctr + 0, 1024, slot, [&](int it) { const int bh = it >> 3; attn_item<true, true>(p, bh >> 3, bh & 7, 0, smem, dq, it & 7); });
  attn_queue(ctr + 1, 2048, slot, [&](int u) { const int w = u & 511; const int qb = 15 - (w >> 5), bh = (u >> 9) * 32 + (w & 31); attn_item<true, false>(p, bh >> 3, bh & 7, qb, smem, dq); });
  attn_queue(ctr + 2, 128, slot, [&](int u) { attn_item<false, true>(p, u >> 3, u & 7, 0, smem, dq); });
  attn_queue(ctr + 3, 2048, slot, [&](int u) { const int w = u & 511; const int qb = 15 - (w >> 5), bh = (u >> 9) * 32 + (w & 31); attn_item<false, false>(p, bh >> 3, bh & 7, qb, smem, dq); });
}

DI void phase_wout(const Params& p, char* smem) {
  u16* pre = (u16*)(p.ws + WS_A);
  const u16* o = (const u16*)(p.ws + WS_E);
  float* sc_s = (float*)(smem + 73728);
  for_tiles(DM, [&](int m0, int n0, auto tag) {
    constexpr int MI = decltype(tag)::value;
    {
      const int tid = threadIdx.x;
      if (tid < MI * 64) {
        const float2 q = ((const float2*)(p.ws + WS_SSQ))[m0 + tid];
        const float s0 = rsqrtf(q.x * (1.f / 512.f) + 1e-6f), s1 = rsqrtf(q.y * (1.f / 512.f) + 1e-6f);
        sc_s[tid * 2] = s0 / s1; sc_s[tid * 2 + 1] = s1;
      }
      __syncthreads();
    }
    GldsBf16<MI * 64> al; al.base = o + (size_t)m0 * DM; al.ld = DM;
    const u16* xr = (const u16*)(p.ws + WS_C) + (size_t)m0 * DM;
    auto epi = [=](int r0, int c0, const f32x16& acc) {
      const int lane = threadIdx.x & 63, hh = lane >> 5, col = c0 + (lane & 31);
      const unsigned b0 = (unsigned)(r0 + 4 * hh) * 1024u + col, b1 = (unsigned)(r0 - m0 + 4 * hh) * 1024u + col;
      store_bf16_pairs_res(pre, b0, acc, xr, b1);
    };
    gemm_tile<MI, true>(al, (const u16*)(p.ws + WS_WOUT), DM, DM, m0, n0, epi, smem, sc_s);
  });
}

DI void phase_ln(const Params& p, const float* gam, const float* bet) {
  const u16* pre = (const u16*)(p.ws + WS_A);
  u16* xb = (u16*)(p.ws + WS_C);
  const int lane = threadIdx.x & 63;
  const int wg = blockIdx.x * 4 + (threadIdx.x >> 6), nw = gridDim.x * 4;
  for (int row0 = wg * 2; row0 < NT; row0 += nw * 2) {
    float4 v[2][4];
    float s[2], q[2];
#pragma unroll
    for (int r = 0; r < 2; ++r) {
      s[r] = 0.f;
#pragma unroll
      for (int j = 0; j < 4; ++j) { const uint2 w = ((const uint2*)(pre + (size_t)(row0 + r) * DM))[lane + 64 * j]; v[r][j] = make_float4(bflo(w.x), bfhi(w.x), bflo(w.y), bfhi(w.y)); s[r] += v[r][j].x + v[r][j].y + v[r][j].z + v[r][j].w; }
    }
#pragma unroll
    for (int o = 32; o >= 1; o >>= 1)
#pragma unroll
      for (int r = 0; r < 2; ++r) s[r] += __shfl_xor(s[r], o);
#pragma unroll
    for (int r = 0; r < 2; ++r) {
      s[r] *= (1.f / 1024.f); q[r] = 0.f;
#pragma unroll
      for (int j = 0; j < 4; ++j) { const float a = v[r][j].x - s[r], b2 = v[r][j].y - s[r], c = v[r][j].z - s[r], d = v[r][j].w - s[r]; q[r] += a * a + b2 * b2 + c * c + d * d; }
    }
#pragma unroll
    for (int o = 32; o >= 1; o >>= 1)
#pragma unroll
      for (int r = 0; r < 2; ++r) q[r] += __shfl_xor(q[r], o);
#pragma unroll
    for (int r = 0; r < 2; ++r) {
      const float mu = s[r], rs = rsqrtf(q[r] * (1.f / 1024.f) + 1e-5f);
#pragma unroll
      for (int j = 0; j < 4; ++j) {
        const float4 gg = ((const float4*)gam)[lane + 64 * j], bb = ((const float4*)bet)[lane + 64 * j];
        float4 y;
        y.x = (v[r][j].x - mu) * rs * gg.x + bb.x; y.y = (v[r][j].y - mu) * rs * gg.y + bb.y;
        y.z = (v[r][j].z - mu) * rs * gg.z + bb.z; y.w = (v[r][j].w - mu) * rs * gg.w + bb.w;
        ((uint2*)(xb + (size_t)(row0 + r) * DM))[lane + 64 * j] = make_uint2(pk2(y.x, y.y), pk2(y.z, y.w));
      }
    }
  }
}

template <bool NOEPI = false>
DI void phase_gemm_bf16(const Params& p, const u16* A, const u16* Wt, int N, u16* O, float scale, char* smem) {
  for_tiles(N, [&](int m0, int n0, auto tag) {
    constexpr int MI = decltype(tag)::value;
    GldsBf16<MI * 64> al; al.base = A + (size_t)m0 * DM; al.ld = DM;
    auto epi = [=](int r0, int c0, const f32x16& acc) {
      const int lane = threadIdx.x & 63, hh = lane >> 5, col = c0 + (lane & 31);
      const unsigned b0 = (unsigned)(r0 + 4 * hh) * (unsigned)N + col;
      if (NOEPI) { float t = 0.f;
#pragma unroll
        for (int e = 0; e < 16; ++e) t += acc[e];
        if (t == 12345.678f) O[b0] = bf1(t);
        return; }
#pragma unroll
      for (int e = 0; e < 16; ++e) O[b0 + ACC_R0(e) * (unsigned)N] = bf1(acc[e] * scale);
    };
    gemm_tile<MI>(al, Wt, DM, DM, m0, n0, epi, smem);
  });
}

template <class F>
DI void for_mem_tiles(F body) {
  const int vb = vblock(), nb = gridDim.x;
  for (int t = vb; t < 2048 + 256; t += nb) {
    if (t < 2048) { const int mt = t >> 3; body(mt * 128, (t >> 1) & 3, (t & 1) * 128, mt >> 4, IC<2>{}); }
    else { const int u = t - 2048; const int mt = u >> 4; body(NTP + mt * 64, (u >> 2) & 3, (u & 3) * 64, 16 + mt, IC<1>{}); }
  }
}
DI void phase_mem_s(const Params& p, char* smem) {
  const u16* qm = (const u16*)(p.ws + WS_D);
  u16* S = (u16*)(p.ws + WS_F);
  for_mem_tiles([&](int m0, int hd, int n0, int batch, auto tag) {
    constexpr int MI = decltype(tag)::value;
    GldsBf16<MI * 64> al; al.base = qm + (size_t)m0 * DM + hd * 256; al.ld = DM;
    const u16* Bt = (const u16*)(p.ws + WS_MEMK) + (size_t)batch * 256 * DM + hd * 256;
    auto epi = [=](int r0, int c0, const f32x16& acc) {
      const int lane = threadIdx.x & 63, hh = lane >> 5, col = c0 + (lane & 31);
      const unsigned b0 = (unsigned)(r0 + 4 * hh) * 1024u + hd * 256 + col;
      store_bf16_pairs(S, b0, 1024u, acc, 1.f);
    };
    gemm_tile<MI>(al, Bt, DM, 256, m0, n0, epi, smem);
  });
}
DI void phase_mem_softmax(const Params& p) {
  const u16* S = (const u16*)(p.ws + WS_F);
  u16* P = (u16*)(p.ws + WS_D);
  const int lane = threadIdx.x & 63;
  const int wg = blockIdx.x * 4 + (threadIdx.x >> 6), nw = gridDim.x * 4;
  for (int row0 = wg * 8; row0 < NT * 4; row0 += nw * 8) {
    float4 v[8]; float m[8], sm[8];
#pragma unroll
    for (int r = 0; r < 8; ++r) { const uint2 w = ((const uint2*)(S + (size_t)(row0 + r) * 256))[lane]; v[r] = make_float4(bflo(w.x), bfhi(w.x), bflo(w.y), bfhi(w.y)); }
#pragma unroll
    for (int r = 0; r < 8; ++r) m[r] = fmaxf(fmaxf(v[r].x, v[r].y), fmaxf(v[r].z, v[r].w));
#pragma unroll
    for (int o = 32; o >= 1; o >>= 1)
#pragma unroll
      for (int r = 0; r < 8; ++r) m[r] = fmaxf(m[r], __shfl_xor(m[r], o));
#pragma unroll
    for (int r = 0; r < 8; ++r) { v[r].x = __expf(v[r].x - m[r]); v[r].y = __expf(v[r].y - m[r]); v[r].z = __expf(v[r].z - m[r]); v[r].w = __expf(v[r].w - m[r]); sm[r] = v[r].x + v[r].y + v[r].z + v[r].w; }
#pragma unroll
    for (int o = 32; o >= 1; o >>= 1)
#pragma unroll
      for (int r = 0; r < 8; ++r) sm[r] += __shfl_xor(sm[r], o);
#pragma unroll
    for (int r = 0; r < 8; ++r) { const float inv = 1.f / sm[r]; ((uint2*)(P + (size_t)(row0 + r) * 256))[lane] = make_uint2(pk2(v[r].x * inv, v[r].y * inv), pk2(v[r].z * inv, v[r].w * inv)); }
  }
}
DI void phase_mem_pv(const Params& p, char* smem) {
  const u16* P = (const u16*)(p.ws + WS_D);
  u16* om = (u16*)(p.ws + WS_E);
  for_mem_tiles([&](int m0, int hd, int n0, int batch, auto tag) {
    constexpr int MI = decltype(tag)::value;
    GldsBf16<MI * 64> al; al.base = P + (size_t)m0 * DM + hd * 256; al.ld = DM;
    const u16* Bt = (const u16*)(p.ws + WS_MEMVT) + ((size_t)batch * DM + hd * 256) * 256;
    auto epi = [=](int r0, int c0, const f32x16& acc) {
      const int lane = threadIdx.x & 63, hh = lane >> 5, col = c0 + (lane & 31);
      const unsigned b0 = (unsigned)(r0 + 4 * hh) * 1024u + hd * 256 + col;
#pragma unroll
      for (int e = 0; e < 16; ++e) om[b0 + ACC_R0(e) * 1024u] = bf1(acc[e]);
    };
    gemm_tile<MI>(al, Bt, 256, 256, m0, n0, epi, smem);
  });
}
DI void phase_wmo(const Params& p, char* smem) {
  u16* pre = (u16*)(p.ws + WS_A);
  const u16* xbs = (const u16*)(p.ws + WS_C);
  const u16* om = (const u16*)(p.ws + WS_E);
  for_tiles(DM, [&](int m0, int n0, auto tag) {
    constexpr int MI = decltype(tag)::value;
    GldsBf16<MI * 64> al; al.base = om + (size_t)m0 * DM; al.ld = DM;
    auto epi = [=](int r0, int c0, const f32x16& acc) {
      const int lane = threadIdx.x & 63, hh = lane >> 5, col = c0 + (lane & 31);
      const unsigned b0 = (unsigned)(r0 + 4 * hh) * 1024u + col;
      store_bf16_pairs_res(pre, b0, acc, xbs, b0);
    };
    gemm_tile<MI>(al, (const u16*)(p.ws + WS_WMO), DM, DM, m0, n0, epi, smem);
  });
}

DI void insert16(float (&v)[16], float x) {
#pragma unroll
  for (int j = 15; j >= 1; --j) v[j] = __builtin_amdgcn_fmed3f(x, v[j - 1], v[j]);
  v[0] = fmaxf(v[0], x);
}
DI void phase_topk(const Params& p, char* smem) {
  const int vb = vblock(), nb = gridDim.x;
  const u16* qp = (const u16*)(p.ws + WS_F);
  int* idxo = (int*)(p.ws + WS_A);
  float* gato = (float*)(p.ws + WS_A + (size_t)NT * 128 * 4);
  float* sc = (float*)smem;
  const int tid = threadIdx.x;
  for (int t = vb; t < 264 * 8; t += nb) {
    const int mt = t >> 3, hd = t & 7;
    const int m0 = mt * 128;
    float va[16], vbv[16];
#pragma unroll
    for (int side = 0; side < 2; ++side) {
      GldsBf16<128> al; al.base = qp + (size_t)m0 * 2048 + hd * 256 + side * 128; al.ld = 2048;
      const u16* Bt = (const u16*)(p.ws + (side ? WS_KB : WS_KA)) + (size_t)hd * 128 * 128;
      auto epi = [=](int r0, int c0, const f32x16& acc) {
        const int lane = threadIdx.x & 63, hh = lane >> 5, col = c0 + (lane & 31);
#pragma unroll
        for (int e = 0; e < 16; ++e) sc[(r0 - m0 + ACC_ROW(e, hh)) * 129 + col] = acc[e];
      };
      gemm_tile<2>(al, Bt, 128, 128, m0, 0, epi, smem);
      __syncthreads();
      {
        const int row = tid & 127, half = tid >> 7;
        float* mg = (float*)(smem + 66048);
        float v[16];
#pragma unroll
        for (int j = 0; j < 16; ++j) v[j] = -INFINITY;
        for (int k = 64 * half; k < 64 * half + 64; ++k) {
          const float x = __uint_as_float((__float_as_uint(sc[row * 129 + k]) & ~0x7Fu) | (unsigned)k);
          insert16(v, x);
        }
        if (half == 1) {
#pragma unroll
          for (int j = 0; j < 16; ++j) mg[row * 17 + j] = v[j];
        }
        __syncthreads();
        if (half == 0) {
#pragma unroll
          for (int j = 0; j < 16; ++j) insert16(v, mg[row * 17 + j]);
#pragma unroll
          for (int j = 0; j < 16; ++j) { if (side == 0) va[j] = v[j]; else vbv[j] = v[j]; }
        }
      }
      __syncthreads();
    }
    unsigned char* ids = (unsigned char*)smem;
    if (tid < 128) {
#pragma unroll
      for (int j = 0; j < 16; ++j) { ids[tid * 32 + j] = (unsigned char)(__float_as_uint(va[j]) & 0x7F); ids[tid * 32 + 16 + j] = (unsigned char)(__float_as_uint(vbv[j]) & 0x7F); }
      float top[16];
#pragma unroll
      for (int j = 0; j < 16; ++j) top[j] = -INFINITY;
#pragma unroll
      for (int i = 0; i < 16; ++i)
#pragma unroll
        for (int j = 0; j < 16; ++j)
          if ((i + 1) * (j + 1) <= 16) {
            const float a = __uint_as_float(__float_as_uint(va[i]) & ~0x7Fu), b = __uint_as_float(__float_as_uint(vbv[j]) & ~0x7Fu);
            const float c = __uint_as_float((__float_as_uint(a + b) & ~0xFFu) | (unsigned)(i * 16 + j));
            insert16(top, c);
          }
      const float m = __uint_as_float(__float_as_uint(top[0]) & ~0xFFu);
      float ex[16], ssum = 0.f;
      int eid[16];
#pragma unroll
      for (int j = 0; j < 16; ++j) {
        const unsigned bits = __float_as_uint(top[j]);
        const int code = bits & 0xFF;
        ex[j] = __expf(__uint_as_float(bits & ~0xFFu) - m); ssum += ex[j];
        eid[j] = (int)ids[tid * 32 + (code >> 4)] * 128 + (int)ids[tid * 32 + 16 + (code & 15)];
      }
      const float inv = 1.f / ssum;
      const size_t ob = (size_t)(m0 + tid) * 128 + hd * 16;
#pragma unroll
      for (int j4 = 0; j4 < 4; ++j4) {
        *(int4*)(idxo + ob + 4 * j4) = make_int4(eid[4 * j4], eid[4 * j4 + 1], eid[4 * j4 + 2], eid[4 * j4 + 3]);
        *(float4*)(gato + ob + 4 * j4) = make_float4(ex[4 * j4] * inv, ex[4 * j4 + 1] * inv, ex[4 * j4 + 2] * inv, ex[4 * j4 + 3] * inv);
      }
    }
    __syncthreads();
  }
}

#if USE_FP8
typedef float f32x2v __attribute__((ext_vector_type(2)));
DI void unpack16(const uint4& v, float (&f)[16]) {
  const unsigned w[4] = {v.x, v.y, v.z, v.w};
#pragma unroll
  for (int j = 0; j < 4; ++j) {
    const f32x2v lo = __builtin_amdgcn_cvt_pk_f32_fp8((int)w[j], false), hi = __builtin_amdgcn_cvt_pk_f32_fp8((int)w[j], true);
    f[4 * j] = lo[0]; f[4 * j + 1] = lo[1]; f[4 * j + 2] = hi[0]; f[4 * j + 3] = hi[1];
  }
}
DI void peer_dot8(const char* U, int idreg, int e0, int lane, const float (&x)[16], float& dacc) {
  uint4 w[8];
#pragma unroll
  for (int j = 0; j < 8; ++j) { const int id = __builtin_amdgcn_readlane(idreg, e0 + j); w[j] = *(const uint4*)(U + (size_t)id * DM + 16 * lane); }
  float s[8];
#pragma unroll
  for (int j = 0; j < 8; ++j) {
    float f[16]; unpack16(w[j], f);
    float a = 0.f;
#pragma unroll
    for (int k = 0; k < 16; ++k) a += f[k] * x[k];
    s[j] = a;
  }
  const bool b5 = lane & 32, b4 = lane & 16, b3 = lane & 8;
  float t4[4], t2[2], t1;
#pragma unroll
  for (int i = 0; i < 4; ++i) { const float snd = b5 ? s[i] : s[4 + i], kp = b5 ? s[4 + i] : s[i]; t4[i] = kp + __shfl_xor(snd, 32); }
#pragma unroll
  for (int i = 0; i < 2; ++i) { const float snd = b4 ? t4[i] : t4[2 + i], kp = b4 ? t4[2 + i] : t4[i]; t2[i] = kp + __shfl_xor(snd, 16); }
  { const float snd = b3 ? t2[0] : t2[1], kp = b3 ? t2[1] : t2[0]; t1 = kp + __shfl_xor(snd, 8); }
  t1 += __shfl_xor(t1, 4); t1 += __shfl_xor(t1, 2); t1 += __shfl_xor(t1, 1);
  const float g = __shfl(t1, (lane & 7) * 8);
  if ((lane >> 3) == (e0 >> 3)) dacc = g;
}
DI void peer_axpy8(const char* V, int idreg, float hreg, int e0, int lane, float (&acc)[16]) {
  uint4 w[8];
#pragma unroll
  for (int j = 0; j < 8; ++j) { const int id = __builtin_amdgcn_readlane(idreg, e0 + j); w[j] = *(const uint4*)(V + (size_t)id * DM + 16 * lane); }
#pragma unroll
  for (int j = 0; j < 8; ++j) {
    const float hs = __uint_as_float(__builtin_amdgcn_readlane(__float_as_uint(hreg), e0 + j));
    float f[16]; unpack16(w[j], f);
#pragma unroll
    for (int k = 0; k < 16; ++k) acc[k] += hs * f[k];
  }
}
DI void peer_sort(int& id0, int& id1, float& g0, float& g1, int lane) {
  unsigned k0 = ((unsigned)id0 << 7) | (unsigned)lane, k1 = ((unsigned)id1 << 7) | (unsigned)(lane + 64);
#pragma unroll
  for (int k = 2; k <= 128; k <<= 1) {
#pragma unroll
    for (int j = k >> 1; j >= 1; j >>= 1) {
      if (j == 64) {
        const unsigned lo = min(k0, k1), hi = max(k0, k1); k0 = lo; k1 = hi;
      } else {
        const unsigned p0 = (unsigned)__shfl_xor((int)k0, j), p1 = (unsigned)__shfl_xor((int)k1, j);
        const bool upper = (lane & j) != 0;
        const bool asc0 = ((lane & k) == 0), asc1 = (((lane + 64) & k) == 0);
        k0 = (upper == asc0) ? max(k0, p0) : min(k0, p0);
        k1 = (upper == asc1) ? max(k1, p1) : min(k1, p1);
      }
    }
  }
  const int s0 = k0 & 127, s1 = k1 & 127;
  const float a0 = __shfl(g0, s0 & 63), b0 = __shfl(g1, s0 & 63), a1 = __shfl(g0, s1 & 63), b1 = __shfl(g1, s1 & 63);
  g0 = (s0 < 64) ? a0 : b0; g1 = (s1 < 64) ? a1 : b1;
  id0 = (int)(k0 >> 7); id1 = (int)(k1 >> 7);
}
DI void peer_load(const Params& p, int row, int lane, float (&x)[16], int& id0, int& id1, float& g0, float& g1) {
  const int* idxo = (const int*)(p.ws + WS_A);
  const float* gato = (const float*)(p.ws + WS_A + (size_t)NT * 128 * 4);
  {
    const uint4* xr = (const uint4*)((const u16*)(p.ws + WS_C) + (size_t)row * DM) + 2 * lane;
    const uint4 a = xr[0], b = xr[1];
    x[0] = bflo(a.x); x[1] = bfhi(a.x); x[2] = bflo(a.y); x[3] = bfhi(a.y); x[4] = bflo(a.z); x[5] = bfhi(a.z); x[6] = bflo(a.w); x[7] = bfhi(a.w);
    x[8] = bflo(b.x); x[9] = bfhi(b.x); x[10] = bflo(b.y); x[11] = bfhi(b.y); x[12] = bflo(b.z); x[13] = bfhi(b.z); x[14] = bflo(b.w); x[15] = bfhi(b.w);
  }
  id0 = idxo[(size_t)row * 128 + lane]; id1 = idxo[(size_t)row * 128 + 64 + lane];
  g0 = gato[(size_t)row * 128 + lane]; g1 = gato[(size_t)row * 128 + 64 + lane];
  peer_sort(id0, id1, g0, g1, lane);
}
DI void peer_finish(const Params& p, int row, int lane, float (&acc)[16]) {
  float x[16];
  {
    const uint4* xr = (const uint4*)((const u16*)(p.ws + WS_C) + (size_t)row * DM) + 2 * lane;
    const uint4 a = xr[0], b = xr[1];
    x[0] = bflo(a.x); x[1] = bfhi(a.x); x[2] = bflo(a.y); x[3] = bfhi(a.y); x[4] = bflo(a.z); x[5] = bfhi(a.z); x[6] = bflo(a.w); x[7] = bfhi(a.w);
    x[8] = bflo(b.x); x[9] = bfhi(b.x); x[10] = bflo(b.y); x[11] = bfhi(b.y); x[12] = bflo(b.z); x[13] = bfhi(b.z); x[14] = bflo(b.w); x[15] = bfhi(b.w);
  }
  float s = 0.f;
#pragma unroll
  for (int k = 0; k < 16; ++k) { acc[k] = DN_ALPHA * x[k] + acc[k]; s += acc[k]; }
  const float mu = wave_sum(s) * (1.f / 1024.f);
  float q = 0.f;
#pragma unroll
  for (int k = 0; k < 16; ++k) { const float dd = acc[k] - mu; q += dd * dd; }
  const float rs = rsqrtf(wave_sum(q) * (1.f / 1024.f) + 1e-5f);
  float* y = (row < NTP) ? p.out + OUT_YP + (size_t)row * DM : p.out + OUT_YS + (size_t)(row - NTP) * DM;
#pragma unroll
  for (int j = 0; j < 4; ++j) {
    const float4 ga = ((const float4*)p.ln3_g)[4 * lane + j], ba = ((const float4*)p.ln3_b)[4 * lane + j];
    float4 ya;
    ya.x = (acc[4 * j + 0] - mu) * rs * ga.x + ba.x; ya.y = (acc[4 * j + 1] - mu) * rs * ga.y + ba.y;
    ya.z = (acc[4 * j + 2] - mu) * rs * ga.z + ba.z; ya.w = (acc[4 * j + 3] - mu) * rs * ga.w + ba.w;
    ((float4*)y)[4 * lane + j] = ya;
  }
}
DI float peer_gelu_gate(float d, float g) { return 0.5f * d * (1.f + erff(d * 0.7071067811865476f)) * g; }
DI void phase_peer(const Params& p, int rr0 = 0, int rr1 = 1 << 10) {
  const char* U = p.ws + WS_U;
  const char* V = p.ws + WS_V;
  const float* usc = (const float*)(p.ws + WS_USC);
  const float* vsc = (const float*)(p.ws + WS_VSC);
  const int lane = threadIdx.x & 63;
  const int wg = blockIdx.x * 4 + (threadIdx.x >> 6), nw = gridDim.x * 4;
  for (int rowA = wg + rr0 * 2 * nw; rowA < NT && rowA < wg + rr1 * 2 * nw; rowA += 2 * nw) {
    const bool hasB = rowA + nw < NT;
    const int rowB = hasB ? rowA + nw : rowA;
    asm volatile("" ::: "memory");
    float xA[16], xB[16];
    int a0, a1, b0, b1; float ga0, ga1, gb0, gb1;
    peer_load(p, rowA, lane, xA, a0, a1, ga0, ga1);
    peer_load(p, rowB, lane, xB, b0, b1, gb0, gb1);
    const float sua0 = usc[a0], sua1 = usc[a1], sva0 = vsc[a0], sva1 = vsc[a1];
    const float sub0 = usc[b0], sub1 = usc[b1], svb0 = vsc[b0], svb1 = vsc[b1];
    float da0 = 0.f, da1 = 0.f, db0 = 0.f, db1 = 0.f;
#pragma unroll 1
    for (int e0 = 0; e0 < 64; e0 += 8) { peer_dot8(U, a0, e0, lane, xA, da0); if (hasB) peer_dot8(U, b0, e0, lane, xB, db0); }
#pragma unroll 1
    for (int e0 = 0; e0 < 64; e0 += 8) { peer_dot8(U, a1, e0, lane, xA, da1); if (hasB) peer_dot8(U, b1, e0, lane, xB, db1); }
    const float ha0 = peer_gelu_gate(da0 * sua0, ga0) * sva0, ha1 = peer_gelu_gate(da1 * sua1, ga1) * sva1;
    const float hb0 = peer_gelu_gate(db0 * sub0, gb0) * svb0, hb1 = peer_gelu_gate(db1 * sub1, gb1) * svb1;
    float accA[16], accB[16];
#pragma unroll
    for (int k = 0; k < 16; ++k) { accA[k] = 0.f; accB[k] = 0.f; }
#pragma unroll 1
    for (int e0 = 0; e0 < 64; e0 += 8) { peer_axpy8(V, a0, ha0, e0, lane, accA); if (hasB) peer_axpy8(V, b0, hb0, e0, lane, accB); }
#pragma unroll 1
    for (int e0 = 0; e0 < 64; e0 += 8) { peer_axpy8(V, a1, ha1, e0, lane, accA); if (hasB) peer_axpy8(V, b1, hb1, e0, lane, accB); }
    peer_finish(p, rowA, lane, accA);
    if (hasB) peer_finish(p, rowB, lane, accB);
  }
}
#else
DI void unpack8(const uint4& v, float (&f)[8]) {
  f[0] = bflo(v.x); f[1] = bfhi(v.x); f[2] = bflo(v.y); f[3] = bfhi(v.y); f[4] = bflo(v.z); f[5] = bfhi(v.z); f[6] = bflo(v.w); f[7] = bfhi(v.w);
}
DI void phase_peer(const Params& p) {
  const float* xf = (const float*)(p.ws + WS_B);
  const int* idxo = (const int*)(p.ws + WS_A);
  const float* gato = (const float*)(p.ws + WS_A + (size_t)NT * 128 * 4);
  const u16* U = (const u16*)(p.ws + WS_U);
  const u16* V = (const u16*)(p.ws + WS_V);
  const int lane = threadIdx.x & 63;
  const int wg = blockIdx.x * 4 + (threadIdx.x >> 6), nw = gridDim.x * 4;
  for (int row = wg; row < NT; row += nw) {
    float x[16];
    {
      const float4* xr = (const float4*)(xf + (size_t)row * DM);
      const float4 a = xr[2 * lane], b = xr[2 * lane + 1], c = xr[128 + 2 * lane], d = xr[128 + 2 * lane + 1];
      x[0] = a.x; x[1] = a.y; x[2] = a.z; x[3] = a.w; x[4] = b.x; x[5] = b.y; x[6] = b.z; x[7] = b.w;
      x[8] = c.x; x[9] = c.y; x[10] = c.z; x[11] = c.w; x[12] = d.x; x[13] = d.y; x[14] = d.z; x[15] = d.w;
    }
    const int id0 = idxo[(size_t)row * 128 + lane], id1 = idxo[(size_t)row * 128 + 64 + lane];
    const float g0 = gato[(size_t)row * 128 + lane], g1 = gato[(size_t)row * 128 + 64 + lane];
    float d0 = 0.f, d1 = 0.f;
#pragma unroll 8
    for (int e = 0; e < 64; ++e) {
      const int id = __builtin_amdgcn_readlane(id0, e);
      const uint4* ur = (const uint4*)(U + (size_t)id * DM);
      const uint4 ua = ur[lane], ub = ur[64 + lane];
      float f[8], s = 0.f;
      unpack8(ua, f);
#pragma unroll
      for (int k = 0; k < 8; ++k) s += f[k] * x[k];
      unpack8(ub, f);
#pragma unroll
      for (int k = 0; k < 8; ++k) s += f[k] * x[8 + k];
      s = wave_sum(s);
      if (lane == e) d0 = s;
    }
#pragma unroll 8
    for (int e = 0; e < 64; ++e) {
      const int id = __builtin_amdgcn_readlane(id1, e);
      const uint4* ur = (const uint4*)(U + (size_t)id * DM);
      const uint4 ua = ur[lane], ub = ur[64 + lane];
      float f[8], s = 0.f;
      unpack8(ua, f);
#pragma unroll
      for (int k = 0; k < 8; ++k) s += f[k] * x[k];
      unpack8(ub, f);
#pragma unroll
      for (int k = 0; k < 8; ++k) s += f[k] * x[8 + k];
      s = wave_sum(s);
      if (lane == e) d1 = s;
    }
    const float h0 = 0.5f * d0 * (1.f + erff(d0 * 0.7071067811865476f)) * g0;
    const float h1 = 0.5f * d1 * (1.f + erff(d1 * 0.7071067811865476f)) * g1;
    float acc[16];
#pragma unroll
    for (int k = 0; k < 16; ++k) acc[k] = 0.f;
#pragma unroll 8
    for (int e = 0; e < 64; ++e) {
      const int id = __builtin_amdgcn_readlane(id0, e);
      const float hs = __uint_as_float(__builtin_amdgcn_readlane(__float_as_uint(h0), e));
      const uint4* vr = (const uint4*)(V + (size_t)id * DM);
      const uint4 va = vr[lane], vb2 = vr[64 + lane];
      float f[8];
      unpack8(va, f);
#pragma unroll
      for (int k = 0; k < 8; ++k) acc[k] += hs * f[k];
      unpack8(vb2, f);
#pragma unroll
      for (int k = 0; k < 8; ++k) acc[8 + k] += hs * f[k];
    }
#pragma unroll 8
    for (int e = 0; e < 64; ++e) {
      const int id = __builtin_amdgcn_readlane(id1, e);
      const float hs = __uint_as_float(__builtin_amdgcn_readlane(__float_as_uint(h1), e));
      const uint4* vr = (const uint4*)(V + (size_t)id * DM);
      const uint4 va = vr[lane], vb2 = vr[64 + lane];
      float f[8];
      unpack8(va, f);
#pragma unroll
      for (int k = 0; k < 8; ++k) acc[k] += hs * f[k];
      unpack8(vb2, f);
#pragma unroll
      for (int k = 0; k < 8; ++k) acc[8 + k] += hs * f[k];
    }
    float s = 0.f;
#pragma unroll
    for (int k = 0; k < 16; ++k) { acc[k] = DN_ALPHA * x[k] + acc[k]; s += acc[k]; }
    const float mu = wave_sum(s) * (1.f / 1024.f);
    float q = 0.f;
#pragma unroll
    for (int k = 0; k < 16; ++k) { const float dd = acc[k] - mu; q += dd * dd; }
    const float rs = rsqrtf(wave_sum(q) * (1.f / 1024.f) + 1e-5f);
    float* y = (row < NTP) ? p.out + OUT_YP + (size_t)row * DM : p.out + OUT_YS + (size_t)(row - NTP) * DM;
#pragma unroll
    for (int c = 0; c < 2; ++c) {
      const int off = c * 512 + lane * 8;
      const float4 ga = *(const float4*)(p.ln3_g + off), gb = *(const float4*)(p.ln3_g + off + 4);
      const float4 ba = *(const float4*)(p.ln3_b + off), bb = *(const float4*)(p.ln3_b + off + 4);
      float4 ya, yb;
      ya.x = (acc[8 * c + 0] - mu) * rs * ga.x + ba.x; ya.y = (acc[8 * c + 1] - mu) * rs * ga.y + ba.y;
      ya.z = (acc[8 * c + 2] - mu) * rs * ga.z + ba.z; ya.w = (acc[8 * c + 3] - mu) * rs * ga.w + ba.w;
      yb.x = (acc[8 * c + 4] - mu) * rs * gb.x + bb.x; yb.y = (acc[8 * c + 5] - mu) * rs * gb.y + bb.y;
      yb.z = (acc[8 * c + 6] - mu) * rs * gb.z + bb.z; yb.w = (acc[8 * c + 7] - mu) * rs * gb.w + bb.w;
      *(float4*)(y + off) = ya; *(float4*)(y + off + 4) = yb;
    }
  }
}

#endif

constexpr int NPHASE = 15;
template <int PH>
DI void run_phase(const Params& p, char* smem) {
  if (PH == 0) phase_prep(p, smem);
  else if (PH == 1) phase_proj(p, smem);
  else if (PH == 2) phase_scan(p, smem);
  else if (PH == 3) phase_attn(p, smem);
  else if (PH == 4) phase_wout(p, smem);
  else if (PH == 5) phase_ln(p, p.ln1_g, p.ln1_b);
  else if (PH == 6) phase_gemm_bf16(p, (const u16*)(p.ws + WS_C), (const u16*)(p.ws + WS_WMQ), 1024, (u16*)(p.ws + WS_D), 0.0625f, smem);
  else if (PH == 7) phase_mem_s(p, smem);
  else if (PH == 8) phase_mem_softmax(p);
  else if (PH == 9) phase_mem_pv(p, smem);
  else if (PH == 10) phase_wmo(p, smem);
  else if (PH == 11) phase_ln(p, p.ln2_g, p.ln2_b);
  else if (PH == 12) phase_gemm_bf16(p, (const u16*)(p.ws + WS_C), (const u16*)(p.ws + WS_WPQ), 2048, (u16*)(p.ws + WS_F), 1.f, smem);
  else if (PH == 13) phase_topk(p, smem);
  else if (PH == 14) phase_peer(p);
}

template <int PH>
__global__ void __launch_bounds__(256, 2) k_phase(Params p) {
  __shared__ __attribute__((aligned(16))) char smem[SMEM_BYTES];
  run_phase<PH>(p, smem);
}

#define XB_TMO      128
#define XB_XCNT(j)  (256  + 64 * (j))
#define XB_XSUB(j)  (1280 + 64 * (j))
#define XB_XGEN(j)  (2304 + 64 * (j))
#define XB_TOP      3328
#define XB_TOPGEN   3392
#define XB_SPIN_CAP (1u << 20)
DI unsigned xb_ld(unsigned* p) { return __hip_atomic_load(p, __ATOMIC_RELAXED, __HIP_MEMORY_SCOPE_AGENT); }
DI unsigned xb_add(unsigned* p, unsigned v) { return __hip_atomic_fetch_add(p, v, __ATOMIC_RELAXED, __HIP_MEMORY_SCOPE_AGENT); }
DI unsigned xb_xcc_id() { return (unsigned)__builtin_amdgcn_s_getreg((3 << 11) | 20) & 0xFu; }
#define XB_SPIN(cond, bar) do { unsigned _sp = 0; while (cond) { __builtin_amdgcn_s_sleep(1); \
    if ((++_sp & 255u) == 0u) { if (xb_ld(&(bar)[XB_TMO])) break; if (_sp > XB_SPIN_CAP) { atomicAdd(&(bar)[XB_TMO], 1u); break; } } } } while (0)
struct XcdBarrier { unsigned* bar; unsigned x; volatile unsigned* st; };
DI XcdBarrier xcd_barrier_post(unsigned* bar, volatile unsigned* st) {
  XcdBarrier b; b.bar = bar; b.x = xb_xcc_id(); b.st = st;
  if (threadIdx.x == 0) (void)xb_add(&bar[XB_XCNT(b.x)], 1u);
  return b;
}
DI void xcd_barrier_complete(unsigned* bar, unsigned x, unsigned& nloc, unsigned& nx) {
  const unsigned G = gridDim.x;
  unsigned sum, cnt, mine, sp = 0u;
  for (;;) {
    sum = 0u; cnt = 0u; mine = 0u;
#pragma unroll
    for (unsigned j = 0; j < 16; ++j) { const unsigned c = xb_ld(&bar[XB_XCNT(j)]); sum += c; cnt += (c > 0u) ? 1u : 0u; mine = (j == x) ? c : mine; }
    if (sum == G) break;
    __builtin_amdgcn_s_sleep(1);
    if ((++sp & 255u) == 0u) { if (xb_ld(&bar[XB_TMO])) break; if (sp > XB_SPIN_CAP) { atomicAdd(&bar[XB_TMO], 1u); break; } }
  }
  nloc = mine > 0u ? mine : 1u; nx = cnt > 0u ? cnt : 1u;
}
DI void xcd_barrier(const XcdBarrier& b) {
  asm volatile("s_waitcnt vmcnt(0)" ::: "memory");
  __syncthreads();
  if (threadIdx.x == 0) {
    unsigned* bar = b.bar;
    __builtin_amdgcn_s_waitcnt(0);
    unsigned nloc = b.st[0], nx = b.st[1];
    if (nloc == 0u) { xcd_barrier_complete(bar, b.x, nloc, nx); b.st[0] = nloc; b.st[1] = nx; }
    const unsigned old = xb_add(&bar[XB_XSUB(b.x)], 1u);
    const unsigned gen = old / nloc;
    if (old + 1u == (gen + 1u) * nloc) {
      __builtin_amdgcn_fence(__ATOMIC_RELEASE, "agent");
      asm volatile("s_waitcnt vmcnt(0)" ::: "memory");
      const unsigned og = xb_add(&bar[XB_TOP], 1u);
      const unsigned tg = og / nx;
      if (og + 1u == (tg + 1u) * nx) xb_add(&bar[XB_TOPGEN], 1u);
      else XB_SPIN(xb_ld(&bar[XB_TOPGEN]) == tg, bar);
      __builtin_amdgcn_fence(__ATOMIC_ACQUIRE, "agent");
      xb_add(&bar[XB_XGEN(b.x)], 1u);
      asm volatile("s_waitcnt vmcnt(0)" ::: "memory");
    } else {
      XB_SPIN(xb_ld(&bar[XB_XGEN(b.x)]) == gen, bar);
      __builtin_amdgcn_fence(__ATOMIC_ACQUIRE, "agent");
      asm volatile("s_waitcnt vmcnt(0)" ::: "memory");
    }
  }
  __syncthreads();
}
#if ONE_LAUNCH
DI void grid_barrier(unsigned* bar, unsigned& target) {
  target += gridDim.x;
  asm volatile("s_waitcnt vmcnt(0)" ::: "memory");
  __syncthreads();
  if (threadIdx.x == 0) {
    __builtin_amdgcn_fence(__ATOMIC_RELEASE, "agent");
    asm volatile("s_waitcnt vmcnt(0)" ::: "memory");
    __hip_atomic_fetch_add(bar, 1u, __ATOMIC_RELAXED, __HIP_MEMORY_SCOPE_AGENT);
    while (__hip_atomic_load(bar, __ATOMIC_RELAXED, __HIP_MEMORY_SCOPE_AGENT) < target) __builtin_amdgcn_s_sleep(2);
    __builtin_amdgcn_fence(__ATOMIC_ACQUIRE, "agent");
    asm volatile("s_waitcnt vmcnt(0)" ::: "memory");
  }
  __syncthreads();
}
__global__ void __launch_bounds__(256, 2) k_mega(Params p) {
  __shared__ __attribute__((aligned(16))) char smem[SMEM_BYTES];
  cg::grid_group grid = cg::this_grid();
#define RUN(n) do { run_phase<n>(p, smem); if (REPEAT_PHASE == n || (REPEAT_PHASE >= 1000 && (((REPEAT_PHASE - 1000) >> n) & 1))) { GSYNC(); run_phase<n>(p, smem); GSYNC(); run_phase<n>(p, smem); } if (REPEAT_PHASE == 203 && n == 3) { GSYNC(); phase_attn(p, smem, 1); GSYNC(); phase_attn(p, smem, 2); } if (REPEAT_PHASE == 100 + n) { GSYNC(); phase_gemm_bf16<true>(p, (const u16*)(p.ws + WS_C), (const u16*)(p.ws + WS_WPQ), 2048, (u16*)(p.ws + WS_F), 1.f, smem); GSYNC(); phase_gemm_bf16<true>(p, (const u16*)(p.ws + WS_C), (const u16*)(p.ws + WS_WPQ), 2048, (u16*)(p.ws + WS_F), 1.f, smem); } } while (0)
#if CUSTOM_BAR
  volatile unsigned* xst = (volatile unsigned*)(smem + 73728 + 1024);
  if (threadIdx.x == 0) { xst[0] = 0u; xst[1] = 0u; }
  __syncthreads();
  const XcdBarrier xb = xcd_barrier_post((unsigned*)(p.ws + WS_XBAR), xst);
#define GSYNC() xcd_barrier(xb)
#else
#define GSYNC() grid.sync()
#endif
  RUN(0); grid.sync();
  RUN(1); GSYNC();
  RUN(2); GSYNC();
  RUN(3); GSYNC();
  RUN(4); GSYNC();
  RUN(5); GSYNC();
  if (REPEAT_PHASE == 300) { GSYNC(); GSYNC(); GSYNC(); GSYNC(); GSYNC(); GSYNC(); GSYNC(); GSYNC(); }
  RUN(6); GSYNC();
  RUN(7); GSYNC();
  RUN(8); GSYNC();
  RUN(9); GSYNC();
  RUN(10); GSYNC();
  RUN(11); GSYNC();
  RUN(12); GSYNC();
  RUN(13); GSYNC();
#if PEER_RESYNC
  {
    const int nrounds = (NT + 8 * (int)gridDim.x - 1) / (8 * (int)gridDim.x);
    for (int rr = 0; rr < nrounds; rr += PEER_RESYNC) { if (rr) GSYNC(); phase_peer(p, rr, rr + PEER_RESYNC); }
  }
#else
  RUN(14);
#endif
}
#endif

extern "C" void kernel_launch(void* const* d_in, const int* in_sizes, int n_in, void* d_out, int out_size, void* d_ws, size_t ws_size,
                              hipStream_t stream) {
  (void)in_sizes; (void)n_in; (void)out_size;
  if (ws_size < WS_TOTAL) { fprintf(stderr, "workspace too small: %zu < %zu\n", ws_size, (size_t)WS_TOTAL); return; }
  Params p{};
  const float** pp = (const float**)&p;
  for (int i = 0; i < 29; ++i) pp[i] = (const float*)d_in[i];
  p.out = (float*)d_out;
  p.ws = (char*)d_ws;
#if ONE_LAUNCH
  static int grid_blocks = 0;
  if (!grid_blocks) {
    int dev = 0, cus = 0, per_cu = 0;
    hipGetDevice(&dev);
    hipDeviceGetAttribute(&cus, hipDeviceAttributeMultiprocessorCount, dev);
    hipOccupancyMaxActiveBlocksPerMultiprocessor(&per_cu, k_mega, 256, 0);
    if (per_cu > 2) per_cu = 2;
    grid_blocks = cus * per_cu;
  }
  hipMemsetAsync((char*)d_ws + WS_BAR, 0, 2048, stream);
  hipMemsetAsync((char*)d_ws + WS_XBAR, 0, 16384, stream);
  void* args[] = {&p};
  hipError_t e = hipLaunchCooperativeKernel((void*)k_mega, dim3(grid_blocks), dim3(256), args, 0, stream);
  if (e != hipSuccess) fprintf(stderr, "cooperative launch failed: %s (grid %d)\n", hipGetErrorString(e), grid_blocks);
#else
  const int G = 512;
  hipMemsetAsync((char*)d_ws + WS_BAR, 0, 2048, stream);
  k_phase<0><<<G, 256, 0, stream>>>(p);
  k_phase<1><<<G, 256, 0, stream>>>(p);
  k_phase<2><<<G, 256, 0, stream>>>(p);
  k_phase<3><<<G, 256, 0, stream>>>(p);
  k_phase<4><<<G, 256, 0, stream>>>(p);
  k_phase<5><<<G, 256, 0, stream>>>(p);
  k_phase<6><<<G, 256, 0, stream>>>(p);
  k_phase<7><<<G, 256, 0, stream>>>(p);
  k_phase<8><<<G, 256, 0, stream>>>(p);
  k_phase<9><<<G, 256, 0, stream>>>(p);
  k_phase<10><<<G, 256, 0, stream>>>(p);
  k_phase<11><<<G, 256, 0, stream>>>(p);
  k_phase<12><<<G, 256, 0, stream>>>(p);
  k_phase<13><<<G, 256, 0, stream>>>(p);
  k_phase<14><<<G, 256, 0, stream>>>(p);
#endif
}
```

```cpp
#include <hip/hip_runtime.h>
#include <hip/hip_cooperative_groups.h>
#include <cstdio>
#include <cstdint>
namespace cg = cooperative_groups;

#ifndef ONE_LAUNCH
#define ONE_LAUNCH 1
#endif

#ifndef USE_FP8
#define USE_FP8 1
#endif
#ifndef SB_EXIT
#define SB_EXIT 1
#endif
#ifndef REPEAT_PHASE
#define REPEAT_PHASE -1
#endif
#ifndef PEER_RESYNC
#define PEER_RESYNC 0
#endif
#ifndef CUSTOM_BAR
#define CUSTOM_BAR 1
#endif
#define DI __device__ __forceinline__
typedef unsigned short u16;
typedef short bf16x8 __attribute__((ext_vector_type(8)));
typedef short s16x4 __attribute__((ext_vector_type(4)));
typedef float f32x16 __attribute__((ext_vector_type(16)));
typedef __bf16 bf2_t __attribute__((ext_vector_type(2)));
typedef float f2_t __attribute__((ext_vector_type(2)));
#define MFMA(a, b, c) __builtin_amdgcn_mfma_f32_32x32x16_bf16((a), (b), (c), 0, 0, 0)

constexpr int DM = 1024;
constexpr int NTP = 32768;
constexpr int NTS = 1024;
constexpr int NT = NTP + NTS;
constexpr int SEQ = 2048, DSEQ = 64, PAST = 4096, NMEM = 256;
constexpr int INC = 3080, INCP = 3200;
constexpr float DN_ALPHA = 1.189207115002721f;
constexpr float LOG2E = 1.4426950408889634f;

constexpr size_t OUT_YP = 0;
constexpr size_t OUT_YS = OUT_YP + (size_t)NTP * DM;
constexpr size_t OUT_SBK_P = OUT_YS + (size_t)NTS * DM;
constexpr size_t OUT_SBV_P = OUT_SBK_P + (size_t)NTP * 512;
constexpr size_t OUT_FXK_P = OUT_SBV_P + (size_t)NTP * 512;
constexpr size_t OUT_FXV_P = OUT_FXK_P + (size_t)NTP * 512;
constexpr size_t OUT_LF_P = OUT_FXV_P + (size_t)NTP * 512;
constexpr size_t OUT_MK_P = OUT_LF_P + (size_t)NTP * 8;
constexpr size_t OUT_MV_P = OUT_MK_P + (size_t)4096 * DM;
constexpr size_t OUT_SBK_S = OUT_MV_P + (size_t)4096 * DM;
constexpr size_t OUT_SBV_S = OUT_SBK_S + (size_t)NTS * 512;
constexpr size_t OUT_FXK_S = OUT_SBV_S + (size_t)NTS * 512;
constexpr size_t OUT_FXV_S = OUT_FXK_S + (size_t)NTS * 512;
constexpr size_t OUT_LF_S = OUT_FXV_S + (size_t)NTS * 512;
constexpr size_t OUT_TOTAL = OUT_LF_S + (size_t)NTS * 8;

constexpr size_t WS_WIN = 0;
constexpr size_t WS_WOUT = WS_WIN + (size_t)INCP * DM * 2;
constexpr size_t WS_WMQ = WS_WOUT + (size_t)DM * DM * 2;
constexpr size_t WS_WMKV = WS_WMQ + (size_t)DM * DM * 2;
constexpr size_t WS_WMO = WS_WMKV + (size_t)2048 * DM * 2;
constexpr size_t WS_WPQ = WS_WMO + (size_t)DM * DM * 2;
constexpr size_t WS_KA = WS_WPQ + (size_t)2048 * DM * 2;
constexpr size_t WS_KB = WS_KA + (size_t)8 * 128 * 128 * 2;
constexpr size_t WS_U = WS_KB + (size_t)8 * 128 * 128 * 2;
constexpr size_t WS_V = WS_U + (size_t)16384 * DM * 2;
constexpr size_t WS_MEMK = WS_V + (size_t)16384 * DM * 2;
constexpr size_t WS_MEMVT = WS_MEMK + (size_t)32 * 256 * DM * 2;
constexpr size_t WS_A = WS_MEMVT + (size_t)32 * 256 * DM * 2;
constexpr size_t WS_B = WS_A + (size_t)NT * DM * 4;
constexpr size_t WS_C = WS_B + (size_t)NT * DM * 4;
constexpr size_t WS_D = WS_C + (size_t)NT * DM * 2;
constexpr size_t WS_E = WS_D + (size_t)NT * DM * 2;
constexpr size_t WS_F = WS_E + (size_t)NT * DM * 2;
constexpr size_t WS_BAR = WS_F + (size_t)NT * DM * 4;
constexpr size_t WS_USC = WS_BAR + 2048;
constexpr size_t WS_VSC = WS_USC + (size_t)16384 * 4;
constexpr size_t WS_CBP = WS_VSC + (size_t)16384 * 4;
constexpr size_t WS_CBS = WS_CBP + (size_t)128 * 2048 * 4;
constexpr size_t WS_SSQ = WS_CBS + (size_t)128 * 4160 * 4;
constexpr size_t WS_XBAR = WS_SSQ + (size_t)NT * 2 * 4;
constexpr size_t WS_TOTAL = WS_XBAR + 16384;

struct Params {
  const float *x_prompt, *x_sample, *mem_prompt, *c_sb_k, *c_sb_v, *c_fx_k, *c_fx_v, *c_fx_logf, *c_mem_k, *c_mem_v;
  const float *w_in, *b_f, *w_gn, *w_out, *ln1_g, *ln1_b, *w_mq, *w_mk, *w_mv, *w_mo, *ln2_g, *ln2_b;
  const float *w_pq, *keys_a, *keys_b, *peer_u, *peer_v, *ln3_g, *ln3_b;
  float* out;
  char* ws;
};

DI const Params* kparams() { auto ka = __builtin_amdgcn_kernarg_segment_ptr(); asm volatile("" : "+s"(ka)); return (const Params*)ka; }
constexpr int SMEM_BYTES = 73728 + 1024 + 64;

typedef float nf4 __attribute__((ext_vector_type(4)));
DI nf4 ld_nt(const float* p) { return __builtin_nontemporal_load((const nf4*)p); }
DI unsigned pk2(float a, float b) { f2_t v = {a, b}; bf2_t r = __builtin_convertvector(v, bf2_t); return __builtin_bit_cast(unsigned, r); }
DI u16 bf1(float a) { return (u16)(pk2(a, 0.f) & 0xffffu); }
DI float bflo(unsigned w) { return __uint_as_float(w << 16); }
DI float bfhi(unsigned w) { return __uint_as_float(w & 0xffff0000u); }
DI float wave_sum(float v) {
#pragma unroll
  for (int o = 32; o >= 1; o >>= 1) v += __shfl_xor(v, o);
  return v;
}
DI float wave_max(float v) {
#pragma unroll
  for (int o = 32; o >= 1; o >>= 1) v = fmaxf(v, __shfl_xor(v, o));
  return v;
}
DI int vblock() { int nb = gridDim.x, b = blockIdx.x; return ((nb & 7) == 0) ? (b & 7) * (nb >> 3) + (b >> 3) : b; }
DI const float* xrow(const Params& p, int g) { return g < NTP ? p.x_prompt + (size_t)g * DM : p.x_sample + (size_t)(g - NTP) * DM; }

DI void tconv_tile(const float* src, int ldsrc, int C, u16* dst, int lddst, const float* rowscale, int tr, int tc, float* tile) {
  const int tid = threadIdx.x;
  {
    const int r = tid >> 2, c0 = (tid & 3) * 16;
    const int gr = tr * 64 + r;
    const float sc = rowscale ? rowscale[gr] : 1.f;
#pragma unroll
    for (int j = 0; j < 4; ++j) {
      const int gc = tc * 64 + c0 + 4 * j;
      float4 v = make_float4(0.f, 0.f, 0.f, 0.f);
      if (gc < C) v = *(const float4*)(src + (size_t)gr * ldsrc + gc);
      float* t = tile + r * 65 + c0 + 4 * j;
      t[0] = v.x * sc; t[1] = v.y * sc; t[2] = v.z * sc; t[3] = v.w * sc;
    }
  }
  __syncthreads();
  {
    const int n = tid >> 2, k0 = (tid & 3) * 16;
    unsigned w[8];
#pragma unroll
    for (int e = 0; e < 8; ++e) w[e] = pk2(tile[(k0 + 2 * e) * 65 + n], tile[(k0 + 2 * e + 1) * 65 + n]);
    uint4* d = (uint4*)(dst + (size_t)(tc * 64 + n) * lddst + tr * 64 + k0);
    d[0] = make_uint4(w[0], w[1], w[2], w[3]);
    d[1] = make_uint4(w[4], w[5], w[6], w[7]);
  }
  __syncthreads();
}

DI void conv_range(const float* src, u16* dst, size_t n8, int bid, int nb) {
  const size_t step = (size_t)nb * 256;
  size_t i = (size_t)bid * 256 + threadIdx.x;
  for (; i + 3 * step < n8; i += 4 * step) {
    float4 a[4], b[4];
#pragma unroll
    for (int u = 0; u < 4; ++u) { a[u] = ((const float4*)src)[2 * (i + u * step)]; b[u] = ((const float4*)src)[2 * (i + u * step) + 1]; }
#pragma unroll
    for (int u = 0; u < 4; ++u) ((uint4*)dst)[i + u * step] = make_uint4(pk2(a[u].x, a[u].y), pk2(a[u].z, a[u].w), pk2(b[u].x, b[u].y), pk2(b[u].z, b[u].w));
  }
  for (; i < n8; i += step) {
    const float4 a = ((const float4*)src)[2 * i], b = ((const float4*)src)[2 * i + 1];
    ((uint4*)dst)[i] = make_uint4(pk2(a.x, a.y), pk2(a.z, a.w), pk2(b.x, b.y), pk2(b.z, b.w));
  }
}

DI void phase_prep(const Params& p, char* smem) {
  float* tile = (float*)smem;
  const int bid = blockIdx.x, nb = gridDim.x;
  u16* ws16 = (u16*)p.ws;
  constexpr int T_WIN = 16 * 50, T_SQ = 256, T_PQ = 16 * 32, T_MV = 16 * 4 * 16;
  constexpr int T0 = T_WIN, T1 = T0 + T_SQ, T2 = T1 + T_SQ, T3 = T2 + T_SQ, T4 = T3 + T_SQ, T5 = T4 + T_SQ, T6 = T5 + T_PQ, T7 = T6 + T_MV;
  for (int t = bid; t < T7; t += nb) {
    if (t < T0) { tconv_tile(p.w_in, INC, INC, (u16*)(p.ws + WS_WIN), DM, nullptr, t / 50, t % 50, tile); }
    else if (t < T1) { int u = t - T0; tconv_tile(p.w_out, DM, DM, (u16*)(p.ws + WS_WOUT), DM, p.w_gn, u >> 4, u & 15, tile); }
    else if (t < T2) { int u = t - T1; tconv_tile(p.w_mq, DM, DM, (u16*)(p.ws + WS_WMQ), DM, nullptr, u >> 4, u & 15, tile); }
    else if (t < T3) { int u = t - T2; tconv_tile(p.w_mk, DM, DM, (u16*)(p.ws + WS_WMKV), DM, nullptr, u >> 4, u & 15, tile); }
    else if (t < T4) { int u = t - T3; tconv_tile(p.w_mv, DM, DM, (u16*)(p.ws + WS_WMKV) + (size_t)DM * DM, DM, nullptr, u >> 4, u & 15, tile); }
    else if (t < T5) { int u = t - T4; tconv_tile(p.w_mo, DM, DM, (u16*)(p.ws + WS_WMO), DM, nullptr, u >> 4, u & 15, tile); }
    else if (t < T6) { int u = t - T5; tconv_tile(p.w_pq, 2048, 2048, (u16*)(p.ws + WS_WPQ), DM, nullptr, u >> 5, u & 31, tile); }
    else { int u = t - T6; int b = u >> 6, r = u & 63;
      tconv_tile(p.c_mem_v + (size_t)b * 256 * DM, DM, DM, (u16*)(p.ws + WS_MEMVT) + (size_t)(16 + b) * DM * 256, 256, nullptr, r >> 4, r & 15, tile); }
  }
  (void)ws16;
  for (int i = bid * 256 + threadIdx.x; i < NT * 2; i += nb * 256) ((float*)(p.ws + WS_SSQ))[i] = 0.f;
  conv_range(p.x_prompt, (u16*)(p.ws + WS_C), (size_t)NTP * DM / 8, bid, nb);
  conv_range(p.x_sample, (u16*)(p.ws + WS_C) + (size_t)NTP * DM, (size_t)NTS * DM / 8, bid, nb);
  conv_range(p.mem_prompt, (u16*)(p.ws + WS_E), (size_t)4096 * DM / 8, bid, nb);
  conv_range(p.c_mem_k, (u16*)(p.ws + WS_MEMK) + (size_t)16 * 256 * DM, (size_t)16 * 256 * DM / 8, bid, nb);
  conv_range(p.keys_a, (u16*)(p.ws + WS_KA), (size_t)8 * 128 * 128 / 8, bid, nb);
  conv_range(p.keys_b, (u16*)(p.ws + WS_KB), (size_t)8 * 128 * 128 / 8, bid, nb);
#if USE_FP8
  {
    const int lane = threadIdx.x & 63;
    const int wg = bid * 4 + (threadIdx.x >> 6), nw = nb * 4;
    for (int row0 = wg; row0 < 32768; row0 += 2 * nw) {
      float4 a[2][4];
      float am[2];
#pragma unroll
      for (int u = 0; u < 2; ++u) {
        const int row = row0 + u * nw;
        const bool isv = row >= 16384;
        const int r = isv ? row - 16384 : row;
        const float4* src = (const float4*)((isv ? p.peer_v : p.peer_u) + (size_t)r * DM) + 4 * lane;
        am[u] = 0.f;
#pragma unroll
        for (int j = 0; j < 4; ++j) { a[u][j] = src[j]; am[u] = fmaxf(am[u], fmaxf(fmaxf(fabsf(a[u][j].x), fabsf(a[u][j].y)), fmaxf(fabsf(a[u][j].z), fabsf(a[u][j].w)))); }
      }
#pragma unroll
      for (int o = 32; o >= 1; o >>= 1)
#pragma unroll
        for (int u = 0; u < 2; ++u) am[u] = fmaxf(am[u], __shfl_xor(am[u], o));
#pragma unroll
      for (int u = 0; u < 2; ++u) {
        const int row = row0 + u * nw;
        const bool isv = row >= 16384;
        const int r = isv ? row - 16384 : row;
        int ex = 0;
        if (am[u] > 0.f) (void)frexpf(am[u], &ex);
        const float sc = ldexpf(1.f, 8 - ex), isc = ldexpf(1.f, ex - 8);
        unsigned w[4];
#pragma unroll
        for (int j = 0; j < 4; ++j) {
          int t = __builtin_amdgcn_cvt_pk_fp8_f32(a[u][j].x * sc, a[u][j].y * sc, 0, false);
          t = __builtin_amdgcn_cvt_pk_fp8_f32(a[u][j].z * sc, a[u][j].w * sc, t, true);
          w[j] = (unsigned)t;
        }
        *(uint4*)(p.ws + (isv ? WS_V : WS_U) + (size_t)r * DM + 16 * lane) = make_uint4(w[0], w[1], w[2], w[3]);
        if (lane == 0) ((float*)(p.ws + (isv ? WS_VSC : WS_USC)))[r] = isc;
      }
    }
  }
#else
  conv_range(p.peer_u, (u16*)(p.ws + WS_U), (size_t)16384 * DM / 8, bid, nb);
  conv_range(p.peer_v, (u16*)(p.ws + WS_V), (size_t)16384 * DM / 8, bid, nb);
#endif
}

#define ACC_ROW(e, hh) (((e) & 3) + 8 * ((e) >> 2) + 4 * (hh))
#define ACC_R0(e) (((e) & 3) + 8 * ((e) >> 2))
DI void store_bf16_pairs(u16* O, unsigned b0, unsigned ld, const f32x16& acc, float scale) {
  const bool odd = (threadIdx.x & 1) != 0;
#pragma unroll
  for (int e = 0; e < 16; e += 2) {
    const float a = acc[e] * scale, b = acc[e + 1] * scale;
    const float snd = odd ? a : b;
    const float rcv = __int_as_float(__builtin_amdgcn_update_dpp(0, __float_as_int(snd), 0xB1, 0xF, 0xF, true));
    const unsigned w = odd ? pk2(rcv, b) : pk2(a, rcv);
    const unsigned idx = b0 + (ACC_R0(e) + (odd ? 1u : 0u)) * ld - (odd ? 1u : 0u);
    *(unsigned*)(O + idx) = w;
  }
}
DI void store_bf16_pairs_res(u16* O, unsigned b0, const f32x16& acc, const u16* res, unsigned r0) {
  const bool odd = (threadIdx.x & 1) != 0;
#pragma unroll
  for (int e = 0; e < 16; e += 2) {
    const float a = DN_ALPHA * bflo((unsigned)res[r0 + ACC_R0(e) * 1024u]) + acc[e];
    const float b = DN_ALPHA * bflo((unsigned)res[r0 + ACC_R0(e + 1) * 1024u]) + acc[e + 1];
    const float snd = odd ? a : b;
    const float rcv = __int_as_float(__builtin_amdgcn_update_dpp(0, __float_as_int(snd), 0xB1, 0xF, 0xF, true));
    const unsigned w = odd ? pk2(rcv, b) : pk2(a, rcv);
    const unsigned idx = b0 + (ACC_R0(e) + (odd ? 1u : 0u)) * 1024u - (odd ? 1u : 0u);
    *(unsigned*)(O + idx) = w;
  }
}
template <int V> struct IC { static constexpr int value = V; };
struct SmemGemm { u16 a[2][128 * 64]; u16 b[2][128 * 64]; };

template <int ROWS>
struct GldsBf16 {
  const u16* base; int ld;
  DI void issue(int kt, u16* lds, int tid) {
    const int wid = tid >> 6, lane = tid & 63;
    constexpr int NCH = ROWS / 32;
#pragma unroll
    for (int q = 0; q < NCH; ++q) {
      const int ch = wid * NCH + q;
      const int r = ch * 8 + (lane >> 3);
      const int c = (lane & 7) ^ ((r >> 1) & 7);
      __builtin_amdgcn_global_load_lds((const unsigned*)(base + (size_t)r * ld + kt * 64 + c * 8), (unsigned*)(lds + ch * 512), 16, 0, 0);
    }
  }
  DI void commit(u16*, int) {}
};
#ifndef GEMM_REG2
#define GEMM_REG2 1
#endif
#if GEMM_REG2
typedef unsigned u32x4 __attribute__((ext_vector_type(4)));
template <int ROWS>
struct LdReg {
  static constexpr int N = ROWS / 32;
  const u16* base; int ld;
  u32x4 r0, r1, r2, r3;
  DI const u32x4* src(int kt, int tid, int i) const { const int c = tid + 256 * i; return (const u32x4*)(base + (size_t)(c >> 3) * ld + kt * 64 + (c & 7) * 8); }
  DI static u32x4* dst(u16* lds, int tid, int i) { const int c = tid + 256 * i; const int row = c >> 3; return (u32x4*)(lds + row * 64 + (((c & 7) ^ ((row >> 1) & 7)) * 8)); }
  DI void fetch(int kt, int tid) {
    r0 = *src(kt, tid, 0); r1 = *src(kt, tid, 1);
    if (N > 2) { r2 = *src(kt, tid, 2); r3 = *src(kt, tid, 3); }
  }
  DI void stash(u16* lds, int tid) const {
    *dst(lds, tid, 0) = r0; *dst(lds, tid, 1) = r1;
    if (N > 2) { *dst(lds, tid, 2) = r2; *dst(lds, tid, 3) = r3; }
  }
};
template <int MI, bool GRMS>
DI void gemm_compute(const u16* pa, const u16* pb, f32x16 (&acc)[MI][MI], int o0, int o1, int o2, int o3, int wr, int hh, bool scale_now, const float* rsc) {
  if (GRMS && scale_now) {
#pragma unroll
    for (int i = 0; i < MI; ++i)
#pragma unroll
      for (int e = 0; e < 16; ++e) {
        const float rt = rsc[((wr * MI + i) * 32 + ACC_ROW(e, hh)) * 2];
#pragma unroll
        for (int j = 0; j < MI; ++j) acc[i][j][e] *= rt;
      }
  }
  const int off[4] = {o0, o1, o2, o3};
  bf16x8 af[2][MI], bfr[2][MI];
#pragma unroll
  for (int i = 0; i < MI; ++i) { af[0][i] = *(const bf16x8*)(pa + i * 32 * 64 + off[0]); bfr[0][i] = *(const bf16x8*)(pb + i * 32 * 64 + off[0]); }
#pragma unroll
  for (int kk = 0; kk < 4; ++kk) {
    if (kk < 3) {
#pragma unroll
      for (int i = 0; i < MI; ++i) { af[(kk + 1) & 1][i] = *(const bf16x8*)(pa + i * 32 * 64 + off[kk + 1]); bfr[(kk + 1) & 1][i] = *(const bf16x8*)(pb + i * 32 * 64 + off[kk + 1]); }
    }
#pragma unroll
    for (int i = 0; i < MI; ++i)
#pragma unroll
      for (int j = 0; j < MI; ++j) acc[i][j] = MFMA(af[kk & 1][i], bfr[kk & 1][j], acc[i][j]);
  }
}
template <int MI, bool GRMS = false, class AL, class EPI>
DI void gemm_tile(AL& al, const u16* Bt, int ldb, int K, int m0, int n0, EPI epi, char* smem, const float* rsc = nullptr) {
  SmemGemm& sm = *(SmemGemm*)smem;
  const int tid = threadIdx.x, lane = tid & 63, wid = tid >> 6, wr = wid >> 1, wc = wid & 1, r31 = lane & 31, hh = lane >> 5;
  LdReg<MI * 64> a0, a1, b0, b1;
  a0.base = al.base; a0.ld = al.ld; a1.base = al.base; a1.ld = al.ld;
  b0.base = Bt + (size_t)n0 * ldb; b0.ld = ldb; b1.base = b0.base; b1.ld = ldb;
  f32x16 acc[MI][MI];
#pragma unroll
  for (int i = 0; i < MI; ++i)
#pragma unroll
    for (int j = 0; j < MI; ++j)
#pragma unroll
      for (int e = 0; e < 16; ++e) acc[i][j][e] = 0.f;
  int off[4];
#pragma unroll
  for (int kk = 0; kk < 4; ++kk) off[kk] = r31 * 64 + (((kk * 2 + hh) ^ ((r31 >> 1) & 7)) * 8);
  const int KT = K >> 6;
  a0.fetch(0, tid); b0.fetch(0, tid);
  a1.fetch(1, tid); b1.fetch(1, tid);
  a0.stash(sm.a[0], tid); b0.stash(sm.b[0], tid);
  __syncthreads();
  for (int kt = 0; kt < KT; kt += 2) {
    { const int kn = min(kt + 2, KT - 1); a0.fetch(kn, tid); b0.fetch(kn, tid); }
    gemm_compute<MI, GRMS>(sm.a[0] + (wr * MI * 32) * 64, sm.b[0] + (wc * MI * 32) * 64, acc, off[0], off[1], off[2], off[3], wr, hh, kt == (KT >> 1), rsc);
    a1.stash(sm.a[1], tid); b1.stash(sm.b[1], tid);
    __syncthreads();
    { const int kn = min(kt + 3, KT - 1); a1.fetch(kn, tid); b1.fetch(kn, tid); }
    gemm_compute<MI, GRMS>(sm.a[1] + (wr * MI * 32) * 64, sm.b[1] + (wc * MI * 32) * 64, acc, off[0], off[1], off[2], off[3], wr, hh, (kt + 1) == (KT >> 1), rsc);
    a0.stash(sm.a[0], tid); b0.stash(sm.b[0], tid);
    __syncthreads();
  }
  if (GRMS) {
#pragma unroll
    for (int i = 0; i < MI; ++i)
#pragma unroll
      for (int e = 0; e < 16; ++e) {
        const float s1 = rsc[((wr * MI + i) * 32 + ACC_ROW(e, hh)) * 2 + 1];
#pragma unroll
        for (int j = 0; j < MI; ++j) acc[i][j][e] *= s1;
      }
  }
#pragma unroll
  for (int i = 0; i < MI; ++i)
#pragma unroll
    for (int j = 0; j < MI; ++j) epi(m0 + (wr * MI + i) * 32, n0 + (wc * MI + j) * 32, acc[i][j]);
}
#else
template <int MI, bool GRMS = false, class AL, class EPI>
DI void gemm_tile(AL& al, const u16* Bt, int ldb, int K, int m0, int n0, EPI epi, char* smem, const float* rsc = nullptr) {
  SmemGemm& sm = *(SmemGemm*)smem;
  const int tid = threadIdx.x, lane = tid & 63, wid = tid >> 6, wr = wid >> 1, wc = wid & 1, r31 = lane & 31, hh = lane >> 5;
  GldsBf16<MI * 64> bl; bl.base = Bt + (size_t)n0 * ldb; bl.ld = ldb;
  f32x16 acc[MI][MI];
#pragma unroll
  for (int i = 0; i < MI; ++i)
#pragma unroll
    for (int j = 0; j < MI; ++j)
#pragma unroll
      for (int e = 0; e < 16; ++e) acc[i][j][e] = 0.f;
  int off[4];
#pragma unroll
  for (int kk = 0; kk < 4; ++kk) off[kk] = r31 * 64 + (((kk * 2 + hh) ^ ((r31 >> 1) & 7)) * 8);
  const int KT = K >> 6;
  al.issue(0, sm.a[0], tid); bl.issue(0, sm.b[0], tid);
  al.commit(sm.a[0], tid);
  asm volatile("s_waitcnt vmcnt(0)" ::: "memory");
  __syncthreads();
  for (int kt = 0; kt < KT; ++kt) {
    const int cur = kt & 1;
    if (kt + 1 < KT) { al.issue(kt + 1, sm.a[cur ^ 1], tid); bl.issue(kt + 1, sm.b[cur ^ 1], tid); }
    const u16* pa = sm.a[cur] + (wr * MI * 32) * 64;
    const u16* pb = sm.b[cur] + (wc * MI * 32) * 64;
    if (GRMS && kt == (KT >> 1)) {
#pragma unroll
      for (int i = 0; i < MI; ++i)
#pragma unroll
        for (int e = 0; e < 16; ++e) {
          const float rt = rsc[((wr * MI + i) * 32 + ACC_ROW(e, hh)) * 2];
#pragma unroll
          for (int j = 0; j < MI; ++j) acc[i][j][e] *= rt;
        }
    }
#pragma unroll
    for (int kk = 0; kk < 4; ++kk) {
      bf16x8 af[MI], bfr[MI];
#pragma unroll
      for (int i = 0; i < MI; ++i) { af[i] = *(const bf16x8*)(pa + i * 32 * 64 + off[kk]); bfr[i] = *(const bf16x8*)(pb + i * 32 * 64 + off[kk]); }
#pragma unroll
      for (int i = 0; i < MI; ++i)
#pragma unroll
        for (int j = 0; j < MI; ++j) acc[i][j] = MFMA(af[i], bfr[j], acc[i][j]);
    }
    if (kt + 1 < KT) al.commit(sm.a[cur ^ 1], tid);
    asm volatile("s_waitcnt vmcnt(0)" ::: "memory");
    __syncthreads();
  }
  if (GRMS) {
#pragma unroll
    for (int i = 0; i < MI; ++i)
#pragma unroll
      for (int e = 0; e < 16; ++e) {
        const float s1 = rsc[((wr * MI + i) * 32 + ACC_ROW(e, hh)) * 2 + 1];
#pragma unroll
        for (int j = 0; j < MI; ++j) acc[i][j][e] *= s1;
      }
  }
#pragma unroll
  for (int i = 0; i < MI; ++i)
#pragma unroll
    for (int j = 0; j < MI; ++j) epi(m0 + (wr * MI + i) * 32, n0 + (wc * MI + j) * 32, acc[i][j]);
}
#endif
template <class F>
DI void for_tiles(int N, F body) {
  const int vb = vblock(), nb = gridDim.x;
  const int ntn = N >> 7, ntn2 = N >> 6;
  const int nbig = 256 * ntn, nsmall = 16 * ntn2;
  for (int t = vb; t < nbig + nsmall; t += nb) {
    if (t < nbig) { body((t / ntn) * 128, (t % ntn) * 128, IC<2>{}); }
    else { const int u = t - nbig; body(NTP + (u / ntn2) * 64, (u % ntn2) * 64, IC<1>{}); }
  }
}

DI void phase_proj(const Params& p, char* smem) {
  const int vb = vblock(), nb = gridDim.x;
  constexpr int T_G1 = 264 * 25, T_MKV = 32 * 16;
  float* out = p.out;
  for (int t = vb; t < T_G1 + T_MKV; t += nb) {
    if (t < T_G1) {
      const int mt = t / 25, nt = t % 25;
      const int m0 = mt * 128, n0 = nt * 128;
      GldsBf16<128> al; al.base = (const u16*)(p.ws + WS_C) + (size_t)m0 * DM; al.ld = DM;
      const bool smp = m0 >= NTP;
      const float* b_f = p.b_f;
      u16* qsb = (u16*)(p.ws + WS_D);
      u16* qfx = qsb + (size_t)NT * 512;
      char* ws = p.ws;
      auto epi = [=](int r0, int c0, const f32x16& acc) {
        const int lane = threadIdx.x & 63, hh = lane >> 5, col = c0 + (lane & 31);
        const int seg = c0 >> 9, cc = col & 511;
        if (seg == 0 || seg == 3) {
          u16* q = (seg == 0) ? qsb : qfx;
#pragma unroll
          for (int e = 0; e < 16; ++e) q[(unsigned)(r0 + 4 * hh) * 512u + cc + ACC_R0(e) * 512u] = bf1(acc[e] * 0.125f);
        } else if (seg < 6) {
          size_t ob;
          if (!smp) ob = (seg == 1) ? OUT_SBK_P : (seg == 2) ? OUT_SBV_P : (seg == 4) ? OUT_FXK_P : OUT_FXV_P;
          else ob = (seg == 1) ? OUT_SBK_S : (seg == 2) ? OUT_SBV_S : (seg == 4) ? OUT_FXK_S : OUT_FXV_S;
          const int rb = smp ? r0 - NTP : r0;
          float* ov = out + ob;
          const unsigned b0 = (unsigned)(rb + 4 * hh) * 512u + cc;
#pragma unroll
          for (int e = 0; e < 16; ++e) __builtin_nontemporal_store(acc[e], ov + b0 + ACC_R0(e) * 512u);
          if (!smp) {
            if (seg == 1 || seg == 4) {
              u16* k16 = (u16*)(ws + WS_A) + (seg == 4 ? (size_t)NTP * 512 : 0);
#pragma unroll
              for (int e = 0; e < 16; ++e) k16[b0 + ACC_R0(e) * 512u] = bf1(acc[e]);
            } else {
              u16* vt16 = (u16*)(ws + WS_B) + (seg == 5 ? (size_t)NTP * 512 : 0);
              const unsigned vb0 = (unsigned)(((r0 >> 11) * 8 + (cc >> 6)) * 64 + (cc & 63)) * 2048u + (unsigned)(r0 & 2047) + 4 * hh;
#pragma unroll
              for (int g4 = 0; g4 < 4; ++g4) *(uint2*)(vt16 + vb0 + 8 * g4) = make_uint2(pk2(acc[4 * g4], acc[4 * g4 + 1]), pk2(acc[4 * g4 + 2], acc[4 * g4 + 3]));
            }
          }
        } else {
          const int c = col - 3072;
          if (c < 8) {
            const float bf = b_f[c];
            const size_t ob = smp ? OUT_LF_S : OUT_LF_P;
            const int rb = smp ? r0 - NTP : r0;
#pragma unroll
            for (int e = 0; e < 16; ++e) {
              const float z = acc[e] + bf;
              const float ls = fminf(z, 0.f) - log1pf(__expf(-fabsf(z)));
              out[ob + (unsigned)(rb + ACC_ROW(e, hh)) * 8u + c] = ls;
            }
          }
        }
      };
      gemm_tile<2>(al, (const u16*)(p.ws + WS_WIN), DM, DM, m0, n0, epi, smem);
    } else {
      const int u = t - T_G1;
      const int mt = u >> 4, nt = u & 15;
      const int m0 = mt * 128, n0 = nt * 128;
      GldsBf16<128> al; al.base = (const u16*)(p.ws + WS_E) + (size_t)m0 * DM; al.ld = DM;
      u16* kb = (u16*)(p.ws + WS_MEMK);
      u16* vt = (u16*)(p.ws + WS_MEMVT);
      auto epi = [=](int r0, int c0, const f32x16& acc) {
        const int lane = threadIdx.x & 63, hh = lane >> 5, col = c0 + (lane & 31);
        if (c0 < 1024) {
          float* ov = out + OUT_MK_P;
          const unsigned b0 = (unsigned)(r0 + 4 * hh) * 1024u + col;
#pragma unroll
          for (int e = 0; e < 16; ++e) { const unsigned idx = b0 + ACC_R0(e) * 1024u; ov[idx] = acc[e]; kb[idx] = bf1(acc[e]); }
        } else {
          const int c = col - 1024;
          float* ov = out + OUT_MV_P;
          const unsigned b0 = (unsigned)(r0 + 4 * hh) * 1024u + c;
#pragma unroll
          for (int e = 0; e < 16; ++e) ov[b0 + ACC_R0(e) * 1024u] = acc[e];
          const int b = r0 >> 8;
#pragma unroll
          for (int g4 = 0; g4 < 4; ++g4) {
            const int m = (r0 & 255) + 8 * g4 + 4 * hh;
            *(uint2*)(vt + ((size_t)b * DM + c) * 256 + m) = make_uint2(pk2(acc[4 * g4], acc[4 * g4 + 1]), pk2(acc[4 * g4 + 2], acc[4 * g4 + 3]));
          }
        }
      };
      gemm_tile<2>(al, (const u16*)(p.ws + WS_WMKV), DM, DM, m0, n0, epi, smem);
    }
  }
}

template <int PER>
DI void scan_one(const float* src0, int n0, const float* src1, int n, float* dst, float* part) {
  const int tid = threadIdx.x;
  const int s0 = tid * PER;
  float v[PER];
#pragma unroll
  for (int i = 0; i < PER; ++i) { const int s = s0 + i; v[i] = (s < n) ? ((s < n0) ? src0[(size_t)s * 8] : src1[(size_t)(s - n0) * 8]) : 0.f; }
  float loc = 0.f;
#pragma unroll
  for (int i = 0; i < PER; ++i) loc += v[i];
  part[tid] = loc;
  __syncthreads();
  float run = 0.f;
  for (int i = 0; i < tid; ++i) run += part[i];
#pragma unroll
  for (int i = 0; i < PER; ++i) { run += v[i]; if (s0 + i < n) dst[s0 + i] = -run * LOG2E; }
  __syncthreads();
}
DI void phase_scan(const Params& p, char* smem) {
  float* part = (float*)smem;
  for (int it = blockIdx.x; it < 256; it += gridDim.x) {
    const int bh = it & 127, b = bh >> 3, h = bh & 7;
    if (it < 128) scan_one<17>(p.c_fx_logf + (size_t)b * PAST * 8 + h, PAST, p.out + OUT_LF_S + (size_t)b * DSEQ * 8 + h, PAST + DSEQ, (float*)(p.ws + WS_CBS) + (size_t)bh * 4160, part);
    else scan_one<8>(p.out + OUT_LF_P + (size_t)b * SEQ * 8 + h, SEQ, nullptr, SEQ, (float*)(p.ws + WS_CBP) + (size_t)bh * 2048, part);
  }
}

constexpr int KLD = 72, VLD = 68;
struct SmemAttn { u16 k[2][64 * KLD]; u16 vt[2][64 * VLD]; float cb[4160]; float part[256]; u16 q[128 * KLD]; };
static_assert(sizeof(SmemAttn) <= SMEM_BYTES, "attn smem");

struct KVRegs { float4 k[4], v[4]; };
DI void kv_fetch(KVRegs& r, const float* kb, const float* vb, int tid) {
#pragma unroll
  for (int i = 0; i < 4; ++i) { const int c = tid + 256 * i; const size_t o = (size_t)(c >> 4) * 512 + (c & 15) * 4; const nf4 tk = ld_nt(kb + o), tv = ld_nt(vb + o); r.k[i] = make_float4(tk[0], tk[1], tk[2], tk[3]); r.v[i] = make_float4(tv[0], tv[1], tv[2], tv[3]); }
}
DI void kv_stash(const KVRegs& r, u16* ks, u16* vts, int tid) {
#pragma unroll
  for (int i = 0; i < 4; ++i) {
    const int c = tid + 256 * i; const int row = c >> 4, c4 = (c & 15) * 4;
    *(uint2*)(ks + row * KLD + c4) = make_uint2(pk2(r.k[i].x, r.k[i].y), pk2(r.k[i].z, r.k[i].w));
    vts[(c4 + 0) * VLD + row] = bf1(r.v[i].x); vts[(c4 + 1) * VLD + row] = bf1(r.v[i].y);
    vts[(c4 + 2) * VLD + row] = bf1(r.v[i].z); vts[(c4 + 3) * VLD + row] = bf1(r.v[i].w);
  }
}
typedef unsigned kv_u32x4 __attribute__((ext_vector_type(4)));
typedef unsigned kv_u32x2 __attribute__((ext_vector_type(2)));
struct KV16 { kv_u32x4 k0, k1, v0, v1; };
DI void kv_fetch16(KV16& r, const u16* kb, const u16* vtb, int tid) {
  const int c0 = tid, c1 = tid + 256;
  r.k0 = *(const kv_u32x4*)(kb + (size_t)(c0 >> 3) * 512 + (c0 & 7) * 8); r.k1 = *(const kv_u32x4*)(kb + (size_t)(c1 >> 3) * 512 + (c1 & 7) * 8);
  r.v0 = *(const kv_u32x4*)(vtb + (size_t)(c0 >> 3) * SEQ + (c0 & 7) * 8); r.v1 = *(const kv_u32x4*)(vtb + (size_t)(c1 >> 3) * SEQ + (c1 & 7) * 8);
}
DI void kv_stash16(const KV16& r, u16* ks, u16* vts, int tid) {
  const int c0 = tid, c1 = tid + 256;
  *(kv_u32x4*)(ks + (c0 >> 3) * KLD + (c0 & 7) * 8) = r.k0;
  *(kv_u32x4*)(ks + (c1 >> 3) * KLD + (c1 & 7) * 8) = r.k1;
  kv_u32x2 a = {r.v0[0], r.v0[1]}, b2 = {r.v0[2], r.v0[3]}, c = {r.v1[0], r.v1[1]}, d = {r.v1[2], r.v1[3]};
  *(kv_u32x2*)(vts + (c0 >> 3) * VLD + (c0 & 7) * 8) = a; *(kv_u32x2*)(vts + (c0 >> 3) * VLD + (c0 & 7) * 8 + 4) = b2;
  *(kv_u32x2*)(vts + (c1 >> 3) * VLD + (c1 & 7) * 8) = c; *(kv_u32x2*)(vts + (c1 >> 3) * VLD + (c1 & 7) * 8 + 4) = d;
}
DI bf16x8 pack8(const f32x16& x, int s) {
  union { unsigned u[4]; bf16x8 v; } t;
  t.u[0] = pk2(x[8 * s + 0], x[8 * s + 1]); t.u[1] = pk2(x[8 * s + 2], x[8 * s + 3]);
  t.u[2] = pk2(x[8 * s + 4], x[8 * s + 5]); t.u[3] = pk2(x[8 * s + 6], x[8 * s + 7]);
  return t.v;
}

template <bool FOX, bool SMP>
DI void attn_item(const Params& p, int b, int h, int qb, char* smem, bool do_ssq = true, int split = 0) {
  constexpr int smp = SMP ? 1 : 0;
  constexpr bool SPLIT = FOX && SMP;
  SmemAttn& sm = *(SmemAttn*)smem;
  const int tid = threadIdx.x, lane = tid & 63, wid = tid >> 6, r31 = lane & 31, hh = lane >> 5;
  const int jt0 = SPLIT ? split * 8 : 0;
  const int nkt = SPLIT ? (split == 7 ? 9 : 8) : (smp ? 65 : 2 * qb + 2);
  const int jdiag = smp ? 64 : 2 * qb;
  int qi = wid * 32 + r31; if (smp) qi &= 63;
  const int qpos = (smp ? PAST : qb * 128) + qi;
  const int g = smp ? NTP + b * DSEQ + qi : b * SEQ + qb * 128 + qi;
  const u16* Q = (const u16*)(p.ws + WS_D) + (FOX ? (size_t)NT * 512 : 0);
  {
#pragma unroll
    for (int i = 0; i < 4; ++i) {
      const int c = tid + 256 * i; const int row = c >> 3, kc = (c & 7) * 8;
      const int qr = smp ? (row & 63) : row;
      const int gr = smp ? NTP + b * DSEQ + qr : b * SEQ + qb * 128 + qr;
      *(kv_u32x4*)(sm.q + row * KLD + kc) = *(const kv_u32x4*)(Q + (size_t)gr * 512 + h * 64 + kc);
    }
    __syncthreads();
  }

  const float* kcache = FOX ? p.c_fx_k : p.c_sb_k;
  const float* vcache = FOX ? p.c_fx_v : p.c_sb_v;
  const size_t okp = FOX ? OUT_FXK_P : OUT_SBK_P, ovp = FOX ? OUT_FXV_P : OUT_SBV_P;
  const size_t oks = FOX ? OUT_FXK_S : OUT_SBK_S, ovs = FOX ? OUT_FXV_S : OUT_SBV_S;
  auto kptr = [&](int j) -> const float* {
    if (!smp) return p.out + okp + ((size_t)(b * SEQ + 64 * j) * 512 + h * 64);
    if (j < 64) return kcache + ((size_t)(b * PAST + 64 * j) * 512 + h * 64);
    return p.out + oks + ((size_t)(b * DSEQ) * 512 + h * 64);
  };
  auto vptr = [&](int j) -> const float* {
    if (!smp) return p.out + ovp + ((size_t)(b * SEQ + 64 * j) * 512 + h * 64);
    if (j < 64) return vcache + ((size_t)(b * PAST + 64 * j) * 512 + h * 64);
    return p.out + ovs + ((size_t)(b * DSEQ) * 512 + h * 64);
  };

  if (FOX) {
    const float4* src = (const float4*)(smp ? (const float*)(p.ws + WS_CBS) + (size_t)(b * 8 + h) * 4160 : (const float*)(p.ws + WS_CBP) + (size_t)(b * 8 + h) * 2048);
    for (int i = jt0 * 16 + tid; i < (jt0 + nkt) * 16; i += 256) ((float4*)sm.cb)[i] = src[i];
    __syncthreads();
  }

  bf16x8 tri[2];
  if (!FOX) {
#pragma unroll
    for (int s = 0; s < 2; ++s)
#pragma unroll
      for (int j = 0; j < 8; ++j) { const int kin = 16 * s + 8 * (j >> 2) + 4 * hh + (j & 3); tri[s][j] = (kin >= r31) ? (short)0x3F80 : (short)0; }
  }

  f32x16 o[2];
#pragma unroll
  for (int d = 0; d < 2; ++d)
#pragma unroll
    for (int e = 0; e < 16; ++e) o[d][e] = 0.f;
  float mrun = -1e30f, lrun = 0.f, R = 0.f;

  KVRegs kv;
  KV16 kw;
  const int jfirst = FOX ? jt0 : nkt - 1;
  const u16* k16 = (const u16*)(p.ws + WS_A) + (FOX ? (size_t)NTP * 512 : 0) + (size_t)(b * SEQ) * 512 + h * 64;
  const u16* vt16 = (const u16*)(p.ws + WS_B) + (FOX ? (size_t)NTP * 512 : 0) + (size_t)((b * 8 + h) * 64) * SEQ;
  if (smp) { kv_fetch(kv, kptr(jfirst), vptr(jfirst), tid); kv_stash(kv, sm.k[0], sm.vt[0], tid); }
  else { kv_fetch16(kw, k16 + (size_t)(64 * jfirst) * 512, vt16 + 64 * jfirst, tid); kv_stash16(kw, sm.k[0], sm.vt[0], tid); }
  __syncthreads();
  for (int it = 0; it < nkt; ++it) {
    const int j = FOX ? jt0 + it : nkt - 1 - it;
    const int cur = it & 1;
    if (it + 1 < nkt) { const int jn = FOX ? j + 1 : j - 1; if (smp) kv_fetch(kv, kptr(jn), vptr(jn), tid); else kv_fetch16(kw, k16 + (size_t)(64 * jn) * 512, vt16 + 64 * jn, tid); }
    f32x16 s[2];
#pragma unroll
    for (int t2 = 0; t2 < 2; ++t2) {
#pragma unroll
      for (int e = 0; e < 16; ++e) s[t2][e] = 0.f;
      const u16* pk = sm.k[cur] + (t2 * 32 + r31) * KLD + hh * 8;
      const u16* pq = sm.q + (wid * 32 + r31) * KLD + hh * 8;
#pragma unroll
      for (int kk = 0; kk < 4; ++kk) { const bf16x8 a = *(const bf16x8*)(pk + kk * 16); const bf16x8 qv = *(const bf16x8*)(pq + kk * 16); s[t2] = MFMA(a, qv, s[t2]); }
    }
    const bool diag = j >= jdiag;
    const int kbase = 64 * j + 4 * hh;
    if (FOX) {
      float mloc = -1e30f;
#pragma unroll
      for (int t2 = 0; t2 < 2; ++t2) {
        f32x16 bvec;
#pragma unroll
        for (int g4 = 0; g4 < 4; ++g4) {
          const float4 bb = *(const float4*)(sm.cb + 64 * j + 32 * t2 + 8 * g4 + 4 * hh);
          bvec[4 * g4] = bb.x; bvec[4 * g4 + 1] = bb.y; bvec[4 * g4 + 2] = bb.z; bvec[4 * g4 + 3] = bb.w;
        }
        s[t2] = s[t2] * LOG2E + bvec;
      }
      if (diag) {
#pragma unroll
        for (int t2 = 0; t2 < 2; ++t2)
#pragma unroll
          for (int e = 0; e < 16; ++e) if (kbase + 32 * t2 + ACC_ROW(e, 0) > qpos) s[t2][e] = -1e30f;
      }
#pragma unroll
      for (int t2 = 0; t2 < 2; ++t2)
#pragma unroll
        for (int e = 0; e < 16; ++e) mloc = fmaxf(mloc, s[t2][e]);
      mloc = fmaxf(mloc, __shfl_xor(mloc, 32));
      const float mnew = fmaxf(mrun, mloc);
      const float alpha = __builtin_amdgcn_exp2f(mrun - mnew);
      mrun = mnew;
      float ls = 0.f;
#pragma unroll
      for (int t2 = 0; t2 < 2; ++t2) {
        s[t2] = s[t2] - mnew;
#pragma unroll
        for (int e = 0; e < 16; ++e) { const float pv = __builtin_amdgcn_exp2f(s[t2][e]); s[t2][e] = pv; ls += pv; }
      }
      lrun = lrun * alpha + ls;
#pragma unroll
      for (int d = 0; d < 2; ++d) o[d] = o[d] * alpha;
    } else {
#pragma unroll
      for (int t2 = 1; t2 >= 0; --t2) {
        f32x16 lk;
#pragma unroll
        for (int e = 0; e < 16; ++e) {
          const float z = s[t2][e];
          const float sp = fmaxf(z, 0.f) + __logf(1.f + __expf(-fabsf(z)));
          const bool vis = !diag || (kbase + 32 * t2 + ACC_ROW(e, 0) < qpos);
          lk[e] = vis ? -sp : 0.f;
        }
        bf16x8 fh[2], fl[2];
#pragma unroll
        for (int sI = 0; sI < 2; ++sI) fh[sI] = pack8(lk, sI);
#pragma unroll
        for (int e = 0; e < 16; ++e) lk[e] -= __uint_as_float(((unsigned)(u16)fh[e >> 3][e & 7]) << 16);
#pragma unroll
        for (int sI = 0; sI < 2; ++sI) fl[sI] = pack8(lk, sI);
        f32x16 inc;
#pragma unroll
        for (int e = 0; e < 16; ++e) inc[e] = R;
#pragma unroll
        for (int sI = 0; sI < 2; ++sI) { inc = MFMA(tri[sI], fh[sI], inc); inc = MFMA(tri[sI], fl[sI], inc); }
#pragma unroll
        for (int e = 0; e < 16; ++e) {
          const bool vis = !diag || (kbase + 32 * t2 + ACC_ROW(e, 0) < qpos);
          const float w = __builtin_amdgcn_exp2f((s[t2][e] + inc[e]) * LOG2E);
          s[t2][e] = vis ? w : 0.f;
        }
        R = __shfl(inc[0], r31);
      }
    }
#pragma unroll
    for (int t2 = 0; t2 < 2; ++t2)
#pragma unroll
      for (int sI = 0; sI < 2; ++sI) {
        const bf16x8 pf = pack8(s[t2], sI);
#pragma unroll
        for (int d = 0; d < 2; ++d) {
          const u16* pv = sm.vt[cur] + (d * 32 + r31) * VLD + 32 * t2 + 16 * sI + 4 * hh;
          union { s16x4 q[2]; bf16x8 v; } a;
          a.q[0] = *(const s16x4*)(pv); a.q[1] = *(const s16x4*)(pv + 8);
          o[d] = MFMA(a.v, pf, o[d]);
        }
      }
    if (it + 1 < nkt) { if (smp) kv_stash(kv, sm.k[cur ^ 1], sm.vt[cur ^ 1], tid); else kv_stash16(kw, sm.k[cur ^ 1], sm.vt[cur ^ 1], tid); }
#if SB_EXIT
    if (!FOX) { if (__syncthreads_and(R < -110.f)) break; } else __syncthreads();
#else
    __syncthreads();
#endif
  }
  if (SPLIT) {
    constexpr int NS = 8;
    const int bh = b * 8 + h;
    float* po = (float*)(p.ws + WS_F) + (size_t)(bh * NS) * 4096;
    float* pml = (float*)(p.ws + WS_F) + (size_t)128 * NS * 4096 + (size_t)(bh * NS) * 128;
    const float lt = lrun + __shfl_xor(lrun, 32);
    if (wid < 2) {
      float* dst = po + (size_t)split * 4096 + qi * 64;
#pragma unroll
      for (int d = 0; d < 2; ++d)
#pragma unroll
        for (int g4 = 0; g4 < 4; ++g4) *(float4*)(dst + d * 32 + 8 * g4 + 4 * hh) = make_float4(o[d][4 * g4], o[d][4 * g4 + 1], o[d][4 * g4 + 2], o[d][4 * g4 + 3]);
      if (hh == 0) *(float2*)(pml + (size_t)split * 128 + qi * 2) = make_float2(mrun, lt);
    }
    int* slot2 = (int*)(smem + 73728 + 528);
    asm volatile("s_waitcnt vmcnt(0)" ::: "memory");
    __syncthreads();
    if (tid == 0) {
      __builtin_amdgcn_fence(__ATOMIC_RELEASE, "agent");
      asm volatile("s_waitcnt vmcnt(0)" ::: "memory");
      const unsigned old = __hip_atomic_fetch_add((unsigned*)(p.ws + WS_BAR + 256) + bh + (do_ssq ? 0 : 128), 1u, __ATOMIC_RELAXED, __HIP_MEMORY_SCOPE_AGENT);
      __builtin_amdgcn_fence(__ATOMIC_ACQUIRE, "agent");
      asm volatile("s_waitcnt vmcnt(0)" ::: "memory");
      *slot2 = (int)old;
    }
    __syncthreads();
    const bool last = (*slot2 == NS - 1);
    __syncthreads();
    if (last) {
      const int q = tid >> 2, d0 = (tid & 3) * 16;
      float ms[NS], ls[NS], M = -1e30f;
#pragma unroll
      for (int s2 = 0; s2 < NS; ++s2) { const float2 ml = *(const float2*)(pml + (size_t)s2 * 128 + q * 2); ms[s2] = ml.x; ls[s2] = ml.y; M = fmaxf(M, ml.x); }
      float L = 0.f, acc[16];
#pragma unroll
      for (int k = 0; k < 16; ++k) acc[k] = 0.f;
#pragma unroll
      for (int s2 = 0; s2 < NS; ++s2) {
        const float w = exp2f(ms[s2] - M);
        L += ls[s2] * w;
        const float4* src = (const float4*)(po + (size_t)s2 * 4096 + q * 64 + d0);
#pragma unroll
        for (int k4 = 0; k4 < 4; ++k4) { const float4 v = src[k4]; acc[4 * k4] += w * v.x; acc[4 * k4 + 1] += w * v.y; acc[4 * k4 + 2] += w * v.z; acc[4 * k4 + 3] += w * v.w; }
      }
      const float invL = 1.f / L;
      float ssq = 0.f;
#pragma unroll
      for (int k = 0; k < 16; ++k) { acc[k] *= invL; ssq += acc[k] * acc[k]; }
      ssq += __shfl_xor(ssq, 1); ssq += __shfl_xor(ssq, 2);
      const int gq = NTP + b * DSEQ + q;
      if (do_ssq && (tid & 3) == 0) atomicAdd((float*)(p.ws + WS_SSQ) + (size_t)gq * 2 + 1, ssq);
      u16* od = (u16*)(p.ws + WS_E) + (size_t)gq * DM + 512 + h * 64 + d0;
      *(uint4*)od = make_uint4(pk2(acc[0], acc[1]), pk2(acc[2], acc[3]), pk2(acc[4], acc[5]), pk2(acc[6], acc[7]));
      *(uint4*)(od + 8) = make_uint4(pk2(acc[8], acc[9]), pk2(acc[10], acc[11]), pk2(acc[12], acc[13]), pk2(acc[14], acc[15]));
    }
    return;
  }
  float inv = 1.f;
  if (FOX) { const float lt = lrun + __shfl_xor(lrun, 32); inv = 1.f / lt; }
  {
    float ssq = 0.f;
#pragma unroll
    for (int d = 0; d < 2; ++d)
#pragma unroll
      for (int e = 0; e < 16; ++e) { const float t = o[d][e] * inv; ssq += t * t; }
    ssq += __shfl_xor(ssq, 32);
    if (do_ssq && hh == 0 && (!smp || wid < 2)) atomicAdd((float*)(p.ws + WS_SSQ) + (size_t)g * 2 + (FOX ? 1 : 0), ssq);
  }
  if (!smp || wid < 2) {
    u16* od = (u16*)(p.ws + WS_E) + (size_t)g * DM + (FOX ? 512 : 0) + h * 64;
#pragma unroll
    for (int d = 0; d < 2; ++d)
#pragma unroll
      for (int g4 = 0; g4 < 4; ++g4)
        *(uint2*)(od + d * 32 + 8 * g4 + 4 * hh) = make_uint2(pk2(o[d][4 * g4] * inv, o[d][4 * g4 + 1] * inv), pk2(o[d][4 * g4 + 2] * inv, o[d][4 * g4 + 3] * inv));
  }
}

template <class F>
DI void attn_queue(unsigned* ctr, int n, int* slot, F body) {
  for (;;) {
    if (threadIdx.x == 0) *slot = (int)atomicAdd(ctr, 1u);
    __syncthreads();
    const int it = *slot;
    __syncthreads();
    if (it >= n) break;
    body(it);
  }
}
DI void phase_attn(const Params& p, char* smem, int rep = 0) {
  unsigned* ctr = (unsigned*)(p.ws + WS_BAR + 128) + rep * 4;
  int* slot = (int*)(smem + 73728 + 512);
  const bool dq = rep == 0;
  attn_queue(ctr + 0, 1024, slot, [&](int it) { const int bh = it >> 3; attn_item<true, true>(p, bh >> 3, bh & 7, 0, smem, dq, it & 7); });
  attn_queue(ctr + 1, 2048, slot, [&](int u) { const int w = u & 511; const int qb = 15 - (w >> 5), bh = (u >> 9) * 32 + (w & 31); attn_item<true, false>(p, bh >> 3, bh & 7, qb, smem, dq); });
  attn_queue(ctr + 2, 128, slot, [&](int u) { attn_item<false, true>(p, u >> 3, u & 7, 0, smem, dq); });
  attn_queue(ctr + 3, 2048, slot, [&](int u) { const int w = u & 511; const int qb = 15 - (w >> 5), bh = (u >> 9) * 32 + (w & 31); attn_item<false, false>(p, bh >> 3, bh & 7, qb, smem, dq); });
}

DI void phase_wout(const Params& p, char* smem) {
  u16* pre = (u16*)(p.ws + WS_A);
  const u16* o = (const u16*)(p.ws + WS_E);
  float* sc_s = (float*)(smem + 73728);
  for_tiles(DM, [&](int m0, int n0, auto tag) {
    constexpr int MI = decltype(tag)::value;
    {
      const int tid = threadIdx.x;
      if (tid < MI * 64) {
        const float2 q = ((const float2*)(p.ws + WS_SSQ))[m0 + tid];
        const float s0 = rsqrtf(q.x * (1.f / 512.f) + 1e-6f), s1 = rsqrtf(q.y * (1.f / 512.f) + 1e-6f);
        sc_s[tid * 2] = s0 / s1; sc_s[tid * 2 + 1] = s1;
      }
      __syncthreads();
    }
    GldsBf16<MI * 64> al; al.base = o + (size_t)m0 * DM; al.ld = DM;
    const u16* xr = (const u16*)(p.ws + WS_C) + (size_t)m0 * DM;
    auto epi = [=](int r0, int c0, const f32x16& acc) {
      const int lane = threadIdx.x & 63, hh = lane >> 5, col = c0 + (lane & 31);
      const unsigned b0 = (unsigned)(r0 + 4 * hh) * 1024u + col, b1 = (unsigned)(r0 - m0 + 4 * hh) * 1024u + col;
      store_bf16_pairs_res(pre, b0, acc, xr, b1);
    };
    gemm_tile<MI, true>(al, (const u16*)(p.ws + WS_WOUT), DM, DM, m0, n0, epi, smem, sc_s);
  });
}

DI void phase_ln(const Params& p, const float* gam, const float* bet) {
  const u16* pre = (const u16*)(p.ws + WS_A);
  u16* xb = (u16*)(p.ws + WS_C);
  const int lane = threadIdx.x & 63;
  const int wg = blockIdx.x * 4 + (threadIdx.x >> 6), nw = gridDim.x * 4;
  for (int row0 = wg * 2; row0 < NT; row0 += nw * 2) {
    float4 v[2][4];
    float s[2], q[2];
#pragma unroll
    for (int r = 0; r < 2; ++r) {
      s[r] = 0.f;
#pragma unroll
      for (int j = 0; j < 4; ++j) { const uint2 w = ((const uint2*)(pre + (size_t)(row0 + r) * DM))[lane + 64 * j]; v[r][j] = make_float4(bflo(w.x), bfhi(w.x), bflo(w.y), bfhi(w.y)); s[r] += v[r][j].x + v[r][j].y + v[r][j].z + v[r][j].w; }
    }
#pragma unroll
    for (int o = 32; o >= 1; o >>= 1)
#pragma unroll
      for (int r = 0; r < 2; ++r) s[r] += __shfl_xor(s[r], o);
#pragma unroll
    for (int r = 0; r < 2; ++r) {
      s[r] *= (1.f / 1024.f); q[r] = 0.f;
#pragma unroll
      for (int j = 0; j < 4; ++j) { const float a = v[r][j].x - s[r], b2 = v[r][j].y - s[r], c = v[r][j].z - s[r], d = v[r][j].w - s[r]; q[r] += a * a + b2 * b2 + c * c + d * d; }
    }
#pragma unroll
    for (int o = 32; o >= 1; o >>= 1)
#pragma unroll
      for (int r = 0; r < 2; ++r) q[r] += __shfl_xor(q[r], o);
#pragma unroll
    for (int r = 0; r < 2; ++r) {
      const float mu = s[r], rs = rsqrtf(q[r] * (1.f / 1024.f) + 1e-5f);
#pragma unroll
      for (int j = 0; j < 4; ++j) {
        const float4 gg = ((const float4*)gam)[lane + 64 * j], bb = ((const float4*)bet)[lane + 64 * j];
        float4 y;
        y.x = (v[r][j].x - mu) * rs * gg.x + bb.x; y.y = (v[r][j].y - mu) * rs * gg.y + bb.y;
        y.z = (v[r][j].z - mu) * rs * gg.z + bb.z; y.w = (v[r][j].w - mu) * rs * gg.w + bb.w;
        ((uint2*)(xb + (size_t)(row0 + r) * DM))[lane + 64 * j] = make_uint2(pk2(y.x, y.y), pk2(y.z, y.w));
      }
    }
  }
}

template <bool NOEPI = false>
DI void phase_gemm_bf16(const Params& p, const u16* A, const u16* Wt, int N, u16* O, float scale, char* smem) {
  for_tiles(N, [&](int m0, int n0, auto tag) {
    constexpr int MI = decltype(tag)::value;
    GldsBf16<MI * 64> al; al.base = A + (size_t)m0 * DM; al.ld = DM;
    auto epi = [=](int r0, int c0, const f32x16& acc) {
      const int lane = threadIdx.x & 63, hh = lane >> 5, col = c0 + (lane & 31);
      const unsigned b0 = (unsigned)(r0 + 4 * hh) * (unsigned)N + col;
      if (NOEPI) { float t = 0.f;
#pragma unroll
        for (int e = 0; e < 16; ++e) t += acc[e];
        if (t == 12345.678f) O[b0] = bf1(t);
        return; }
#pragma unroll
      for (int e = 0; e < 16; ++e) O[b0 + ACC_R0(e) * (unsigned)N] = bf1(acc[e] * scale);
    };
    gemm_tile<MI>(al, Wt, DM, DM, m0, n0, epi, smem);
  });
}

template <class F>
DI void for_mem_tiles(F body) {
  const int vb = vblock(), nb = gridDim.x;
  for (int t = vb; t < 2048 + 256; t += nb) {
    if (t < 2048) { const int mt = t >> 3; body(mt * 128, (t >> 1) & 3, (t & 1) * 128, mt >> 4, IC<2>{}); }
    else { const int u = t - 2048; const int mt = u >> 4; body(NTP + mt * 64, (u >> 2) & 3, (u & 3) * 64, 16 + mt, IC<1>{}); }
  }
}
DI void phase_mem_s(const Params& p, char* smem) {
  const u16* qm = (const u16*)(p.ws + WS_D);
  u16* S = (u16*)(p.ws + WS_F);
  for_mem_tiles([&](int m0, int hd, int n0, int batch, auto tag) {
    constexpr int MI = decltype(tag)::value;
    GldsBf16<MI * 64> al; al.base = qm + (size_t)m0 * DM + hd * 256; al.ld = DM;
    const u16* Bt = (const u16*)(p.ws + WS_MEMK) + (size_t)batch * 256 * DM + hd * 256;
    auto epi = [=](int r0, int c0, const f32x16& acc) {
      const int lane = threadIdx.x & 63, hh = lane >> 5, col = c0 + (lane & 31);
      const unsigned b0 = (unsigned)(r0 + 4 * hh) * 1024u + hd * 256 + col;
      store_bf16_pairs(S, b0, 1024u, acc, 1.f);
    };
    gemm_tile<MI>(al, Bt, DM, 256, m0, n0, epi, smem);
  });
}
DI void phase_mem_softmax(const Params& p) {
  const u16* S = (const u16*)(p.ws + WS_F);
  u16* P = (u16*)(p.ws + WS_D);
  const int lane = threadIdx.x & 63;
  const int wg = blockIdx.x * 4 + (threadIdx.x >> 6), nw = gridDim.x * 4;
  for (int row0 = wg * 8; row0 < NT * 4; row0 += nw * 8) {
    float4 v[8]; float m[8], sm[8];
#pragma unroll
    for (int r = 0; r < 8; ++r) { const uint2 w = ((const uint2*)(S + (size_t)(row0 + r) * 256))[lane]; v[r] = make_float4(bflo(w.x), bfhi(w.x), bflo(w.y), bfhi(w.y)); }
#pragma unroll
    for (int r = 0; r < 8; ++r) m[r] = fmaxf(fmaxf(v[r].x, v[r].y), fmaxf(v[r].z, v[r].w));
#pragma unroll
    for (int o = 32; o >= 1; o >>= 1)
#pragma unroll
      for (int r = 0; r < 8; ++r) m[r] = fmaxf(m[r], __shfl_xor(m[r], o));
#pragma unroll
    for (int r = 0; r < 8; ++r) { v[r].x = __expf(v[r].x - m[r]); v[r].y = __expf(v[r].y - m[r]); v[r].z = __expf(v[r].z - m[r]); v[r].w = __expf(v[r].w - m[r]); sm[r] = v[r].x + v[r].y + v[r].z + v[r].w; }
#pragma unroll
    for (int o = 32; o >= 1; o >>= 1)
#pragma unroll
      for (int r = 0; r < 8; ++r) sm[r] += __shfl_xor(sm[r], o);
#pragma unroll
    for (int r = 0; r < 8; ++r) { const float inv = 1.f / sm[r]; ((uint2*)(P + (size_t)(row0 + r) * 256))[lane] = make_uint2(pk2(v[r].x * inv, v[r].y * inv), pk2(v[r].z * inv, v[r].w * inv)); }
  }
}
DI void phase_mem_pv(const Params& p, char* smem) {
  const u16* P = (const u16*)(p.ws + WS_D);
  u16* om = (u16*)(p.ws + WS_E);
  for_mem_tiles([&](int m0, int hd, int n0, int batch, auto tag) {
    constexpr int MI = decltype(tag)::value;
    GldsBf16<MI * 64> al; al.base = P + (size_t)m0 * DM + hd * 256; al.ld = DM;
    const u16* Bt = (const u16*)(p.ws + WS_MEMVT) + ((size_t)batch * DM + hd * 256) * 256;
    auto epi = [=](int r0, int c0, const f32x16& acc) {
      const int lane = threadIdx.x & 63, hh = lane >> 5, col = c0 + (lane & 31);
      const unsigned b0 = (unsigned)(r0 + 4 * hh) * 1024u + hd * 256 + col;
#pragma unroll
      for (int e = 0; e < 16; ++e) om[b0 + ACC_R0(e) * 1024u] = bf1(acc[e]);
    };
    gemm_tile<MI>(al, Bt, 256, 256, m0, n0, epi, smem);
  });
}
DI void phase_wmo(const Params& p, char* smem) {
  u16* pre = (u16*)(p.ws + WS_A);
  const u16* xbs = (const u16*)(p.ws + WS_C);
  const u16* om = (const u16*)(p.ws + WS_E);
  for_tiles(DM, [&](int m0, int n0, auto tag) {
    constexpr int MI = decltype(tag)::value;
    GldsBf16<MI * 64> al; al.base = om + (size_t)m0 * DM; al.ld = DM;
    auto epi = [=](int r0, int c0, const f32x16& acc) {
      const int lane = threadIdx.x & 63, hh = lane >> 5, col = c0 + (lane & 31);
      const unsigned b0 = (unsigned)(r0 + 4 * hh) * 1024u + col;
      store_bf16_pairs_res(pre, b0, acc, xbs, b0);
    };
    gemm_tile<MI>(al, (const u16*)(p.ws + WS_WMO), DM, DM, m0, n0, epi, smem);
  });
}

DI void insert16(float (&v)[16], float x) {
#pragma unroll
  for (int j = 15; j >= 1; --j) v[j] = __builtin_amdgcn_fmed3f(x, v[j - 1], v[j]);
  v[0] = fmaxf(v[0], x);
}
DI void phase_topk(const Params& p, char* smem) {
  const int vb = vblock(), nb = gridDim.x;
  const u16* qp = (const u16*)(p.ws + WS_F);
  int* idxo = (int*)(p.ws + WS_A);
  float* gato = (float*)(p.ws + WS_A + (size_t)NT * 128 * 4);
  float* sc = (float*)smem;
  const int tid = threadIdx.x;
  for (int t = vb; t < 264 * 8; t += nb) {
    const int mt = t >> 3, hd = t & 7;
    const int m0 = mt * 128;
    float va[16], vbv[16];
#pragma unroll
    for (int side = 0; side < 2; ++side) {
      GldsBf16<128> al; al.base = qp + (size_t)m0 * 2048 + hd * 256 + side * 128; al.ld = 2048;
      const u16* Bt = (const u16*)(p.ws + (side ? WS_KB : WS_KA)) + (size_t)hd * 128 * 128;
      auto epi = [=](int r0, int c0, const f32x16& acc) {
        const int lane = threadIdx.x & 63, hh = lane >> 5, col = c0 + (lane & 31);
#pragma unroll
        for (int e = 0; e < 16; ++e) sc[(r0 - m0 + ACC_ROW(e, hh)) * 129 + col] = acc[e];
      };
      gemm_tile<2>(al, Bt, 128, 128, m0, 0, epi, smem);
      __syncthreads();
      {
        const int row = tid & 127, half = tid >> 7;
        float* mg = (float*)(smem + 66048);
        float v[16];
#pragma unroll
        for (int j = 0; j < 16; ++j) v[j] = -INFINITY;
        for (int k = 64 * half; k < 64 * half + 64; ++k) {
          const float x = __uint_as_float((__float_as_uint(sc[row * 129 + k]) & ~0x7Fu) | (unsigned)k);
          insert16(v, x);
        }
        if (half == 1) {
#pragma unroll
          for (int j = 0; j < 16; ++j) mg[row * 17 + j] = v[j];
        }
        __syncthreads();
        if (half == 0) {
#pragma unroll
          for (int j = 0; j < 16; ++j) insert16(v, mg[row * 17 + j]);
#pragma unroll
          for (int j = 0; j < 16; ++j) { if (side == 0) va[j] = v[j]; else vbv[j] = v[j]; }
        }
      }
      __syncthreads();
    }
    unsigned char* ids = (unsigned char*)smem;
    if (tid < 128) {
#pragma unroll
      for (int j = 0; j < 16; ++j) { ids[tid * 32 + j] = (unsigned char)(__float_as_uint(va[j]) & 0x7F); ids[tid * 32 + 16 + j] = (unsigned char)(__float_as_uint(vbv[j]) & 0x7F); }
      float top[16];
#pragma unroll
      for (int j = 0; j < 16; ++j) top[j] = -INFINITY;
#pragma unroll
      for (int i = 0; i < 16; ++i)
#pragma unroll
        for (int j = 0; j < 16; ++j)
          if ((i + 1) * (j + 1) <= 16) {
            const float a = __uint_as_float(__float_as_uint(va[i]) & ~0x7Fu), b = __uint_as_float(__float_as_uint(vbv[j]) & ~0x7Fu);
            const float c = __uint_as_float((__float_as_uint(a + b) & ~0xFFu) | (unsigned)(i * 16 + j));
            insert16(top, c);
          }
      const float m = __uint_as_float(__float_as_uint(top[0]) & ~0xFFu);
      float ex[16], ssum = 0.f;
      int eid[16];
#pragma unroll
      for (int j = 0; j < 16; ++j) {
        const unsigned bits = __float_as_uint(top[j]);
        const int code = bits & 0xFF;
        ex[j] = __expf(__uint_as_float(bits & ~0xFFu) - m); ssum += ex[j];
        eid[j] = (int)ids[tid * 32 + (code >> 4)] * 128 + (int)ids[tid * 32 + 16 + (code & 15)];
      }
      const float inv = 1.f / ssum;
      const size_t ob = (size_t)(m0 + tid) * 128 + hd * 16;
#pragma unroll
      for (int j4 = 0; j4 < 4; ++j4) {
        *(int4*)(idxo + ob + 4 * j4) = make_int4(eid[4 * j4], eid[4 * j4 + 1], eid[4 * j4 + 2], eid[4 * j4 + 3]);
        *(float4*)(gato + ob + 4 * j4) = make_float4(ex[4 * j4] * inv, ex[4 * j4 + 1] * inv, ex[4 * j4 + 2] * inv, ex[4 * j4 + 3] * inv);
      }
    }
    __syncthreads();
  }
}

#if USE_FP8
typedef float f32x2v __attribute__((ext_vector_type(2)));
DI void unpack16(const uint4& v, float (&f)[16]) {
  const unsigned w[4] = {v.x, v.y, v.z, v.w};
#pragma unroll
  for (int j = 0; j < 4; ++j) {
    const f32x2v lo = __builtin_amdgcn_cvt_pk_f32_fp8((int)w[j], false), hi = __builtin_amdgcn_cvt_pk_f32_fp8((int)w[j], true);
    f[4 * j] = lo[0]; f[4 * j + 1] = lo[1]; f[4 * j + 2] = hi[0]; f[4 * j + 3] = hi[1];
  }
}
DI void peer_dot8(const char* U, int idreg, int e0, int lane, const float (&x)[16], float& dacc) {
  uint4 w[8];
#pragma unroll
  for (int j = 0; j < 8; ++j) { const int id = __builtin_amdgcn_readlane(idreg, e0 + j); w[j] = *(const uint4*)(U + (size_t)id * DM + 16 * lane); }
  float s[8];
#pragma unroll
  for (int j = 0; j < 8; ++j) {
    float f[16]; unpack16(w[j], f);
    float a = 0.f;
#pragma unroll
    for (int k = 0; k < 16; ++k) a += f[k] * x[k];
    s[j] = a;
  }
  const bool b5 = lane & 32, b4 = lane & 16, b3 = lane & 8;
  float t4[4], t2[2], t1;
#pragma unroll
  for (int i = 0; i < 4; ++i) { const float snd = b5 ? s[i] : s[4 + i], kp = b5 ? s[4 + i] : s[i]; t4[i] = kp + __shfl_xor(snd, 32); }
#pragma unroll
  for (int i = 0; i < 2; ++i) { const float snd = b4 ? t4[i] : t4[2 + i], kp = b4 ? t4[2 + i] : t4[i]; t2[i] = kp + __shfl_xor(snd, 16); }
  { const float snd = b3 ? t2[0] : t2[1], kp = b3 ? t2[1] : t2[0]; t1 = kp + __shfl_xor(snd, 8); }
  t1 += __shfl_xor(t1, 4); t1 += __shfl_xor(t1, 2); t1 += __shfl_xor(t1, 1);
  const float g = __shfl(t1, (lane & 7) * 8);
  if ((lane >> 3) == (e0 >> 3)) dacc = g;
}
DI void peer_axpy8(const char* V, int idreg, float hreg, int e0, int lane, float (&acc)[16]) {
  uint4 w[8];
#pragma unroll
  for (int j = 0; j < 8; ++j) { const int id = __builtin_amdgcn_readlane(idreg, e0 + j); w[j] = *(const uint4*)(V + (size_t)id * DM + 16 * lane); }
#pragma unroll
  for (int j = 0; j < 8; ++j) {
    const float hs = __uint_as_float(__builtin_amdgcn_readlane(__float_as_uint(hreg), e0 + j));
    float f[16]; unpack16(w[j], f);
#pragma unroll
    for (int k = 0; k < 16; ++k) acc[k] += hs * f[k];
  }
}
DI void peer_sort(int& id0, int& id1, float& g0, float& g1, int lane) {
  unsigned k0 = ((unsigned)id0 << 7) | (unsigned)lane, k1 = ((unsigned)id1 << 7) | (unsigned)(lane + 64);
#pragma unroll
  for (int k = 2; k <= 128; k <<= 1) {
#pragma unroll
    for (int j = k >> 1; j >= 1; j >>= 1) {
      if (j == 64) {
        const unsigned lo = min(k0, k1), hi = max(k0, k1); k0 = lo; k1 = hi;
      } else {
        const unsigned p0 = (unsigned)__shfl_xor((int)k0, j), p1 = (unsigned)__shfl_xor((int)k1, j);
        const bool upper = (lane & j) != 0;
        const bool asc0 = ((lane & k) == 0), asc1 = (((lane + 64) & k) == 0);
        k0 = (upper == asc0) ? max(k0, p0) : min(k0, p0);
        k1 = (upper == asc1) ? max(k1, p1) : min(k1, p1);
      }
    }
  }
  const int s0 = k0 & 127, s1 = k1 & 127;
  const float a0 = __shfl(g0, s0 & 63), b0 = __shfl(g1, s0 & 63), a1 = __shfl(g0, s1 & 63), b1 = __shfl(g1, s1 & 63);
  g0 = (s0 < 64) ? a0 : b0; g1 = (s1 < 64) ? a1 : b1;
  id0 = (int)(k0 >> 7); id1 = (int)(k1 >> 7);
}
DI void peer_load(const Params& p, int row, int lane, float (&x)[16], int& id0, int& id1, float& g0, float& g1) {
  const int* idxo = (const int*)(p.ws + WS_A);
  const float* gato = (const float*)(p.ws + WS_A + (size_t)NT * 128 * 4);
  {
    const uint4* xr = (const uint4*)((const u16*)(p.ws + WS_C) + (size_t)row * DM) + 2 * lane;
    const uint4 a = xr[0], b = xr[1];
    x[0] = bflo(a.x); x[1] = bfhi(a.x); x[2] = bflo(a.y); x[3] = bfhi(a.y); x[4] = bflo(a.z); x[5] = bfhi(a.z); x[6] = bflo(a.w); x[7] = bfhi(a.w);
    x[8] = bflo(b.x); x[9] = bfhi(b.x); x[10] = bflo(b.y); x[11] = bfhi(b.y); x[12] = bflo(b.z); x[13] = bfhi(b.z); x[14] = bflo(b.w); x[15] = bfhi(b.w);
  }
  id0 = idxo[(size_t)row * 128 + lane]; id1 = idxo[(size_t)row * 128 + 64 + lane];
  g0 = gato[(size_t)row * 128 + lane]; g1 = gato[(size_t)row * 128 + 64 + lane];
  peer_sort(id0, id1, g0, g1, lane);
}
DI void peer_finish(const Params& p, int row, int lane, float (&acc)[16]) {
  float x[16];
  {
    const uint4* xr = (const uint4*)((const u16*)(p.ws + WS_C) + (size_t)row * DM) + 2 * lane;
    const uint4 a = xr[0], b = xr[1];
    x[0] = bflo(a.x); x[1] = bfhi(a.x); x[2] = bflo(a.y); x[3] = bfhi(a.y); x[4] = bflo(a.z); x[5] = bfhi(a.z); x[6] = bflo(a.w); x[7] = bfhi(a.w);
    x[8] = bflo(b.x); x[9] = bfhi(b.x); x[10] = bflo(b.y); x[11] = bfhi(b.y); x[12] = bflo(b.z); x[13] = bfhi(b.z); x[14] = bflo(b.w); x[15] = bfhi(b.w);
  }
  float s = 0.f;
#pragma unroll
  for (int k = 0; k < 16; ++k) { acc[k] = DN_ALPHA * x[k] + acc[k]; s += acc[k]; }
  const float mu = wave_sum(s) * (1.f / 1024.f);
  float q = 0.f;
#pragma unroll
  for (int k = 0; k < 16; ++k) { const float dd = acc[k] - mu; q += dd * dd; }
  const float rs = rsqrtf(wave_sum(q) * (1.f / 1024.f) + 1e-5f);
  float* y = (row < NTP) ? p.out + OUT_YP + (size_t)row * DM : p.out + OUT_YS + (size_t)(row - NTP) * DM;
#pragma unroll
  for (int j = 0; j < 4; ++j) {
    const float4 ga = ((const float4*)p.ln3_g)[4 * lane + j], ba = ((const float4*)p.ln3_b)[4 * lane + j];
    float4 ya;
    ya.x = (acc[4 * j + 0] - mu) * rs * ga.x + ba.x; ya.y = (acc[4 * j + 1] - mu) * rs * ga.y + ba.y;
    ya.z = (acc[4 * j + 2] - mu) * rs * ga.z + ba.z; ya.w = (acc[4 * j + 3] - mu) * rs * ga.w + ba.w;
    ((float4*)y)[4 * lane + j] = ya;
  }
}
DI float peer_gelu_gate(float d, float g) { return 0.5f * d * (1.f + erff(d * 0.7071067811865476f)) * g; }
DI void phase_peer(const Params& p, int rr0 = 0, int rr1 = 1 << 10) {
  const char* U = p.ws + WS_U;
  const char* V = p.ws + WS_V;
  const float* usc = (const float*)(p.ws + WS_USC);
  const float* vsc = (const float*)(p.ws + WS_VSC);
  const int lane = threadIdx.x & 63;
  const int wg = blockIdx.x * 4 + (threadIdx.x >> 6), nw = gridDim.x * 4;
  for (int rowA = wg + rr0 * 2 * nw; rowA < NT && rowA < wg + rr1 * 2 * nw; rowA += 2 * nw) {
    const bool hasB = rowA + nw < NT;
    const int rowB = hasB ? rowA + nw : rowA;
    asm volatile("" ::: "memory");
    float xA[16], xB[16];
    int a0, a1, b0, b1; float ga0, ga1, gb0, gb1;
    peer_load(p, rowA, lane, xA, a0, a1, ga0, ga1);
    peer_load(p, rowB, lane, xB, b0, b1, gb0, gb1);
    const float sua0 = usc[a0], sua1 = usc[a1], sva0 = vsc[a0], sva1 = vsc[a1];
    const float sub0 = usc[b0], sub1 = usc[b1], svb0 = vsc[b0], svb1 = vsc[b1];
    float da0 = 0.f, da1 = 0.f, db0 = 0.f, db1 = 0.f;
#pragma unroll 1
    for (int e0 = 0; e0 < 64; e0 += 8) { peer_dot8(U, a0, e0, lane, xA, da0); if (hasB) peer_dot8(U, b0, e0, lane, xB, db0); }
#pragma unroll 1
    for (int e0 = 0; e0 < 64; e0 += 8) { peer_dot8(U, a1, e0, lane, xA, da1); if (hasB) peer_dot8(U, b1, e0, lane, xB, db1); }
    const float ha0 = peer_gelu_gate(da0 * sua0, ga0) * sva0, ha1 = peer_gelu_gate(da1 * sua1, ga1) * sva1;
    const float hb0 = peer_gelu_gate(db0 * sub0, gb0) * svb0, hb1 = peer_gelu_gate(db1 * sub1, gb1) * svb1;
    float accA[16], accB[16];
#pragma unroll
    for (int k = 0; k < 16; ++k) { accA[k] = 0.f; accB[k] = 0.f; }
#pragma unroll 1
    for (int e0 = 0; e0 < 64; e0 += 8) { peer_axpy8(V, a0, ha0, e0, lane, accA); if (hasB) peer_axpy8(V, b0, hb0, e0, lane, accB); }
#pragma unroll 1
    for (int e0 = 0; e0 < 64; e0 += 8) { peer_axpy8(V, a1, ha1, e0, lane, accA); if (hasB) peer_axpy8(V, b1, hb1, e0, lane, accB); }
    peer_finish(p, rowA, lane, accA);
    if (hasB) peer_finish(p, rowB, lane, accB);
  }
}
#else
DI void unpack8(const uint4& v, float (&f)[8]) {
  f[0] = bflo(v.x); f[1] = bfhi(v.x); f[2] = bflo(v.y); f[3] = bfhi(v.y); f[4] = bflo(v.z); f[5] = bfhi(v.z); f[6] = bflo(v.w); f[7] = bfhi(v.w);
}
DI void phase_peer(const Params& p) {
  const float* xf = (const float*)(p.ws + WS_B);
  const int* idxo = (const int*)(p.ws + WS_A);
  const float* gato = (const float*)(p.ws + WS_A + (size_t)NT * 128 * 4);
  const u16* U = (const u16*)(p.ws + WS_U);
  const u16* V = (const u16*)(p.ws + WS_V);
  const int lane = threadIdx.x & 63;
  const int wg = blockIdx.x * 4 + (threadIdx.x >> 6), nw = gridDim.x * 4;
  for (int row = wg; row < NT; row += nw) {
    float x[16];
    {
      const float4* xr = (const float4*)(xf + (size_t)row * DM);
      const float4 a = xr[2 * lane], b = xr[2 * lane + 1], c = xr[128 + 2 * lane], d = xr[128 + 2 * lane + 1];
      x[0] = a.x; x[1] = a.y; x[2] = a.z; x[3] = a.w; x[4] = b.x; x[5] = b.y; x[6] = b.z; x[7] = b.w;
      x[8] = c.x; x[9] = c.y; x[10] = c.z; x[11] = c.w; x[12] = d.x; x[13] = d.y; x[14] = d.z; x[15] = d.w;
    }
    const int id0 = idxo[(size_t)row * 128 + lane], id1 = idxo[(size_t)row * 128 + 64 + lane];
    const float g0 = gato[(size_t)row * 128 + lane], g1 = gato[(size_t)row * 128 + 64 + lane];
    float d0 = 0.f, d1 = 0.f;
#pragma unroll 8
    for (int e = 0; e < 64; ++e) {
      const int id = __builtin_amdgcn_readlane(id0, e);
      const uint4* ur = (const uint4*)(U + (size_t)id * DM);
      const uint4 ua = ur[lane], ub = ur[64 + lane];
      float f[8], s = 0.f;
      unpack8(ua, f);
#pragma unroll
      for (int k = 0; k < 8; ++k) s += f[k] * x[k];
      unpack8(ub, f);
#pragma unroll
      for (int k = 0; k < 8; ++k) s += f[k] * x[8 + k];
      s = wave_sum(s);
      if (lane == e) d0 = s;
    }
#pragma unroll 8
    for (int e = 0; e < 64; ++e) {
      const int id = __builtin_amdgcn_readlane(id1, e);
      const uint4* ur = (const uint4*)(U + (size_t)id * DM);
      const uint4 ua = ur[lane], ub = ur[64 + lane];
      float f[8], s = 0.f;
      unpack8(ua, f);
#pragma unroll
      for (int k = 0; k < 8; ++k) s += f[k] * x[k];
      unpack8(ub, f);
#pragma unroll
      for (int k = 0; k < 8; ++k) s += f[k] * x[8 + k];
      s = wave_sum(s);
      if (lane == e) d1 = s;
    }
    const float h0 = 0.5f * d0 * (1.f + erff(d0 * 0.7071067811865476f)) * g0;
    const float h1 = 0.5f * d1 * (1.f + erff(d1 * 0.7071067811865476f)) * g1;
    float acc[16];
#pragma unroll
    for (int k = 0; k < 16; ++k) acc[k] = 0.f;
#pragma unroll 8
    for (int e = 0; e < 64; ++e) {
      const int id = __builtin_amdgcn_readlane(id0, e);
      const float hs = __uint_as_float(__builtin_amdgcn_readlane(__float_as_uint(h0), e));
      const uint4* vr = (const uint4*)(V + (size_t)id * DM);
      const uint4 va = vr[lane], vb2 = vr[64 + lane];
      float f[8];
      unpack8(va, f);
#pragma unroll
      for (int k = 0; k < 8; ++k) acc[k] += hs * f[k];
      unpack8(vb2, f);
#pragma unroll
      for (int k = 0; k < 8; ++k) acc[8 + k] += hs * f[k];
    }
#pragma unroll 8
    for (int e = 0; e < 64; ++e) {
      const int id = __builtin_amdgcn_readlane(id1, e);
      const float hs = __uint_as_float(__builtin_amdgcn_readlane(__float_as_uint(h1), e));
      const uint4* vr = (const uint4*)(V + (size_t)id * DM);
      const uint4 va = vr[lane], vb2 = vr[64 + lane];
      float f[8];
      unpack8(va, f);
#pragma unroll
      for (int k = 0; k < 8; ++k) acc[k] += hs * f[k];
      unpack8(vb2, f);
#pragma unroll
      for (int k = 0; k < 8; ++k) acc[8 + k] += hs * f[k];
    }
    float s = 0.f;
#pragma unroll
    for (int k = 0; k < 16; ++k) { acc[k] = DN_ALPHA * x[k] + acc[k]; s += acc[k]; }
    const float mu = wave_sum(s) * (1.f / 1024.f);
    float q = 0.f;
#pragma unroll
    for (int k = 0; k < 16; ++k) { const float dd = acc[k] - mu; q += dd * dd; }
    const float rs = rsqrtf(wave_sum(q) * (1.f / 1024.f) + 1e-5f);
    float* y = (row < NTP) ? p.out + OUT_YP + (size_t)row * DM : p.out + OUT_YS + (size_t)(row - NTP) * DM;
#pragma unroll
    for (int c = 0; c < 2; ++c) {
      const int off = c * 512 + lane * 8;
      const float4 ga = *(const float4*)(p.ln3_g + off), gb = *(const float4*)(p.ln3_g + off + 4);
      const float4 ba = *(const float4*)(p.ln3_b + off), bb = *(const float4*)(p.ln3_b + off + 4);
      float4 ya, yb;
      ya.x = (acc[8 * c + 0] - mu) * rs * ga.x + ba.x; ya.y = (acc[8 * c + 1] - mu) * rs * ga.y + ba.y;
      ya.z = (acc[8 * c + 2] - mu) * rs * ga.z + ba.z; ya.w = (acc[8 * c + 3] - mu) * rs * ga.w + ba.w;
      yb.x = (acc[8 * c + 4] - mu) * rs * gb.x + bb.x; yb.y = (acc[8 * c + 5] - mu) * rs * gb.y + bb.y;
      yb.z = (acc[8 * c + 6] - mu) * rs * gb.z + bb.z; yb.w = (acc[8 * c + 7] - mu) * rs * gb.w + bb.w;
      *(float4*)(y + off) = ya; *(float4*)(y + off + 4) = yb;
    }
  }
}

#endif

constexpr int NPHASE = 15;
template <int PH>
DI void run_phase(const Params& p, char* smem) {
  if (PH == 0) phase_prep(p, smem);
  else if (PH == 1) phase_proj(p, smem);
  else if (PH == 2) phase_scan(p, smem);
  else if (PH == 3) phase_attn(p, smem);
  else if (PH == 4) phase_wout(p, smem);
  else if (PH == 5) phase_ln(p, p.ln1_g, p.ln1_b);
  else if (PH == 6) phase_gemm_bf16(p, (const u16*)(p.ws + WS_C), (const u16*)(p.ws + WS_WMQ), 1024, (u16*)(p.ws + WS_D), 0.0625f, smem);
  else if (PH == 7) phase_mem_s(p, smem);
  else if (PH == 8) phase_mem_softmax(p);
  else if (PH == 9) phase_mem_pv(p, smem);
  else if (PH == 10) phase_wmo(p, smem);
  else if (PH == 11) phase_ln(p, p.ln2_g, p.ln2_b);
  else if (PH == 12) phase_gemm_bf16(p, (const u16*)(p.ws + WS_C), (const u16*)(p.ws + WS_WPQ), 2048, (u16*)(p.ws + WS_F), 1.f, smem);
  else if (PH == 13) phase_topk(p, smem);
  else if (PH == 14) phase_peer(p);
}

template <int PH>
__global__ void __launch_bounds__(256, 2) k_phase(Params p) {
  __shared__ __attribute__((aligned(16))) char smem[SMEM_BYTES];
  run_phase<PH>(p, smem);
}

#define XB_TMO      128
#define XB_XCNT(j)  (256  + 64 * (j))
#define XB_XSUB(j)  (1280 + 64 * (j))
#define XB_XGEN(j)  (2304 + 64 * (j))
#define XB_TOP      3328
#define XB_TOPGEN   3392
#define XB_SPIN_CAP (1u << 20)
DI unsigned xb_ld(unsigned* p) { return __hip_atomic_load(p, __ATOMIC_RELAXED, __HIP_MEMORY_SCOPE_AGENT); }
DI unsigned xb_add(unsigned* p, unsigned v) { return __hip_atomic_fetch_add(p, v, __ATOMIC_RELAXED, __HIP_MEMORY_SCOPE_AGENT); }
DI unsigned xb_xcc_id() { return (unsigned)__builtin_amdgcn_s_getreg((3 << 11) | 20) & 0xFu; }
#define XB_SPIN(cond, bar) do { unsigned _sp = 0; while (cond) { __builtin_amdgcn_s_sleep(1); \
    if ((++_sp & 255u) == 0u) { if (xb_ld(&(bar)[XB_TMO])) break; if (_sp > XB_SPIN_CAP) { atomicAdd(&(bar)[XB_TMO], 1u); break; } } } } while (0)
struct XcdBarrier { unsigned* bar; unsigned x; volatile unsigned* st; };
DI XcdBarrier xcd_barrier_post(unsigned* bar, volatile unsigned* st) {
  XcdBarrier b; b.bar = bar; b.x = xb_xcc_id(); b.st = st;
  if (threadIdx.x == 0) (void)xb_add(&bar[XB_XCNT(b.x)], 1u);
  return b;
}
DI void xcd_barrier_complete(unsigned* bar, unsigned x, unsigned& nloc, unsigned& nx) {
  const unsigned G = gridDim.x;
  unsigned sum, cnt, mine, sp = 0u;
  for (;;) {
    sum = 0u; cnt = 0u; mine = 0u;
#pragma unroll
    for (unsigned j = 0; j < 16; ++j) { const unsigned c = xb_ld(&bar[XB_XCNT(j)]); sum += c; cnt += (c > 0u) ? 1u : 0u; mine = (j == x) ? c : mine; }
    if (sum == G) break;
    __builtin_amdgcn_s_sleep(1);
    if ((++sp & 255u) == 0u) { if (xb_ld(&bar[XB_TMO])) break; if (sp > XB_SPIN_CAP) { atomicAdd(&bar[XB_TMO], 1u); break; } }
  }
  nloc = mine > 0u ? mine : 1u; nx = cnt > 0u ? cnt : 1u;
}
DI void xcd_barrier(const XcdBarrier& b) {
  asm volatile("s_waitcnt vmcnt(0)" ::: "memory");
  __syncthreads();
  if (threadIdx.x == 0) {
    unsigned* bar = b.bar;
    __builtin_amdgcn_s_waitcnt(0);
    unsigned nloc = b.st[0], nx = b.st[1];
    if (nloc == 0u) { xcd_barrier_complete(bar, b.x, nloc, nx); b.st[0] = nloc; b.st[1] = nx; }
    const unsigned old = xb_add(&bar[XB_XSUB(b.x)], 1u);
    const unsigned gen = old / nloc;
    if (old + 1u == (gen + 1u) * nloc) {
      __builtin_amdgcn_fence(__ATOMIC_RELEASE, "agent");
      asm volatile("s_waitcnt vmcnt(0)" ::: "memory");
      const unsigned og = xb_add(&bar[XB_TOP], 1u);
      const unsigned tg = og / nx;
      if (og + 1u == (tg + 1u) * nx) xb_add(&bar[XB_TOPGEN], 1u);
      else XB_SPIN(xb_ld(&bar[XB_TOPGEN]) == tg, bar);
      __builtin_amdgcn_fence(__ATOMIC_ACQUIRE, "agent");
      xb_add(&bar[XB_XGEN(b.x)], 1u);
      asm volatile("s_waitcnt vmcnt(0)" ::: "memory");
    } else {
      XB_SPIN(xb_ld(&bar[XB_XGEN(b.x)]) == gen, bar);
      __builtin_amdgcn_fence(__ATOMIC_ACQUIRE, "agent");
      asm volatile("s_waitcnt vmcnt(0)" ::: "memory");
    }
  }
  __syncthreads();
}
#if ONE_LAUNCH
DI void grid_barrier(unsigned* bar, unsigned& target) {
  target += gridDim.x;
  asm volatile("s_waitcnt vmcnt(0)" ::: "memory");
  __syncthreads();
  if (threadIdx.x == 0) {
    __builtin_amdgcn_fence(__ATOMIC_RELEASE, "agent");
    asm volatile("s_waitcnt vmcnt(0)" ::: "memory");
    __hip_atomic_fetch_add(bar, 1u, __ATOMIC_RELAXED, __HIP_MEMORY_SCOPE_AGENT);
    while (__hip_atomic_load(bar, __ATOMIC_RELAXED, __HIP_MEMORY_SCOPE_AGENT) < target) __builtin_amdgcn_s_sleep(2);
    __builtin_amdgcn_fence(__ATOMIC_ACQUIRE, "agent");
    asm volatile("s_waitcnt vmcnt(0)" ::: "memory");
  }
  __syncthreads();
}
__global__ void __launch_bounds__(256, 2) k_mega(Params p) {
  __shared__ __attribute__((aligned(16))) char smem[SMEM_BYTES];
  cg::grid_group grid = cg::this_grid();
#define RUN(n) do { run_phase<n>(p, smem); if (REPEAT_PHASE == n || (REPEAT_PHASE >= 1000 && (((REPEAT_PHASE - 1000) >> n) & 1))) { GSYNC(); run_phase<n>(p, smem); GSYNC(); run_phase<n>(p, smem); } if (REPEAT_PHASE == 203 && n == 3) { GSYNC(); phase_attn(p, smem, 1); GSYNC(); phase_attn(p, smem, 2); } if (REPEAT_PHASE == 100 + n) { GSYNC(); phase_gemm_bf16<true>(p, (const u16*)(p.ws + WS_C), (const u16*)(p.ws + WS_WPQ), 2048, (u16*)(p.ws + WS_F), 1.f, smem); GSYNC(); phase_gemm_bf16<true>(p, (const u16*)(p.ws + WS_C), (const u16*)(p.ws + WS_WPQ), 2048, (u16*)(p.ws + WS_F), 1.f, smem); } } while (0)
#if CUSTOM_BAR
  volatile unsigned* xst = (volatile unsigned*)(smem + 73728 + 1024);
  if (threadIdx.x == 0) { xst[0] = 0u; xst[1] = 0u; }
  __syncthreads();
  const XcdBarrier xb = xcd_barrier_post((unsigned*)(p.ws + WS_XBAR), xst);
#define GSYNC() xcd_barrier(xb)
#else
#define GSYNC() grid.sync()
#endif
  RUN(0); grid.sync();
  RUN(1); GSYNC();
  RUN(2); GSYNC();
  RUN(3); GSYNC();
  RUN(4); GSYNC();
  RUN(5); GSYNC();
  if (REPEAT_PHASE == 300) { GSYNC(); GSYNC(); GSYNC(); GSYNC(); GSYNC(); GSYNC(); GSYNC(); GSYNC(); }
  RUN(6); GSYNC();
  RUN(7); GSYNC();
  RUN(8); GSYNC();
  RUN(9); GSYNC();
  RUN(10); GSYNC();
  RUN(11); GSYNC();
  RUN(12); GSYNC();
  RUN(13); GSYNC();
#if PEER_RESYNC
  {
    const int nrounds = (NT + 8 * (int)gridDim.x - 1) / (8 * (int)gridDim.x);
    for (int rr = 0; rr < nrounds; rr += PEER_RESYNC) { if (rr) GSYNC(); phase_peer(p, rr, rr + PEER_RESYNC); }
  }
#else
  RUN(14);
#endif
}
#endif

extern "C" void kernel_launch(void* const* d_in, const int* in_sizes, int n_in, void* d_out, int out_size, void* d_ws, size_t ws_size,
                              hipStream_t stream) {
  (void)in_sizes; (void)n_in; (void)out_size;
  if (ws_size < WS_TOTAL) { fprintf(stderr, "workspace too small: %zu < %zu\n", ws_size, (size_t)WS_TOTAL); return; }
  Params p{};
  const float** pp = (const float**)&p;
  for (int i = 0; i < 29; ++i) pp[i] = (const float*)d_in[i];
  p.out = (float*)d_out;
  p.ws = (char*)d_ws;
#if ONE_LAUNCH
  static int grid_blocks = 0;
  if (!grid_blocks) {
    int dev = 0, cus = 0, per_cu = 0;
    hipGetDevice(&dev);
    hipDeviceGetAttribute(&cus, hipDeviceAttributeMultiprocessorCount, dev);
    hipOccupancyMaxActiveBlocksPerMultiprocessor(&per_cu, k_mega, 256, 0);
    if (per_cu > 2) per_cu = 2;
    grid_blocks = cus * per_cu;
  }
  hipMemsetAsync((char*)d_ws + WS_BAR, 0, 2048, stream);
  hipMemsetAsync((char*)d_ws + WS_XBAR, 0, 16384, stream);
  void* args[] = {&p};
  hipError_t e = hipLaunchCooperativeKernel((void*)k_mega, dim3(grid_blocks), dim3(256), args, 0, stream);
  if (e != hipSuccess) fprintf(stderr, "cooperative launch failed: %s (grid %d)\n", hipGetErrorString(e), grid_blocks);
#else
  const int G = 512;
  hipMemsetAsync((char*)d_ws + WS_BAR, 0, 2048, stream);
  k_phase<0><<<G, 256, 0, stream>>>(p);
  k_phase<1><<<G, 256, 0, stream>>>(p);
  k_phase<2><<<G, 256, 0, stream>>>(p);
  k_phase<3><<<G, 256, 0, stream>>>(p);
  k_phase<4><<<G, 256, 0, stream>>>(p);
  k_phase<5><<<G, 256, 0, stream>>>(p);
  k_phase<6><<<G, 256, 0, stream>>>(p);
  k_phase<7><<<G, 256, 0, stream>>>(p);
  k_phase<8><<<G, 256, 0, stream>>>(p);
  k_phase<9><<<G, 256, 0, stream>>>(p);
  k_phase<10><<<G, 256, 0, stream>>>(p);
  k_phase<11><<<G, 256, 0, stream>>>(p);
  k_phase<12><<<G, 256, 0, stream>>>(p);
  k_phase<13><<<G, 256, 0, stream>>>(p);
  k_phase<14><<<G, 256, 0, stream>>>(p);
#endif
}
```
